# Optimizing an MI355X kernel written in HIP

```python
import math
import jax
import jax.numpy as jnp
from jax import lax
import numpy as np

D_MODEL = 1024
BATCH = 4
SEQ = 8192
DEPTH = 2

P_DIM = 256
N_BRANCH = 4
BRANCH_W = 256
DA_HEADS = 4
DA_QK = 32
DA_V = 2 * DA_QK
DSA_HEADS = 4
DSA_HD = 64
IDX_HEADS = 4
IDX_HD = 32
TOPK_MAX = 256
RET_HEADS = 4
RET_QK = 64
RET_V = 64
RET_CHUNK = 128
GLA_HEADS = 4
GLA_QK = 32
GLA_V = 64
GLA_RANK = 16
GLA_GATE_TEMP = 16.0
GLA_CHUNK = 64
D_FF = 2816
CONV_W = 3
Q_BLOCK = 128
N_SOFTMAX_HEADS = DA_HEADS + DSA_HEADS
LN_EPS = 1e-5
NEG_INF = -1e30
DEEPNORM_ALPHA = (2.0 * DEPTH) ** 0.25
DEEPNORM_BETA = (8.0 * DEPTH) ** -0.25

IN_SIZES = (
    DA_HEADS * 2 * DA_QK, DA_HEADS * 2 * DA_QK, DA_HEADS * DA_V,
    DSA_HEADS * DSA_HD, DSA_HEADS * DSA_HD, DSA_HEADS * DSA_HD,
    IDX_HEADS * IDX_HD, IDX_HD, IDX_HEADS,
    RET_HEADS * RET_QK, RET_HEADS * RET_QK, RET_HEADS * RET_V, RET_HEADS * RET_V,
    GLA_HEADS * GLA_QK, GLA_HEADS * GLA_QK, GLA_HEADS * GLA_V, GLA_RANK, GLA_HEADS * GLA_V,
    N_BRANCH * D_MODEL,
)
N_IN = sum(IN_SIZES)

kernel_name = "hybrid_gated_diff_dsa_ret_gla_deepnorm"


def _split_columns(z):
    offsets = np.cumsum(IN_SIZES)[:-1].tolist()
    return jnp.split(z, offsets, axis=-1)


def _layer_norm(x, w, b):
    xf = x.astype(jnp.float32)
    mu = jnp.mean(xf, -1, keepdims=True)
    var = jnp.mean(jnp.square(xf - mu), -1, keepdims=True)
    y = (xf - mu) * lax.rsqrt(var + LN_EPS) * w.astype(jnp.float32) + b.astype(jnp.float32)
    return y.astype(x.dtype)


def _head_rms_norm(o, w):
    return o * lax.rsqrt(jnp.mean(o * o, -1, keepdims=True) + LN_EPS) * w


def _head_layer_norm(o, w):
    mu = jnp.mean(o, -1, keepdims=True)
    var = jnp.mean(jnp.square(o - mu), -1, keepdims=True)
    return (o - mu) * lax.rsqrt(var + LN_EPS) * w


def _alibi_slopes():
    i = jnp.arange(1, N_SOFTMAX_HEADS + 1, dtype=jnp.float32)
    return jnp.power(2.0, -(8.0 / N_SOFTMAX_HEADS) * i)


def _to_qblocks(t):
    bn, s = t.shape[:2]
    return jnp.swapaxes(t.reshape((bn, s // Q_BLOCK, Q_BLOCK) + t.shape[2:]), 0, 1)


def _from_qblocks(t):
    t = jnp.swapaxes(t, 0, 1)
    return t.reshape((t.shape[0], t.shape[1] * t.shape[2]) + t.shape[3:])


def _diff_attention(q, k, v, lam, norm_w, lam_init, slopes):
    bn, s = q.shape[:2]
    nb = s // Q_BLOCK
    scale = DA_QK ** -0.5
    kpos = jnp.arange(s)

    def block(args):
        qi, start = args
        qpos = start + jnp.arange(Q_BLOCK)
        dist = (qpos[:, None] - kpos[None, :]).astype(jnp.float32)
        bias = jnp.where(dist >= 0, -slopes[:, None, None] * dist, NEG_INF)
        sc = jnp.einsum('bqhmd,bkhmd->bhmqk', qi, k) * scale + bias[None, :, None]
        pr = jax.nn.softmax(sc, axis=-1)
        a = pr[:, :, 0] - lam * pr[:, :, 1]
        return jnp.einsum('bhqk,bkhe->bqhe', a, v)

    o = lax.map(block, (_to_qblocks(q), jnp.arange(nb) * Q_BLOCK))
    o = _from_qblocks(o)
    o = _head_rms_norm(o, norm_w) * (1.0 - lam_init)
    return o.reshape(bn, s, DA_HEADS * DA_V)


def _dsa_attention(q, k, v, iq, ik, iw, slopes):
    bn, s = q.shape[:2]
    topk = min(TOPK_MAX, s // 4)
    nb = s // Q_BLOCK
    kpos = jnp.arange(s)
    iscale = IDX_HD ** -0.5
    scale = DSA_HD ** -0.5

    def block(args):
        qi, iqi, iwi, start = args
        qpos = start + jnp.arange(Q_BLOCK)
        causal = kpos[None, :] <= qpos[:, None]
        logits = jnp.einsum('bqhd,bkd->bqhk', iqi, ik) * iscale
        score = jnp.einsum('bqh,bqhk->bqk', iwi, jax.nn.relu(logits))
        score = jnp.where(causal[None], score, -jnp.inf)
        _, idx = lax.top_k(score, topk)
        valid = idx <= qpos[None, :, None]
        kg = jax.vmap(lambda kb, ib: kb[ib])(k, idx)
        vg = jax.vmap(lambda vb, ib: vb[ib])(v, idx)
        dist = (qpos[None, :, None] - idx).astype(jnp.float32)
        sc = jnp.einsum('bqhd,bqkhd->bhqk', qi, kg) * scale - slopes[None, :, None, None] * dist[:, None]
        sc = jnp.where(valid[:, None], sc, NEG_INF)
        pr = jax.nn.softmax(sc, axis=-1)
        return jnp.einsum('bhqk,bqkhd->bqhd', pr, vg)

    o = lax.map(block, (_to_qblocks(q), _to_qblocks(iq), _to_qblocks(iw), jnp.arange(nb) * Q_BLOCK))
    return _from_qblocks(o).reshape(bn, s, DSA_HEADS * DSA_HD)


def _retention(q, k, v):
    bn, s, h, dk = q.shape
    dv = v.shape[-1]
    c = RET_CHUNK
    nc = s // c
    log_g = jnp.log1p(-jnp.power(2.0, -5.0 - jnp.arange(h, dtype=jnp.float32)))
    pos = jnp.arange(c, dtype=jnp.float32)
    rel = pos[:, None] - pos[None, :]
    intra = jnp.where(rel >= 0, jnp.exp(log_g[:, None, None] * jnp.maximum(rel, 0.0)), 0.0)
    q_decay = jnp.exp(log_g[:, None] * (pos[None, :] + 1.0))
    k_decay = jnp.exp(log_g[:, None] * (c - 1.0 - pos[None, :]))
    chunk_decay = jnp.exp(log_g * c)
    k = k * dk ** -0.5

    def to_chunks(t):
        return t.reshape(bn, nc, c, h, t.shape[-1]).transpose(1, 0, 3, 2, 4)

    def step(state, inp):
        qc, kc, vc = inp
        att = jnp.einsum('bhid,bhjd->bhij', qc, kc) * intra
        o = (jnp.einsum('bhij,bhje->bhie', att, vc)
             + jnp.einsum('bhid,bhde->bhie', qc, state) * q_decay[..., None])
        state = (state * chunk_decay[:, None, None]
                 + jnp.einsum('bhjd,bhje->bhde', kc * k_decay[..., None], vc))
        return state, o

    state0 = jnp.zeros((bn, h, dk, dv), jnp.float32)
    _, o = lax.scan(step, state0, (to_chunks(q), to_chunks(k), to_chunks(v)))
    return o.transpose(1, 0, 3, 2, 4).reshape(bn, s, h, dv)


def _gla(q, k, v, log_a):
    bn, s, h, dk = q.shape
    dv = v.shape[-1]
    c = GLA_CHUNK
    nc = s // c
    q = q * dk ** -0.5
    causal = jnp.tril(jnp.ones((c, c), dtype=bool))

    def to_chunks(t):
        return t.reshape(bn, nc, c, h, t.shape[-1]).transpose(1, 0, 3, 2, 4)

    def step(state, inp):
        qc, kc, vc, ac = inp
        b = jnp.cumsum(ac, axis=2)
        diff = b[:, :, :, None, :] - b[:, :, None, :, :]
        dec = jnp.where(causal[:, :, None], jnp.exp(jnp.minimum(diff, 0.0)), 0.0)
        att = jnp.einsum('bhid,bhjd,bhijd->bhij', qc, kc, dec)
        o = (jnp.einsum('bhij,bhje->bhie', att, vc)
             + jnp.einsum('bhid,bhde->bhie', qc * jnp.exp(b), state))
        b_last = b[:, :, -1]
        state = (state * jnp.exp(b_last)[..., None]
                 + jnp.einsum('bhjd,bhje->bhde', kc * jnp.exp(b_last[:, :, None, :] - b), vc))
        return state, o

    state0 = jnp.zeros((bn, h, dk, dv), jnp.float32)
    _, o = lax.scan(step, state0, (to_chunks(q), to_chunks(k), to_chunks(v), to_chunks(log_a)))
    return o.transpose(1, 0, 3, 2, 4).reshape(bn, s, h, dv)


def _causal_dwconv(x, w, b):
    s = x.shape[1]
    xp = jnp.pad(x, ((0, 0), (CONV_W - 1, 0), (0, 0)))
    y = b + w[0] * xp[:, 0:s]
    for j in range(1, CONV_W):
        y = y + w[j] * xp[:, j:j + s]
    return y


def setup_inputs(seed: int = 0) -> dict:
    key = jax.random.key(seed)
    ks = jax.random.split(key, 24)
    f32 = jnp.float32

    def nrm(k, shape, scale):
        return jax.random.normal(k, shape, f32) * scale

    beta = DEEPNORM_BETA
    return {
        "x": nrm(ks[0], (BATCH, SEQ, D_MODEL), 1.0),
        "p": nrm(ks[1], (DEPTH, BATCH, SEQ, P_DIM), 1.0),
        "w_in": nrm(ks[2], (DEPTH, D_MODEL, N_IN), D_MODEL ** -0.5),
        "a_lambda": nrm(ks[3], (DEPTH, 4, DA_QK), 0.1),
        "a_norm_w": 1.0 + nrm(ks[4], (DEPTH, DA_V), 0.02),
        "ret_norm_w": 1.0 + nrm(ks[5], (DEPTH, RET_HEADS * RET_V), 0.02),
        "gla_w_a2": nrm(ks[6], (DEPTH, GLA_RANK, GLA_HEADS * GLA_QK), GLA_RANK ** -0.5),
        "gla_b_a": nrm(ks[7], (DEPTH, GLA_HEADS * GLA_QK), 0.02),
        "gla_norm_w": 1.0 + nrm(ks[8], (DEPTH, GLA_V), 0.02),
        "w_branch": nrm(ks[9], (DEPTH, N_BRANCH, BRANCH_W, D_MODEL), BRANCH_W ** -0.5 * beta),
        "w_out": nrm(ks[10], (DEPTH, D_MODEL, D_MODEL), D_MODEL ** -0.5 * beta),
        "ln1_w": 1.0 + nrm(ks[11], (DEPTH, D_MODEL), 0.02),
        "ln1_b": nrm(ks[12], (DEPTH, D_MODEL), 0.02),
        "w_ffn_up": nrm(ks[13], (DEPTH, D_MODEL, 2 * D_FF), D_MODEL ** -0.5),
        "ffn_conv_w": nrm(ks[14], (DEPTH, CONV_W, D_FF), CONV_W ** -0.5),
        "ffn_conv_b": nrm(ks[15], (DEPTH, D_FF), 0.02),
        "w_ffn_down": nrm(ks[16], (DEPTH, D_FF, D_MODEL), D_FF ** -0.5 * beta),
        "w_ple_gate": nrm(ks[17], (DEPTH, D_MODEL, D_MODEL), D_MODEL ** -0.5),
        "w_ple_proj": nrm(ks[18], (DEPTH, P_DIM, D_MODEL), P_DIM ** -0.5 * beta),
        "ln2_w": 1.0 + nrm(ks[19], (DEPTH, D_MODEL), 0.02),
        "ln2_b": nrm(ks[20], (DEPTH, D_MODEL), 0.02),
    }


def reference(x, p, w_in, a_lambda, a_norm_w, ret_norm_w, gla_w_a2, gla_b_a, gla_norm_w,
              w_branch, w_out, ln1_w, ln1_b, w_ffn_up, ffn_conv_w, ffn_conv_b, w_ffn_down,
              w_ple_gate, w_ple_proj, ln2_w, ln2_b):
    f32 = jnp.float32
    bn, s, _ = x.shape
    slopes = _alibi_slopes()
    slopes_a, slopes_b = slopes[0::2], slopes[1::2]
    for i in range(DEPTH):
        z = (x @ w_in[i]).astype(f32)
        (a_q, a_k, a_v, b_q, b_k, b_v, b_iq, b_ik, b_iw,
         c_q, c_k, c_v, c_g, d_q, d_k, d_v, d_a, d_g, m_g) = _split_columns(z)

        lam_init = 0.8 - 0.6 * math.exp(-0.3 * i)
        lam_p = a_lambda[i].astype(f32)
        lam = jnp.exp(jnp.sum(lam_p[0] * lam_p[1])) - jnp.exp(jnp.sum(lam_p[2] * lam_p[3])) + lam_init
        y_a = _diff_attention(a_q.reshape(bn, s, DA_HEADS, 2, DA_QK), a_k.reshape(bn, s, DA_HEADS, 2, DA_QK),
                              a_v.reshape(bn, s, DA_HEADS, DA_V), lam, a_norm_w[i].astype(f32), lam_init, slopes_a)

        y_b = _dsa_attention(b_q.reshape(bn, s, DSA_HEADS, DSA_HD), b_k.reshape(bn, s, DSA_HEADS, DSA_HD),
                             b_v.reshape(bn, s, DSA_HEADS, DSA_HD), b_iq.reshape(bn, s, IDX_HEADS, IDX_HD),
                             b_ik, b_iw * IDX_HEADS ** -0.5, slopes_b)

        o_c = _retention(c_q.reshape(bn, s, RET_HEADS, RET_QK), c_k.reshape(bn, s, RET_HEADS, RET_QK),
                         c_v.reshape(bn, s, RET_HEADS, RET_V))
        o_c = _head_layer_norm(o_c, ret_norm_w[i].astype(f32).reshape(RET_HEADS, RET_V))
        y_c = jax.nn.silu(c_g) * o_c.reshape(bn, s, RET_HEADS * RET_V)

        log_a = jax.nn.log_sigmoid(d_a @ gla_w_a2[i].astype(f32) + gla_b_a[i].astype(f32)) / GLA_GATE_TEMP
        o_d = _gla(d_q.reshape(bn, s, GLA_HEADS, GLA_QK), d_k.reshape(bn, s, GLA_HEADS, GLA_QK),
                   d_v.reshape(bn, s, GLA_HEADS, GLA_V), log_a.reshape(bn, s, GLA_HEADS, GLA_QK))
        o_d = _head_rms_norm(o_d, gla_norm_w[i].astype(f32))
        y_d = jax.nn.silu(d_g) * o_d.reshape(bn, s, GLA_HEADS * GLA_V)

        gates = jax.nn.sigmoid(m_g).reshape(bn, s, N_BRANCH, D_MODEL)
        branches = (y_a, y_b, y_c, y_d)
        merged = gates[:, :, 0] * (branches[0].astype(x.dtype) @ w_branch[i, 0])
        for n in range(1, N_BRANCH):
            merged = merged + gates[:, :, n] * (branches[n].astype(x.dtype) @ w_branch[i, n])
        mix = merged.astype(x.dtype) @ w_out[i]
        h = _layer_norm(DEEPNORM_ALPHA * x + mix, ln1_w[i], ln1_b[i])

        u, g = jnp.split(h @ w_ffn_up[i], 2, axis=-1)
        g = _causal_dwconv(g, ffn_conv_w[i], ffn_conv_b[i])
        f = (jax.nn.gelu(g) * u) @ w_ffn_down[i]

        e = jax.nn.sigmoid(h @ w_ple_gate[i]) * (p[i] @ w_ple_proj[i])
        x = _layer_norm(DEEPNORM_ALPHA * h + f + e, ln2_w[i], ln2_b[i])
    return x
```

```cpp
#include <hip/hip_runtime.h>
#include <cstdio>
#include <cstdint>

#ifndef EXP
#define EXP 0
#endif
#ifndef EXPM
#define EXPM 15
#endif
#ifndef MK_ONE_LAUNCH
#define MK_ONE_LAUNCH 1
#endif

#define GAS __attribute__((address_space(1)))
#define LAS __attribute__((address_space(3)))
typedef unsigned short bf16;
typedef unsigned u32x4 __attribute__((ext_vector_type(4)));
typedef unsigned u32x2 __attribute__((ext_vector_type(2)));
typedef float f32x2 __attribute__((ext_vector_type(2)));
typedef float f32x4 __attribute__((ext_vector_type(4)));
typedef float f32x16 __attribute__((ext_vector_type(16)));
typedef short bf16x8 __attribute__((ext_vector_type(8)));
typedef short s16x4 __attribute__((ext_vector_type(4)));
typedef GAS unsigned gu32;

constexpr int BATCH = 4, SEQ = 8192, DM = 1024, M = BATCH * SEQ, DEPTH = 2;
constexpr int NIN = 7604, ZW = 3584, DFF = 2816, UGW = 5632, PDIM = 256;
constexpr float LN_EPS = 1e-5f;
constexpr float ALPHA = 1.41421356237f;
constexpr float LOG2E = 1.4426950408889634f;
constexpr int ZC_AQ = 0, ZC_AK = 256, ZC_AV = 512, ZC_BQ = 768, ZC_BK = 1024, ZC_BV = 1280, ZC_CQ = 1536, ZC_CK = 1792, ZC_CV = 2048, ZC_CG = 2304,
              ZC_DQ = 2560, ZC_DK = 2688, ZC_DV = 2816, ZC_DG = 3072, ZC_IQ = 3328, ZC_IK = 3456, ZC_IW = 3488, ZC_DA = 3504;
constexpr int SRC_MG = 3508;

constexpr size_t MiB = 1u << 20;
constexpr size_t WS_CTL = 0, CTL_ZERO_BYTES = 1 * MiB;
constexpr size_t WS_XB = 1 * MiB;
constexpr size_t WS_BIG = 65 * MiB;
constexpr size_t WS_Z = WS_BIG, WS_Y = WS_BIG + 224 * MiB, WS_MERGED = WS_BIG + 288 * MiB, WS_UG = WS_BIG;
constexpr size_t WS_MASK = WS_MERGED, WS_KVC = WS_MERGED + 32 * MiB, WS_KVD = WS_MERGED + 40 * MiB, WS_DE = WS_MERGED + 56 * MiB;
constexpr size_t WS_SCR2 = WS_Z;
constexpr size_t WS_W45 = 417 * MiB, W45_STRIDE = 19 * MiB;
constexpr size_t W45_UP = 0, W45_PG = 11 * MiB, W45_PP = 13 * MiB, W45_DN = 13 * MiB + 512 * 1024;
constexpr size_t WS_PB = 455 * MiB;
constexpr size_t WS_W123 = 487 * MiB;
constexpr size_t WS_END = 506 * MiB;
constexpr size_t W123_W1 = 0, W123_GB = 7 * MiB, W123_WO = 17 * MiB;
constexpr size_t DO_SCR5 = 0;

constexpr int CW_BAR = 4096;

constexpr int RING_BYTES = 131072;
constexpr int MISC_OFF = 131072 + 320;
constexpr int QST_OFF = 132096;
constexpr int LDS_BYTES = 147456;

constexpr int NWAVES = 8;

#define RLX_AGENT __ATOMIC_RELAXED, __HIP_MEMORY_SCOPE_AGENT
__device__ __forceinline__ unsigned f2bf(float f) { unsigned u = __builtin_bit_cast(unsigned, f); return (u + 0x7fffu + ((u >> 16) & 1u)) >> 16; }
typedef __bf16 bf16x2_t __attribute__((ext_vector_type(2)));
__device__ __forceinline__ unsigned pk2(float lo, float hi) { const f32x2 v = {lo, hi}; const bf16x2_t b = __builtin_convertvector(v, bf16x2_t); return __builtin_bit_cast(unsigned, b); }
__device__ __forceinline__ float bflo(unsigned w) { return __uint_as_float(w << 16); }
__device__ __forceinline__ float bfhi(unsigned w) { return __uint_as_float(w & 0xffff0000u); }
__device__ __forceinline__ float bf1(bf16 b) { return __uint_as_float((unsigned)b << 16); }
__device__ __forceinline__ float sigmoidf_(float x) { return __builtin_amdgcn_rcpf(1.0f + __builtin_amdgcn_exp2f(-LOG2E * x)); }
__device__ __forceinline__ float wave_sum(float v) {
#pragma unroll
    for (int o = 1; o < 64; o <<= 1) v += __shfl_xor(v, o);
    return v;
}

#define XB_TMO      128
#define XB_XCNT(j)  (256  + 64 * (j))
#define XB_XSUB(j)  (1280 + 64 * (j))
#define XB_XGEN(j)  (2304 + 64 * (j))
#define XB_TOP      3328
#define XB_TOPGEN   3392
#define XCD_BAR_WORDS 3456
#define XB_SPIN_CAP (1u << 22)

__device__ __forceinline__ unsigned xb_ld(unsigned* p)              { return __hip_atomic_load(p, __ATOMIC_RELAXED, __HIP_MEMORY_SCOPE_AGENT); }
__device__ __forceinline__ unsigned xb_add(unsigned* p, unsigned v) { return __hip_atomic_fetch_add(p, v, __ATOMIC_RELAXED, __HIP_MEMORY_SCOPE_AGENT); }
__device__ __forceinline__ unsigned xb_xcc_id() { return (unsigned)__builtin_amdgcn_s_getreg((3 << 11) | 20) & 0xFu; }
#define XB_SPIN(cond, bar) do { unsigned _sp = 0; while (cond) { __builtin_amdgcn_s_sleep(1); \
    if ((++_sp & 255u) == 0u) { if (xb_ld(&(bar)[XB_TMO])) break; if (_sp > XB_SPIN_CAP) { atomicAdd(&(bar)[XB_TMO], 1u); break; } } } } while (0)

struct XcdBarrier { unsigned* bar; unsigned x; volatile LAS unsigned* st; };

__device__ __forceinline__ XcdBarrier xcd_barrier_post(unsigned* bar, volatile LAS unsigned* st) {
    XcdBarrier b; b.bar = bar; b.x = xb_xcc_id(); b.st = st;
    if (threadIdx.x == 0) (void)xb_add(&bar[XB_XCNT(b.x)], 1u);
    return b;
}
__device__ __forceinline__ void xcd_barrier_complete(unsigned* bar, unsigned x, unsigned& nloc, unsigned& nx) {
    const unsigned G = gridDim.x * gridDim.y * gridDim.z;
    unsigned sum, cnt, mine, sp = 0u;
    for (;;) {
        sum = 0u; cnt = 0u; mine = 0u;
#pragma unroll
        for (unsigned j = 0; j < 16; ++j) { const unsigned c = xb_ld(&bar[XB_XCNT(j)]); sum += c; cnt += (c > 0u) ? 1u : 0u; mine = (j == x) ? c : mine; }
        if (sum == G) break;
        __builtin_amdgcn_s_sleep(1);
        if ((++sp & 255u) == 0u) { if (xb_ld(&bar[XB_TMO])) break; if (sp > XB_SPIN_CAP) { atomicAdd(&bar[XB_TMO], 1u); break; } }
    }
    nloc = mine > 0u ? mine : 1u; nx = cnt > 0u ? cnt : 1u;
}
__device__ __forceinline__ void xcd_barrier(const XcdBarrier& b, const bool leader_thread) {
    asm volatile("s_waitcnt vmcnt(0)" ::: "memory");
    __syncthreads();
    if (leader_thread) {
        unsigned* bar = b.bar;
        __builtin_amdgcn_s_waitcnt(0);
        unsigned nloc = b.st[0], nx = b.st[1];
        if (nloc == 0u) { xcd_barrier_complete(bar, b.x, nloc, nx); b.st[0] = nloc; b.st[1] = nx; }
        const unsigned old = xb_add(&bar[XB_XSUB(b.x)], 1u);
        const unsigned gen = old / nloc;
        if (old + 1u == (gen + 1u) * nloc) {
            __builtin_amdgcn_fence(__ATOMIC_RELEASE, "agent");
            asm volatile("s_waitcnt vmcnt(0)" ::: "memory");
            const unsigned og = xb_add(&bar[XB_TOP], 1u);
            const unsigned tg = og / nx;
            if (og + 1u == (tg + 1u) * nx) xb_add(&bar[XB_TOPGEN], 1u);
            else XB_SPIN(xb_ld(&bar[XB_TOPGEN]) == tg, bar);
            __builtin_amdgcn_fence(__ATOMIC_ACQUIRE, "agent");
            xb_add(&bar[XB_XGEN(b.x)], 1u);
            asm volatile("s_waitcnt vmcnt(0)" ::: "memory");
        } else {
            XB_SPIN(xb_ld(&bar[XB_XGEN(b.x)]) == gen, bar);
            __builtin_amdgcn_fence(__ATOMIC_ACQUIRE, "agent");
            asm volatile("s_waitcnt vmcnt(0)" ::: "memory");
        }
    }
    __syncthreads();
}

namespace pg8 {
constexpr int BM = 256, BK = 64, HALF = 128, HTB = HALF * BK * 2, STAGE_BYTES = 8 * HTB, NXCD = 8, WGM = 8;
__device__ __forceinline__ int lds_byte(int r, int c) { const int st = (r >> 4) * 2 + (c >> 5), rr = r & 15, cc = c & 31, ob = rr * 64 + cc * 2; return st * 1024 + (ob ^ (((ob >> 9) & 1) << 5)); }
__device__ __forceinline__ void stage_rc(int b, int& R, int& C) { const int st = b / 1024, sb = b % 1024, swz = sb ^ (((sb >> 9) & 1) << 5); R = (st >> 1) * 16 + swz / 64; C = (st & 1) * 32 + (swz % 64) / 2; }
__device__ __forceinline__ int perm32(int rho) { const int n = rho >> 4, i = rho & 15; return 8 * (i >> 2) + 4 * n + (i & 3); }

struct UnitD { const char* A; const char* B; int lda2, ldb2, nt, pm, pn, kind; };

__device__ __forceinline__ void tile_map(int L, int nM, int nN, int& pm, int& pn) {
    const int nwg = nM * nN; int wgid = L;
    { const int q = nwg / NXCD, r = nwg % NXCD, xcd = wgid % NXCD, off = wgid / NXCD; wgid = (xcd < r ? xcd * (q + 1) : r * (q + 1) + (xcd - r) * q) + off; }
    const int nig = WGM * nN, gid = wgid / nig, fm = gid * WGM, gsz = (nM - fm) < WGM ? (nM - fm) : WGM;
    pm = fm + ((wgid % nig) % gsz); pn = (wgid % nig) / gsz;
}

template <class Epi, class Sched>
__device__ __forceinline__ void gemm_phase(LAS unsigned char* lds, const Sched& S, const Epi& E, const int tid) {
    const int wid = __builtin_amdgcn_readfirstlane(tid >> 6), lane = tid & 63, wr = wid >> 2, wc = wid & 3, fr = lane & 15, fq = lane >> 4;
    int sR, sRb, sC2;
    { int R, C; stage_rc(tid * 16, R, C); sR = R; sRb = (R & ~31) + perm32(R & 31); sC2 = C * 2; }
    const size_t kstep = (size_t)(BK * 2);
    const unsigned ldsw = (unsigned)wid * 1024u;
    const int aoff = lds_byte(wr * 64 + fr, fq * 8), boff = lds_byte(wc * 32 + fr, fq * 8);
#define PG8_SA(b, h) (((b) * 2 + (h)) * HTB)
#define PG8_SB(b, h) ((4 + (b) * 2 + (h)) * HTB)
#define PG8_STAGE(bufoff, gbase, rows, pitch) do { const unsigned _o = (unsigned)((rows) * (pitch) + sC2); _Pragma("unroll") for (int _i = 0; _i < 2; ++_i) \
        __builtin_amdgcn_global_load_lds((const unsigned*)((const char*)(gbase) + (size_t)(_i * 64) * (pitch) + _o), (LAS unsigned*)(lds + (bufoff) + ldsw + _i * 8192), 16, 0, 0); } while (0)
#define PG8_LDA(dst, b, h) do { _Pragma("unroll") for (int m = 0; m < 4; ++m) _Pragma("unroll") for (int k = 0; k < 2; ++k) dst[m][k] = *(const LAS bf16x8*)(lds + PG8_SA(b, h) + aoff + m * 2048 + k * 1024); } while (0)
#define PG8_LDB(dst, b, h) do { _Pragma("unroll") for (int n = 0; n < 2; ++n) _Pragma("unroll") for (int k = 0; k < 2; ++k) dst[n][k] = *(const LAS bf16x8*)(lds + PG8_SB(b, h) + boff + n * 2048 + k * 1024); } while (0)
#define PG8_MMA(ai, bj, At, Bt) do { __builtin_amdgcn_s_setprio(1); _Pragma("unroll") for (int m = 0; m < 4; ++m) _Pragma("unroll") for (int n = 0; n < 2; ++n) _Pragma("unroll") for (int k = 0; k < 2; ++k) \
        acc[ai][bj][m][n] = __builtin_amdgcn_mfma_f32_16x16x32_bf16(Bt[n][k], At[m][k], acc[ai][bj][m][n], 0, 0, 0); __builtin_amdgcn_s_setprio(0); } while (0)
#define PG8_WAIT_V(n) asm volatile("s_waitcnt vmcnt(" #n ")" ::: "memory")
#define PG8_WAIT_L(n) asm volatile("s_waitcnt lgkmcnt(" #n ")" ::: "memory")
#define PG8_BAR __builtin_amdgcn_s_barrier()
#define PG8_SCHED __builtin_amdgcn_sched_barrier(0)
    UnitD cur, nxt; int ui = 0;
    if (!S.next(0, cur)) return;
    f32x4 acc[2][2][4][2];
#pragma unroll
    for (int a = 0; a < 2; ++a)
#pragma unroll
        for (int b = 0; b < 2; ++b)
#pragma unroll
            for (int m = 0; m < 4; ++m)
#pragma unroll
                for (int n = 0; n < 2; ++n) acc[a][b][m][n] = (f32x4){0.f, 0.f, 0.f, 0.f};
    bf16x8 At[4][2], B0[2][2], B1[2][2];
    const char* cA = cur.A; const char* cB = cur.B;
    int pA = cur.lda2, pB = cur.ldb2;
    PG8_STAGE(PG8_SB(0, 0), cB, sRb, pB); PG8_STAGE(PG8_SB(0, 1), cB + (size_t)HALF * pB, sRb, pB); PG8_STAGE(PG8_SA(0, 0), cA, sR, pA); PG8_STAGE(PG8_SA(0, 1), cA + (size_t)HALF * pA, sR, pA);
    if (wr == 1) PG8_BAR;
    PG8_WAIT_V(2); PG8_BAR;
    PG8_STAGE(PG8_SB(1, 0), cB + kstep, sRb, pB); PG8_STAGE(PG8_SA(1, 0), cA + kstep, sR, pA); PG8_STAGE(PG8_SB(1, 1), cB + (size_t)HALF * pB + kstep, sRb, pB);
    PG8_WAIT_V(6); PG8_BAR;
    for (;;) {
        const bool has_next = S.next(ui + 1, nxt);
        if (!has_next) nxt = cur;
        const char* nA = nxt.A; const char* nB = nxt.B;
        const int nt = cur.nt;
        for (int t = 0; t < nt; t += 2) {
            const bool last = (t == nt - 2);
            const char* a1 = cA + (size_t)(t + 1) * kstep + (size_t)HALF * pA;
            const char* a2 = last ? nA : cA + (size_t)(t + 2) * kstep; const char* b2 = last ? nB : cB + (size_t)(t + 2) * kstep;
            const int p2A = last ? nxt.lda2 : pA, p2B = last ? nxt.ldb2 : pB;
            const char* a2h = a2 + (size_t)HALF * p2A; const char* b2h = b2 + (size_t)HALF * p2B;
            PG8_LDB(B0, 0, 0); PG8_LDB(B1, 0, 1); PG8_SCHED; PG8_LDA(At, 0, 0); PG8_STAGE(PG8_SA(1, 1), a1, sR, pA);
            PG8_WAIT_V(8); PG8_WAIT_L(0); PG8_BAR; PG8_MMA(0, 0, At, B0); PG8_MMA(0, 1, At, B1); PG8_BAR; PG8_SCHED;
            PG8_LDA(At, 0, 1); PG8_STAGE(PG8_SB(0, 0), b2, sRb, p2B); PG8_STAGE(PG8_SB(0, 1), b2h, sRb, p2B); PG8_STAGE(PG8_SA(0, 0), a2, sR, p2A);
            PG8_WAIT_V(8); PG8_WAIT_L(0); PG8_BAR; PG8_MMA(1, 0, At, B0); PG8_MMA(1, 1, At, B1); PG8_BAR; PG8_SCHED;
            PG8_LDB(B0, 1, 0); PG8_LDB(B1, 1, 1); PG8_SCHED; PG8_LDA(At, 1, 0); PG8_STAGE(PG8_SA(0, 1), a2h, sR, p2A);
            PG8_WAIT_V(8); PG8_WAIT_L(0); PG8_BAR; PG8_MMA(0, 0, At, B0); PG8_MMA(0, 1, At, B1); PG8_BAR; PG8_SCHED;
            PG8_LDA(At, 1, 1); PG8_STAGE(PG8_SB(1, 0), b2 + kstep, sRb, p2B); PG8_STAGE(PG8_SB(1, 1), b2h + kstep, sRb, p2B); PG8_STAGE(PG8_SA(1, 0), a2 + kstep, sR, p2A);
            PG8_WAIT_V(8); PG8_WAIT_L(0); PG8_BAR; PG8_MMA(1, 0, At, B0); PG8_MMA(1, 1, At, B1); PG8_BAR; PG8_SCHED;
        }
        if (wr == 0) PG8_BAR;
        { int l2; asm volatile("v_mbcnt_lo_u32_b32 %0, -1, 0\n\tv_mbcnt_hi_u32_b32 %0, -1, %0" : "=v"(l2)); E(acc, cur, wr, wc, l2 & 15, l2 >> 4, wid * 64 + l2); asm volatile("s_waitcnt vmcnt(0)" ::: "memory"); }
        if (!has_next) break;
#pragma unroll
        for (int a = 0; a < 2; ++a)
#pragma unroll
            for (int b = 0; b < 2; ++b)
#pragma unroll
                for (int m = 0; m < 4; ++m)
#pragma unroll
                    for (int n = 0; n < 2; ++n) acc[a][b][m][n] = (f32x4){0.f, 0.f, 0.f, 0.f};
        cur = nxt; cA = nA; cB = nB; pA = cur.lda2; pB = cur.ldb2;
        ++ui;
        if (wr == 1) PG8_BAR;
    }
    PG8_WAIT_V(0);
    PG8_BAR;
#undef PG8_SA
#undef PG8_SB
#undef PG8_STAGE
#undef PG8_LDA
#undef PG8_LDB
#undef PG8_MMA
#undef PG8_WAIT_V
#undef PG8_WAIT_L
#undef PG8_BAR
#undef PG8_SCHED
}

struct SchedPlain {
    const char* A; const char* B; int lda2, ldb2, nt, nM, nN, G, c;
    __device__ __forceinline__ bool next(int i, UnitD& u) const {
        const long L = (long)i * G + c; if (L >= (long)nM * nN) return false;
        int pm, pn; tile_map((int)L, nM, nN, pm, pn);
        u.A = A + (size_t)pm * 256 * lda2; u.B = B + (size_t)pn * 256 * ldb2; u.lda2 = lda2; u.ldb2 = ldb2; u.nt = nt; u.pm = pm; u.pn = pn; u.kind = i; return true;
    }
};
struct SchedG5b {
    const char* A; const char* B; int G, c;
    __device__ __forceinline__ bool next(int i, UnitD& u) const {
        const long L = (long)i * G + c; if (L >= 128 * 4) return false;
        int pm, pn; tile_map((int)L, 128, 4, pm, pn);
        u.A = A + (size_t)pm * 256 * (UGW * 2); u.lda2 = UGW * 2; u.B = B + (size_t)pn * 256 * (DFF * 2); u.ldb2 = DFF * 2; u.nt = 44; u.pm = pm; u.pn = pn; u.kind = i; return true;
    }
};

#define EPI_LOOP for (int ai = 0; ai < 2; ++ai) _Pragma("unroll") for (int m = 0; m < 4; ++m) _Pragma("unroll") for (int bj = 0; bj < 2; ++bj)
struct EpiStore {
    bf16* O; int ldc;
    __device__ __forceinline__ void operator()(const f32x4 (&acc)[2][2][4][2], const UnitD& u, int wr, int wc, int fr, int fq, int tid) const {
        const int row0 = u.pm * BM + wr * 64 + fr, col0 = u.pn * BM + wc * 32 + 8 * fq;
#pragma unroll
        EPI_LOOP { const f32x4 v0 = acc[ai][bj][m][0], v1 = acc[ai][bj][m][1];
            u32x4 w; w.x = pk2(v0[0], v0[1]); w.y = pk2(v0[2], v0[3]); w.z = pk2(v1[0], v1[1]); w.w = pk2(v1[2], v1[3]);
            *(u32x4*)(O + (size_t)(row0 + ai * HALF + m * 16) * ldc + col0 + bj * HALF) = w; }
    }
};
struct EpiSlotStore {
    unsigned char* sc_; int act;
    __device__ __forceinline__ void operator()(const f32x4 (&acc)[2][2][4][2], const UnitD& u, int wr, int wc, int fr, int fq, int tid) const {
        unsigned loff = (unsigned)tid * 16u; asm volatile("" : "+v"(loff));
        unsigned char* sc = sc_ + (size_t)u.kind * 131072 + loff;
#pragma unroll
        EPI_LOOP { const int q = (ai * 2 + bj) * 4 + m; f32x4 v0 = acc[ai][bj][m][0], v1 = acc[ai][bj][m][1];
            if (act) { v0 = (f32x4){sigmoidf_(v0[0]), sigmoidf_(v0[1]), sigmoidf_(v0[2]), sigmoidf_(v0[3])}; v1 = (f32x4){sigmoidf_(v1[0]), sigmoidf_(v1[1]), sigmoidf_(v1[2]), sigmoidf_(v1[3])}; }
            u32x4 w; w.x = pk2(v0[0], v0[1]); w.y = pk2(v0[2], v0[3]); w.z = pk2(v1[0], v1[1]); w.w = pk2(v1[2], v1[3]);
            *(u32x4*)(sc + (size_t)q * 8192) = w; }
    }
};
struct EpiSlotMul {
    unsigned char* sc_;
    __device__ __forceinline__ void operator()(const f32x4 (&acc)[2][2][4][2], const UnitD& u, int wr, int wc, int fr, int fq, int tid) const {
        unsigned loff = (unsigned)tid * 16u; asm volatile("" : "+v"(loff));
        unsigned char* sc = sc_ + (size_t)u.kind * 131072 + loff;
#pragma unroll
        EPI_LOOP { const int q = (ai * 2 + bj) * 4 + m; const f32x4 v0 = acc[ai][bj][m][0], v1 = acc[ai][bj][m][1];
            u32x4* sp = (u32x4*)(sc + (size_t)q * 8192); const u32x4 p = *sp;
            u32x4 w; w.x = pk2(sigmoidf_(v0[0]) * bflo(p.x), sigmoidf_(v0[1]) * bfhi(p.x)); w.y = pk2(sigmoidf_(v0[2]) * bflo(p.y), sigmoidf_(v0[3]) * bfhi(p.y));
            w.z = pk2(sigmoidf_(v1[0]) * bflo(p.z), sigmoidf_(v1[1]) * bfhi(p.z)); w.w = pk2(sigmoidf_(v1[2]) * bflo(p.w), sigmoidf_(v1[3]) * bfhi(p.w));
            *sp = w;
            if (m & 1) asm volatile("" ::: "memory"); }
    }
};
struct EpiBranch {
    const unsigned char* sc_; bf16* MG; int first;
    __device__ __forceinline__ void operator()(const f32x4 (&acc)[2][2][4][2], const UnitD& u, int wr, int wc, int fr, int fq, int tid) const {
        const int row0 = u.pm * BM + wr * 64 + fr, col0 = u.pn * BM + wc * 32 + 8 * fq;
        unsigned loff = (unsigned)tid * 16u; asm volatile("" : "+v"(loff));
        const unsigned char* sc = sc_ + (size_t)u.kind * 131072 + loff;
#pragma unroll
        EPI_LOOP { const int q = (ai * 2 + bj) * 4 + m; const f32x4 v0 = acc[ai][bj][m][0], v1 = acc[ai][bj][m][1];
            const u32x4 g = *(const u32x4*)(sc + (size_t)q * 8192);
            u32x4* p = (u32x4*)(MG + (size_t)(row0 + ai * HALF + m * 16) * DM + col0 + bj * HALF);
            f32x4 t0 = (f32x4){bflo(g.x) * v0[0], bfhi(g.x) * v0[1], bflo(g.y) * v0[2], bfhi(g.y) * v0[3]};
            f32x4 t1 = (f32x4){bflo(g.z) * v1[0], bfhi(g.z) * v1[1], bflo(g.w) * v1[2], bfhi(g.w) * v1[3]};
            if (!first) { const u32x4 x = *p; t0 += (f32x4){bflo(x.x), bfhi(x.x), bflo(x.y), bfhi(x.y)}; t1 += (f32x4){bflo(x.z), bfhi(x.z), bflo(x.w), bfhi(x.w)}; }
            u32x4 w; w.x = pk2(t0[0], t0[1]); w.y = pk2(t0[2], t0[3]); w.z = pk2(t1[0], t1[1]); w.w = pk2(t1[2], t1[3]);
            *p = w;
            if (m & 1) asm volatile("" ::: "memory"); }
    }
};
struct EpiG3 {
    bf16* XB;
    __device__ __forceinline__ void operator()(const f32x4 (&acc)[2][2][4][2], const UnitD& u, int wr, int wc, int fr, int fq, int tid) const {
        const int row0 = u.pm * BM + wr * 64 + fr, col0 = u.pn * BM + wc * 32 + 8 * fq;
#pragma unroll
        EPI_LOOP { const f32x4 v0 = acc[ai][bj][m][0], v1 = acc[ai][bj][m][1];
            u32x4* p = (u32x4*)(XB + (size_t)(row0 + ai * HALF + m * 16) * DM + col0 + bj * HALF); const u32x4 x = *p;
            u32x4 w; w.x = pk2(ALPHA * bflo(x.x) + v0[0], ALPHA * bfhi(x.x) + v0[1]); w.y = pk2(ALPHA * bflo(x.y) + v0[2], ALPHA * bfhi(x.y) + v0[3]);
            w.z = pk2(ALPHA * bflo(x.z) + v1[0], ALPHA * bfhi(x.z) + v1[1]); w.w = pk2(ALPHA * bflo(x.w) + v1[2], ALPHA * bfhi(x.w) + v1[3]);
            *p = w; }
    }
};
struct EpiG5b {
    const unsigned char* esc_; bf16* XB;
    __device__ __forceinline__ void operator()(const f32x4 (&acc)[2][2][4][2], const UnitD& u, int wr, int wc, int fr, int fq, int tid) const {
        const int row0 = u.pm * BM + wr * 64 + fr, col0 = u.pn * BM + wc * 32 + 8 * fq;
        unsigned loff = (unsigned)tid * 16u; asm volatile("" : "+v"(loff));
        const unsigned char* esc = esc_ + (size_t)u.kind * 131072 + loff;
#pragma unroll
        EPI_LOOP { const int q = (ai * 2 + bj) * 4 + m; const f32x4 v0 = acc[ai][bj][m][0], v1 = acc[ai][bj][m][1];
            const u32x4 e = *(const u32x4*)(esc + (size_t)q * 8192);
            u32x4* p = (u32x4*)(XB + (size_t)(row0 + ai * HALF + m * 16) * DM + col0 + bj * HALF); const u32x4 x = *p;
            u32x4 w; w.x = pk2(ALPHA * bflo(x.x) + v0[0] + bflo(e.x), ALPHA * bfhi(x.x) + v0[1] + bfhi(e.x)); w.y = pk2(ALPHA * bflo(x.y) + v0[2] + bflo(e.y), ALPHA * bfhi(x.y) + v0[3] + bfhi(e.y));
            w.z = pk2(ALPHA * bflo(x.z) + v1[0] + bflo(e.z), ALPHA * bfhi(x.z) + v1[1] + bfhi(e.z)); w.w = pk2(ALPHA * bflo(x.w) + v1[2] + bflo(e.w), ALPHA * bfhi(x.w) + v1[3] + bfhi(e.w));
            *p = w;
            if (m & 1) asm volatile("" ::: "memory"); }
    }
};
}

struct Frame {
    LAS unsigned char* lds;
    int tid, lane, wave, G, wg;
    unsigned char* ws; unsigned char* dob;
};
struct Args { const float* in[21]; float* out; unsigned char* ws; int ph_lo, ph_hi; };

__device__ __forceinline__ int z_src(int n, float& sc) {
    sc = 1.f;
    if (n < 768) { if (n < 256) sc = 0.17677669529663687f * LOG2E; return n; }
    if (n < 1536) { if (n < 1024) sc = 0.125f * LOG2E; return n; }
    if (n < 2560) { if (n >= 1792 && n < 2048) sc = 0.125f; return 1700 + (n - 1536); }
    if (n < 2816) { if (n < 2688) sc = 0.17677669529663687f; return 2724 + (n - 2560); }
    if (n < 3072) return 2980 + (n - 2816);
    if (n < 3328) return 3252 + (n - 3072);
    if (n < 3456) return 1536 + (n - 3328);
    if (n < 3488) return 1664 + (n - 3456);
    if (n < 3492) return 1696 + (n - 3488);
    if (n >= 3504 && n < 3520) return 3236 + (n - 3504);
    return -1;
}
template <int MODE>
__device__ __forceinline__ void transpose_item(const float* W, int Nsrc, int soff, bf16* WT, int dpitch, int dcol0, int k0, int n0, LAS float* scr, int lane) {
    const int nn = lane & 31; float sc = 1.f; int s;
    if (MODE == 1) s = z_src(n0 + nn, sc); else s = soff + n0 + nn;
#pragma unroll 8
    for (int i = 0; i < 32; ++i) { const int kk = 2 * i + (lane >> 5); scr[kk * 33 + nn] = (s >= 0) ? W[(size_t)(k0 + kk) * Nsrc + s] * sc : 0.f; }
    asm volatile("s_waitcnt lgkmcnt(0)" ::: "memory");
    const int c = lane & 7;
#pragma unroll
    for (int j = 0; j < 4; ++j) { const int n = (lane >> 3) + 8 * j; const LAS float* sp = scr + (8 * c) * 33 + n;
        u32x4 o; o.x = pk2(sp[0 * 33], sp[1 * 33]); o.y = pk2(sp[2 * 33], sp[3 * 33]); o.z = pk2(sp[4 * 33], sp[5 * 33]); o.w = pk2(sp[6 * 33], sp[7 * 33]);
        *(u32x4*)(WT + (size_t)(n0 + n) * dpitch + dcol0 + k0 + 8 * c) = o; }
    asm volatile("s_waitcnt lgkmcnt(0)" ::: "memory");
}
typedef __attribute__((address_space(4))) const struct Args* KArgPtr;
__device__ __forceinline__ void convert_w123(Frame& F, const float* w_in, const float* w_branch, const float* w_out) {
    LAS float* scr = (LAS float*)(F.lds + F.wave * 16384);
    const int gw = F.wg * NWAVES + F.wave, NGW = F.G * NWAVES;
    constexpr int I1 = 16 * 112, I2 = 16 * 128, I3 = 4 * 128, I4 = 16 * 32;
    unsigned char* w123 = F.ws + WS_W123;
    for (int it = gw; it < I1 + I2 + I3 + I4; it += NGW) {
        int r = it;
        if (r < I1) { transpose_item<1>(w_in, NIN, 0, (bf16*)(w123 + W123_W1), 1024, 0, 64 * (r / 112), 32 * (r % 112), scr, F.lane); continue; } r -= I1;
        if (r < I2) { transpose_item<0>(w_in, NIN, SRC_MG, (bf16*)(w123 + W123_GB), 1024, 0, 64 * (r / 128), 32 * (r % 128), scr, F.lane); continue; } r -= I2;
        if (r < I3) { const int n = r / 128, rr = r % 128; transpose_item<0>(w_branch + (size_t)n * 256 * DM, DM, 0, (bf16*)(w123 + W123_GB + 8 * MiB) + (size_t)n * 1024 * 256, 256, 0, 64 * (rr / 32), 32 * (rr % 32), scr, F.lane); continue; } r -= I3;
        transpose_item<0>(w_out, DM, 0, (bf16*)(w123 + W123_WO), 1024, 0, 64 * (r / 32), 32 * (r % 32), scr, F.lane);
    }
}
__device__ __forceinline__ void p0_prologue(Frame& F, __attribute__((address_space(4))) const Args* Ap) {
    LAS float* scr = (LAS float*)(F.lds + F.wave * 16384);
    const int gw = F.wg * NWAVES + F.wave, NGW = F.G * NWAVES;
    constexpr int I5 = 16 * 176, I6 = 16 * 32, I7 = 4 * 32, I8 = 44 * 32;
    constexpr int IL = I5 + I6 + I7 + I8;
    for (int it = gw; it < 2 * IL; it += NGW) {
        const int l = it / IL; int r = it - l * IL;
        unsigned char* w45 = F.ws + WS_W45 + (size_t)l * W45_STRIDE;
        if (r < I5) { transpose_item<0>(Ap->in[13] + (size_t)l * DM * UGW, UGW, 0, (bf16*)(w45 + W45_UP), 1024, 0, 64 * (r / 176), 32 * (r % 176), scr, F.lane); continue; } r -= I5;
        if (r < I6) { transpose_item<0>(Ap->in[17] + (size_t)l * DM * DM, DM, 0, (bf16*)(w45 + W45_PG), 1024, 0, 64 * (r / 32), 32 * (r % 32), scr, F.lane); continue; } r -= I6;
        if (r < I7) { transpose_item<0>(Ap->in[18] + (size_t)l * PDIM * DM, DM, 0, (bf16*)(w45 + W45_PP), 256, 0, 64 * (r / 32), 32 * (r % 32), scr, F.lane); continue; } r -= I7;
        transpose_item<0>(Ap->in[16] + (size_t)l * DFF * DM, DM, 0, (bf16*)(w45 + W45_DN), DFF, 0, 64 * (r / 32), 32 * (r % 32), scr, F.lane);
    }
    convert_w123(F, Ap->in[2], Ap->in[9], Ap->in[10]);
    {   const size_t n8 = (size_t)M * DM / 8; const f32x4* src = (const f32x4*)Ap->in[0]; u32x4* dst = (u32x4*)(F.ws + WS_XB);
        for (size_t i = (size_t)F.wg * 512 + F.tid; i < n8; i += (size_t)F.G * 512) { const f32x4 a = src[2 * i], b = src[2 * i + 1]; u32x4 o; o.x = pk2(a[0], a[1]); o.y = pk2(a[2], a[3]); o.z = pk2(b[0], b[1]); o.w = pk2(b[2], b[3]); dst[i] = o; } }
    {   const size_t n8 = (size_t)DEPTH * M * PDIM / 8; const f32x4* src = (const f32x4*)Ap->in[1]; u32x4* dst = (u32x4*)(F.ws + WS_PB);
        for (size_t i = (size_t)F.wg * 512 + F.tid; i < n8; i += (size_t)F.G * 512) { const f32x4 a = src[2 * i], b = src[2 * i + 1]; u32x4 o; o.x = pk2(a[0], a[1]); o.y = pk2(a[2], a[3]); o.z = pk2(b[0], b[1]); o.w = pk2(b[2], b[3]); dst[i] = o; } }
}

__device__ __forceinline__ void ln_phase(Frame& F, const float* w, const float* bvec, float* outf) {
    const int gw = F.wg * NWAVES + F.wave, NGW = F.G * NWAVES;
    bf16* XB = (bf16*)(F.ws + WS_XB);
    for (int row = gw; row < M; row += NGW) {
        u32x4* p = (u32x4*)(XB + (size_t)row * DM) + F.lane;
        const u32x4 a = p[0], b = p[64];
        float v[16] = {bflo(a.x), bfhi(a.x), bflo(a.y), bfhi(a.y), bflo(a.z), bfhi(a.z), bflo(a.w), bfhi(a.w), bflo(b.x), bfhi(b.x), bflo(b.y), bfhi(b.y), bflo(b.z), bfhi(b.z), bflo(b.w), bfhi(b.w)};
        float s = 0.f;
#pragma unroll
        for (int i = 0; i < 16; ++i) s += v[i];
        const float mean = wave_sum(s) * (1.f / DM); float q = 0.f;
#pragma unroll
        for (int i = 0; i < 16; ++i) { v[i] -= mean; q += v[i] * v[i]; }
        const float rstd = 1.f / sqrtf(wave_sum(q) * (1.f / DM) + LN_EPS);
        const int c0 = F.lane * 8, c1 = 512 + F.lane * 8;
        const f32x4 w0 = *(const f32x4*)(w + c0), w1 = *(const f32x4*)(w + c0 + 4), w2 = *(const f32x4*)(w + c1), w3 = *(const f32x4*)(w + c1 + 4);
        const f32x4 b0 = *(const f32x4*)(bvec + c0), b1 = *(const f32x4*)(bvec + c0 + 4), b2 = *(const f32x4*)(bvec + c1), b3 = *(const f32x4*)(bvec + c1 + 4);
        f32x4 y0, y1, y2, y3;
#pragma unroll
        for (int i = 0; i < 4; ++i) { y0[i] = v[i] * rstd * w0[i] + b0[i]; y1[i] = v[4 + i] * rstd * w1[i] + b1[i]; y2[i] = v[8 + i] * rstd * w2[i] + b2[i]; y3[i] = v[12 + i] * rstd * w3[i] + b3[i]; }
        u32x4 o0, o1; o0.x = pk2(y0[0], y0[1]); o0.y = pk2(y0[2], y0[3]); o0.z = pk2(y1[0], y1[1]); o0.w = pk2(y1[2], y1[3]);
        o1.x = pk2(y2[0], y2[1]); o1.y = pk2(y2[2], y2[3]); o1.z = pk2(y3[0], y3[1]); o1.w = pk2(y3[2], y3[3]);
        p[0] = o0; p[64] = o1;
        if (outf) { f32x4* op = (f32x4*)(outf + (size_t)row * DM); op[2 * F.lane] = y0; op[2 * F.lane + 1] = y1; op[128 + 2 * F.lane] = y2; op[128 + 2 * F.lane + 1] = y3; }
    }
}

__device__ __forceinline__ float gelu_tanh_(float y) { const float t = 1.5957691216057308f * (y + 0.044715f * y * y * y); return y * __builtin_amdgcn_rcpf(1.0f + __builtin_amdgcn_exp2f(-LOG2E * t)); }
__device__ __forceinline__ void up8(const u32x4 w, float (&v)[8]) { v[0] = bflo(w.x); v[1] = bfhi(w.x); v[2] = bflo(w.y); v[3] = bfhi(w.y); v[4] = bflo(w.z); v[5] = bfhi(w.z); v[6] = bflo(w.w); v[7] = bfhi(w.w); }
__device__ __forceinline__ void ffn_act_phase(Frame& F, const float* cw, const float* cb) {
    bf16* UG = (bf16*)(F.ws + WS_UG);
    constexpr int NCG = DFF / 8, NRB = M / 64;
    for (int task = F.wg * 512 + F.tid; task < NCG * NRB; task += F.G * 512) {
        const int rb = task / NCG, cg = task - rb * NCG; const int t0 = rb * 64, c0 = cg * 8;
        float w0[8], w1[8], w2[8], bb[8];
#pragma unroll
        for (int i = 0; i < 8; ++i) { w0[i] = cw[c0 + i]; w1[i] = cw[DFF + c0 + i]; w2[i] = cw[2 * DFF + c0 + i]; bb[i] = cb[c0 + i]; }
        float gm2[8], gm1[8];
        if ((t0 & (SEQ - 1)) == 0) {
#pragma unroll
            for (int i = 0; i < 8; ++i) { gm2[i] = 0.f; gm1[i] = 0.f; }
        } else { up8(*(const u32x4*)(UG + (size_t)(t0 - 2) * UGW + DFF + c0), gm2); up8(*(const u32x4*)(UG + (size_t)(t0 - 1) * UGW + DFF + c0), gm1); }
        for (int r = 0; r < 64; ++r) {
            bf16* rowp = UG + (size_t)(t0 + r) * UGW;
            float g0[8], uu[8]; up8(*(const u32x4*)(rowp + DFF + c0), g0); up8(*(const u32x4*)(rowp + c0), uu);
            float o[8];
#pragma unroll
            for (int i = 0; i < 8; ++i) { const float y = bb[i] + w0[i] * gm2[i] + w1[i] * gm1[i] + w2[i] * g0[i]; o[i] = gelu_tanh_(y) * uu[i]; gm2[i] = gm1[i]; gm1[i] = g0[i]; }
            u32x4 w; w.x = pk2(o[0], o[1]); w.y = pk2(o[2], o[3]); w.z = pk2(o[4], o[5]); w.w = pk2(o[6], o[7]);
            *(u32x4*)(rowp + c0) = w;
        }
    }
}

namespace mx {
__device__ __forceinline__ f32x16 mfma32(bf16x8 a, bf16x8 b, f32x16 c) { return __builtin_amdgcn_mfma_f32_32x32x16_bf16(a, b, c, 0, 0, 0); }
__device__ __forceinline__ f32x16 splat16(float v) { f32x16 r;
#pragma unroll
    for (int i = 0; i < 16; ++i) r[i] = v;
    return r; }
__device__ __forceinline__ int crow_c(int e) { return (e & 3) + 8 * (e >> 2); }
typedef short v4i16_t __attribute__((ext_vector_type(4)));
__device__ __forceinline__ s16x4 vtr(const LAS unsigned char* p) { return __builtin_bit_cast(s16x4, __builtin_amdgcn_ds_read_tr16_b64_v4i16((LAS v4i16_t*)p)); }
__device__ __forceinline__ bf16x8 pack8(float a0, float a1, float a2, float a3, float a4, float a5, float a6, float a7) {
    u32x4 w; w.x = pk2(a0, a1); w.y = pk2(a2, a3); w.z = pk2(a4, a5); w.w = pk2(a6, a7); return __builtin_bit_cast(bf16x8, w); }

__device__ __forceinline__ float log2gam(int h) { return __builtin_log2f(1.0f - __builtin_exp2f(-5.0f - (float)h)); }
__device__ __forceinline__ void prepkv_unit(Frame& F, int blk, const float* wa2, const float* bap) {
    bf16* Z = (bf16*)(F.ws + WS_Z);
    const size_t r0 = (size_t)blk * 256; const int b = blk >> 5, cb = blk & 31;
    const int tid = F.tid;
    {   const int ch = tid >> 7, col = tid & 127;
        const float ba = bap[col];
        float wa[16];
#pragma unroll
        for (int r = 0; r < 16; ++r) wa[r] = wa2[r * 128 + col];
        float cum = 0.f;
        for (int t = 0; t < 64; ++t) {
            const bf16* zr = Z + (r0 + ch * 64 + t) * ZW; float da[8], db[8]; up8(*(const u32x4*)(zr + ZC_DA), da); up8(*(const u32x4*)(zr + ZC_DA + 8), db);
            float x = ba;
#pragma unroll
            for (int r = 0; r < 8; ++r) x += da[r] * wa[r];
#pragma unroll
            for (int r = 0; r < 8; ++r) x += db[r] * wa[8 + r];
            const float ls = fminf(x, 0.f) - __logf(1.0f + __expf(-fabsf(x)));
            cum += ls * 0.0625f;
        }
        const float bl = cum; cum = 0.f;
        for (int t = 0; t < 64; ++t) {
            bf16* zr = Z + (r0 + ch * 64 + t) * ZW; float da[8], db[8]; up8(*(const u32x4*)(zr + ZC_DA), da); up8(*(const u32x4*)(zr + ZC_DA + 8), db);
            float x = ba;
#pragma unroll
            for (int r = 0; r < 8; ++r) x += da[r] * wa[r];
#pragma unroll
            for (int r = 0; r < 8; ++r) x += db[r] * wa[8 + r];
            const float ls = fminf(x, 0.f) - __logf(1.0f + __expf(-fabsf(x)));
            cum += ls * 0.0625f;
            const float q = bf1(zr[ZC_DQ + col]), k = bf1(zr[ZC_DK + col]);
            zr[ZC_DQ + col] = (bf16)f2bf(q * __expf(cum - bl)); zr[ZC_DK + col] = (bf16)f2bf(k * __expf(bl - cum));
        }
        ((float*)(F.ws + WS_DE))[((size_t)b * 128 + cb * 4 + ch) * 128 + col] = __expf(bl);
    }
    for (int idx = tid; idx < 256 * 64; idx += 512) {
        const int row = idx >> 6, chunk = idx & 63, isk = chunk >> 5, c8 = (chunk & 31) * 8, h = c8 >> 6;
        const float e = (float)(255 - row) * log2gam(h); const float f = __builtin_amdgcn_exp2f(isk ? e : -e);
        u32x4* p = (u32x4*)(Z + (r0 + row) * ZW + (isk ? ZC_CK : ZC_CQ) + c8); float v[8]; up8(*p, v);
        u32x4 w; w.x = pk2(v[0] * f, v[1] * f); w.y = pk2(v[2] * f, v[3] * f); w.z = pk2(v[4] * f, v[5] * f); w.w = pk2(v[6] * f, v[7] * f); *p = w;
    }
    __threadfence_block(); __syncthreads();
    LAS unsigned char* Kl = F.lds; LAS unsigned char* Vl = F.lds + 36864;
    for (int h = 0; h < 4; ++h) {
        for (int idx = tid; idx < 256 * 8; idx += 512) { const int row = idx >> 3, c = idx & 7;
            *(LAS u32x4*)(Kl + row * 144 + c * 16) = *(const u32x4*)(Z + (r0 + row) * ZW + ZC_CK + h * 64 + c * 8);
            *(LAS u32x4*)(Vl + row * 144 + c * 16) = *(const u32x4*)(Z + (r0 + row) * ZW + ZC_CV + h * 64 + c * 8); }
        __syncthreads();
        {   const int d = tid >> 3, dk8 = (tid & 7) * 8; float acc[8];
#pragma unroll
            for (int i = 0; i < 8; ++i) acc[i] = 0.f;
            for (int j = 0; j < 256; ++j) { const float vv = bf1(*(const LAS bf16*)(Vl + j * 144 + d * 2)); float kk[8]; up8(*(const LAS u32x4*)(Kl + j * 144 + dk8 * 2), kk);
#pragma unroll
                for (int i = 0; i < 8; ++i) acc[i] += vv * kk[i]; }
            float* o = (float*)(F.ws + WS_KVC) + ((size_t)((b * 4 + h) * 32 + cb) * 4096 + d * 64 + dk8);
            *(f32x4*)o = (f32x4){acc[0], acc[1], acc[2], acc[3]}; *(f32x4*)(o + 4) = (f32x4){acc[4], acc[5], acc[6], acc[7]}; }
        __syncthreads();
        for (int idx = tid; idx < 256 * 8; idx += 512) { const int row = idx >> 3, c = idx & 7;
            if (c < 4) *(LAS u32x4*)(Kl + row * 144 + c * 16) = *(const u32x4*)(Z + (r0 + row) * ZW + ZC_DK + h * 32 + c * 8);
            *(LAS u32x4*)(Vl + row * 144 + c * 16) = *(const u32x4*)(Z + (r0 + row) * ZW + ZC_DV + h * 64 + c * 8); }
        __syncthreads();
        {   const int ch = tid >> 7, d = (tid >> 1) & 63, dk16 = (tid & 1) * 16; float acc[16];
#pragma unroll
            for (int i = 0; i < 16; ++i) acc[i] = 0.f;
            for (int j = 0; j < 64; ++j) { const int row = ch * 64 + j; const float vv = bf1(*(const LAS bf16*)(Vl + row * 144 + d * 2)); float k0[8], k1[8];
                up8(*(const LAS u32x4*)(Kl + row * 144 + dk16 * 2), k0); up8(*(const LAS u32x4*)(Kl + row * 144 + dk16 * 2 + 16), k1);
#pragma unroll
                for (int i = 0; i < 8; ++i) { acc[i] += vv * k0[i]; acc[8 + i] += vv * k1[i]; } }
            float* o = (float*)(F.ws + WS_KVD) + ((size_t)((b * 4 + h) * 128 + cb * 4 + ch) * 2048 + d * 32 + dk16);
#pragma unroll
            for (int i = 0; i < 4; ++i) *(f32x4*)(o + 4 * i) = (f32x4){acc[4 * i], acc[4 * i + 1], acc[4 * i + 2], acc[4 * i + 3]}; }
        __syncthreads();
    }
}

__device__ __forceinline__ void scan_phase(Frame& F) {
    const int gt = F.wg * 512 + F.tid, NT = F.G * 512;
    for (int e = gt; e < 16 * 4096; e += NT) {
        const int bh = e >> 12, idx = e & 4095, h = bh & 3; const float g256 = __builtin_amdgcn_exp2f(256.0f * log2gam(h));
        float* p = (float*)(F.ws + WS_KVC) + (size_t)bh * 32 * 4096 + idx; float S = 0.f;
        for (int c = 0; c < 32; ++c) { const float kv = p[(size_t)c * 4096]; const float Sp = g256 * S; p[(size_t)c * 4096] = Sp; S = Sp + kv; }
    }
    for (int e = gt; e < 16 * 2048; e += NT) {
        const int bh = e >> 11, idx = e & 2047, b = bh >> 2, h = bh & 3, dk = idx & 31;
        float* p = (float*)(F.ws + WS_KVD) + (size_t)bh * 128 * 2048 + idx; const float* de = (const float*)(F.ws + WS_DE) + (size_t)b * 128 * 128 + h * 32 + dk; float S = 0.f;
        for (int c = 0; c < 128; ++c) { const float kv = p[(size_t)c * 2048]; const float Sp = de[c * 128] * S; p[(size_t)c * 2048] = Sp; S = Sp + kv; }
    }
}

constexpr int HPITCH = 1026, CAP = 256;
struct QState { unsigned mode, thr_lo, thr_hi, thr_idx, krem, lcount, pad0, pad1; };
__device__ __forceinline__ unsigned okey_of(float s) { const unsigned u = __float_as_uint(s); return u ^ ((unsigned)((int)u >> 31) | 0x80000000u); }
__device__ __forceinline__ void b1_scores(const bf16* Zb, int t, const bf16x8 (&iqf)[4][2], const float (&w)[4], int r, int hh, float (&sc)[16]) {
    const bf16* kr = Zb + (size_t)(32 * t + r) * ZW + ZC_IK + 8 * hh;
    const bf16x8 k0 = *(const bf16x8*)kr, k1 = *(const bf16x8*)(kr + 16);
#pragma unroll
    for (int e = 0; e < 16; ++e) sc[e] = 0.f;
#pragma unroll
    for (int ih = 0; ih < 4; ++ih) { f32x16 lg = mfma32(k0, iqf[ih][0], splat16(0.f)); lg = mfma32(k1, iqf[ih][1], lg);
#pragma unroll
        for (int e = 0; e < 16; ++e) sc[e] = fmaf(w[ih], fmaxf(lg[e], 0.f), sc[e]); }
}
__device__ __forceinline__ void b1_unit(Frame& F, int b, int g) {
    const int tid = F.tid, lane = F.lane, r = lane & 31, hh = lane >> 5, wid = F.wave;
    const bf16* Zb = (const bf16*)(F.ws + WS_Z) + (size_t)b * SEQ * ZW;
    LAS unsigned* hist = (LAS unsigned*)F.lds;
    LAS QState* qst = (LAS QState*)(F.lds + QST_OFF);
    const int qpos = 32 * g + r;
    bf16x8 iqf[4][2]; float w[4];
    {   const bf16* qr = Zb + (size_t)qpos * ZW;
#pragma unroll
        for (int ih = 0; ih < 4; ++ih) { iqf[ih][0] = *(const bf16x8*)(qr + ZC_IQ + ih * 32 + 8 * hh); iqf[ih][1] = *(const bf16x8*)(qr + ZC_IQ + ih * 32 + 16 + 8 * hh); w[ih] = bf1(qr[ZC_IW + ih]); } }
    if (g >= 8) {
        for (int i = tid; i < 32 * HPITCH; i += 512) hist[i] = 0u;
        __syncthreads();
        for (int t = wid; t <= g; t += 8) { float sc[16]; b1_scores(Zb, t, iqf, w, r, hh, sc);
#pragma unroll
            for (int e = 0; e < 16; ++e) { const int j = 32 * t + crow_c(e) + 4 * hh; if (j <= qpos) { const unsigned bin = okey_of(sc[e]) >> 21;
                __hip_atomic_fetch_add(hist + r * HPITCH + (bin >> 1), 1u << ((bin & 1) * 16), __ATOMIC_RELAXED, __HIP_MEMORY_SCOPE_WORKGROUP); } } }
        __syncthreads();
        for (int qq = 0; qq < 4; ++qq) { const int q = 4 * wid + qq; const LAS unsigned* hq = hist + q * HPITCH;
            const int wbase = 1008 - 16 * lane; unsigned s = 0;
#pragma unroll
            for (int k = 0; k < 16; ++k) { const unsigned x = hq[wbase + k]; s += (x & 0xffffu) + (x >> 16); }
            unsigned P = s;
#pragma unroll
            for (int o = 1; o < 64; o <<= 1) { const unsigned t = __shfl_up(P, o); if (lane >= o) P += t; }
            const unsigned long long bal = __ballot(P >= 256u);
            const int Lsel = bal ? __builtin_ctzll(bal) : 63;
            if (lane == Lsel) { unsigned cum = P - s; unsigned b1 = 0, cin = 0, cab = 0;
                for (int k = 0; k < 32; ++k) { const int bin = 2047 - 32 * lane - k; const unsigned x = hq[bin >> 1]; const unsigned c = (bin & 1) ? (x >> 16) : (x & 0xffffu);
                    if (cum + c >= 256u) { b1 = (unsigned)bin; cin = c; cab = cum; break; } cum += c; }
                qst[q].thr_lo = b1 << 21; qst[q].thr_hi = (b1 << 21) | 0x1fffffu; qst[q].thr_idx = 0xffffu; qst[q].krem = 256u - cab; qst[q].lcount = 0u; qst[q].pad0 = cin; qst[q].pad1 = 0u;
                qst[q].mode = (b1 == 1024u || cin > (unsigned)CAP) ? 2u : 1u; }
        }
        __syncthreads();
        for (int i = tid; i < 32 * 256; i += 512) ((LAS unsigned*)(F.lds + 65536))[i] = 0u;
        __syncthreads();
        {   const unsigned mode = qst[r].mode, tlo = qst[r].thr_lo, thi = qst[r].thr_hi;
            for (int t = wid; t <= g; t += 8) { float sc[16]; b1_scores(Zb, t, iqf, w, r, hh, sc);
#pragma unroll
                for (int e = 0; e < 16; ++e) { const int j = 32 * t + crow_c(e) + 4 * hh; const unsigned ok = okey_of(sc[e]);
                    if (j <= qpos && ok >= tlo && ok <= thi) {
                        if (mode == 1u) { const unsigned pos = __hip_atomic_fetch_add(&qst[r].lcount, 1u, __ATOMIC_RELAXED, __HIP_MEMORY_SCOPE_WORKGROUP);
                            if (pos < (unsigned)CAP) { LAS unsigned* le = (LAS unsigned*)(F.lds + ((size_t)r * CAP + pos) * 8); le[0] = ok; le[1] = (unsigned)j; } }
                        else __hip_atomic_fetch_or((LAS unsigned*)(F.lds + 65536 + r * 1024) + (j >> 5), 1u << (j & 31), __ATOMIC_RELAXED, __HIP_MEMORY_SCOPE_WORKGROUP); } } } }
        __syncthreads();
        for (int qq = 0; qq < 4; ++qq) { const int q = 4 * wid + qq; const unsigned mode = qst[q].mode, krem = qst[q].krem;
            if (mode == 1u) { unsigned L = qst[q].lcount; if (L > (unsigned)CAP) L = CAP; const LAS unsigned* lb = (const LAS unsigned*)(F.lds + (size_t)q * CAP * 8);
                for (unsigned c = lane; c < L; c += 64) { const unsigned ok = lb[2 * c], jd = lb[2 * c + 1]; unsigned rank = 0;
                    for (unsigned c2 = 0; c2 < L; ++c2) { const unsigned ok2 = lb[2 * c2], j2 = lb[2 * c2 + 1]; rank += (ok2 > ok || (ok2 == ok && j2 < jd)) ? 1u : 0u; }
                    if (rank == krem - 1u) { qst[q].thr_lo = ok; qst[q].thr_hi = ok; qst[q].thr_idx = jd; } } }
            else { const LAS unsigned* bm = (const LAS unsigned*)(F.lds + 65536 + q * 1024); unsigned x[4]; unsigned s = 0;
#pragma unroll
                for (int k = 0; k < 4; ++k) { x[k] = bm[4 * lane + k]; s += __builtin_popcount(x[k]); }
                unsigned P = s;
#pragma unroll
                for (int o = 1; o < 64; o <<= 1) { const unsigned t = __shfl_up(P, o); if (lane >= o) P += t; }
                const unsigned long long bal = __ballot(P >= krem);
                const int Lsel = bal ? __builtin_ctzll(bal) : 63;
                if (lane == Lsel) { unsigned need = krem - (P - s); unsigned idx = 0xffffu;
#pragma unroll
                    for (int k = 0; k < 4; ++k) { const unsigned pc = __builtin_popcount(x[k]); if (idx == 0xffffu) { if (need <= pc && pc > 0u) { unsigned y = x[k]; for (unsigned z = 1; z < need; ++z) y &= y - 1u; idx = 32u * (4 * lane + k) + (unsigned)__builtin_ctz(y); } else need -= pc; } }
                    qst[q].thr_idx = idx; } }
        }
        __syncthreads();
    }
    {   unsigned tlo = 0u, thi = 0xffffffffu, tidx = 0xffffu;
        if (g >= 8) { tlo = qst[r].thr_lo; thi = qst[r].thr_hi; tidx = qst[r].thr_idx; }
        unsigned* MW = (unsigned*)(F.ws + WS_MASK) + ((size_t)(b * 256 + g) * 128) * 64 + lane;
        for (int kt = wid; kt <= (g >> 1); kt += 8) { unsigned word = 0u;
#pragma unroll
            for (int kh = 0; kh < 2; ++kh) { const int t = 2 * kt + kh; if (t <= g) { float sc[16]; b1_scores(Zb, t, iqf, w, r, hh, sc);
#pragma unroll
                for (int e = 0; e < 16; ++e) { const int j = 32 * t + crow_c(e) + 4 * hh; const unsigned ok = okey_of(sc[e]);
                    const bool sel = (j <= qpos) && (ok > thi || (ok >= tlo && (unsigned)j <= tidx)); word |= (sel ? 1u : 0u) << (e + 16 * kh); } } }
            MW[(size_t)kt * 64] = word; }
    }
    __syncthreads();
}

struct EngP { const bf16* Z; bf16* Y; const unsigned* MASK; const float* ST; const float* nw; float lam, lam_init; };
template <int MODE>
__device__ __forceinline__ void eng_unit(Frame& F, const EngP& P, int b, int h, int qb) {
    constexpr bool SOFT = MODE <= 1;
    constexpr int NMAP = MODE == 0 ? 2 : 1;
    constexpr int NS = (MODE == 0 || MODE == 3) ? 2 : 4;
    constexpr int KCH = MODE == 3 ? 4 : 8;
    constexpr int QC = MODE == 0 ? ZC_AQ : MODE == 1 ? ZC_BQ : MODE == 2 ? ZC_CQ : ZC_DQ;
    constexpr int KC = MODE == 0 ? ZC_AK : MODE == 1 ? ZC_BK : MODE == 2 ? ZC_CK : ZC_DK;
    constexpr int VC = MODE == 0 ? ZC_AV : MODE == 1 ? ZC_BV : MODE == 2 ? ZC_CV : ZC_DV;
    constexpr int HW = MODE == 3 ? 32 : 64;
    const int tid = F.tid, lane = F.lane, r = lane & 31, hh = lane >> 5, w = F.wave;
    const size_t rowbase = (size_t)b * SEQ;
    const int qw0 = qb * 256 + 32 * w;
    const float NEG = -__builtin_inff();
    const int hidx = MODE <= 1 ? (MODE == 0 ? 2 * h + 1 : 2 * h + 2) : 0;
    const float slope2 = SOFT ? __builtin_amdgcn_exp2f(-(float)hidx) * LOG2E : 0.f;
    bf16x8 qf[NMAP][NS];
    {   const bf16* qrow = P.Z + (rowbase + qw0 + r) * ZW + QC + h * HW;
#pragma unroll
        for (int m = 0; m < NMAP; ++m)
#pragma unroll
            for (int s = 0; s < NS; ++s) qf[m][s] = *(const bf16x8*)(qrow + m * 32 + 16 * s + 8 * hh); }
    f32x16 cinit;
#pragma unroll
    for (int e = 0; e < 16; ++e) cinit[e] = SOFT ? slope2 * (float)(crow_c(e) + 4 * hh) : 0.f;
    float m_run[NMAP], l_run[NMAP]; f32x16 O[NMAP][2];
#pragma unroll
    for (int m = 0; m < NMAP; ++m) { m_run[m] = NEG; l_run[m] = 0.f; O[m][0] = splat16(0.f); O[m][1] = splat16(0.f); }
    if (!SOFT) {
        const int sidx = MODE == 2 ? ((b * 4 + h) * 32 + qb) : ((b * 4 + h) * 128 + 4 * qb + (w >> 1));
        const float* sp = P.ST + (size_t)sidx * (64 * HW);
#pragma unroll
        for (int db = 0; db < 2; ++db)
#pragma unroll
            for (int s = 0; s < NS; ++s) { const float* a = sp + (size_t)(32 * db + r) * HW + 16 * s + 8 * hh; const f32x4 a0 = *(const f32x4*)a, a1 = *(const f32x4*)(a + 4);
                O[0][db] = mfma32(pack8(a0[0], a0[1], a0[2], a0[3], a1[0], a1[1], a1[2], a1[3]), qf[0][s], O[0][db]); }
    }
    const int kt_lo = SOFT ? 0 : 4 * qb, kt_hi = 4 * qb + 3;
    const int srow = tid >> 3, sch = tid & 7;
    u32x4 kreg = (u32x4){0u, 0u, 0u, 0u}, vreg;
    {   const bf16* zr = P.Z + (rowbase + 64 * kt_lo + srow) * ZW;
        if (sch < KCH) kreg = *(const u32x4*)(zr + KC + h * HW + sch * 8);
        vreg = *(const u32x4*)(zr + VC + h * 64 + sch * 8);
        LAS unsigned char* Kb = F.lds + (kt_lo & 1) * 9216; LAS unsigned char* Vb = F.lds + 18432 + (kt_lo & 1) * 9216;
        if (sch < KCH) *(LAS u32x4*)(Kb + srow * 144 + sch * 16) = kreg;
        *(LAS u32x4*)(Vb + srow * 144 + sch * 16) = vreg; }
    __syncthreads();
    for (int kt = kt_lo; kt <= kt_hi; ++kt) {
        if (kt < kt_hi) { const bf16* zr = P.Z + (rowbase + 64 * (kt + 1) + srow) * ZW;
            if (sch < KCH) kreg = *(const u32x4*)(zr + KC + h * HW + sch * 8);
            vreg = *(const u32x4*)(zr + VC + h * 64 + sch * 8); }
        const int j0 = 64 * kt;
        const bool act = (MODE == 3) ? (kt == 4 * qb + (w >> 1)) : (j0 <= qw0 + 31);
        if (act) {
            const LAS unsigned char* Kb = F.lds + (kt & 1) * 9216; const LAS unsigned char* Vb = F.lds + 18432 + (kt & 1) * 9216;
            unsigned mw = 0xffffffffu;
            if (MODE == 1) mw = P.MASK[((size_t)(b * 256 + qb * 8 + w) * 128 + kt) * 64 + lane];
            const bool hact1 = (j0 + 32 <= qw0 + 31);
#pragma unroll
            for (int m = 0; m < NMAP; ++m) {
                f32x16 st[2];
#pragma unroll
                for (int kh = 0; kh < 2; ++kh) {
                    if (kh == 0 || hact1) {
                        f32x16 a = cinit;
#pragma unroll
                        for (int s = 0; s < NS; ++s) { const bf16x8 kf = *(const LAS bf16x8*)(Kb + (32 * kh + r) * 144 + (m * 32 + 16 * s + 8 * hh) * 2); a = mfma32(kf, qf[m][s], a); }
                        if (j0 + 32 * kh + 31 > qw0) { const int lim = qw0 + r - j0 - 32 * kh - 4 * hh;
#pragma unroll
                            for (int e = 0; e < 16; ++e) if (crow_c(e) > lim) a[e] = SOFT ? NEG : 0.f; }
                        if (MODE == 1) {
#pragma unroll
                            for (int e = 0; e < 16; ++e) if (!((mw >> (e + 16 * kh)) & 1u)) a[e] = NEG; }
                        st[kh] = a;
                    } else st[kh] = splat16(SOFT ? NEG : 0.f);
                }
                if (SOFT) {
                    const float off0 = slope2 * (float)(j0 - qw0 - r), off1 = off0 + 32.f * slope2;
                    float mx0 = st[0][0], mx1 = st[1][0];
#pragma unroll
                    for (int e = 1; e < 16; ++e) { mx0 = fmaxf(mx0, st[0][e]); mx1 = fmaxf(mx1, st[1][e]); }
                    float mx = fmaxf(mx0 + off0, mx1 + off1); mx = fmaxf(mx, __shfl_xor(mx, 32));
                    const float mn = fmaxf(m_run[m], mx); const float msafe = (mn == NEG) ? 0.f : mn;
                    const float alpha = __builtin_amdgcn_exp2f(m_run[m] - msafe); m_run[m] = mn;
                    const float d0 = off0 - msafe, d1 = off1 - msafe; float rs = 0.f;
#pragma unroll
                    for (int e = 0; e < 16; ++e) { const float p0 = __builtin_amdgcn_exp2f(st[0][e] + d0), p1 = __builtin_amdgcn_exp2f(st[1][e] + d1); st[0][e] = p0; st[1][e] = p1; rs += p0 + p1; }
                    rs += __shfl_xor(rs, 32); l_run[m] = l_run[m] * alpha + rs;
#pragma unroll
                    for (int e = 0; e < 16; ++e) { O[m][0][e] *= alpha; O[m][1][e] *= alpha; }
                }
#pragma unroll
                for (int kh = 0; kh < 2; ++kh) {
                    if (kh == 0 || hact1) {
#pragma unroll
                        for (int s = 0; s < 2; ++s) {
                            const bf16x8 pf = pack8(st[kh][8 * s], st[kh][8 * s + 1], st[kh][8 * s + 2], st[kh][8 * s + 3], st[kh][8 * s + 4], st[kh][8 * s + 5], st[kh][8 * s + 6], st[kh][8 * s + 7]);
#pragma unroll
                            for (int db = 0; db < 2; ++db) {
                                const LAS unsigned char* vp = Vb + (32 * kh + 16 * s + 4 * hh + ((lane & 15) >> 2)) * 144 + (32 * db + 16 * ((lane >> 4) & 1) + 4 * (lane & 3)) * 2;
                                const s16x4 lo = vtr(vp), hi = vtr(vp + 8 * 144);
                                const bf16x8 vf = (bf16x8){lo[0], lo[1], lo[2], lo[3], hi[0], hi[1], hi[2], hi[3]};
                                O[m][db] = mfma32(vf, pf, O[m][db]); } } } }
            }
        }
        if (kt < kt_hi) { LAS unsigned char* Kb = F.lds + ((kt + 1) & 1) * 9216; LAS unsigned char* Vb = F.lds + 18432 + ((kt + 1) & 1) * 9216;
            if (sch < KCH) *(LAS u32x4*)(Kb + srow * 144 + sch * 16) = kreg;
            *(LAS u32x4*)(Vb + srow * 144 + sch * 16) = vreg; }
        __syncthreads();
    }
    const size_t orow = rowbase + qw0 + r;
    const int ycol = MODE * 256 + h * 64;
    f32x16 o[2];
    if (MODE == 0) { const float i0 = 1.f / l_run[0], i1 = P.lam / l_run[NMAP - 1];
#pragma unroll
        for (int db = 0; db < 2; ++db)
#pragma unroll
            for (int e = 0; e < 16; ++e) o[db][e] = O[0][db][e] * i0 - O[NMAP - 1][db][e] * i1; }
    else if (MODE == 1) { const float i0 = 1.f / l_run[0];
#pragma unroll
        for (int db = 0; db < 2; ++db)
#pragma unroll
            for (int e = 0; e < 16; ++e) o[db][e] = O[0][db][e] * i0; }
    else { o[0] = O[0][0]; o[1] = O[0][1]; }
    float mu = 0.f;
    if (MODE == 2) { float s = 0.f;
#pragma unroll
        for (int db = 0; db < 2; ++db)
#pragma unroll
            for (int e = 0; e < 16; ++e) s += o[db][e];
        s += __shfl_xor(s, 32); mu = s * (1.f / 64.f); }
    float ss = 0.f;
    if (MODE != 1) {
#pragma unroll
        for (int db = 0; db < 2; ++db)
#pragma unroll
            for (int e = 0; e < 16; ++e) { const float d = o[db][e] - mu; ss += d * d; }
        ss += __shfl_xor(ss, 32); }
    float rn = 1.f;
    if (MODE != 1) rn = 1.f / sqrtf(ss * (1.f / 64.f) + LN_EPS);
    if (MODE == 0) rn *= (1.f - P.lam_init);
#pragma unroll
    for (int db = 0; db < 2; ++db)
#pragma unroll
        for (int g4 = 0; g4 < 4; ++g4) { const int d0 = 32 * db + 8 * g4 + 4 * hh; float v[4];
#pragma unroll
            for (int i = 0; i < 4; ++i) v[i] = o[db][4 * g4 + i];
            if (MODE != 1) { const f32x4 nw = *(const f32x4*)(P.nw + (MODE == 2 ? h * 64 : 0) + d0);
#pragma unroll
                for (int i = 0; i < 4; ++i) v[i] = (v[i] - mu) * rn * nw[i]; }
            if (MODE >= 2) { const u32x2 gw = *(const u32x2*)(P.Z + orow * ZW + (MODE == 2 ? ZC_CG : ZC_DG) + h * 64 + d0);
                const float g0 = bflo(gw.x), g1 = bfhi(gw.x), g2 = bflo(gw.y), g3 = bfhi(gw.y);
                v[0] *= g0 * sigmoidf_(g0); v[1] *= g1 * sigmoidf_(g1); v[2] *= g2 * sigmoidf_(g2); v[3] *= g3 * sigmoidf_(g3); }
            u32x2 ow; ow.x = pk2(v[0], v[1]); ow.y = pk2(v[2], v[3]);
            *(u32x2*)(P.Y + orow * DM + ycol + d0) = ow; }
}
}

constexpr int PH_PER_LAYER = 12, N_PHASES = 1 + DEPTH * PH_PER_LAYER;

__global__ void __launch_bounds__(NWAVES * 64, 2) fwd_kernel(Args args) {
    extern __shared__ __attribute__((aligned(16))) unsigned char lds_raw[];
    Frame F;
    F.lds = (LAS unsigned char*)lds_raw;
    F.tid = threadIdx.x; F.lane = F.tid & 63; F.wave = __builtin_amdgcn_readfirstlane(F.tid >> 6);
    F.G = gridDim.x; F.wg = blockIdx.x;
    F.ws = args.ws; F.dob = (unsigned char*)args.out;
    volatile LAS unsigned* MISC = (volatile LAS unsigned*)(F.lds + MISC_OFF);
    if (F.tid < 32) MISC[F.tid] = 0u;
    __syncthreads();
    unsigned* ctl = (unsigned*)(F.ws + WS_CTL);
    XcdBarrier bar; bar.bar = ctl + CW_BAR; bar.x = 0; bar.st = nullptr;
#if MK_ONE_LAUNCH
    bar = xcd_barrier_post(ctl + CW_BAR, MISC + 8);
#endif
    const int lo = args.ph_lo, hi = args.ph_hi;
#ifdef ONLY_SITE
#define SITE(s) ((s) == ONLY_SITE)
#else
#define SITE(s) true
#endif
#define IN(k) (lo <= (k) && (k) < hi)
#if MK_ONE_LAUNCH
#define SEAM(k) do { if ((k) + 1 < hi) xcd_barrier(bar, F.tid == 0); } while (0)
#else
#define SEAM(k) do { } while (0)
#endif
    typedef __attribute__((address_space(4))) const Args* KArgP;
    const int G0 = F.G, wg0 = F.wg;
#define SITE_BEGIN KArgP KA = (KArgP)__builtin_amdgcn_kernarg_segment_ptr(); do { asm volatile("" : "+s"(KA)); \
        int ln_; asm volatile("v_mbcnt_lo_u32_b32 %0, -1, 0\n\tv_mbcnt_hi_u32_b32 %0, -1, %0" : "=v"(ln_)); \
        unsigned tk_ = 0u; if (ln_ == 0) tk_ = __hip_atomic_fetch_add((LAS unsigned*)(F.lds + MISC_OFF + 64), 1u, __ATOMIC_RELAXED, __HIP_MEMORY_SCOPE_WORKGROUP); \
        F.wave = __builtin_amdgcn_readfirstlane((int)(tk_ & 7u)); F.lane = ln_; F.tid = F.wave * 64 + F.lane; \
        F.ws = KA->ws; F.dob = (unsigned char*)KA->out; F.G = G0; F.wg = wg0; asm volatile("" : "+s"(F.G), "+s"(F.wg)); } while (0)

    if (SITE(0) && IN(0)) { SITE_BEGIN; p0_prologue(F, KA); SEAM(0); }

    for (int l = 0; l < DEPTH; ++l) {
        const int pb = 1 + l * PH_PER_LAYER;
        if (SITE(1) && IN(pb + 0)) { SITE_BEGIN; const char* XBc = (const char*)(F.ws + WS_XB); (void)XBc; const unsigned char* w123 = F.ws + WS_W123; const unsigned char* w45 = F.ws + WS_W45 + (size_t)l * W45_STRIDE; (void)w123; (void)w45;
            pg8::SchedPlain S{XBc, (const char*)(w123 + W123_W1), 2048, 2048, 16, 128, 14, F.G, F.wg};
            pg8::EpiStore E{(bf16*)(F.ws + WS_Z), ZW};
            pg8::gemm_phase(F.lds, S, E, F.tid);
            SEAM(pb + 0);
        }
        if (SITE(2) && IN(pb + 1)) { SITE_BEGIN; const char* XBc = (const char*)(F.ws + WS_XB); (void)XBc; const unsigned char* w123 = F.ws + WS_W123; const unsigned char* w45 = F.ws + WS_W45 + (size_t)l * W45_STRIDE; (void)w123; (void)w45;
            if (EXPM != 15) { u32x4* yp = (u32x4*)(F.ws + WS_Y); for (size_t i = (size_t)F.wg * 512 + F.tid; i < (size_t)M * DM / 8; i += (size_t)F.G * 512) yp[i] = (u32x4){0u, 0u, 0u, 0u}; }
            if (EXPM & 2) for (int u = F.wg; u < 512; u += F.G) { const int b = u >> 7, p = u & 127; mx::b1_unit(F, b, 255 - p); mx::b1_unit(F, b, p); }
            if (EXPM & 12) for (int u = F.wg; u < 128; u += F.G) mx::prepkv_unit(F, u, KA->in[6] + (size_t)l * 16 * 128, KA->in[7] + l * 128);
            SEAM(pb + 1);
        }
        if (SITE(3) && IN(pb + 2)) { SITE_BEGIN; const char* XBc = (const char*)(F.ws + WS_XB); (void)XBc; const unsigned char* w123 = F.ws + WS_W123; const unsigned char* w45 = F.ws + WS_W45 + (size_t)l * W45_STRIDE; (void)w123; (void)w45;
            if (EXPM & 12) mx::scan_phase(F);
            float lam_init = 0.8f - 0.6f * __expf(-0.3f * (float)l);
            const float* lp = KA->in[3] + l * 128; float s01 = 0.f, s23 = 0.f;
            for (int i = 0; i < 32; ++i) { s01 += lp[i] * lp[32 + i]; s23 += lp[64 + i] * lp[96 + i]; }
            mx::EngP P{(const bf16*)(F.ws + WS_Z), (bf16*)(F.ws + WS_Y), nullptr, nullptr, KA->in[4] + l * 64, __expf(s01) - __expf(s23) + lam_init, lam_init};
            if (EXPM & 1) for (int u = F.wg; u < 256; u += F.G) { const int b = u >> 6, h = (u >> 4) & 3, pp = u & 15; mx::eng_unit<0>(F, P, b, h, 31 - pp); mx::eng_unit<0>(F, P, b, h, pp); }
            SEAM(pb + 2);
        }
        if (SITE(4) && IN(pb + 3)) { SITE_BEGIN; const char* XBc = (const char*)(F.ws + WS_XB); (void)XBc; const unsigned char* w123 = F.ws + WS_W123; const unsigned char* w45 = F.ws + WS_W45 + (size_t)l * W45_STRIDE; (void)w123; (void)w45;
            {   mx::EngP P{(const bf16*)(F.ws + WS_Z), (bf16*)(F.ws + WS_Y), (const unsigned*)(F.ws + WS_MASK), nullptr, nullptr, 0.f, 0.f};
                if (EXPM & 2) for (int u = F.wg; u < 256; u += F.G) { const int b = u >> 6, h = (u >> 4) & 3, pp = u & 15; mx::eng_unit<1>(F, P, b, h, 31 - pp); mx::eng_unit<1>(F, P, b, h, pp); } }
            {   mx::EngP P{(const bf16*)(F.ws + WS_Z), (bf16*)(F.ws + WS_Y), nullptr, (const float*)(F.ws + WS_KVC), KA->in[5] + l * 256, 0.f, 0.f};
                if (EXPM & 4) for (int u = F.wg; u < 512; u += F.G) mx::eng_unit<2>(F, P, u >> 7, (u >> 5) & 3, u & 31); }
            {   mx::EngP P{(const bf16*)(F.ws + WS_Z), (bf16*)(F.ws + WS_Y), nullptr, (const float*)(F.ws + WS_KVD), KA->in[8] + l * 64, 0.f, 0.f};
                if (EXPM & 8) for (int u = F.wg; u < 512; u += F.G) mx::eng_unit<3>(F, P, u >> 7, (u >> 5) & 3, u & 31); }
            SEAM(pb + 3);
        }
        if (SITE(5) && IN(pb + 4)) { SITE_BEGIN;
            const unsigned char* w123 = F.ws + WS_W123;
            for (int n = 0; n < 4; ++n) {
                {   pg8::SchedPlain S{(const char*)(F.ws + WS_XB), (const char*)(w123 + W123_GB) + (size_t)n * 1024 * 2048, 2048, 2048, 16, 128, 4, F.G, F.wg};
                    pg8::EpiSlotStore E{F.ws + WS_SCR2 + (size_t)F.wg * 262144, 1};
                    pg8::gemm_phase(F.lds, S, E, F.tid); }
                {   pg8::SchedPlain S{(const char*)(F.ws + WS_Y) + n * 512, (const char*)(w123 + W123_GB + 8 * MiB) + (size_t)n * 1024 * 512, 2048, 512, 4, 128, 4, F.G, F.wg};
                    pg8::EpiBranch E{F.ws + WS_SCR2 + (size_t)F.wg * 262144, (bf16*)(F.ws + WS_MERGED), n == 0};
                    pg8::gemm_phase(F.lds, S, E, F.tid); }
            }
            SEAM(pb + 4);
        }
        if (SITE(6) && IN(pb + 5)) { SITE_BEGIN; const char* XBc = (const char*)(F.ws + WS_XB); (void)XBc; const unsigned char* w123 = F.ws + WS_W123; const unsigned char* w45 = F.ws + WS_W45 + (size_t)l * W45_STRIDE; (void)w123; (void)w45;
            pg8::SchedPlain S{(const char*)(F.ws + WS_MERGED), (const char*)(w123 + W123_WO), 2048, 2048, 16, 128, 4, F.G, F.wg};
            pg8::EpiG3 E{(bf16*)(F.ws + WS_XB)};
            pg8::gemm_phase(F.lds, S, E, F.tid);
            SEAM(pb + 5);
        }
        if (SITE(7) && IN(pb + 6)) { SITE_BEGIN; const char* XBc = (const char*)(F.ws + WS_XB); (void)XBc; const unsigned char* w123 = F.ws + WS_W123; const unsigned char* w45 = F.ws + WS_W45 + (size_t)l * W45_STRIDE; (void)w123; (void)w45; ln_phase(F, KA->in[11] + l * DM, KA->in[12] + l * DM, nullptr);
            if (l + 1 < DEPTH) convert_w123(F, KA->in[2] + (size_t)(l + 1) * DM * NIN, KA->in[9] + (size_t)(l + 1) * 4 * 256 * DM, KA->in[10] + (size_t)(l + 1) * DM * DM);
            SEAM(pb + 6); }
        if (SITE(8) && IN(pb + 7)) { SITE_BEGIN; const char* XBc = (const char*)(F.ws + WS_XB); (void)XBc; const unsigned char* w123 = F.ws + WS_W123; const unsigned char* w45 = F.ws + WS_W45 + (size_t)l * W45_STRIDE; (void)w123; (void)w45;
            pg8::SchedPlain S{XBc, (const char*)(w45 + W45_UP), 2048, 2048, 16, 128, 22, F.G, F.wg};
            pg8::EpiStore E{(bf16*)(F.ws + WS_UG), UGW};
            pg8::gemm_phase(F.lds, S, E, F.tid);
            SEAM(pb + 7);
        }
        if (SITE(9) && IN(pb + 8)) { SITE_BEGIN; const char* XBc = (const char*)(F.ws + WS_XB); (void)XBc; const unsigned char* w123 = F.ws + WS_W123; const unsigned char* w45 = F.ws + WS_W45 + (size_t)l * W45_STRIDE; (void)w123; (void)w45; ffn_act_phase(F, KA->in[14] + (size_t)l * 3 * DFF, KA->in[15] + (size_t)l * DFF); SEAM(pb + 8); }
        if (SITE(10) && IN(pb + 9)) { SITE_BEGIN;
            const unsigned char* w45 = F.ws + WS_W45 + (size_t)l * W45_STRIDE;
            {   pg8::SchedPlain S{(const char*)(F.ws + WS_PB + (size_t)l * M * PDIM * 2), (const char*)(w45 + W45_PP), 512, 512, 4, 128, 4, F.G, F.wg};
                pg8::EpiSlotStore E{F.dob + DO_SCR5 + (size_t)F.wg * 262144, 0};
                pg8::gemm_phase(F.lds, S, E, F.tid); }
            {   pg8::SchedPlain S{(const char*)(F.ws + WS_XB), (const char*)(w45 + W45_PG), 2048, 2048, 16, 128, 4, F.G, F.wg};
                pg8::EpiSlotMul E{F.dob + DO_SCR5 + (size_t)F.wg * 262144};
                pg8::gemm_phase(F.lds, S, E, F.tid); }
            SEAM(pb + 9);
        }
        if (SITE(11) && IN(pb + 10)) { SITE_BEGIN;
            const unsigned char* w45 = F.ws + WS_W45 + (size_t)l * W45_STRIDE;
            pg8::SchedG5b S{(const char*)(F.ws + WS_UG), (const char*)(w45 + W45_DN), F.G, F.wg};
            pg8::EpiG5b E{F.dob + DO_SCR5 + (size_t)F.wg * 262144, (bf16*)(F.ws + WS_XB)};
            pg8::gemm_phase(F.lds, S, E, F.tid);
            SEAM(pb + 10);
        }
        if (SITE(12) && IN(pb + 11)) { SITE_BEGIN; const char* XBc = (const char*)(F.ws + WS_XB); (void)XBc; const unsigned char* w123 = F.ws + WS_W123; const unsigned char* w45 = F.ws + WS_W45 + (size_t)l * W45_STRIDE; (void)w123; (void)w45; ln_phase(F, KA->in[19] + l * DM, KA->in[20] + l * DM, l == DEPTH - 1 ? KA->out : nullptr); SEAM(pb + 11); }
    }
#undef IN
#undef SEAM
}

extern "C" void kernel_launch(void* const* d_in, const int* in_sizes, int n_in, void* d_out, int out_size, void* d_ws, size_t ws_size, hipStream_t stream) {
    static int grid = 0;
    if (grid == 0) {
        if (n_in != 21 || out_size != M * DM || ws_size < WS_END) { fprintf(stderr, "kernel_launch: unexpected shapes (n_in %d out %d ws %zu)\n", n_in, out_size, ws_size); grid = -1; return; }
        int dev = 0, cus = 0, per_cu = 0;
        if (hipGetDevice(&dev) != hipSuccess || hipDeviceGetAttribute(&cus, hipDeviceAttributeMultiprocessorCount, dev) != hipSuccess) { grid = -1; return; }
        if (hipFuncSetAttribute((const void*)fwd_kernel, hipFuncAttributeMaxDynamicSharedMemorySize, LDS_BYTES) != hipSuccess) { grid = -1; return; }
        if (hipOccupancyMaxActiveBlocksPerMultiprocessor(&per_cu, (const void*)fwd_kernel, NWAVES * 64, LDS_BYTES) != hipSuccess || per_cu < 1)
            fprintf(stderr, "kernel_launch: occupancy query reports %d\n", per_cu);
        (void)hipGetLastError();
        grid = cus;
    }
    if (grid < 0) return;
    (void)hipMemsetAsync((char*)d_ws + WS_CTL, 0, CTL_ZERO_BYTES, stream);
    Args a{};
    for (int i = 0; i < 21; ++i) a.in[i] = (const float*)d_in[i];
    a.out = (float*)d_out; a.ws = (unsigned char*)d_ws;
#if MK_ONE_LAUNCH
    a.ph_lo = 0; a.ph_hi = N_PHASES;
    hipLaunchKernelGGL(fwd_kernel, dim3(grid), dim3(NWAVES * 64), LDS_BYTES, stream, a);
#else
    for (int p = 0; p < N_PHASES; ++p) { a.ph_lo = p; a.ph_hi = p + 1; hipLaunchKernelGGL(fwd_kernel, dim3(grid), dim3(NWAVES * 64), LDS_BYTES, stream, a); }
#endif
}
```

```cpp
#include <hip/hip_runtime.h>
#include <cstdio>
#include <cstdint>

#ifndef EXP
#define EXP 0
#endif
#ifndef EXPM
#define EXPM 15
#endif
#ifndef MK_ONE_LAUNCH
#define MK_ONE_LAUNCH 1
#endif

#define GAS __attribute__((address_space(1)))
#define LAS __attribute__((address_space(3)))
typedef unsigned short bf16;
typedef unsigned u32x4 __attribute__((ext_vector_type(4)));
typedef unsigned u32x2 __attribute__((ext_vector_type(2)));
typedef float f32x2 __attribute__((ext_vector_type(2)));
typedef float f32x4 __attribute__((ext_vector_type(4)));
typedef float f32x16 __attribute__((ext_vector_type(16)));
typedef short bf16x8 __attribute__((ext_vector_type(8)));
typedef short s16x4 __attribute__((ext_vector_type(4)));
typedef GAS unsigned gu32;

constexpr int BATCH = 4, SEQ = 8192, DM = 1024, M = BATCH * SEQ, DEPTH = 2;
constexpr int NIN = 7604, ZW = 3584, DFF = 2816, UGW = 5632, PDIM = 256;
constexpr float LN_EPS = 1e-5f;
constexpr float ALPHA = 1.41421356237f;
constexpr float LOG2E = 1.4426950408889634f;
constexpr int ZC_AQ = 0, ZC_AK = 256, ZC_AV = 512, ZC_BQ = 768, ZC_BK = 1024, ZC_BV = 1280, ZC_CQ = 1536, ZC_CK = 1792, ZC_CV = 2048, ZC_CG = 2304,
              ZC_DQ = 2560, ZC_DK = 2688, ZC_DV = 2816, ZC_DG = 3072, ZC_IQ = 3328, ZC_IK = 3456, ZC_IW = 3488, ZC_DA = 3504;
constexpr int SRC_MG = 3508;

constexpr size_t MiB = 1u << 20;
constexpr size_t WS_CTL = 0, CTL_ZERO_BYTES = 1 * MiB;
constexpr size_t WS_XB = 1 * MiB;
constexpr size_t WS_BIG = 65 * MiB;
constexpr size_t WS_Z = WS_BIG, WS_Y = WS_BIG + 224 * MiB, WS_MERGED = WS_BIG + 288 * MiB, WS_UG = WS_BIG;
constexpr size_t WS_MASK = WS_MERGED, WS_KVC = WS_MERGED + 32 * MiB, WS_KVD = WS_MERGED + 40 * MiB, WS_DE = WS_MERGED + 56 * MiB;
constexpr size_t WS_SCR2 = WS_Z;
constexpr size_t WS_W45 = 417 * MiB, W45_STRIDE = 19 * MiB;
constexpr size_t W45_UP = 0, W45_PG = 11 * MiB, W45_PP = 13 * MiB, W45_DN = 13 * MiB + 512 * 1024;
constexpr size_t WS_PB = 455 * MiB;
constexpr size_t WS_W123 = 487 * MiB;
constexpr size_t WS_END = 506 * MiB;
constexpr size_t W123_W1 = 0, W123_GB = 7 * MiB, W123_WO = 17 * MiB;
constexpr size_t DO_SCR5 = 0;

constexpr int CW_BAR = 4096;

constexpr int RING_BYTES = 131072;
constexpr int MISC_OFF = 131072 + 320;
constexpr int QST_OFF = 132096;
constexpr int LDS_BYTES = 147456;

constexpr int NWAVES = 8;

#define RLX_AGENT __ATOMIC_RELAXED, __HIP_MEMORY_SCOPE_AGENT
__device__ __forceinline__ unsigned f2bf(float f) { unsigned u = __builtin_bit_cast(unsigned, f); return (u + 0x7fffu + ((u >> 16) & 1u)) >> 16; }
typedef __bf16 bf16x2_t __attribute__((ext_vector_type(2)));
__device__ __forceinline__ unsigned pk2(float lo, float hi) { const f32x2 v = {lo, hi}; const bf16x2_t b = __builtin_convertvector(v, bf16x2_t); return __builtin_bit_cast(unsigned, b); }
__device__ __forceinline__ float bflo(unsigned w) { return __uint_as_float(w << 16); }
__device__ __forceinline__ float bfhi(unsigned w) { return __uint_as_float(w & 0xffff0000u); }
__device__ __forceinline__ float bf1(bf16 b) { return __uint_as_float((unsigned)b << 16); }
__device__ __forceinline__ float sigmoidf_(float x) { return __builtin_amdgcn_rcpf(1.0f + __builtin_amdgcn_exp2f(-LOG2E * x)); }
__device__ __forceinline__ float wave_sum(float v) {
#pragma unroll
    for (int o = 1; o < 64; o <<= 1) v += __shfl_xor(v, o);
    return v;
}

#define XB_TMO      128
#define XB_XCNT(j)  (256  + 64 * (j))
#define XB_XSUB(j)  (1280 + 64 * (j))
#define XB_XGEN(j)  (2304 + 64 * (j))
#define XB_TOP      3328
#define XB_TOPGEN   3392
#define XCD_BAR_WORDS 3456
#define XB_SPIN_CAP (1u << 22)

__device__ __forceinline__ unsigned xb_ld(unsigned* p)              { return __hip_atomic_load(p, __ATOMIC_RELAXED, __HIP_MEMORY_SCOPE_AGENT); }
__device__ __forceinline__ unsigned xb_add(unsigned* p, unsigned v) { return __hip_atomic_fetch_add(p, v, __ATOMIC_RELAXED, __HIP_MEMORY_SCOPE_AGENT); }
__device__ __forceinline__ unsigned xb_xcc_id() { return (unsigned)__builtin_amdgcn_s_getreg((3 << 11) | 20) & 0xFu; }
#define XB_SPIN(cond, bar) do { unsigned _sp = 0; while (cond) { __builtin_amdgcn_s_sleep(1); \
    if ((++_sp & 255u) == 0u) { if (xb_ld(&(bar)[XB_TMO])) break; if (_sp > XB_SPIN_CAP) { atomicAdd(&(bar)[XB_TMO], 1u); break; } } } } while (0)

struct XcdBarrier { unsigned* bar; unsigned x; volatile LAS unsigned* st; };

__device__ __forceinline__ XcdBarrier xcd_barrier_post(unsigned* bar, volatile LAS unsigned* st) {
    XcdBarrier b; b.bar = bar; b.x = xb_xcc_id(); b.st = st;
    if (threadIdx.x == 0) (void)xb_add(&bar[XB_XCNT(b.x)], 1u);
    return b;
}
__device__ __forceinline__ void xcd_barrier_complete(unsigned* bar, unsigned x, unsigned& nloc, unsigned& nx) {
    const unsigned G = gridDim.x * gridDim.y * gridDim.z;
    unsigned sum, cnt, mine, sp = 0u;
    for (;;) {
        sum = 0u; cnt = 0u; mine = 0u;
#pragma unroll
        for (unsigned j = 0; j < 16; ++j) { const unsigned c = xb_ld(&bar[XB_XCNT(j)]); sum += c; cnt += (c > 0u) ? 1u : 0u; mine = (j == x) ? c : mine; }
        if (sum == G) break;
        __builtin_amdgcn_s_sleep(1);
        if ((++sp & 255u) == 0u) { if (xb_ld(&bar[XB_TMO])) break; if (sp > XB_SPIN_CAP) { atomicAdd(&bar[XB_TMO], 1u); break; } }
    }
    nloc = mine > 0u ? mine : 1u; nx = cnt > 0u ? cnt : 1u;
}
__device__ __forceinline__ void xcd_barrier(const XcdBarrier& b, const bool leader_thread) {
    asm volatile("s_waitcnt vmcnt(0)" ::: "memory");
    __syncthreads();
    if (leader_thread) {
        unsigned* bar = b.bar;
        __builtin_amdgcn_s_waitcnt(0);
        unsigned nloc = b.st[0], nx = b.st[1];
        if (nloc == 0u) { xcd_barrier_complete(bar, b.x, nloc, nx); b.st[0] = nloc; b.st[1] = nx; }
        const unsigned old = xb_add(&bar[XB_XSUB(b.x)], 1u);
        const unsigned gen = old / nloc;
        if (old + 1u == (gen + 1u) * nloc) {
            __builtin_amdgcn_fence(__ATOMIC_RELEASE, "agent");
            asm volatile("s_waitcnt vmcnt(0)" ::: "memory");
            const unsigned og = xb_add(&bar[XB_TOP], 1u);
            const unsigned tg = og / nx;
            if (og + 1u == (tg + 1u) * nx) xb_add(&bar[XB_TOPGEN], 1u);
            else XB_SPIN(xb_ld(&bar[XB_TOPGEN]) == tg, bar);
            __builtin_amdgcn_fence(__ATOMIC_ACQUIRE, "agent");
            xb_add(&bar[XB_XGEN(b.x)], 1u);
            asm volatile("s_waitcnt vmcnt(0)" ::: "memory");
        } else {
            XB_SPIN(xb_ld(&bar[XB_XGEN(b.x)]) == gen, bar);
            __builtin_amdgcn_fence(__ATOMIC_ACQUIRE, "agent");
            asm volatile("s_waitcnt vmcnt(0)" ::: "memory");
        }
    }
    __syncthreads();
}

namespace pg8 {
constexpr int BM = 256, BK = 64, HALF = 128, HTB = HALF * BK * 2, STAGE_BYTES = 8 * HTB, NXCD = 8, WGM = 8;
__device__ __forceinline__ int lds_byte(int r, int c) { const int st = (r >> 4) * 2 + (c >> 5), rr = r & 15, cc = c & 31, ob = rr * 64 + cc * 2; return st * 1024 + (ob ^ (((ob >> 9) & 1) << 5)); }
__device__ __forceinline__ void stage_rc(int b, int& R, int& C) { const int st = b / 1024, sb = b % 1024, swz = sb ^ (((sb >> 9) & 1) << 5); R = (st >> 1) * 16 + swz / 64; C = (st & 1) * 32 + (swz % 64) / 2; }
__device__ __forceinline__ int perm32(int rho) { const int n = rho >> 4, i = rho & 15; return 8 * (i >> 2) + 4 * n + (i & 3); }

struct UnitD { const char* A; const char* B; int lda2, ldb2, nt, pm, pn, kind; };

__device__ __forceinline__ void tile_map(int L, int nM, int nN, int& pm, int& pn) {
    const int nwg = nM * nN; int wgid = L;
    { const int q = nwg / NXCD, r = nwg % NXCD, xcd = wgid % NXCD, off = wgid / NXCD; wgid = (xcd < r ? xcd * (q + 1) : r * (q + 1) + (xcd - r) * q) + off; }
    const int nig = WGM * nN, gid = wgid / nig, fm = gid * WGM, gsz = (nM - fm) < WGM ? (nM - fm) : WGM;
    pm = fm + ((wgid % nig) % gsz); pn = (wgid % nig) / gsz;
}

template <class Epi, class Sched>
__device__ __forceinline__ void gemm_phase(LAS unsigned char* lds, const Sched& S, const Epi& E, const int tid) {
    const int wid = __builtin_amdgcn_readfirstlane(tid >> 6), lane = tid & 63, wr = wid >> 2, wc = wid & 3, fr = lane & 15, fq = lane >> 4;
    int sR, sRb, sC2;
    { int R, C; stage_rc(tid * 16, R, C); sR = R; sRb = (R & ~31) + perm32(R & 31); sC2 = C * 2; }
    const size_t kstep = (size_t)(BK * 2);
    const unsigned ldsw = (unsigned)wid * 1024u;
    const int aoff = lds_byte(wr * 64 + fr, fq * 8), boff = lds_byte(wc * 32 + fr, fq * 8);
#define PG8_SA(b, h) (((b) * 2 + (h)) * HTB)
#define PG8_SB(b, h) ((4 + (b) * 2 + (h)) * HTB)
#define PG8_STAGE(bufoff, gbase, rows, pitch) do { const unsigned _o = (unsigned)((rows) * (pitch) + sC2); _Pragma("unroll") for (int _i = 0; _i < 2; ++_i) \
        __builtin_amdgcn_global_load_lds((const unsigned*)((const char*)(gbase) + (size_t)(_i * 64) * (pitch) + _o), (LAS unsigned*)(lds + (bufoff) + ldsw + _i * 8192), 16, 0, 0); } while (0)
#define PG8_LDA(dst, b, h) do { _Pragma("unroll") for (int m = 0; m < 4; ++m) _Pragma("unroll") for (int k = 0; k < 2; ++k) dst[m][k] = *(const LAS bf16x8*)(lds + PG8_SA(b, h) + aoff + m * 2048 + k * 1024); } while (0)
#define PG8_LDB(dst, b, h) do { _Pragma("unroll") for (int n = 0; n < 2; ++n) _Pragma("unroll") for (int k = 0; k < 2; ++k) dst[n][k] = *(const LAS bf16x8*)(lds + PG8_SB(b, h) + boff + n * 2048 + k * 1024); } while (0)
#define PG8_MMA(ai, bj, At, Bt) do { __builtin_amdgcn_s_setprio(1); _Pragma("unroll") for (int m = 0; m < 4; ++m) _Pragma("unroll") for (int n = 0; n < 2; ++n) _Pragma("unroll") for (int k = 0; k < 2; ++k) \
        acc[ai][bj][m][n] = __builtin_amdgcn_mfma_f32_16x16x32_bf16(Bt[n][k], At[m][k], acc[ai][bj][m][n], 0, 0, 0); __builtin_amdgcn_s_setprio(0); } while (0)
#define PG8_WAIT_V(n) asm volatile("s_waitcnt vmcnt(" #n ")" ::: "memory")
#define PG8_WAIT_L(n) asm volatile("s_waitcnt lgkmcnt(" #n ")" ::: "memory")
#define PG8_BAR __builtin_amdgcn_s_barrier()
#define PG8_SCHED __builtin_amdgcn_sched_barrier(0)
    UnitD cur, nxt; int ui = 0;
    if (!S.next(0, cur)) return;
    f32x4 acc[2][2][4][2];
#pragma unroll
    for (int a = 0; a < 2; ++a)
#pragma unroll
        for (int b = 0; b < 2; ++b)
#pragma unroll
            for (int m = 0; m < 4; ++m)
#pragma unroll
                for (int n = 0; n < 2; ++n) acc[a][b][m][n] = (f32x4){0.f, 0.f, 0.f, 0.f};
    bf16x8 At[4][2], B0[2][2], B1[2][2];
    const char* cA = cur.A; const char* cB = cur.B;
    int pA = cur.lda2, pB = cur.ldb2;
    PG8_STAGE(PG8_SB(0, 0), cB, sRb, pB); PG8_STAGE(PG8_SB(0, 1), cB + (size_t)HALF * pB, sRb, pB); PG8_STAGE(PG8_SA(0, 0), cA, sR, pA); PG8_STAGE(PG8_SA(0, 1), cA + (size_t)HALF * pA, sR, pA);
    if (wr == 1) PG8_BAR;
    PG8_WAIT_V(2); PG8_BAR;
    PG8_STAGE(PG8_SB(1, 0), cB + kstep, sRb, pB); PG8_STAGE(PG8_SA(1, 0), cA + kstep, sR, pA); PG8_STAGE(PG8_SB(1, 1), cB + (size_t)HALF * pB + kstep, sRb, pB);
    PG8_WAIT_V(6); PG8_BAR;
    for (;;) {
        const bool has_next = S.next(ui + 1, nxt);
        if (!has_next) nxt = cur;
        const char* nA = nxt.A; const char* nB = nxt.B;
        const int nt = cur.nt;
        for (int t = 0; t < nt; t += 2) {
            const bool last = (t == nt - 2);
            const char* a1 = cA + (size_t)(t + 1) * kstep + (size_t)HALF * pA;
            const char* a2 = last ? nA : cA + (size_t)(t + 2) * kstep; const char* b2 = last ? nB : cB + (size_t)(t + 2) * kstep;
            const int p2A = last ? nxt.lda2 : pA, p2B = last ? nxt.ldb2 : pB;
            const char* a2h = a2 + (size_t)HALF * p2A; const char* b2h = b2 + (size_t)HALF * p2B;
            PG8_LDB(B0, 0, 0); PG8_LDB(B1, 0, 1); PG8_SCHED; PG8_LDA(At, 0, 0); PG8_STAGE(PG8_SA(1, 1), a1, sR, pA);
            PG8_WAIT_V(8); PG8_WAIT_L(0); PG8_BAR; PG8_MMA(0, 0, At, B0); PG8_MMA(0, 1, At, B1); PG8_BAR; PG8_SCHED;
            PG8_LDA(At, 0, 1); PG8_STAGE(PG8_SB(0, 0), b2, sRb, p2B); PG8_STAGE(PG8_SB(0, 1), b2h, sRb, p2B); PG8_STAGE(PG8_SA(0, 0), a2, sR, p2A);
            PG8_WAIT_V(8); PG8_WAIT_L(0); PG8_BAR; PG8_MMA(1, 0, At, B0); PG8_MMA(1, 1, At, B1); PG8_BAR; PG8_SCHED;
            PG8_LDB(B0, 1, 0); PG8_LDB(B1, 1, 1); PG8_SCHED; PG8_LDA(At, 1, 0); PG8_STAGE(PG8_SA(0, 1), a2h, sR, p2A);
            PG8_WAIT_V(8); PG8_WAIT_L(0); PG8_BAR; PG8_MMA(0, 0, At, B0); PG8_MMA(0, 1, At, B1); PG8_BAR; PG8_SCHED;
            PG8_LDA(At, 1, 1); PG8_STAGE(PG8_SB(1, 0), b2 + kstep, sRb, p2B); PG8_STAGE(PG8_SB(1, 1), b2h + kstep, sRb, p2B); PG8_STAGE(PG8_SA(1, 0), a2 + kstep, sR, p2A);
            PG8_WAIT_V(8); PG8_WAIT_L(0); PG8_BAR; PG8_MMA(1, 0, At, B0); PG8_MMA(1, 1, At, B1); PG8_BAR; PG8_SCHED;
        }
        if (wr == 0) PG8_BAR;
        { int l2; asm volatile("v_mbcnt_lo_u32_b32 %0, -1, 0\n\tv_mbcnt_hi_u32_b32 %0, -1, %0" : "=v"(l2)); E(acc, cur, wr, wc, l2 & 15, l2 >> 4, wid * 64 + l2); asm volatile("s_waitcnt vmcnt(0)" ::: "memory"); }
        if (!has_next) break;
#pragma unroll
        for (int a = 0; a < 2; ++a)
#pragma unroll
            for (int b = 0; b < 2; ++b)
#pragma unroll
                for (int m = 0; m < 4; ++m)
#pragma unroll
                    for (int n = 0; n < 2; ++n) acc[a][b][m][n] = (f32x4){0.f, 0.f, 0.f, 0.f};
        cur = nxt; cA = nA; cB = nB; pA = cur.lda2; pB = cur.ldb2;
        ++ui;
        if (wr == 1) PG8_BAR;
    }
    PG8_WAIT_V(0);
    PG8_BAR;
#undef PG8_SA
#undef PG8_SB
#undef PG8_STAGE
#undef PG8_LDA
#undef PG8_LDB
#undef PG8_MMA
#undef PG8_WAIT_V
#undef PG8_WAIT_L
#undef PG8_BAR
#undef PG8_SCHED
}

struct SchedPlain {
    const char* A; const char* B; int lda2, ldb2, nt, nM, nN, G, c;
    __device__ __forceinline__ bool next(int i, UnitD& u) const {
        const long L = (long)i * G + c; if (L >= (long)nM * nN) return false;
        int pm, pn; tile_map((int)L, nM, nN, pm, pn);
        u.A = A + (size_t)pm * 256 * lda2; u.B = B + (size_t)pn * 256 * ldb2; u.lda2 = lda2; u.ldb2 = ldb2; u.nt = nt; u.pm = pm; u.pn = pn; u.kind = i; return true;
    }
};
struct SchedG5b {
    const char* A; const char* B; int G, c;
    __device__ __forceinline__ bool next(int i, UnitD& u) const {
        const long L = (long)i * G + c; if (L >= 128 * 4) return false;
        int pm, pn; tile_map((int)L, 128, 4, pm, pn);
        u.A = A + (size_t)pm * 256 * (UGW * 2); u.lda2 = UGW * 2; u.B = B + (size_t)pn * 256 * (DFF * 2); u.ldb2 = DFF * 2; u.nt = 44; u.pm = pm; u.pn = pn; u.kind = i; return true;
    }
};

#define EPI_LOOP for (int ai = 0; ai < 2; ++ai) _Pragma("unroll") for (int m = 0; m < 4; ++m) _Pragma("unroll") for (int bj = 0; bj < 2; ++bj)
struct EpiStore {
    bf16* O; int ldc;
    __device__ __forceinline__ void operator()(const f32x4 (&acc)[2][2][4][2], const UnitD& u, int wr, int wc, int fr, int fq, int tid) const {
        const int row0 = u.pm * BM + wr * 64 + fr, col0 = u.pn * BM + wc * 32 + 8 * fq;
#pragma unroll
        EPI_LOOP { const f32x4 v0 = acc[ai][bj][m][0], v1 = acc[ai][bj][m][1];
            u32x4 w; w.x = pk2(v0[0], v0[1]); w.y = pk2(v0[2], v0[3]); w.z = pk2(v1[0], v1[1]); w.w = pk2(v1[2], v1[3]);
            *(u32x4*)(O + (size_t)(row0 + ai * HALF + m * 16) * ldc + col0 + bj * HALF) = w; }
    }
};
struct EpiSlotStore {
    unsigned char* sc_; int act;
    __device__ __forceinline__ void operator()(const f32x4 (&acc)[2][2][4][2], const UnitD& u, int wr, int wc, int fr, int fq, int tid) const {
        unsigned loff = (unsigned)tid * 16u; asm volatile("" : "+v"(loff));
        unsigned char* sc = sc_ + (size_t)u.kind * 131072 + loff;
#pragma unroll
        EPI_LOOP { const int q = (ai * 2 + bj) * 4 + m; f32x4 v0 = acc[ai][bj][m][0], v1 = acc[ai][bj][m][1];
            if (act) { v0 = (f32x4){sigmoidf_(v0[0]), sigmoidf_(v0[1]), sigmoidf_(v0[2]), sigmoidf_(v0[3])}; v1 = (f32x4){sigmoidf_(v1[0]), sigmoidf_(v1[1]), sigmoidf_(v1[2]), sigmoidf_(v1[3])}; }
            u32x4 w; w.x = pk2(v0[0], v0[1]); w.y = pk2(v0[2], v0[3]); w.z = pk2(v1[0], v1[1]); w.w = pk2(v1[2], v1[3]);
            *(u32x4*)(sc + (size_t)q * 8192) = w; }
    }
};
struct EpiSlotMul {
    unsigned char* sc_;
    __device__ __forceinline__ void operator()(const f32x4 (&acc)[2][2][4][2], const UnitD& u, int wr, int wc, int fr, int fq, int tid) const {
        unsigned loff = (unsigned)tid * 16u; asm volatile("" : "+v"(loff));
        unsigned char* sc = sc_ + (size_t)u.kind * 131072 + loff;
#pragma unroll
        EPI_LOOP { const int q = (ai * 2 + bj) * 4 + m; const f32x4 v0 = acc[ai][bj][m][0], v1 = acc[ai][bj][m][1];
            u32x4* sp = (u32x4*)(sc + (size_t)q * 8192); const u32x4 p = *sp;
            u32x4 w; w.x = pk2(sigmoidf_(v0[0]) * bflo(p.x), sigmoidf_(v0[1]) * bfhi(p.x)); w.y = pk2(sigmoidf_(v0[2]) * bflo(p.y), sigmoidf_(v0[3]) * bfhi(p.y));
            w.z = pk2(sigmoidf_(v1[0]) * bflo(p.z), sigmoidf_(v1[1]) * bfhi(p.z)); w.w = pk2(sigmoidf_(v1[2]) * bflo(p.w), sigmoidf_(v1[3]) * bfhi(p.w));
            *sp = w;
            if (m & 1) asm volatile("" ::: "memory"); }
    }
};
struct EpiBranch {
    const unsigned char* sc_; bf16* MG; int first;
    __device__ __forceinline__ void operator()(const f32x4 (&acc)[2][2][4][2], const UnitD& u, int wr, int wc, int fr, int fq, int tid) const {
        const int row0 = u.pm * BM + wr * 64 + fr, col0 = u.pn * BM + wc * 32 + 8 * fq;
        unsigned loff = (unsigned)tid * 16u; asm volatile("" : "+v"(loff));
        const unsigned char* sc = sc_ + (size_t)u.kind * 131072 + loff;
#pragma unroll
        EPI_LOOP { const int q = (ai * 2 + bj) * 4 + m; const f32x4 v0 = acc[ai][bj][m][0], v1 = acc[ai][bj][m][1];
            const u32x4 g = *(const u32x4*)(sc + (size_t)q * 8192);
            u32x4* p = (u32x4*)(MG + (size_t)(row0 + ai * HALF + m * 16) * DM + col0 + bj * HALF);
            f32x4 t0 = (f32x4){bflo(g.x) * v0[0], bfhi(g.x) * v0[1], bflo(g.y) * v0[2], bfhi(g.y) * v0[3]};
            f32x4 t1 = (f32x4){bflo(g.z) * v1[0], bfhi(g.z) * v1[1], bflo(g.w) * v1[2], bfhi(g.w) * v1[3]};
            if (!first) { const u32x4 x = *p; t0 += (f32x4){bflo(x.x), bfhi(x.x), bflo(x.y), bfhi(x.y)}; t1 += (f32x4){bflo(x.z), bfhi(x.z), bflo(x.w), bfhi(x.w)}; }
            u32x4 w; w.x = pk2(t0[0], t0[1]); w.y = pk2(t0[2], t0[3]); w.z = pk2(t1[0], t1[1]); w.w = pk2(t1[2], t1[3]);
            *p = w;
            if (m & 1) asm volatile("" ::: "memory"); }
    }
};
struct EpiG3 {
    bf16* XB;
    __device__ __forceinline__ void operator()(const f32x4 (&acc)[2][2][4][2], const UnitD& u, int wr, int wc, int fr, int fq, int tid) const {
        const int row0 = u.pm * BM + wr * 64 + fr, col0 = u.pn * BM + wc * 32 + 8 * fq;
#pragma unroll
        EPI_LOOP { const f32x4 v0 = acc[ai][bj][m][0], v1 = acc[ai][bj][m][1];
            u32x4* p = (u32x4*)(XB + (size_t)(row0 + ai * HALF + m * 16) * DM + col0 + bj * HALF); const u32x4 x = *p;
            u32x4 w; w.x = pk2(ALPHA * bflo(x.x) + v0[0], ALPHA * bfhi(x.x) + v0[1]); w.y = pk2(ALPHA * bflo(x.y) + v0[2], ALPHA * bfhi(x.y) + v0[3]);
            w.z = pk2(ALPHA * bflo(x.z) + v1[0], ALPHA * bfhi(x.z) + v1[1]); w.w = pk2(ALPHA * bflo(x.w) + v1[2], ALPHA * bfhi(x.w) + v1[3]);
            *p = w; }
    }
};
struct EpiG5b {
    const unsigned char* esc_; bf16* XB;
    __device__ __forceinline__ void operator()(const f32x4 (&acc)[2][2][4][2], const UnitD& u, int wr, int wc, int fr, int fq, int tid) const {
        const int row0 = u.pm * BM + wr * 64 + fr, col0 = u.pn * BM + wc * 32 + 8 * fq;
        unsigned loff = (unsigned)tid * 16u; asm volatile("" : "+v"(loff));
        const unsigned char* esc = esc_ + (size_t)u.kind * 131072 + loff;
#pragma unroll
        EPI_LOOP { const int q = (ai * 2 + bj) * 4 + m; const f32x4 v0 = acc[ai][bj][m][0], v1 = acc[ai][bj][m][1];
            const u32x4 e = *(const u32x4*)(esc + (size_t)q * 8192);
            u32x4* p = (u32x4*)(XB + (size_t)(row0 + ai * HALF + m * 16) * DM + col0 + bj * HALF); const u32x4 x = *p;
            u32x4 w; w.x = pk2(ALPHA * bflo(x.x) + v0[0] + bflo(e.x), ALPHA * bfhi(x.x) + v0[1] + bfhi(e.x)); w.y = pk2(ALPHA * bflo(x.y) + v0[2] + bflo(e.y), ALPHA * bfhi(x.y) + v0[3] + bfhi(e.y));
            w.z = pk2(ALPHA * bflo(x.z) + v1[0] + bflo(e.z), ALPHA * bfhi(x.z) + v1[1] + bfhi(e.z)); w.w = pk2(ALPHA * bflo(x.w) + v1[2] + bflo(e.w), ALPHA * bfhi(x.w) + v1[3] + bfhi(e.w));
            *p = w;
            if (m & 1) asm volatile("" ::: "memory"); }
    }
};
}

struct Frame {
    LAS unsigned char* lds;
    int tid, lane, wave, G, wg;
    unsigned char* ws; unsigned char* dob;
};
struct Args { const float* in[21]; float* out; unsigned char* ws; int ph_lo, ph_hi; };

__device__ __forceinline__ int z_src(int n, float& sc) {
    sc = 1.f;
    if (n < 768) { if (n < 256) sc = 0.17677669529663687f * LOG2E; return n; }
    if (n < 1536) { if (n < 1024) sc = 0.125f * LOG2E; return n; }
    if (n < 2560) { if (n >= 1792 && n < 2048) sc = 0.125f; return 1700 + (n - 1536); }
    if (n < 2816) { if (n < 2688) sc = 0.17677669529663687f; return 2724 + (n - 2560); }
    if (n < 3072) return 2980 + (n - 2816);
    if (n < 3328) return 3252 + (n - 3072);
    if (n < 3456) return 1536 + (n - 3328);
    if (n < 3488) return 1664 + (n - 3456);
    if (n < 3492) return 1696 + (n - 3488);
    if (n >= 3504 && n < 3520) return 3236 + (n - 3504);
    return -1;
}
template <int MODE>
__device__ __forceinline__ void transpose_item(const float* W, int Nsrc, int soff, bf16* WT, int dpitch, int dcol0, int k0, int n0, LAS float* scr, int lane) {
    const int nn = lane & 31; float sc = 1.f; int s;
    if (MODE == 1) s = z_src(n0 + nn, sc); else s = soff + n0 + nn;
#pragma unroll 8
    for (int i = 0; i < 32; ++i) { const int kk = 2 * i + (lane >> 5); scr[kk * 33 + nn] = (s >= 0) ? W[(size_t)(k0 + kk) * Nsrc + s] * sc : 0.f; }
    asm volatile("s_waitcnt lgkmcnt(0)" ::: "memory");
    const int c = lane & 7;
#pragma unroll
    for (int j = 0; j < 4; ++j) { const int n = (lane >> 3) + 8 * j; const LAS float* sp = scr + (8 * c) * 33 + n;
        u32x4 o; o.x = pk2(sp[0 * 33], sp[1 * 33]); o.y = pk2(sp[2 * 33], sp[3 * 33]); o.z = pk2(sp[4 * 33], sp[5 * 33]); o.w = pk2(sp[6 * 33], sp[7 * 33]);
        *(u32x4*)(WT + (size_t)(n0 + n) * dpitch + dcol0 + k0 + 8 * c) = o; }
    asm volatile("s_waitcnt lgkmcnt(0)" ::: "memory");
}
typedef __attribute__((address_space(4))) const struct Args* KArgPtr;
__device__ __forceinline__ void convert_w123(Frame& F, const float* w_in, const float* w_branch, const float* w_out) {
    LAS float* scr = (LAS float*)(F.lds + F.wave * 16384);
    const int gw = F.wg * NWAVES + F.wave, NGW = F.G * NWAVES;
    constexpr int I1 = 16 * 112, I2 = 16 * 128, I3 = 4 * 128, I4 = 16 * 32;
    unsigned char* w123 = F.ws + WS_W123;
    for (int it = gw; it < I1 + I2 + I3 + I4; it += NGW) {
        int r = it;
        if (r < I1) { transpose_item<1>(w_in, NIN, 0, (bf16*)(w123 + W123_W1), 1024, 0, 64 * (r / 112), 32 * (r % 112), scr, F.lane); continue; } r -= I1;
        if (r < I2) { transpose_item<0>(w_in, NIN, SRC_MG, (bf16*)(w123 + W123_GB), 1024, 0, 64 * (r / 128), 32 * (r % 128), scr, F.lane); continue; } r -= I2;
        if (r < I3) { const int n = r / 128, rr = r % 128; transpose_item<0>(w_branch + (size_t)n * 256 * DM, DM, 0, (bf16*)(w123 + W123_GB + 8 * MiB) + (size_t)n * 1024 * 256, 256, 0, 64 * (rr / 32), 32 * (rr % 32), scr, F.lane); continue; } r -= I3;
        transpose_item<0>(w_out, DM, 0, (bf16*)(w123 + W123_WO), 1024, 0, 64 * (r / 32), 32 * (r % 32), scr, F.lane);
    }
}
__device__ __forceinline__ void p0_prologue(Frame& F, __attribute__((address_space(4))) const Args* Ap) {
    LAS float* scr = (LAS float*)(F.lds + F.wave * 16384);
    const int gw = F.wg * NWAVES + F.wave, NGW = F.G * NWAVES;
    constexpr int I5 = 16 * 176, I6 = 16 * 32, I7 = 4 * 32, I8 = 44 * 32;
    constexpr int IL = I5 + I6 + I7 + I8;
    for (int it = gw; it < 2 * IL; it += NGW) {
        const int l = it / IL; int r = it - l * IL;
        unsigned char* w45 = F.ws + WS_W45 + (size_t)l * W45_STRIDE;
        if (r < I5) { transpose_item<0>(Ap->in[13] + (size_t)l * DM * UGW, UGW, 0, (bf16*)(w45 + W45_UP), 1024, 0, 64 * (r / 176), 32 * (r % 176), scr, F.lane); continue; } r -= I5;
        if (r < I6) { transpose_item<0>(Ap->in[17] + (size_t)l * DM * DM, DM, 0, (bf16*)(w45 + W45_PG), 1024, 0, 64 * (r / 32), 32 * (r % 32), scr, F.lane); continue; } r -= I6;
        if (r < I7) { transpose_item<0>(Ap->in[18] + (size_t)l * PDIM * DM, DM, 0, (bf16*)(w45 + W45_PP), 256, 0, 64 * (r / 32), 32 * (r % 32), scr, F.lane); continue; } r -= I7;
        transpose_item<0>(Ap->in[16] + (size_t)l * DFF * DM, DM, 0, (bf16*)(w45 + W45_DN), DFF, 0, 64 * (r / 32), 32 * (r % 32), scr, F.lane);
    }
    convert_w123(F, Ap->in[2], Ap->in[9], Ap->in[10]);
    {   const size_t n8 = (size_t)M * DM / 8; const f32x4* src = (const f32x4*)Ap->in[0]; u32x4* dst = (u32x4*)(F.ws + WS_XB);
        for (size_t i = (size_t)F.wg * 512 + F.tid; i < n8; i += (size_t)F.G * 512) { const f32x4 a = src[2 * i], b = src[2 * i + 1]; u32x4 o; o.x = pk2(a[0], a[1]); o.y = pk2(a[2], a[3]); o.z = pk2(b[0], b[1]); o.w = pk2(b[2], b[3]); dst[i] = o; } }
    {   const size_t n8 = (size_t)DEPTH * M * PDIM / 8; const f32x4* src = (const f32x4*)Ap->in[1]; u32x4* dst = (u32x4*)(F.ws + WS_PB);
        for (size_t i = (size_t)F.wg * 512 + F.tid; i < n8; i += (size_t)F.G * 512) { const f32x4 a = src[2 * i], b = src[2 * i + 1]; u32x4 o; o.x = pk2(a[0], a[1]); o.y = pk2(a[2], a[3]); o.z = pk2(b[0], b[1]); o.w = pk2(b[2], b[3]); dst[i] = o; } }
}

__device__ __forceinline__ void ln_phase(Frame& F, const float* w, const float* bvec, float* outf) {
    const int gw = F.wg * NWAVES + F.wave, NGW = F.G * NWAVES;
    bf16* XB = (bf16*)(F.ws + WS_XB);
    for (int row = gw; row < M; row += NGW) {
        u32x4* p = (u32x4*)(XB + (size_t)row * DM) + F.lane;
        const u32x4 a = p[0], b = p[64];
        float v[16] = {bflo(a.x), bfhi(a.x), bflo(a.y), bfhi(a.y), bflo(a.z), bfhi(a.z), bflo(a.w), bfhi(a.w), bflo(b.x), bfhi(b.x), bflo(b.y), bfhi(b.y), bflo(b.z), bfhi(b.z), bflo(b.w), bfhi(b.w)};
        float s = 0.f;
#pragma unroll
        for (int i = 0; i < 16; ++i) s += v[i];
        const float mean = wave_sum(s) * (1.f / DM); float q = 0.f;
#pragma unroll
        for (int i = 0; i < 16; ++i) { v[i] -= mean; q += v[i] * v[i]; }
        const float rstd = 1.f / sqrtf(wave_sum(q) * (1.f / DM) + LN_EPS);
        const int c0 = F.lane * 8, c1 = 512 + F.lane * 8;
        const f32x4 w0 = *(const f32x4*)(w + c0), w1 = *(const f32x4*)(w + c0 + 4), w2 = *(const f32x4*)(w + c1), w3 = *(const f32x4*)(w + c1 + 4);
        const f32x4 b0 = *(const f32x4*)(bvec + c0), b1 = *(const f32x4*)(bvec + c0 + 4), b2 = *(const f32x4*)(bvec + c1), b3 = *(const f32x4*)(bvec + c1 + 4);
        f32x4 y0, y1, y2, y3;
#pragma unroll
        for (int i = 0; i < 4; ++i) { y0[i] = v[i] * rstd * w0[i] + b0[i]; y1[i] = v[4 + i] * rstd * w1[i] + b1[i]; y2[i] = v[8 + i] * rstd * w2[i] + b2[i]; y3[i] = v[12 + i] * rstd * w3[i] + b3[i]; }
        u32x4 o0, o1; o0.x = pk2(y0[0], y0[1]); o0.y = pk2(y0[2], y0[3]); o0.z = pk2(y1[0], y1[1]); o0.w = pk2(y1[2], y1[3]);
        o1.x = pk2(y2[0], y2[1]); o1.y = pk2(y2[2], y2[3]); o1.z = pk2(y3[0], y3[1]); o1.w = pk2(y3[2], y3[3]);
        p[0] = o0; p[64] = o1;
        if (outf) { f32x4* op = (f32x4*)(outf + (size_t)row * DM); op[2 * F.lane] = y0; op[2 * F.lane + 1] = y1; op[128 + 2 * F.lane] = y2; op[128 + 2 * F.lane + 1] = y3; }
    }
}

__device__ __forceinline__ float gelu_tanh_(float y) { const float t = 1.5957691216057308f * (y + 0.044715f * y * y * y); return y * __builtin_amdgcn_rcpf(1.0f + __builtin_amdgcn_exp2f(-LOG2E * t)); }
__device__ __forceinline__ void up8(const u32x4 w, float (&v)[8]) { v[0] = bflo(w.x); v[1] = bfhi(w.x); v[2] = bflo(w.y); v[3] = bfhi(w.y); v[4] = bflo(w.z); v[5] = bfhi(w.z); v[6] = bflo(w.w); v[7] = bfhi(w.w); }
__device__ __forceinline__ void ffn_act_phase(Frame& F, const float* cw, const float* cb) {
    bf16* UG = (bf16*)(F.ws + WS_UG);
    constexpr int NCG = DFF / 8, NRB = M / 64;
    for (int task = F.wg * 512 + F.tid; task < NCG * NRB; task += F.G * 512) {
        const int rb = task / NCG, cg = task - rb * NCG; const int t0 = rb * 64, c0 = cg * 8;
        float w0[8], w1[8], w2[8], bb[8];
#pragma unroll
        for (int i = 0; i < 8; ++i) { w0[i] = cw[c0 + i]; w1[i] = cw[DFF + c0 + i]; w2[i] = cw[2 * DFF + c0 + i]; bb[i] = cb[c0 + i]; }
        float gm2[8], gm1[8];
        if ((t0 & (SEQ - 1)) == 0) {
#pragma unroll
            for (int i = 0; i < 8; ++i) { gm2[i] = 0.f; gm1[i] = 0.f; }
        } else { up8(*(const u32x4*)(UG + (size_t)(t0 - 2) * UGW + DFF + c0), gm2); up8(*(const u32x4*)(UG + (size_t)(t0 - 1) * UGW + DFF + c0), gm1); }
        for (int r = 0; r < 64; ++r) {
            bf16* rowp = UG + (size_t)(t0 + r) * UGW;
            float g0[8], uu[8]; up8(*(const u32x4*)(rowp + DFF + c0), g0); up8(*(const u32x4*)(rowp + c0), uu);
            float o[8];
#pragma unroll
            for (int i = 0; i < 8; ++i) { const float y = bb[i] + w0[i] * gm2[i] + w1[i] * gm1[i] + w2[i] * g0[i]; o[i] = gelu_tanh_(y) * uu[i]; gm2[i] = gm1[i]; gm1[i] = g0[i]; }
            u32x4 w; w.x = pk2(o[0], o[1]); w.y = pk2(o[2], o[3]); w.z = pk2(o[4], o[5]); w.w = pk2(o[6], o[7]);
            *(u32x4*)(rowp + c0) = w;
        }
    }
}

namespace mx {
__device__ __forceinline__ f32x16 mfma32(bf16x8 a, bf16x8 b, f32x16 c) { return __builtin_amdgcn_mfma_f32_32x32x16_bf16(a, b, c, 0, 0, 0); }
__device__ __forceinline__ f32x16 splat16(float v) { f32x16 r;
#pragma unroll
    for (int i = 0; i < 16; ++i) r[i] = v;
    return r; }
__device__ __forceinline__ int crow_c(int e) { return (e & 3) + 8 * (e >> 2); }
typedef short v4i16_t __attribute__((ext_vector_type(4)));
__device__ __forceinline__ s16x4 vtr(const LAS unsigned char* p) { return __builtin_bit_cast(s16x4, __builtin_amdgcn_ds_read_tr16_b64_v4i16((LAS v4i16_t*)p)); }
__device__ __forceinline__ bf16x8 pack8(float a0, float a1, float a2, float a3, float a4, float a5, float a6, float a7) {
    u32x4 w; w.x = pk2(a0, a1); w.y = pk2(a2, a3); w.z = pk2(a4, a5); w.w = pk2(a6, a7); return __builtin_bit_cast(bf16x8, w); }

__device__ __forceinline__ float log2gam(int h) { return __builtin_log2f(1.0f - __builtin_exp2f(-5.0f - (float)h)); }
__device__ __forceinline__ void prepkv_unit(Frame& F, int blk, const float* wa2, const float* bap) {
    bf16* Z = (bf16*)(F.ws + WS_Z);
    const size_t r0 = (size_t)blk * 256; const int b = blk >> 5, cb = blk & 31;
    const int tid = F.tid;
    {   const int ch = tid >> 7, col = tid & 127;
        const float ba = bap[col];
        float wa[16];
#pragma unroll
        for (int r = 0; r < 16; ++r) wa[r] = wa2[r * 128 + col];
        float cum = 0.f;
        for (int t = 0; t < 64; ++t) {
            const bf16* zr = Z + (r0 + ch * 64 + t) * ZW; float da[8], db[8]; up8(*(const u32x4*)(zr + ZC_DA), da); up8(*(const u32x4*)(zr + ZC_DA + 8), db);
            float x = ba;
#pragma unroll
            for (int r = 0; r < 8; ++r) x += da[r] * wa[r];
#pragma unroll
            for (int r = 0; r < 8; ++r) x += db[r] * wa[8 + r];
            const float ls = fminf(x, 0.f) - __logf(1.0f + __expf(-fabsf(x)));
            cum += ls * 0.0625f;
        }
        const float bl = cum; cum = 0.f;
        for (int t = 0; t < 64; ++t) {
            bf16* zr = Z + (r0 + ch * 64 + t) * ZW; float da[8], db[8]; up8(*(const u32x4*)(zr + ZC_DA), da); up8(*(const u32x4*)(zr + ZC_DA + 8), db);
            float x = ba;
#pragma unroll
            for (int r = 0; r < 8; ++r) x += da[r] * wa[r];
#pragma unroll
            for (int r = 0; r < 8; ++r) x += db[r] * wa[8 + r];
            const float ls = fminf(x, 0.f) - __logf(1.0f + __expf(-fabsf(x)));
            cum += ls * 0.0625f;
            const float q = bf1(zr[ZC_DQ + col]), k = bf1(zr[ZC_DK + col]);
            zr[ZC_DQ + col] = (bf16)f2bf(q * __expf(cum - bl)); zr[ZC_DK + col] = (bf16)f2bf(k * __expf(bl - cum));
        }
        ((float*)(F.ws + WS_DE))[((size_t)b * 128 + cb * 4 + ch) * 128 + col] = __expf(bl);
    }
    for (int idx = tid; idx < 256 * 64; idx += 512) {
        const int row = idx >> 6, chunk = idx & 63, isk = chunk >> 5, c8 = (chunk & 31) * 8, h = c8 >> 6;
        const float e = (float)(255 - row) * log2gam(h); const float f = __builtin_amdgcn_exp2f(isk ? e : -e);
        u32x4* p = (u32x4*)(Z + (r0 + row) * ZW + (isk ? ZC_CK : ZC_CQ) + c8); float v[8]; up8(*p, v);
        u32x4 w; w.x = pk2(v[0] * f, v[1] * f); w.y = pk2(v[2] * f, v[3] * f); w.z = pk2(v[4] * f, v[5] * f); w.w = pk2(v[6] * f, v[7] * f); *p = w;
    }
    __threadfence_block(); __syncthreads();
    LAS unsigned char* Kl = F.lds; LAS unsigned char* Vl = F.lds + 36864;
    for (int h = 0; h < 4; ++h) {
        for (int idx = tid; idx < 256 * 8; idx += 512) { const int row = idx >> 3, c = idx & 7;
            *(LAS u32x4*)(Kl + row * 144 + c * 16) = *(const u32x4*)(Z + (r0 + row) * ZW + ZC_CK + h * 64 + c * 8);
            *(LAS u32x4*)(Vl + row * 144 + c * 16) = *(const u32x4*)(Z + (r0 + row) * ZW + ZC_CV + h * 64 + c * 8); }
        __syncthreads();
        {   const int d = tid >> 3, dk8 = (tid & 7) * 8; float acc[8];
#pragma unroll
            for (int i = 0; i < 8; ++i) acc[i] = 0.f;
            for (int j = 0; j < 256; ++j) { const float vv = bf1(*(const LAS bf16*)(Vl + j * 144 + d * 2)); float kk[8]; up8(*(const LAS u32x4*)(Kl + j * 144 + dk8 * 2), kk);
#pragma unroll
                for (int i = 0; i < 8; ++i) acc[i] += vv * kk[i]; }
            float* o = (float*)(F.ws + WS_KVC) + ((size_t)((b * 4 + h) * 32 + cb) * 4096 + d * 64 + dk8);
            *(f32x4*)o = (f32x4){acc[0], acc[1], acc[2], acc[3]}; *(f32x4*)(o + 4) = (f32x4){acc[4], acc[5], acc[6], acc[7]}; }
        __syncthreads();
        for (int idx = tid; idx < 256 * 8; idx += 512) { const int row = idx >> 3, c = idx & 7;
            if (c < 4) *(LAS u32x4*)(Kl + row * 144 + c * 16) = *(const u32x4*)(Z + (r0 + row) * ZW + ZC_DK + h * 32 + c * 8);
            *(LAS u32x4*)(Vl + row * 144 + c * 16) = *(const u32x4*)(Z + (r0 + row) * ZW + ZC_DV + h * 64 + c * 8); }
        __syncthreads();
        {   const int ch = tid >> 7, d = (tid >> 1) & 63, dk16 = (tid & 1) * 16; float acc[16];
#pragma unroll
            for (int i = 0; i < 16; ++i) acc[i] = 0.f;
            for (int j = 0; j < 64; ++j) { const int row = ch * 64 + j; const float vv = bf1(*(const LAS bf16*)(Vl + row * 144 + d * 2)); float k0[8], k1[8];
                up8(*(const LAS u32x4*)(Kl + row * 144 + dk16 * 2), k0); up8(*(const LAS u32x4*)(Kl + row * 144 + dk16 * 2 + 16), k1);
#pragma unroll
                for (int i = 0; i < 8; ++i) { acc[i] += vv * k0[i]; acc[8 + i] += vv * k1[i]; } }
            float* o = (float*)(F.ws + WS_KVD) + ((size_t)((b * 4 + h) * 128 + cb * 4 + ch) * 2048 + d * 32 + dk16);
#pragma unroll
            for (int i = 0; i < 4; ++i) *(f32x4*)(o + 4 * i) = (f32x4){acc[4 * i], acc[4 * i + 1], acc[4 * i + 2], acc[4 * i + 3]}; }
        __syncthreads();
    }
}

__device__ __forceinline__ void scan_phase(Frame& F) {
    const int gt = F.wg * 512 + F.tid, NT = F.G * 512;
    for (int e = gt; e < 16 * 4096; e += NT) {
        const int bh = e >> 12, idx = e & 4095, h = bh & 3; const float g256 = __builtin_amdgcn_exp2f(256.0f * log2gam(h));
        float* p = (float*)(F.ws + WS_KVC) + (size_t)bh * 32 * 4096 + idx; float S = 0.f;
        for (int c = 0; c < 32; ++c) { const float kv = p[(size_t)c * 4096]; const float Sp = g256 * S; p[(size_t)c * 4096] = Sp; S = Sp + kv; }
    }
    for (int e = gt; e < 16 * 2048; e += NT) {
        const int bh = e >> 11, idx = e & 2047, b = bh >> 2, h = bh & 3, dk = idx & 31;
        float* p = (float*)(F.ws + WS_KVD) + (size_t)bh * 128 * 2048 + idx; const float* de = (const float*)(F.ws + WS_DE) + (size_t)b * 128 * 128 + h * 32 + dk; float S = 0.f;
        for (int c = 0; c < 128; ++c) { const float kv = p[(size_t)c * 2048]; const float Sp = de[c * 128] * S; p[(size_t)c * 2048] = Sp; S = Sp + kv; }
    }
}

constexpr int HPITCH = 1026, CAP = 256;
struct QState { unsigned mode, thr_lo, thr_hi, thr_idx, krem, lcount, pad0, pad1; };
__device__ __forceinline__ unsigned okey_of(float s) { const unsigned u = __float_as_uint(s); return u ^ ((unsigned)((int)u >> 31) | 0x80000000u); }
__device__ __forceinline__ void b1_load(const bf16* Zb, int t, int r, int hh, bf16x8& k0, bf16x8& k1) {
    const bf16* kr = Zb + (size_t)(32 * t + r) * ZW + ZC_IK + 8 * hh; k0 = *(const bf16x8*)kr; k1 = *(const bf16x8*)(kr + 16); }
__device__ __forceinline__ void b1_scores(const bf16x8 k0, const bf16x8 k1, const bf16x8 (&iqf)[4][2], const float (&w)[4], float (&sc)[16]) {
#pragma unroll
    for (int e = 0; e < 16; ++e) sc[e] = 0.f;
#pragma unroll
    for (int ih = 0; ih < 4; ++ih) { f32x16 lg = mfma32(k0, iqf[ih][0], splat16(0.f)); lg = mfma32(k1, iqf[ih][1], lg);
#pragma unroll
        for (int e = 0; e < 16; ++e) sc[e] = fmaf(w[ih], fmaxf(lg[e], 0.f), sc[e]); }
}
__device__ __forceinline__ void b1_setbit(unsigned* MWq, unsigned j) {
    const unsigned wi = j & 31u, hh = (wi >> 2) & 1u, e = (wi & 3u) + 4u * (wi >> 3), kh = (j >> 5) & 1u;
    __hip_atomic_fetch_or(MWq + (size_t)(j >> 6) * 64 + 32u * hh, 1u << (e + 16u * kh), __ATOMIC_RELAXED, __HIP_MEMORY_SCOPE_AGENT);
}
__device__ __forceinline__ void b1_unit(Frame& F, int b, int g) {
    const int tid = F.tid, lane = F.lane, r = lane & 31, hh = lane >> 5, wid = F.wave;
    const bf16* Zb = (const bf16*)(F.ws + WS_Z) + (size_t)b * SEQ * ZW;
    LAS unsigned* hist = (LAS unsigned*)F.lds;
    LAS QState* qst = (LAS QState*)(F.lds + QST_OFF);
    const int qpos = 32 * g + r;
    unsigned* MWb = (unsigned*)(F.ws + WS_MASK) + ((size_t)(b * 256 + g) * 128) * 64;
    bf16x8 iqf[4][2]; float w[4];
    {   const bf16* qr = Zb + (size_t)qpos * ZW;
#pragma unroll
        for (int ih = 0; ih < 4; ++ih) { iqf[ih][0] = *(const bf16x8*)(qr + ZC_IQ + ih * 32 + 8 * hh); iqf[ih][1] = *(const bf16x8*)(qr + ZC_IQ + ih * 32 + 16 + 8 * hh); w[ih] = bf1(qr[ZC_IW + ih]); } }
    if (g >= 8) {
        for (int i = tid; i < 32 * HPITCH; i += 512) hist[i] = 0u;
        __syncthreads();
        {   bf16x8 n0 = iqf[0][0], n1 = iqf[0][0]; int t = wid; if (t <= g) b1_load(Zb, t, r, hh, n0, n1);
            for (; t <= g; t += 8) { const bf16x8 k0 = n0, k1 = n1; if (t + 8 <= g) b1_load(Zb, t + 8, r, hh, n0, n1);
                float sc[16]; b1_scores(k0, k1, iqf, w, sc);
#pragma unroll
                for (int e = 0; e < 16; ++e) { const int j = 32 * t + crow_c(e) + 4 * hh; if (j <= qpos) { const unsigned bin = okey_of(sc[e]) >> 21;
                    __hip_atomic_fetch_add(hist + r * HPITCH + (bin >> 1), 1u << ((bin & 1) * 16), __ATOMIC_RELAXED, __HIP_MEMORY_SCOPE_WORKGROUP); } } } }
        __syncthreads();
        for (int qq = 0; qq < 4; ++qq) { const int q = 4 * wid + qq; const LAS unsigned* hq = hist + q * HPITCH;
            const int wbase = 1008 - 16 * lane; unsigned s = 0;
#pragma unroll
            for (int k = 0; k < 16; ++k) { const unsigned x = hq[wbase + k]; s += (x & 0xffffu) + (x >> 16); }
            unsigned P = s;
#pragma unroll
            for (int o = 1; o < 64; o <<= 1) { const unsigned t = __shfl_up(P, o); if (lane >= o) P += t; }
            const unsigned long long bal = __ballot(P >= 256u);
            const int Lsel = bal ? __builtin_ctzll(bal) : 63;
            if (lane == Lsel) { unsigned cum = P - s; unsigned b1 = 0, cin = 0, cab = 0;
                for (int k = 0; k < 32; ++k) { const int bin = 2047 - 32 * lane - k; const unsigned x = hq[bin >> 1]; const unsigned c = (bin & 1) ? (x >> 16) : (x & 0xffffu);
                    if (cum + c >= 256u) { b1 = (unsigned)bin; cin = c; cab = cum; break; } cum += c; }
                qst[q].thr_lo = b1 << 21; qst[q].thr_hi = (b1 << 21) | 0x1fffffu; qst[q].thr_idx = 0xffffu; qst[q].krem = 256u - cab; qst[q].lcount = 0u; qst[q].pad0 = cin; qst[q].pad1 = 0u;
                qst[q].mode = (b1 == 1024u || cin > (unsigned)CAP) ? 2u : 1u; }
        }
        __syncthreads();
        for (int i = tid; i < 32 * 256; i += 512) ((LAS unsigned*)(F.lds + 65536))[i] = 0u;
        __syncthreads();
    }
    {   unsigned mode = 0u, tlo = 1u, thi = 0u;
        const bool allsel = (g < 8);
        if (!allsel) { mode = qst[r].mode; tlo = qst[r].thr_lo; thi = qst[r].thr_hi; }
        const int nk = g >> 1;
        bf16x8 n0 = iqf[0][0], n1 = iqf[0][0], n2 = iqf[0][0], n3 = iqf[0][0]; int kt = wid;
        if (kt <= nk) { b1_load(Zb, 2 * kt, r, hh, n0, n1); if (2 * kt + 1 <= g) b1_load(Zb, 2 * kt + 1, r, hh, n2, n3); }
        for (; kt <= nk; kt += 8) {
            const bf16x8 k0 = n0, k1 = n1, k2 = n2, k3 = n3;
            if (kt + 8 <= nk) { b1_load(Zb, 2 * kt + 16, r, hh, n0, n1); if (2 * kt + 17 <= g) b1_load(Zb, 2 * kt + 17, r, hh, n2, n3); }
            unsigned word = 0u;
#pragma unroll
            for (int kh = 0; kh < 2; ++kh) { const int t = 2 * kt + kh; if (t <= g) { float sc[16]; b1_scores(kh ? k2 : k0, kh ? k3 : k1, iqf, w, sc);
#pragma unroll
                for (int e = 0; e < 16; ++e) { const int j = 32 * t + crow_c(e) + 4 * hh; const unsigned ok = okey_of(sc[e]); const bool valid = (j <= qpos);
                    const bool sel = valid && (allsel || ok > thi); word |= (sel ? 1u : 0u) << (e + 16 * kh);
                    if (!allsel && valid && ok >= tlo && ok <= thi) {
                        if (mode == 1u) { const unsigned pos = __hip_atomic_fetch_add(&qst[r].lcount, 1u, __ATOMIC_RELAXED, __HIP_MEMORY_SCOPE_WORKGROUP);
                            if (pos < (unsigned)CAP) { LAS unsigned* le = (LAS unsigned*)(F.lds + ((size_t)r * CAP + pos) * 8); le[0] = ok; le[1] = (unsigned)j; } }
                        else __hip_atomic_fetch_or((LAS unsigned*)(F.lds + 65536 + r * 1024) + (j >> 5), 1u << (j & 31), __ATOMIC_RELAXED, __HIP_MEMORY_SCOPE_WORKGROUP); } } } }
            MWb[(size_t)kt * 64 + lane] = word; }
    }
    __syncthreads();
    if (g >= 8) {
        for (int qq = 0; qq < 4; ++qq) { const int q = 4 * wid + qq; const unsigned mode = qst[q].mode, krem = qst[q].krem; unsigned* MWq = MWb + q;
            if (mode == 1u) {
                unsigned L = qst[q].lcount; if (L > (unsigned)CAP) L = CAP; const LAS unsigned* lb = (const LAS unsigned*)(F.lds + (size_t)q * CAP * 8);
                unsigned long long comp[4]; bool has[4]; unsigned jj[4];
#pragma unroll
                for (int k = 0; k < 4; ++k) { const unsigned c = lane + 64 * k; has[k] = c < L; const unsigned ok = has[k] ? lb[2 * c] : 0u; jj[k] = has[k] ? lb[2 * c + 1] : 0u;
                    comp[k] = ((unsigned long long)(ok & 0x1fffffu) << 13) | (unsigned long long)(8191u - jj[k]); }
                unsigned long long prefix = 0ull; unsigned need = krem;
                for (int bit = 33; bit >= 0; --bit) { const unsigned long long want = (prefix >> bit) | 1ull; unsigned cnt = 0;
#pragma unroll
                    for (int k = 0; k < 4; ++k) cnt += (unsigned)__builtin_popcountll(__ballot(has[k] && ((comp[k] >> bit) == want)));
                    if (cnt >= need) prefix |= (1ull << bit); else need -= cnt; }
#pragma unroll
                for (int k = 0; k < 4; ++k) if (has[k] && comp[k] >= prefix) b1_setbit(MWq, jj[k]); }
            else { const LAS unsigned* bm = (const LAS unsigned*)(F.lds + 65536 + q * 1024); unsigned x[4]; unsigned s = 0;
#pragma unroll
                for (int k = 0; k < 4; ++k) { x[k] = bm[4 * lane + k]; s += __builtin_popcount(x[k]); }
                unsigned P = s;
#pragma unroll
                for (int o = 1; o < 64; o <<= 1) { const unsigned t = __shfl_up(P, o); if (lane >= o) P += t; }
                unsigned before = P - s;
#pragma unroll
                for (int k = 0; k < 4; ++k) { unsigned y = x[k]; while (y != 0u && before < krem) { const unsigned bit = (unsigned)__builtin_ctz(y); y &= y - 1u; b1_setbit(MWq, 32u * (4 * lane + k) + bit); ++before; } before += __builtin_popcount(y); } }
        }
        __syncthreads();
    }
}

struct EngP { const bf16* Z; bf16* Y; const unsigned* MASK; const float* ST; const float* nw; float lam, lam_init; };
template <int MODE>
__device__ __forceinline__ void eng_unit(Frame& F, const EngP& P, int b, int h, int qb) {
    constexpr bool SOFT = MODE <= 1;
    constexpr int NMAP = MODE == 0 ? 2 : 1;
    constexpr int NS = (MODE == 0 || MODE == 3) ? 2 : 4;
    constexpr int KCH = MODE == 3 ? 4 : 8;
    constexpr int QC = MODE == 0 ? ZC_AQ : MODE == 1 ? ZC_BQ : MODE == 2 ? ZC_CQ : ZC_DQ;
    constexpr int KC = MODE == 0 ? ZC_AK : MODE == 1 ? ZC_BK : MODE == 2 ? ZC_CK : ZC_DK;
    constexpr int VC = MODE == 0 ? ZC_AV : MODE == 1 ? ZC_BV : MODE == 2 ? ZC_CV : ZC_DV;
    constexpr int HW = MODE == 3 ? 32 : 64;
    const int tid = F.tid, lane = F.lane, r = lane & 31, hh = lane >> 5, w = F.wave;
    const size_t rowbase = (size_t)b * SEQ;
    const int qw0 = qb * 256 + 32 * w;
    const float NEG = -__builtin_inff();
    const int hidx = MODE <= 1 ? (MODE == 0 ? 2 * h + 1 : 2 * h + 2) : 0;
    const float slope2 = SOFT ? __builtin_amdgcn_exp2f(-(float)hidx) * LOG2E : 0.f;
    bf16x8 qf[NMAP][NS];
    {   const bf16* qrow = P.Z + (rowbase + qw0 + r) * ZW + QC + h * HW;
#pragma unroll
        for (int m = 0; m < NMAP; ++m)
#pragma unroll
            for (int s = 0; s < NS; ++s) qf[m][s] = *(const bf16x8*)(qrow + m * 32 + 16 * s + 8 * hh); }
    f32x16 cinit;
#pragma unroll
    for (int e = 0; e < 16; ++e) cinit[e] = SOFT ? slope2 * (float)(crow_c(e) + 4 * hh) : 0.f;
    float m_run[NMAP], l_run[NMAP]; f32x16 O[NMAP][2];
#pragma unroll
    for (int m = 0; m < NMAP; ++m) { m_run[m] = NEG; l_run[m] = 0.f; O[m][0] = splat16(0.f); O[m][1] = splat16(0.f); }
    if (!SOFT) {
        const int sidx = MODE == 2 ? ((b * 4 + h) * 32 + qb) : ((b * 4 + h) * 128 + 4 * qb + (w >> 1));
        const float* sp = P.ST + (size_t)sidx * (64 * HW);
#pragma unroll
        for (int db = 0; db < 2; ++db)
#pragma unroll
            for (int s = 0; s < NS; ++s) { const float* a = sp + (size_t)(32 * db + r) * HW + 16 * s + 8 * hh; const f32x4 a0 = *(const f32x4*)a, a1 = *(const f32x4*)(a + 4);
                O[0][db] = mfma32(pack8(a0[0], a0[1], a0[2], a0[3], a1[0], a1[1], a1[2], a1[3]), qf[0][s], O[0][db]); }
    }
    const int kt_lo = SOFT ? 0 : 4 * qb, kt_hi = 4 * qb + 3;
    const int srow = tid >> 3, sch = tid & 7;
    u32x4 kreg = (u32x4){0u, 0u, 0u, 0u}, vreg;
    {   const bf16* zr = P.Z + (rowbase + 64 * kt_lo + srow) * ZW;
        if (sch < KCH) kreg = *(const u32x4*)(zr + KC + h * HW + sch * 8);
        vreg = *(const u32x4*)(zr + VC + h * 64 + sch * 8);
        LAS unsigned char* Kb = F.lds + (kt_lo & 1) * 9216; LAS unsigned char* Vb = F.lds + 18432 + (kt_lo & 1) * 9216;
        if (sch < KCH) *(LAS u32x4*)(Kb + srow * 144 + sch * 16) = kreg;
        *(LAS u32x4*)(Vb + srow * 144 + sch * 16) = vreg; }
    __syncthreads();
    for (int kt = kt_lo; kt <= kt_hi; ++kt) {
        if (kt < kt_hi) { const bf16* zr = P.Z + (rowbase + 64 * (kt + 1) + srow) * ZW;
            if (sch < KCH) kreg = *(const u32x4*)(zr + KC + h * HW + sch * 8);
            vreg = *(const u32x4*)(zr + VC + h * 64 + sch * 8); }
        const int j0 = 64 * kt;
        const bool act = (MODE == 3) ? (kt == 4 * qb + (w >> 1)) : (j0 <= qw0 + 31);
        if (act) {
            const LAS unsigned char* Kb = F.lds + (kt & 1) * 9216; const LAS unsigned char* Vb = F.lds + 18432 + (kt & 1) * 9216;
            unsigned mw = 0xffffffffu;
            if (MODE == 1) mw = P.MASK[((size_t)(b * 256 + qb * 8 + w) * 128 + kt) * 64 + lane];
            const bool hact1 = (j0 + 32 <= qw0 + 31);
#pragma unroll
            for (int m = 0; m < NMAP; ++m) {
                f32x16 st[2];
#pragma unroll
                for (int kh = 0; kh < 2; ++kh) {
                    if (kh == 0 || hact1) {
                        f32x16 a = cinit;
#pragma unroll
                        for (int s = 0; s < NS; ++s) { const bf16x8 kf = *(const LAS bf16x8*)(Kb + (32 * kh + r) * 144 + (m * 32 + 16 * s + 8 * hh) * 2); a = mfma32(kf, qf[m][s], a); }
                        if (j0 + 32 * kh + 31 > qw0) { const int lim = qw0 + r - j0 - 32 * kh - 4 * hh;
#pragma unroll
                            for (int e = 0; e < 16; ++e) if (crow_c(e) > lim) a[e] = SOFT ? NEG : 0.f; }
                        if (MODE == 1) {
#pragma unroll
                            for (int e = 0; e < 16; ++e) if (!((mw >> (e + 16 * kh)) & 1u)) a[e] = NEG; }
                        st[kh] = a;
                    } else st[kh] = splat16(SOFT ? NEG : 0.f);
                }
                if (SOFT) {
                    const float off0 = slope2 * (float)(j0 - qw0 - r), off1 = off0 + 32.f * slope2;
                    float mx0 = st[0][0], mx1 = st[1][0];
#pragma unroll
                    for (int e = 1; e < 16; ++e) { mx0 = fmaxf(mx0, st[0][e]); mx1 = fmaxf(mx1, st[1][e]); }
                    float mx = fmaxf(mx0 + off0, mx1 + off1); mx = fmaxf(mx, __shfl_xor(mx, 32));
                    const float mn = fmaxf(m_run[m], mx); const float msafe = (mn == NEG) ? 0.f : mn;
                    const float alpha = __builtin_amdgcn_exp2f(m_run[m] - msafe); m_run[m] = mn;
                    const float d0 = off0 - msafe, d1 = off1 - msafe; float rs = 0.f;
#pragma unroll
                    for (int e = 0; e < 16; ++e) { const float p0 = __builtin_amdgcn_exp2f(st[0][e] + d0), p1 = __builtin_amdgcn_exp2f(st[1][e] + d1); st[0][e] = p0; st[1][e] = p1; rs += p0 + p1; }
                    rs += __shfl_xor(rs, 32); l_run[m] = l_run[m] * alpha + rs;
#pragma unroll
                    for (int e = 0; e < 16; ++e) { O[m][0][e] *= alpha; O[m][1][e] *= alpha; }
                }
#pragma unroll
                for (int kh = 0; kh < 2; ++kh) {
                    if (kh == 0 || hact1) {
#pragma unroll
                        for (int s = 0; s < 2; ++s) {
                            const bf16x8 pf = pack8(st[kh][8 * s], st[kh][8 * s + 1], st[kh][8 * s + 2], st[kh][8 * s + 3], st[kh][8 * s + 4], st[kh][8 * s + 5], st[kh][8 * s + 6], st[kh][8 * s + 7]);
#pragma unroll
                            for (int db = 0; db < 2; ++db) {
                                const LAS unsigned char* vp = Vb + (32 * kh + 16 * s + 4 * hh + ((lane & 15) >> 2)) * 144 + (32 * db + 16 * ((lane >> 4) & 1) + 4 * (lane & 3)) * 2;
                                const s16x4 lo = vtr(vp), hi = vtr(vp + 8 * 144);
                                const bf16x8 vf = (bf16x8){lo[0], lo[1], lo[2], lo[3], hi[0], hi[1], hi[2], hi[3]};
                                O[m][db] = mfma32(vf, pf, O[m][db]); } } } }
            }
        }
        if (kt < kt_hi) { LAS unsigned char* Kb = F.lds + ((kt + 1) & 1) * 9216; LAS unsigned char* Vb = F.lds + 18432 + ((kt + 1) & 1) * 9216;
            if (sch < KCH) *(LAS u32x4*)(Kb + srow * 144 + sch * 16) = kreg;
            *(LAS u32x4*)(Vb + srow * 144 + sch * 16) = vreg; }
        __syncthreads();
    }
    const size_t orow = rowbase + qw0 + r;
    const int ycol = MODE * 256 + h * 64;
    f32x16 o[2];
    if (MODE == 0) { const float i0 = 1.f / l_run[0], i1 = P.lam / l_run[NMAP - 1];
#pragma unroll
        for (int db = 0; db < 2; ++db)
#pragma unroll
            for (int e = 0; e < 16; ++e) o[db][e] = O[0][db][e] * i0 - O[NMAP - 1][db][e] * i1; }
    else if (MODE == 1) { const float i0 = 1.f / l_run[0];
#pragma unroll
        for (int db = 0; db < 2; ++db)
#pragma unroll
            for (int e = 0; e < 16; ++e) o[db][e] = O[0][db][e] * i0; }
    else { o[0] = O[0][0]; o[1] = O[0][1]; }
    float mu = 0.f;
    if (MODE == 2) { float s = 0.f;
#pragma unroll
        for (int db = 0; db < 2; ++db)
#pragma unroll
            for (int e = 0; e < 16; ++e) s += o[db][e];
        s += __shfl_xor(s, 32); mu = s * (1.f / 64.f); }
    float ss = 0.f;
    if (MODE != 1) {
#pragma unroll
        for (int db = 0; db < 2; ++db)
#pragma unroll
            for (int e = 0; e < 16; ++e) { const float d = o[db][e] - mu; ss += d * d; }
        ss += __shfl_xor(ss, 32); }
    float rn = 1.f;
    if (MODE != 1) rn = 1.f / sqrtf(ss * (1.f / 64.f) + LN_EPS);
    if (MODE == 0) rn *= (1.f - P.lam_init);
#pragma unroll
    for (int db = 0; db < 2; ++db)
#pragma unroll
        for (int g4 = 0; g4 < 4; ++g4) { const int d0 = 32 * db + 8 * g4 + 4 * hh; float v[4];
#pragma unroll
            for (int i = 0; i < 4; ++i) v[i] = o[db][4 * g4 + i];
            if (MODE != 1) { const f32x4 nw = *(const f32x4*)(P.nw + (MODE == 2 ? h * 64 : 0) + d0);
#pragma unroll
                for (int i = 0; i < 4; ++i) v[i] = (v[i] - mu) * rn * nw[i]; }
            if (MODE >= 2) { const u32x2 gw = *(const u32x2*)(P.Z + orow * ZW + (MODE == 2 ? ZC_CG : ZC_DG) + h * 64 + d0);
                const float g0 = bflo(gw.x), g1 = bfhi(gw.x), g2 = bflo(gw.y), g3 = bfhi(gw.y);
                v[0] *= g0 * sigmoidf_(g0); v[1] *= g1 * sigmoidf_(g1); v[2] *= g2 * sigmoidf_(g2); v[3] *= g3 * sigmoidf_(g3); }
            u32x2 ow; ow.x = pk2(v[0], v[1]); ow.y = pk2(v[2], v[3]);
            *(u32x2*)(P.Y + orow * DM + ycol + d0) = ow; }
}
}

constexpr int PH_PER_LAYER = 12, N_PHASES = 1 + DEPTH * PH_PER_LAYER;

__global__ void __launch_bounds__(NWAVES * 64, 2) fwd_kernel(Args args) {
    extern __shared__ __attribute__((aligned(16))) unsigned char lds_raw[];
    Frame F;
    F.lds = (LAS unsigned char*)lds_raw;
    F.tid = threadIdx.x; F.lane = F.tid & 63; F.wave = __builtin_amdgcn_readfirstlane(F.tid >> 6);
    F.G = gridDim.x; F.wg = blockIdx.x;
    F.ws = args.ws; F.dob = (unsigned char*)args.out;
    volatile LAS unsigned* MISC = (volatile LAS unsigned*)(F.lds + MISC_OFF);
    if (F.tid < 32) MISC[F.tid] = 0u;
    __syncthreads();
    unsigned* ctl = (unsigned*)(F.ws + WS_CTL);
    XcdBarrier bar; bar.bar = ctl + CW_BAR; bar.x = 0; bar.st = nullptr;
#if MK_ONE_LAUNCH
    bar = xcd_barrier_post(ctl + CW_BAR, MISC + 8);
#endif
    const int lo = args.ph_lo, hi = args.ph_hi;
#ifdef ONLY_SITE
#define SITE(s) ((s) == ONLY_SITE)
#else
#define SITE(s) true
#endif
#define IN(k) (lo <= (k) && (k) < hi)
#if MK_ONE_LAUNCH
#define SEAM(k) do { if ((k) + 1 < hi) xcd_barrier(bar, F.tid == 0); } while (0)
#else
#define SEAM(k) do { } while (0)
#endif
    typedef __attribute__((address_space(4))) const Args* KArgP;
    const int G0 = F.G, wg0 = F.wg;
#define SITE_BEGIN KArgP KA = (KArgP)__builtin_amdgcn_kernarg_segment_ptr(); do { asm volatile("" : "+s"(KA)); \
        int ln_; asm volatile("v_mbcnt_lo_u32_b32 %0, -1, 0\n\tv_mbcnt_hi_u32_b32 %0, -1, %0" : "=v"(ln_)); \
        unsigned tk_ = 0u; if (ln_ == 0) tk_ = __hip_atomic_fetch_add((LAS unsigned*)(F.lds + MISC_OFF + 64), 1u, __ATOMIC_RELAXED, __HIP_MEMORY_SCOPE_WORKGROUP); \
        F.wave = __builtin_amdgcn_readfirstlane((int)(tk_ & 7u)); F.lane = ln_; F.tid = F.wave * 64 + F.lane; \
        F.ws = KA->ws; F.dob = (unsigned char*)KA->out; F.G = G0; F.wg = wg0; asm volatile("" : "+s"(F.G), "+s"(F.wg)); } while (0)

    if (SITE(0) && IN(0)) { SITE_BEGIN; p0_prologue(F, KA); SEAM(0); }

    for (int l = 0; l < DEPTH; ++l) {
        const int pb = 1 + l * PH_PER_LAYER;
        if (SITE(1) && IN(pb + 0)) { SITE_BEGIN; const char* XBc = (const char*)(F.ws + WS_XB); (void)XBc; const unsigned char* w123 = F.ws + WS_W123; const unsigned char* w45 = F.ws + WS_W45 + (size_t)l * W45_STRIDE; (void)w123; (void)w45;
            pg8::SchedPlain S{XBc, (const char*)(w123 + W123_W1), 2048, 2048, 16, 128, 14, F.G, F.wg};
            pg8::EpiStore E{(bf16*)(F.ws + WS_Z), ZW};
            pg8::gemm_phase(F.lds, S, E, F.tid);
            SEAM(pb + 0);
        }
        if (SITE(2) && IN(pb + 1)) { SITE_BEGIN; const char* XBc = (const char*)(F.ws + WS_XB); (void)XBc; const unsigned char* w123 = F.ws + WS_W123; const unsigned char* w45 = F.ws + WS_W45 + (size_t)l * W45_STRIDE; (void)w123; (void)w45;
            if (EXPM != 15) { u32x4* yp = (u32x4*)(F.ws + WS_Y); for (size_t i = (size_t)F.wg * 512 + F.tid; i < (size_t)M * DM / 8; i += (size_t)F.G * 512) yp[i] = (u32x4){0u, 0u, 0u, 0u}; }
            if (EXPM & 2) for (int u = F.wg; u < 512; u += F.G) { const int b = u >> 7, p = u & 127; mx::b1_unit(F, b, 255 - p); mx::b1_unit(F, b, p); }
            if (EXPM & 12) for (int u = F.wg; u < 128; u += F.G) mx::prepkv_unit(F, u, KA->in[6] + (size_t)l * 16 * 128, KA->in[7] + l * 128);
            SEAM(pb + 1);
        }
        if (SITE(3) && IN(pb + 2)) { SITE_BEGIN; const char* XBc = (const char*)(F.ws + WS_XB); (void)XBc; const unsigned char* w123 = F.ws + WS_W123; const unsigned char* w45 = F.ws + WS_W45 + (size_t)l * W45_STRIDE; (void)w123; (void)w45;
            if (EXPM & 12) mx::scan_phase(F);
            float lam_init = 0.8f - 0.6f * __expf(-0.3f * (float)l);
            const float* lp = KA->in[3] + l * 128; float s01 = 0.f, s23 = 0.f;
            for (int i = 0; i < 32; ++i) { s01 += lp[i] * lp[32 + i]; s23 += lp[64 + i] * lp[96 + i]; }
            mx::EngP P{(const bf16*)(F.ws + WS_Z), (bf16*)(F.ws + WS_Y), nullptr, nullptr, KA->in[4] + l * 64, __expf(s01) - __expf(s23) + lam_init, lam_init};
            if (EXPM & 1) for (int u = F.wg; u < 256; u += F.G) { const int b = u >> 6, h = (u >> 4) & 3, pp = u & 15; mx::eng_unit<0>(F, P, b, h, 31 - pp); mx::eng_unit<0>(F, P, b, h, pp); }
            SEAM(pb + 2);
        }
        if (SITE(4) && IN(pb + 3)) { SITE_BEGIN; const char* XBc = (const char*)(F.ws + WS_XB); (void)XBc; const unsigned char* w123 = F.ws + WS_W123; const unsigned char* w45 = F.ws + WS_W45 + (size_t)l * W45_STRIDE; (void)w123; (void)w45;
            {   mx::EngP P{(const bf16*)(F.ws + WS_Z), (bf16*)(F.ws + WS_Y), (const unsigned*)(F.ws + WS_MASK), nullptr, nullptr, 0.f, 0.f};
                if (EXPM & 2) for (int u = F.wg; u < 256; u += F.G) { const int b = u >> 6, h = (u >> 4) & 3, pp = u & 15; mx::eng_unit<1>(F, P, b, h, 31 - pp); mx::eng_unit<1>(F, P, b, h, pp); } }
            {   mx::EngP P{(const bf16*)(F.ws + WS_Z), (bf16*)(F.ws + WS_Y), nullptr, (const float*)(F.ws + WS_KVC), KA->in[5] + l * 256, 0.f, 0.f};
                if (EXPM & 4) for (int u = F.wg; u < 512; u += F.G) mx::eng_unit<2>(F, P, u >> 7, (u >> 5) & 3, u & 31); }
            {   mx::EngP P{(const bf16*)(F.ws + WS_Z), (bf16*)(F.ws + WS_Y), nullptr, (const float*)(F.ws + WS_KVD), KA->in[8] + l * 64, 0.f, 0.f};
                if (EXPM & 8) for (int u = F.wg; u < 512; u += F.G) mx::eng_unit<3>(F, P, u >> 7, (u >> 5) & 3, u & 31); }
            SEAM(pb + 3);
        }
        if (SITE(5) && IN(pb + 4)) { SITE_BEGIN;
            const unsigned char* w123 = F.ws + WS_W123;
            for (int n = 0; n < 4; ++n) {
                {   pg8::SchedPlain S{(const char*)(F.ws + WS_XB), (const char*)(w123 + W123_GB) + (size_t)n * 1024 * 2048, 2048, 2048, 16, 128, 4, F.G, F.wg};
                    pg8::EpiSlotStore E{F.ws + WS_SCR2 + (size_t)F.wg * 262144, 1};
                    pg8::gemm_phase(F.lds, S, E, F.tid); }
                {   pg8::SchedPlain S{(const char*)(F.ws + WS_Y) + n * 512, (const char*)(w123 + W123_GB + 8 * MiB) + (size_t)n * 1024 * 512, 2048, 512, 4, 128, 4, F.G, F.wg};
                    pg8::EpiBranch E{F.ws + WS_SCR2 + (size_t)F.wg * 262144, (bf16*)(F.ws + WS_MERGED), n == 0};
                    pg8::gemm_phase(F.lds, S, E, F.tid); }
            }
            SEAM(pb + 4);
        }
        if (SITE(6) && IN(pb + 5)) { SITE_BEGIN; const char* XBc = (const char*)(F.ws + WS_XB); (void)XBc; const unsigned char* w123 = F.ws + WS_W123; const unsigned char* w45 = F.ws + WS_W45 + (size_t)l * W45_STRIDE; (void)w123; (void)w45;
            pg8::SchedPlain S{(const char*)(F.ws + WS_MERGED), (const char*)(w123 + W123_WO), 2048, 2048, 16, 128, 4, F.G, F.wg};
            pg8::EpiG3 E{(bf16*)(F.ws + WS_XB)};
            pg8::gemm_phase(F.lds, S, E, F.tid);
            SEAM(pb + 5);
        }
        if (SITE(7) && IN(pb + 6)) { SITE_BEGIN; const char* XBc = (const char*)(F.ws + WS_XB); (void)XBc; const unsigned char* w123 = F.ws + WS_W123; const unsigned char* w45 = F.ws + WS_W45 + (size_t)l * W45_STRIDE; (void)w123; (void)w45; ln_phase(F, KA->in[11] + l * DM, KA->in[12] + l * DM, nullptr);
            if (l + 1 < DEPTH) convert_w123(F, KA->in[2] + (size_t)(l + 1) * DM * NIN, KA->in[9] + (size_t)(l + 1) * 4 * 256 * DM, KA->in[10] + (size_t)(l + 1) * DM * DM);
            SEAM(pb + 6); }
        if (SITE(8) && IN(pb + 7)) { SITE_BEGIN; const char* XBc = (const char*)(F.ws + WS_XB); (void)XBc; const unsigned char* w123 = F.ws + WS_W123; const unsigned char* w45 = F.ws + WS_W45 + (size_t)l * W45_STRIDE; (void)w123; (void)w45;
            pg8::SchedPlain S{XBc, (const char*)(w45 + W45_UP), 2048, 2048, 16, 128, 22, F.G, F.wg};
            pg8::EpiStore E{(bf16*)(F.ws + WS_UG), UGW};
            pg8::gemm_phase(F.lds, S, E, F.tid);
            SEAM(pb + 7);
        }
        if (SITE(9) && IN(pb + 8)) { SITE_BEGIN; const char* XBc = (const char*)(F.ws + WS_XB); (void)XBc; const unsigned char* w123 = F.ws + WS_W123; const unsigned char* w45 = F.ws + WS_W45 + (size_t)l * W45_STRIDE; (void)w123; (void)w45; ffn_act_phase(F, KA->in[14] + (size_t)l * 3 * DFF, KA->in[15] + (size_t)l * DFF); SEAM(pb + 8); }
        if (SITE(10) && IN(pb + 9)) { SITE_BEGIN;
            const unsigned char* w45 = F.ws + WS_W45 + (size_t)l * W45_STRIDE;
            {   pg8::SchedPlain S{(const char*)(F.ws + WS_PB + (size_t)l * M * PDIM * 2), (const char*)(w45 + W45_PP), 512, 512, 4, 128, 4, F.G, F.wg};
                pg8::EpiSlotStore E{F.dob + DO_SCR5 + (size_t)F.wg * 262144, 0};
                pg8::gemm_phase(F.lds, S, E, F.tid); }
            {   pg8::SchedPlain S{(const char*)(F.ws + WS_XB), (const char*)(w45 + W45_PG), 2048, 2048, 16, 128, 4, F.G, F.wg};
                pg8::EpiSlotMul E{F.dob + DO_SCR5 + (size_t)F.wg * 262144};
                pg8::gemm_phase(F.lds, S, E, F.tid); }
            SEAM(pb + 9);
        }
        if (SITE(11) && IN(pb + 10)) { SITE_BEGIN;
            const unsigned char* w45 = F.ws + WS_W45 + (size_t)l * W45_STRIDE;
            pg8::SchedG5b S{(const char*)(F.ws + WS_UG), (const char*)(w45 + W45_DN), F.G, F.wg};
            pg8::EpiG5b E{F.dob + DO_SCR5 + (size_t)F.wg * 262144, (bf16*)(F.ws + WS_XB)};
            pg8::gemm_phase(F.lds, S, E, F.tid);
            SEAM(pb + 10);
        }
        if (SITE(12) && IN(pb + 11)) { SITE_BEGIN; const char* XBc = (const char*)(F.ws + WS_XB); (void)XBc; const unsigned char* w123 = F.ws + WS_W123; const unsigned char* w45 = F.ws + WS_W45 + (size_t)l * W45_STRIDE; (void)w123; (void)w45; ln_phase(F, KA->in[19] + l * DM, KA->in[20] + l * DM, l == DEPTH - 1 ? KA->out : nullptr); SEAM(pb + 11); }
    }
#undef IN
#undef SEAM
}

extern "C" void kernel_launch(void* const* d_in, const int* in_sizes, int n_in, void* d_out, int out_size, void* d_ws, size_t ws_size, hipStream_t stream) {
    static int grid = 0;
    if (grid == 0) {
        if (n_in != 21 || out_size != M * DM || ws_size < WS_END) { fprintf(stderr, "kernel_launch: unexpected shapes (n_in %d out %d ws %zu)\n", n_in, out_size, ws_size); grid = -1; return; }
        int dev = 0, cus = 0, per_cu = 0;
        if (hipGetDevice(&dev) != hipSuccess || hipDeviceGetAttribute(&cus, hipDeviceAttributeMultiprocessorCount, dev) != hipSuccess) { grid = -1; return; }
        if (hipFuncSetAttribute((const void*)fwd_kernel, hipFuncAttributeMaxDynamicSharedMemorySize, LDS_BYTES) != hipSuccess) { grid = -1; return; }
        if (hipOccupancyMaxActiveBlocksPerMultiprocessor(&per_cu, (const void*)fwd_kernel, NWAVES * 64, LDS_BYTES) != hipSuccess || per_cu < 1)
            fprintf(stderr, "kernel_launch: occupancy query reports %d\n", per_cu);
        (void)hipGetLastError();
        grid = cus;
    }
    if (grid < 0) return;
    (void)hipMemsetAsync((char*)d_ws + WS_CTL, 0, CTL_ZERO_BYTES, stream);
    Args a{};
    for (int i = 0; i < 21; ++i) a.in[i] = (const float*)d_in[i];
    a.out = (float*)d_out; a.ws = (unsigned char*)d_ws;
#if MK_ONE_LAUNCH
    a.ph_lo = 0; a.ph_hi = N_PHASES;
    hipLaunchKernelGGL(fwd_kernel, dim3(grid), dim3(NWAVES * 64), LDS_BYTES, stream, a);
#else
    for (int p = 0; p < N_PHASES; ++p) { a.ph_lo = p; a.ph_hi = p + 1; hipLaunchKernelGGL(fwd_kernel, dim3(grid), dim3(NWAVES * 64), LDS_BYTES, stream, a); }
#endif
}
```

```cpp
#include <hip/hip_runtime.h>
#include <cstdio>
#include <cstdint>

#ifndef EXP
#define EXP 0
#endif
#ifndef EXPM
#define EXPM 15
#endif
#ifndef MK_ONE_LAUNCH
#define MK_ONE_LAUNCH 1
#endif

#define GAS __attribute__((address_space(1)))
#define LAS __attribute__((address_space(3)))
typedef unsigned short bf16;
typedef unsigned u32x4 __attribute__((ext_vector_type(4)));
typedef unsigned u32x2 __attribute__((ext_vector_type(2)));
typedef float f32x2 __attribute__((ext_vector_type(2)));
typedef float f32x4 __attribute__((ext_vector_type(4)));
typedef float f32x16 __attribute__((ext_vector_type(16)));
typedef short bf16x8 __attribute__((ext_vector_type(8)));
typedef short s16x4 __attribute__((ext_vector_type(4)));
typedef GAS unsigned gu32;

constexpr int BATCH = 4, SEQ = 8192, DM = 1024, M = BATCH * SEQ, DEPTH = 2;
constexpr int NIN = 7604, ZW = 3584, DFF = 2816, UGW = 5632, PDIM = 256;
constexpr float LN_EPS = 1e-5f;
constexpr float ALPHA = 1.41421356237f;
constexpr float LOG2E = 1.4426950408889634f;
constexpr int ZC_AQ = 0, ZC_AK = 256, ZC_AV = 512, ZC_BQ = 768, ZC_BK = 1024, ZC_BV = 1280, ZC_CQ = 1536, ZC_CK = 1792, ZC_CV = 2048, ZC_CG = 2304,
              ZC_DQ = 2560, ZC_DK = 2688, ZC_DV = 2816, ZC_DG = 3072, ZC_IQ = 3328, ZC_IK = 3456, ZC_IW = 3488, ZC_DA = 3504;
constexpr int SRC_MG = 3508;

constexpr size_t MiB = 1u << 20;
constexpr size_t WS_CTL = 0, CTL_ZERO_BYTES = 1 * MiB;
constexpr size_t WS_XB = 1 * MiB;
constexpr size_t WS_BIG = 65 * MiB;
constexpr size_t WS_Z = WS_BIG, WS_Y = WS_BIG + 224 * MiB, WS_MERGED = WS_BIG + 288 * MiB, WS_UG = WS_BIG;
constexpr size_t WS_MASK = WS_MERGED, WS_KVC = WS_MERGED + 32 * MiB, WS_KVD = WS_MERGED + 40 * MiB, WS_DE = WS_MERGED + 56 * MiB;
constexpr size_t WS_SCR2 = WS_Z;
constexpr size_t WS_W45 = 417 * MiB, W45_STRIDE = 19 * MiB;
constexpr size_t W45_UP = 0, W45_PG = 11 * MiB, W45_PP = 13 * MiB, W45_DN = 13 * MiB + 512 * 1024;
constexpr size_t WS_PB = 455 * MiB;
constexpr size_t WS_W123 = 487 * MiB;
constexpr size_t WS_END = 506 * MiB;
constexpr size_t W123_W1 = 0, W123_GB = 7 * MiB, W123_WO = 17 * MiB;
constexpr size_t DO_SCR5 = 0;

constexpr int CW_BAR = 4096, CW_WQ = 8448  , CW_KMAX = 8192;

constexpr int RING_BYTES = 131072;
constexpr int MISC_OFF = 131072 + 320;
constexpr int QST_OFF = 132096;
constexpr int LDS_BYTES = 147456;

constexpr int NWAVES = 8;

#define RLX_AGENT __ATOMIC_RELAXED, __HIP_MEMORY_SCOPE_AGENT
__device__ __forceinline__ unsigned f2bf(float f) { unsigned u = __builtin_bit_cast(unsigned, f); return (u + 0x7fffu + ((u >> 16) & 1u)) >> 16; }
typedef __bf16 bf16x2_t __attribute__((ext_vector_type(2)));
__device__ __forceinline__ unsigned pk2(float lo, float hi) { const f32x2 v = {lo, hi}; const bf16x2_t b = __builtin_convertvector(v, bf16x2_t); return __builtin_bit_cast(unsigned, b); }
__device__ __forceinline__ float bflo(unsigned w) { return __uint_as_float(w << 16); }
__device__ __forceinline__ float bfhi(unsigned w) { return __uint_as_float(w & 0xffff0000u); }
__device__ __forceinline__ float bf1(bf16 b) { return __uint_as_float((unsigned)b << 16); }
__device__ __forceinline__ float sigmoidf_(float x) { return __builtin_amdgcn_rcpf(1.0f + __builtin_amdgcn_exp2f(-LOG2E * x)); }
__device__ __forceinline__ float shx(float v, int lane, int m) { return __int_as_float(__builtin_amdgcn_ds_bpermute((lane ^ m) << 2, __float_as_int(v))); }
__device__ __forceinline__ unsigned shup(unsigned v, int lane, int o) { return (unsigned)__builtin_amdgcn_ds_bpermute((lane - o) << 2, (int)v); }
__device__ __forceinline__ float wave_sum(float v, int lane) {
#pragma unroll
    for (int o = 1; o < 64; o <<= 1) v += shx(v, lane, o);
    return v;
}

#define XB_TMO      128
#define XB_XCNT(j)  (256  + 64 * (j))
#define XB_XSUB(j)  (1280 + 64 * (j))
#define XB_XGEN(j)  (2304 + 64 * (j))
#define XB_TOP      3328
#define XB_TOPGEN   3392
#define XCD_BAR_WORDS 3456
#define XB_SPIN_CAP (1u << 22)

__device__ __forceinline__ unsigned xb_ld(unsigned* p)              { return __hip_atomic_load(p, __ATOMIC_RELAXED, __HIP_MEMORY_SCOPE_AGENT); }
__device__ __forceinline__ unsigned xb_add(unsigned* p, unsigned v) { return __hip_atomic_fetch_add(p, v, __ATOMIC_RELAXED, __HIP_MEMORY_SCOPE_AGENT); }
__device__ __forceinline__ unsigned xb_xcc_id() { return (unsigned)__builtin_amdgcn_s_getreg((3 << 11) | 20) & 0xFu; }
#define XB_SPIN(cond, bar) do { unsigned _sp = 0; while (cond) { __builtin_amdgcn_s_sleep(1); \
    if ((++_sp & 255u) == 0u) { if (xb_ld(&(bar)[XB_TMO])) break; if (_sp > XB_SPIN_CAP) { atomicAdd(&(bar)[XB_TMO], 1u); break; } } } } while (0)

struct XcdBarrier { unsigned* bar; unsigned x; volatile LAS unsigned* st; };

__device__ __forceinline__ XcdBarrier xcd_barrier_post(unsigned* bar, volatile LAS unsigned* st) {
    XcdBarrier b; b.bar = bar; b.x = xb_xcc_id(); b.st = st;
    if (threadIdx.x == 0) (void)xb_add(&bar[XB_XCNT(b.x)], 1u);
    return b;
}
__device__ __forceinline__ void xcd_barrier_complete(unsigned* bar, unsigned x, unsigned& nloc, unsigned& nx) {
    const unsigned G = gridDim.x * gridDim.y * gridDim.z;
    unsigned sum, cnt, mine, sp = 0u;
    for (;;) {
        sum = 0u; cnt = 0u; mine = 0u;
#pragma unroll
        for (unsigned j = 0; j < 16; ++j) { const unsigned c = xb_ld(&bar[XB_XCNT(j)]); sum += c; cnt += (c > 0u) ? 1u : 0u; mine = (j == x) ? c : mine; }
        if (sum == G) break;
        __builtin_amdgcn_s_sleep(1);
        if ((++sp & 255u) == 0u) { if (xb_ld(&bar[XB_TMO])) break; if (sp > XB_SPIN_CAP) { atomicAdd(&bar[XB_TMO], 1u); break; } }
    }
    nloc = mine > 0u ? mine : 1u; nx = cnt > 0u ? cnt : 1u;
}
__device__ __forceinline__ void xcd_barrier(const XcdBarrier& b, const bool leader_thread) {
    asm volatile("s_waitcnt vmcnt(0)" ::: "memory");
    __syncthreads();
    if (leader_thread) {
        unsigned* bar = b.bar;
        __builtin_amdgcn_s_waitcnt(0);
        unsigned nloc = b.st[0], nx = b.st[1];
        if (nloc == 0u) { xcd_barrier_complete(bar, b.x, nloc, nx); b.st[0] = nloc; b.st[1] = nx; }
        const unsigned old = xb_add(&bar[XB_XSUB(b.x)], 1u);
        const unsigned gen = old / nloc;
        if (old + 1u == (gen + 1u) * nloc) {
            __builtin_amdgcn_fence(__ATOMIC_RELEASE, "agent");
            asm volatile("s_waitcnt vmcnt(0)" ::: "memory");
            const unsigned og = xb_add(&bar[XB_TOP], 1u);
            const unsigned tg = og / nx;
            if (og + 1u == (tg + 1u) * nx) xb_add(&bar[XB_TOPGEN], 1u);
            else XB_SPIN(xb_ld(&bar[XB_TOPGEN]) == tg, bar);
            __builtin_amdgcn_fence(__ATOMIC_ACQUIRE, "agent");
            xb_add(&bar[XB_XGEN(b.x)], 1u);
            asm volatile("s_waitcnt vmcnt(0)" ::: "memory");
        } else {
            XB_SPIN(xb_ld(&bar[XB_XGEN(b.x)]) == gen, bar);
            __builtin_amdgcn_fence(__ATOMIC_ACQUIRE, "agent");
            asm volatile("s_waitcnt vmcnt(0)" ::: "memory");
        }
    }
    __syncthreads();
}

namespace pg8 {
constexpr int BM = 256, BK = 64, HALF = 128, HTB = HALF * BK * 2, STAGE_BYTES = 8 * HTB, NXCD = 8, WGM = 8;
__device__ __forceinline__ int lds_byte(int r, int c) { const int st = (r >> 4) * 2 + (c >> 5), rr = r & 15, cc = c & 31, ob = rr * 64 + cc * 2; return st * 1024 + (ob ^ (((ob >> 9) & 1) << 5)); }
__device__ __forceinline__ void stage_rc(int b, int& R, int& C) { const int st = b / 1024, sb = b % 1024, swz = sb ^ (((sb >> 9) & 1) << 5); R = (st >> 1) * 16 + swz / 64; C = (st & 1) * 32 + (swz % 64) / 2; }
__device__ __forceinline__ int perm32(int rho) { const int n = rho >> 4, i = rho & 15; return 8 * (i >> 2) + 4 * n + (i & 3); }

struct UnitD { const char* A; const char* B; int lda2, ldb2, nt, pm, pn, kind; };

__device__ __forceinline__ void tile_map(int L, int nM, int nN, int& pm, int& pn) {
    const int nwg = nM * nN; int wgid = L;
    { const int q = nwg / NXCD, r = nwg % NXCD, xcd = wgid % NXCD, off = wgid / NXCD; wgid = (xcd < r ? xcd * (q + 1) : r * (q + 1) + (xcd - r) * q) + off; }
    const int nig = WGM * nN, gid = wgid / nig, fm = gid * WGM, gsz = (nM - fm) < WGM ? (nM - fm) : WGM;
    pm = fm + ((wgid % nig) % gsz); pn = (wgid % nig) / gsz;
}

template <class Epi, class Sched>
__device__ __forceinline__ void gemm_phase(LAS unsigned char* lds, const Sched& S, const Epi& E, const int tid) {
    const int wid = __builtin_amdgcn_readfirstlane(tid >> 6), lane = tid & 63, wr = wid >> 2, wc = wid & 3, fr = lane & 15, fq = lane >> 4;
    int sR, sRb, sC2;
    { int R, C; stage_rc(tid * 16, R, C); sR = R; sRb = (R & ~31) + perm32(R & 31); sC2 = C * 2; }
    const size_t kstep = (size_t)(BK * 2);
    const unsigned ldsw = (unsigned)wid * 1024u;
    const int aoff = lds_byte(wr * 64 + fr, fq * 8), boff = lds_byte(wc * 32 + fr, fq * 8);
#define PG8_SA(b, h) (((b) * 2 + (h)) * HTB)
#define PG8_SB(b, h) ((4 + (b) * 2 + (h)) * HTB)
#define PG8_STAGE(bufoff, gbase, rows, pitch) do { const unsigned _o = (unsigned)((rows) * (pitch) + sC2); _Pragma("unroll") for (int _i = 0; _i < 2; ++_i) \
        __builtin_amdgcn_global_load_lds((const unsigned*)((const char*)(gbase) + (size_t)(_i * 64) * (pitch) + _o), (LAS unsigned*)(lds + (bufoff) + ldsw + _i * 8192), 16, 0, 0); } while (0)
#define PG8_LDA(dst, b, h) do { _Pragma("unroll") for (int m = 0; m < 4; ++m) _Pragma("unroll") for (int k = 0; k < 2; ++k) dst[m][k] = *(const LAS bf16x8*)(lds + PG8_SA(b, h) + aoff + m * 2048 + k * 1024); } while (0)
#define PG8_LDB(dst, b, h) do { _Pragma("unroll") for (int n = 0; n < 2; ++n) _Pragma("unroll") for (int k = 0; k < 2; ++k) dst[n][k] = *(const LAS bf16x8*)(lds + PG8_SB(b, h) + boff + n * 2048 + k * 1024); } while (0)
#define PG8_MMA(ai, bj, At, Bt) do { __builtin_amdgcn_s_setprio(1); _Pragma("unroll") for (int m = 0; m < 4; ++m) _Pragma("unroll") for (int n = 0; n < 2; ++n) _Pragma("unroll") for (int k = 0; k < 2; ++k) \
        acc[ai][bj][m][n] = __builtin_amdgcn_mfma_f32_16x16x32_bf16(Bt[n][k], At[m][k], acc[ai][bj][m][n], 0, 0, 0); __builtin_amdgcn_s_setprio(0); } while (0)
#define PG8_WAIT_V(n) asm volatile("s_waitcnt vmcnt(" #n ")" ::: "memory")
#define PG8_WAIT_L(n) asm volatile("s_waitcnt lgkmcnt(" #n ")" ::: "memory")
#define PG8_BAR __builtin_amdgcn_s_barrier()
#define PG8_SCHED __builtin_amdgcn_sched_barrier(0)
    UnitD cur, nxt; int ui = 0;
    if (!S.next(0, cur)) return;
    f32x4 acc[2][2][4][2];
#pragma unroll
    for (int a = 0; a < 2; ++a)
#pragma unroll
        for (int b = 0; b < 2; ++b)
#pragma unroll
            for (int m = 0; m < 4; ++m)
#pragma unroll
                for (int n = 0; n < 2; ++n) acc[a][b][m][n] = (f32x4){0.f, 0.f, 0.f, 0.f};
    bf16x8 At[4][2], B0[2][2], B1[2][2];
    const char* cA = cur.A; const char* cB = cur.B;
    int pA = cur.lda2, pB = cur.ldb2;
    PG8_STAGE(PG8_SB(0, 0), cB, sRb, pB); PG8_STAGE(PG8_SB(0, 1), cB + (size_t)HALF * pB, sRb, pB); PG8_STAGE(PG8_SA(0, 0), cA, sR, pA); PG8_STAGE(PG8_SA(0, 1), cA + (size_t)HALF * pA, sR, pA);
    if (wr == 1) PG8_BAR;
    PG8_WAIT_V(2); PG8_BAR;
    PG8_STAGE(PG8_SB(1, 0), cB + kstep, sRb, pB); PG8_STAGE(PG8_SA(1, 0), cA + kstep, sR, pA); PG8_STAGE(PG8_SB(1, 1), cB + (size_t)HALF * pB + kstep, sRb, pB);
    PG8_WAIT_V(6); PG8_BAR;
    for (;;) {
        const bool has_next = S.next(ui + 1, nxt);
        if (!has_next) nxt = cur;
        const char* nA = nxt.A; const char* nB = nxt.B;
        const int nt = cur.nt;
        for (int t = 0; t < nt; t += 2) {
            const bool last = (t == nt - 2);
            const char* a1 = cA + (size_t)(t + 1) * kstep + (size_t)HALF * pA;
            const char* a2 = last ? nA : cA + (size_t)(t + 2) * kstep; const char* b2 = last ? nB : cB + (size_t)(t + 2) * kstep;
            const int p2A = last ? nxt.lda2 : pA, p2B = last ? nxt.ldb2 : pB;
            const char* a2h = a2 + (size_t)HALF * p2A; const char* b2h = b2 + (size_t)HALF * p2B;
            PG8_LDB(B0, 0, 0); PG8_LDB(B1, 0, 1); PG8_SCHED; PG8_LDA(At, 0, 0); PG8_STAGE(PG8_SA(1, 1), a1, sR, pA);
            PG8_WAIT_V(8); PG8_WAIT_L(0); PG8_BAR; PG8_MMA(0, 0, At, B0); PG8_MMA(0, 1, At, B1); PG8_BAR; PG8_SCHED;
            PG8_LDA(At, 0, 1); PG8_STAGE(PG8_SB(0, 0), b2, sRb, p2B); PG8_STAGE(PG8_SB(0, 1), b2h, sRb, p2B); PG8_STAGE(PG8_SA(0, 0), a2, sR, p2A);
            PG8_WAIT_V(8); PG8_WAIT_L(0); PG8_BAR; PG8_MMA(1, 0, At, B0); PG8_MMA(1, 1, At, B1); PG8_BAR; PG8_SCHED;
            PG8_LDB(B0, 1, 0); PG8_LDB(B1, 1, 1); PG8_SCHED; PG8_LDA(At, 1, 0); PG8_STAGE(PG8_SA(0, 1), a2h, sR, p2A);
            PG8_WAIT_V(8); PG8_WAIT_L(0); PG8_BAR; PG8_MMA(0, 0, At, B0); PG8_MMA(0, 1, At, B1); PG8_BAR; PG8_SCHED;
            PG8_LDA(At, 1, 1); PG8_STAGE(PG8_SB(1, 0), b2 + kstep, sRb, p2B); PG8_STAGE(PG8_SB(1, 1), b2h + kstep, sRb, p2B); PG8_STAGE(PG8_SA(1, 0), a2 + kstep, sR, p2A);
            PG8_WAIT_V(8); PG8_WAIT_L(0); PG8_BAR; PG8_MMA(1, 0, At, B0); PG8_MMA(1, 1, At, B1); PG8_BAR; PG8_SCHED;
        }
        if (wr == 0) PG8_BAR;
        { int l2; asm volatile("v_mbcnt_lo_u32_b32 %0, -1, 0\n\tv_mbcnt_hi_u32_b32 %0, -1, %0" : "=v"(l2)); E(acc, cur, wr, wc, l2 & 15, l2 >> 4, wid * 64 + l2); asm volatile("s_waitcnt vmcnt(0)" ::: "memory"); }
        if (!has_next) break;
#pragma unroll
        for (int a = 0; a < 2; ++a)
#pragma unroll
            for (int b = 0; b < 2; ++b)
#pragma unroll
                for (int m = 0; m < 4; ++m)
#pragma unroll
                    for (int n = 0; n < 2; ++n) acc[a][b][m][n] = (f32x4){0.f, 0.f, 0.f, 0.f};
        cur = nxt; cA = nA; cB = nB; pA = cur.lda2; pB = cur.ldb2;
        ++ui;
        if (wr == 1) PG8_BAR;
    }
    PG8_WAIT_V(0);
    PG8_BAR;
#undef PG8_SA
#undef PG8_SB
#undef PG8_STAGE
#undef PG8_LDA
#undef PG8_LDB
#undef PG8_MMA
#undef PG8_WAIT_V
#undef PG8_WAIT_L
#undef PG8_BAR
#undef PG8_SCHED
}

struct SchedPlain {
    const char* A; const char* B; int lda2, ldb2, nt, nM, nN, G, c;
    __device__ __forceinline__ bool next(int i, UnitD& u) const {
        const long L = (long)i * G + c; if (L >= (long)nM * nN) return false;
        int pm, pn; tile_map((int)L, nM, nN, pm, pn);
        u.A = A + (size_t)pm * 256 * lda2; u.B = B + (size_t)pn * 256 * ldb2; u.lda2 = lda2; u.ldb2 = ldb2; u.nt = nt; u.pm = pm; u.pn = pn; u.kind = i; return true;
    }
};
struct SchedG5b {
    const char* A; const char* B; int G, c;
    __device__ __forceinline__ bool next(int i, UnitD& u) const {
        const long L = (long)i * G + c; if (L >= 128 * 4) return false;
        int pm, pn; tile_map((int)L, 128, 4, pm, pn);
        u.A = A + (size_t)pm * 256 * (UGW * 2); u.lda2 = UGW * 2; u.B = B + (size_t)pn * 256 * (DFF * 2); u.ldb2 = DFF * 2; u.nt = 44; u.pm = pm; u.pn = pn; u.kind = i; return true;
    }
};

#define EPI_LOOP for (int ai = 0; ai < 2; ++ai) _Pragma("unroll") for (int m = 0; m < 4; ++m) _Pragma("unroll") for (int bj = 0; bj < 2; ++bj)
struct EpiStore {
    bf16* O; int ldc;
    __device__ __forceinline__ void operator()(const f32x4 (&acc)[2][2][4][2], const UnitD& u, int wr, int wc, int fr, int fq, int tid) const {
        const int row0 = u.pm * BM + wr * 64 + fr, col0 = u.pn * BM + wc * 32 + 8 * fq;
#pragma unroll
        EPI_LOOP { const f32x4 v0 = acc[ai][bj][m][0], v1 = acc[ai][bj][m][1];
            u32x4 w; w.x = pk2(v0[0], v0[1]); w.y = pk2(v0[2], v0[3]); w.z = pk2(v1[0], v1[1]); w.w = pk2(v1[2], v1[3]);
            *(u32x4*)(O + (size_t)(row0 + ai * HALF + m * 16) * ldc + col0 + bj * HALF) = w; }
    }
};
struct EpiSlotStore {
    unsigned char* sc_; int act;
    __device__ __forceinline__ void operator()(const f32x4 (&acc)[2][2][4][2], const UnitD& u, int wr, int wc, int fr, int fq, int tid) const {
        unsigned loff = (unsigned)tid * 16u; asm volatile("" : "+v"(loff));
        unsigned char* sc = sc_ + (size_t)u.kind * 131072 + loff;
#pragma unroll
        EPI_LOOP { const int q = (ai * 2 + bj) * 4 + m; f32x4 v0 = acc[ai][bj][m][0], v1 = acc[ai][bj][m][1];
            if (act) { v0 = (f32x4){sigmoidf_(v0[0]), sigmoidf_(v0[1]), sigmoidf_(v0[2]), sigmoidf_(v0[3])}; v1 = (f32x4){sigmoidf_(v1[0]), sigmoidf_(v1[1]), sigmoidf_(v1[2]), sigmoidf_(v1[3])}; }
            u32x4 w; w.x = pk2(v0[0], v0[1]); w.y = pk2(v0[2], v0[3]); w.z = pk2(v1[0], v1[1]); w.w = pk2(v1[2], v1[3]);
            *(u32x4*)(sc + (size_t)q * 8192) = w; }
    }
};
struct EpiSlotMul {
    unsigned char* sc_;
    __device__ __forceinline__ void operator()(const f32x4 (&acc)[2][2][4][2], const UnitD& u, int wr, int wc, int fr, int fq, int tid) const {
        unsigned loff = (unsigned)tid * 16u; asm volatile("" : "+v"(loff));
        unsigned char* sc = sc_ + (size_t)u.kind * 131072 + loff;
#pragma unroll
        EPI_LOOP { const int q = (ai * 2 + bj) * 4 + m; const f32x4 v0 = acc[ai][bj][m][0], v1 = acc[ai][bj][m][1];
            u32x4* sp = (u32x4*)(sc + (size_t)q * 8192); const u32x4 p = *sp;
            u32x4 w; w.x = pk2(sigmoidf_(v0[0]) * bflo(p.x), sigmoidf_(v0[1]) * bfhi(p.x)); w.y = pk2(sigmoidf_(v0[2]) * bflo(p.y), sigmoidf_(v0[3]) * bfhi(p.y));
            w.z = pk2(sigmoidf_(v1[0]) * bflo(p.z), sigmoidf_(v1[1]) * bfhi(p.z)); w.w = pk2(sigmoidf_(v1[2]) * bflo(p.w), sigmoidf_(v1[3]) * bfhi(p.w));
            *sp = w;
            if (m & 1) asm volatile("" ::: "memory"); }
    }
};
struct EpiBranch {
    const unsigned char* sc_; bf16* MG; int first;
    __device__ __forceinline__ void operator()(const f32x4 (&acc)[2][2][4][2], const UnitD& u, int wr, int wc, int fr, int fq, int tid) const {
        const int row0 = u.pm * BM + wr * 64 + fr, col0 = u.pn * BM + wc * 32 + 8 * fq;
        unsigned loff = (unsigned)tid * 16u; asm volatile("" : "+v"(loff));
        const unsigned char* sc = sc_ + (size_t)u.kind * 131072 + loff;
#pragma unroll
        EPI_LOOP { const int q = (ai * 2 + bj) * 4 + m; const f32x4 v0 = acc[ai][bj][m][0], v1 = acc[ai][bj][m][1];
            const u32x4 g = *(const u32x4*)(sc + (size_t)q * 8192);
            u32x4* p = (u32x4*)(MG + (size_t)(row0 + ai * HALF + m * 16) * DM + col0 + bj * HALF);
            f32x4 t0 = (f32x4){bflo(g.x) * v0[0], bfhi(g.x) * v0[1], bflo(g.y) * v0[2], bfhi(g.y) * v0[3]};
            f32x4 t1 = (f32x4){bflo(g.z) * v1[0], bfhi(g.z) * v1[1], bflo(g.w) * v1[2], bfhi(g.w) * v1[3]};
            if (!first) { const u32x4 x = *p; t0 += (f32x4){bflo(x.x), bfhi(x.x), bflo(x.y), bfhi(x.y)}; t1 += (f32x4){bflo(x.z), bfhi(x.z), bflo(x.w), bfhi(x.w)}; }
            u32x4 w; w.x = pk2(t0[0], t0[1]); w.y = pk2(t0[2], t0[3]); w.z = pk2(t1[0], t1[1]); w.w = pk2(t1[2], t1[3]);
            *p = w;
            if (m & 1) asm volatile("" ::: "memory"); }
    }
};
struct EpiG3 {
    bf16* XB;
    __device__ __forceinline__ void operator()(const f32x4 (&acc)[2][2][4][2], const UnitD& u, int wr, int wc, int fr, int fq, int tid) const {
        const int row0 = u.pm * BM + wr * 64 + fr, col0 = u.pn * BM + wc * 32 + 8 * fq;
#pragma unroll
        EPI_LOOP { const f32x4 v0 = acc[ai][bj][m][0], v1 = acc[ai][bj][m][1];
            u32x4* p = (u32x4*)(XB + (size_t)(row0 + ai * HALF + m * 16) * DM + col0 + bj * HALF); const u32x4 x = *p;
            u32x4 w; w.x = pk2(ALPHA * bflo(x.x) + v0[0], ALPHA * bfhi(x.x) + v0[1]); w.y = pk2(ALPHA * bflo(x.y) + v0[2], ALPHA * bfhi(x.y) + v0[3]);
            w.z = pk2(ALPHA * bflo(x.z) + v1[0], ALPHA * bfhi(x.z) + v1[1]); w.w = pk2(ALPHA * bflo(x.w) + v1[2], ALPHA * bfhi(x.w) + v1[3]);
            *p = w; }
    }
};
struct EpiG5b {
    const unsigned char* esc_; bf16* XB;
    __device__ __forceinline__ void operator()(const f32x4 (&acc)[2][2][4][2], const UnitD& u, int wr, int wc, int fr, int fq, int tid) const {
        const int row0 = u.pm * BM + wr * 64 + fr, col0 = u.pn * BM + wc * 32 + 8 * fq;
        unsigned loff = (unsigned)tid * 16u; asm volatile("" : "+v"(loff));
        const unsigned char* esc = esc_ + (size_t)u.kind * 131072 + loff;
#pragma unroll
        EPI_LOOP { const int q = (ai * 2 + bj) * 4 + m; const f32x4 v0 = acc[ai][bj][m][0], v1 = acc[ai][bj][m][1];
            const u32x4 e = *(const u32x4*)(esc + (size_t)q * 8192);
            u32x4* p = (u32x4*)(XB + (size_t)(row0 + ai * HALF + m * 16) * DM + col0 + bj * HALF); const u32x4 x = *p;
            u32x4 w; w.x = pk2(ALPHA * bflo(x.x) + v0[0] + bflo(e.x), ALPHA * bfhi(x.x) + v0[1] + bfhi(e.x)); w.y = pk2(ALPHA * bflo(x.y) + v0[2] + bflo(e.y), ALPHA * bfhi(x.y) + v0[3] + bfhi(e.y));
            w.z = pk2(ALPHA * bflo(x.z) + v1[0] + bflo(e.z), ALPHA * bfhi(x.z) + v1[1] + bfhi(e.z)); w.w = pk2(ALPHA * bflo(x.w) + v1[2] + bflo(e.w), ALPHA * bfhi(x.w) + v1[3] + bfhi(e.w));
            *p = w;
            if (m & 1) asm volatile("" ::: "memory"); }
    }
};
}

struct Frame {
    LAS unsigned char* lds;
    int tid, lane, wave, G, wg;
    unsigned char* ws; unsigned char* dob;
};
struct Args { const float* in[21]; float* out; unsigned char* ws; int ph_lo, ph_hi; };

__device__ __forceinline__ int z_src(int n, float& sc) {
    sc = 1.f;
    if (n < 768) { if (n < 256) sc = 0.17677669529663687f * LOG2E; return n; }
    if (n < 1536) { if (n < 1024) sc = 0.125f * LOG2E; return n; }
    if (n < 2560) { if (n >= 1792 && n < 2048) sc = 0.125f; return 1700 + (n - 1536); }
    if (n < 2816) { if (n < 2688) sc = 0.17677669529663687f; return 2724 + (n - 2560); }
    if (n < 3072) return 2980 + (n - 2816);
    if (n < 3328) return 3252 + (n - 3072);
    if (n < 3456) return 1536 + (n - 3328);
    if (n < 3488) return 1664 + (n - 3456);
    if (n < 3492) return 1696 + (n - 3488);
    if (n >= 3504 && n < 3520) return 3236 + (n - 3504);
    return -1;
}
template <int MODE>
__device__ __forceinline__ void transpose_item(const float* W, int Nsrc, int soff, bf16* WT, int dpitch, int dcol0, int k0, int n0, LAS float* scr, int lane) {
    const int nn = lane & 31; float sc = 1.f; int s;
    if (MODE == 1) s = z_src(n0 + nn, sc); else s = soff + n0 + nn;
#pragma unroll 8
    for (int i = 0; i < 32; ++i) { const int kk = 2 * i + (lane >> 5); scr[kk * 33 + nn] = (s >= 0) ? W[(size_t)(k0 + kk) * Nsrc + s] * sc : 0.f; }
    asm volatile("s_waitcnt lgkmcnt(0)" ::: "memory");
    const int c = lane & 7;
#pragma unroll
    for (int j = 0; j < 4; ++j) { const int n = (lane >> 3) + 8 * j; const LAS float* sp = scr + (8 * c) * 33 + n;
        u32x4 o; o.x = pk2(sp[0 * 33], sp[1 * 33]); o.y = pk2(sp[2 * 33], sp[3 * 33]); o.z = pk2(sp[4 * 33], sp[5 * 33]); o.w = pk2(sp[6 * 33], sp[7 * 33]);
        *(u32x4*)(WT + (size_t)(n0 + n) * dpitch + dcol0 + k0 + 8 * c) = o; }
    asm volatile("s_waitcnt lgkmcnt(0)" ::: "memory");
}
typedef __attribute__((address_space(4))) const struct Args* KArgPtr;
__device__ __forceinline__ void convert_w123(Frame& F, const float* w_in, const float* w_branch, const float* w_out) {
    LAS float* scr = (LAS float*)(F.lds + F.wave * 16384);
    const int gw = F.wg * NWAVES + F.wave, NGW = F.G * NWAVES;
    constexpr int I1 = 16 * 112, I2 = 16 * 128, I3 = 4 * 128, I4 = 16 * 32;
    unsigned char* w123 = F.ws + WS_W123;
    for (int it = gw; it < I1 + I2 + I3 + I4; it += NGW) {
        int r = it;
        if (r < I1) { transpose_item<1>(w_in, NIN, 0, (bf16*)(w123 + W123_W1), 1024, 0, 64 * (r / 112), 32 * (r % 112), scr, F.lane); continue; } r -= I1;
        if (r < I2) { transpose_item<0>(w_in, NIN, SRC_MG, (bf16*)(w123 + W123_GB), 1024, 0, 64 * (r / 128), 32 * (r % 128), scr, F.lane); continue; } r -= I2;
        if (r < I3) { const int n = r / 128, rr = r % 128; transpose_item<0>(w_branch + (size_t)n * 256 * DM, DM, 0, (bf16*)(w123 + W123_GB + 8 * MiB) + (size_t)n * 1024 * 256, 256, 0, 64 * (rr / 32), 32 * (rr % 32), scr, F.lane); continue; } r -= I3;
        transpose_item<0>(w_out, DM, 0, (bf16*)(w123 + W123_WO), 1024, 0, 64 * (r / 32), 32 * (r % 32), scr, F.lane);
    }
}
__device__ __forceinline__ void p0_prologue(Frame& F, __attribute__((address_space(4))) const Args* Ap) {
    LAS float* scr = (LAS float*)(F.lds + F.wave * 16384);
    const int gw = F.wg * NWAVES + F.wave, NGW = F.G * NWAVES;
    constexpr int I5 = 16 * 176, I6 = 16 * 32, I7 = 4 * 32, I8 = 44 * 32;
    constexpr int IL = I5 + I6 + I7 + I8;
    for (int it = gw; it < 2 * IL; it += NGW) {
        const int l = it / IL; int r = it - l * IL;
        unsigned char* w45 = F.ws + WS_W45 + (size_t)l * W45_STRIDE;
        if (r < I5) { transpose_item<0>(Ap->in[13] + (size_t)l * DM * UGW, UGW, 0, (bf16*)(w45 + W45_UP), 1024, 0, 64 * (r / 176), 32 * (r % 176), scr, F.lane); continue; } r -= I5;
        if (r < I6) { transpose_item<0>(Ap->in[17] + (size_t)l * DM * DM, DM, 0, (bf16*)(w45 + W45_PG), 1024, 0, 64 * (r / 32), 32 * (r % 32), scr, F.lane); continue; } r -= I6;
        if (r < I7) { transpose_item<0>(Ap->in[18] + (size_t)l * PDIM * DM, DM, 0, (bf16*)(w45 + W45_PP), 256, 0, 64 * (r / 32), 32 * (r % 32), scr, F.lane); continue; } r -= I7;
        transpose_item<0>(Ap->in[16] + (size_t)l * DFF * DM, DM, 0, (bf16*)(w45 + W45_DN), DFF, 0, 64 * (r / 32), 32 * (r % 32), scr, F.lane);
    }
    convert_w123(F, Ap->in[2], Ap->in[9], Ap->in[10]);
    {   const size_t n8 = (size_t)M * DM / 8; const f32x4* src = (const f32x4*)Ap->in[0]; u32x4* dst = (u32x4*)(F.ws + WS_XB);
        for (size_t i = (size_t)F.wg * 512 + F.tid; i < n8; i += (size_t)F.G * 512) { const f32x4 a = src[2 * i], b = src[2 * i + 1]; u32x4 o; o.x = pk2(a[0], a[1]); o.y = pk2(a[2], a[3]); o.z = pk2(b[0], b[1]); o.w = pk2(b[2], b[3]); dst[i] = o; } }
    {   const size_t n8 = (size_t)DEPTH * M * PDIM / 8; const f32x4* src = (const f32x4*)Ap->in[1]; u32x4* dst = (u32x4*)(F.ws + WS_PB);
        for (size_t i = (size_t)F.wg * 512 + F.tid; i < n8; i += (size_t)F.G * 512) { const f32x4 a = src[2 * i], b = src[2 * i + 1]; u32x4 o; o.x = pk2(a[0], a[1]); o.y = pk2(a[2], a[3]); o.z = pk2(b[0], b[1]); o.w = pk2(b[2], b[3]); dst[i] = o; } }
}

__device__ __forceinline__ void ln_phase(Frame& F, const float* w, const float* bvec, float* outf) {
    const int gw = F.wg * NWAVES + F.wave, NGW = F.G * NWAVES;
    bf16* XB = (bf16*)(F.ws + WS_XB);
    for (int row = gw; row < M; row += NGW) {
        u32x4* p = (u32x4*)(XB + (size_t)row * DM) + F.lane;
        const u32x4 a = p[0], b = p[64];
        float v[16] = {bflo(a.x), bfhi(a.x), bflo(a.y), bfhi(a.y), bflo(a.z), bfhi(a.z), bflo(a.w), bfhi(a.w), bflo(b.x), bfhi(b.x), bflo(b.y), bfhi(b.y), bflo(b.z), bfhi(b.z), bflo(b.w), bfhi(b.w)};
        float s = 0.f;
#pragma unroll
        for (int i = 0; i < 16; ++i) s += v[i];
        const float mean = wave_sum(s, F.lane) * (1.f / DM); float q = 0.f;
#pragma unroll
        for (int i = 0; i < 16; ++i) { v[i] -= mean; q += v[i] * v[i]; }
        const float rstd = 1.f / sqrtf(wave_sum(q, F.lane) * (1.f / DM) + LN_EPS);
        const int c0 = F.lane * 8, c1 = 512 + F.lane * 8;
        const f32x4 w0 = *(const f32x4*)(w + c0), w1 = *(const f32x4*)(w + c0 + 4), w2 = *(const f32x4*)(w + c1), w3 = *(const f32x4*)(w + c1 + 4);
        const f32x4 b0 = *(const f32x4*)(bvec + c0), b1 = *(const f32x4*)(bvec + c0 + 4), b2 = *(const f32x4*)(bvec + c1), b3 = *(const f32x4*)(bvec + c1 + 4);
        f32x4 y0, y1, y2, y3;
#pragma unroll
        for (int i = 0; i < 4; ++i) { y0[i] = v[i] * rstd * w0[i] + b0[i]; y1[i] = v[4 + i] * rstd * w1[i] + b1[i]; y2[i] = v[8 + i] * rstd * w2[i] + b2[i]; y3[i] = v[12 + i] * rstd * w3[i] + b3[i]; }
        u32x4 o0, o1; o0.x = pk2(y0[0], y0[1]); o0.y = pk2(y0[2], y0[3]); o0.z = pk2(y1[0], y1[1]); o0.w = pk2(y1[2], y1[3]);
        o1.x = pk2(y2[0], y2[1]); o1.y = pk2(y2[2], y2[3]); o1.z = pk2(y3[0], y3[1]); o1.w = pk2(y3[2], y3[3]);
        p[0] = o0; p[64] = o1;
        if (outf) { f32x4* op = (f32x4*)(outf + (size_t)row * DM); op[2 * F.lane] = y0; op[2 * F.lane + 1] = y1; op[128 + 2 * F.lane] = y2; op[128 + 2 * F.lane + 1] = y3; }
    }
}

__device__ __forceinline__ float gelu_tanh_(float y) { const float t = 1.5957691216057308f * (y + 0.044715f * y * y * y); return y * __builtin_amdgcn_rcpf(1.0f + __builtin_amdgcn_exp2f(-LOG2E * t)); }
__device__ __forceinline__ void up8(const u32x4 w, float (&v)[8]) { v[0] = bflo(w.x); v[1] = bfhi(w.x); v[2] = bflo(w.y); v[3] = bfhi(w.y); v[4] = bflo(w.z); v[5] = bfhi(w.z); v[6] = bflo(w.w); v[7] = bfhi(w.w); }
__device__ __forceinline__ void ffn_act_phase(Frame& F, const float* cw, const float* cb) {
    bf16* UG = (bf16*)(F.ws + WS_UG);
    constexpr int NCG = DFF / 8, NRB = M / 64;
    for (int task = F.wg * 512 + F.tid; task < NCG * NRB; task += F.G * 512) {
        const int rb = task / NCG, cg = task - rb * NCG; const int t0 = rb * 64, c0 = cg * 8;
        float w0[8], w1[8], w2[8], bb[8];
#pragma unroll
        for (int i = 0; i < 8; ++i) { w0[i] = cw[c0 + i]; w1[i] = cw[DFF + c0 + i]; w2[i] = cw[2 * DFF + c0 + i]; bb[i] = cb[c0 + i]; }
        float gm2[8], gm1[8];
        if ((t0 & (SEQ - 1)) == 0) {
#pragma unroll
            for (int i = 0; i < 8; ++i) { gm2[i] = 0.f; gm1[i] = 0.f; }
        } else { up8(*(const u32x4*)(UG + (size_t)(t0 - 2) * UGW + DFF + c0), gm2); up8(*(const u32x4*)(UG + (size_t)(t0 - 1) * UGW + DFF + c0), gm1); }
        for (int r = 0; r < 64; ++r) {
            bf16* rowp = UG + (size_t)(t0 + r) * UGW;
            float g0[8], uu[8]; up8(*(const u32x4*)(rowp + DFF + c0), g0); up8(*(const u32x4*)(rowp + c0), uu);
            float o[8];
#pragma unroll
            for (int i = 0; i < 8; ++i) { const float y = bb[i] + w0[i] * gm2[i] + w1[i] * gm1[i] + w2[i] * g0[i]; o[i] = gelu_tanh_(y) * uu[i]; gm2[i] = gm1[i]; gm1[i] = g0[i]; }
            u32x4 w; w.x = pk2(o[0], o[1]); w.y = pk2(o[2], o[3]); w.z = pk2(o[4], o[5]); w.w = pk2(o[6], o[7]);
            *(u32x4*)(rowp + c0) = w;
        }
    }
}

namespace mx {
__device__ __forceinline__ f32x16 mfma32(bf16x8 a, bf16x8 b, f32x16 c) { return __builtin_amdgcn_mfma_f32_32x32x16_bf16(a, b, c, 0, 0, 0); }
__device__ __forceinline__ f32x16 splat16(float v) { f32x16 r;
#pragma unroll
    for (int i = 0; i < 16; ++i) r[i] = v;
    return r; }
__device__ __forceinline__ int crow_c(int e) { return (e & 3) + 8 * (e >> 2); }
typedef short v4i16_t __attribute__((ext_vector_type(4)));
__device__ __forceinline__ s16x4 vtr(const LAS unsigned char* p) { return __builtin_bit_cast(s16x4, __builtin_amdgcn_ds_read_tr16_b64_v4i16((LAS v4i16_t*)p)); }
__device__ __forceinline__ bf16x8 pack8(float a0, float a1, float a2, float a3, float a4, float a5, float a6, float a7) {
    u32x4 w; w.x = pk2(a0, a1); w.y = pk2(a2, a3); w.z = pk2(a4, a5); w.w = pk2(a6, a7); return __builtin_bit_cast(bf16x8, w); }

__device__ __forceinline__ float log2gam(int h) { return __builtin_log2f(1.0f - __builtin_exp2f(-5.0f - (float)h)); }
__device__ __forceinline__ void prepkv_unit(Frame& F, int blk, const float* wa2, const float* bap, unsigned* kmaxl) {
    bf16* Z = (bf16*)(F.ws + WS_Z);
    const size_t r0 = (size_t)blk * 256; const int b = blk >> 5, cb = blk & 31;
    const int tid = F.tid;
    {   const int ch = tid >> 7, col = tid & 127;
        const float ba = bap[col];
        float wa[16];
#pragma unroll
        for (int r = 0; r < 16; ++r) wa[r] = wa2[r * 128 + col];
        float cum = 0.f;
        for (int t = 0; t < 64; ++t) {
            const bf16* zr = Z + (r0 + ch * 64 + t) * ZW; float da[8], db[8]; up8(*(const u32x4*)(zr + ZC_DA), da); up8(*(const u32x4*)(zr + ZC_DA + 8), db);
            float x = ba;
#pragma unroll
            for (int r = 0; r < 8; ++r) x += da[r] * wa[r];
#pragma unroll
            for (int r = 0; r < 8; ++r) x += db[r] * wa[8 + r];
            const float ls = fminf(x, 0.f) - __logf(1.0f + __expf(-fabsf(x)));
            cum += ls * 0.0625f;
        }
        const float bl = cum; cum = 0.f;
        for (int t = 0; t < 64; ++t) {
            bf16* zr = Z + (r0 + ch * 64 + t) * ZW; float da[8], db[8]; up8(*(const u32x4*)(zr + ZC_DA), da); up8(*(const u32x4*)(zr + ZC_DA + 8), db);
            float x = ba;
#pragma unroll
            for (int r = 0; r < 8; ++r) x += da[r] * wa[r];
#pragma unroll
            for (int r = 0; r < 8; ++r) x += db[r] * wa[8 + r];
            const float ls = fminf(x, 0.f) - __logf(1.0f + __expf(-fabsf(x)));
            cum += ls * 0.0625f;
            const float q = bf1(zr[ZC_DQ + col]), k = bf1(zr[ZC_DK + col]);
            zr[ZC_DQ + col] = (bf16)f2bf(q * __expf(cum - bl)); zr[ZC_DK + col] = (bf16)f2bf(k * __expf(bl - cum));
        }
        ((float*)(F.ws + WS_DE))[((size_t)b * 128 + cb * 4 + ch) * 128 + col] = __expf(bl);
    }
    for (int itn = 0; itn < 6; ++itn) { const int task = tid + 512 * itn, sl = task >> 8, row = task & 255;
        const bf16* kp = Z + (r0 + row) * ZW + (sl < 8 ? ZC_AK + (sl >> 1) * 64 + (sl & 1) * 32 : ZC_BK + (sl - 8) * 64); float ss = 0.f;
        const int nch = sl < 8 ? 4 : 8;
        for (int c = 0; c < nch; ++c) { float v[8]; up8(*(const u32x4*)(kp + 8 * c), v);
#pragma unroll
            for (int i = 0; i < 8; ++i) ss += v[i] * v[i]; }
#pragma unroll
        for (int o = 1; o < 64; o <<= 1) ss = fmaxf(ss, shx(ss, F.lane, o));
        if (F.lane == 0) __hip_atomic_fetch_max(kmaxl + b * 16 + sl, __float_as_uint(sqrtf(ss)), __ATOMIC_RELAXED, __HIP_MEMORY_SCOPE_AGENT); }
    for (int idx = tid; idx < 256 * 64; idx += 512) {
        const int row = idx >> 6, chunk = idx & 63, isk = chunk >> 5, c8 = (chunk & 31) * 8, h = c8 >> 6;
        const float e = (float)(255 - row) * log2gam(h); const float f = __builtin_amdgcn_exp2f(isk ? e : -e);
        u32x4* p = (u32x4*)(Z + (r0 + row) * ZW + (isk ? ZC_CK : ZC_CQ) + c8); float v[8]; up8(*p, v);
        u32x4 w; w.x = pk2(v[0] * f, v[1] * f); w.y = pk2(v[2] * f, v[3] * f); w.z = pk2(v[4] * f, v[5] * f); w.w = pk2(v[6] * f, v[7] * f); *p = w;
    }
    __threadfence_block(); __syncthreads();
    LAS unsigned char* Kl = F.lds; LAS unsigned char* Vl = F.lds + 36864;
    for (int h = 0; h < 4; ++h) {
        for (int idx = tid; idx < 256 * 8; idx += 512) { const int row = idx >> 3, c = idx & 7;
            *(LAS u32x4*)(Kl + row * 144 + c * 16) = *(const u32x4*)(Z + (r0 + row) * ZW + ZC_CK + h * 64 + c * 8);
            *(LAS u32x4*)(Vl + row * 144 + c * 16) = *(const u32x4*)(Z + (r0 + row) * ZW + ZC_CV + h * 64 + c * 8); }
        __syncthreads();
        {   const int d = tid >> 3, dk8 = (tid & 7) * 8; float acc[8];
#pragma unroll
            for (int i = 0; i < 8; ++i) acc[i] = 0.f;
            for (int j = 0; j < 256; ++j) { const float vv = bf1(*(const LAS bf16*)(Vl + j * 144 + d * 2)); float kk[8]; up8(*(const LAS u32x4*)(Kl + j * 144 + dk8 * 2), kk);
#pragma unroll
                for (int i = 0; i < 8; ++i) acc[i] += vv * kk[i]; }
            float* o = (float*)(F.ws + WS_KVC) + ((size_t)((b * 4 + h) * 32 + cb) * 4096 + d * 64 + dk8);
            *(f32x4*)o = (f32x4){acc[0], acc[1], acc[2], acc[3]}; *(f32x4*)(o + 4) = (f32x4){acc[4], acc[5], acc[6], acc[7]}; }
        __syncthreads();
        for (int idx = tid; idx < 256 * 8; idx += 512) { const int row = idx >> 3, c = idx & 7;
            if (c < 4) *(LAS u32x4*)(Kl + row * 144 + c * 16) = *(const u32x4*)(Z + (r0 + row) * ZW + ZC_DK + h * 32 + c * 8);
            *(LAS u32x4*)(Vl + row * 144 + c * 16) = *(const u32x4*)(Z + (r0 + row) * ZW + ZC_DV + h * 64 + c * 8); }
        __syncthreads();
        {   const int ch = tid >> 7, d = (tid >> 1) & 63, dk16 = (tid & 1) * 16; float acc[16];
#pragma unroll
            for (int i = 0; i < 16; ++i) acc[i] = 0.f;
            for (int j = 0; j < 64; ++j) { const int row = ch * 64 + j; const float vv = bf1(*(const LAS bf16*)(Vl + row * 144 + d * 2)); float k0[8], k1[8];
                up8(*(const LAS u32x4*)(Kl + row * 144 + dk16 * 2), k0); up8(*(const LAS u32x4*)(Kl + row * 144 + dk16 * 2 + 16), k1);
#pragma unroll
                for (int i = 0; i < 8; ++i) { acc[i] += vv * k0[i]; acc[8 + i] += vv * k1[i]; } }
            float* o = (float*)(F.ws + WS_KVD) + ((size_t)((b * 4 + h) * 128 + cb * 4 + ch) * 2048 + d * 32 + dk16);
#pragma unroll
            for (int i = 0; i < 4; ++i) *(f32x4*)(o + 4 * i) = (f32x4){acc[4 * i], acc[4 * i + 1], acc[4 * i + 2], acc[4 * i + 3]}; }
        __syncthreads();
    }
}

__device__ __forceinline__ void scan_phase(Frame& F) {
    const int gt = F.wg * 512 + F.tid, NT = F.G * 512;
    for (int e = gt; e < 16 * 4096; e += NT) {
        const int bh = e >> 12, idx = e & 4095, h = bh & 3; const float g256 = __builtin_amdgcn_exp2f(256.0f * log2gam(h));
        float* p = (float*)(F.ws + WS_KVC) + (size_t)bh * 32 * 4096 + idx; float S = 0.f;
        for (int c = 0; c < 32; ++c) { const float kv = p[(size_t)c * 4096]; const float Sp = g256 * S; p[(size_t)c * 4096] = Sp; S = Sp + kv; }
    }
    for (int e = gt; e < 16 * 2048; e += NT) {
        const int bh = e >> 11, idx = e & 2047, b = bh >> 2, h = bh & 3, dk = idx & 31;
        float* p = (float*)(F.ws + WS_KVD) + (size_t)bh * 128 * 2048 + idx; const float* de = (const float*)(F.ws + WS_DE) + (size_t)b * 128 * 128 + h * 32 + dk; float S = 0.f;
        for (int c = 0; c < 128; ++c) { const float kv = p[(size_t)c * 2048]; const float Sp = de[c * 128] * S; p[(size_t)c * 2048] = Sp; S = Sp + kv; }
    }
}

constexpr int HPITCH = 1026, CAP = 256;
struct QState { unsigned mode, thr_lo, thr_hi, thr_idx, krem, lcount, pad0, pad1; };
__device__ __forceinline__ unsigned okey_of(float s) { const unsigned u = __float_as_uint(s); return u ^ ((unsigned)((int)u >> 31) | 0x80000000u); }
__device__ __forceinline__ void b1_load(const bf16* Zb, int t, int r, int hh, bf16x8& k0, bf16x8& k1) {
    const bf16* kr = Zb + (size_t)(32 * t + r) * ZW + ZC_IK + 8 * hh; k0 = *(const bf16x8*)kr; k1 = *(const bf16x8*)(kr + 16); }
__device__ __forceinline__ void b1_scores(const bf16x8 k0, const bf16x8 k1, const bf16x8 (&iqf)[4][2], const float (&w)[4], float (&sc)[16]) {
#pragma unroll
    for (int e = 0; e < 16; ++e) sc[e] = 0.f;
#pragma unroll
    for (int ih = 0; ih < 4; ++ih) { f32x16 lg = mfma32(k0, iqf[ih][0], splat16(0.f)); lg = mfma32(k1, iqf[ih][1], lg);
#pragma unroll
        for (int e = 0; e < 16; ++e) sc[e] = fmaf(w[ih], fmaxf(lg[e], 0.f), sc[e]); }
}
__device__ __forceinline__ void b1_setbit(unsigned* MWq, unsigned j) {
    const unsigned wi = j & 31u, hh = (wi >> 2) & 1u, e = (wi & 3u) + 4u * (wi >> 3), kh = (j >> 5) & 1u;
    __hip_atomic_fetch_or(MWq + (size_t)(j >> 6) * 64 + 32u * hh, 1u << (e + 16u * kh), __ATOMIC_RELAXED, __HIP_MEMORY_SCOPE_AGENT);
}
__device__ __forceinline__ void b1_unit(Frame& F, int b, int g) {
    const int tid = F.tid, lane = F.lane, r = lane & 31, hh = lane >> 5, wid = F.wave;
    const bf16* Zb = (const bf16*)(F.ws + WS_Z) + (size_t)b * SEQ * ZW;
    LAS unsigned* hist = (LAS unsigned*)F.lds;
    LAS QState* qst = (LAS QState*)(F.lds + QST_OFF);
    const int qpos = 32 * g + r;
    unsigned* MWb = (unsigned*)(F.ws + WS_MASK) + ((size_t)(b * 256 + g) * 128) * 64;
    bf16x8 iqf[4][2]; float w[4];
    {   const bf16* qr = Zb + (size_t)qpos * ZW;
#pragma unroll
        for (int ih = 0; ih < 4; ++ih) { iqf[ih][0] = *(const bf16x8*)(qr + ZC_IQ + ih * 32 + 8 * hh); iqf[ih][1] = *(const bf16x8*)(qr + ZC_IQ + ih * 32 + 16 + 8 * hh); w[ih] = bf1(qr[ZC_IW + ih]); } }
    if (g >= 8) {
        for (int i = tid; i < 32 * HPITCH; i += 512) hist[i] = 0u;
        __syncthreads();
        {   bf16x8 n0 = iqf[0][0], n1 = iqf[0][0]; int t = wid; if (t <= g) b1_load(Zb, t, r, hh, n0, n1);
            for (; t <= g; t += 8) { const bf16x8 k0 = n0, k1 = n1; if (t + 8 <= g) b1_load(Zb, t + 8, r, hh, n0, n1);
                float sc[16]; b1_scores(k0, k1, iqf, w, sc);
#pragma unroll
                for (int e = 0; e < 16; ++e) { const int j = 32 * t + crow_c(e) + 4 * hh; if (j <= qpos) { const unsigned bin = okey_of(sc[e]) >> 21;
                    __hip_atomic_fetch_add(hist + r * HPITCH + (bin >> 1), 1u << ((bin & 1) * 16), __ATOMIC_RELAXED, __HIP_MEMORY_SCOPE_WORKGROUP); } } } }
        __syncthreads();
        for (int qq = 0; qq < 4; ++qq) { const int q = 4 * wid + qq; const LAS unsigned* hq = hist + q * HPITCH;
            const int wbase = 1008 - 16 * lane; unsigned s = 0;
#pragma unroll
            for (int k = 0; k < 16; ++k) { const unsigned x = hq[wbase + k]; s += (x & 0xffffu) + (x >> 16); }
            unsigned P = s;
#pragma unroll
            for (int o = 1; o < 64; o <<= 1) { const unsigned t = shup(P, lane, o); if (lane >= o) P += t; }
            const unsigned long long bal = __ballot(P >= 256u);
            const int Lsel = bal ? __builtin_ctzll(bal) : 63;
            if (lane == Lsel) { unsigned cum = P - s; unsigned b1 = 0, cin = 0, cab = 0;
                for (int k = 0; k < 32; ++k) { const int bin = 2047 - 32 * lane - k; const unsigned x = hq[bin >> 1]; const unsigned c = (bin & 1) ? (x >> 16) : (x & 0xffffu);
                    if (cum + c >= 256u) { b1 = (unsigned)bin; cin = c; cab = cum; break; } cum += c; }
                qst[q].thr_lo = b1 << 21; qst[q].thr_hi = (b1 << 21) | 0x1fffffu; qst[q].thr_idx = 0xffffu; qst[q].krem = 256u - cab; qst[q].lcount = 0u; qst[q].pad0 = cin; qst[q].pad1 = 0u;
                qst[q].mode = (b1 == 1024u || cin > (unsigned)CAP) ? 2u : 1u; }
        }
        __syncthreads();
        for (int i = tid; i < 32 * 256; i += 512) ((LAS unsigned*)(F.lds + 65536))[i] = 0u;
        __syncthreads();
    }
    {   unsigned mode = 0u, tlo = 1u, thi = 0u;
        const bool allsel = (g < 8);
        if (!allsel) { mode = qst[r].mode; tlo = qst[r].thr_lo; thi = qst[r].thr_hi; }
        const int nk = g >> 1;
        bf16x8 n0 = iqf[0][0], n1 = iqf[0][0], n2 = iqf[0][0], n3 = iqf[0][0]; int kt = wid;
        if (kt <= nk) { b1_load(Zb, 2 * kt, r, hh, n0, n1); if (2 * kt + 1 <= g) b1_load(Zb, 2 * kt + 1, r, hh, n2, n3); }
        for (; kt <= nk; kt += 8) {
            const bf16x8 k0 = n0, k1 = n1, k2 = n2, k3 = n3;
            if (kt + 8 <= nk) { b1_load(Zb, 2 * kt + 16, r, hh, n0, n1); if (2 * kt + 17 <= g) b1_load(Zb, 2 * kt + 17, r, hh, n2, n3); }
            unsigned word = 0u;
#pragma unroll
            for (int kh = 0; kh < 2; ++kh) { const int t = 2 * kt + kh; if (t <= g) { float sc[16]; b1_scores(kh ? k2 : k0, kh ? k3 : k1, iqf, w, sc);
#pragma unroll
                for (int e = 0; e < 16; ++e) { const int j = 32 * t + crow_c(e) + 4 * hh; const unsigned ok = okey_of(sc[e]); const bool valid = (j <= qpos);
                    const bool sel = valid && (allsel || ok > thi); word |= (sel ? 1u : 0u) << (e + 16 * kh);
                    if (!allsel && valid && ok >= tlo && ok <= thi) {
                        if (mode == 1u) { const unsigned pos = __hip_atomic_fetch_add(&qst[r].lcount, 1u, __ATOMIC_RELAXED, __HIP_MEMORY_SCOPE_WORKGROUP);
                            if (pos < (unsigned)CAP) { LAS unsigned* le = (LAS unsigned*)(F.lds + ((size_t)r * CAP + pos) * 8); le[0] = ok; le[1] = (unsigned)j; } }
                        else __hip_atomic_fetch_or((LAS unsigned*)(F.lds + 65536 + r * 1024) + (j >> 5), 1u << (j & 31), __ATOMIC_RELAXED, __HIP_MEMORY_SCOPE_WORKGROUP); } } } }
            MWb[(size_t)kt * 64 + lane] = word; }
    }
    __syncthreads();
    if (g >= 8) {
        for (int qq = 0; qq < 4; ++qq) { const int q = 4 * wid + qq; const unsigned mode = qst[q].mode, krem = qst[q].krem; unsigned* MWq = MWb + q;
            if (mode == 1u) {
                unsigned L = qst[q].lcount; if (L > (unsigned)CAP) L = CAP; const LAS unsigned* lb = (const LAS unsigned*)(F.lds + (size_t)q * CAP * 8);
                unsigned long long comp[4]; bool has[4]; unsigned jj[4];
#pragma unroll
                for (int k = 0; k < 4; ++k) { const unsigned c = lane + 64 * k; has[k] = c < L; const unsigned ok = has[k] ? lb[2 * c] : 0u; jj[k] = has[k] ? lb[2 * c + 1] : 0u;
                    comp[k] = ((unsigned long long)(ok & 0x1fffffu) << 13) | (unsigned long long)(8191u - jj[k]); }
                unsigned long long prefix = 0ull; unsigned need = krem;
                for (int bit = 33; bit >= 0; --bit) { const unsigned long long want = (prefix >> bit) | 1ull; unsigned cnt = 0;
#pragma unroll
                    for (int k = 0; k < 4; ++k) cnt += (unsigned)__builtin_popcountll(__ballot(has[k] && ((comp[k] >> bit) == want)));
                    if (cnt >= need) prefix |= (1ull << bit); else need -= cnt; }
#pragma unroll
                for (int k = 0; k < 4; ++k) if (has[k] && comp[k] >= prefix) b1_setbit(MWq, jj[k]); }
            else { const LAS unsigned* bm = (const LAS unsigned*)(F.lds + 65536 + q * 1024); unsigned x[4]; unsigned s = 0;
#pragma unroll
                for (int k = 0; k < 4; ++k) { x[k] = bm[4 * lane + k]; s += __builtin_popcount(x[k]); }
                unsigned P = s;
#pragma unroll
                for (int o = 1; o < 64; o <<= 1) { const unsigned t = shup(P, lane, o); if (lane >= o) P += t; }
                unsigned before = P - s;
#pragma unroll
                for (int k = 0; k < 4; ++k) { unsigned y = x[k]; while (y != 0u && before < krem) { const unsigned bit = (unsigned)__builtin_ctz(y); y &= y - 1u; b1_setbit(MWq, 32u * (4 * lane + k) + bit); ++before; } before += __builtin_popcount(y); } }
        }
        __syncthreads();
    }
}

struct EngP { const bf16* Z; bf16* Y; const unsigned* MASK; const float* ST; const float* nw; float lam, lam_init; const unsigned* kmax; };
__device__ __forceinline__ int wq_next(Frame& F, unsigned* head) {
    LAS int* slot = (LAS int*)(F.lds + 36880);
    if (F.tid == 0) *slot = (int)__hip_atomic_fetch_add(head, 1u, __ATOMIC_RELAXED, __HIP_MEMORY_SCOPE_AGENT);
    __syncthreads(); const int u = *slot; __syncthreads(); return u;
}
template <int MODE>
__device__ __forceinline__ void eng_unit(Frame& F, const EngP& P, int b, int h, int qb) {
    constexpr bool SOFT = MODE <= 1;
    constexpr int NMAP = MODE == 0 ? 2 : 1;
    constexpr int NS = (MODE == 0 || MODE == 3) ? 2 : 4;
    constexpr int KCH = MODE == 3 ? 4 : 8;
    constexpr int QC = MODE == 0 ? ZC_AQ : MODE == 1 ? ZC_BQ : MODE == 2 ? ZC_CQ : ZC_DQ;
    constexpr int KC = MODE == 0 ? ZC_AK : MODE == 1 ? ZC_BK : MODE == 2 ? ZC_CK : ZC_DK;
    constexpr int VC = MODE == 0 ? ZC_AV : MODE == 1 ? ZC_BV : MODE == 2 ? ZC_CV : ZC_DV;
    constexpr int HW = MODE == 3 ? 32 : 64;
    const int tid = F.tid, lane = F.lane, r = lane & 31, hh = lane >> 5, w = F.wave;
    const size_t rowbase = (size_t)b * SEQ;
    const int qw0 = qb * 256 + 32 * w;
    const float NEG = -__builtin_inff();
    const int hidx = MODE <= 1 ? (MODE == 0 ? 2 * h + 1 : 2 * h + 2) : 0;
    const float slope2 = SOFT ? __builtin_amdgcn_exp2f(-(float)hidx) * LOG2E : 0.f;
    bf16x8 qf[NMAP][NS];
    {   const bf16* qrow = P.Z + (rowbase + qw0 + r) * ZW + QC + h * HW;
#pragma unroll
        for (int m = 0; m < NMAP; ++m)
#pragma unroll
            for (int s = 0; s < NS; ++s) qf[m][s] = *(const bf16x8*)(qrow + m * 32 + 16 * s + 8 * hh); }
    f32x16 cinit;
#pragma unroll
    for (int e = 0; e < 16; ++e) cinit[e] = SOFT ? slope2 * (float)(crow_c(e) + 4 * hh) : 0.f;
    float m_run[NMAP], l_run[NMAP]; f32x16 O[NMAP][2];
#pragma unroll
    for (int m = 0; m < NMAP; ++m) { m_run[m] = NEG; l_run[m] = 0.f; O[m][0] = splat16(0.f); O[m][1] = splat16(0.f); }
    if (!SOFT) {
        const int sidx = MODE == 2 ? ((b * 4 + h) * 32 + qb) : ((b * 4 + h) * 128 + 4 * qb + (w >> 1));
        const float* sp = P.ST + (size_t)sidx * (64 * HW);
#pragma unroll
        for (int db = 0; db < 2; ++db)
#pragma unroll
            for (int s = 0; s < NS; ++s) { const float* a = sp + (size_t)(32 * db + r) * HW + 16 * s + 8 * hh; const f32x4 a0 = *(const f32x4*)a, a1 = *(const f32x4*)(a + 4);
                O[0][db] = mfma32(pack8(a0[0], a0[1], a0[2], a0[3], a1[0], a1[1], a1[2], a1[3]), qf[0][s], O[0][db]); }
    }
    const int kt_lo = SOFT ? 0 : 4 * qb, kt_hi = 4 * qb + 3;
    const int srow = tid >> 3, sch = tid & 7;
    float qk[NMAP];
    if (SOFT) {
#pragma unroll
        for (int m = 0; m < NMAP; ++m) { float ss = 0.f;
#pragma unroll
            for (int s = 0; s < NS; ++s) { const u32x4 qq = __builtin_bit_cast(u32x4, qf[m][s]); float v[8]; up8(qq, v);
#pragma unroll
                for (int i = 0; i < 8; ++i) ss += v[i] * v[i]; }
            ss += shx(ss, lane, 32);
            qk[m] = 1.02f * sqrtf(ss) * __uint_as_float(P.kmax[b * 16 + (MODE == 0 ? (h * 2 + m) : (8 + h))]) + 0.01f; }
    }
    LAS unsigned* wflag = (LAS unsigned*)(F.lds + 36864);
    if (SOFT && tid < 3) wflag[tid] = 0u;
    const int kt_first = SOFT ? kt_hi : kt_lo;
    u32x4 kreg = (u32x4){0u, 0u, 0u, 0u}, vreg;
    {   const bf16* zr = P.Z + (rowbase + 64 * kt_first + srow) * ZW;
        if (sch < KCH) kreg = *(const u32x4*)(zr + KC + h * HW + sch * 8);
        vreg = *(const u32x4*)(zr + VC + h * 64 + sch * 8);
        LAS unsigned char* Kb = F.lds; LAS unsigned char* Vb = F.lds + 18432;
        if (sch < KCH) *(LAS u32x4*)(Kb + srow * 144 + sch * 16) = kreg;
        *(LAS u32x4*)(Vb + srow * 144 + sch * 16) = vreg; }
    __syncthreads();
    const int nit = kt_hi - kt_lo + 1;
    bool wave_done = false;
    for (int it = 0; it < nit; ++it) {
        const int kt = SOFT ? kt_hi - it : kt_lo + it, ktn = SOFT ? kt - 1 : kt + 1;
        const bool more = it + 1 < nit;
        if (more) { const bf16* zr = P.Z + (rowbase + 64 * ktn + srow) * ZW;
            if (sch < KCH) kreg = *(const u32x4*)(zr + KC + h * HW + sch * 8);
            vreg = *(const u32x4*)(zr + VC + h * 64 + sch * 8); }
        const int j0 = 64 * kt;
        const bool act = ((MODE == 3) ? (kt == 4 * qb + (w >> 1)) : (j0 <= qw0 + 31)) && !wave_done;
        if (act) {
            const LAS unsigned char* Kb = F.lds + (it & 1) * 9216; const LAS unsigned char* Vb = F.lds + 18432 + (it & 1) * 9216;
            unsigned mw = 0xffffffffu;
            if (MODE == 1) mw = P.MASK[((size_t)(b * 256 + qb * 8 + w) * 128 + kt) * 64 + lane];
            const bool hact1 = (j0 + 32 <= qw0 + 31);
#pragma unroll
            for (int m = 0; m < NMAP; ++m) {
                f32x16 st[2];
#pragma unroll
                for (int kh = 0; kh < 2; ++kh) {
                    if (kh == 0 || hact1) {
                        f32x16 a = cinit;
#pragma unroll
                        for (int s = 0; s < NS; ++s) { const bf16x8 kf = *(const LAS bf16x8*)(Kb + (32 * kh + r) * 144 + (m * 32 + 16 * s + 8 * hh) * 2); a = mfma32(kf, qf[m][s], a); }
                        if (j0 + 32 * kh + 31 > qw0) { const int lim = qw0 + r - j0 - 32 * kh - 4 * hh;
#pragma unroll
                            for (int e = 0; e < 16; ++e) if (crow_c(e) > lim) a[e] = SOFT ? NEG : 0.f; }
                        if (MODE == 1) {
#pragma unroll
                            for (int e = 0; e < 16; ++e) if (!((mw >> (e + 16 * kh)) & 1u)) a[e] = NEG; }
                        st[kh] = a;
                    } else st[kh] = splat16(SOFT ? NEG : 0.f);
                }
                if (SOFT) {
                    const float off0 = slope2 * (float)(j0 - qw0 - r), off1 = off0 + 32.f * slope2;
                    float mx0 = st[0][0], mx1 = st[1][0];
#pragma unroll
                    for (int e = 1; e < 16; ++e) { mx0 = fmaxf(mx0, st[0][e]); mx1 = fmaxf(mx1, st[1][e]); }
                    float mx = fmaxf(mx0 + off0, mx1 + off1); mx = fmaxf(mx, shx(mx, lane, 32));
                    const float mn = fmaxf(m_run[m], mx); const float msafe = (mn == NEG) ? 0.f : mn;
                    const float alpha = __builtin_amdgcn_exp2f(m_run[m] - msafe); m_run[m] = mn;
                    const float d0 = off0 - msafe, d1 = off1 - msafe; float rs = 0.f;
#pragma unroll
                    for (int e = 0; e < 16; ++e) { const float p0 = __builtin_amdgcn_exp2f(st[0][e] + d0), p1 = __builtin_amdgcn_exp2f(st[1][e] + d1); st[0][e] = p0; st[1][e] = p1; rs += p0 + p1; }
                    rs += shx(rs, lane, 32); l_run[m] = l_run[m] * alpha + rs;
#pragma unroll
                    for (int e = 0; e < 16; ++e) { O[m][0][e] *= alpha; O[m][1][e] *= alpha; }
                }
#pragma unroll
                for (int kh = 0; kh < 2; ++kh) {
                    if (kh == 0 || hact1) {
#pragma unroll
                        for (int s = 0; s < 2; ++s) {
                            const bf16x8 pf = pack8(st[kh][8 * s], st[kh][8 * s + 1], st[kh][8 * s + 2], st[kh][8 * s + 3], st[kh][8 * s + 4], st[kh][8 * s + 5], st[kh][8 * s + 6], st[kh][8 * s + 7]);
#pragma unroll
                            for (int db = 0; db < 2; ++db) {
                                const LAS unsigned char* vp = Vb + (32 * kh + 16 * s + 4 * hh + ((lane & 15) >> 2)) * 144 + (32 * db + 16 * ((lane >> 4) & 1) + 4 * (lane & 3)) * 2;
                                const s16x4 lo = vtr(vp), hi = vtr(vp + 8 * 144);
                                const bf16x8 vf = (bf16x8){lo[0], lo[1], lo[2], lo[3], hi[0], hi[1], hi[2], hi[3]};
                                O[m][db] = mfma32(vf, pf, O[m][db]); } } } }
            }
            if (SOFT) {
                const float dist = slope2 * (float)(qw0 + r - (j0 - 1)); bool fin = true;
#pragma unroll
                for (int m = 0; m < NMAP; ++m) fin = fin && (qk[m] - dist - m_run[m] < -32.f);
                wave_done = (__ballot(fin) == ~0ull);
            }
        }
        if (SOFT && !wave_done && lane == 0) wflag[it % 3] = 1u;
        if (more) { LAS unsigned char* Kb = F.lds + ((it + 1) & 1) * 9216; LAS unsigned char* Vb = F.lds + 18432 + ((it + 1) & 1) * 9216;
            if (sch < KCH) *(LAS u32x4*)(Kb + srow * 144 + sch * 16) = kreg;
            *(LAS u32x4*)(Vb + srow * 144 + sch * 16) = vreg; }
        __syncthreads();
        if (SOFT) { const unsigned any = wflag[it % 3]; if (tid == 0) wflag[(it + 2) % 3] = 0u; if (any == 0u) break; }
    }
    const size_t orow = rowbase + qw0 + r;
    const int ycol = MODE * 256 + h * 64;
    f32x16 o[2];
    if (MODE == 0) { const float i0 = 1.f / l_run[0], i1 = P.lam / l_run[NMAP - 1];
#pragma unroll
        for (int db = 0; db < 2; ++db)
#pragma unroll
            for (int e = 0; e < 16; ++e) o[db][e] = O[0][db][e] * i0 - O[NMAP - 1][db][e] * i1; }
    else if (MODE == 1) { const float i0 = 1.f / l_run[0];
#pragma unroll
        for (int db = 0; db < 2; ++db)
#pragma unroll
            for (int e = 0; e < 16; ++e) o[db][e] = O[0][db][e] * i0; }
    else { o[0] = O[0][0]; o[1] = O[0][1]; }
    float mu = 0.f;
    if (MODE == 2) { float s = 0.f;
#pragma unroll
        for (int db = 0; db < 2; ++db)
#pragma unroll
            for (int e = 0; e < 16; ++e) s += o[db][e];
        s += shx(s, lane, 32); mu = s * (1.f / 64.f); }
    float ss = 0.f;
    if (MODE != 1) {
#pragma unroll
        for (int db = 0; db < 2; ++db)
#pragma unroll
            for (int e = 0; e < 16; ++e) { const float d = o[db][e] - mu; ss += d * d; }
        ss += shx(ss, lane, 32); }
    float rn = 1.f;
    if (MODE != 1) rn = 1.f / sqrtf(ss * (1.f / 64.f) + LN_EPS);
    if (MODE == 0) rn *= (1.f - P.lam_init);
#pragma unroll
    for (int db = 0; db < 2; ++db)
#pragma unroll
        for (int g4 = 0; g4 < 4; ++g4) { const int d0 = 32 * db + 8 * g4 + 4 * hh; float v[4];
#pragma unroll
            for (int i = 0; i < 4; ++i) v[i] = o[db][4 * g4 + i];
            if (MODE != 1) { const f32x4 nw = *(const f32x4*)(P.nw + (MODE == 2 ? h * 64 : 0) + d0);
#pragma unroll
                for (int i = 0; i < 4; ++i) v[i] = (v[i] - mu) * rn * nw[i]; }
            if (MODE >= 2) { const u32x2 gw = *(const u32x2*)(P.Z + orow * ZW + (MODE == 2 ? ZC_CG : ZC_DG) + h * 64 + d0);
                const float g0 = bflo(gw.x), g1 = bfhi(gw.x), g2 = bflo(gw.y), g3 = bfhi(gw.y);
                v[0] *= g0 * sigmoidf_(g0); v[1] *= g1 * sigmoidf_(g1); v[2] *= g2 * sigmoidf_(g2); v[3] *= g3 * sigmoidf_(g3); }
            u32x2 ow; ow.x = pk2(v[0], v[1]); ow.y = pk2(v[2], v[3]);
            *(u32x2*)(P.Y + orow * DM + ycol + d0) = ow; }
}
}

constexpr int PH_PER_LAYER = 12, N_PHASES = 1 + DEPTH * PH_PER_LAYER;

typedef __attribute__((address_space(4))) const Args* KArgP;
#ifdef ONLY_SITE
#define SITE(s) ((s) == ONLY_SITE)
#else
#define SITE(s) true
#endif
#if MK_ONE_LAUNCH
#define IN(k) true
#define SEAM(k) do { if ((k) + 1 < N_PHASES) { XcdBarrier b2_ = bar; asm volatile("" : "+s"(b2_.bar), "+s"(b2_.x)); xcd_barrier(b2_, F.tid == 0); } } while (0)
#else
#define IN(k) (lo <= (k) && (k) < hi)
#define SEAM(k) do { } while (0)
#endif
#define SITE_BEGIN KArgP KA = (KArgP)__builtin_amdgcn_kernarg_segment_ptr(); do { asm volatile("" : "+s"(KA)); \
        int ln_; asm volatile("v_mbcnt_lo_u32_b32 %0, -1, 0\n\tv_mbcnt_hi_u32_b32 %0, -1, %0" : "=v"(ln_)); \
        unsigned tk_ = 0u; if (ln_ == 0) tk_ = __hip_atomic_fetch_add((LAS unsigned*)(F.lds + MISC_OFF + 64), 1u, __ATOMIC_RELAXED, __HIP_MEMORY_SCOPE_WORKGROUP); \
        F.wave = __builtin_amdgcn_readfirstlane((int)(tk_ & 7u)); F.lane = ln_; F.tid = F.wave * 64 + F.lane; \
        F.ws = KA->ws; F.dob = (unsigned char*)KA->out; F.G = G0; F.wg = wg0; asm volatile("" : "+s"(F.G), "+s"(F.wg)); } while (0)


__global__ void __launch_bounds__(NWAVES * 64, 2) fwd_kernel(Args args) {
    extern __shared__ __attribute__((aligned(16))) unsigned char lds_raw[];
    Frame F;
    F.lds = (LAS unsigned char*)lds_raw;
    F.tid = threadIdx.x; F.lane = F.tid & 63; F.wave = __builtin_amdgcn_readfirstlane(F.tid >> 6);
    F.G = gridDim.x; F.wg = blockIdx.x;
    F.ws = args.ws; F.dob = (unsigned char*)args.out;
    volatile LAS unsigned* MISC = (volatile LAS unsigned*)(F.lds + MISC_OFF);
    if (F.tid < 32) MISC[F.tid] = 0u;
    __syncthreads();
    unsigned* ctl = (unsigned*)(F.ws + WS_CTL);
    XcdBarrier bar; bar.bar = ctl + CW_BAR; bar.x = 0; bar.st = nullptr;
#if MK_ONE_LAUNCH
    bar = xcd_barrier_post(ctl + CW_BAR, MISC + 8);
#endif
    const int lo = args.ph_lo, hi = args.ph_hi;
    const int G0 = F.G, wg0 = F.wg;
    if (SITE(0) && IN(0)) { SITE_BEGIN; p0_prologue(F, KA); SEAM(0); }

    for (int l = 0; l < DEPTH; ++l) {
        const int pb = 1 + l * PH_PER_LAYER;
        if (SITE(1) && IN(pb + 0)) { SITE_BEGIN; const char* XBc = (const char*)(F.ws + WS_XB); (void)XBc; const unsigned char* w123 = F.ws + WS_W123; const unsigned char* w45 = F.ws + WS_W45 + (size_t)l * W45_STRIDE; (void)w123; (void)w45;
            pg8::SchedPlain S{XBc, (const char*)(w123 + W123_W1), 2048, 2048, 16, 128, 14, F.G, F.wg};
            pg8::EpiStore E{(bf16*)(F.ws + WS_Z), ZW};
            pg8::gemm_phase(F.lds, S, E, F.tid);
            SEAM(pb + 0);
        }
        if (SITE(2) && IN(pb + 1)) { SITE_BEGIN; const char* XBc = (const char*)(F.ws + WS_XB); (void)XBc; const unsigned char* w123 = F.ws + WS_W123; const unsigned char* w45 = F.ws + WS_W45 + (size_t)l * W45_STRIDE; (void)w123; (void)w45;
            if (EXPM != 15) { u32x4* yp = (u32x4*)(F.ws + WS_Y); for (size_t i = (size_t)F.wg * 512 + F.tid; i < (size_t)M * DM / 8; i += (size_t)F.G * 512) yp[i] = (u32x4){0u, 0u, 0u, 0u}; }
            if (EXPM & 2) for (int u = F.wg; u < 512; u += F.G) { const int b = u >> 7, p = u & 127; mx::b1_unit(F, b, 255 - p); mx::b1_unit(F, b, p); }
            if (EXPM & 12) for (int u = F.wg; u < 128; u += F.G) mx::prepkv_unit(F, u, KA->in[6] + (size_t)l * 16 * 128, KA->in[7] + l * 128, (unsigned*)(F.ws + WS_CTL) + CW_KMAX + l * 64);
            SEAM(pb + 1);
        }
        if (SITE(3) && IN(pb + 2)) { SITE_BEGIN; const char* XBc = (const char*)(F.ws + WS_XB); (void)XBc; const unsigned char* w123 = F.ws + WS_W123; const unsigned char* w45 = F.ws + WS_W45 + (size_t)l * W45_STRIDE; (void)w123; (void)w45;
            if (EXPM & 12) mx::scan_phase(F);
            float lam_init = 0.8f - 0.6f * __expf(-0.3f * (float)l);
            const float* lp = KA->in[3] + l * 128; float s01 = 0.f, s23 = 0.f;
            for (int i = 0; i < 32; ++i) { s01 += lp[i] * lp[32 + i]; s23 += lp[64 + i] * lp[96 + i]; }
            mx::EngP P{(const bf16*)(F.ws + WS_Z), (bf16*)(F.ws + WS_Y), nullptr, nullptr, KA->in[4] + l * 64, __expf(s01) - __expf(s23) + lam_init, lam_init, (const unsigned*)(F.ws + WS_CTL) + CW_KMAX + l * 64};
            {   unsigned* head = (unsigned*)(F.ws + WS_CTL) + CW_WQ + l * 64;
                for (;;) { const int i = mx::wq_next(F, head); if (i >= 512) break; const int j = i & 127; mx::eng_unit<0>(F, P, j & 3, 3 - (i >> 7), 31 - (j >> 2)); } }
            SEAM(pb + 2);
        }
        if (SITE(4) && IN(pb + 3)) { SITE_BEGIN; const char* XBc = (const char*)(F.ws + WS_XB); (void)XBc; const unsigned char* w123 = F.ws + WS_W123; const unsigned char* w45 = F.ws + WS_W45 + (size_t)l * W45_STRIDE; (void)w123; (void)w45;
            {   unsigned* head = (unsigned*)(F.ws + WS_CTL) + CW_WQ + l * 64 + 16;
                const mx::EngP PB{(const bf16*)(F.ws + WS_Z), (bf16*)(F.ws + WS_Y), (const unsigned*)(F.ws + WS_MASK), nullptr, nullptr, 0.f, 0.f, (const unsigned*)(F.ws + WS_CTL) + CW_KMAX + l * 64};
                const mx::EngP PC{(const bf16*)(F.ws + WS_Z), (bf16*)(F.ws + WS_Y), nullptr, (const float*)(F.ws + WS_KVC), KA->in[5] + l * 256, 0.f, 0.f, nullptr};
                const mx::EngP PD{(const bf16*)(F.ws + WS_Z), (bf16*)(F.ws + WS_Y), nullptr, (const float*)(F.ws + WS_KVD), KA->in[8] + l * 64, 0.f, 0.f, nullptr};
                for (;;) { const int i = mx::wq_next(F, head); if (i >= 1536) break;
                    if (i < 512) { const int j = i & 127; mx::eng_unit<1>(F, PB, j & 3, 3 - (i >> 7), 31 - (j >> 2)); }
                    else if (i < 1024) { const int u = i - 512; mx::eng_unit<2>(F, PC, u >> 7, (u >> 5) & 3, u & 31); }
                    else { const int u = i - 1024; mx::eng_unit<3>(F, PD, u >> 7, (u >> 5) & 3, u & 31); } } }
            SEAM(pb + 3);
        }
        if (SITE(5) && IN(pb + 4)) { SITE_BEGIN;
            const unsigned char* w123 = F.ws + WS_W123;
            for (int n = 0; n < 4; ++n) {
                {   pg8::SchedPlain S{(const char*)(F.ws + WS_XB), (const char*)(w123 + W123_GB) + (size_t)n * 1024 * 2048, 2048, 2048, 16, 128, 4, F.G, F.wg};
                    pg8::EpiSlotStore E{F.ws + WS_SCR2 + (size_t)F.wg * 262144, 1};
                    pg8::gemm_phase(F.lds, S, E, F.tid); }
                {   pg8::SchedPlain S{(const char*)(F.ws + WS_Y) + n * 512, (const char*)(w123 + W123_GB + 8 * MiB) + (size_t)n * 1024 * 512, 2048, 512, 4, 128, 4, F.G, F.wg};
                    pg8::EpiBranch E{F.ws + WS_SCR2 + (size_t)F.wg * 262144, (bf16*)(F.ws + WS_MERGED), n == 0};
                    pg8::gemm_phase(F.lds, S, E, F.tid); }
            }
            SEAM(pb + 4);
        }
        if (SITE(6) && IN(pb + 5)) { SITE_BEGIN; const char* XBc = (const char*)(F.ws + WS_XB); (void)XBc; const unsigned char* w123 = F.ws + WS_W123; const unsigned char* w45 = F.ws + WS_W45 + (size_t)l * W45_STRIDE; (void)w123; (void)w45;
            pg8::SchedPlain S{(const char*)(F.ws + WS_MERGED), (const char*)(w123 + W123_WO), 2048, 2048, 16, 128, 4, F.G, F.wg};
            pg8::EpiG3 E{(bf16*)(F.ws + WS_XB)};
            pg8::gemm_phase(F.lds, S, E, F.tid);
            SEAM(pb + 5);
        }
        if (SITE(7) && IN(pb + 6)) { SITE_BEGIN; const char* XBc = (const char*)(F.ws + WS_XB); (void)XBc; const unsigned char* w123 = F.ws + WS_W123; const unsigned char* w45 = F.ws + WS_W45 + (size_t)l * W45_STRIDE; (void)w123; (void)w45; ln_phase(F, KA->in[11] + l * DM, KA->in[12] + l * DM, nullptr);
            if (l + 1 < DEPTH) convert_w123(F, KA->in[2] + (size_t)(l + 1) * DM * NIN, KA->in[9] + (size_t)(l + 1) * 4 * 256 * DM, KA->in[10] + (size_t)(l + 1) * DM * DM);
            SEAM(pb + 6); }
        if (SITE(8) && IN(pb + 7)) { SITE_BEGIN; const char* XBc = (const char*)(F.ws + WS_XB); (void)XBc; const unsigned char* w123 = F.ws + WS_W123; const unsigned char* w45 = F.ws + WS_W45 + (size_t)l * W45_STRIDE; (void)w123; (void)w45;
            pg8::SchedPlain S{XBc, (const char*)(w45 + W45_UP), 2048, 2048, 16, 128, 22, F.G, F.wg};
            pg8::EpiStore E{(bf16*)(F.ws + WS_UG), UGW};
            pg8::gemm_phase(F.lds, S, E, F.tid);
            SEAM(pb + 7);
        }
        if (SITE(9) && IN(pb + 8)) { SITE_BEGIN; const char* XBc = (const char*)(F.ws + WS_XB); (void)XBc; const unsigned char* w123 = F.ws + WS_W123; const unsigned char* w45 = F.ws + WS_W45 + (size_t)l * W45_STRIDE; (void)w123; (void)w45; ffn_act_phase(F, KA->in[14] + (size_t)l * 3 * DFF, KA->in[15] + (size_t)l * DFF); SEAM(pb + 8); }
        if (SITE(10) && IN(pb + 9)) { SITE_BEGIN;
            const unsigned char* w45 = F.ws + WS_W45 + (size_t)l * W45_STRIDE;
            {   pg8::SchedPlain S{(const char*)(F.ws + WS_PB + (size_t)l * M * PDIM * 2), (const char*)(w45 + W45_PP), 512, 512, 4, 128, 4, F.G, F.wg};
                pg8::EpiSlotStore E{F.dob + DO_SCR5 + (size_t)F.wg * 262144, 0};
                pg8::gemm_phase(F.lds, S, E, F.tid); }
            {   pg8::SchedPlain S{(const char*)(F.ws + WS_XB), (const char*)(w45 + W45_PG), 2048, 2048, 16, 128, 4, F.G, F.wg};
                pg8::EpiSlotMul E{F.dob + DO_SCR5 + (size_t)F.wg * 262144};
                pg8::gemm_phase(F.lds, S, E, F.tid); }
            SEAM(pb + 9);
        }
        if (SITE(11) && IN(pb + 10)) { SITE_BEGIN;
            const unsigned char* w45 = F.ws + WS_W45 + (size_t)l * W45_STRIDE;
            pg8::SchedG5b S{(const char*)(F.ws + WS_UG), (const char*)(w45 + W45_DN), F.G, F.wg};
            pg8::EpiG5b E{F.dob + DO_SCR5 + (size_t)F.wg * 262144, (bf16*)(F.ws + WS_XB)};
            pg8::gemm_phase(F.lds, S, E, F.tid);
            SEAM(pb + 10);
        }
        if (SITE(12) && IN(pb + 11)) { SITE_BEGIN; const char* XBc = (const char*)(F.ws + WS_XB); (void)XBc; const unsigned char* w123 = F.ws + WS_W123; const unsigned char* w45 = F.ws + WS_W45 + (size_t)l * W45_STRIDE; (void)w123; (void)w45; ln_phase(F, KA->in[19] + l * DM, KA->in[20] + l * DM, l == DEPTH - 1 ? KA->out : nullptr); SEAM(pb + 11); }
    }
#undef IN
#undef SEAM
}

extern "C" void kernel_launch(void* const* d_in, const int* in_sizes, int n_in, void* d_out, int out_size, void* d_ws, size_t ws_size, hipStream_t stream) {
    static int grid = 0;
    if (grid == 0) {
        if (n_in != 21 || out_size != M * DM || ws_size < WS_END) { fprintf(stderr, "kernel_launch: unexpected shapes (n_in %d out %d ws %zu)\n", n_in, out_size, ws_size); grid = -1; return; }
        int dev = 0, cus = 0, per_cu = 0;
        if (hipGetDevice(&dev) != hipSuccess || hipDeviceGetAttribute(&cus, hipDeviceAttributeMultiprocessorCount, dev) != hipSuccess) { grid = -1; return; }
        if (hipFuncSetAttribute((const void*)fwd_kernel, hipFuncAttributeMaxDynamicSharedMemorySize, LDS_BYTES) != hipSuccess) { grid = -1; return; }
        if (hipOccupancyMaxActiveBlocksPerMultiprocessor(&per_cu, (const void*)fwd_kernel, NWAVES * 64, LDS_BYTES) != hipSuccess || per_cu < 1)
            fprintf(stderr, "kernel_launch: occupancy query reports %d\n", per_cu);
        (void)hipGetLastError();
        grid = cus;
    }
    if (grid < 0) return;
    (void)hipMemsetAsync((char*)d_ws + WS_CTL, 0, CTL_ZERO_BYTES, stream);
    Args a{};
    for (int i = 0; i < 21; ++i) a.in[i] = (const float*)d_in[i];
    a.out = (float*)d_out; a.ws = (unsigned char*)d_ws;
#if MK_ONE_LAUNCH
    a.ph_lo = 0; a.ph_hi = N_PHASES;
    hipLaunchKernelGGL(fwd_kernel, dim3(grid), dim3(NWAVES * 64), LDS_BYTES, stream, a);
#else
    for (int p = 0; p < N_PHASES; ++p) { a.ph_lo = p; a.ph_hi = p + 1; hipLaunchKernelGGL(fwd_kernel, dim3(grid), dim3(NWAVES * 64), LDS_BYTES, stream, a); }
#endif
}
```

```cpp
#include <hip/hip_runtime.h>
#include <cstdio>
#include <cstdint>

#ifndef EXP
#define EXP 0
#endif
#ifndef EXPM
#define EXPM 15
#endif
#ifndef MK_ONE_LAUNCH
#define MK_ONE_LAUNCH 1
#endif

#define GAS __attribute__((address_space(1)))
#define LAS __attribute__((address_space(3)))
typedef unsigned short bf16;
typedef unsigned u32x4 __attribute__((ext_vector_type(4)));
typedef unsigned u32x2 __attribute__((ext_vector_type(2)));
typedef float f32x2 __attribute__((ext_vector_type(2)));
typedef float f32x4 __attribute__((ext_vector_type(4)));
typedef float f32x16 __attribute__((ext_vector_type(16)));
typedef short bf16x8 __attribute__((ext_vector_type(8)));
typedef short s16x4 __attribute__((ext_vector_type(4)));
typedef GAS unsigned gu32;

constexpr int BATCH = 4, SEQ = 8192, DM = 1024, M = BATCH * SEQ, DEPTH = 2;
constexpr int NIN = 7604, ZW = 3584, DFF = 2816, UGW = 5632, PDIM = 256;
constexpr float LN_EPS = 1e-5f;
constexpr float ALPHA = 1.41421356237f;
constexpr float LOG2E = 1.4426950408889634f;
constexpr int ZC_AQ = 0, ZC_AK = 256, ZC_AV = 512, ZC_BQ = 768, ZC_BK = 1024, ZC_BV = 1280, ZC_CQ = 1536, ZC_CK = 1792, ZC_CV = 2048, ZC_CG = 2304,
              ZC_DQ = 2560, ZC_DK = 2688, ZC_DV = 2816, ZC_DG = 3072, ZC_IQ = 3328, ZC_IK = 3456, ZC_IW = 3488, ZC_DA = 3504;
constexpr int SRC_MG = 3508;

constexpr size_t MiB = 1u << 20;
constexpr size_t WS_CTL = 0, CTL_ZERO_BYTES = 1 * MiB;
constexpr size_t WS_XB = 1 * MiB;
constexpr size_t WS_BIG = 65 * MiB;
constexpr size_t WS_Z = WS_BIG, WS_Y = WS_BIG + 224 * MiB, WS_MERGED = WS_BIG + 288 * MiB, WS_UG = WS_BIG;
constexpr size_t WS_MASK = WS_MERGED, WS_KVC = WS_MERGED + 32 * MiB, WS_KVD = WS_MERGED + 40 * MiB, WS_DE = WS_MERGED + 56 * MiB;
constexpr size_t WS_SCR2 = WS_Z;
constexpr size_t WS_W45 = 417 * MiB, W45_STRIDE = 19 * MiB;
constexpr size_t W45_UP = 0, W45_PG = 11 * MiB, W45_PP = 13 * MiB, W45_DN = 13 * MiB + 512 * 1024;
constexpr size_t WS_PB = 455 * MiB;
constexpr size_t WS_W123 = 487 * MiB;
constexpr size_t WS_END = 506 * MiB;
constexpr size_t W123_W1 = 0, W123_GB = 7 * MiB, W123_WO = 17 * MiB;
constexpr size_t DO_SCR5 = 0;

constexpr int CW_BAR = 4096, CW_WQ = 8448  , CW_KMAX = 8192;

constexpr int RING_BYTES = 131072;
constexpr int MISC_OFF = 131072 + 320;
constexpr int QST_OFF = 132096;
constexpr int LDS_BYTES = 147456;

constexpr int NWAVES = 8;

#define RLX_AGENT __ATOMIC_RELAXED, __HIP_MEMORY_SCOPE_AGENT
__device__ __forceinline__ unsigned f2bf(float f) { unsigned u = __builtin_bit_cast(unsigned, f); return (u + 0x7fffu + ((u >> 16) & 1u)) >> 16; }
typedef __bf16 bf16x2_t __attribute__((ext_vector_type(2)));
__device__ __forceinline__ unsigned pk2(float lo, float hi) { const f32x2 v = {lo, hi}; const bf16x2_t b = __builtin_convertvector(v, bf16x2_t); return __builtin_bit_cast(unsigned, b); }
__device__ __forceinline__ float bflo(unsigned w) { return __uint_as_float(w << 16); }
__device__ __forceinline__ float bfhi(unsigned w) { return __uint_as_float(w & 0xffff0000u); }
__device__ __forceinline__ float bf1(bf16 b) { return __uint_as_float((unsigned)b << 16); }
__device__ __forceinline__ float sigmoidf_(float x) { return __builtin_amdgcn_rcpf(1.0f + __builtin_amdgcn_exp2f(-LOG2E * x)); }
__device__ __forceinline__ float shx(float v, int lane, int m) { return __int_as_float(__builtin_amdgcn_ds_bpermute((lane ^ m) << 2, __float_as_int(v))); }
__device__ __forceinline__ unsigned shup(unsigned v, int lane, int o) { return (unsigned)__builtin_amdgcn_ds_bpermute((lane - o) << 2, (int)v); }
__device__ __forceinline__ float wave_sum(float v, int lane) {
#pragma unroll
    for (int o = 1; o < 64; o <<= 1) v += shx(v, lane, o);
    return v;
}

#define XB_TMO      128
#define XB_XCNT(j)  (256  + 64 * (j))
#define XB_XSUB(j)  (1280 + 64 * (j))
#define XB_XGEN(j)  (2304 + 64 * (j))
#define XB_TOP      3328
#define XB_TOPGEN   3392
#define XCD_BAR_WORDS 3456
#define XB_SPIN_CAP (1u << 22)

__device__ __forceinline__ unsigned xb_ld(unsigned* p)              { return __hip_atomic_load(p, __ATOMIC_RELAXED, __HIP_MEMORY_SCOPE_AGENT); }
__device__ __forceinline__ unsigned xb_add(unsigned* p, unsigned v) { return __hip_atomic_fetch_add(p, v, __ATOMIC_RELAXED, __HIP_MEMORY_SCOPE_AGENT); }
__device__ __forceinline__ unsigned xb_xcc_id() { return (unsigned)__builtin_amdgcn_s_getreg((3 << 11) | 20) & 0xFu; }
#define XB_SPIN(cond, bar) do { unsigned _sp = 0; while (cond) { __builtin_amdgcn_s_sleep(1); \
    if ((++_sp & 255u) == 0u) { if (xb_ld(&(bar)[XB_TMO])) break; if (_sp > XB_SPIN_CAP) { atomicAdd(&(bar)[XB_TMO], 1u); break; } } } } while (0)

struct XcdBarrier { unsigned* bar; unsigned x; volatile LAS unsigned* st; };

__device__ __forceinline__ XcdBarrier xcd_barrier_post(unsigned* bar, volatile LAS unsigned* st) {
    XcdBarrier b; b.bar = bar; b.x = xb_xcc_id(); b.st = st;
    if (threadIdx.x == 0) (void)xb_add(&bar[XB_XCNT(b.x)], 1u);
    return b;
}
__device__ __forceinline__ void xcd_barrier_complete(unsigned* bar, unsigned x, unsigned& nloc, unsigned& nx) {
    const unsigned G = gridDim.x * gridDim.y * gridDim.z;
    unsigned sum, cnt, mine, sp = 0u;
    for (;;) {
        sum = 0u; cnt = 0u; mine = 0u;
#pragma unroll
        for (unsigned j = 0; j < 16; ++j) { const unsigned c = xb_ld(&bar[XB_XCNT(j)]); sum += c; cnt += (c > 0u) ? 1u : 0u; mine = (j == x) ? c : mine; }
        if (sum == G) break;
        __builtin_amdgcn_s_sleep(1);
        if ((++sp & 255u) == 0u) { if (xb_ld(&bar[XB_TMO])) break; if (sp > XB_SPIN_CAP) { atomicAdd(&bar[XB_TMO], 1u); break; } }
    }
    nloc = mine > 0u ? mine : 1u; nx = cnt > 0u ? cnt : 1u;
}
__device__ __forceinline__ void xcd_barrier(const XcdBarrier& b, const bool leader_thread) {
    asm volatile("s_waitcnt vmcnt(0)" ::: "memory");
    __syncthreads();
    if (leader_thread) {
        unsigned* bar = b.bar;
        __builtin_amdgcn_s_waitcnt(0);
        unsigned nloc = b.st[0], nx = b.st[1];
        if (nloc == 0u) { xcd_barrier_complete(bar, b.x, nloc, nx); b.st[0] = nloc; b.st[1] = nx; }
        const unsigned old = xb_add(&bar[XB_XSUB(b.x)], 1u);
        const unsigned gen = old / nloc;
        if (old + 1u == (gen + 1u) * nloc) {
            __builtin_amdgcn_fence(__ATOMIC_RELEASE, "agent");
            asm volatile("s_waitcnt vmcnt(0)" ::: "memory");
            const unsigned og = xb_add(&bar[XB_TOP], 1u);
            const unsigned tg = og / nx;
            if (og + 1u == (tg + 1u) * nx) xb_add(&bar[XB_TOPGEN], 1u);
            else XB_SPIN(xb_ld(&bar[XB_TOPGEN]) == tg, bar);
            __builtin_amdgcn_fence(__ATOMIC_ACQUIRE, "agent");
            xb_add(&bar[XB_XGEN(b.x)], 1u);
            asm volatile("s_waitcnt vmcnt(0)" ::: "memory");
        } else {
            XB_SPIN(xb_ld(&bar[XB_XGEN(b.x)]) == gen, bar);
            __builtin_amdgcn_fence(__ATOMIC_ACQUIRE, "agent");
            asm volatile("s_waitcnt vmcnt(0)" ::: "memory");
        }
    }
    __syncthreads();
}

namespace pg8 {
constexpr int BM = 256, BK = 64, HALF = 128, HTB = HALF * BK * 2, STAGE_BYTES = 8 * HTB, NXCD = 8, WGM = 8;
__device__ __forceinline__ int lds_byte(int r, int c) { const int st = (r >> 4) * 2 + (c >> 5), rr = r & 15, cc = c & 31, ob = rr * 64 + cc * 2; return st * 1024 + (ob ^ (((ob >> 9) & 1) << 5)); }
__device__ __forceinline__ void stage_rc(int b, int& R, int& C) { const int st = b / 1024, sb = b % 1024, swz = sb ^ (((sb >> 9) & 1) << 5); R = (st >> 1) * 16 + swz / 64; C = (st & 1) * 32 + (swz % 64) / 2; }
__device__ __forceinline__ int perm32(int rho) { const int n = rho >> 4, i = rho & 15; return 8 * (i >> 2) + 4 * n + (i & 3); }

struct UnitD { const char* A; const char* B; int lda2, ldb2, nt, pm, pn, kind; };

__device__ __forceinline__ void tile_map(int L, int nM, int nN, int& pm, int& pn) {
    const int nwg = nM * nN; int wgid = L;
    { const int q = nwg / NXCD, r = nwg % NXCD, xcd = wgid % NXCD, off = wgid / NXCD; wgid = (xcd < r ? xcd * (q + 1) : r * (q + 1) + (xcd - r) * q) + off; }
    const int nig = WGM * nN, gid = wgid / nig, fm = gid * WGM, gsz = (nM - fm) < WGM ? (nM - fm) : WGM;
    pm = fm + ((wgid % nig) % gsz); pn = (wgid % nig) / gsz;
}

template <class Epi, class Sched>
__device__ __forceinline__ void gemm_phase(LAS unsigned char* lds, const Sched& S, const Epi& E, const int tid) {
    const int wid = __builtin_amdgcn_readfirstlane(tid >> 6), lane = tid & 63, wr = wid >> 2, wc = wid & 3, fr = lane & 15, fq = lane >> 4;
    int sR, sRb, sC2;
    { int R, C; stage_rc(tid * 16, R, C); sR = R; sRb = (R & ~31) + perm32(R & 31); sC2 = C * 2; }
    const size_t kstep = (size_t)(BK * 2);
    const unsigned ldsw = (unsigned)wid * 1024u;
    const int aoff = lds_byte(wr * 64 + fr, fq * 8), boff = lds_byte(wc * 32 + fr, fq * 8);
#define PG8_SA(b, h) (((b) * 2 + (h)) * HTB)
#define PG8_SB(b, h) ((4 + (b) * 2 + (h)) * HTB)
#define PG8_STAGE(bufoff, gbase, rows, pitch) do { const unsigned _o = (unsigned)((rows) * (pitch) + sC2); _Pragma("unroll") for (int _i = 0; _i < 2; ++_i) \
        __builtin_amdgcn_global_load_lds((const unsigned*)((const char*)(gbase) + (size_t)(_i * 64) * (pitch) + _o), (LAS unsigned*)(lds + (bufoff) + ldsw + _i * 8192), 16, 0, 0); } while (0)
#define PG8_LDA(dst, b, h) do { _Pragma("unroll") for (int m = 0; m < 4; ++m) _Pragma("unroll") for (int k = 0; k < 2; ++k) dst[m][k] = *(const LAS bf16x8*)(lds + PG8_SA(b, h) + aoff + m * 2048 + k * 1024); } while (0)
#define PG8_LDB(dst, b, h) do { _Pragma("unroll") for (int n = 0; n < 2; ++n) _Pragma("unroll") for (int k = 0; k < 2; ++k) dst[n][k] = *(const LAS bf16x8*)(lds + PG8_SB(b, h) + boff + n * 2048 + k * 1024); } while (0)
#define PG8_MMA(ai, bj, At, Bt) do { __builtin_amdgcn_s_setprio(1); _Pragma("unroll") for (int m = 0; m < 4; ++m) _Pragma("unroll") for (int n = 0; n < 2; ++n) _Pragma("unroll") for (int k = 0; k < 2; ++k) \
        acc[ai][bj][m][n] = __builtin_amdgcn_mfma_f32_16x16x32_bf16(Bt[n][k], At[m][k], acc[ai][bj][m][n], 0, 0, 0); __builtin_amdgcn_s_setprio(0); } while (0)
#define PG8_WAIT_V(n) asm volatile("s_waitcnt vmcnt(" #n ")" ::: "memory")
#define PG8_WAIT_L(n) asm volatile("s_waitcnt lgkmcnt(" #n ")" ::: "memory")
#define PG8_BAR __builtin_amdgcn_s_barrier()
#define PG8_SCHED __builtin_amdgcn_sched_barrier(0)
    UnitD cur, nxt; int ui = 0;
    if (!S.next(0, cur)) return;
    f32x4 acc[2][2][4][2];
#pragma unroll
    for (int a = 0; a < 2; ++a)
#pragma unroll
        for (int b = 0; b < 2; ++b)
#pragma unroll
            for (int m = 0; m < 4; ++m)
#pragma unroll
                for (int n = 0; n < 2; ++n) acc[a][b][m][n] = (f32x4){0.f, 0.f, 0.f, 0.f};
    bf16x8 At[4][2], B0[2][2], B1[2][2];
    const char* cA = cur.A; const char* cB = cur.B;
    int pA = cur.lda2, pB = cur.ldb2;
    PG8_STAGE(PG8_SB(0, 0), cB, sRb, pB); PG8_STAGE(PG8_SB(0, 1), cB + (size_t)HALF * pB, sRb, pB); PG8_STAGE(PG8_SA(0, 0), cA, sR, pA); PG8_STAGE(PG8_SA(0, 1), cA + (size_t)HALF * pA, sR, pA);
    if (wr == 1) PG8_BAR;
    PG8_WAIT_V(2); PG8_BAR;
    PG8_STAGE(PG8_SB(1, 0), cB + kstep, sRb, pB); PG8_STAGE(PG8_SA(1, 0), cA + kstep, sR, pA); PG8_STAGE(PG8_SB(1, 1), cB + (size_t)HALF * pB + kstep, sRb, pB);
    PG8_WAIT_V(6); PG8_BAR;
    for (;;) {
        const bool has_next = S.next(ui + 1, nxt);
        if (!has_next) nxt = cur;
        const char* nA = nxt.A; const char* nB = nxt.B;
        const int nt = cur.nt;
        for (int t = 0; t < nt; t += 2) {
            const bool last = (t == nt - 2);
            const char* a1 = cA + (size_t)(t + 1) * kstep + (size_t)HALF * pA;
            const char* a2 = last ? nA : cA + (size_t)(t + 2) * kstep; const char* b2 = last ? nB : cB + (size_t)(t + 2) * kstep;
            const int p2A = last ? nxt.lda2 : pA, p2B = last ? nxt.ldb2 : pB;
            const char* a2h = a2 + (size_t)HALF * p2A; const char* b2h = b2 + (size_t)HALF * p2B;
            PG8_LDB(B0, 0, 0); PG8_LDB(B1, 0, 1); PG8_SCHED; PG8_LDA(At, 0, 0); PG8_STAGE(PG8_SA(1, 1), a1, sR, pA);
            PG8_WAIT_V(8); PG8_WAIT_L(0); PG8_BAR; PG8_MMA(0, 0, At, B0); PG8_MMA(0, 1, At, B1); PG8_BAR; PG8_SCHED;
            PG8_LDA(At, 0, 1); PG8_STAGE(PG8_SB(0, 0), b2, sRb, p2B); PG8_STAGE(PG8_SB(0, 1), b2h, sRb, p2B); PG8_STAGE(PG8_SA(0, 0), a2, sR, p2A);
            PG8_WAIT_V(8); PG8_WAIT_L(0); PG8_BAR; PG8_MMA(1, 0, At, B0); PG8_MMA(1, 1, At, B1); PG8_BAR; PG8_SCHED;
            PG8_LDB(B0, 1, 0); PG8_LDB(B1, 1, 1); PG8_SCHED; PG8_LDA(At, 1, 0); PG8_STAGE(PG8_SA(0, 1), a2h, sR, p2A);
            PG8_WAIT_V(8); PG8_WAIT_L(0); PG8_BAR; PG8_MMA(0, 0, At, B0); PG8_MMA(0, 1, At, B1); PG8_BAR; PG8_SCHED;
            PG8_LDA(At, 1, 1); PG8_STAGE(PG8_SB(1, 0), b2 + kstep, sRb, p2B); PG8_STAGE(PG8_SB(1, 1), b2h + kstep, sRb, p2B); PG8_STAGE(PG8_SA(1, 0), a2 + kstep, sR, p2A);
            PG8_WAIT_V(8); PG8_WAIT_L(0); PG8_BAR; PG8_MMA(1, 0, At, B0); PG8_MMA(1, 1, At, B1); PG8_BAR; PG8_SCHED;
        }
        if (wr == 0) PG8_BAR;
        { int l2; asm volatile("v_mbcnt_lo_u32_b32 %0, -1, 0\n\tv_mbcnt_hi_u32_b32 %0, -1, %0" : "=v"(l2)); E(acc, cur, wr, wc, l2 & 15, l2 >> 4, wid * 64 + l2); asm volatile("s_waitcnt vmcnt(0)" ::: "memory"); }
        if (!has_next) break;
#pragma unroll
        for (int a = 0; a < 2; ++a)
#pragma unroll
            for (int b = 0; b < 2; ++b)
#pragma unroll
                for (int m = 0; m < 4; ++m)
#pragma unroll
                    for (int n = 0; n < 2; ++n) acc[a][b][m][n] = (f32x4){0.f, 0.f, 0.f, 0.f};
        cur = nxt; cA = nA; cB = nB; pA = cur.lda2; pB = cur.ldb2;
        ++ui;
        if (wr == 1) PG8_BAR;
    }
    PG8_WAIT_V(0);
    PG8_BAR;
#undef PG8_SA
#undef PG8_SB
#undef PG8_STAGE
#undef PG8_LDA
#undef PG8_LDB
#undef PG8_MMA
#undef PG8_WAIT_V
#undef PG8_WAIT_L
#undef PG8_BAR
#undef PG8_SCHED
}

struct SchedPlain {
    const char* A; const char* B; int lda2, ldb2, nt, nM, nN, G, c;
    __device__ __forceinline__ bool next(int i, UnitD& u) const {
        const long L = (long)i * G + c; if (L >= (long)nM * nN) return false;
        int pm, pn; tile_map((int)L, nM, nN, pm, pn);
        u.A = A + (size_t)pm * 256 * lda2; u.B = B + (size_t)pn * 256 * ldb2; u.lda2 = lda2; u.ldb2 = ldb2; u.nt = nt; u.pm = pm; u.pn = pn; u.kind = i; return true;
    }
};
struct SchedG5b {
    const char* A; const char* B; int G, c;
    __device__ __forceinline__ bool next(int i, UnitD& u) const {
        const long L = (long)i * G + c; if (L >= 128 * 4) return false;
        int pm, pn; tile_map((int)L, 128, 4, pm, pn);
        u.A = A + (size_t)pm * 256 * (UGW * 2); u.lda2 = UGW * 2; u.B = B + (size_t)pn * 256 * (DFF * 2); u.ldb2 = DFF * 2; u.nt = 44; u.pm = pm; u.pn = pn; u.kind = i; return true;
    }
};

#define EPI_LOOP for (int ai = 0; ai < 2; ++ai) _Pragma("unroll") for (int m = 0; m < 4; ++m) _Pragma("unroll") for (int bj = 0; bj < 2; ++bj)
struct EpiStore {
    bf16* O; int ldc;
    __device__ __forceinline__ void operator()(const f32x4 (&acc)[2][2][4][2], const UnitD& u, int wr, int wc, int fr, int fq, int tid) const {
        const int row0 = u.pm * BM + wr * 64 + fr, col0 = u.pn * BM + wc * 32 + 8 * fq;
#pragma unroll
        EPI_LOOP { const f32x4 v0 = acc[ai][bj][m][0], v1 = acc[ai][bj][m][1];
            u32x4 w; w.x = pk2(v0[0], v0[1]); w.y = pk2(v0[2], v0[3]); w.z = pk2(v1[0], v1[1]); w.w = pk2(v1[2], v1[3]);
            *(u32x4*)(O + (size_t)(row0 + ai * HALF + m * 16) * ldc + col0 + bj * HALF) = w; }
    }
};
struct EpiSlotStore {
    unsigned char* sc_; int act;
    __device__ __forceinline__ void operator()(const f32x4 (&acc)[2][2][4][2], const UnitD& u, int wr, int wc, int fr, int fq, int tid) const {
        unsigned loff = (unsigned)tid * 16u; asm volatile("" : "+v"(loff));
        unsigned char* sc = sc_ + (size_t)u.kind * 131072 + loff;
#pragma unroll
        EPI_LOOP { const int q = (ai * 2 + bj) * 4 + m; f32x4 v0 = acc[ai][bj][m][0], v1 = acc[ai][bj][m][1];
            if (act) { v0 = (f32x4){sigmoidf_(v0[0]), sigmoidf_(v0[1]), sigmoidf_(v0[2]), sigmoidf_(v0[3])}; v1 = (f32x4){sigmoidf_(v1[0]), sigmoidf_(v1[1]), sigmoidf_(v1[2]), sigmoidf_(v1[3])}; }
            u32x4 w; w.x = pk2(v0[0], v0[1]); w.y = pk2(v0[2], v0[3]); w.z = pk2(v1[0], v1[1]); w.w = pk2(v1[2], v1[3]);
            *(u32x4*)(sc + (size_t)q * 8192) = w; }
    }
};
struct EpiSlotMul {
    unsigned char* sc_;
    __device__ __forceinline__ void operator()(const f32x4 (&acc)[2][2][4][2], const UnitD& u, int wr, int wc, int fr, int fq, int tid) const {
        unsigned loff = (unsigned)tid * 16u; asm volatile("" : "+v"(loff));
        unsigned char* sc = sc_ + (size_t)u.kind * 131072 + loff;
#pragma unroll
        EPI_LOOP { const int q = (ai * 2 + bj) * 4 + m; const f32x4 v0 = acc[ai][bj][m][0], v1 = acc[ai][bj][m][1];
            u32x4* sp = (u32x4*)(sc + (size_t)q * 8192); const u32x4 p = *sp;
            u32x4 w; w.x = pk2(sigmoidf_(v0[0]) * bflo(p.x), sigmoidf_(v0[1]) * bfhi(p.x)); w.y = pk2(sigmoidf_(v0[2]) * bflo(p.y), sigmoidf_(v0[3]) * bfhi(p.y));
            w.z = pk2(sigmoidf_(v1[0]) * bflo(p.z), sigmoidf_(v1[1]) * bfhi(p.z)); w.w = pk2(sigmoidf_(v1[2]) * bflo(p.w), sigmoidf_(v1[3]) * bfhi(p.w));
            *sp = w;
            if (m & 1) asm volatile("" ::: "memory"); }
    }
};
struct EpiBranch {
    const unsigned char* sc_; bf16* MG; int first;
    __device__ __forceinline__ void operator()(const f32x4 (&acc)[2][2][4][2], const UnitD& u, int wr, int wc, int fr, int fq, int tid) const {
        const int row0 = u.pm * BM + wr * 64 + fr, col0 = u.pn * BM + wc * 32 + 8 * fq;
        unsigned loff = (unsigned)tid * 16u; asm volatile("" : "+v"(loff));
        const unsigned char* sc = sc_ + (size_t)u.kind * 131072 + loff;
#pragma unroll
        EPI_LOOP { const int q = (ai * 2 + bj) * 4 + m; const f32x4 v0 = acc[ai][bj][m][0], v1 = acc[ai][bj][m][1];
            const u32x4 g = *(const u32x4*)(sc + (size_t)q * 8192);
            u32x4* p = (u32x4*)(MG + (size_t)(row0 + ai * HALF + m * 16) * DM + col0 + bj * HALF);
            f32x4 t0 = (f32x4){bflo(g.x) * v0[0], bfhi(g.x) * v0[1], bflo(g.y) * v0[2], bfhi(g.y) * v0[3]};
            f32x4 t1 = (f32x4){bflo(g.z) * v1[0], bfhi(g.z) * v1[1], bflo(g.w) * v1[2], bfhi(g.w) * v1[3]};
            if (!first) { const u32x4 x = *p; t0 += (f32x4){bflo(x.x), bfhi(x.x), bflo(x.y), bfhi(x.y)}; t1 += (f32x4){bflo(x.z), bfhi(x.z), bflo(x.w), bfhi(x.w)}; }
            u32x4 w; w.x = pk2(t0[0], t0[1]); w.y = pk2(t0[2], t0[3]); w.z = pk2(t1[0], t1[1]); w.w = pk2(t1[2], t1[3]);
            *p = w;
            if (m & 1) asm volatile("" ::: "memory"); }
    }
};
struct EpiG3 {
    bf16* XB;
    __device__ __forceinline__ void operator()(const f32x4 (&acc)[2][2][4][2], const UnitD& u, int wr, int wc, int fr, int fq, int tid) const {
        const int row0 = u.pm * BM + wr * 64 + fr, col0 = u.pn * BM + wc * 32 + 8 * fq;
#pragma unroll
        EPI_LOOP { const f32x4 v0 = acc[ai][bj][m][0], v1 = acc[ai][bj][m][1];
            u32x4* p = (u32x4*)(XB + (size_t)(row0 + ai * HALF + m * 16) * DM + col0 + bj * HALF); const u32x4 x = *p;
            u32x4 w; w.x = pk2(ALPHA * bflo(x.x) + v0[0], ALPHA * bfhi(x.x) + v0[1]); w.y = pk2(ALPHA * bflo(x.y) + v0[2], ALPHA * bfhi(x.y) + v0[3]);
            w.z = pk2(ALPHA * bflo(x.z) + v1[0], ALPHA * bfhi(x.z) + v1[1]); w.w = pk2(ALPHA * bflo(x.w) + v1[2], ALPHA * bfhi(x.w) + v1[3]);
            *p = w; }
    }
};
struct EpiG5b {
    const unsigned char* esc_; bf16* XB;
    __device__ __forceinline__ void operator()(const f32x4 (&acc)[2][2][4][2], const UnitD& u, int wr, int wc, int fr, int fq, int tid) const {
        const int row0 = u.pm * BM + wr * 64 + fr, col0 = u.pn * BM + wc * 32 + 8 * fq;
        unsigned loff = (unsigned)tid * 16u; asm volatile("" : "+v"(loff));
        const unsigned char* esc = esc_ + (size_t)u.kind * 131072 + loff;
#pragma unroll
        EPI_LOOP { const int q = (ai * 2 + bj) * 4 + m; const f32x4 v0 = acc[ai][bj][m][0], v1 = acc[ai][bj][m][1];
            const u32x4 e = *(const u32x4*)(esc + (size_t)q * 8192);
            u32x4* p = (u32x4*)(XB + (size_t)(row0 + ai * HALF + m * 16) * DM + col0 + bj * HALF); const u32x4 x = *p;
            u32x4 w; w.x = pk2(ALPHA * bflo(x.x) + v0[0] + bflo(e.x), ALPHA * bfhi(x.x) + v0[1] + bfhi(e.x)); w.y = pk2(ALPHA * bflo(x.y) + v0[2] + bflo(e.y), ALPHA * bfhi(x.y) + v0[3] + bfhi(e.y));
            w.z = pk2(ALPHA * bflo(x.z) + v1[0] + bflo(e.z), ALPHA * bfhi(x.z) + v1[1] + bfhi(e.z)); w.w = pk2(ALPHA * bflo(x.w) + v1[2] + bflo(e.w), ALPHA * bfhi(x.w) + v1[3] + bfhi(e.w));
            *p = w;
            if (m & 1) asm volatile("" ::: "memory"); }
    }
};
}

struct Frame {
    LAS unsigned char* lds;
    int tid, lane, wave, G, wg;
    unsigned char* ws; unsigned char* dob;
};
struct Args { const float* in[21]; float* out; unsigned char* ws; int ph_lo, ph_hi, sub, pad; };

__device__ __forceinline__ int z_src(int n, float& sc) {
    sc = 1.f;
    if (n < 768) { if (n < 256) sc = 0.17677669529663687f * LOG2E; return n; }
    if (n < 1536) { if (n < 1024) sc = 0.125f * LOG2E; return n; }
    if (n < 2560) { if (n >= 1792 && n < 2048) sc = 0.125f; return 1700 + (n - 1536); }
    if (n < 2816) { if (n < 2688) sc = 0.17677669529663687f; return 2724 + (n - 2560); }
    if (n < 3072) return 2980 + (n - 2816);
    if (n < 3328) return 3252 + (n - 3072);
    if (n < 3456) return 1536 + (n - 3328);
    if (n < 3488) return 1664 + (n - 3456);
    if (n < 3492) return 1696 + (n - 3488);
    if (n >= 3504 && n < 3520) return 3236 + (n - 3504);
    return -1;
}
template <int MODE>
__device__ __forceinline__ void transpose_item(const float* W, int Nsrc, int soff, bf16* WT, int dpitch, int dcol0, int k0, int n0, LAS float* scr, int lane) {
    const int nn = lane & 31; float sc = 1.f; int s;
    if (MODE == 1) s = z_src(n0 + nn, sc); else s = soff + n0 + nn;
#pragma unroll 8
    for (int i = 0; i < 32; ++i) { const int kk = 2 * i + (lane >> 5); scr[kk * 33 + nn] = (s >= 0) ? W[(size_t)(k0 + kk) * Nsrc + s] * sc : 0.f; }
    asm volatile("s_waitcnt lgkmcnt(0)" ::: "memory");
    const int c = lane & 7;
#pragma unroll
    for (int j = 0; j < 4; ++j) { const int n = (lane >> 3) + 8 * j; const LAS float* sp = scr + (8 * c) * 33 + n;
        u32x4 o; o.x = pk2(sp[0 * 33], sp[1 * 33]); o.y = pk2(sp[2 * 33], sp[3 * 33]); o.z = pk2(sp[4 * 33], sp[5 * 33]); o.w = pk2(sp[6 * 33], sp[7 * 33]);
        *(u32x4*)(WT + (size_t)(n0 + n) * dpitch + dcol0 + k0 + 8 * c) = o; }
    asm volatile("s_waitcnt lgkmcnt(0)" ::: "memory");
}
typedef __attribute__((address_space(4))) const struct Args* KArgPtr;
__device__ __forceinline__ void convert_w123(Frame& F, const float* w_in, const float* w_branch, const float* w_out) {
    LAS float* scr = (LAS float*)(F.lds + F.wave * 16384);
    const int gw = F.wg * NWAVES + F.wave, NGW = F.G * NWAVES;
    constexpr int I1 = 16 * 112, I2 = 16 * 128, I3 = 4 * 128, I4 = 16 * 32;
    unsigned char* w123 = F.ws + WS_W123;
    for (int it = gw; it < I1 + I2 + I3 + I4; it += NGW) {
        int r = it;
        if (r < I1) { transpose_item<1>(w_in, NIN, 0, (bf16*)(w123 + W123_W1), 1024, 0, 64 * (r / 112), 32 * (r % 112), scr, F.lane); continue; } r -= I1;
        if (r < I2) { transpose_item<0>(w_in, NIN, SRC_MG, (bf16*)(w123 + W123_GB), 1024, 0, 64 * (r / 128), 32 * (r % 128), scr, F.lane); continue; } r -= I2;
        if (r < I3) { const int n = r / 128, rr = r % 128; transpose_item<0>(w_branch + (size_t)n * 256 * DM, DM, 0, (bf16*)(w123 + W123_GB + 8 * MiB) + (size_t)n * 1024 * 256, 256, 0, 64 * (rr / 32), 32 * (rr % 32), scr, F.lane); continue; } r -= I3;
        transpose_item<0>(w_out, DM, 0, (bf16*)(w123 + W123_WO), 1024, 0, 64 * (r / 32), 32 * (r % 32), scr, F.lane);
    }
}
__device__ __forceinline__ void p0_prologue(Frame& F, __attribute__((address_space(4))) const Args* Ap) {
    LAS float* scr = (LAS float*)(F.lds + F.wave * 16384);
    const int gw = F.wg * NWAVES + F.wave, NGW = F.G * NWAVES;
    constexpr int I5 = 16 * 176, I6 = 16 * 32, I7 = 4 * 32, I8 = 44 * 32;
    constexpr int IL = I5 + I6 + I7 + I8;
    for (int it = gw; it < 2 * IL; it += NGW) {
        const int l = it / IL; int r = it - l * IL;
        unsigned char* w45 = F.ws + WS_W45 + (size_t)l * W45_STRIDE;
        if (r < I5) { transpose_item<0>(Ap->in[13] + (size_t)l * DM * UGW, UGW, 0, (bf16*)(w45 + W45_UP), 1024, 0, 64 * (r / 176), 32 * (r % 176), scr, F.lane); continue; } r -= I5;
        if (r < I6) { transpose_item<0>(Ap->in[17] + (size_t)l * DM * DM, DM, 0, (bf16*)(w45 + W45_PG), 1024, 0, 64 * (r / 32), 32 * (r % 32), scr, F.lane); continue; } r -= I6;
        if (r < I7) { transpose_item<0>(Ap->in[18] + (size_t)l * PDIM * DM, DM, 0, (bf16*)(w45 + W45_PP), 256, 0, 64 * (r / 32), 32 * (r % 32), scr, F.lane); continue; } r -= I7;
        transpose_item<0>(Ap->in[16] + (size_t)l * DFF * DM, DM, 0, (bf16*)(w45 + W45_DN), DFF, 0, 64 * (r / 32), 32 * (r % 32), scr, F.lane);
    }
    convert_w123(F, Ap->in[2], Ap->in[9], Ap->in[10]);
    {   const size_t n8 = (size_t)M * DM / 8; const f32x4* src = (const f32x4*)Ap->in[0]; u32x4* dst = (u32x4*)(F.ws + WS_XB);
        for (size_t i = (size_t)F.wg * 512 + F.tid; i < n8; i += (size_t)F.G * 512) { const f32x4 a = src[2 * i], b = src[2 * i + 1]; u32x4 o; o.x = pk2(a[0], a[1]); o.y = pk2(a[2], a[3]); o.z = pk2(b[0], b[1]); o.w = pk2(b[2], b[3]); dst[i] = o; } }
    {   const size_t n8 = (size_t)DEPTH * M * PDIM / 8; const f32x4* src = (const f32x4*)Ap->in[1]; u32x4* dst = (u32x4*)(F.ws + WS_PB);
        for (size_t i = (size_t)F.wg * 512 + F.tid; i < n8; i += (size_t)F.G * 512) { const f32x4 a = src[2 * i], b = src[2 * i + 1]; u32x4 o; o.x = pk2(a[0], a[1]); o.y = pk2(a[2], a[3]); o.z = pk2(b[0], b[1]); o.w = pk2(b[2], b[3]); dst[i] = o; } }
}

__device__ __forceinline__ void ln_phase(Frame& F, const float* w, const float* bvec, float* outf) {
    const int gw = F.wg * NWAVES + F.wave, NGW = F.G * NWAVES;
    bf16* XB = (bf16*)(F.ws + WS_XB);
    for (int row = gw; row < M; row += NGW) {
        u32x4* p = (u32x4*)(XB + (size_t)row * DM) + F.lane;
        const u32x4 a = p[0], b = p[64];
        float v[16] = {bflo(a.x), bfhi(a.x), bflo(a.y), bfhi(a.y), bflo(a.z), bfhi(a.z), bflo(a.w), bfhi(a.w), bflo(b.x), bfhi(b.x), bflo(b.y), bfhi(b.y), bflo(b.z), bfhi(b.z), bflo(b.w), bfhi(b.w)};
        float s = 0.f;
#pragma unroll
        for (int i = 0; i < 16; ++i) s += v[i];
        const float mean = wave_sum(s, F.lane) * (1.f / DM); float q = 0.f;
#pragma unroll
        for (int i = 0; i < 16; ++i) { v[i] -= mean; q += v[i] * v[i]; }
        const float rstd = 1.f / sqrtf(wave_sum(q, F.lane) * (1.f / DM) + LN_EPS);
        const int c0 = F.lane * 8, c1 = 512 + F.lane * 8;
        const f32x4 w0 = *(const f32x4*)(w + c0), w1 = *(const f32x4*)(w + c0 + 4), w2 = *(const f32x4*)(w + c1), w3 = *(const f32x4*)(w + c1 + 4);
        const f32x4 b0 = *(const f32x4*)(bvec + c0), b1 = *(const f32x4*)(bvec + c0 + 4), b2 = *(const f32x4*)(bvec + c1), b3 = *(const f32x4*)(bvec + c1 + 4);
        f32x4 y0, y1, y2, y3;
#pragma unroll
        for (int i = 0; i < 4; ++i) { y0[i] = v[i] * rstd * w0[i] + b0[i]; y1[i] = v[4 + i] * rstd * w1[i] + b1[i]; y2[i] = v[8 + i] * rstd * w2[i] + b2[i]; y3[i] = v[12 + i] * rstd * w3[i] + b3[i]; }
        u32x4 o0, o1; o0.x = pk2(y0[0], y0[1]); o0.y = pk2(y0[2], y0[3]); o0.z = pk2(y1[0], y1[1]); o0.w = pk2(y1[2], y1[3]);
        o1.x = pk2(y2[0], y2[1]); o1.y = pk2(y2[2], y2[3]); o1.z = pk2(y3[0], y3[1]); o1.w = pk2(y3[2], y3[3]);
        p[0] = o0; p[64] = o1;
        if (outf) { f32x4* op = (f32x4*)(outf + (size_t)row * DM); op[2 * F.lane] = y0; op[2 * F.lane + 1] = y1; op[128 + 2 * F.lane] = y2; op[128 + 2 * F.lane + 1] = y3; }
    }
}

__device__ __forceinline__ float gelu_tanh_(float y) { const float t = 1.5957691216057308f * (y + 0.044715f * y * y * y); return y * __builtin_amdgcn_rcpf(1.0f + __builtin_amdgcn_exp2f(-LOG2E * t)); }
__device__ __forceinline__ void up8(const u32x4 w, float (&v)[8]) { v[0] = bflo(w.x); v[1] = bfhi(w.x); v[2] = bflo(w.y); v[3] = bfhi(w.y); v[4] = bflo(w.z); v[5] = bfhi(w.z); v[6] = bflo(w.w); v[7] = bfhi(w.w); }
__device__ __forceinline__ void ffn_act_phase(Frame& F, const float* cw, const float* cb) {
    bf16* UG = (bf16*)(F.ws + WS_UG);
    constexpr int NCG = DFF / 8, NRB = M / 64;
    for (int task = F.wg * 512 + F.tid; task < NCG * NRB; task += F.G * 512) {
        const int rb = task / NCG, cg = task - rb * NCG; const int t0 = rb * 64, c0 = cg * 8;
        float w0[8], w1[8], w2[8], bb[8];
#pragma unroll
        for (int i = 0; i < 8; ++i) { w0[i] = cw[c0 + i]; w1[i] = cw[DFF + c0 + i]; w2[i] = cw[2 * DFF + c0 + i]; bb[i] = cb[c0 + i]; }
        float gm2[8], gm1[8];
        if ((t0 & (SEQ - 1)) == 0) {
#pragma unroll
            for (int i = 0; i < 8; ++i) { gm2[i] = 0.f; gm1[i] = 0.f; }
        } else { up8(*(const u32x4*)(UG + (size_t)(t0 - 2) * UGW + DFF + c0), gm2); up8(*(const u32x4*)(UG + (size_t)(t0 - 1) * UGW + DFF + c0), gm1); }
        for (int r = 0; r < 64; ++r) {
            bf16* rowp = UG + (size_t)(t0 + r) * UGW;
            float g0[8], uu[8]; up8(*(const u32x4*)(rowp + DFF + c0), g0); up8(*(const u32x4*)(rowp + c0), uu);
            float o[8];
#pragma unroll
            for (int i = 0; i < 8; ++i) { const float y = bb[i] + w0[i] * gm2[i] + w1[i] * gm1[i] + w2[i] * g0[i]; o[i] = gelu_tanh_(y) * uu[i]; gm2[i] = gm1[i]; gm1[i] = g0[i]; }
            u32x4 w; w.x = pk2(o[0], o[1]); w.y = pk2(o[2], o[3]); w.z = pk2(o[4], o[5]); w.w = pk2(o[6], o[7]);
            *(u32x4*)(rowp + c0) = w;
        }
    }
}

namespace mx {
__device__ __forceinline__ f32x16 mfma32(bf16x8 a, bf16x8 b, f32x16 c) { return __builtin_amdgcn_mfma_f32_32x32x16_bf16(a, b, c, 0, 0, 0); }
__device__ __forceinline__ f32x16 splat16(float v) { f32x16 r;
#pragma unroll
    for (int i = 0; i < 16; ++i) r[i] = v;
    return r; }
__device__ __forceinline__ int crow_c(int e) { return (e & 3) + 8 * (e >> 2); }
typedef short v4i16_t __attribute__((ext_vector_type(4)));
__device__ __forceinline__ s16x4 vtr(const LAS unsigned char* p) { return __builtin_bit_cast(s16x4, __builtin_amdgcn_ds_read_tr16_b64_v4i16((LAS v4i16_t*)p)); }
__device__ __forceinline__ bf16x8 pack8(float a0, float a1, float a2, float a3, float a4, float a5, float a6, float a7) {
    u32x4 w; w.x = pk2(a0, a1); w.y = pk2(a2, a3); w.z = pk2(a4, a5); w.w = pk2(a6, a7); return __builtin_bit_cast(bf16x8, w); }

__device__ __forceinline__ float log2gam(int h) { return __builtin_log2f(1.0f - __builtin_exp2f(-5.0f - (float)h)); }
__device__ __forceinline__ void prepkv_unit(Frame& F, int blk, const float* wa2, const float* bap, unsigned* kmaxl) {
    bf16* Z = (bf16*)(F.ws + WS_Z);
    const size_t r0 = (size_t)blk * 256; const int b = blk >> 5, cb = blk & 31;
    const int tid = F.tid;
    {   const int ch = tid >> 7, col = tid & 127;
        const float ba = bap[col];
        float wa[16];
#pragma unroll
        for (int r = 0; r < 16; ++r) wa[r] = wa2[r * 128 + col];
        float cum = 0.f;
        for (int t = 0; t < 64; ++t) {
            const bf16* zr = Z + (r0 + ch * 64 + t) * ZW; float da[8], db[8]; up8(*(const u32x4*)(zr + ZC_DA), da); up8(*(const u32x4*)(zr + ZC_DA + 8), db);
            float x = ba;
#pragma unroll
            for (int r = 0; r < 8; ++r) x += da[r] * wa[r];
#pragma unroll
            for (int r = 0; r < 8; ++r) x += db[r] * wa[8 + r];
            const float ls = fminf(x, 0.f) - __logf(1.0f + __expf(-fabsf(x)));
            cum += ls * 0.0625f;
        }
        const float bl = cum; cum = 0.f;
        for (int t = 0; t < 64; ++t) {
            bf16* zr = Z + (r0 + ch * 64 + t) * ZW; float da[8], db[8]; up8(*(const u32x4*)(zr + ZC_DA), da); up8(*(const u32x4*)(zr + ZC_DA + 8), db);
            float x = ba;
#pragma unroll
            for (int r = 0; r < 8; ++r) x += da[r] * wa[r];
#pragma unroll
            for (int r = 0; r < 8; ++r) x += db[r] * wa[8 + r];
            const float ls = fminf(x, 0.f) - __logf(1.0f + __expf(-fabsf(x)));
            cum += ls * 0.0625f;
            const float q = bf1(zr[ZC_DQ + col]), k = bf1(zr[ZC_DK + col]);
            zr[ZC_DQ + col] = (bf16)f2bf(q * __expf(cum - bl)); zr[ZC_DK + col] = (bf16)f2bf(k * __expf(bl - cum));
        }
        ((float*)(F.ws + WS_DE))[((size_t)b * 128 + cb * 4 + ch) * 128 + col] = __expf(bl);
    }
    for (int itn = 0; itn < 6; ++itn) { const int task = tid + 512 * itn, sl = task >> 8, row = task & 255;
        const bf16* kp = Z + (r0 + row) * ZW + (sl < 8 ? ZC_AK + (sl >> 1) * 64 + (sl & 1) * 32 : ZC_BK + (sl - 8) * 64); float ss = 0.f;
        const int nch = sl < 8 ? 4 : 8;
        for (int c = 0; c < nch; ++c) { float v[8]; up8(*(const u32x4*)(kp + 8 * c), v);
#pragma unroll
            for (int i = 0; i < 8; ++i) ss += v[i] * v[i]; }
#pragma unroll
        for (int o = 1; o < 64; o <<= 1) ss = fmaxf(ss, shx(ss, F.lane, o));
        if (F.lane == 0) __hip_atomic_fetch_max(kmaxl + b * 16 + sl, __float_as_uint(sqrtf(ss)), __ATOMIC_RELAXED, __HIP_MEMORY_SCOPE_AGENT); }
    for (int idx = tid; idx < 256 * 64; idx += 512) {
        const int row = idx >> 6, chunk = idx & 63, isk = chunk >> 5, c8 = (chunk & 31) * 8, h = c8 >> 6;
        const float e = (float)(255 - row) * log2gam(h); const float f = __builtin_amdgcn_exp2f(isk ? e : -e);
        u32x4* p = (u32x4*)(Z + (r0 + row) * ZW + (isk ? ZC_CK : ZC_CQ) + c8); float v[8]; up8(*p, v);
        u32x4 w; w.x = pk2(v[0] * f, v[1] * f); w.y = pk2(v[2] * f, v[3] * f); w.z = pk2(v[4] * f, v[5] * f); w.w = pk2(v[6] * f, v[7] * f); *p = w;
    }
    __threadfence_block(); __syncthreads();
    LAS unsigned char* Kl = F.lds; LAS unsigned char* Vl = F.lds + 36864;
    for (int h = 0; h < 4; ++h) {
        for (int idx = tid; idx < 256 * 8; idx += 512) { const int row = idx >> 3, c = idx & 7;
            *(LAS u32x4*)(Kl + row * 144 + c * 16) = *(const u32x4*)(Z + (r0 + row) * ZW + ZC_CK + h * 64 + c * 8);
            *(LAS u32x4*)(Vl + row * 144 + c * 16) = *(const u32x4*)(Z + (r0 + row) * ZW + ZC_CV + h * 64 + c * 8); }
        __syncthreads();
        {   const int d = tid >> 3, dk8 = (tid & 7) * 8; float acc[8];
#pragma unroll
            for (int i = 0; i < 8; ++i) acc[i] = 0.f;
            for (int j = 0; j < 256; ++j) { const float vv = bf1(*(const LAS bf16*)(Vl + j * 144 + d * 2)); float kk[8]; up8(*(const LAS u32x4*)(Kl + j * 144 + dk8 * 2), kk);
#pragma unroll
                for (int i = 0; i < 8; ++i) acc[i] += vv * kk[i]; }
            float* o = (float*)(F.ws + WS_KVC) + ((size_t)((b * 4 + h) * 32 + cb) * 4096 + d * 64 + dk8);
            *(f32x4*)o = (f32x4){acc[0], acc[1], acc[2], acc[3]}; *(f32x4*)(o + 4) = (f32x4){acc[4], acc[5], acc[6], acc[7]}; }
        __syncthreads();
        for (int idx = tid; idx < 256 * 8; idx += 512) { const int row = idx >> 3, c = idx & 7;
            if (c < 4) *(LAS u32x4*)(Kl + row * 144 + c * 16) = *(const u32x4*)(Z + (r0 + row) * ZW + ZC_DK + h * 32 + c * 8);
            *(LAS u32x4*)(Vl + row * 144 + c * 16) = *(const u32x4*)(Z + (r0 + row) * ZW + ZC_DV + h * 64 + c * 8); }
        __syncthreads();
        {   const int ch = tid >> 7, d = (tid >> 1) & 63, dk16 = (tid & 1) * 16; float acc[16];
#pragma unroll
            for (int i = 0; i < 16; ++i) acc[i] = 0.f;
            for (int j = 0; j < 64; ++j) { const int row = ch * 64 + j; const float vv = bf1(*(const LAS bf16*)(Vl + row * 144 + d * 2)); float k0[8], k1[8];
                up8(*(const LAS u32x4*)(Kl + row * 144 + dk16 * 2), k0); up8(*(const LAS u32x4*)(Kl + row * 144 + dk16 * 2 + 16), k1);
#pragma unroll
                for (int i = 0; i < 8; ++i) { acc[i] += vv * k0[i]; acc[8 + i] += vv * k1[i]; } }
            float* o = (float*)(F.ws + WS_KVD) + ((size_t)((b * 4 + h) * 128 + cb * 4 + ch) * 2048 + d * 32 + dk16);
#pragma unroll
            for (int i = 0; i < 4; ++i) *(f32x4*)(o + 4 * i) = (f32x4){acc[4 * i], acc[4 * i + 1], acc[4 * i + 2], acc[4 * i + 3]}; }
        __syncthreads();
    }
}

__device__ __forceinline__ void scan_phase(Frame& F) {
    const int gt = F.wg * 512 + F.tid, NT = F.G * 512;
    for (int e = gt; e < 16 * 4096; e += NT) {
        const int bh = e >> 12, idx = e & 4095, h = bh & 3; const float g256 = __builtin_amdgcn_exp2f(256.0f * log2gam(h));
        float* p = (float*)(F.ws + WS_KVC) + (size_t)bh * 32 * 4096 + idx; float S = 0.f;
        for (int c = 0; c < 32; ++c) { const float kv = p[(size_t)c * 4096]; const float Sp = g256 * S; p[(size_t)c * 4096] = Sp; S = Sp + kv; }
    }
    for (int e = gt; e < 16 * 2048; e += NT) {
        const int bh = e >> 11, idx = e & 2047, b = bh >> 2, h = bh & 3, dk = idx & 31;
        float* p = (float*)(F.ws + WS_KVD) + (size_t)bh * 128 * 2048 + idx; const float* de = (const float*)(F.ws + WS_DE) + (size_t)b * 128 * 128 + h * 32 + dk; float S = 0.f;
        for (int c = 0; c < 128; ++c) { const float kv = p[(size_t)c * 2048]; const float Sp = de[c * 128] * S; p[(size_t)c * 2048] = Sp; S = Sp + kv; }
    }
}

constexpr int HPITCH = 1026, CAP = 256;
struct QState { unsigned mode, thr_lo, thr_hi, thr_idx, krem, lcount, pad0, pad1; };
__device__ __forceinline__ unsigned okey_of(float s) { const unsigned u = __float_as_uint(s); return u ^ ((unsigned)((int)u >> 31) | 0x80000000u); }
__device__ __forceinline__ void b1_load(const bf16* Zb, int t, int r, int hh, bf16x8& k0, bf16x8& k1) {
    const bf16* kr = Zb + (size_t)(32 * t + r) * ZW + ZC_IK + 8 * hh; k0 = *(const bf16x8*)kr; k1 = *(const bf16x8*)(kr + 16); }
__device__ __forceinline__ void b1_scores(const bf16x8 k0, const bf16x8 k1, const bf16x8 (&iqf)[4][2], const float (&w)[4], float (&sc)[16]) {
#pragma unroll
    for (int e = 0; e < 16; ++e) sc[e] = 0.f;
#pragma unroll
    for (int ih = 0; ih < 4; ++ih) { f32x16 lg = mfma32(k0, iqf[ih][0], splat16(0.f)); lg = mfma32(k1, iqf[ih][1], lg);
#pragma unroll
        for (int e = 0; e < 16; ++e) sc[e] = fmaf(w[ih], fmaxf(lg[e], 0.f), sc[e]); }
}
__device__ __forceinline__ void b1_setbit(unsigned* MWq, unsigned j) {
    const unsigned wi = j & 31u, hh = (wi >> 2) & 1u, e = (wi & 3u) + 4u * (wi >> 3), kh = (j >> 5) & 1u;
    __hip_atomic_fetch_or(MWq + (size_t)(j >> 6) * 64 + 32u * hh, 1u << (e + 16u * kh), __ATOMIC_RELAXED, __HIP_MEMORY_SCOPE_AGENT);
}
__device__ __forceinline__ void b1_unit(Frame& F, int b, int g) {
    const int tid = F.tid, lane = F.lane, r = lane & 31, hh = lane >> 5, wid = F.wave;
    const bf16* Zb = (const bf16*)(F.ws + WS_Z) + (size_t)b * SEQ * ZW;
    LAS unsigned* hist = (LAS unsigned*)F.lds;
    LAS QState* qst = (LAS QState*)(F.lds + QST_OFF);
    const int qpos = 32 * g + r;
    unsigned* MWb = (unsigned*)(F.ws + WS_MASK) + ((size_t)(b * 256 + g) * 128) * 64;
    bf16x8 iqf[4][2]; float w[4];
    {   const bf16* qr = Zb + (size_t)qpos * ZW;
#pragma unroll
        for (int ih = 0; ih < 4; ++ih) { iqf[ih][0] = *(const bf16x8*)(qr + ZC_IQ + ih * 32 + 8 * hh); iqf[ih][1] = *(const bf16x8*)(qr + ZC_IQ + ih * 32 + 16 + 8 * hh); w[ih] = bf1(qr[ZC_IW + ih]); } }
    if (g >= 8) {
        for (int i = tid; i < 32 * HPITCH; i += 512) hist[i] = 0u;
        __syncthreads();
        {   bf16x8 n0 = iqf[0][0], n1 = iqf[0][0]; int t = wid; if (t <= g) b1_load(Zb, t, r, hh, n0, n1);
            for (; t <= g; t += 8) { const bf16x8 k0 = n0, k1 = n1; if (t + 8 <= g) b1_load(Zb, t + 8, r, hh, n0, n1);
                float sc[16]; b1_scores(k0, k1, iqf, w, sc);
#pragma unroll
                for (int e = 0; e < 16; ++e) { const int j = 32 * t + crow_c(e) + 4 * hh; if (j <= qpos) { const unsigned bin = okey_of(sc[e]) >> 21;
                    __hip_atomic_fetch_add(hist + r * HPITCH + (bin >> 1), 1u << ((bin & 1) * 16), __ATOMIC_RELAXED, __HIP_MEMORY_SCOPE_WORKGROUP); } } } }
        __syncthreads();
        for (int qq = 0; qq < 4; ++qq) { const int q = 4 * wid + qq; const LAS unsigned* hq = hist + q * HPITCH;
            const int wbase = 1008 - 16 * lane; unsigned s = 0;
#pragma unroll
            for (int k = 0; k < 16; ++k) { const unsigned x = hq[wbase + k]; s += (x & 0xffffu) + (x >> 16); }
            unsigned P = s;
#pragma unroll
            for (int o = 1; o < 64; o <<= 1) { const unsigned t = shup(P, lane, o); if (lane >= o) P += t; }
            const unsigned long long bal = __ballot(P >= 256u);
            const int Lsel = bal ? __builtin_ctzll(bal) : 63;
            if (lane == Lsel) { unsigned cum = P - s; unsigned b1 = 0, cin = 0, cab = 0;
                for (int k = 0; k < 32; ++k) { const int bin = 2047 - 32 * lane - k; const unsigned x = hq[bin >> 1]; const unsigned c = (bin & 1) ? (x >> 16) : (x & 0xffffu);
                    if (cum + c >= 256u) { b1 = (unsigned)bin; cin = c; cab = cum; break; } cum += c; }
                qst[q].thr_lo = b1 << 21; qst[q].thr_hi = (b1 << 21) | 0x1fffffu; qst[q].thr_idx = 0xffffu; qst[q].krem = 256u - cab; qst[q].lcount = 0u; qst[q].pad0 = cin; qst[q].pad1 = 0u;
                qst[q].mode = (b1 == 1024u || cin > (unsigned)CAP) ? 2u : 1u; }
        }
        __syncthreads();
        for (int i = tid; i < 32 * 256; i += 512) ((LAS unsigned*)(F.lds + 65536))[i] = 0u;
        __syncthreads();
    }
    {   unsigned mode = 0u, tlo = 1u, thi = 0u;
        const bool allsel = (g < 8);
        if (!allsel) { mode = qst[r].mode; tlo = qst[r].thr_lo; thi = qst[r].thr_hi; }
        const int nk = g >> 1;
        bf16x8 n0 = iqf[0][0], n1 = iqf[0][0], n2 = iqf[0][0], n3 = iqf[0][0]; int kt = wid;
        if (kt <= nk) { b1_load(Zb, 2 * kt, r, hh, n0, n1); if (2 * kt + 1 <= g) b1_load(Zb, 2 * kt + 1, r, hh, n2, n3); }
        for (; kt <= nk; kt += 8) {
            const bf16x8 k0 = n0, k1 = n1, k2 = n2, k3 = n3;
            if (kt + 8 <= nk) { b1_load(Zb, 2 * kt + 16, r, hh, n0, n1); if (2 * kt + 17 <= g) b1_load(Zb, 2 * kt + 17, r, hh, n2, n3); }
            unsigned word = 0u;
#pragma unroll
            for (int kh = 0; kh < 2; ++kh) { const int t = 2 * kt + kh; if (t <= g) { float sc[16]; b1_scores(kh ? k2 : k0, kh ? k3 : k1, iqf, w, sc);
#pragma unroll
                for (int e = 0; e < 16; ++e) { const int j = 32 * t + crow_c(e) + 4 * hh; const unsigned ok = okey_of(sc[e]); const bool valid = (j <= qpos);
                    const bool sel = valid && (allsel || ok > thi); word |= (sel ? 1u : 0u) << (e + 16 * kh);
                    if (!allsel && valid && ok >= tlo && ok <= thi) {
                        if (mode == 1u) { const unsigned pos = __hip_atomic_fetch_add(&qst[r].lcount, 1u, __ATOMIC_RELAXED, __HIP_MEMORY_SCOPE_WORKGROUP);
                            if (pos < (unsigned)CAP) { LAS unsigned* le = (LAS unsigned*)(F.lds + ((size_t)r * CAP + pos) * 8); le[0] = ok; le[1] = (unsigned)j; } }
                        else __hip_atomic_fetch_or((LAS unsigned*)(F.lds + 65536 + r * 1024) + (j >> 5), 1u << (j & 31), __ATOMIC_RELAXED, __HIP_MEMORY_SCOPE_WORKGROUP); } } } }
            MWb[(size_t)kt * 64 + lane] = word; }
    }
    __syncthreads();
    if (g >= 8) {
        for (int qq = 0; qq < 4; ++qq) { const int q = 4 * wid + qq; const unsigned mode = qst[q].mode, krem = qst[q].krem; unsigned* MWq = MWb + q;
            if (mode == 1u) {
                unsigned L = qst[q].lcount; if (L > (unsigned)CAP) L = CAP; const LAS unsigned* lb = (const LAS unsigned*)(F.lds + (size_t)q * CAP * 8);
                unsigned long long comp[4]; bool has[4]; unsigned jj[4];
#pragma unroll
                for (int k = 0; k < 4; ++k) { const unsigned c = lane + 64 * k; has[k] = c < L; const unsigned ok = has[k] ? lb[2 * c] : 0u; jj[k] = has[k] ? lb[2 * c + 1] : 0u;
                    comp[k] = ((unsigned long long)(ok & 0x1fffffu) << 13) | (unsigned long long)(8191u - jj[k]); }
                unsigned long long prefix = 0ull; unsigned need = krem;
                for (int bit = 33; bit >= 0; --bit) { const unsigned long long want = (prefix >> bit) | 1ull; unsigned cnt = 0;
#pragma unroll
                    for (int k = 0; k < 4; ++k) cnt += (unsigned)__builtin_popcountll(__ballot(has[k] && ((comp[k] >> bit) == want)));
                    if (cnt >= need) prefix |= (1ull << bit); else need -= cnt; }
#pragma unroll
                for (int k = 0; k < 4; ++k) if (has[k] && comp[k] >= prefix) b1_setbit(MWq, jj[k]); }
            else { const LAS unsigned* bm = (const LAS unsigned*)(F.lds + 65536 + q * 1024); unsigned x[4]; unsigned s = 0;
#pragma unroll
                for (int k = 0; k < 4; ++k) { x[k] = bm[4 * lane + k]; s += __builtin_popcount(x[k]); }
                unsigned P = s;
#pragma unroll
                for (int o = 1; o < 64; o <<= 1) { const unsigned t = shup(P, lane, o); if (lane >= o) P += t; }
                unsigned before = P - s;
#pragma unroll
                for (int k = 0; k < 4; ++k) { unsigned y = x[k]; while (y != 0u && before < krem) { const unsigned bit = (unsigned)__builtin_ctz(y); y &= y - 1u; b1_setbit(MWq, 32u * (4 * lane + k) + bit); ++before; } before += __builtin_popcount(y); } }
        }
        __syncthreads();
    }
}

struct EngP { const bf16* Z; bf16* Y; const unsigned* MASK; const float* ST; const float* nw; float lam, lam_init; const unsigned* kmax; };
__device__ __forceinline__ int wq_next(Frame& F, unsigned* head) {
    LAS int* slot = (LAS int*)(F.lds + 36880);
    if (F.tid == 0) *slot = (int)__hip_atomic_fetch_add(head, 1u, __ATOMIC_RELAXED, __HIP_MEMORY_SCOPE_AGENT);
    __syncthreads(); const int u = *slot; __syncthreads(); return u;
}
template <int MODE>
__device__ __forceinline__ void eng_unit(Frame& F, const EngP& P, int b, int h, int qb) {
    constexpr bool SOFT = MODE <= 1;
    constexpr int NMAP = MODE == 0 ? 2 : 1;
    constexpr int NS = (MODE == 0 || MODE == 3) ? 2 : 4;
    constexpr int KCH = MODE == 3 ? 4 : 8;
    constexpr int QC = MODE == 0 ? ZC_AQ : MODE == 1 ? ZC_BQ : MODE == 2 ? ZC_CQ : ZC_DQ;
    constexpr int KC = MODE == 0 ? ZC_AK : MODE == 1 ? ZC_BK : MODE == 2 ? ZC_CK : ZC_DK;
    constexpr int VC = MODE == 0 ? ZC_AV : MODE == 1 ? ZC_BV : MODE == 2 ? ZC_CV : ZC_DV;
    constexpr int HW = MODE == 3 ? 32 : 64;
    const int tid = F.tid, lane = F.lane, r = lane & 31, hh = lane >> 5, w = F.wave;
    const size_t rowbase = (size_t)b * SEQ;
    const int qw0 = qb * 256 + 32 * w;
    const float NEG = -__builtin_inff();
    const int hidx = MODE <= 1 ? (MODE == 0 ? 2 * h + 1 : 2 * h + 2) : 0;
    const float slope2 = SOFT ? __builtin_amdgcn_exp2f(-(float)hidx) * LOG2E : 0.f;
    bf16x8 qf[NMAP][NS];
    {   const bf16* qrow = P.Z + (rowbase + qw0 + r) * ZW + QC + h * HW;
#pragma unroll
        for (int m = 0; m < NMAP; ++m)
#pragma unroll
            for (int s = 0; s < NS; ++s) qf[m][s] = *(const bf16x8*)(qrow + m * 32 + 16 * s + 8 * hh); }
    f32x16 cinit;
#pragma unroll
    for (int e = 0; e < 16; ++e) cinit[e] = SOFT ? slope2 * (float)(crow_c(e) + 4 * hh) : 0.f;
    float m_run[NMAP], l_run[NMAP]; f32x16 O[NMAP][2];
#pragma unroll
    for (int m = 0; m < NMAP; ++m) { m_run[m] = NEG; l_run[m] = 0.f; O[m][0] = splat16(0.f); O[m][1] = splat16(0.f); }
    if (!SOFT) {
        const int sidx = MODE == 2 ? ((b * 4 + h) * 32 + qb) : ((b * 4 + h) * 128 + 4 * qb + (w >> 1));
        const float* sp = P.ST + (size_t)sidx * (64 * HW);
#pragma unroll
        for (int db = 0; db < 2; ++db)
#pragma unroll
            for (int s = 0; s < NS; ++s) { const float* a = sp + (size_t)(32 * db + r) * HW + 16 * s + 8 * hh; const f32x4 a0 = *(const f32x4*)a, a1 = *(const f32x4*)(a + 4);
                O[0][db] = mfma32(pack8(a0[0], a0[1], a0[2], a0[3], a1[0], a1[1], a1[2], a1[3]), qf[0][s], O[0][db]); }
    }
    const int kt_lo = SOFT ? 0 : 4 * qb, kt_hi = 4 * qb + 3;
    const int srow = tid >> 3, sch = tid & 7;
    float qk[NMAP];
    if (SOFT) {
#pragma unroll
        for (int m = 0; m < NMAP; ++m) { float ss = 0.f;
#pragma unroll
            for (int s = 0; s < NS; ++s) { const u32x4 qq = __builtin_bit_cast(u32x4, qf[m][s]); float v[8]; up8(qq, v);
#pragma unroll
                for (int i = 0; i < 8; ++i) ss += v[i] * v[i]; }
            ss += shx(ss, lane, 32);
            qk[m] = 1.02f * sqrtf(ss) * __uint_as_float(P.kmax[b * 16 + (MODE == 0 ? (h * 2 + m) : (8 + h))]) + 0.01f; }
    }
    LAS unsigned* wflag = (LAS unsigned*)(F.lds + 36864);
    if (SOFT && tid < 3) wflag[tid] = 0u;
    const int kt_first = SOFT ? kt_hi : kt_lo;
    u32x4 kreg = (u32x4){0u, 0u, 0u, 0u}, vreg;
    {   const bf16* zr = P.Z + (rowbase + 64 * kt_first + srow) * ZW;
        if (sch < KCH) kreg = *(const u32x4*)(zr + KC + h * HW + sch * 8);
        vreg = *(const u32x4*)(zr + VC + h * 64 + sch * 8);
        LAS unsigned char* Kb = F.lds; LAS unsigned char* Vb = F.lds + 18432;
        if (sch < KCH) *(LAS u32x4*)(Kb + srow * 144 + sch * 16) = kreg;
        *(LAS u32x4*)(Vb + srow * 144 + sch * 16) = vreg; }
    __syncthreads();
    const int nit = kt_hi - kt_lo + 1;
    bool wave_done = false;
    for (int it = 0; it < nit; ++it) {
        const int kt = SOFT ? kt_hi - it : kt_lo + it, ktn = SOFT ? kt - 1 : kt + 1;
        const bool more = it + 1 < nit;
        if (more) { const bf16* zr = P.Z + (rowbase + 64 * ktn + srow) * ZW;
            if (sch < KCH) kreg = *(const u32x4*)(zr + KC + h * HW + sch * 8);
            vreg = *(const u32x4*)(zr + VC + h * 64 + sch * 8); }
        const int j0 = 64 * kt;
        const bool act = ((MODE == 3) ? (kt == 4 * qb + (w >> 1)) : (j0 <= qw0 + 31)) && !wave_done;
        if (act) {
            const LAS unsigned char* Kb = F.lds + (it & 1) * 9216; const LAS unsigned char* Vb = F.lds + 18432 + (it & 1) * 9216;
            unsigned mw = 0xffffffffu;
            if (MODE == 1) mw = P.MASK[((size_t)(b * 256 + qb * 8 + w) * 128 + kt) * 64 + lane];
            const bool hact1 = (j0 + 32 <= qw0 + 31);
#pragma unroll
            for (int m = 0; m < NMAP; ++m) {
                f32x16 st[2];
#pragma unroll
                for (int kh = 0; kh < 2; ++kh) {
                    if (kh == 0 || hact1) {
                        f32x16 a = cinit;
#pragma unroll
                        for (int s = 0; s < NS; ++s) { const bf16x8 kf = *(const LAS bf16x8*)(Kb + (32 * kh + r) * 144 + (m * 32 + 16 * s + 8 * hh) * 2); a = mfma32(kf, qf[m][s], a); }
                        if (j0 + 32 * kh + 31 > qw0) { const int lim = qw0 + r - j0 - 32 * kh - 4 * hh;
#pragma unroll
                            for (int e = 0; e < 16; ++e) if (crow_c(e) > lim) a[e] = SOFT ? NEG : 0.f; }
                        if (MODE == 1) {
#pragma unroll
                            for (int e = 0; e < 16; ++e) if (!((mw >> (e + 16 * kh)) & 1u)) a[e] = NEG; }
                        st[kh] = a;
                    } else st[kh] = splat16(SOFT ? NEG : 0.f);
                }
                if (SOFT) {
                    const float off0 = slope2 * (float)(j0 - qw0 - r), off1 = off0 + 32.f * slope2;
                    float mx0 = st[0][0], mx1 = st[1][0];
#pragma unroll
                    for (int e = 1; e < 16; ++e) { mx0 = fmaxf(mx0, st[0][e]); mx1 = fmaxf(mx1, st[1][e]); }
                    float mx = fmaxf(mx0 + off0, mx1 + off1); mx = fmaxf(mx, shx(mx, lane, 32));
                    const float mn = fmaxf(m_run[m], mx); const float msafe = (mn == NEG) ? 0.f : mn;
                    const float alpha = __builtin_amdgcn_exp2f(m_run[m] - msafe); m_run[m] = mn;
                    const float d0 = off0 - msafe, d1 = off1 - msafe; float rs = 0.f;
#pragma unroll
                    for (int e = 0; e < 16; ++e) { const float p0 = __builtin_amdgcn_exp2f(st[0][e] + d0), p1 = __builtin_amdgcn_exp2f(st[1][e] + d1); st[0][e] = p0; st[1][e] = p1; rs += p0 + p1; }
                    rs += shx(rs, lane, 32); l_run[m] = l_run[m] * alpha + rs;
#pragma unroll
                    for (int e = 0; e < 16; ++e) { O[m][0][e] *= alpha; O[m][1][e] *= alpha; }
                }
#pragma unroll
                for (int kh = 0; kh < 2; ++kh) {
                    if (kh == 0 || hact1) {
#pragma unroll
                        for (int s = 0; s < 2; ++s) {
                            const bf16x8 pf = pack8(st[kh][8 * s], st[kh][8 * s + 1], st[kh][8 * s + 2], st[kh][8 * s + 3], st[kh][8 * s + 4], st[kh][8 * s + 5], st[kh][8 * s + 6], st[kh][8 * s + 7]);
#pragma unroll
                            for (int db = 0; db < 2; ++db) {
                                const LAS unsigned char* vp = Vb + (32 * kh + 16 * s + 4 * hh + ((lane & 15) >> 2)) * 144 + (32 * db + 16 * ((lane >> 4) & 1) + 4 * (lane & 3)) * 2;
                                const s16x4 lo = vtr(vp), hi = vtr(vp + 8 * 144);
                                const bf16x8 vf = (bf16x8){lo[0], lo[1], lo[2], lo[3], hi[0], hi[1], hi[2], hi[3]};
                                O[m][db] = mfma32(vf, pf, O[m][db]); } } } }
            }
            if (SOFT) {
                const float dist = slope2 * (float)(qw0 + r - (j0 - 1)); bool fin = true;
#pragma unroll
                for (int m = 0; m < NMAP; ++m) fin = fin && (qk[m] - dist - m_run[m] < -32.f);
                wave_done = (__ballot(fin) == ~0ull);
            }
        }
        if (SOFT && !wave_done && lane == 0) wflag[it % 3] = 1u;
        if (more) { LAS unsigned char* Kb = F.lds + ((it + 1) & 1) * 9216; LAS unsigned char* Vb = F.lds + 18432 + ((it + 1) & 1) * 9216;
            if (sch < KCH) *(LAS u32x4*)(Kb + srow * 144 + sch * 16) = kreg;
            *(LAS u32x4*)(Vb + srow * 144 + sch * 16) = vreg; }
        __syncthreads();
        if (SOFT) { const unsigned any = wflag[it % 3]; if (tid == 0) wflag[(it + 2) % 3] = 0u; if (any == 0u) break; }
    }
    const size_t orow = rowbase + qw0 + r;
    const int ycol = MODE * 256 + h * 64;
    f32x16 o[2];
    if (MODE == 0) { const float i0 = 1.f / l_run[0], i1 = P.lam / l_run[NMAP - 1];
#pragma unroll
        for (int db = 0; db < 2; ++db)
#pragma unroll
            for (int e = 0; e < 16; ++e) o[db][e] = O[0][db][e] * i0 - O[NMAP - 1][db][e] * i1; }
    else if (MODE == 1) { const float i0 = 1.f / l_run[0];
#pragma unroll
        for (int db = 0; db < 2; ++db)
#pragma unroll
            for (int e = 0; e < 16; ++e) o[db][e] = O[0][db][e] * i0; }
    else { o[0] = O[0][0]; o[1] = O[0][1]; }
    float mu = 0.f;
    if (MODE == 2) { float s = 0.f;
#pragma unroll
        for (int db = 0; db < 2; ++db)
#pragma unroll
            for (int e = 0; e < 16; ++e) s += o[db][e];
        s += shx(s, lane, 32); mu = s * (1.f / 64.f); }
    float ss = 0.f;
    if (MODE != 1) {
#pragma unroll
        for (int db = 0; db < 2; ++db)
#pragma unroll
            for (int e = 0; e < 16; ++e) { const float d = o[db][e] - mu; ss += d * d; }
        ss += shx(ss, lane, 32); }
    float rn = 1.f;
    if (MODE != 1) rn = 1.f / sqrtf(ss * (1.f / 64.f) + LN_EPS);
    if (MODE == 0) rn *= (1.f - P.lam_init);
#pragma unroll
    for (int db = 0; db < 2; ++db)
#pragma unroll
        for (int g4 = 0; g4 < 4; ++g4) { const int d0 = 32 * db + 8 * g4 + 4 * hh; float v[4];
#pragma unroll
            for (int i = 0; i < 4; ++i) v[i] = o[db][4 * g4 + i];
            if (MODE != 1) { const f32x4 nw = *(const f32x4*)(P.nw + (MODE == 2 ? h * 64 : 0) + d0);
#pragma unroll
                for (int i = 0; i < 4; ++i) v[i] = (v[i] - mu) * rn * nw[i]; }
            if (MODE >= 2) { const u32x2 gw = *(const u32x2*)(P.Z + orow * ZW + (MODE == 2 ? ZC_CG : ZC_DG) + h * 64 + d0);
                const float g0 = bflo(gw.x), g1 = bfhi(gw.x), g2 = bflo(gw.y), g3 = bfhi(gw.y);
                v[0] *= g0 * sigmoidf_(g0); v[1] *= g1 * sigmoidf_(g1); v[2] *= g2 * sigmoidf_(g2); v[3] *= g3 * sigmoidf_(g3); }
            u32x2 ow; ow.x = pk2(v[0], v[1]); ow.y = pk2(v[2], v[3]);
            *(u32x2*)(P.Y + orow * DM + ycol + d0) = ow; }
}
}

constexpr int PH_PER_LAYER = 12, N_PHASES = 1 + DEPTH * PH_PER_LAYER;

typedef __attribute__((address_space(4))) const Args* KArgP;
#ifdef ONLY_SITE
#define SITE(s) ((s) == ONLY_SITE)
#else
#define SITE(s) true
#endif
#if MK_ONE_LAUNCH
#define IN(k) true
#define SEAM(k) do { if ((k) + 1 < N_PHASES) { XcdBarrier b2_ = bar; asm volatile("" : "+s"(b2_.bar), "+s"(b2_.x)); xcd_barrier(b2_, F.tid == 0); } } while (0)
#else
#define IN(k) (lo <= (k) && (k) < hi)
#define SEAM(k) do { } while (0)
#endif
#define SITE_BEGIN KArgP KA = (KArgP)__builtin_amdgcn_kernarg_segment_ptr(); do { asm volatile("" : "+s"(KA)); \
        int ln_; asm volatile("v_mbcnt_lo_u32_b32 %0, -1, 0\n\tv_mbcnt_hi_u32_b32 %0, -1, %0" : "=v"(ln_)); \
        const unsigned simd_ = (unsigned)__builtin_amdgcn_s_getreg(((2 - 1) << 11) | (4 << 6) | 4);   \
        unsigned tk_ = 0u; if (ln_ == 0) tk_ = __hip_atomic_fetch_add((LAS unsigned*)(F.lds + MISC_OFF + 64) + simd_, 1u, __ATOMIC_RELAXED, __HIP_MEMORY_SCOPE_WORKGROUP); \
        F.wave = __builtin_amdgcn_readfirstlane((int)(simd_ + 4u * (tk_ & 1u))); F.lane = ln_; F.tid = F.wave * 64 + F.lane; \
        F.ws = KA->ws; F.dob = (unsigned char*)KA->out; F.G = G0; F.wg = wg0; asm volatile("" : "+s"(F.G), "+s"(F.wg)); } while (0)


__global__ void __launch_bounds__(NWAVES * 64, 2) fwd_kernel(Args args) {
    extern __shared__ __attribute__((aligned(16))) unsigned char lds_raw[];
    Frame F;
    F.lds = (LAS unsigned char*)lds_raw;
    F.tid = threadIdx.x; F.lane = F.tid & 63; F.wave = __builtin_amdgcn_readfirstlane(F.tid >> 6);
    F.G = gridDim.x; F.wg = blockIdx.x;
    F.ws = args.ws; F.dob = (unsigned char*)args.out;
    volatile LAS unsigned* MISC = (volatile LAS unsigned*)(F.lds + MISC_OFF);
    if (F.tid < 32) MISC[F.tid] = 0u;
    __syncthreads();
    unsigned* ctl = (unsigned*)(F.ws + WS_CTL);
    XcdBarrier bar; bar.bar = ctl + CW_BAR; bar.x = 0; bar.st = nullptr;
#if MK_ONE_LAUNCH
    bar = xcd_barrier_post(ctl + CW_BAR, MISC + 8);
#endif
    const int lo = args.ph_lo, hi = args.ph_hi, subm = args.sub;
    const int G0 = F.G, wg0 = F.wg;
    if (SITE(0) && IN(0)) { SITE_BEGIN; p0_prologue(F, KA); SEAM(0); }

    for (int l = 0; l < DEPTH; ++l) {
        const int pb = 1 + l * PH_PER_LAYER;
        if (SITE(1) && IN(pb + 0)) { SITE_BEGIN; const char* XBc = (const char*)(F.ws + WS_XB); (void)XBc; const unsigned char* w123 = F.ws + WS_W123; const unsigned char* w45 = F.ws + WS_W45 + (size_t)l * W45_STRIDE; (void)w123; (void)w45;
            pg8::SchedPlain S{XBc, (const char*)(w123 + W123_W1), 2048, 2048, 16, 128, 14, F.G, F.wg};
            pg8::EpiStore E{(bf16*)(F.ws + WS_Z), ZW};
            pg8::gemm_phase(F.lds, S, E, F.tid);
            SEAM(pb + 0);
        }
        if (SITE(2) && IN(pb + 1)) { SITE_BEGIN; const char* XBc = (const char*)(F.ws + WS_XB); (void)XBc; const unsigned char* w123 = F.ws + WS_W123; const unsigned char* w45 = F.ws + WS_W45 + (size_t)l * W45_STRIDE; (void)w123; (void)w45;
            if (subm & 1) for (int u = F.wg; u < 512; u += F.G) { const int b = u >> 7, p = u & 127; mx::b1_unit(F, b, 255 - p); mx::b1_unit(F, b, p); }
            if (subm & 2) for (int u = F.wg; u < 128; u += F.G) mx::prepkv_unit(F, u, KA->in[6] + (size_t)l * 16 * 128, KA->in[7] + l * 128, (unsigned*)(F.ws + WS_CTL) + CW_KMAX + l * 64);
            SEAM(pb + 1);
        }
        if (SITE(3) && IN(pb + 2)) { SITE_BEGIN; const char* XBc = (const char*)(F.ws + WS_XB); (void)XBc; const unsigned char* w123 = F.ws + WS_W123; const unsigned char* w45 = F.ws + WS_W45 + (size_t)l * W45_STRIDE; (void)w123; (void)w45;
            if (subm & 1) mx::scan_phase(F);
            float lam_init = 0.8f - 0.6f * __expf(-0.3f * (float)l);
            const float* lp = KA->in[3] + l * 128; float s01 = 0.f, s23 = 0.f;
            for (int i = 0; i < 32; ++i) { s01 += lp[i] * lp[32 + i]; s23 += lp[64 + i] * lp[96 + i]; }
            mx::EngP P{(const bf16*)(F.ws + WS_Z), (bf16*)(F.ws + WS_Y), nullptr, nullptr, KA->in[4] + l * 64, __expf(s01) - __expf(s23) + lam_init, lam_init, (const unsigned*)(F.ws + WS_CTL) + CW_KMAX + l * 64};
            {   unsigned* head = (unsigned*)(F.ws + WS_CTL) + CW_WQ + l * 64;
                for (;;) { const int i = mx::wq_next(F, head); if (i >= 512) break; const int j = i & 127; mx::eng_unit<0>(F, P, j & 3, 3 - (i >> 7), 31 - (j >> 2)); } }
            SEAM(pb + 2);
        }
        if (SITE(4) && IN(pb + 3)) { SITE_BEGIN; const char* XBc = (const char*)(F.ws + WS_XB); (void)XBc; const unsigned char* w123 = F.ws + WS_W123; const unsigned char* w45 = F.ws + WS_W45 + (size_t)l * W45_STRIDE; (void)w123; (void)w45;
            {   unsigned* head = (unsigned*)(F.ws + WS_CTL) + CW_WQ + l * 64 + 16;
                const mx::EngP PB{(const bf16*)(F.ws + WS_Z), (bf16*)(F.ws + WS_Y), (const unsigned*)(F.ws + WS_MASK), nullptr, nullptr, 0.f, 0.f, (const unsigned*)(F.ws + WS_CTL) + CW_KMAX + l * 64};
                const mx::EngP PC{(const bf16*)(F.ws + WS_Z), (bf16*)(F.ws + WS_Y), nullptr, (const float*)(F.ws + WS_KVC), KA->in[5] + l * 256, 0.f, 0.f, nullptr};
                const mx::EngP PD{(const bf16*)(F.ws + WS_Z), (bf16*)(F.ws + WS_Y), nullptr, (const float*)(F.ws + WS_KVD), KA->in[8] + l * 64, 0.f, 0.f, nullptr};
                for (;;) { const int i = mx::wq_next(F, head); if (i >= 1536) break;
                    if (i < 512) { if (subm & 1) { const int j = i & 127; mx::eng_unit<1>(F, PB, j & 3, 3 - (i >> 7), 31 - (j >> 2)); } }
                    else if (!(subm & (i < 1024 ? 2 : 4))) continue;
                    else if (i < 1024) { const int u = i - 512; mx::eng_unit<2>(F, PC, u >> 7, (u >> 5) & 3, u & 31); }
                    else { const int u = i - 1024; mx::eng_unit<3>(F, PD, u >> 7, (u >> 5) & 3, u & 31); } } }
            SEAM(pb + 3);
        }
        if (SITE(5) && IN(pb + 4)) { SITE_BEGIN;
            const unsigned char* w123 = F.ws + WS_W123;
            for (int n = 0; n < 4; ++n) {
                {   pg8::SchedPlain S{(const char*)(F.ws + WS_XB), (const char*)(w123 + W123_GB) + (size_t)n * 1024 * 2048, 2048, 2048, 16, 128, 4, F.G, F.wg};
                    pg8::EpiSlotStore E{F.ws + WS_SCR2 + (size_t)F.wg * 262144, 1};
                    pg8::gemm_phase(F.lds, S, E, F.tid); }
                {   pg8::SchedPlain S{(const char*)(F.ws + WS_Y) + n * 512, (const char*)(w123 + W123_GB + 8 * MiB) + (size_t)n * 1024 * 512, 2048, 512, 4, 128, 4, F.G, F.wg};
                    pg8::EpiBranch E{F.ws + WS_SCR2 + (size_t)F.wg * 262144, (bf16*)(F.ws + WS_MERGED), n == 0};
                    pg8::gemm_phase(F.lds, S, E, F.tid); }
            }
            SEAM(pb + 4);
        }
        if (SITE(6) && IN(pb + 5)) { SITE_BEGIN; const char* XBc = (const char*)(F.ws + WS_XB); (void)XBc; const unsigned char* w123 = F.ws + WS_W123; const unsigned char* w45 = F.ws + WS_W45 + (size_t)l * W45_STRIDE; (void)w123; (void)w45;
            pg8::SchedPlain S{(const char*)(F.ws + WS_MERGED), (const char*)(w123 + W123_WO), 2048, 2048, 16, 128, 4, F.G, F.wg};
            pg8::EpiG3 E{(bf16*)(F.ws + WS_XB)};
            pg8::gemm_phase(F.lds, S, E, F.tid);
            SEAM(pb + 5);
        }
        if (SITE(7) && IN(pb + 6)) { SITE_BEGIN; const char* XBc = (const char*)(F.ws + WS_XB); (void)XBc; const unsigned char* w123 = F.ws + WS_W123; const unsigned char* w45 = F.ws + WS_W45 + (size_t)l * W45_STRIDE; (void)w123; (void)w45; ln_phase(F, KA->in[11] + l * DM, KA->in[12] + l * DM, nullptr);
            if (l + 1 < DEPTH) convert_w123(F, KA->in[2] + (size_t)(l + 1) * DM * NIN, KA->in[9] + (size_t)(l + 1) * 4 * 256 * DM, KA->in[10] + (size_t)(l + 1) * DM * DM);
            SEAM(pb + 6); }
        if (SITE(8) && IN(pb + 7)) { SITE_BEGIN; const char* XBc = (const char*)(F.ws + WS_XB); (void)XBc; const unsigned char* w123 = F.ws + WS_W123; const unsigned char* w45 = F.ws + WS_W45 + (size_t)l * W45_STRIDE; (void)w123; (void)w45;
            pg8::SchedPlain S{XBc, (const char*)(w45 + W45_UP), 2048, 2048, 16, 128, 22, F.G, F.wg};
            pg8::EpiStore E{(bf16*)(F.ws + WS_UG), UGW};
            pg8::gemm_phase(F.lds, S, E, F.tid);
            SEAM(pb + 7);
        }
        if (SITE(9) && IN(pb + 8)) { SITE_BEGIN; const char* XBc = (const char*)(F.ws + WS_XB); (void)XBc; const unsigned char* w123 = F.ws + WS_W123; const unsigned char* w45 = F.ws + WS_W45 + (size_t)l * W45_STRIDE; (void)w123; (void)w45; ffn_act_phase(F, KA->in[14] + (size_t)l * 3 * DFF, KA->in[15] + (size_t)l * DFF); SEAM(pb + 8); }
        if (SITE(10) && IN(pb + 9)) { SITE_BEGIN;
            const unsigned char* w45 = F.ws + WS_W45 + (size_t)l * W45_STRIDE;
            {   pg8::SchedPlain S{(const char*)(F.ws + WS_PB + (size_t)l * M * PDIM * 2), (const char*)(w45 + W45_PP), 512, 512, 4, 128, 4, F.G, F.wg};
                pg8::EpiSlotStore E{F.dob + DO_SCR5 + (size_t)F.wg * 262144, 0};
                pg8::gemm_phase(F.lds, S, E, F.tid); }
            {   pg8::SchedPlain S{(const char*)(F.ws + WS_XB), (const char*)(w45 + W45_PG), 2048, 2048, 16, 128, 4, F.G, F.wg};
                pg8::EpiSlotMul E{F.dob + DO_SCR5 + (size_t)F.wg * 262144};
                pg8::gemm_phase(F.lds, S, E, F.tid); }
            SEAM(pb + 9);
        }
        if (SITE(11) && IN(pb + 10)) { SITE_BEGIN;
            const unsigned char* w45 = F.ws + WS_W45 + (size_t)l * W45_STRIDE;
            pg8::SchedG5b S{(const char*)(F.ws + WS_UG), (const char*)(w45 + W45_DN), F.G, F.wg};
            pg8::EpiG5b E{F.dob + DO_SCR5 + (size_t)F.wg * 262144, (bf16*)(F.ws + WS_XB)};
            pg8::gemm_phase(F.lds, S, E, F.tid);
            SEAM(pb + 10);
        }
        if (SITE(12) && IN(pb + 11)) { SITE_BEGIN; const char* XBc = (const char*)(F.ws + WS_XB); (void)XBc; const unsigned char* w123 = F.ws + WS_W123; const unsigned char* w45 = F.ws + WS_W45 + (size_t)l * W45_STRIDE; (void)w123; (void)w45; ln_phase(F, KA->in[19] + l * DM, KA->in[20] + l * DM, l == DEPTH - 1 ? KA->out : nullptr); SEAM(pb + 11); }
    }
#undef IN
#undef SEAM
}

extern "C" void kernel_launch(void* const* d_in, const int* in_sizes, int n_in, void* d_out, int out_size, void* d_ws, size_t ws_size, hipStream_t stream) {
    static int grid = 0;
    if (grid == 0) {
        if (n_in != 21 || out_size != M * DM || ws_size < WS_END) { fprintf(stderr, "kernel_launch: unexpected shapes (n_in %d out %d ws %zu)\n", n_in, out_size, ws_size); grid = -1; return; }
        int dev = 0, cus = 0, per_cu = 0;
        if (hipGetDevice(&dev) != hipSuccess || hipDeviceGetAttribute(&cus, hipDeviceAttributeMultiprocessorCount, dev) != hipSuccess) { grid = -1; return; }
        if (hipFuncSetAttribute((const void*)fwd_kernel, hipFuncAttributeMaxDynamicSharedMemorySize, LDS_BYTES) != hipSuccess) { grid = -1; return; }
        if (hipOccupancyMaxActiveBlocksPerMultiprocessor(&per_cu, (const void*)fwd_kernel, NWAVES * 64, LDS_BYTES) != hipSuccess || per_cu < 1)
            fprintf(stderr, "kernel_launch: occupancy query reports %d\n", per_cu);
        (void)hipGetLastError();
        grid = cus;
    }
    if (grid < 0) return;
    (void)hipMemsetAsync((char*)d_ws + WS_CTL, 0, CTL_ZERO_BYTES, stream);
    Args a{};
    for (int i = 0; i < 21; ++i) a.in[i] = (const float*)d_in[i];
    a.out = (float*)d_out; a.ws = (unsigned char*)d_ws;
#if MK_ONE_LAUNCH
    a.ph_lo = 0; a.ph_hi = N_PHASES; a.sub = 7;
    hipLaunchKernelGGL(fwd_kernel, dim3(grid), dim3(NWAVES * 64), LDS_BYTES, stream, a);
#else
    for (int p = 0; p < N_PHASES; ++p) { a.ph_lo = p; a.ph_hi = p + 1; a.sub = 7;
        hipLaunchKernelGGL(fwd_kernel, dim3(grid), dim3(NWAVES * 64), LDS_BYTES, stream, a);
#ifdef PROBE_PHASE
        if (p >= 1 && (p - 1) % PH_PER_LAYER == PROBE_PHASE) { (void)hipMemsetAsync((char*)d_ws + WS_CTL + CW_WQ * 4, 0, 1024, stream); a.sub = PROBE_SUB;
            hipLaunchKernelGGL(fwd_kernel, dim3(grid), dim3(NWAVES * 64), LDS_BYTES, stream, a); }
#endif
    }
#endif
}
```

```cpp
#include <hip/hip_runtime.h>
#include <cstdio>
#include <cstdint>

#ifndef EXP
#define EXP 0
#endif
#ifndef EXPM
#define EXPM 15
#endif
#ifndef MK_ONE_LAUNCH
#define MK_ONE_LAUNCH 1
#endif

#define GAS __attribute__((address_space(1)))
#define LAS __attribute__((address_space(3)))
typedef unsigned short bf16;
typedef unsigned u32x4 __attribute__((ext_vector_type(4)));
typedef unsigned u32x2 __attribute__((ext_vector_type(2)));
typedef float f32x2 __attribute__((ext_vector_type(2)));
typedef float f32x4 __attribute__((ext_vector_type(4)));
typedef float f32x16 __attribute__((ext_vector_type(16)));
typedef short bf16x8 __attribute__((ext_vector_type(8)));
typedef short s16x4 __attribute__((ext_vector_type(4)));
typedef GAS unsigned gu32;

constexpr int BATCH = 4, SEQ = 8192, DM = 1024, M = BATCH * SEQ, DEPTH = 2;
constexpr int NIN = 7604, ZW = 3584, DFF = 2816, UGW = 5632, PDIM = 256;
constexpr float LN_EPS = 1e-5f;
constexpr float ALPHA = 1.41421356237f;
constexpr float LOG2E = 1.4426950408889634f;
constexpr int ZC_AQ = 0, ZC_AK = 256, ZC_AV = 512, ZC_BQ = 768, ZC_BK = 1024, ZC_BV = 1280, ZC_CQ = 1536, ZC_CK = 1792, ZC_CV = 2048, ZC_CG = 2304,
              ZC_DQ = 2560, ZC_DK = 2688, ZC_DV = 2816, ZC_DG = 3072, ZC_IQ = 3328, ZC_IK = 3456, ZC_IW = 3488, ZC_DA = 3504;
constexpr int SRC_MG = 3508;

constexpr size_t MiB = 1u << 20;
constexpr size_t WS_CTL = 0, CTL_ZERO_BYTES = 1 * MiB;
constexpr size_t WS_XB = 1 * MiB;
constexpr size_t WS_BIG = 65 * MiB;
constexpr size_t WS_Z = WS_BIG, WS_Y = WS_BIG + 224 * MiB, WS_MERGED = WS_BIG + 288 * MiB, WS_UG = WS_BIG;
constexpr size_t WS_MASK = WS_MERGED, WS_KVC = WS_MERGED + 32 * MiB, WS_KVD = WS_MERGED + 40 * MiB, WS_DE = WS_MERGED + 56 * MiB;
constexpr size_t WS_SCR2 = WS_Z;
constexpr size_t WS_W45 = 417 * MiB, W45_STRIDE = 19 * MiB;
constexpr size_t W45_UP = 0, W45_PG = 11 * MiB, W45_PP = 13 * MiB, W45_DN = 13 * MiB + 512 * 1024;
constexpr size_t WS_PB = 455 * MiB;
constexpr size_t WS_W123 = 487 * MiB;
constexpr size_t WS_END = 506 * MiB;
constexpr size_t W123_W1 = 0, W123_GB = 7 * MiB, W123_WO = 17 * MiB;
constexpr size_t DO_SCR5 = 0;
constexpr size_t DO_XB8 = 64 * MiB;
constexpr size_t DO_W8 = 96 * MiB, W8_STRIDE = 10 * MiB + 512 * 1024, W8_G = 0, W8_UP = 4 * MiB, W8_PG = 9 * MiB + 512 * 1024;

constexpr int CW_BAR = 4096, CW_WQ = 8448  , CW_KMAX = 8192;

constexpr int RING_BYTES = 131072;
constexpr int MISC_OFF = 131072 + 320;
constexpr int QST_OFF = 132096;
constexpr int LDS_BYTES = 147456;

constexpr int NWAVES = 8;

#define RLX_AGENT __ATOMIC_RELAXED, __HIP_MEMORY_SCOPE_AGENT
__device__ __forceinline__ unsigned f2bf(float f) { unsigned u = __builtin_bit_cast(unsigned, f); return (u + 0x7fffu + ((u >> 16) & 1u)) >> 16; }
typedef __bf16 bf16x2_t __attribute__((ext_vector_type(2)));
__device__ __forceinline__ unsigned pk2(float lo, float hi) { const f32x2 v = {lo, hi}; const bf16x2_t b = __builtin_convertvector(v, bf16x2_t); return __builtin_bit_cast(unsigned, b); }
__device__ __forceinline__ unsigned pk4f8(float a, float b, float c, float d) { int p = __builtin_amdgcn_cvt_pk_fp8_f32(a, b, 0, false); p = __builtin_amdgcn_cvt_pk_fp8_f32(c, d, p, true); return (unsigned)p; }
__device__ __forceinline__ float bflo(unsigned w) { return __uint_as_float(w << 16); }
__device__ __forceinline__ float bfhi(unsigned w) { return __uint_as_float(w & 0xffff0000u); }
__device__ __forceinline__ float bf1(bf16 b) { return __uint_as_float((unsigned)b << 16); }
__device__ __forceinline__ float sigmoidf_(float x) { return __builtin_amdgcn_rcpf(1.0f + __builtin_amdgcn_exp2f(-LOG2E * x)); }
__device__ __forceinline__ float shx(float v, int lane, int m) { return __int_as_float(__builtin_amdgcn_ds_bpermute((lane ^ m) << 2, __float_as_int(v))); }
__device__ __forceinline__ unsigned shup(unsigned v, int lane, int o) { return (unsigned)__builtin_amdgcn_ds_bpermute((lane - o) << 2, (int)v); }
__device__ __forceinline__ float wave_sum(float v, int lane) {
#pragma unroll
    for (int o = 1; o < 64; o <<= 1) v += shx(v, lane, o);
    return v;
}

#define XB_TMO      128
#define XB_XCNT(j)  (256  + 64 * (j))
#define XB_XSUB(j)  (1280 + 64 * (j))
#define XB_XGEN(j)  (2304 + 64 * (j))
#define XB_TOP      3328
#define XB_TOPGEN   3392
#define XCD_BAR_WORDS 3456
#define XB_SPIN_CAP (1u << 22)

__device__ __forceinline__ unsigned xb_ld(unsigned* p)              { return __hip_atomic_load(p, __ATOMIC_RELAXED, __HIP_MEMORY_SCOPE_AGENT); }
__device__ __forceinline__ unsigned xb_add(unsigned* p, unsigned v) { return __hip_atomic_fetch_add(p, v, __ATOMIC_RELAXED, __HIP_MEMORY_SCOPE_AGENT); }
__device__ __forceinline__ unsigned xb_xcc_id() { return (unsigned)__builtin_amdgcn_s_getreg((3 << 11) | 20) & 0xFu; }
#define XB_SPIN(cond, bar) do { unsigned _sp = 0; while (cond) { __builtin_amdgcn_s_sleep(1); \
    if ((++_sp & 255u) == 0u) { if (xb_ld(&(bar)[XB_TMO])) break; if (_sp > XB_SPIN_CAP) { atomicAdd(&(bar)[XB_TMO], 1u); break; } } } } while (0)

struct XcdBarrier { unsigned* bar; unsigned x; volatile LAS unsigned* st; };

__device__ __forceinline__ XcdBarrier xcd_barrier_post(unsigned* bar, volatile LAS unsigned* st) {
    XcdBarrier b; b.bar = bar; b.x = xb_xcc_id(); b.st = st;
    if (threadIdx.x == 0) (void)xb_add(&bar[XB_XCNT(b.x)], 1u);
    return b;
}
__device__ __forceinline__ void xcd_barrier_complete(unsigned* bar, unsigned x, unsigned& nloc, unsigned& nx) {
    const unsigned G = gridDim.x * gridDim.y * gridDim.z;
    unsigned sum, cnt, mine, sp = 0u;
    for (;;) {
        sum = 0u; cnt = 0u; mine = 0u;
#pragma unroll
        for (unsigned j = 0; j < 16; ++j) { const unsigned c = xb_ld(&bar[XB_XCNT(j)]); sum += c; cnt += (c > 0u) ? 1u : 0u; mine = (j == x) ? c : mine; }
        if (sum == G) break;
        __builtin_amdgcn_s_sleep(1);
        if ((++sp & 255u) == 0u) { if (xb_ld(&bar[XB_TMO])) break; if (sp > XB_SPIN_CAP) { atomicAdd(&bar[XB_TMO], 1u); break; } }
    }
    nloc = mine > 0u ? mine : 1u; nx = cnt > 0u ? cnt : 1u;
}
__device__ __forceinline__ void xcd_barrier(const XcdBarrier& b, const bool leader_thread) {
    asm volatile("s_waitcnt vmcnt(0)" ::: "memory");
    __syncthreads();
    if (leader_thread) {
        unsigned* bar = b.bar;
        __builtin_amdgcn_s_waitcnt(0);
        unsigned nloc = b.st[0], nx = b.st[1];
        if (nloc == 0u) { xcd_barrier_complete(bar, b.x, nloc, nx); b.st[0] = nloc; b.st[1] = nx; }
        const unsigned old = xb_add(&bar[XB_XSUB(b.x)], 1u);
        const unsigned gen = old / nloc;
        if (old + 1u == (gen + 1u) * nloc) {
            __builtin_amdgcn_fence(__ATOMIC_RELEASE, "agent");
            asm volatile("s_waitcnt vmcnt(0)" ::: "memory");
            const unsigned og = xb_add(&bar[XB_TOP], 1u);
            const unsigned tg = og / nx;
            if (og + 1u == (tg + 1u) * nx) xb_add(&bar[XB_TOPGEN], 1u);
            else XB_SPIN(xb_ld(&bar[XB_TOPGEN]) == tg, bar);
            __builtin_amdgcn_fence(__ATOMIC_ACQUIRE, "agent");
            xb_add(&bar[XB_XGEN(b.x)], 1u);
            asm volatile("s_waitcnt vmcnt(0)" ::: "memory");
        } else {
            XB_SPIN(xb_ld(&bar[XB_XGEN(b.x)]) == gen, bar);
            __builtin_amdgcn_fence(__ATOMIC_ACQUIRE, "agent");
            asm volatile("s_waitcnt vmcnt(0)" ::: "memory");
        }
    }
    __syncthreads();
}

namespace pg8 {
constexpr int BM = 256, BK = 64, HALF = 128, HTB = HALF * BK * 2, STAGE_BYTES = 8 * HTB, NXCD = 8, WGM = 8;
__device__ __forceinline__ int lds_byte(int r, int c) { const int st = (r >> 4) * 2 + (c >> 5), rr = r & 15, cc = c & 31, ob = rr * 64 + cc * 2; return st * 1024 + (ob ^ (((ob >> 9) & 1) << 5)); }
__device__ __forceinline__ void stage_rc(int b, int& R, int& C) { const int st = b / 1024, sb = b % 1024, swz = sb ^ (((sb >> 9) & 1) << 5); R = (st >> 1) * 16 + swz / 64; C = (st & 1) * 32 + (swz % 64) / 2; }
__device__ __forceinline__ int perm32(int rho) { const int n = rho >> 4, i = rho & 15; return 8 * (i >> 2) + 4 * n + (i & 3); }

struct UnitD { const char* A; const char* B; int lda2, ldb2, nt, pm, pn, kind; };

__device__ __forceinline__ void tile_map(int L, int nM, int nN, int& pm, int& pn) {
    const int nwg = nM * nN; int wgid = L;
    { const int q = nwg / NXCD, r = nwg % NXCD, xcd = wgid % NXCD, off = wgid / NXCD; wgid = (xcd < r ? xcd * (q + 1) : r * (q + 1) + (xcd - r) * q) + off; }
    const int nig = WGM * nN, gid = wgid / nig, fm = gid * WGM, gsz = (nM - fm) < WGM ? (nM - fm) : WGM;
    pm = fm + ((wgid % nig) % gsz); pn = (wgid % nig) / gsz;
}

typedef int i32x8 __attribute__((ext_vector_type(8)));
template <class Epi, class Sched, bool FP8 = false>
__device__ __forceinline__ void gemm_phase(LAS unsigned char* lds, const Sched& S, const Epi& E, const int tid) {
    const int wid = __builtin_amdgcn_readfirstlane(tid >> 6), lane = tid & 63, wr = wid >> 2, wc = wid & 3, fr = lane & 15, fq = lane >> 4;
    int sR, sRb, sC2;
    { int R, C; stage_rc(tid * 16, R, C); sR = R; sRb = (R & ~31) + perm32(R & 31); sC2 = C * 2; }
    const size_t kstep = (size_t)(BK * 2);
    const unsigned ldsw = (unsigned)wid * 1024u;
    const int aoff = lds_byte(wr * 64 + fr, FP8 ? fq * 16 : fq * 8), boff = lds_byte(wc * 32 + fr, FP8 ? fq * 16 : fq * 8);
#define PG8_SA(b, h) (((b) * 2 + (h)) * HTB)
#define PG8_SB(b, h) ((4 + (b) * 2 + (h)) * HTB)
#define PG8_STAGE(bufoff, gbase, rows, pitch) do { const unsigned _o = (unsigned)((rows) * (pitch) + sC2); _Pragma("unroll") for (int _i = 0; _i < 2; ++_i) \
        __builtin_amdgcn_global_load_lds((const unsigned*)((const char*)(gbase) + (size_t)(_i * 64) * (pitch) + _o), (LAS unsigned*)(lds + (bufoff) + ldsw + _i * 8192), 16, 0, 0); } while (0)
#define PG8_LDA(dst, b, h) do { if constexpr (FP8) { _Pragma("unroll") for (int m = 0; m < 4; ++m) { const u32x4 lo_ = *(const LAS u32x4*)(lds + PG8_SA(b, h) + aoff + m * 2048), hi_ = *(const LAS u32x4*)(lds + PG8_SA(b, h) + aoff + m * 2048 + 16); \
            dst##8[m] = (i32x8){(int)lo_.x, (int)lo_.y, (int)lo_.z, (int)lo_.w, (int)hi_.x, (int)hi_.y, (int)hi_.z, (int)hi_.w}; } } \
        else { _Pragma("unroll") for (int m = 0; m < 4; ++m) _Pragma("unroll") for (int k = 0; k < 2; ++k) dst[m][k] = *(const LAS bf16x8*)(lds + PG8_SA(b, h) + aoff + m * 2048 + k * 1024); } } while (0)
#define PG8_LDB(dst, b, h) do { if constexpr (FP8) { _Pragma("unroll") for (int n = 0; n < 2; ++n) { const u32x4 lo_ = *(const LAS u32x4*)(lds + PG8_SB(b, h) + boff + n * 2048), hi_ = *(const LAS u32x4*)(lds + PG8_SB(b, h) + boff + n * 2048 + 16); \
            dst##8[n] = (i32x8){(int)lo_.x, (int)lo_.y, (int)lo_.z, (int)lo_.w, (int)hi_.x, (int)hi_.y, (int)hi_.z, (int)hi_.w}; } } \
        else { _Pragma("unroll") for (int n = 0; n < 2; ++n) _Pragma("unroll") for (int k = 0; k < 2; ++k) dst[n][k] = *(const LAS bf16x8*)(lds + PG8_SB(b, h) + boff + n * 2048 + k * 1024); } } while (0)
#define PG8_MMA(ai, bj, At, Bt) do { __builtin_amdgcn_s_setprio(1); if constexpr (FP8) { _Pragma("unroll") for (int m = 0; m < 4; ++m) _Pragma("unroll") for (int n = 0; n < 2; ++n) \
            asm volatile("v_mfma_scale_f32_16x16x128_f8f6f4 %0, %1, %2, %0, %3, %3 op_sel_hi:[0,0,0]" : "+v"(acc[ai][bj][m][n]) : "v"(Bt##8[n]), "v"(At##8[m]), "v"(scl8)); } \
        else { _Pragma("unroll") for (int m = 0; m < 4; ++m) _Pragma("unroll") for (int n = 0; n < 2; ++n) _Pragma("unroll") for (int k = 0; k < 2; ++k) \
            acc[ai][bj][m][n] = __builtin_amdgcn_mfma_f32_16x16x32_bf16(Bt[n][k], At[m][k], acc[ai][bj][m][n], 0, 0, 0); } __builtin_amdgcn_s_setprio(0); } while (0)
#define PG8_WAIT_V(n) asm volatile("s_waitcnt vmcnt(" #n ")" ::: "memory")
#define PG8_WAIT_L(n) asm volatile("s_waitcnt lgkmcnt(" #n ")" ::: "memory")
#define PG8_BAR __builtin_amdgcn_s_barrier()
#define PG8_SCHED __builtin_amdgcn_sched_barrier(0)
    UnitD cur, nxt; int ui = 0;
    if (!S.next(0, cur)) return;
    f32x4 acc[2][2][4][2];
#pragma unroll
    for (int a = 0; a < 2; ++a)
#pragma unroll
        for (int b = 0; b < 2; ++b)
#pragma unroll
            for (int m = 0; m < 4; ++m)
#pragma unroll
                for (int n = 0; n < 2; ++n) acc[a][b][m][n] = (f32x4){0.f, 0.f, 0.f, 0.f};
    bf16x8 At[4][2], B0[2][2], B1[2][2]; i32x8 At8[4], B08[2], B18[2];
    int scl8 = 0x7c7c7c7c; asm volatile("" : "+v"(scl8));
    const char* cA = cur.A; const char* cB = cur.B;
    int pA = cur.lda2, pB = cur.ldb2;
    PG8_STAGE(PG8_SB(0, 0), cB, sRb, pB); PG8_STAGE(PG8_SB(0, 1), cB + (size_t)HALF * pB, sRb, pB); PG8_STAGE(PG8_SA(0, 0), cA, sR, pA); PG8_STAGE(PG8_SA(0, 1), cA + (size_t)HALF * pA, sR, pA);
    if (wr == 1) PG8_BAR;
    PG8_WAIT_V(2); PG8_BAR;
    PG8_STAGE(PG8_SB(1, 0), cB + kstep, sRb, pB); PG8_STAGE(PG8_SA(1, 0), cA + kstep, sR, pA); PG8_STAGE(PG8_SB(1, 1), cB + (size_t)HALF * pB + kstep, sRb, pB);
    PG8_WAIT_V(6); PG8_BAR;
    for (;;) {
        const bool has_next = S.next(ui + 1, nxt);
        if (!has_next) nxt = cur;
        const char* nA = nxt.A; const char* nB = nxt.B;
        const int nt = cur.nt;
        for (int t = 0; t < nt; t += 2) {
            const bool last = (t == nt - 2);
            const char* a1 = cA + (size_t)(t + 1) * kstep + (size_t)HALF * pA;
            const char* a2 = last ? nA : cA + (size_t)(t + 2) * kstep; const char* b2 = last ? nB : cB + (size_t)(t + 2) * kstep;
            const int p2A = last ? nxt.lda2 : pA, p2B = last ? nxt.ldb2 : pB;
            const char* a2h = a2 + (size_t)HALF * p2A; const char* b2h = b2 + (size_t)HALF * p2B;
            PG8_LDB(B0, 0, 0); PG8_LDB(B1, 0, 1); PG8_SCHED; PG8_LDA(At, 0, 0); PG8_STAGE(PG8_SA(1, 1), a1, sR, pA);
            PG8_WAIT_V(8); PG8_WAIT_L(0); PG8_BAR; PG8_MMA(0, 0, At, B0); PG8_MMA(0, 1, At, B1); PG8_BAR; PG8_SCHED;
            PG8_LDA(At, 0, 1); PG8_STAGE(PG8_SB(0, 0), b2, sRb, p2B); PG8_STAGE(PG8_SB(0, 1), b2h, sRb, p2B); PG8_STAGE(PG8_SA(0, 0), a2, sR, p2A);
            PG8_WAIT_V(8); PG8_WAIT_L(0); PG8_BAR; PG8_MMA(1, 0, At, B0); PG8_MMA(1, 1, At, B1); PG8_BAR; PG8_SCHED;
            PG8_LDB(B0, 1, 0); PG8_LDB(B1, 1, 1); PG8_SCHED; PG8_LDA(At, 1, 0); PG8_STAGE(PG8_SA(0, 1), a2h, sR, p2A);
            PG8_WAIT_V(8); PG8_WAIT_L(0); PG8_BAR; PG8_MMA(0, 0, At, B0); PG8_MMA(0, 1, At, B1); PG8_BAR; PG8_SCHED;
            PG8_LDA(At, 1, 1); PG8_STAGE(PG8_SB(1, 0), b2 + kstep, sRb, p2B); PG8_STAGE(PG8_SB(1, 1), b2h + kstep, sRb, p2B); PG8_STAGE(PG8_SA(1, 0), a2 + kstep, sR, p2A);
            PG8_WAIT_V(8); PG8_WAIT_L(0); PG8_BAR; PG8_MMA(1, 0, At, B0); PG8_MMA(1, 1, At, B1); PG8_BAR; PG8_SCHED;
        }
        if constexpr (FP8) asm volatile("s_nop 15\n\ts_nop 15" ::: "memory");
        if (wr == 0) PG8_BAR;
        { int l2; asm volatile("v_mbcnt_lo_u32_b32 %0, -1, 0\n\tv_mbcnt_hi_u32_b32 %0, -1, %0" : "=v"(l2)); E(acc, cur, wr, wc, l2 & 15, l2 >> 4, wid * 64 + l2); asm volatile("s_waitcnt vmcnt(0)" ::: "memory"); }
        if (!has_next) break;
#pragma unroll
        for (int a = 0; a < 2; ++a)
#pragma unroll
            for (int b = 0; b < 2; ++b)
#pragma unroll
                for (int m = 0; m < 4; ++m)
#pragma unroll
                    for (int n = 0; n < 2; ++n) acc[a][b][m][n] = (f32x4){0.f, 0.f, 0.f, 0.f};
        cur = nxt; cA = nA; cB = nB; pA = cur.lda2; pB = cur.ldb2;
        ++ui;
        if (wr == 1) PG8_BAR;
    }
    PG8_WAIT_V(0);
    PG8_BAR;
#undef PG8_SA
#undef PG8_SB
#undef PG8_STAGE
#undef PG8_LDA
#undef PG8_LDB
#undef PG8_MMA
#undef PG8_WAIT_V
#undef PG8_WAIT_L
#undef PG8_BAR
#undef PG8_SCHED
}

struct SchedPlain {
    const char* A; const char* B; int lda2, ldb2, nt, nM, nN, G, c;
    __device__ __forceinline__ bool next(int i, UnitD& u) const {
        const long L = (long)i * G + c; if (L >= (long)nM * nN) return false;
        int pm, pn; tile_map((int)L, nM, nN, pm, pn);
        u.A = A + (size_t)pm * 256 * lda2; u.B = B + (size_t)pn * 256 * ldb2; u.lda2 = lda2; u.ldb2 = ldb2; u.nt = nt; u.pm = pm; u.pn = pn; u.kind = i; return true;
    }
};
struct SchedG5b {
    const char* A; const char* B; int G, c;
    __device__ __forceinline__ bool next(int i, UnitD& u) const {
        const long L = (long)i * G + c; if (L >= 128 * 4) return false;
        int pm, pn; tile_map((int)L, 128, 4, pm, pn);
        u.A = A + (size_t)pm * 256 * (UGW * 2); u.lda2 = UGW * 2; u.B = B + (size_t)pn * 256 * (DFF * 2); u.ldb2 = DFF * 2; u.nt = 44; u.pm = pm; u.pn = pn; u.kind = i; return true;
    }
};

#define EPI_LOOP for (int ai = 0; ai < 2; ++ai) _Pragma("unroll") for (int m = 0; m < 4; ++m) _Pragma("unroll") for (int bj = 0; bj < 2; ++bj)
struct EpiStore {
    bf16* O; int ldc;
    __device__ __forceinline__ void operator()(const f32x4 (&acc)[2][2][4][2], const UnitD& u, int wr, int wc, int fr, int fq, int tid) const {
        const int row0 = u.pm * BM + wr * 64 + fr, col0 = u.pn * BM + wc * 32 + 8 * fq;
#pragma unroll
        EPI_LOOP { const f32x4 v0 = acc[ai][bj][m][0], v1 = acc[ai][bj][m][1];
            u32x4 w; w.x = pk2(v0[0], v0[1]); w.y = pk2(v0[2], v0[3]); w.z = pk2(v1[0], v1[1]); w.w = pk2(v1[2], v1[3]);
            *(u32x4*)(O + (size_t)(row0 + ai * HALF + m * 16) * ldc + col0 + bj * HALF) = w; }
    }
};
struct EpiSlotStore {
    unsigned char* sc_; int act;
    __device__ __forceinline__ void operator()(const f32x4 (&acc)[2][2][4][2], const UnitD& u, int wr, int wc, int fr, int fq, int tid) const {
        unsigned loff = (unsigned)tid * 16u; asm volatile("" : "+v"(loff));
        unsigned char* sc = sc_ + (size_t)u.kind * 131072 + loff;
#pragma unroll
        EPI_LOOP { const int q = (ai * 2 + bj) * 4 + m; f32x4 v0 = acc[ai][bj][m][0], v1 = acc[ai][bj][m][1];
            if (act) { v0 = (f32x4){sigmoidf_(v0[0]), sigmoidf_(v0[1]), sigmoidf_(v0[2]), sigmoidf_(v0[3])}; v1 = (f32x4){sigmoidf_(v1[0]), sigmoidf_(v1[1]), sigmoidf_(v1[2]), sigmoidf_(v1[3])}; }
            u32x4 w; w.x = pk2(v0[0], v0[1]); w.y = pk2(v0[2], v0[3]); w.z = pk2(v1[0], v1[1]); w.w = pk2(v1[2], v1[3]);
            *(u32x4*)(sc + (size_t)q * 8192) = w; }
    }
};
struct EpiSlotMul {
    unsigned char* sc_;
    __device__ __forceinline__ void operator()(const f32x4 (&acc)[2][2][4][2], const UnitD& u, int wr, int wc, int fr, int fq, int tid) const {
        unsigned loff = (unsigned)tid * 16u; asm volatile("" : "+v"(loff));
        unsigned char* sc = sc_ + (size_t)u.kind * 131072 + loff;
#pragma unroll
        EPI_LOOP { const int q = (ai * 2 + bj) * 4 + m; const f32x4 v0 = acc[ai][bj][m][0], v1 = acc[ai][bj][m][1];
            u32x4* sp = (u32x4*)(sc + (size_t)q * 8192); const u32x4 p = *sp;
            u32x4 w; w.x = pk2(sigmoidf_(v0[0]) * bflo(p.x), sigmoidf_(v0[1]) * bfhi(p.x)); w.y = pk2(sigmoidf_(v0[2]) * bflo(p.y), sigmoidf_(v0[3]) * bfhi(p.y));
            w.z = pk2(sigmoidf_(v1[0]) * bflo(p.z), sigmoidf_(v1[1]) * bfhi(p.z)); w.w = pk2(sigmoidf_(v1[2]) * bflo(p.w), sigmoidf_(v1[3]) * bfhi(p.w));
            *sp = w;
            if (m & 1) asm volatile("" ::: "memory"); }
    }
};
struct EpiBranch {
    const unsigned char* sc_; bf16* MG; int first;
    __device__ __forceinline__ void operator()(const f32x4 (&acc)[2][2][4][2], const UnitD& u, int wr, int wc, int fr, int fq, int tid) const {
        const int row0 = u.pm * BM + wr * 64 + fr, col0 = u.pn * BM + wc * 32 + 8 * fq;
        unsigned loff = (unsigned)tid * 16u; asm volatile("" : "+v"(loff));
        const unsigned char* sc = sc_ + (size_t)u.kind * 131072 + loff;
#pragma unroll
        EPI_LOOP { const int q = (ai * 2 + bj) * 4 + m; const f32x4 v0 = acc[ai][bj][m][0], v1 = acc[ai][bj][m][1];
            const u32x4 g = *(const u32x4*)(sc + (size_t)q * 8192);
            u32x4* p = (u32x4*)(MG + (size_t)(row0 + ai * HALF + m * 16) * DM + col0 + bj * HALF);
            f32x4 t0 = (f32x4){bflo(g.x) * v0[0], bfhi(g.x) * v0[1], bflo(g.y) * v0[2], bfhi(g.y) * v0[3]};
            f32x4 t1 = (f32x4){bflo(g.z) * v1[0], bfhi(g.z) * v1[1], bflo(g.w) * v1[2], bfhi(g.w) * v1[3]};
            if (!first) { const u32x4 x = *p; t0 += (f32x4){bflo(x.x), bfhi(x.x), bflo(x.y), bfhi(x.y)}; t1 += (f32x4){bflo(x.z), bfhi(x.z), bflo(x.w), bfhi(x.w)}; }
            u32x4 w; w.x = pk2(t0[0], t0[1]); w.y = pk2(t0[2], t0[3]); w.z = pk2(t1[0], t1[1]); w.w = pk2(t1[2], t1[3]);
            *p = w;
            if (m & 1) asm volatile("" ::: "memory"); }
    }
};
struct EpiG3 {
    bf16* XB;
    __device__ __forceinline__ void operator()(const f32x4 (&acc)[2][2][4][2], const UnitD& u, int wr, int wc, int fr, int fq, int tid) const {
        const int row0 = u.pm * BM + wr * 64 + fr, col0 = u.pn * BM + wc * 32 + 8 * fq;
#pragma unroll
        EPI_LOOP { const f32x4 v0 = acc[ai][bj][m][0], v1 = acc[ai][bj][m][1];
            u32x4* p = (u32x4*)(XB + (size_t)(row0 + ai * HALF + m * 16) * DM + col0 + bj * HALF); const u32x4 x = *p;
            u32x4 w; w.x = pk2(ALPHA * bflo(x.x) + v0[0], ALPHA * bfhi(x.x) + v0[1]); w.y = pk2(ALPHA * bflo(x.y) + v0[2], ALPHA * bfhi(x.y) + v0[3]);
            w.z = pk2(ALPHA * bflo(x.z) + v1[0], ALPHA * bfhi(x.z) + v1[1]); w.w = pk2(ALPHA * bflo(x.w) + v1[2], ALPHA * bfhi(x.w) + v1[3]);
            *p = w; }
    }
};
struct EpiG5b {
    const unsigned char* esc_; bf16* XB;
    __device__ __forceinline__ void operator()(const f32x4 (&acc)[2][2][4][2], const UnitD& u, int wr, int wc, int fr, int fq, int tid) const {
        const int row0 = u.pm * BM + wr * 64 + fr, col0 = u.pn * BM + wc * 32 + 8 * fq;
        unsigned loff = (unsigned)tid * 16u; asm volatile("" : "+v"(loff));
        const unsigned char* esc = esc_ + (size_t)u.kind * 131072 + loff;
#pragma unroll
        EPI_LOOP { const int q = (ai * 2 + bj) * 4 + m; const f32x4 v0 = acc[ai][bj][m][0], v1 = acc[ai][bj][m][1];
            const u32x4 e = *(const u32x4*)(esc + (size_t)q * 8192);
            u32x4* p = (u32x4*)(XB + (size_t)(row0 + ai * HALF + m * 16) * DM + col0 + bj * HALF); const u32x4 x = *p;
            u32x4 w; w.x = pk2(ALPHA * bflo(x.x) + v0[0] + bflo(e.x), ALPHA * bfhi(x.x) + v0[1] + bfhi(e.x)); w.y = pk2(ALPHA * bflo(x.y) + v0[2] + bflo(e.y), ALPHA * bfhi(x.y) + v0[3] + bfhi(e.y));
            w.z = pk2(ALPHA * bflo(x.z) + v1[0] + bflo(e.z), ALPHA * bfhi(x.z) + v1[1] + bfhi(e.z)); w.w = pk2(ALPHA * bflo(x.w) + v1[2] + bflo(e.w), ALPHA * bfhi(x.w) + v1[3] + bfhi(e.w));
            *p = w;
            if (m & 1) asm volatile("" ::: "memory"); }
    }
};
}

struct Frame {
    LAS unsigned char* lds;
    int tid, lane, wave, G, wg;
    unsigned char* ws; unsigned char* dob;
};
struct Args { const float* in[21]; float* out; unsigned char* ws; int ph_lo, ph_hi, sub, pad; };

__device__ __forceinline__ int z_src(int n, float& sc) {
    sc = 1.f;
    if (n < 768) { if (n < 256) sc = 0.17677669529663687f * LOG2E; return n; }
    if (n < 1536) { if (n < 1024) sc = 0.125f * LOG2E; return n; }
    if (n < 2560) { if (n >= 1792 && n < 2048) sc = 0.125f; return 1700 + (n - 1536); }
    if (n < 2816) { if (n < 2688) sc = 0.17677669529663687f; return 2724 + (n - 2560); }
    if (n < 3072) return 2980 + (n - 2816);
    if (n < 3328) return 3252 + (n - 3072);
    if (n < 3456) return 1536 + (n - 3328);
    if (n < 3488) return 1664 + (n - 3456);
    if (n < 3492) return 1696 + (n - 3488);
    if (n >= 3504 && n < 3520) return 3236 + (n - 3504);
    return -1;
}
template <int MODE>
__device__ __forceinline__ void transpose_item(const float* W, int Nsrc, int soff, bf16* WT, int dpitch, int dcol0, int k0, int n0, LAS float* scr, int lane) {
    const int nn = lane & 31; float sc = 1.f; int s;
    if (MODE == 1) s = z_src(n0 + nn, sc); else s = soff + n0 + nn;
#pragma unroll 8
    for (int i = 0; i < 32; ++i) { const int kk = 2 * i + (lane >> 5); scr[kk * 33 + nn] = (s >= 0) ? W[(size_t)(k0 + kk) * Nsrc + s] * sc : 0.f; }
    asm volatile("s_waitcnt lgkmcnt(0)" ::: "memory");
    const int c = lane & 7;
#pragma unroll
    for (int j = 0; j < 4; ++j) { const int n = (lane >> 3) + 8 * j; const LAS float* sp = scr + (8 * c) * 33 + n;
        u32x4 o; o.x = pk2(sp[0 * 33], sp[1 * 33]); o.y = pk2(sp[2 * 33], sp[3 * 33]); o.z = pk2(sp[4 * 33], sp[5 * 33]); o.w = pk2(sp[6 * 33], sp[7 * 33]);
        *(u32x4*)(WT + (size_t)(n0 + n) * dpitch + dcol0 + k0 + 8 * c) = o; }
    asm volatile("s_waitcnt lgkmcnt(0)" ::: "memory");
}
__device__ __forceinline__ void transpose_item8(const float* W, int Nsrc, int soff, unsigned char* WT, int K, int k0, int n0, LAS float* scr, int lane) {
    const int nn = lane & 31; const int s = soff + n0 + nn;
#pragma unroll 8
    for (int i = 0; i < 32; ++i) { const int kk = 2 * i + (lane >> 5); scr[kk * 33 + nn] = W[(size_t)(k0 + kk) * Nsrc + s] * 64.f; }
    asm volatile("s_waitcnt lgkmcnt(0)" ::: "memory");
    const int c = lane & 7;
#pragma unroll
    for (int j = 0; j < 4; ++j) { const int n = (lane >> 3) + 8 * j; const LAS float* sp = scr + (8 * c) * 33 + n;
        u32x2 o; o.x = pk4f8(sp[0 * 33], sp[1 * 33], sp[2 * 33], sp[3 * 33]); o.y = pk4f8(sp[4 * 33], sp[5 * 33], sp[6 * 33], sp[7 * 33]);
        *(u32x2*)(WT + (size_t)(n0 + n) * K + k0 + 8 * c) = o; }
    asm volatile("s_waitcnt lgkmcnt(0)" ::: "memory");
}
typedef __attribute__((address_space(4))) const struct Args* KArgPtr;
__device__ __forceinline__ void convert_w123(Frame& F, const float* w_in, const float* w_branch, const float* w_out) {
    LAS float* scr = (LAS float*)(F.lds + F.wave * 16384);
    const int gw = F.wg * NWAVES + F.wave, NGW = F.G * NWAVES;
    constexpr int I1 = 16 * 112, I2 = 16 * 128, I3 = 4 * 128, I4 = 16 * 32;
    unsigned char* w123 = F.ws + WS_W123;
    for (int it = gw; it < I1 + I2 + I3 + I4; it += NGW) {
        int r = it;
        if (r < I1) { transpose_item<1>(w_in, NIN, 0, (bf16*)(w123 + W123_W1), 1024, 0, 64 * (r / 112), 32 * (r % 112), scr, F.lane); continue; } r -= I1;
        if (r < I2) { transpose_item<0>(w_in, NIN, SRC_MG, (bf16*)(w123 + W123_GB), 1024, 0, 64 * (r / 128), 32 * (r % 128), scr, F.lane); continue; } r -= I2;
        if (r < I3) { const int n = r / 128, rr = r % 128; transpose_item<0>(w_branch + (size_t)n * 256 * DM, DM, 0, (bf16*)(w123 + W123_GB + 8 * MiB) + (size_t)n * 1024 * 256, 256, 0, 64 * (rr / 32), 32 * (rr % 32), scr, F.lane); continue; } r -= I3;
        transpose_item<0>(w_out, DM, 0, (bf16*)(w123 + W123_WO), 1024, 0, 64 * (r / 32), 32 * (r % 32), scr, F.lane);
    }
}
__device__ __forceinline__ void p0_prologue(Frame& F, __attribute__((address_space(4))) const Args* Ap) {
    LAS float* scr = (LAS float*)(F.lds + F.wave * 16384);
    const int gw = F.wg * NWAVES + F.wave, NGW = F.G * NWAVES;
    constexpr int I5 = 16 * 176, I6 = 16 * 32, I7 = 4 * 32, I8 = 44 * 32;
    constexpr int IL = I5 + I6 + I7 + I8;
    for (int it = gw; it < 2 * IL; it += NGW) {
        const int l = it / IL; int r = it - l * IL;
        unsigned char* w45 = F.ws + WS_W45 + (size_t)l * W45_STRIDE;
        if (r < I5) { transpose_item<0>(Ap->in[13] + (size_t)l * DM * UGW, UGW, 0, (bf16*)(w45 + W45_UP), 1024, 0, 64 * (r / 176), 32 * (r % 176), scr, F.lane); continue; } r -= I5;
        if (r < I6) { transpose_item<0>(Ap->in[17] + (size_t)l * DM * DM, DM, 0, (bf16*)(w45 + W45_PG), 1024, 0, 64 * (r / 32), 32 * (r % 32), scr, F.lane); continue; } r -= I6;
        if (r < I7) { transpose_item<0>(Ap->in[18] + (size_t)l * PDIM * DM, DM, 0, (bf16*)(w45 + W45_PP), 256, 0, 64 * (r / 32), 32 * (r % 32), scr, F.lane); continue; } r -= I7;
        transpose_item<0>(Ap->in[16] + (size_t)l * DFF * DM, DM, 0, (bf16*)(w45 + W45_DN), DFF, 0, 64 * (r / 32), 32 * (r % 32), scr, F.lane);
    }
    {   constexpr int J1 = 16 * 128, J2 = 16 * 176, J3 = 16 * 32, JL = J1 + J2 + J3;
        for (int it = gw; it < 2 * JL; it += NGW) { const int l = it / JL; int r = it - l * JL; unsigned char* w8 = F.dob + DO_W8 + (size_t)l * W8_STRIDE;
            if (r < J1) { transpose_item8(Ap->in[2] + (size_t)l * DM * NIN, NIN, SRC_MG, w8 + W8_G, 1024, 64 * (r / 128), 32 * (r % 128), scr, F.lane); continue; } r -= J1;
            if (r < J2) { transpose_item8(Ap->in[13] + (size_t)l * DM * UGW, UGW, 0, w8 + W8_UP, 1024, 64 * (r / 176), 32 * (r % 176), scr, F.lane); continue; } r -= J2;
            transpose_item8(Ap->in[17] + (size_t)l * DM * DM, DM, 0, w8 + W8_PG, 1024, 64 * (r / 32), 32 * (r % 32), scr, F.lane); } }
    convert_w123(F, Ap->in[2], Ap->in[9], Ap->in[10]);
    {   const size_t n8 = (size_t)M * DM / 8; const f32x4* src = (const f32x4*)Ap->in[0]; u32x4* dst = (u32x4*)(F.ws + WS_XB); u32x2* dst8 = (u32x2*)(F.dob + DO_XB8);
        for (size_t i = (size_t)F.wg * 512 + F.tid; i < n8; i += (size_t)F.G * 512) { const f32x4 a = src[2 * i], b = src[2 * i + 1]; u32x4 o; o.x = pk2(a[0], a[1]); o.y = pk2(a[2], a[3]); o.z = pk2(b[0], b[1]); o.w = pk2(b[2], b[3]); dst[i] = o;
            u32x2 o8; o8.x = pk4f8(a[0], a[1], a[2], a[3]); o8.y = pk4f8(b[0], b[1], b[2], b[3]); dst8[i] = o8; } }
    {   const size_t n8 = (size_t)DEPTH * M * PDIM / 8; const f32x4* src = (const f32x4*)Ap->in[1]; u32x4* dst = (u32x4*)(F.ws + WS_PB);
        for (size_t i = (size_t)F.wg * 512 + F.tid; i < n8; i += (size_t)F.G * 512) { const f32x4 a = src[2 * i], b = src[2 * i + 1]; u32x4 o; o.x = pk2(a[0], a[1]); o.y = pk2(a[2], a[3]); o.z = pk2(b[0], b[1]); o.w = pk2(b[2], b[3]); dst[i] = o; } }
}

__device__ __forceinline__ void ln_phase(Frame& F, const float* w, const float* bvec, float* outf, unsigned char* xb8) {
    const int gw = F.wg * NWAVES + F.wave, NGW = F.G * NWAVES;
    bf16* XB = (bf16*)(F.ws + WS_XB);
    for (int row = gw; row < M; row += NGW) {
        u32x4* p = (u32x4*)(XB + (size_t)row * DM) + F.lane;
        const u32x4 a = p[0], b = p[64];
        float v[16] = {bflo(a.x), bfhi(a.x), bflo(a.y), bfhi(a.y), bflo(a.z), bfhi(a.z), bflo(a.w), bfhi(a.w), bflo(b.x), bfhi(b.x), bflo(b.y), bfhi(b.y), bflo(b.z), bfhi(b.z), bflo(b.w), bfhi(b.w)};
        float s = 0.f;
#pragma unroll
        for (int i = 0; i < 16; ++i) s += v[i];
        const float mean = wave_sum(s, F.lane) * (1.f / DM); float q = 0.f;
#pragma unroll
        for (int i = 0; i < 16; ++i) { v[i] -= mean; q += v[i] * v[i]; }
        const float rstd = 1.f / sqrtf(wave_sum(q, F.lane) * (1.f / DM) + LN_EPS);
        const int c0 = F.lane * 8, c1 = 512 + F.lane * 8;
        const f32x4 w0 = *(const f32x4*)(w + c0), w1 = *(const f32x4*)(w + c0 + 4), w2 = *(const f32x4*)(w + c1), w3 = *(const f32x4*)(w + c1 + 4);
        const f32x4 b0 = *(const f32x4*)(bvec + c0), b1 = *(const f32x4*)(bvec + c0 + 4), b2 = *(const f32x4*)(bvec + c1), b3 = *(const f32x4*)(bvec + c1 + 4);
        f32x4 y0, y1, y2, y3;
#pragma unroll
        for (int i = 0; i < 4; ++i) { y0[i] = v[i] * rstd * w0[i] + b0[i]; y1[i] = v[4 + i] * rstd * w1[i] + b1[i]; y2[i] = v[8 + i] * rstd * w2[i] + b2[i]; y3[i] = v[12 + i] * rstd * w3[i] + b3[i]; }
        u32x4 o0, o1; o0.x = pk2(y0[0], y0[1]); o0.y = pk2(y0[2], y0[3]); o0.z = pk2(y1[0], y1[1]); o0.w = pk2(y1[2], y1[3]);
        o1.x = pk2(y2[0], y2[1]); o1.y = pk2(y2[2], y2[3]); o1.z = pk2(y3[0], y3[1]); o1.w = pk2(y3[2], y3[3]);
        p[0] = o0; p[64] = o1;
        if (xb8) { u32x2* q8 = (u32x2*)(xb8 + (size_t)row * DM) + F.lane; u32x2 a8, b8; a8.x = pk4f8(y0[0], y0[1], y0[2], y0[3]); a8.y = pk4f8(y1[0], y1[1], y1[2], y1[3]); b8.x = pk4f8(y2[0], y2[1], y2[2], y2[3]); b8.y = pk4f8(y3[0], y3[1], y3[2], y3[3]); q8[0] = a8; q8[64] = b8; }
        if (outf) { f32x4* op = (f32x4*)(outf + (size_t)row * DM); op[2 * F.lane] = y0; op[2 * F.lane + 1] = y1; op[128 + 2 * F.lane] = y2; op[128 + 2 * F.lane + 1] = y3; }
    }
}

__device__ __forceinline__ float gelu_tanh_(float y) { const float t = 1.5957691216057308f * (y + 0.044715f * y * y * y); return y * __builtin_amdgcn_rcpf(1.0f + __builtin_amdgcn_exp2f(-LOG2E * t)); }
__device__ __forceinline__ void up8(const u32x4 w, float (&v)[8]) { v[0] = bflo(w.x); v[1] = bfhi(w.x); v[2] = bflo(w.y); v[3] = bfhi(w.y); v[4] = bflo(w.z); v[5] = bfhi(w.z); v[6] = bflo(w.w); v[7] = bfhi(w.w); }
__device__ __forceinline__ void ffn_act_phase(Frame& F, const float* cw, const float* cb) {
    bf16* UG = (bf16*)(F.ws + WS_UG);
    constexpr int NCG = DFF / 8, RB = 32, NRB = M / RB;
    for (int task = F.wg * 512 + F.tid; task < NCG * NRB; task += F.G * 512) {
        const int rb = task / NCG, cg = task - rb * NCG; const int t0 = rb * RB, c0 = cg * 8;
        float w0[8], w1[8], w2[8], bb[8];
#pragma unroll
        for (int i = 0; i < 8; ++i) { w0[i] = cw[c0 + i]; w1[i] = cw[DFF + c0 + i]; w2[i] = cw[2 * DFF + c0 + i]; bb[i] = cb[c0 + i]; }
        float gm2[8], gm1[8];
        if ((t0 & (SEQ - 1)) == 0) {
#pragma unroll
            for (int i = 0; i < 8; ++i) { gm2[i] = 0.f; gm1[i] = 0.f; }
        } else { up8(*(const u32x4*)(UG + (size_t)(t0 - 2) * UGW + DFF + c0), gm2); up8(*(const u32x4*)(UG + (size_t)(t0 - 1) * UGW + DFF + c0), gm1); }
        for (int r0 = 0; r0 < RB; r0 += 8) { u32x4 gq[8], uq[8];
#pragma unroll
            for (int r = 0; r < 8; ++r) { const bf16* rowp = UG + (size_t)(t0 + r0 + r) * UGW; gq[r] = *(const u32x4*)(rowp + DFF + c0); uq[r] = *(const u32x4*)(rowp + c0); }
#pragma unroll
            for (int r = 0; r < 8; ++r) { float g0[8], uu[8], o[8]; up8(gq[r], g0); up8(uq[r], uu);
#pragma unroll
                for (int i = 0; i < 8; ++i) { const float y = bb[i] + w0[i] * gm2[i] + w1[i] * gm1[i] + w2[i] * g0[i]; o[i] = gelu_tanh_(y) * uu[i]; gm2[i] = gm1[i]; gm1[i] = g0[i]; }
                u32x4 w; w.x = pk2(o[0], o[1]); w.y = pk2(o[2], o[3]); w.z = pk2(o[4], o[5]); w.w = pk2(o[6], o[7]);
                *(u32x4*)(UG + (size_t)(t0 + r0 + r) * UGW + c0) = w; } }
    }
}

namespace mx {
__device__ __forceinline__ f32x16 mfma32(bf16x8 a, bf16x8 b, f32x16 c) { return __builtin_amdgcn_mfma_f32_32x32x16_bf16(a, b, c, 0, 0, 0); }
__device__ __forceinline__ f32x16 splat16(float v) { f32x16 r;
#pragma unroll
    for (int i = 0; i < 16; ++i) r[i] = v;
    return r; }
__device__ __forceinline__ int crow_c(int e) { return (e & 3) + 8 * (e >> 2); }
typedef short v4i16_t __attribute__((ext_vector_type(4)));
__device__ __forceinline__ s16x4 vtr(const LAS unsigned char* p) { return __builtin_bit_cast(s16x4, __builtin_amdgcn_ds_read_tr16_b64_v4i16((LAS v4i16_t*)p)); }
__device__ __forceinline__ bf16x8 pack8(float a0, float a1, float a2, float a3, float a4, float a5, float a6, float a7) {
    u32x4 w; w.x = pk2(a0, a1); w.y = pk2(a2, a3); w.z = pk2(a4, a5); w.w = pk2(a6, a7); return __builtin_bit_cast(bf16x8, w); }

__device__ __forceinline__ float log2gam(int h) { return __builtin_log2f(1.0f - __builtin_exp2f(-5.0f - (float)h)); }
__device__ __forceinline__ void prepkv_unit(Frame& F, int blk, const float* wa2, const float* bap, unsigned* kmaxl) {
    bf16* Z = (bf16*)(F.ws + WS_Z);
    const size_t r0 = (size_t)blk * 256; const int b = blk >> 5, cb = blk & 31;
    const int tid = F.tid;
    {   const int ch = tid >> 7, col = tid & 127;
        const float ba = bap[col];
        float wa[16];
#pragma unroll
        for (int r = 0; r < 16; ++r) wa[r] = wa2[r * 128 + col];
        float cum = 0.f;
        for (int t0 = 0; t0 < 64; t0 += 8) { u32x4 A[8], B[8];
#pragma unroll
            for (int tt = 0; tt < 8; ++tt) { const bf16* zr = Z + (r0 + ch * 64 + t0 + tt) * ZW; A[tt] = *(const u32x4*)(zr + ZC_DA); B[tt] = *(const u32x4*)(zr + ZC_DA + 8); }
#pragma unroll
            for (int tt = 0; tt < 8; ++tt) { float da[8], db[8]; up8(A[tt], da); up8(B[tt], db); float x = ba;
#pragma unroll
                for (int r = 0; r < 8; ++r) x += da[r] * wa[r];
#pragma unroll
                for (int r = 0; r < 8; ++r) x += db[r] * wa[8 + r];
                cum += (fminf(x, 0.f) - __logf(1.0f + __expf(-fabsf(x)))) * 0.0625f; } }
        const float bl = cum; cum = 0.f;
        for (int t0 = 0; t0 < 64; t0 += 8) { u32x4 A[8], B[8]; bf16 qv[8], kv[8];
#pragma unroll
            for (int tt = 0; tt < 8; ++tt) { const bf16* zr = Z + (r0 + ch * 64 + t0 + tt) * ZW; A[tt] = *(const u32x4*)(zr + ZC_DA); B[tt] = *(const u32x4*)(zr + ZC_DA + 8); qv[tt] = zr[ZC_DQ + col]; kv[tt] = zr[ZC_DK + col]; }
#pragma unroll
            for (int tt = 0; tt < 8; ++tt) { bf16* zr = Z + (r0 + ch * 64 + t0 + tt) * ZW; float da[8], db[8]; up8(A[tt], da); up8(B[tt], db); float x = ba;
#pragma unroll
                for (int r = 0; r < 8; ++r) x += da[r] * wa[r];
#pragma unroll
                for (int r = 0; r < 8; ++r) x += db[r] * wa[8 + r];
                cum += (fminf(x, 0.f) - __logf(1.0f + __expf(-fabsf(x)))) * 0.0625f;
                zr[ZC_DQ + col] = (bf16)f2bf(bf1(qv[tt]) * __expf(cum - bl)); zr[ZC_DK + col] = (bf16)f2bf(bf1(kv[tt]) * __expf(bl - cum)); } }
        ((float*)(F.ws + WS_DE))[((size_t)b * 128 + cb * 4 + ch) * 128 + col] = __expf(bl);
    }
    for (int itn = 0; itn < 6; ++itn) { const int task = tid + 512 * itn, sl = task >> 8, row = task & 255;
        const bf16* kp = Z + (r0 + row) * ZW + (sl < 8 ? ZC_AK + (sl >> 1) * 64 + (sl & 1) * 32 : ZC_BK + (sl - 8) * 64); float ss = 0.f;
        const int nch = sl < 8 ? 4 : 8;
        for (int c = 0; c < nch; ++c) { float v[8]; up8(*(const u32x4*)(kp + 8 * c), v);
#pragma unroll
            for (int i = 0; i < 8; ++i) ss += v[i] * v[i]; }
#pragma unroll
        for (int o = 1; o < 64; o <<= 1) ss = fmaxf(ss, shx(ss, F.lane, o));
        if (F.lane == 0) __hip_atomic_fetch_max(kmaxl + b * 16 + sl, __float_as_uint(sqrtf(ss)), __ATOMIC_RELAXED, __HIP_MEMORY_SCOPE_AGENT); }
    for (int i0 = 0; i0 < 32; i0 += 4) { u32x4 vv[4];
#pragma unroll
        for (int k = 0; k < 4; ++k) { const int idx = tid + 512 * (i0 + k); const int row = idx >> 6, chunk = idx & 63, isk = chunk >> 5, c8 = (chunk & 31) * 8;
            vv[k] = *(const u32x4*)(Z + (r0 + row) * ZW + (isk ? ZC_CK : ZC_CQ) + c8); }
#pragma unroll
        for (int k = 0; k < 4; ++k) { const int idx = tid + 512 * (i0 + k); const int row = idx >> 6, chunk = idx & 63, isk = chunk >> 5, c8 = (chunk & 31) * 8, h = c8 >> 6;
            const float e = (float)(255 - row) * log2gam(h); const float f = __builtin_amdgcn_exp2f(isk ? e : -e); float v[8]; up8(vv[k], v);
            u32x4 w; w.x = pk2(v[0] * f, v[1] * f); w.y = pk2(v[2] * f, v[3] * f); w.z = pk2(v[4] * f, v[5] * f); w.w = pk2(v[6] * f, v[7] * f);
            *(u32x4*)(Z + (r0 + row) * ZW + (isk ? ZC_CK : ZC_CQ) + c8) = w; } }
    __threadfence_block(); __syncthreads();
    LAS unsigned char* Kl = F.lds; LAS unsigned char* Vl = F.lds + 36864;
    for (int h = 0; h < 4; ++h) {
        for (int idx = tid; idx < 256 * 8; idx += 512) { const int row = idx >> 3, c = idx & 7;
            *(LAS u32x4*)(Kl + row * 144 + c * 16) = *(const u32x4*)(Z + (r0 + row) * ZW + ZC_CK + h * 64 + c * 8);
            *(LAS u32x4*)(Vl + row * 144 + c * 16) = *(const u32x4*)(Z + (r0 + row) * ZW + ZC_CV + h * 64 + c * 8); }
        __syncthreads();
        {   const int d = tid >> 3, dk8 = (tid & 7) * 8; float acc[8];
#pragma unroll
            for (int i = 0; i < 8; ++i) acc[i] = 0.f;
            for (int j = 0; j < 256; ++j) { const float vv = bf1(*(const LAS bf16*)(Vl + j * 144 + d * 2)); float kk[8]; up8(*(const LAS u32x4*)(Kl + j * 144 + dk8 * 2), kk);
#pragma unroll
                for (int i = 0; i < 8; ++i) acc[i] += vv * kk[i]; }
            float* o = (float*)(F.ws + WS_KVC) + ((size_t)((b * 4 + h) * 32 + cb) * 4096 + d * 64 + dk8);
            *(f32x4*)o = (f32x4){acc[0], acc[1], acc[2], acc[3]}; *(f32x4*)(o + 4) = (f32x4){acc[4], acc[5], acc[6], acc[7]}; }
        __syncthreads();
        for (int idx = tid; idx < 256 * 8; idx += 512) { const int row = idx >> 3, c = idx & 7;
            if (c < 4) *(LAS u32x4*)(Kl + row * 144 + c * 16) = *(const u32x4*)(Z + (r0 + row) * ZW + ZC_DK + h * 32 + c * 8);
            *(LAS u32x4*)(Vl + row * 144 + c * 16) = *(const u32x4*)(Z + (r0 + row) * ZW + ZC_DV + h * 64 + c * 8); }
        __syncthreads();
        {   const int ch = tid >> 7, d = (tid >> 1) & 63, dk16 = (tid & 1) * 16; float acc[16];
#pragma unroll
            for (int i = 0; i < 16; ++i) acc[i] = 0.f;
            for (int j = 0; j < 64; ++j) { const int row = ch * 64 + j; const float vv = bf1(*(const LAS bf16*)(Vl + row * 144 + d * 2)); float k0[8], k1[8];
                up8(*(const LAS u32x4*)(Kl + row * 144 + dk16 * 2), k0); up8(*(const LAS u32x4*)(Kl + row * 144 + dk16 * 2 + 16), k1);
#pragma unroll
                for (int i = 0; i < 8; ++i) { acc[i] += vv * k0[i]; acc[8 + i] += vv * k1[i]; } }
            float* o = (float*)(F.ws + WS_KVD) + ((size_t)((b * 4 + h) * 128 + cb * 4 + ch) * 2048 + d * 32 + dk16);
#pragma unroll
            for (int i = 0; i < 4; ++i) *(f32x4*)(o + 4 * i) = (f32x4){acc[4 * i], acc[4 * i + 1], acc[4 * i + 2], acc[4 * i + 3]}; }
        __syncthreads();
    }
}

__device__ __forceinline__ void scan_phase(Frame& F) {
    const int gt = F.wg * 512 + F.tid, NT = F.G * 512;
    for (int e0 = gt; e0 < 16 * 4096 + 16 * 2048; e0 += NT) {
        if (e0 < 16 * 4096) { const int e = e0;
            const int bh = e >> 12, idx = e & 4095, h = bh & 3; const float g256 = __builtin_amdgcn_exp2f(256.0f * log2gam(h));
            float* p = (float*)(F.ws + WS_KVC) + (size_t)bh * 32 * 4096 + idx; float S = 0.f; float kv[32];
#pragma unroll
            for (int c = 0; c < 32; ++c) kv[c] = p[(size_t)c * 4096];
#pragma unroll
            for (int c = 0; c < 32; ++c) { const float Sp = g256 * S; p[(size_t)c * 4096] = Sp; S = Sp + kv[c]; }
        } else { const int e = e0 - 16 * 4096;
            const int bh = e >> 11, idx = e & 2047, b = bh >> 2, h = bh & 3, dk = idx & 31;
            float* p = (float*)(F.ws + WS_KVD) + (size_t)bh * 128 * 2048 + idx; const float* de = (const float*)(F.ws + WS_DE) + (size_t)b * 128 * 128 + h * 32 + dk; float S = 0.f;
            for (int c0 = 0; c0 < 128; c0 += 16) { float kv[16], dd[16];
#pragma unroll
                for (int c = 0; c < 16; ++c) { kv[c] = p[(size_t)(c0 + c) * 2048]; dd[c] = de[(c0 + c) * 128]; }
#pragma unroll
                for (int c = 0; c < 16; ++c) { const float Sp = dd[c] * S; p[(size_t)(c0 + c) * 2048] = Sp; S = Sp + kv[c]; } }
        }
    }
}

constexpr int HPITCH = 1026, CAP = 256;
struct QState { unsigned mode, thr_lo, thr_hi, thr_idx, krem, lcount, pad0, pad1; };
__device__ __forceinline__ unsigned okey_of(float s) { const unsigned u = __float_as_uint(s); return u ^ ((unsigned)((int)u >> 31) | 0x80000000u); }
__device__ __forceinline__ void b1_load(const bf16* Zb, int t, int r, int hh, bf16x8& k0, bf16x8& k1) {
    const bf16* kr = Zb + (size_t)(32 * t + r) * ZW + ZC_IK + 8 * hh; k0 = *(const bf16x8*)kr; k1 = *(const bf16x8*)(kr + 16); }
__device__ __forceinline__ void b1_scores(const bf16x8 k0, const bf16x8 k1, const bf16x8 (&iqf)[4][2], const float (&w)[4], float (&sc)[16]) {
#pragma unroll
    for (int e = 0; e < 16; ++e) sc[e] = 0.f;
#pragma unroll
    for (int ih = 0; ih < 4; ++ih) { f32x16 lg = mfma32(k0, iqf[ih][0], splat16(0.f)); lg = mfma32(k1, iqf[ih][1], lg);
#pragma unroll
        for (int e = 0; e < 16; ++e) sc[e] = fmaf(w[ih], fmaxf(lg[e], 0.f), sc[e]); }
}
__device__ __forceinline__ void b1_setbit(unsigned* MWq, unsigned j) {
    const unsigned wi = j & 31u, hh = (wi >> 2) & 1u, e = (wi & 3u) + 4u * (wi >> 3), kh = (j >> 5) & 1u;
    __hip_atomic_fetch_or(MWq + (size_t)(j >> 6) * 64 + 32u * hh, 1u << (e + 16u * kh), __ATOMIC_RELAXED, __HIP_MEMORY_SCOPE_AGENT);
}
__device__ __forceinline__ void b1_unit(Frame& F, int b, int g) {
    const int tid = F.tid, lane = F.lane, r = lane & 31, hh = lane >> 5, wid = F.wave;
    const bf16* Zb = (const bf16*)(F.ws + WS_Z) + (size_t)b * SEQ * ZW;
    LAS unsigned* hist = (LAS unsigned*)F.lds;
    LAS QState* qst = (LAS QState*)(F.lds + QST_OFF);
    const int qpos = 32 * g + r;
    unsigned* MWb = (unsigned*)(F.ws + WS_MASK) + ((size_t)(b * 256 + g) * 128) * 64;
    bf16x8 iqf[4][2]; float w[4];
    {   const bf16* qr = Zb + (size_t)qpos * ZW;
#pragma unroll
        for (int ih = 0; ih < 4; ++ih) { iqf[ih][0] = *(const bf16x8*)(qr + ZC_IQ + ih * 32 + 8 * hh); iqf[ih][1] = *(const bf16x8*)(qr + ZC_IQ + ih * 32 + 16 + 8 * hh); w[ih] = bf1(qr[ZC_IW + ih]); } }
    if (g >= 8) {
        for (int i = tid; i < 32 * HPITCH; i += 512) hist[i] = 0u;
        __syncthreads();
        {   bf16x8 n0 = iqf[0][0], n1 = iqf[0][0]; int t = wid; if (t <= g) b1_load(Zb, t, r, hh, n0, n1);
            for (; t <= g; t += 8) { const bf16x8 k0 = n0, k1 = n1; if (t + 8 <= g) b1_load(Zb, t + 8, r, hh, n0, n1);
                float sc[16]; b1_scores(k0, k1, iqf, w, sc);
#pragma unroll
                for (int e = 0; e < 16; ++e) { const int j = 32 * t + crow_c(e) + 4 * hh; if (j <= qpos) { const unsigned bin = okey_of(sc[e]) >> 21;
                    __hip_atomic_fetch_add(hist + r * HPITCH + (bin >> 1), 1u << ((bin & 1) * 16), __ATOMIC_RELAXED, __HIP_MEMORY_SCOPE_WORKGROUP); } } } }
        __syncthreads();
        for (int qq = 0; qq < 4; ++qq) { const int q = 4 * wid + qq; const LAS unsigned* hq = hist + q * HPITCH;
            const int wbase = 1008 - 16 * lane; unsigned s = 0;
#pragma unroll
            for (int k = 0; k < 16; ++k) { const unsigned x = hq[wbase + k]; s += (x & 0xffffu) + (x >> 16); }
            unsigned P = s;
#pragma unroll
            for (int o = 1; o < 64; o <<= 1) { const unsigned t = shup(P, lane, o); if (lane >= o) P += t; }
            const unsigned long long bal = __ballot(P >= 256u);
            const int Lsel = bal ? __builtin_ctzll(bal) : 63;
            if (lane == Lsel) { unsigned cum = P - s; unsigned b1 = 0, cin = 0, cab = 0;
                for (int k = 0; k < 32; ++k) { const int bin = 2047 - 32 * lane - k; const unsigned x = hq[bin >> 1]; const unsigned c = (bin & 1) ? (x >> 16) : (x & 0xffffu);
                    if (cum + c >= 256u) { b1 = (unsigned)bin; cin = c; cab = cum; break; } cum += c; }
                qst[q].thr_lo = b1 << 21; qst[q].thr_hi = (b1 << 21) | 0x1fffffu; qst[q].thr_idx = 0xffffu; qst[q].krem = 256u - cab; qst[q].lcount = 0u; qst[q].pad0 = cin; qst[q].pad1 = 0u;
                qst[q].mode = (b1 == 1024u || cin > (unsigned)CAP) ? 2u : 1u; }
        }
        __syncthreads();
        for (int i = tid; i < 32 * 256; i += 512) ((LAS unsigned*)(F.lds + 65536))[i] = 0u;
        __syncthreads();
    }
    {   unsigned mode = 0u, tlo = 1u, thi = 0u;
        const bool allsel = (g < 8);
        if (!allsel) { mode = qst[r].mode; tlo = qst[r].thr_lo; thi = qst[r].thr_hi; }
        const int nk = g >> 1;
        bf16x8 n0 = iqf[0][0], n1 = iqf[0][0], n2 = iqf[0][0], n3 = iqf[0][0]; int kt = wid;
        if (kt <= nk) { b1_load(Zb, 2 * kt, r, hh, n0, n1); if (2 * kt + 1 <= g) b1_load(Zb, 2 * kt + 1, r, hh, n2, n3); }
        for (; kt <= nk; kt += 8) {
            const bf16x8 k0 = n0, k1 = n1, k2 = n2, k3 = n3;
            if (kt + 8 <= nk) { b1_load(Zb, 2 * kt + 16, r, hh, n0, n1); if (2 * kt + 17 <= g) b1_load(Zb, 2 * kt + 17, r, hh, n2, n3); }
            unsigned word = 0u;
#pragma unroll
            for (int kh = 0; kh < 2; ++kh) { const int t = 2 * kt + kh; if (t <= g) { float sc[16]; b1_scores(kh ? k2 : k0, kh ? k3 : k1, iqf, w, sc);
#pragma unroll
                for (int e = 0; e < 16; ++e) { const int j = 32 * t + crow_c(e) + 4 * hh; const unsigned ok = okey_of(sc[e]); const bool valid = (j <= qpos);
                    const bool sel = valid && (allsel || ok > thi); word |= (sel ? 1u : 0u) << (e + 16 * kh);
                    if (!allsel && valid && ok >= tlo && ok <= thi) {
                        if (mode == 1u) { const unsigned pos = __hip_atomic_fetch_add(&qst[r].lcount, 1u, __ATOMIC_RELAXED, __HIP_MEMORY_SCOPE_WORKGROUP);
                            if (pos < (unsigned)CAP) { LAS unsigned* le = (LAS unsigned*)(F.lds + ((size_t)r * CAP + pos) * 8); le[0] = ok; le[1] = (unsigned)j; } }
                        else __hip_atomic_fetch_or((LAS unsigned*)(F.lds + 65536 + r * 1024) + (j >> 5), 1u << (j & 31), __ATOMIC_RELAXED, __HIP_MEMORY_SCOPE_WORKGROUP); } } } }
            MWb[(size_t)kt * 64 + lane] = word; }
    }
    __syncthreads();
    if (g >= 8) {
        for (int qq = 0; qq < 4; ++qq) { const int q = 4 * wid + qq; const unsigned mode = qst[q].mode, krem = qst[q].krem; unsigned* MWq = MWb + q;
            if (mode == 1u) {
                unsigned L = qst[q].lcount; if (L > (unsigned)CAP) L = CAP; const LAS unsigned* lb = (const LAS unsigned*)(F.lds + (size_t)q * CAP * 8);
                unsigned long long comp[4]; bool has[4]; unsigned jj[4];
#pragma unroll
                for (int k = 0; k < 4; ++k) { const unsigned c = lane + 64 * k; has[k] = c < L; const unsigned ok = has[k] ? lb[2 * c] : 0u; jj[k] = has[k] ? lb[2 * c + 1] : 0u;
                    comp[k] = ((unsigned long long)(ok & 0x1fffffu) << 13) | (unsigned long long)(8191u - jj[k]); }
                unsigned long long prefix = 0ull; unsigned need = krem;
                for (int bit = 33; bit >= 0; --bit) { const unsigned long long want = (prefix >> bit) | 1ull; unsigned cnt = 0;
#pragma unroll
                    for (int k = 0; k < 4; ++k) cnt += (unsigned)__builtin_popcountll(__ballot(has[k] && ((comp[k] >> bit) == want)));
                    if (cnt >= need) prefix |= (1ull << bit); else need -= cnt; }
#pragma unroll
                for (int k = 0; k < 4; ++k) if (has[k] && comp[k] >= prefix) b1_setbit(MWq, jj[k]); }
            else { const LAS unsigned* bm = (const LAS unsigned*)(F.lds + 65536 + q * 1024); unsigned x[4]; unsigned s = 0;
#pragma unroll
                for (int k = 0; k < 4; ++k) { x[k] = bm[4 * lane + k]; s += __builtin_popcount(x[k]); }
                unsigned P = s;
#pragma unroll
                for (int o = 1; o < 64; o <<= 1) { const unsigned t = shup(P, lane, o); if (lane >= o) P += t; }
                unsigned before = P - s;
#pragma unroll
                for (int k = 0; k < 4; ++k) { unsigned y = x[k]; while (y != 0u && before < krem) { const unsigned bit = (unsigned)__builtin_ctz(y); y &= y - 1u; b1_setbit(MWq, 32u * (4 * lane + k) + bit); ++before; } before += __builtin_popcount(y); } }
        }
        __syncthreads();
    }
}

struct EngP { const bf16* Z; bf16* Y; const unsigned* MASK; const float* ST; const float* nw; float lam, lam_init; const unsigned* kmax; };
__device__ __forceinline__ int wq_next(Frame& F, unsigned* head) {
    LAS int* slot = (LAS int*)(F.lds + 36880);
    if (F.tid == 0) *slot = (int)__hip_atomic_fetch_add(head, 1u, __ATOMIC_RELAXED, __HIP_MEMORY_SCOPE_AGENT);
    __syncthreads(); const int u = *slot; __syncthreads();
    asm volatile("" : "+v"(F.tid), "+v"(F.lane));
    return u;
}
template <int MODE>
__device__ __forceinline__ void eng_unit(Frame& F, const EngP& P, int b, int h, int qb) {
    constexpr bool SOFT = MODE <= 1;
    constexpr int NMAP = MODE == 0 ? 2 : 1;
    constexpr int NS = (MODE == 0 || MODE == 3) ? 2 : 4;
    constexpr int KCH = MODE == 3 ? 4 : 8;
    constexpr int QC = MODE == 0 ? ZC_AQ : MODE == 1 ? ZC_BQ : MODE == 2 ? ZC_CQ : ZC_DQ;
    constexpr int KC = MODE == 0 ? ZC_AK : MODE == 1 ? ZC_BK : MODE == 2 ? ZC_CK : ZC_DK;
    constexpr int VC = MODE == 0 ? ZC_AV : MODE == 1 ? ZC_BV : MODE == 2 ? ZC_CV : ZC_DV;
    constexpr int HW = MODE == 3 ? 32 : 64;
    const int tid = F.tid, lane = F.lane, r = lane & 31, hh = lane >> 5, w = F.wave;
    const size_t rowbase = (size_t)b * SEQ;
    const int qw0 = qb * 256 + 32 * w;
    const float NEG = -__builtin_inff();
    const int hidx = MODE <= 1 ? (MODE == 0 ? 2 * h + 1 : 2 * h + 2) : 0;
    const float slope2 = SOFT ? __builtin_amdgcn_exp2f(-(float)hidx) * LOG2E : 0.f;
    bf16x8 qf[NMAP][NS];
    {   const bf16* qrow = P.Z + (rowbase + qw0 + r) * ZW + QC + h * HW;
#pragma unroll
        for (int m = 0; m < NMAP; ++m)
#pragma unroll
            for (int s = 0; s < NS; ++s) qf[m][s] = *(const bf16x8*)(qrow + m * 32 + 16 * s + 8 * hh); }
    f32x16 cinit;
#pragma unroll
    for (int e = 0; e < 16; ++e) cinit[e] = SOFT ? slope2 * (float)(crow_c(e) + 4 * hh) : 0.f;
    float m_run[NMAP], l_run[NMAP]; f32x16 O[NMAP][2];
#pragma unroll
    for (int m = 0; m < NMAP; ++m) { m_run[m] = NEG; l_run[m] = 0.f; O[m][0] = splat16(0.f); O[m][1] = splat16(0.f); }
    if (!SOFT) {
        const int sidx = MODE == 2 ? ((b * 4 + h) * 32 + qb) : ((b * 4 + h) * 128 + 4 * qb + (w >> 1));
        const float* sp = P.ST + (size_t)sidx * (64 * HW);
#pragma unroll
        for (int db = 0; db < 2; ++db)
#pragma unroll
            for (int s = 0; s < NS; ++s) { const float* a = sp + (size_t)(32 * db + r) * HW + 16 * s + 8 * hh; const f32x4 a0 = *(const f32x4*)a, a1 = *(const f32x4*)(a + 4);
                O[0][db] = mfma32(pack8(a0[0], a0[1], a0[2], a0[3], a1[0], a1[1], a1[2], a1[3]), qf[0][s], O[0][db]); }
    }
    const int kt_lo = SOFT ? 0 : 4 * qb, kt_hi = 4 * qb + 3;
    const int srow = tid >> 3, sch = tid & 7;
    float qk[NMAP];
    if (SOFT) {
#pragma unroll
        for (int m = 0; m < NMAP; ++m) { float ss = 0.f;
#pragma unroll
            for (int s = 0; s < NS; ++s) { const u32x4 qq = __builtin_bit_cast(u32x4, qf[m][s]); float v[8]; up8(qq, v);
#pragma unroll
                for (int i = 0; i < 8; ++i) ss += v[i] * v[i]; }
            ss += shx(ss, lane, 32);
            qk[m] = 1.02f * sqrtf(ss) * __uint_as_float(P.kmax[b * 16 + (MODE == 0 ? (h * 2 + m) : (8 + h))]) + 0.01f; }
    }
    LAS unsigned* wflag = (LAS unsigned*)(F.lds + 36864);
    if (SOFT && tid < 3) wflag[tid] = 0u;
    const int kt_first = SOFT ? kt_hi : kt_lo;
    u32x4 kreg = (u32x4){0u, 0u, 0u, 0u}, vreg;
    {   const bf16* zr = P.Z + (rowbase + 64 * kt_first + srow) * ZW;
        if (sch < KCH) kreg = *(const u32x4*)(zr + KC + h * HW + sch * 8);
        vreg = *(const u32x4*)(zr + VC + h * 64 + sch * 8);
        LAS unsigned char* Kb = F.lds; LAS unsigned char* Vb = F.lds + 18432;
        if (sch < KCH) *(LAS u32x4*)(Kb + srow * 144 + sch * 16) = kreg;
        *(LAS u32x4*)(Vb + srow * 144 + sch * 16) = vreg; }
    __syncthreads();
    const int nit = kt_hi - kt_lo + 1;
    bool wave_done = false;
    for (int it = 0; it < nit; ++it) {
        const int kt = SOFT ? kt_hi - it : kt_lo + it, ktn = SOFT ? kt - 1 : kt + 1;
        const bool more = it + 1 < nit;
        if (more) { const bf16* zr = P.Z + (rowbase + 64 * ktn + srow) * ZW;
            if (sch < KCH) kreg = *(const u32x4*)(zr + KC + h * HW + sch * 8);
            vreg = *(const u32x4*)(zr + VC + h * 64 + sch * 8); }
        const int j0 = 64 * kt;
        const bool act = ((MODE == 3) ? (kt == 4 * qb + (w >> 1)) : (j0 <= qw0 + 31)) && !wave_done;
        if (act) {
            const LAS unsigned char* Kb = F.lds + (it & 1) * 9216; const LAS unsigned char* Vb = F.lds + 18432 + (it & 1) * 9216;
            unsigned mw = 0xffffffffu;
            if (MODE == 1) mw = P.MASK[((size_t)(b * 256 + qb * 8 + w) * 128 + kt) * 64 + lane];
            const bool hact1 = (j0 + 32 <= qw0 + 31);
#pragma unroll
            for (int m = 0; m < NMAP; ++m) {
                f32x16 st[2];
#pragma unroll
                for (int kh = 0; kh < 2; ++kh) {
                    if (kh == 0 || hact1) {
                        f32x16 a = cinit;
#pragma unroll
                        for (int s = 0; s < NS; ++s) { const bf16x8 kf = *(const LAS bf16x8*)(Kb + (32 * kh + r) * 144 + (m * 32 + 16 * s + 8 * hh) * 2); a = mfma32(kf, qf[m][s], a); }
                        if (j0 + 32 * kh + 31 > qw0) { const int lim = qw0 + r - j0 - 32 * kh - 4 * hh;
#pragma unroll
                            for (int e = 0; e < 16; ++e) if (crow_c(e) > lim) a[e] = SOFT ? NEG : 0.f; }
                        if (MODE == 1) {
#pragma unroll
                            for (int e = 0; e < 16; ++e) if (!((mw >> (e + 16 * kh)) & 1u)) a[e] = NEG; }
                        st[kh] = a;
                    } else st[kh] = splat16(SOFT ? NEG : 0.f);
                }
                if (SOFT) {
                    const float off0 = slope2 * (float)(j0 - qw0 - r), off1 = off0 + 32.f * slope2;
                    float mx0 = st[0][0], mx1 = st[1][0];
#pragma unroll
                    for (int e = 1; e < 16; ++e) { mx0 = fmaxf(mx0, st[0][e]); mx1 = fmaxf(mx1, st[1][e]); }
                    float mx = fmaxf(mx0 + off0, mx1 + off1); mx = fmaxf(mx, shx(mx, lane, 32));
                    const float mn = fmaxf(m_run[m], mx); const float msafe = (mn == NEG) ? 0.f : mn;
                    const float alpha = __builtin_amdgcn_exp2f(m_run[m] - msafe); m_run[m] = mn;
                    const float d0 = off0 - msafe, d1 = off1 - msafe; float rs = 0.f;
#pragma unroll
                    for (int e = 0; e < 16; ++e) { const float p0 = __builtin_amdgcn_exp2f(st[0][e] + d0), p1 = __builtin_amdgcn_exp2f(st[1][e] + d1); st[0][e] = p0; st[1][e] = p1; rs += p0 + p1; }
                    rs += shx(rs, lane, 32); l_run[m] = l_run[m] * alpha + rs;
#pragma unroll
                    for (int e = 0; e < 16; ++e) { O[m][0][e] *= alpha; O[m][1][e] *= alpha; }
                }
#pragma unroll
                for (int kh = 0; kh < 2; ++kh) {
                    if (kh == 0 || hact1) {
#pragma unroll
                        for (int s = 0; s < 2; ++s) {
                            const bf16x8 pf = pack8(st[kh][8 * s], st[kh][8 * s + 1], st[kh][8 * s + 2], st[kh][8 * s + 3], st[kh][8 * s + 4], st[kh][8 * s + 5], st[kh][8 * s + 6], st[kh][8 * s + 7]);
#pragma unroll
                            for (int db = 0; db < 2; ++db) {
                                const LAS unsigned char* vp = Vb + (32 * kh + 16 * s + 4 * hh + ((lane & 15) >> 2)) * 144 + (32 * db + 16 * ((lane >> 4) & 1) + 4 * (lane & 3)) * 2;
                                const s16x4 lo = vtr(vp), hi = vtr(vp + 8 * 144);
                                const bf16x8 vf = (bf16x8){lo[0], lo[1], lo[2], lo[3], hi[0], hi[1], hi[2], hi[3]};
                                O[m][db] = mfma32(vf, pf, O[m][db]); } } } }
            }
            if (SOFT) {
                const float dist = slope2 * (float)(qw0 + r - (j0 - 1)); bool fin = true;
#pragma unroll
                for (int m = 0; m < NMAP; ++m) fin = fin && (qk[m] - dist - m_run[m] < -32.f);
                wave_done = (__ballot(fin) == ~0ull);
            }
        }
        if (SOFT && !wave_done && lane == 0) wflag[it % 3] = 1u;
        if (more) { LAS unsigned char* Kb = F.lds + ((it + 1) & 1) * 9216; LAS unsigned char* Vb = F.lds + 18432 + ((it + 1) & 1) * 9216;
            if (sch < KCH) *(LAS u32x4*)(Kb + srow * 144 + sch * 16) = kreg;
            *(LAS u32x4*)(Vb + srow * 144 + sch * 16) = vreg; }
        __syncthreads();
        if (SOFT) { const unsigned any = wflag[it % 3]; if (tid == 0) wflag[(it + 2) % 3] = 0u; if (any == 0u) break; }
    }
    const size_t orow = rowbase + qw0 + r;
    const int ycol = MODE * 256 + h * 64;
    f32x16 o[2];
    if (MODE == 0) { const float i0 = 1.f / l_run[0], i1 = P.lam / l_run[NMAP - 1];
#pragma unroll
        for (int db = 0; db < 2; ++db)
#pragma unroll
            for (int e = 0; e < 16; ++e) o[db][e] = O[0][db][e] * i0 - O[NMAP - 1][db][e] * i1; }
    else if (MODE == 1) { const float i0 = 1.f / l_run[0];
#pragma unroll
        for (int db = 0; db < 2; ++db)
#pragma unroll
            for (int e = 0; e < 16; ++e) o[db][e] = O[0][db][e] * i0; }
    else { o[0] = O[0][0]; o[1] = O[0][1]; }
    float mu = 0.f;
    if (MODE == 2) { float s = 0.f;
#pragma unroll
        for (int db = 0; db < 2; ++db)
#pragma unroll
            for (int e = 0; e < 16; ++e) s += o[db][e];
        s += shx(s, lane, 32); mu = s * (1.f / 64.f); }
    float ss = 0.f;
    if (MODE != 1) {
#pragma unroll
        for (int db = 0; db < 2; ++db)
#pragma unroll
            for (int e = 0; e < 16; ++e) { const float d = o[db][e] - mu; ss += d * d; }
        ss += shx(ss, lane, 32); }
    float rn = 1.f;
    if (MODE != 1) rn = 1.f / sqrtf(ss * (1.f / 64.f) + LN_EPS);
    if (MODE == 0) rn *= (1.f - P.lam_init);
#pragma unroll
    for (int db = 0; db < 2; ++db)
#pragma unroll
        for (int g4 = 0; g4 < 4; ++g4) { const int d0 = 32 * db + 8 * g4 + 4 * hh; float v[4];
#pragma unroll
            for (int i = 0; i < 4; ++i) v[i] = o[db][4 * g4 + i];
            if (MODE != 1) { const f32x4 nw = *(const f32x4*)(P.nw + (MODE == 2 ? h * 64 : 0) + d0);
#pragma unroll
                for (int i = 0; i < 4; ++i) v[i] = (v[i] - mu) * rn * nw[i]; }
            if (MODE >= 2) { const u32x2 gw = *(const u32x2*)(P.Z + orow * ZW + (MODE == 2 ? ZC_CG : ZC_DG) + h * 64 + d0);
                const float g0 = bflo(gw.x), g1 = bfhi(gw.x), g2 = bflo(gw.y), g3 = bfhi(gw.y);
                v[0] *= g0 * sigmoidf_(g0); v[1] *= g1 * sigmoidf_(g1); v[2] *= g2 * sigmoidf_(g2); v[3] *= g3 * sigmoidf_(g3); }
            u32x2 ow; ow.x = pk2(v[0], v[1]); ow.y = pk2(v[2], v[3]);
            *(u32x2*)(P.Y + orow * DM + ycol + d0) = ow; }
}
}

constexpr int PH_PER_LAYER = 12, N_PHASES = 1 + DEPTH * PH_PER_LAYER;

typedef __attribute__((address_space(4))) const Args* KArgP;
#ifdef ONLY_SITE
#define SITE(s) ((s) == ONLY_SITE)
#else
#define SITE(s) true
#endif
#if MK_ONE_LAUNCH
#define IN(k) true
#define SEAM(k) do { if ((k) + 1 < N_PHASES) { XcdBarrier b2_ = bar; asm volatile("" : "+s"(b2_.bar), "+s"(b2_.x)); xcd_barrier(b2_, F.tid == 0); } } while (0)
#else
#define IN(k) (lo <= (k) && (k) < hi)
#define SEAM(k) do { } while (0)
#endif
#define SITE_BEGIN KArgP KA = (KArgP)__builtin_amdgcn_kernarg_segment_ptr(); do { asm volatile("" : "+s"(KA)); \
        int ln_; asm volatile("v_mbcnt_lo_u32_b32 %0, -1, 0\n\tv_mbcnt_hi_u32_b32 %0, -1, %0" : "=v"(ln_)); \
        const unsigned simd_ = (unsigned)__builtin_amdgcn_s_getreg(((2 - 1) << 11) | (4 << 6) | 4);   \
        unsigned tk_ = 0u; if (ln_ == 0) tk_ = __hip_atomic_fetch_add((LAS unsigned*)(F.lds + MISC_OFF + 64) + simd_, 1u, __ATOMIC_RELAXED, __HIP_MEMORY_SCOPE_WORKGROUP); \
        F.wave = __builtin_amdgcn_readfirstlane((int)(simd_ + 4u * (tk_ & 1u))); F.lane = ln_; F.tid = F.wave * 64 + F.lane; \
        F.ws = KA->ws; F.dob = (unsigned char*)KA->out; F.G = G0; F.wg = wg0; asm volatile("" : "+s"(F.G), "+s"(F.wg)); } while (0)


__global__ void __launch_bounds__(NWAVES * 64, 2) fwd_kernel(Args args) {
    extern __shared__ __attribute__((aligned(16))) unsigned char lds_raw[];
    Frame F;
    F.lds = (LAS unsigned char*)lds_raw;
    F.tid = threadIdx.x; F.lane = F.tid & 63; F.wave = __builtin_amdgcn_readfirstlane(F.tid >> 6);
    F.G = gridDim.x; F.wg = blockIdx.x;
    F.ws = args.ws; F.dob = (unsigned char*)args.out;
    volatile LAS unsigned* MISC = (volatile LAS unsigned*)(F.lds + MISC_OFF);
    if (F.tid < 32) MISC[F.tid] = 0u;
    __syncthreads();
    unsigned* ctl = (unsigned*)(F.ws + WS_CTL);
    XcdBarrier bar; bar.bar = ctl + CW_BAR; bar.x = 0; bar.st = nullptr;
#if MK_ONE_LAUNCH
    bar = xcd_barrier_post(ctl + CW_BAR, MISC + 8);
#endif
    const int lo = args.ph_lo, hi = args.ph_hi, subm = args.sub;
    const int G0 = F.G, wg0 = F.wg;
    if (SITE(0) && IN(0)) { SITE_BEGIN; p0_prologue(F, KA); SEAM(0); }

    for (int l = 0; l < DEPTH; ++l) {
        const int pb = 1 + l * PH_PER_LAYER;
        if (SITE(1) && IN(pb + 0)) { SITE_BEGIN; const char* XBc = (const char*)(F.ws + WS_XB); (void)XBc; const unsigned char* w123 = F.ws + WS_W123; const unsigned char* w45 = F.ws + WS_W45 + (size_t)l * W45_STRIDE; (void)w123; (void)w45;
            pg8::SchedPlain S{XBc, (const char*)(w123 + W123_W1), 2048, 2048, 16, 128, 14, F.G, F.wg};
            pg8::EpiStore E{(bf16*)(F.ws + WS_Z), ZW};
            pg8::gemm_phase(F.lds, S, E, F.tid);
            SEAM(pb + 0);
        }
        if (SITE(2) && IN(pb + 1)) { SITE_BEGIN; const char* XBc = (const char*)(F.ws + WS_XB); (void)XBc; const unsigned char* w123 = F.ws + WS_W123; const unsigned char* w45 = F.ws + WS_W45 + (size_t)l * W45_STRIDE; (void)w123; (void)w45;
            {   unsigned* head = (unsigned*)(F.ws + WS_CTL) + CW_WQ + l * 64 + 32;
                for (;;) { const int i = mx::wq_next(F, head); if (i >= 640) break;
                    if (i < 128) { if (subm & 2) mx::prepkv_unit(F, i, KA->in[6] + (size_t)l * 16 * 128, KA->in[7] + l * 128, (unsigned*)(F.ws + WS_CTL) + CW_KMAX + l * 64); }
                    else if (subm & 1) { const int u = i - 128, b = u >> 7, p = u & 127; mx::b1_unit(F, b, 255 - p); mx::b1_unit(F, b, p); } } }
            SEAM(pb + 1);
        }
        if (SITE(3) && IN(pb + 2)) { SITE_BEGIN; const char* XBc = (const char*)(F.ws + WS_XB); (void)XBc; const unsigned char* w123 = F.ws + WS_W123; const unsigned char* w45 = F.ws + WS_W45 + (size_t)l * W45_STRIDE; (void)w123; (void)w45;
            if (subm & 1) mx::scan_phase(F);
            float lam_init = 0.8f - 0.6f * __expf(-0.3f * (float)l);
            const float* lp = KA->in[3] + l * 128; float s01 = 0.f, s23 = 0.f;
            for (int i = 0; i < 32; ++i) { s01 += lp[i] * lp[32 + i]; s23 += lp[64 + i] * lp[96 + i]; }
            mx::EngP P{(const bf16*)(F.ws + WS_Z), (bf16*)(F.ws + WS_Y), nullptr, nullptr, KA->in[4] + l * 64, __expf(s01) - __expf(s23) + lam_init, lam_init, (const unsigned*)(F.ws + WS_CTL) + CW_KMAX + l * 64};
            {   unsigned* head = (unsigned*)(F.ws + WS_CTL) + CW_WQ + l * 64;
                for (;;) { const int i = mx::wq_next(F, head); if (i >= 512) break; const int j = i & 127; mx::eng_unit<0>(F, P, j & 3, 3 - (i >> 7), 31 - (j >> 2)); } }
            SEAM(pb + 2);
        }
        if (SITE(4) && IN(pb + 3)) { SITE_BEGIN; const char* XBc = (const char*)(F.ws + WS_XB); (void)XBc; const unsigned char* w123 = F.ws + WS_W123; const unsigned char* w45 = F.ws + WS_W45 + (size_t)l * W45_STRIDE; (void)w123; (void)w45;
            {   unsigned* head = (unsigned*)(F.ws + WS_CTL) + CW_WQ + l * 64 + 16;
                const mx::EngP PB{(const bf16*)(F.ws + WS_Z), (bf16*)(F.ws + WS_Y), (const unsigned*)(F.ws + WS_MASK), nullptr, nullptr, 0.f, 0.f, (const unsigned*)(F.ws + WS_CTL) + CW_KMAX + l * 64};
                const mx::EngP PC{(const bf16*)(F.ws + WS_Z), (bf16*)(F.ws + WS_Y), nullptr, (const float*)(F.ws + WS_KVC), KA->in[5] + l * 256, 0.f, 0.f, nullptr};
                const mx::EngP PD{(const bf16*)(F.ws + WS_Z), (bf16*)(F.ws + WS_Y), nullptr, (const float*)(F.ws + WS_KVD), KA->in[8] + l * 64, 0.f, 0.f, nullptr};
                for (;;) { const int i = mx::wq_next(F, head); if (i >= 1536) break;
                    if (i < 512) { if (subm & 1) { const int j = i & 127; mx::eng_unit<1>(F, PB, j & 3, 3 - (i >> 7), 31 - (j >> 2)); } }
                    else if (!(subm & (i < 1024 ? 2 : 4))) continue;
                    else if (i < 1024) { const int u = i - 512; mx::eng_unit<2>(F, PC, u >> 7, (u >> 5) & 3, u & 31); }
                    else { const int u = i - 1024; mx::eng_unit<3>(F, PD, u >> 7, (u >> 5) & 3, u & 31); } } }
            SEAM(pb + 3);
        }
        if (SITE(5) && IN(pb + 4)) { SITE_BEGIN;
            const unsigned char* w123 = F.ws + WS_W123;
            for (int n = 0; n < 4; ++n) {
                {   pg8::SchedPlain S{(const char*)(F.dob + DO_XB8), (const char*)(F.dob + DO_W8 + (size_t)l * W8_STRIDE + W8_G) + (size_t)n * 1024 * 1024, 1024, 1024, 8, 128, 4, F.G, F.wg};
                    pg8::EpiSlotStore E{F.ws + WS_SCR2 + (size_t)F.wg * 262144, 1};
                    { int tl_ = F.tid; asm volatile("" : "+v"(tl_)); pg8::gemm_phase<pg8::EpiSlotStore, pg8::SchedPlain, true>(F.lds, S, E, tl_); } }
                {   pg8::SchedPlain S{(const char*)(F.ws + WS_Y) + n * 512, (const char*)(w123 + W123_GB + 8 * MiB) + (size_t)n * 1024 * 512, 2048, 512, 4, 128, 4, F.G, F.wg};
                    pg8::EpiBranch E{F.ws + WS_SCR2 + (size_t)F.wg * 262144, (bf16*)(F.ws + WS_MERGED), n == 0};
                    { int tl_ = F.tid; asm volatile("" : "+v"(tl_)); pg8::gemm_phase(F.lds, S, E, tl_); } }
            }
            SEAM(pb + 4);
        }
        if (SITE(6) && IN(pb + 5)) { SITE_BEGIN; const char* XBc = (const char*)(F.ws + WS_XB); (void)XBc; const unsigned char* w123 = F.ws + WS_W123; const unsigned char* w45 = F.ws + WS_W45 + (size_t)l * W45_STRIDE; (void)w123; (void)w45;
            pg8::SchedPlain S{(const char*)(F.ws + WS_MERGED), (const char*)(w123 + W123_WO), 2048, 2048, 16, 128, 4, F.G, F.wg};
            pg8::EpiG3 E{(bf16*)(F.ws + WS_XB)};
            pg8::gemm_phase(F.lds, S, E, F.tid);
            SEAM(pb + 5);
        }
        if (SITE(7) && IN(pb + 6)) { SITE_BEGIN; const char* XBc = (const char*)(F.ws + WS_XB); (void)XBc; const unsigned char* w123 = F.ws + WS_W123; const unsigned char* w45 = F.ws + WS_W45 + (size_t)l * W45_STRIDE; (void)w123; (void)w45; ln_phase(F, KA->in[11] + l * DM, KA->in[12] + l * DM, nullptr, F.dob + DO_XB8);
            if (l + 1 < DEPTH) convert_w123(F, KA->in[2] + (size_t)(l + 1) * DM * NIN, KA->in[9] + (size_t)(l + 1) * 4 * 256 * DM, KA->in[10] + (size_t)(l + 1) * DM * DM);
            SEAM(pb + 6); }
        if (SITE(8) && IN(pb + 7)) { SITE_BEGIN; const char* XBc = (const char*)(F.ws + WS_XB); (void)XBc; const unsigned char* w123 = F.ws + WS_W123; const unsigned char* w45 = F.ws + WS_W45 + (size_t)l * W45_STRIDE; (void)w123; (void)w45;
            pg8::SchedPlain S{(const char*)(F.dob + DO_XB8), (const char*)(F.dob + DO_W8 + (size_t)l * W8_STRIDE + W8_UP), 1024, 1024, 8, 128, 22, F.G, F.wg};
            pg8::EpiStore E{(bf16*)(F.ws + WS_UG), UGW};
            pg8::gemm_phase<pg8::EpiStore, pg8::SchedPlain, true>(F.lds, S, E, F.tid);
            SEAM(pb + 7);
        }
        if (SITE(9) && IN(pb + 8)) { SITE_BEGIN; const char* XBc = (const char*)(F.ws + WS_XB); (void)XBc; const unsigned char* w123 = F.ws + WS_W123; const unsigned char* w45 = F.ws + WS_W45 + (size_t)l * W45_STRIDE; (void)w123; (void)w45; ffn_act_phase(F, KA->in[14] + (size_t)l * 3 * DFF, KA->in[15] + (size_t)l * DFF); SEAM(pb + 8); }
        if (SITE(10) && IN(pb + 9)) { SITE_BEGIN;
            const unsigned char* w45 = F.ws + WS_W45 + (size_t)l * W45_STRIDE;
            {   pg8::SchedPlain S{(const char*)(F.ws + WS_PB + (size_t)l * M * PDIM * 2), (const char*)(w45 + W45_PP), 512, 512, 4, 128, 4, F.G, F.wg};
                pg8::EpiSlotStore E{F.dob + DO_SCR5 + (size_t)F.wg * 262144, 0};
                { int tl_ = F.tid; asm volatile("" : "+v"(tl_)); pg8::gemm_phase(F.lds, S, E, tl_); } }
            {   pg8::SchedPlain S{(const char*)(F.dob + DO_XB8), (const char*)(F.dob + DO_W8 + (size_t)l * W8_STRIDE + W8_PG), 1024, 1024, 8, 128, 4, F.G, F.wg};
                pg8::EpiSlotMul E{F.dob + DO_SCR5 + (size_t)F.wg * 262144};
                { int tl_ = F.tid; asm volatile("" : "+v"(tl_)); pg8::gemm_phase<pg8::EpiSlotMul, pg8::SchedPlain, true>(F.lds, S, E, tl_); } }
            SEAM(pb + 9);
        }
        if (SITE(11) && IN(pb + 10)) { SITE_BEGIN;
            const unsigned char* w45 = F.ws + WS_W45 + (size_t)l * W45_STRIDE;
            pg8::SchedG5b S{(const char*)(F.ws + WS_UG), (const char*)(w45 + W45_DN), F.G, F.wg};
            pg8::EpiG5b E{F.dob + DO_SCR5 + (size_t)F.wg * 262144, (bf16*)(F.ws + WS_XB)};
            pg8::gemm_phase(F.lds, S, E, F.tid);
            SEAM(pb + 10);
        }
        if (SITE(12) && IN(pb + 11)) { SITE_BEGIN; const char* XBc = (const char*)(F.ws + WS_XB); (void)XBc; const unsigned char* w123 = F.ws + WS_W123; const unsigned char* w45 = F.ws + WS_W45 + (size_t)l * W45_STRIDE; (void)w123; (void)w45; ln_phase(F, KA->in[19] + l * DM, KA->in[20] + l * DM, l == DEPTH - 1 ? KA->out : nullptr, l == DEPTH - 1 ? nullptr : F.dob + DO_XB8); SEAM(pb + 11); }
    }
#undef IN
#undef SEAM
}

extern "C" void kernel_launch(void* const* d_in, const int* in_sizes, int n_in, void* d_out, int out_size, void* d_ws, size_t ws_size, hipStream_t stream) {
    static int grid = 0;
    if (grid == 0) {
        if (n_in != 21 || out_size != M * DM || ws_size < WS_END) { fprintf(stderr, "kernel_launch: unexpected shapes (n_in %d out %d ws %zu)\n", n_in, out_size, ws_size); grid = -1; return; }
        int dev = 0, cus = 0, per_cu = 0;
        if (hipGetDevice(&dev) != hipSuccess || hipDeviceGetAttribute(&cus, hipDeviceAttributeMultiprocessorCount, dev) != hipSuccess) { grid = -1; return; }
        if (hipFuncSetAttribute((const void*)fwd_kernel, hipFuncAttributeMaxDynamicSharedMemorySize, LDS_BYTES) != hipSuccess) { grid = -1; return; }
        if (hipOccupancyMaxActiveBlocksPerMultiprocessor(&per_cu, (const void*)fwd_kernel, NWAVES * 64, LDS_BYTES) != hipSuccess || per_cu < 1)
            fprintf(stderr, "kernel_launch: occupancy query reports %d\n", per_cu);
        (void)hipGetLastError();
        grid = cus;
    }
    if (grid < 0) return;
    (void)hipMemsetAsync((char*)d_ws + WS_CTL, 0, CTL_ZERO_BYTES, stream);
    Args a{};
    for (int i = 0; i < 21; ++i) a.in[i] = (const float*)d_in[i];
    a.out = (float*)d_out; a.ws = (unsigned char*)d_ws;
#if MK_ONE_LAUNCH
    a.ph_lo = 0; a.ph_hi = N_PHASES; a.sub = 7;
    hipLaunchKernelGGL(fwd_kernel, dim3(grid), dim3(NWAVES * 64), LDS_BYTES, stream, a);
#else
    for (int p = 0; p < N_PHASES; ++p) { a.ph_lo = p; a.ph_hi = p + 1; a.sub = 7;
        hipLaunchKernelGGL(fwd_kernel, dim3(grid), dim3(NWAVES * 64), LDS_BYTES, stream, a);
#ifdef PROBE_PHASE
        if (p >= 1 && (p - 1) % PH_PER_LAYER == PROBE_PHASE) { (void)hipMemsetAsync((char*)d_ws + WS_CTL + CW_WQ * 4, 0, 1024, stream); a.sub = PROBE_SUB;
            hipLaunchKernelGGL(fwd_kernel, dim3(grid), dim3(NWAVES * 64), LDS_BYTES, stream, a); }
#endif
    }
#endif
}
```

```cpp
#include <hip/hip_runtime.h>
#include <cstdio>
#include <cstdint>

#ifndef EXP
#define EXP 0
#endif
#ifndef EXPM
#define EXPM 15
#endif
#ifndef MK_ONE_LAUNCH
#define MK_ONE_LAUNCH 1
#endif

#define GAS __attribute__((address_space(1)))
#define LAS __attribute__((address_space(3)))
typedef unsigned short bf16;
typedef unsigned u32x4 __attribute__((ext_vector_type(4)));
typedef unsigned u32x2 __attribute__((ext_vector_type(2)));
typedef float f32x2 __attribute__((ext_vector_type(2)));
typedef float f32x4 __attribute__((ext_vector_type(4)));
typedef float f32x16 __attribute__((ext_vector_type(16)));
typedef short bf16x8 __attribute__((ext_vector_type(8)));
typedef short s16x4 __attribute__((ext_vector_type(4)));
typedef GAS unsigned gu32;

constexpr int BATCH = 4, SEQ = 8192, DM = 1024, M = BATCH * SEQ, DEPTH = 2;
constexpr int NIN = 7604, ZW = 3584, DFF = 2816, UGW = 5632, PDIM = 256;
constexpr float LN_EPS = 1e-5f;
constexpr float ALPHA = 1.41421356237f;
constexpr float LOG2E = 1.4426950408889634f;
constexpr int ZC_AQ = 0, ZC_AK = 256, ZC_AV = 512, ZC_BQ = 768, ZC_BK = 1024, ZC_BV = 1280, ZC_CQ = 1536, ZC_CK = 1792, ZC_CV = 2048, ZC_CG = 2304,
              ZC_DQ = 2560, ZC_DK = 2688, ZC_DV = 2816, ZC_DG = 3072, ZC_IQ = 3328, ZC_IK = 3456, ZC_IW = 3488, ZC_DA = 3504;
constexpr int SRC_MG = 3508;

constexpr size_t MiB = 1u << 20;
constexpr size_t WS_CTL = 0, CTL_ZERO_BYTES = 1 * MiB;
constexpr size_t WS_XB = 1 * MiB;
constexpr size_t WS_BIG = 65 * MiB;
constexpr size_t WS_Z = WS_BIG, WS_Y = WS_BIG + 224 * MiB, WS_MERGED = WS_BIG + 288 * MiB, WS_UG = WS_BIG;
constexpr size_t WS_MASK = WS_MERGED, WS_KVC = WS_MERGED + 32 * MiB, WS_KVD = WS_MERGED + 40 * MiB, WS_DE = WS_MERGED + 56 * MiB;
constexpr size_t WS_SCR2 = WS_Z;
constexpr size_t WS_W45 = 417 * MiB, W45_STRIDE = 19 * MiB;
constexpr size_t W45_UP = 0, W45_PG = 11 * MiB, W45_PP = 13 * MiB, W45_DN = 13 * MiB + 512 * 1024;
constexpr size_t WS_PB = 455 * MiB;
constexpr size_t WS_W123 = 487 * MiB;
constexpr size_t WS_END = 506 * MiB;
constexpr size_t W123_W1 = 0, W123_GB = 7 * MiB, W123_WO = 17 * MiB;
constexpr size_t DO_SCR5 = 0;
constexpr size_t DO_XB8 = 64 * MiB;
constexpr size_t DO_W8 = 96 * MiB, W8_STRIDE = 15 * MiB + 256 * 1024, W8_G = 0, W8_UP = 4 * MiB, W8_PG = 9 * MiB + 512 * 1024, W8_DN = 10 * MiB + 512 * 1024, W8_Z = 13 * MiB + 256 * 1024;
constexpr unsigned long long G1_F8_TILES = 0xCB987652ull, G1_BF_TILES = 0xDA4310ull;

constexpr int CW_BAR = 4096, CW_WQ = 8448  , CW_KMAX = 8192;

constexpr int RING_BYTES = 131072;
constexpr int MISC_OFF = 131072 + 320;
constexpr int QST_OFF = 132096;
constexpr int LDS_BYTES = 147456;

constexpr int NWAVES = 8;

#define RLX_AGENT __ATOMIC_RELAXED, __HIP_MEMORY_SCOPE_AGENT
__device__ __forceinline__ unsigned f2bf(float f) { unsigned u = __builtin_bit_cast(unsigned, f); return (u + 0x7fffu + ((u >> 16) & 1u)) >> 16; }
typedef __bf16 bf16x2_t __attribute__((ext_vector_type(2)));
__device__ __forceinline__ unsigned pk2(float lo, float hi) { const f32x2 v = {lo, hi}; const bf16x2_t b = __builtin_convertvector(v, bf16x2_t); return __builtin_bit_cast(unsigned, b); }
__device__ __forceinline__ unsigned pk4f8(float a, float b, float c, float d) { int p = __builtin_amdgcn_cvt_pk_fp8_f32(a, b, 0, false); p = __builtin_amdgcn_cvt_pk_fp8_f32(c, d, p, true); return (unsigned)p; }
__device__ __forceinline__ float bflo(unsigned w) { return __uint_as_float(w << 16); }
__device__ __forceinline__ float bfhi(unsigned w) { return __uint_as_float(w & 0xffff0000u); }
__device__ __forceinline__ float bf1(bf16 b) { return __uint_as_float((unsigned)b << 16); }
__device__ __forceinline__ float sigmoidf_(float x) { return __builtin_amdgcn_rcpf(1.0f + __builtin_amdgcn_exp2f(-LOG2E * x)); }
__device__ __forceinline__ float shx(float v, int lane, int m) { return __int_as_float(__builtin_amdgcn_ds_bpermute((lane ^ m) << 2, __float_as_int(v))); }
__device__ __forceinline__ unsigned shup(unsigned v, int lane, int o) { return (unsigned)__builtin_amdgcn_ds_bpermute((lane - o) << 2, (int)v); }
__device__ __forceinline__ float wave_sum(float v, int lane) {
#pragma unroll
    for (int o = 1; o < 64; o <<= 1) v += shx(v, lane, o);
    return v;
}

#define XB_TMO      128
#define XB_XCNT(j)  (256  + 64 * (j))
#define XB_XSUB(j)  (1280 + 64 * (j))
#define XB_XGEN(j)  (2304 + 64 * (j))
#define XB_TOP      3328
#define XB_TOPGEN   3392
#define XCD_BAR_WORDS 3456
#define XB_SPIN_CAP (1u << 22)

__device__ __forceinline__ unsigned xb_ld(unsigned* p)              { return __hip_atomic_load(p, __ATOMIC_RELAXED, __HIP_MEMORY_SCOPE_AGENT); }
__device__ __forceinline__ unsigned xb_add(unsigned* p, unsigned v) { return __hip_atomic_fetch_add(p, v, __ATOMIC_RELAXED, __HIP_MEMORY_SCOPE_AGENT); }
__device__ __forceinline__ unsigned xb_xcc_id() { return (unsigned)__builtin_amdgcn_s_getreg((3 << 11) | 20) & 0xFu; }
#define XB_SPIN(cond, bar) do { unsigned _sp = 0; while (cond) { __builtin_amdgcn_s_sleep(1); \
    if ((++_sp & 255u) == 0u) { if (xb_ld(&(bar)[XB_TMO])) break; if (_sp > XB_SPIN_CAP) { atomicAdd(&(bar)[XB_TMO], 1u); break; } } } } while (0)

struct XcdBarrier { unsigned* bar; unsigned x; volatile LAS unsigned* st; };

__device__ __forceinline__ XcdBarrier xcd_barrier_post(unsigned* bar, volatile LAS unsigned* st) {
    XcdBarrier b; b.bar = bar; b.x = xb_xcc_id(); b.st = st;
    if (threadIdx.x == 0) (void)xb_add(&bar[XB_XCNT(b.x)], 1u);
    return b;
}
__device__ __forceinline__ void xcd_barrier_complete(unsigned* bar, unsigned x, unsigned& nloc, unsigned& nx) {
    const unsigned G = gridDim.x * gridDim.y * gridDim.z;
    unsigned sum, cnt, mine, sp = 0u;
    for (;;) {
        sum = 0u; cnt = 0u; mine = 0u;
#pragma unroll
        for (unsigned j = 0; j < 16; ++j) { const unsigned c = xb_ld(&bar[XB_XCNT(j)]); sum += c; cnt += (c > 0u) ? 1u : 0u; mine = (j == x) ? c : mine; }
        if (sum == G) break;
        __builtin_amdgcn_s_sleep(1);
        if ((++sp & 255u) == 0u) { if (xb_ld(&bar[XB_TMO])) break; if (sp > XB_SPIN_CAP) { atomicAdd(&bar[XB_TMO], 1u); break; } }
    }
    nloc = mine > 0u ? mine : 1u; nx = cnt > 0u ? cnt : 1u;
}
__device__ __forceinline__ void xcd_barrier(const XcdBarrier& b, const bool leader_thread) {
    asm volatile("s_waitcnt vmcnt(0)" ::: "memory");
    __syncthreads();
    if (leader_thread) {
        unsigned* bar = b.bar;
        __builtin_amdgcn_s_waitcnt(0);
        unsigned nloc = b.st[0], nx = b.st[1];
        if (nloc == 0u) { xcd_barrier_complete(bar, b.x, nloc, nx); b.st[0] = nloc; b.st[1] = nx; }
        const unsigned old = xb_add(&bar[XB_XSUB(b.x)], 1u);
        const unsigned gen = old / nloc;
        if (old + 1u == (gen + 1u) * nloc) {
            __builtin_amdgcn_fence(__ATOMIC_RELEASE, "agent");
            asm volatile("s_waitcnt vmcnt(0)" ::: "memory");
            const unsigned og = xb_add(&bar[XB_TOP], 1u);
            const unsigned tg = og / nx;
            if (og + 1u == (tg + 1u) * nx) xb_add(&bar[XB_TOPGEN], 1u);
            else XB_SPIN(xb_ld(&bar[XB_TOPGEN]) == tg, bar);
            __builtin_amdgcn_fence(__ATOMIC_ACQUIRE, "agent");
            xb_add(&bar[XB_XGEN(b.x)], 1u);
            asm volatile("s_waitcnt vmcnt(0)" ::: "memory");
        } else {
            XB_SPIN(xb_ld(&bar[XB_XGEN(b.x)]) == gen, bar);
            __builtin_amdgcn_fence(__ATOMIC_ACQUIRE, "agent");
            asm volatile("s_waitcnt vmcnt(0)" ::: "memory");
        }
    }
    __syncthreads();
}

namespace pg8 {
constexpr int BM = 256, BK = 64, HALF = 128, HTB = HALF * BK * 2, STAGE_BYTES = 8 * HTB, NXCD = 8, WGM = 8;
__device__ __forceinline__ int lds_byte(int r, int c) { const int st = (r >> 4) * 2 + (c >> 5), rr = r & 15, cc = c & 31, ob = rr * 64 + cc * 2; return st * 1024 + (ob ^ (((ob >> 9) & 1) << 5)); }
__device__ __forceinline__ void stage_rc(int b, int& R, int& C) { const int st = b / 1024, sb = b % 1024, swz = sb ^ (((sb >> 9) & 1) << 5); R = (st >> 1) * 16 + swz / 64; C = (st & 1) * 32 + (swz % 64) / 2; }
__device__ __forceinline__ int perm32(int rho) { const int n = rho >> 4, i = rho & 15; return 8 * (i >> 2) + 4 * n + (i & 3); }

struct UnitD { const char* A; const char* B; int lda2, ldb2, nt, pm, pn, kind; };

__device__ __forceinline__ void tile_map(int L, int nM, int nN, int& pm, int& pn) {
    const int nwg = nM * nN; int wgid = L;
    { const int q = nwg / NXCD, r = nwg % NXCD, xcd = wgid % NXCD, off = wgid / NXCD; wgid = (xcd < r ? xcd * (q + 1) : r * (q + 1) + (xcd - r) * q) + off; }
    const int nig = WGM * nN, gid = wgid / nig, fm = gid * WGM, gsz = (nM - fm) < WGM ? (nM - fm) : WGM;
    pm = fm + ((wgid % nig) % gsz); pn = (wgid % nig) / gsz;
}

typedef int i32x8 __attribute__((ext_vector_type(8)));
template <class Epi, class Sched, bool FP8 = false>
__device__ __forceinline__ void gemm_phase(LAS unsigned char* lds, const Sched& S, const Epi& E, const int tid) {
    const int wid = __builtin_amdgcn_readfirstlane(tid >> 6), lane = tid & 63, wr = wid >> 2, wc = wid & 3, fr = lane & 15, fq = lane >> 4;
    int sR, sRb, sC2;
    { int R, C; stage_rc(tid * 16, R, C); sR = R; sRb = (R & ~31) + perm32(R & 31); sC2 = C * 2; }
    const size_t kstep = (size_t)(BK * 2);
    const unsigned ldsw = (unsigned)wid * 1024u;
    const int aoff = lds_byte(wr * 64 + fr, FP8 ? fq * 16 : fq * 8), boff = lds_byte(wc * 32 + fr, FP8 ? fq * 16 : fq * 8);
#define PG8_SA(b, h) (((b) * 2 + (h)) * HTB)
#define PG8_SB(b, h) ((4 + (b) * 2 + (h)) * HTB)
#define PG8_STAGE(bufoff, gbase, rows, pitch) do { const unsigned _o = (unsigned)((rows) * (pitch) + sC2); _Pragma("unroll") for (int _i = 0; _i < 2; ++_i) \
        __builtin_amdgcn_global_load_lds((const unsigned*)((const char*)(gbase) + (size_t)(_i * 64) * (pitch) + _o), (LAS unsigned*)(lds + (bufoff) + ldsw + _i * 8192), 16, 0, 0); } while (0)
#define PG8_LDA(dst, b, h) do { if constexpr (FP8) { _Pragma("unroll") for (int m = 0; m < 4; ++m) { const u32x4 lo_ = *(const LAS u32x4*)(lds + PG8_SA(b, h) + aoff + m * 2048), hi_ = *(const LAS u32x4*)(lds + PG8_SA(b, h) + aoff + m * 2048 + 16); \
            dst##8[m] = (i32x8){(int)lo_.x, (int)lo_.y, (int)lo_.z, (int)lo_.w, (int)hi_.x, (int)hi_.y, (int)hi_.z, (int)hi_.w}; } } \
        else { _Pragma("unroll") for (int m = 0; m < 4; ++m) _Pragma("unroll") for (int k = 0; k < 2; ++k) dst[m][k] = *(const LAS bf16x8*)(lds + PG8_SA(b, h) + aoff + m * 2048 + k * 1024); } } while (0)
#define PG8_LDB(dst, b, h) do { if constexpr (FP8) { _Pragma("unroll") for (int n = 0; n < 2; ++n) { const u32x4 lo_ = *(const LAS u32x4*)(lds + PG8_SB(b, h) + boff + n * 2048), hi_ = *(const LAS u32x4*)(lds + PG8_SB(b, h) + boff + n * 2048 + 16); \
            dst##8[n] = (i32x8){(int)lo_.x, (int)lo_.y, (int)lo_.z, (int)lo_.w, (int)hi_.x, (int)hi_.y, (int)hi_.z, (int)hi_.w}; } } \
        else { _Pragma("unroll") for (int n = 0; n < 2; ++n) _Pragma("unroll") for (int k = 0; k < 2; ++k) dst[n][k] = *(const LAS bf16x8*)(lds + PG8_SB(b, h) + boff + n * 2048 + k * 1024); } } while (0)
#define PG8_MMA(ai, bj, At, Bt) do { __builtin_amdgcn_s_setprio(1); if constexpr (FP8) { _Pragma("unroll") for (int m = 0; m < 4; ++m) _Pragma("unroll") for (int n = 0; n < 2; ++n) \
            asm volatile("v_mfma_scale_f32_16x16x128_f8f6f4 %0, %1, %2, %0, %3, %3 op_sel_hi:[0,0,0]" : "+v"(acc[ai][bj][m][n]) : "v"(Bt##8[n]), "v"(At##8[m]), "v"(scl8)); } \
        else { _Pragma("unroll") for (int m = 0; m < 4; ++m) _Pragma("unroll") for (int n = 0; n < 2; ++n) _Pragma("unroll") for (int k = 0; k < 2; ++k) \
            acc[ai][bj][m][n] = __builtin_amdgcn_mfma_f32_16x16x32_bf16(Bt[n][k], At[m][k], acc[ai][bj][m][n], 0, 0, 0); } __builtin_amdgcn_s_setprio(0); } while (0)
#define PG8_WAIT_V(n) asm volatile("s_waitcnt vmcnt(" #n ")" ::: "memory")
#define PG8_WAIT_L(n) asm volatile("s_waitcnt lgkmcnt(" #n ")" ::: "memory")
#define PG8_BAR __builtin_amdgcn_s_barrier()
#define PG8_SCHED __builtin_amdgcn_sched_barrier(0)
    UnitD cur, nxt; int ui = 0;
    if (!S.next(0, cur)) return;
    f32x4 acc[2][2][4][2];
#pragma unroll
    for (int a = 0; a < 2; ++a)
#pragma unroll
        for (int b = 0; b < 2; ++b)
#pragma unroll
            for (int m = 0; m < 4; ++m)
#pragma unroll
                for (int n = 0; n < 2; ++n) acc[a][b][m][n] = (f32x4){0.f, 0.f, 0.f, 0.f};
    bf16x8 At[4][2], B0[2][2], B1[2][2]; i32x8 At8[4], B08[2], B18[2];
    int scl8 = 0x7c7c7c7c; asm volatile("" : "+v"(scl8));
    const char* cA = cur.A; const char* cB = cur.B;
    int pA = cur.lda2, pB = cur.ldb2;
    PG8_STAGE(PG8_SB(0, 0), cB, sRb, pB); PG8_STAGE(PG8_SB(0, 1), cB + (size_t)HALF * pB, sRb, pB); PG8_STAGE(PG8_SA(0, 0), cA, sR, pA); PG8_STAGE(PG8_SA(0, 1), cA + (size_t)HALF * pA, sR, pA);
    if (wr == 1) PG8_BAR;
    PG8_WAIT_V(2); PG8_BAR;
    PG8_STAGE(PG8_SB(1, 0), cB + kstep, sRb, pB); PG8_STAGE(PG8_SA(1, 0), cA + kstep, sR, pA); PG8_STAGE(PG8_SB(1, 1), cB + (size_t)HALF * pB + kstep, sRb, pB);
    PG8_WAIT_V(6); PG8_BAR;
    for (;;) {
        const bool has_next = S.next(ui + 1, nxt);
        if (!has_next) nxt = cur;
        const char* nA = nxt.A; const char* nB = nxt.B;
        const int nt = cur.nt;
        for (int t = 0; t < nt; t += 2) {
            const bool last = (t == nt - 2);
            const char* a1 = cA + (size_t)(t + 1) * kstep + (size_t)HALF * pA;
            const char* a2 = last ? nA : cA + (size_t)(t + 2) * kstep; const char* b2 = last ? nB : cB + (size_t)(t + 2) * kstep;
            const int p2A = last ? nxt.lda2 : pA, p2B = last ? nxt.ldb2 : pB;
            const char* a2h = a2 + (size_t)HALF * p2A; const char* b2h = b2 + (size_t)HALF * p2B;
            PG8_LDB(B0, 0, 0); PG8_LDB(B1, 0, 1); PG8_SCHED; PG8_LDA(At, 0, 0); PG8_STAGE(PG8_SA(1, 1), a1, sR, pA);
            PG8_WAIT_V(8); PG8_WAIT_L(0); PG8_BAR; PG8_MMA(0, 0, At, B0); PG8_MMA(0, 1, At, B1); PG8_BAR; PG8_SCHED;
            PG8_LDA(At, 0, 1); PG8_STAGE(PG8_SB(0, 0), b2, sRb, p2B); PG8_STAGE(PG8_SB(0, 1), b2h, sRb, p2B); PG8_STAGE(PG8_SA(0, 0), a2, sR, p2A);
            PG8_WAIT_V(8); PG8_WAIT_L(0); PG8_BAR; PG8_MMA(1, 0, At, B0); PG8_MMA(1, 1, At, B1); PG8_BAR; PG8_SCHED;
            PG8_LDB(B0, 1, 0); PG8_LDB(B1, 1, 1); PG8_SCHED; PG8_LDA(At, 1, 0); PG8_STAGE(PG8_SA(0, 1), a2h, sR, p2A);
            PG8_WAIT_V(8); PG8_WAIT_L(0); PG8_BAR; PG8_MMA(0, 0, At, B0); PG8_MMA(0, 1, At, B1); PG8_BAR; PG8_SCHED;
            PG8_LDA(At, 1, 1); PG8_STAGE(PG8_SB(1, 0), b2 + kstep, sRb, p2B); PG8_STAGE(PG8_SB(1, 1), b2h + kstep, sRb, p2B); PG8_STAGE(PG8_SA(1, 0), a2 + kstep, sR, p2A);
            PG8_WAIT_V(8); PG8_WAIT_L(0); PG8_BAR; PG8_MMA(1, 0, At, B0); PG8_MMA(1, 1, At, B1); PG8_BAR; PG8_SCHED;
        }
        if constexpr (FP8) asm volatile("s_nop 15\n\ts_nop 15" ::: "memory");
        if (wr == 0) PG8_BAR;
        { int l2; asm volatile("v_mbcnt_lo_u32_b32 %0, -1, 0\n\tv_mbcnt_hi_u32_b32 %0, -1, %0" : "=v"(l2)); E(acc, cur, wr, wc, l2 & 15, l2 >> 4, wid * 64 + l2); asm volatile("s_waitcnt vmcnt(0)" ::: "memory"); }
        if (!has_next) break;
#pragma unroll
        for (int a = 0; a < 2; ++a)
#pragma unroll
            for (int b = 0; b < 2; ++b)
#pragma unroll
                for (int m = 0; m < 4; ++m)
#pragma unroll
                    for (int n = 0; n < 2; ++n) acc[a][b][m][n] = (f32x4){0.f, 0.f, 0.f, 0.f};
        cur = nxt; cA = nA; cB = nB; pA = cur.lda2; pB = cur.ldb2;
        ++ui;
        if (wr == 1) PG8_BAR;
    }
    PG8_WAIT_V(0);
    PG8_BAR;
#undef PG8_SA
#undef PG8_SB
#undef PG8_STAGE
#undef PG8_LDA
#undef PG8_LDB
#undef PG8_MMA
#undef PG8_WAIT_V
#undef PG8_WAIT_L
#undef PG8_BAR
#undef PG8_SCHED
}

struct SchedPlain {
    const char* A; const char* B; int lda2, ldb2, nt, nM, nN, G, c;
    __device__ __forceinline__ bool next(int i, UnitD& u) const {
        const long L = (long)i * G + c; if (L >= (long)nM * nN) return false;
        int pm, pn; tile_map((int)L, nM, nN, pm, pn);
        u.A = A + (size_t)pm * 256 * lda2; u.B = B + (size_t)pn * 256 * ldb2; u.lda2 = lda2; u.ldb2 = ldb2; u.nt = nt; u.pm = pm; u.pn = pn; u.kind = i; return true;
    }
};
struct SchedTiles {
    const char* A; const char* B; int lda2, ldb2, nt, ntile; unsigned long long list; int compact, G, c;
    __device__ __forceinline__ bool next(int i, UnitD& u) const {
        const long L = (long)i * G + c; if (L >= (long)128 * ntile) return false;
        int pm, pi; tile_map((int)L, 128, ntile, pm, pi); const int col = (int)((list >> (4 * pi)) & 15ull);
        u.A = A + (size_t)pm * 256 * lda2; u.B = B + (size_t)(compact ? pi : col) * 256 * ldb2; u.lda2 = lda2; u.ldb2 = ldb2; u.nt = nt; u.pm = pm; u.pn = col; u.kind = i; return true;
    }
};
struct SchedG5b {
    const char* A; const char* B; int G, c;
    __device__ __forceinline__ bool next(int i, UnitD& u) const {
        const long L = (long)i * G + c; if (L >= 128 * 4) return false;
        int pm, pn; tile_map((int)L, 128, 4, pm, pn);
        u.A = A + (size_t)pm * 256 * (UGW * 2); u.lda2 = UGW * 2; u.B = B + (size_t)pn * 256 * DFF; u.ldb2 = DFF; u.nt = 22; u.pm = pm; u.pn = pn; u.kind = i; return true;
    }
};

#define EPI_LOOP for (int ai = 0; ai < 2; ++ai) _Pragma("unroll") for (int m = 0; m < 4; ++m) _Pragma("unroll") for (int bj = 0; bj < 2; ++bj)
struct EpiStore {
    bf16* O; int ldc;
    __device__ __forceinline__ void operator()(const f32x4 (&acc)[2][2][4][2], const UnitD& u, int wr, int wc, int fr, int fq, int tid) const {
        const int row0 = u.pm * BM + wr * 64 + fr, col0 = u.pn * BM + wc * 32 + 8 * fq;
#pragma unroll
        EPI_LOOP { const f32x4 v0 = acc[ai][bj][m][0], v1 = acc[ai][bj][m][1];
            u32x4 w; w.x = pk2(v0[0], v0[1]); w.y = pk2(v0[2], v0[3]); w.z = pk2(v1[0], v1[1]); w.w = pk2(v1[2], v1[3]);
            *(u32x4*)(O + (size_t)(row0 + ai * HALF + m * 16) * ldc + col0 + bj * HALF) = w; }
    }
};
struct EpiSlotStore {
    unsigned char* sc_; int act;
    __device__ __forceinline__ void operator()(const f32x4 (&acc)[2][2][4][2], const UnitD& u, int wr, int wc, int fr, int fq, int tid) const {
        unsigned loff = (unsigned)tid * 16u; asm volatile("" : "+v"(loff));
        unsigned char* sc = sc_ + (size_t)u.kind * 131072 + loff;
#pragma unroll
        EPI_LOOP { const int q = (ai * 2 + bj) * 4 + m; f32x4 v0 = acc[ai][bj][m][0], v1 = acc[ai][bj][m][1];
            if (act) { v0 = (f32x4){sigmoidf_(v0[0]), sigmoidf_(v0[1]), sigmoidf_(v0[2]), sigmoidf_(v0[3])}; v1 = (f32x4){sigmoidf_(v1[0]), sigmoidf_(v1[1]), sigmoidf_(v1[2]), sigmoidf_(v1[3])}; }
            u32x4 w; w.x = pk2(v0[0], v0[1]); w.y = pk2(v0[2], v0[3]); w.z = pk2(v1[0], v1[1]); w.w = pk2(v1[2], v1[3]);
            *(u32x4*)(sc + (size_t)q * 8192) = w; }
    }
};
struct EpiSlotMul {
    unsigned char* sc_;
    __device__ __forceinline__ void operator()(const f32x4 (&acc)[2][2][4][2], const UnitD& u, int wr, int wc, int fr, int fq, int tid) const {
        unsigned loff = (unsigned)tid * 16u; asm volatile("" : "+v"(loff));
        unsigned char* sc = sc_ + (size_t)u.kind * 131072 + loff;
#pragma unroll
        EPI_LOOP { const int q = (ai * 2 + bj) * 4 + m; const f32x4 v0 = acc[ai][bj][m][0], v1 = acc[ai][bj][m][1];
            u32x4* sp = (u32x4*)(sc + (size_t)q * 8192); const u32x4 p = *sp;
            u32x4 w; w.x = pk2(sigmoidf_(v0[0]) * bflo(p.x), sigmoidf_(v0[1]) * bfhi(p.x)); w.y = pk2(sigmoidf_(v0[2]) * bflo(p.y), sigmoidf_(v0[3]) * bfhi(p.y));
            w.z = pk2(sigmoidf_(v1[0]) * bflo(p.z), sigmoidf_(v1[1]) * bfhi(p.z)); w.w = pk2(sigmoidf_(v1[2]) * bflo(p.w), sigmoidf_(v1[3]) * bfhi(p.w));
            *sp = w;
            if (m & 1) asm volatile("" ::: "memory"); }
    }
};
struct EpiBranch {
    const unsigned char* sc_; bf16* MG; int first;
    __device__ __forceinline__ void operator()(const f32x4 (&acc)[2][2][4][2], const UnitD& u, int wr, int wc, int fr, int fq, int tid) const {
        const int row0 = u.pm * BM + wr * 64 + fr, col0 = u.pn * BM + wc * 32 + 8 * fq;
        unsigned loff = (unsigned)tid * 16u; asm volatile("" : "+v"(loff));
        const unsigned char* sc = sc_ + (size_t)u.kind * 131072 + loff;
#pragma unroll
        EPI_LOOP { const int q = (ai * 2 + bj) * 4 + m; const f32x4 v0 = acc[ai][bj][m][0], v1 = acc[ai][bj][m][1];
            const u32x4 g = *(const u32x4*)(sc + (size_t)q * 8192);
            u32x4* p = (u32x4*)(MG + (size_t)(row0 + ai * HALF + m * 16) * DM + col0 + bj * HALF);
            f32x4 t0 = (f32x4){bflo(g.x) * v0[0], bfhi(g.x) * v0[1], bflo(g.y) * v0[2], bfhi(g.y) * v0[3]};
            f32x4 t1 = (f32x4){bflo(g.z) * v1[0], bfhi(g.z) * v1[1], bflo(g.w) * v1[2], bfhi(g.w) * v1[3]};
            if (!first) { const u32x4 x = *p; t0 += (f32x4){bflo(x.x), bfhi(x.x), bflo(x.y), bfhi(x.y)}; t1 += (f32x4){bflo(x.z), bfhi(x.z), bflo(x.w), bfhi(x.w)}; }
            u32x4 w; w.x = pk2(t0[0], t0[1]); w.y = pk2(t0[2], t0[3]); w.z = pk2(t1[0], t1[1]); w.w = pk2(t1[2], t1[3]);
            *p = w;
            if (m & 1) asm volatile("" ::: "memory"); }
    }
};
struct EpiG3 {
    bf16* XB;
    __device__ __forceinline__ void operator()(const f32x4 (&acc)[2][2][4][2], const UnitD& u, int wr, int wc, int fr, int fq, int tid) const {
        const int row0 = u.pm * BM + wr * 64 + fr, col0 = u.pn * BM + wc * 32 + 8 * fq;
#pragma unroll
        EPI_LOOP { const f32x4 v0 = acc[ai][bj][m][0], v1 = acc[ai][bj][m][1];
            u32x4* p = (u32x4*)(XB + (size_t)(row0 + ai * HALF + m * 16) * DM + col0 + bj * HALF); const u32x4 x = *p;
            u32x4 w; w.x = pk2(ALPHA * bflo(x.x) + v0[0], ALPHA * bfhi(x.x) + v0[1]); w.y = pk2(ALPHA * bflo(x.y) + v0[2], ALPHA * bfhi(x.y) + v0[3]);
            w.z = pk2(ALPHA * bflo(x.z) + v1[0], ALPHA * bfhi(x.z) + v1[1]); w.w = pk2(ALPHA * bflo(x.w) + v1[2], ALPHA * bfhi(x.w) + v1[3]);
            *p = w; }
    }
};
struct EpiG5b {
    const unsigned char* esc_; bf16* XB;
    __device__ __forceinline__ void operator()(const f32x4 (&acc)[2][2][4][2], const UnitD& u, int wr, int wc, int fr, int fq, int tid) const {
        const int row0 = u.pm * BM + wr * 64 + fr, col0 = u.pn * BM + wc * 32 + 8 * fq;
        unsigned loff = (unsigned)tid * 16u; asm volatile("" : "+v"(loff));
        const unsigned char* esc = esc_ + (size_t)u.kind * 131072 + loff;
#pragma unroll
        EPI_LOOP { const int q = (ai * 2 + bj) * 4 + m; const f32x4 v0 = acc[ai][bj][m][0], v1 = acc[ai][bj][m][1];
            const u32x4 e = *(const u32x4*)(esc + (size_t)q * 8192);
            u32x4* p = (u32x4*)(XB + (size_t)(row0 + ai * HALF + m * 16) * DM + col0 + bj * HALF); const u32x4 x = *p;
            u32x4 w; w.x = pk2(ALPHA * bflo(x.x) + v0[0] + bflo(e.x), ALPHA * bfhi(x.x) + v0[1] + bfhi(e.x)); w.y = pk2(ALPHA * bflo(x.y) + v0[2] + bflo(e.y), ALPHA * bfhi(x.y) + v0[3] + bfhi(e.y));
            w.z = pk2(ALPHA * bflo(x.z) + v1[0] + bflo(e.z), ALPHA * bfhi(x.z) + v1[1] + bfhi(e.z)); w.w = pk2(ALPHA * bflo(x.w) + v1[2] + bflo(e.w), ALPHA * bfhi(x.w) + v1[3] + bfhi(e.w));
            *p = w;
            if (m & 1) asm volatile("" ::: "memory"); }
    }
};
}

struct Frame {
    LAS unsigned char* lds;
    int tid, lane, wave, G, wg;
    unsigned char* ws; unsigned char* dob;
};
struct Args { const float* in[21]; float* out; unsigned char* ws; int ph_lo, ph_hi, sub, pad; };

__device__ __forceinline__ int z_src(int n, float& sc) {
    sc = 1.f;
    if (n < 768) { if (n < 256) sc = 0.17677669529663687f * LOG2E; return n; }
    if (n < 1536) { if (n < 1024) sc = 0.125f * LOG2E; return n; }
    if (n < 2560) { if (n >= 1792 && n < 2048) sc = 0.125f; return 1700 + (n - 1536); }
    if (n < 2816) { if (n < 2688) sc = 0.17677669529663687f; return 2724 + (n - 2560); }
    if (n < 3072) return 2980 + (n - 2816);
    if (n < 3328) return 3252 + (n - 3072);
    if (n < 3456) return 1536 + (n - 3328);
    if (n < 3488) return 1664 + (n - 3456);
    if (n < 3492) return 1696 + (n - 3488);
    if (n >= 3504 && n < 3520) return 3236 + (n - 3504);
    return -1;
}
template <int MODE>
__device__ __forceinline__ void transpose_item(const float* W, int Nsrc, int soff, bf16* WT, int dpitch, int dcol0, int k0, int n0, LAS float* scr, int lane) {
    const int nn = lane & 31; float sc = 1.f; int s;
    if (MODE == 1) s = z_src(n0 + nn, sc); else s = soff + n0 + nn;
#pragma unroll 8
    for (int i = 0; i < 32; ++i) { const int kk = 2 * i + (lane >> 5); scr[kk * 33 + nn] = (s >= 0) ? W[(size_t)(k0 + kk) * Nsrc + s] * sc : 0.f; }
    asm volatile("s_waitcnt lgkmcnt(0)" ::: "memory");
    const int c = lane & 7;
#pragma unroll
    for (int j = 0; j < 4; ++j) { const int n = (lane >> 3) + 8 * j; const LAS float* sp = scr + (8 * c) * 33 + n;
        u32x4 o; o.x = pk2(sp[0 * 33], sp[1 * 33]); o.y = pk2(sp[2 * 33], sp[3 * 33]); o.z = pk2(sp[4 * 33], sp[5 * 33]); o.w = pk2(sp[6 * 33], sp[7 * 33]);
        *(u32x4*)(WT + (size_t)(n0 + n) * dpitch + dcol0 + k0 + 8 * c) = o; }
    asm volatile("s_waitcnt lgkmcnt(0)" ::: "memory");
}
__device__ __forceinline__ void transpose_item8(const float* W, int Nsrc, int soff, unsigned char* WT, int K, int k0, int n0, LAS float* scr, int lane) {
    const int nn = lane & 31; const int s = soff + n0 + nn;
#pragma unroll 8
    for (int i = 0; i < 32; ++i) { const int kk = 2 * i + (lane >> 5); scr[kk * 33 + nn] = W[(size_t)(k0 + kk) * Nsrc + s] * 64.f; }
    asm volatile("s_waitcnt lgkmcnt(0)" ::: "memory");
    const int c = lane & 7;
#pragma unroll
    for (int j = 0; j < 4; ++j) { const int n = (lane >> 3) + 8 * j; const LAS float* sp = scr + (8 * c) * 33 + n;
        u32x2 o; o.x = pk4f8(sp[0 * 33], sp[1 * 33], sp[2 * 33], sp[3 * 33]); o.y = pk4f8(sp[4 * 33], sp[5 * 33], sp[6 * 33], sp[7 * 33]);
        *(u32x2*)(WT + (size_t)(n0 + n) * K + k0 + 8 * c) = o; }
    asm volatile("s_waitcnt lgkmcnt(0)" ::: "memory");
}
__device__ __forceinline__ void transpose_item8z(const float* W, unsigned char* WT, int tile, int slot, int k0, int n0, LAS float* scr, int lane) {
    const int nn = lane & 31; float sc = 1.f; const int s = z_src(tile * 256 + n0 + nn, sc); sc *= 64.f;
#pragma unroll 8
    for (int i = 0; i < 32; ++i) { const int kk = 2 * i + (lane >> 5); scr[kk * 33 + nn] = (s >= 0) ? W[(size_t)(k0 + kk) * NIN + s] * sc : 0.f; }
    asm volatile("s_waitcnt lgkmcnt(0)" ::: "memory");
    const int c = lane & 7;
#pragma unroll
    for (int j = 0; j < 4; ++j) { const int n = (lane >> 3) + 8 * j; const LAS float* sp = scr + (8 * c) * 33 + n;
        u32x2 o; o.x = pk4f8(sp[0 * 33], sp[1 * 33], sp[2 * 33], sp[3 * 33]); o.y = pk4f8(sp[4 * 33], sp[5 * 33], sp[6 * 33], sp[7 * 33]);
        *(u32x2*)(WT + (size_t)(slot * 256 + n0 + n) * 1024 + k0 + 8 * c) = o; }
    asm volatile("s_waitcnt lgkmcnt(0)" ::: "memory");
}
typedef __attribute__((address_space(4))) const struct Args* KArgPtr;
__device__ __forceinline__ void convert_w123(Frame& F, const float* w_in, const float* w_branch, const float* w_out) {
    LAS float* scr = (LAS float*)(F.lds + F.wave * 16384);
    const int gw = F.wg * NWAVES + F.wave, NGW = F.G * NWAVES;
    constexpr int I1 = 16 * 112, I2 = 16 * 128, I3 = 4 * 128, I4 = 16 * 32;
    unsigned char* w123 = F.ws + WS_W123;
    for (int it = gw; it < I1 + I2 + I3 + I4; it += NGW) {
        int r = it;
        if (r < I1) { transpose_item<1>(w_in, NIN, 0, (bf16*)(w123 + W123_W1), 1024, 0, 64 * (r / 112), 32 * (r % 112), scr, F.lane); continue; } r -= I1;
        if (r < I2) { transpose_item<0>(w_in, NIN, SRC_MG, (bf16*)(w123 + W123_GB), 1024, 0, 64 * (r / 128), 32 * (r % 128), scr, F.lane); continue; } r -= I2;
        if (r < I3) { const int n = r / 128, rr = r % 128; transpose_item<0>(w_branch + (size_t)n * 256 * DM, DM, 0, (bf16*)(w123 + W123_GB + 8 * MiB) + (size_t)n * 1024 * 256, 256, 0, 64 * (rr / 32), 32 * (rr % 32), scr, F.lane); continue; } r -= I3;
        transpose_item<0>(w_out, DM, 0, (bf16*)(w123 + W123_WO), 1024, 0, 64 * (r / 32), 32 * (r % 32), scr, F.lane);
    }
}
__device__ __forceinline__ void p0_prologue(Frame& F, __attribute__((address_space(4))) const Args* Ap) {
    LAS float* scr = (LAS float*)(F.lds + F.wave * 16384);
    const int gw = F.wg * NWAVES + F.wave, NGW = F.G * NWAVES;
    constexpr int I5 = 16 * 176, I6 = 16 * 32, I7 = 4 * 32, I8 = 44 * 32;
    constexpr int IL = I5 + I6 + I7 + I8;
    for (int it = gw; it < 2 * IL; it += NGW) {
        const int l = it / IL; int r = it - l * IL;
        unsigned char* w45 = F.ws + WS_W45 + (size_t)l * W45_STRIDE;
        if (r < I5) { transpose_item<0>(Ap->in[13] + (size_t)l * DM * UGW, UGW, 0, (bf16*)(w45 + W45_UP), 1024, 0, 64 * (r / 176), 32 * (r % 176), scr, F.lane); continue; } r -= I5;
        if (r < I6) { transpose_item<0>(Ap->in[17] + (size_t)l * DM * DM, DM, 0, (bf16*)(w45 + W45_PG), 1024, 0, 64 * (r / 32), 32 * (r % 32), scr, F.lane); continue; } r -= I6;
        if (r < I7) { transpose_item<0>(Ap->in[18] + (size_t)l * PDIM * DM, DM, 0, (bf16*)(w45 + W45_PP), 256, 0, 64 * (r / 32), 32 * (r % 32), scr, F.lane); continue; } r -= I7;
        transpose_item<0>(Ap->in[16] + (size_t)l * DFF * DM, DM, 0, (bf16*)(w45 + W45_DN), DFF, 0, 64 * (r / 32), 32 * (r % 32), scr, F.lane);
    }
    {   constexpr int J1 = 16 * 128, J2 = 16 * 176, J3 = 16 * 32, J4 = 44 * 32, J5 = 8 * 16 * 8, JL = J1 + J2 + J3 + J4 + J5;
        for (int it = gw; it < 2 * JL; it += NGW) { const int l = it / JL; int r = it - l * JL; unsigned char* w8 = F.dob + DO_W8 + (size_t)l * W8_STRIDE;
            if (r < J1) { transpose_item8(Ap->in[2] + (size_t)l * DM * NIN, NIN, SRC_MG, w8 + W8_G, 1024, 64 * (r / 128), 32 * (r % 128), scr, F.lane); continue; } r -= J1;
            if (r < J2) { transpose_item8(Ap->in[13] + (size_t)l * DM * UGW, UGW, 0, w8 + W8_UP, 1024, 64 * (r / 176), 32 * (r % 176), scr, F.lane); continue; } r -= J2;
            if (r < J3) { transpose_item8(Ap->in[17] + (size_t)l * DM * DM, DM, 0, w8 + W8_PG, 1024, 64 * (r / 32), 32 * (r % 32), scr, F.lane); continue; } r -= J3;
            if (r < J4) { transpose_item8(Ap->in[16] + (size_t)l * DFF * DM, DM, 0, w8 + W8_DN, DFF, 64 * (r / 32), 32 * (r % 32), scr, F.lane); continue; } r -= J4;
            { const int slot = r >> 7, rr = r & 127; transpose_item8z(Ap->in[2] + (size_t)l * DM * NIN, w8 + W8_Z, (int)((G1_F8_TILES >> (4 * slot)) & 15), slot, 64 * (rr >> 3), 32 * (rr & 7), scr, F.lane); } } }
    convert_w123(F, Ap->in[2], Ap->in[9], Ap->in[10]);
    {   const size_t n8 = (size_t)M * DM / 8; const f32x4* src = (const f32x4*)Ap->in[0]; u32x4* dst = (u32x4*)(F.ws + WS_XB); u32x2* dst8 = (u32x2*)(F.dob + DO_XB8);
        for (size_t i = (size_t)F.wg * 512 + F.tid; i < n8; i += (size_t)F.G * 512) { const f32x4 a = src[2 * i], b = src[2 * i + 1]; u32x4 o; o.x = pk2(a[0], a[1]); o.y = pk2(a[2], a[3]); o.z = pk2(b[0], b[1]); o.w = pk2(b[2], b[3]); dst[i] = o;
            u32x2 o8; o8.x = pk4f8(a[0], a[1], a[2], a[3]); o8.y = pk4f8(b[0], b[1], b[2], b[3]); dst8[i] = o8; } }
    {   const size_t n8 = (size_t)DEPTH * M * PDIM / 8; const f32x4* src = (const f32x4*)Ap->in[1]; u32x4* dst = (u32x4*)(F.ws + WS_PB);
        for (size_t i = (size_t)F.wg * 512 + F.tid; i < n8; i += (size_t)F.G * 512) { const f32x4 a = src[2 * i], b = src[2 * i + 1]; u32x4 o; o.x = pk2(a[0], a[1]); o.y = pk2(a[2], a[3]); o.z = pk2(b[0], b[1]); o.w = pk2(b[2], b[3]); dst[i] = o; } }
}

__device__ __forceinline__ void ln_phase(Frame& F, const float* w, const float* bvec, float* outf, unsigned char* xb8) {
    const int gw = F.wg * NWAVES + F.wave, NGW = F.G * NWAVES;
    bf16* XB = (bf16*)(F.ws + WS_XB);
    for (int row = gw; row < M; row += NGW) {
        u32x4* p = (u32x4*)(XB + (size_t)row * DM) + F.lane;
        const u32x4 a = p[0], b = p[64];
        float v[16] = {bflo(a.x), bfhi(a.x), bflo(a.y), bfhi(a.y), bflo(a.z), bfhi(a.z), bflo(a.w), bfhi(a.w), bflo(b.x), bfhi(b.x), bflo(b.y), bfhi(b.y), bflo(b.z), bfhi(b.z), bflo(b.w), bfhi(b.w)};
        float s = 0.f;
#pragma unroll
        for (int i = 0; i < 16; ++i) s += v[i];
        const float mean = wave_sum(s, F.lane) * (1.f / DM); float q = 0.f;
#pragma unroll
        for (int i = 0; i < 16; ++i) { v[i] -= mean; q += v[i] * v[i]; }
        const float rstd = 1.f / sqrtf(wave_sum(q, F.lane) * (1.f / DM) + LN_EPS);
        const int c0 = F.lane * 8, c1 = 512 + F.lane * 8;
        const f32x4 w0 = *(const f32x4*)(w + c0), w1 = *(const f32x4*)(w + c0 + 4), w2 = *(const f32x4*)(w + c1), w3 = *(const f32x4*)(w + c1 + 4);
        const f32x4 b0 = *(const f32x4*)(bvec + c0), b1 = *(const f32x4*)(bvec + c0 + 4), b2 = *(const f32x4*)(bvec + c1), b3 = *(const f32x4*)(bvec + c1 + 4);
        f32x4 y0, y1, y2, y3;
#pragma unroll
        for (int i = 0; i < 4; ++i) { y0[i] = v[i] * rstd * w0[i] + b0[i]; y1[i] = v[4 + i] * rstd * w1[i] + b1[i]; y2[i] = v[8 + i] * rstd * w2[i] + b2[i]; y3[i] = v[12 + i] * rstd * w3[i] + b3[i]; }
        u32x4 o0, o1; o0.x = pk2(y0[0], y0[1]); o0.y = pk2(y0[2], y0[3]); o0.z = pk2(y1[0], y1[1]); o0.w = pk2(y1[2], y1[3]);
        o1.x = pk2(y2[0], y2[1]); o1.y = pk2(y2[2], y2[3]); o1.z = pk2(y3[0], y3[1]); o1.w = pk2(y3[2], y3[3]);
        p[0] = o0; p[64] = o1;
        if (xb8) { u32x2* q8 = (u32x2*)(xb8 + (size_t)row * DM) + F.lane; u32x2 a8, b8; a8.x = pk4f8(y0[0], y0[1], y0[2], y0[3]); a8.y = pk4f8(y1[0], y1[1], y1[2], y1[3]); b8.x = pk4f8(y2[0], y2[1], y2[2], y2[3]); b8.y = pk4f8(y3[0], y3[1], y3[2], y3[3]); q8[0] = a8; q8[64] = b8; }
        if (outf) { f32x4* op = (f32x4*)(outf + (size_t)row * DM); op[2 * F.lane] = y0; op[2 * F.lane + 1] = y1; op[128 + 2 * F.lane] = y2; op[128 + 2 * F.lane + 1] = y3; }
    }
}

__device__ __forceinline__ float gelu_tanh_(float y) { const float t = 1.5957691216057308f * (y + 0.044715f * y * y * y); return y * __builtin_amdgcn_rcpf(1.0f + __builtin_amdgcn_exp2f(-LOG2E * t)); }
__device__ __forceinline__ void up8(const u32x4 w, float (&v)[8]) { v[0] = bflo(w.x); v[1] = bfhi(w.x); v[2] = bflo(w.y); v[3] = bfhi(w.y); v[4] = bflo(w.z); v[5] = bfhi(w.z); v[6] = bflo(w.w); v[7] = bfhi(w.w); }
__device__ __forceinline__ void ffn_act_phase(Frame& F, const float* cw, const float* cb) {
    unsigned char* UGb = F.ws + WS_UG; constexpr int NV = DFF / 8, RB = 16;
    const int v = F.tid, c0 = v * 8; const bool on = v < NV;
    float w0[8], w1[8], w2[8], bb[8];
#pragma unroll
    for (int i = 0; i < 8; ++i) { w0[i] = on ? cw[c0 + i] : 0.f; w1[i] = on ? cw[DFF + c0 + i] : 0.f; w2[i] = on ? cw[2 * DFF + c0 + i] : 0.f; bb[i] = on ? cb[c0 + i] : 0.f; }
    for (int rb = F.wg; rb < M / RB; rb += F.G) {
        const int t0 = rb * RB; u32x2 outv[RB];
        if (on) { u32x4 uq[RB], gq[RB]; const bf16* base = (const bf16*)(UGb + (size_t)t0 * (UGW * 2));
#pragma unroll
            for (int r = 0; r < RB; ++r) { uq[r] = *(const u32x4*)(base + (size_t)r * UGW + c0); gq[r] = *(const u32x4*)(base + (size_t)r * UGW + DFF + c0); }
            float gm2[8], gm1[8];
            if ((t0 & (SEQ - 1)) == 0) {
#pragma unroll
                for (int i = 0; i < 8; ++i) { gm2[i] = 0.f; gm1[i] = 0.f; }
            } else { up8(*(const u32x4*)(base - 2 * UGW + DFF + c0), gm2); up8(*(const u32x4*)(base - UGW + DFF + c0), gm1); }
#pragma unroll
            for (int r = 0; r < RB; ++r) { float g0[8], uu[8], o[8]; up8(gq[r], g0); up8(uq[r], uu);
#pragma unroll
                for (int i = 0; i < 8; ++i) { const float y = bb[i] + w0[i] * gm2[i] + w1[i] * gm1[i] + w2[i] * g0[i]; o[i] = gelu_tanh_(y) * uu[i]; gm2[i] = gm1[i]; gm1[i] = g0[i]; }
                outv[r].x = pk4f8(o[0], o[1], o[2], o[3]); outv[r].y = pk4f8(o[4], o[5], o[6], o[7]); } }
        __syncthreads();
        if (on) {
#pragma unroll
            for (int r = 0; r < RB; ++r) *(u32x2*)(UGb + (size_t)(t0 + r) * (UGW * 2) + c0) = outv[r]; }
    }
}

namespace mx {
__device__ __forceinline__ f32x16 mfma32(bf16x8 a, bf16x8 b, f32x16 c) { return __builtin_amdgcn_mfma_f32_32x32x16_bf16(a, b, c, 0, 0, 0); }
__device__ __forceinline__ f32x16 splat16(float v) { f32x16 r;
#pragma unroll
    for (int i = 0; i < 16; ++i) r[i] = v;
    return r; }
__device__ __forceinline__ int crow_c(int e) { return (e & 3) + 8 * (e >> 2); }
typedef short v4i16_t __attribute__((ext_vector_type(4)));
__device__ __forceinline__ s16x4 vtr(const LAS unsigned char* p) { return __builtin_bit_cast(s16x4, __builtin_amdgcn_ds_read_tr16_b64_v4i16((LAS v4i16_t*)p)); }
__device__ __forceinline__ bf16x8 pack8(float a0, float a1, float a2, float a3, float a4, float a5, float a6, float a7) {
    u32x4 w; w.x = pk2(a0, a1); w.y = pk2(a2, a3); w.z = pk2(a4, a5); w.w = pk2(a6, a7); return __builtin_bit_cast(bf16x8, w); }

__device__ __forceinline__ float log2gam(int h) { return __builtin_log2f(1.0f - __builtin_exp2f(-5.0f - (float)h)); }
__device__ __forceinline__ void prepkv_unit(Frame& F, int blk, const float* wa2, const float* bap, unsigned* kmaxl) {
    bf16* Z = (bf16*)(F.ws + WS_Z);
    const size_t r0 = (size_t)blk * 256; const int b = blk >> 5, cb = blk & 31;
    const int tid = F.tid;
    {   const int ch = tid >> 7, col = tid & 127;
        const float ba = bap[col];
        float wa[16];
#pragma unroll
        for (int r = 0; r < 16; ++r) wa[r] = wa2[r * 128 + col];
        float cum = 0.f;
        for (int t0 = 0; t0 < 64; t0 += 8) { u32x4 A[8], B[8];
#pragma unroll
            for (int tt = 0; tt < 8; ++tt) { const bf16* zr = Z + (r0 + ch * 64 + t0 + tt) * ZW; A[tt] = *(const u32x4*)(zr + ZC_DA); B[tt] = *(const u32x4*)(zr + ZC_DA + 8); }
#pragma unroll
            for (int tt = 0; tt < 8; ++tt) { float da[8], db[8]; up8(A[tt], da); up8(B[tt], db); float x = ba;
#pragma unroll
                for (int r = 0; r < 8; ++r) x += da[r] * wa[r];
#pragma unroll
                for (int r = 0; r < 8; ++r) x += db[r] * wa[8 + r];
                cum += (fminf(x, 0.f) - __logf(1.0f + __expf(-fabsf(x)))) * 0.0625f; } }
        const float bl = cum; cum = 0.f;
        for (int t0 = 0; t0 < 64; t0 += 8) { u32x4 A[8], B[8]; bf16 qv[8], kv[8];
#pragma unroll
            for (int tt = 0; tt < 8; ++tt) { const bf16* zr = Z + (r0 + ch * 64 + t0 + tt) * ZW; A[tt] = *(const u32x4*)(zr + ZC_DA); B[tt] = *(const u32x4*)(zr + ZC_DA + 8); qv[tt] = zr[ZC_DQ + col]; kv[tt] = zr[ZC_DK + col]; }
#pragma unroll
            for (int tt = 0; tt < 8; ++tt) { bf16* zr = Z + (r0 + ch * 64 + t0 + tt) * ZW; float da[8], db[8]; up8(A[tt], da); up8(B[tt], db); float x = ba;
#pragma unroll
                for (int r = 0; r < 8; ++r) x += da[r] * wa[r];
#pragma unroll
                for (int r = 0; r < 8; ++r) x += db[r] * wa[8 + r];
                cum += (fminf(x, 0.f) - __logf(1.0f + __expf(-fabsf(x)))) * 0.0625f;
                zr[ZC_DQ + col] = (bf16)f2bf(bf1(qv[tt]) * __expf(cum - bl)); zr[ZC_DK + col] = (bf16)f2bf(bf1(kv[tt]) * __expf(bl - cum)); } }
        ((float*)(F.ws + WS_DE))[((size_t)b * 128 + cb * 4 + ch) * 128 + col] = __expf(bl);
    }
    for (int itn = 0; itn < 6; ++itn) { const int task = tid + 512 * itn, sl = task >> 8, row = task & 255;
        const bf16* kp = Z + (r0 + row) * ZW + (sl < 8 ? ZC_AK + (sl >> 1) * 64 + (sl & 1) * 32 : ZC_BK + (sl - 8) * 64); float ss = 0.f;
        const int nch = sl < 8 ? 4 : 8;
        for (int c = 0; c < nch; ++c) { float v[8]; up8(*(const u32x4*)(kp + 8 * c), v);
#pragma unroll
            for (int i = 0; i < 8; ++i) ss += v[i] * v[i]; }
#pragma unroll
        for (int o = 1; o < 64; o <<= 1) ss = fmaxf(ss, shx(ss, F.lane, o));
        if (F.lane == 0) __hip_atomic_fetch_max(kmaxl + b * 16 + sl, __float_as_uint(sqrtf(ss)), __ATOMIC_RELAXED, __HIP_MEMORY_SCOPE_AGENT); }
    for (int i0 = 0; i0 < 32; i0 += 4) { u32x4 vv[4];
#pragma unroll
        for (int k = 0; k < 4; ++k) { const int idx = tid + 512 * (i0 + k); const int row = idx >> 6, chunk = idx & 63, isk = chunk >> 5, c8 = (chunk & 31) * 8;
            vv[k] = *(const u32x4*)(Z + (r0 + row) * ZW + (isk ? ZC_CK : ZC_CQ) + c8); }
#pragma unroll
        for (int k = 0; k < 4; ++k) { const int idx = tid + 512 * (i0 + k); const int row = idx >> 6, chunk = idx & 63, isk = chunk >> 5, c8 = (chunk & 31) * 8, h = c8 >> 6;
            const float e = (float)(255 - row) * log2gam(h); const float f = __builtin_amdgcn_exp2f(isk ? e : -e); float v[8]; up8(vv[k], v);
            u32x4 w; w.x = pk2(v[0] * f, v[1] * f); w.y = pk2(v[2] * f, v[3] * f); w.z = pk2(v[4] * f, v[5] * f); w.w = pk2(v[6] * f, v[7] * f);
            *(u32x4*)(Z + (r0 + row) * ZW + (isk ? ZC_CK : ZC_CQ) + c8) = w; } }
    __threadfence_block(); __syncthreads();
    LAS unsigned char* Kl = F.lds; LAS unsigned char* Vl = F.lds + 36864;
    for (int h = 0; h < 4; ++h) {
        for (int idx = tid; idx < 256 * 8; idx += 512) { const int row = idx >> 3, c = idx & 7;
            *(LAS u32x4*)(Kl + row * 144 + c * 16) = *(const u32x4*)(Z + (r0 + row) * ZW + ZC_CK + h * 64 + c * 8);
            *(LAS u32x4*)(Vl + row * 144 + c * 16) = *(const u32x4*)(Z + (r0 + row) * ZW + ZC_CV + h * 64 + c * 8); }
        __syncthreads();
        {   const int d = tid >> 3, dk8 = (tid & 7) * 8; float acc[8];
#pragma unroll
            for (int i = 0; i < 8; ++i) acc[i] = 0.f;
            for (int j = 0; j < 256; ++j) { const float vv = bf1(*(const LAS bf16*)(Vl + j * 144 + d * 2)); float kk[8]; up8(*(const LAS u32x4*)(Kl + j * 144 + dk8 * 2), kk);
#pragma unroll
                for (int i = 0; i < 8; ++i) acc[i] += vv * kk[i]; }
            float* o = (float*)(F.ws + WS_KVC) + ((size_t)((b * 4 + h) * 32 + cb) * 4096 + d * 64 + dk8);
            *(f32x4*)o = (f32x4){acc[0], acc[1], acc[2], acc[3]}; *(f32x4*)(o + 4) = (f32x4){acc[4], acc[5], acc[6], acc[7]}; }
        __syncthreads();
        for (int idx = tid; idx < 256 * 8; idx += 512) { const int row = idx >> 3, c = idx & 7;
            if (c < 4) *(LAS u32x4*)(Kl + row * 144 + c * 16) = *(const u32x4*)(Z + (r0 + row) * ZW + ZC_DK + h * 32 + c * 8);
            *(LAS u32x4*)(Vl + row * 144 + c * 16) = *(const u32x4*)(Z + (r0 + row) * ZW + ZC_DV + h * 64 + c * 8); }
        __syncthreads();
        {   const int ch = tid >> 7, d = (tid >> 1) & 63, dk16 = (tid & 1) * 16; float acc[16];
#pragma unroll
            for (int i = 0; i < 16; ++i) acc[i] = 0.f;
            for (int j = 0; j < 64; ++j) { const int row = ch * 64 + j; const float vv = bf1(*(const LAS bf16*)(Vl + row * 144 + d * 2)); float k0[8], k1[8];
                up8(*(const LAS u32x4*)(Kl + row * 144 + dk16 * 2), k0); up8(*(const LAS u32x4*)(Kl + row * 144 + dk16 * 2 + 16), k1);
#pragma unroll
                for (int i = 0; i < 8; ++i) { acc[i] += vv * k0[i]; acc[8 + i] += vv * k1[i]; } }
            float* o = (float*)(F.ws + WS_KVD) + ((size_t)((b * 4 + h) * 128 + cb * 4 + ch) * 2048 + d * 32 + dk16);
#pragma unroll
            for (int i = 0; i < 4; ++i) *(f32x4*)(o + 4 * i) = (f32x4){acc[4 * i], acc[4 * i + 1], acc[4 * i + 2], acc[4 * i + 3]}; }
        __syncthreads();
    }
}

__device__ __forceinline__ void scan_phase(Frame& F) {
    const int gt = F.wg * 512 + F.tid, NT = F.G * 512;
    for (int e0 = gt; e0 < 16 * 4096 + 16 * 2048; e0 += NT) {
        if (e0 < 16 * 4096) { const int e = e0;
            const int bh = e >> 12, idx = e & 4095, h = bh & 3; const float g256 = __builtin_amdgcn_exp2f(256.0f * log2gam(h));
            float* p = (float*)(F.ws + WS_KVC) + (size_t)bh * 32 * 4096 + idx; float S = 0.f; float kv[32];
#pragma unroll
            for (int c = 0; c < 32; ++c) kv[c] = p[(size_t)c * 4096];
#pragma unroll
            for (int c = 0; c < 32; ++c) { const float Sp = g256 * S; p[(size_t)c * 4096] = Sp; S = Sp + kv[c]; }
        } else { const int e = e0 - 16 * 4096;
            const int bh = e >> 11, idx = e & 2047, b = bh >> 2, h = bh & 3, dk = idx & 31;
            float* p = (float*)(F.ws + WS_KVD) + (size_t)bh * 128 * 2048 + idx; const float* de = (const float*)(F.ws + WS_DE) + (size_t)b * 128 * 128 + h * 32 + dk; float S = 0.f;
            for (int c0 = 0; c0 < 128; c0 += 16) { float kv[16], dd[16];
#pragma unroll
                for (int c = 0; c < 16; ++c) { kv[c] = p[(size_t)(c0 + c) * 2048]; dd[c] = de[(c0 + c) * 128]; }
#pragma unroll
                for (int c = 0; c < 16; ++c) { const float Sp = dd[c] * S; p[(size_t)(c0 + c) * 2048] = Sp; S = Sp + kv[c]; } }
        }
    }
}

constexpr int HPITCH = 1026, CAP = 256;
struct QState { unsigned mode, thr_lo, thr_hi, thr_idx, krem, lcount, pad0, pad1; };
__device__ __forceinline__ unsigned okey_of(float s) { const unsigned u = __float_as_uint(s); return u ^ ((unsigned)((int)u >> 31) | 0x80000000u); }
__device__ __forceinline__ void b1_load(const bf16* Zb, int t, int r, int hh, bf16x8& k0, bf16x8& k1) {
    const bf16* kr = Zb + (size_t)(32 * t + r) * ZW + ZC_IK + 8 * hh; k0 = *(const bf16x8*)kr; k1 = *(const bf16x8*)(kr + 16); }
__device__ __forceinline__ void b1_scores(const bf16x8 k0, const bf16x8 k1, const bf16x8 (&iqf)[4][2], const float (&w)[4], float (&sc)[16]) {
#pragma unroll
    for (int e = 0; e < 16; ++e) sc[e] = 0.f;
#pragma unroll
    for (int ih = 0; ih < 4; ++ih) { f32x16 lg = mfma32(k0, iqf[ih][0], splat16(0.f)); lg = mfma32(k1, iqf[ih][1], lg);
#pragma unroll
        for (int e = 0; e < 16; ++e) sc[e] = fmaf(w[ih], fmaxf(lg[e], 0.f), sc[e]); }
}
__device__ __forceinline__ void b1_setbit(unsigned* MWq, unsigned j) {
    const unsigned wi = j & 31u, hh = (wi >> 2) & 1u, e = (wi & 3u) + 4u * (wi >> 3), kh = (j >> 5) & 1u;
    __hip_atomic_fetch_or(MWq + (size_t)(j >> 6) * 64 + 32u * hh, 1u << (e + 16u * kh), __ATOMIC_RELAXED, __HIP_MEMORY_SCOPE_AGENT);
}
__device__ __forceinline__ void b1_unit(Frame& F, int b, int g) {
    const int tid = F.tid, lane = F.lane, r = lane & 31, hh = lane >> 5, wid = F.wave;
    const bf16* Zb = (const bf16*)(F.ws + WS_Z) + (size_t)b * SEQ * ZW;
    LAS unsigned* hist = (LAS unsigned*)F.lds;
    LAS QState* qst = (LAS QState*)(F.lds + QST_OFF);
    const int qpos = 32 * g + r;
    unsigned* MWb = (unsigned*)(F.ws + WS_MASK) + ((size_t)(b * 256 + g) * 128) * 64;
    bf16x8 iqf[4][2]; float w[4];
    {   const bf16* qr = Zb + (size_t)qpos * ZW;
#pragma unroll
        for (int ih = 0; ih < 4; ++ih) { iqf[ih][0] = *(const bf16x8*)(qr + ZC_IQ + ih * 32 + 8 * hh); iqf[ih][1] = *(const bf16x8*)(qr + ZC_IQ + ih * 32 + 16 + 8 * hh); w[ih] = bf1(qr[ZC_IW + ih]); } }
    if (g >= 8) {
        for (int i = tid; i < 32 * HPITCH; i += 512) hist[i] = 0u;
        __syncthreads();
        {   bf16x8 n0 = iqf[0][0], n1 = iqf[0][0]; int t = wid; if (t <= g) b1_load(Zb, t, r, hh, n0, n1);
            for (; t <= g; t += 8) { const bf16x8 k0 = n0, k1 = n1; if (t + 8 <= g) b1_load(Zb, t + 8, r, hh, n0, n1);
                float sc[16]; b1_scores(k0, k1, iqf, w, sc);
#pragma unroll
                for (int e = 0; e < 16; ++e) { const int j = 32 * t + crow_c(e) + 4 * hh; if (j <= qpos) { const unsigned bin = okey_of(sc[e]) >> 21;
                    __hip_atomic_fetch_add(hist + r * HPITCH + (bin >> 1), 1u << ((bin & 1) * 16), __ATOMIC_RELAXED, __HIP_MEMORY_SCOPE_WORKGROUP); } } } }
        __syncthreads();
        for (int qq = 0; qq < 4; ++qq) { const int q = 4 * wid + qq; const LAS unsigned* hq = hist + q * HPITCH;
            const int wbase = 1008 - 16 * lane; unsigned s = 0;
#pragma unroll
            for (int k = 0; k < 16; ++k) { const unsigned x = hq[wbase + k]; s += (x & 0xffffu) + (x >> 16); }
            unsigned P = s;
#pragma unroll
            for (int o = 1; o < 64; o <<= 1) { const unsigned t = shup(P, lane, o); if (lane >= o) P += t; }
            const unsigned long long bal = __ballot(P >= 256u);
            const int Lsel = bal ? __builtin_ctzll(bal) : 63;
            if (lane == Lsel) { unsigned cum = P - s; unsigned b1 = 0, cin = 0, cab = 0;
                for (int k = 0; k < 32; ++k) { const int bin = 2047 - 32 * lane - k; const unsigned x = hq[bin >> 1]; const unsigned c = (bin & 1) ? (x >> 16) : (x & 0xffffu);
                    if (cum + c >= 256u) { b1 = (unsigned)bin; cin = c; cab = cum; break; } cum += c; }
                qst[q].thr_lo = b1 << 21; qst[q].thr_hi = (b1 << 21) | 0x1fffffu; qst[q].thr_idx = 0xffffu; qst[q].krem = 256u - cab; qst[q].lcount = 0u; qst[q].pad0 = cin; qst[q].pad1 = 0u;
                qst[q].mode = (b1 == 1024u || cin > (unsigned)CAP) ? 2u : 1u; }
        }
        __syncthreads();
        for (int i = tid; i < 32 * 256; i += 512) ((LAS unsigned*)(F.lds + 65536))[i] = 0u;
        __syncthreads();
    }
    {   unsigned mode = 0u, tlo = 1u, thi = 0u;
        const bool allsel = (g < 8);
        if (!allsel) { mode = qst[r].mode; tlo = qst[r].thr_lo; thi = qst[r].thr_hi; }
        const int nk = g >> 1;
        bf16x8 n0 = iqf[0][0], n1 = iqf[0][0], n2 = iqf[0][0], n3 = iqf[0][0]; int kt = wid;
        if (kt <= nk) { b1_load(Zb, 2 * kt, r, hh, n0, n1); if (2 * kt + 1 <= g) b1_load(Zb, 2 * kt + 1, r, hh, n2, n3); }
        for (; kt <= nk; kt += 8) {
            const bf16x8 k0 = n0, k1 = n1, k2 = n2, k3 = n3;
            if (kt + 8 <= nk) { b1_load(Zb, 2 * kt + 16, r, hh, n0, n1); if (2 * kt + 17 <= g) b1_load(Zb, 2 * kt + 17, r, hh, n2, n3); }
            unsigned word = 0u;
#pragma unroll
            for (int kh = 0; kh < 2; ++kh) { const int t = 2 * kt + kh; if (t <= g) { float sc[16]; b1_scores(kh ? k2 : k0, kh ? k3 : k1, iqf, w, sc);
#pragma unroll
                for (int e = 0; e < 16; ++e) { const int j = 32 * t + crow_c(e) + 4 * hh; const unsigned ok = okey_of(sc[e]); const bool valid = (j <= qpos);
                    const bool sel = valid && (allsel || ok > thi); word |= (sel ? 1u : 0u) << (e + 16 * kh);
                    if (!allsel && valid && ok >= tlo && ok <= thi) {
                        if (mode == 1u) { const unsigned pos = __hip_atomic_fetch_add(&qst[r].lcount, 1u, __ATOMIC_RELAXED, __HIP_MEMORY_SCOPE_WORKGROUP);
                            if (pos < (unsigned)CAP) { LAS unsigned* le = (LAS unsigned*)(F.lds + ((size_t)r * CAP + pos) * 8); le[0] = ok; le[1] = (unsigned)j; } }
                        else __hip_atomic_fetch_or((LAS unsigned*)(F.lds + 65536 + r * 1024) + (j >> 5), 1u << (j & 31), __ATOMIC_RELAXED, __HIP_MEMORY_SCOPE_WORKGROUP); } } } }
            MWb[(size_t)kt * 64 + lane] = word; }
    }
    __syncthreads();
    if (g >= 8) {
        for (int qq = 0; qq < 4; ++qq) { const int q = 4 * wid + qq; const unsigned mode = qst[q].mode, krem = qst[q].krem; unsigned* MWq = MWb + q;
            if (mode == 1u) {
                unsigned L = qst[q].lcount; if (L > (unsigned)CAP) L = CAP; const LAS unsigned* lb = (const LAS unsigned*)(F.lds + (size_t)q * CAP * 8);
                unsigned long long comp[4]; bool has[4]; unsigned jj[4];
#pragma unroll
                for (int k = 0; k < 4; ++k) { const unsigned c = lane + 64 * k; has[k] = c < L; const unsigned ok = has[k] ? lb[2 * c] : 0u; jj[k] = has[k] ? lb[2 * c + 1] : 0u;
                    comp[k] = ((unsigned long long)(ok & 0x1fffffu) << 13) | (unsigned long long)(8191u - jj[k]); }
                unsigned long long prefix = 0ull; unsigned need = krem;
                for (int bit = 33; bit >= 0; --bit) { const unsigned long long want = (prefix >> bit) | 1ull; unsigned cnt = 0;
#pragma unroll
                    for (int k = 0; k < 4; ++k) cnt += (unsigned)__builtin_popcountll(__ballot(has[k] && ((comp[k] >> bit) == want)));
                    if (cnt >= need) prefix |= (1ull << bit); else need -= cnt; }
#pragma unroll
                for (int k = 0; k < 4; ++k) if (has[k] && comp[k] >= prefix) b1_setbit(MWq, jj[k]); }
            else { const LAS unsigned* bm = (const LAS unsigned*)(F.lds + 65536 + q * 1024); unsigned x[4]; unsigned s = 0;
#pragma unroll
                for (int k = 0; k < 4; ++k) { x[k] = bm[4 * lane + k]; s += __builtin_popcount(x[k]); }
                unsigned P = s;
#pragma unroll
                for (int o = 1; o < 64; o <<= 1) { const unsigned t = shup(P, lane, o); if (lane >= o) P += t; }
                unsigned before = P - s;
#pragma unroll
                for (int k = 0; k < 4; ++k) { unsigned y = x[k]; while (y != 0u && before < krem) { const unsigned bit = (unsigned)__builtin_ctz(y); y &= y - 1u; b1_setbit(MWq, 32u * (4 * lane + k) + bit); ++before; } before += __builtin_popcount(y); } }
        }
        __syncthreads();
    }
}

struct EngP { const bf16* Z; bf16* Y; const unsigned* MASK; const float* ST; const float* nw; float lam, lam_init; const unsigned* kmax; };
__device__ __forceinline__ int wq_next(Frame& F, unsigned* head) {
    LAS int* slot = (LAS int*)(F.lds + 36880);
    if (F.tid == 0) *slot = (int)__hip_atomic_fetch_add(head, 1u, __ATOMIC_RELAXED, __HIP_MEMORY_SCOPE_AGENT);
    __syncthreads(); const int u = *slot; __syncthreads();
    asm volatile("" : "+v"(F.tid), "+v"(F.lane));
    return u;
}
template <int MODE>
__device__ __forceinline__ void eng_unit(Frame& F, const EngP& P, int b, int h, int qb) {
    constexpr bool SOFT = MODE <= 1;
    constexpr int NMAP = MODE == 0 ? 2 : 1;
    constexpr int NS = (MODE == 0 || MODE == 3) ? 2 : 4;
    constexpr int KCH = MODE == 3 ? 4 : 8;
    constexpr int QC = MODE == 0 ? ZC_AQ : MODE == 1 ? ZC_BQ : MODE == 2 ? ZC_CQ : ZC_DQ;
    constexpr int KC = MODE == 0 ? ZC_AK : MODE == 1 ? ZC_BK : MODE == 2 ? ZC_CK : ZC_DK;
    constexpr int VC = MODE == 0 ? ZC_AV : MODE == 1 ? ZC_BV : MODE == 2 ? ZC_CV : ZC_DV;
    constexpr int HW = MODE == 3 ? 32 : 64;
    const int tid = F.tid, lane = F.lane, r = lane & 31, hh = lane >> 5, w = F.wave;
    const size_t rowbase = (size_t)b * SEQ;
    const int qw0 = qb * 256 + 32 * w;
    const float NEG = -__builtin_inff();
    const int hidx = MODE <= 1 ? (MODE == 0 ? 2 * h + 1 : 2 * h + 2) : 0;
    const float slope2 = SOFT ? __builtin_amdgcn_exp2f(-(float)hidx) * LOG2E : 0.f;
    bf16x8 qf[NMAP][NS];
    {   const bf16* qrow = P.Z + (rowbase + qw0 + r) * ZW + QC + h * HW;
#pragma unroll
        for (int m = 0; m < NMAP; ++m)
#pragma unroll
            for (int s = 0; s < NS; ++s) qf[m][s] = *(const bf16x8*)(qrow + m * 32 + 16 * s + 8 * hh); }
    f32x16 cinit;
#pragma unroll
    for (int e = 0; e < 16; ++e) cinit[e] = SOFT ? slope2 * (float)(crow_c(e) + 4 * hh) : 0.f;
    float m_run[NMAP], l_run[NMAP]; f32x16 O[NMAP][2];
#pragma unroll
    for (int m = 0; m < NMAP; ++m) { m_run[m] = NEG; l_run[m] = 0.f; O[m][0] = splat16(0.f); O[m][1] = splat16(0.f); }
    if (!SOFT) {
        const int sidx = MODE == 2 ? ((b * 4 + h) * 32 + qb) : ((b * 4 + h) * 128 + 4 * qb + (w >> 1));
        const float* sp = P.ST + (size_t)sidx * (64 * HW);
#pragma unroll
        for (int db = 0; db < 2; ++db)
#pragma unroll
            for (int s = 0; s < NS; ++s) { const float* a = sp + (size_t)(32 * db + r) * HW + 16 * s + 8 * hh; const f32x4 a0 = *(const f32x4*)a, a1 = *(const f32x4*)(a + 4);
                O[0][db] = mfma32(pack8(a0[0], a0[1], a0[2], a0[3], a1[0], a1[1], a1[2], a1[3]), qf[0][s], O[0][db]); }
    }
    const int kt_lo = SOFT ? 0 : 4 * qb, kt_hi = 4 * qb + 3;
    const int srow = tid >> 3, sch = tid & 7;
    float qk[NMAP];
    if (SOFT) {
#pragma unroll
        for (int m = 0; m < NMAP; ++m) { float ss = 0.f;
#pragma unroll
            for (int s = 0; s < NS; ++s) { const u32x4 qq = __builtin_bit_cast(u32x4, qf[m][s]); float v[8]; up8(qq, v);
#pragma unroll
                for (int i = 0; i < 8; ++i) ss += v[i] * v[i]; }
            ss += shx(ss, lane, 32);
            qk[m] = 1.02f * sqrtf(ss) * __uint_as_float(P.kmax[b * 16 + (MODE == 0 ? (h * 2 + m) : (8 + h))]) + 0.01f; }
    }
    LAS unsigned* wflag = (LAS unsigned*)(F.lds + 36864);
    if (SOFT && tid < 3) wflag[tid] = 0u;
    const int kt_first = SOFT ? kt_hi : kt_lo;
    u32x4 kreg = (u32x4){0u, 0u, 0u, 0u}, vreg;
    {   const bf16* zr = P.Z + (rowbase + 64 * kt_first + srow) * ZW;
        if (sch < KCH) kreg = *(const u32x4*)(zr + KC + h * HW + sch * 8);
        vreg = *(const u32x4*)(zr + VC + h * 64 + sch * 8);
        LAS unsigned char* Kb = F.lds; LAS unsigned char* Vb = F.lds + 18432;
        if (sch < KCH) *(LAS u32x4*)(Kb + srow * 144 + sch * 16) = kreg;
        *(LAS u32x4*)(Vb + srow * 144 + sch * 16) = vreg; }
    __syncthreads();
    const int nit = kt_hi - kt_lo + 1;
    bool wave_done = false;
    for (int it = 0; it < nit; ++it) {
        const int kt = SOFT ? kt_hi - it : kt_lo + it, ktn = SOFT ? kt - 1 : kt + 1;
        const bool more = it + 1 < nit;
        if (more) { const bf16* zr = P.Z + (rowbase + 64 * ktn + srow) * ZW;
            if (sch < KCH) kreg = *(const u32x4*)(zr + KC + h * HW + sch * 8);
            vreg = *(const u32x4*)(zr + VC + h * 64 + sch * 8); }
        const int j0 = 64 * kt;
        const bool act = ((MODE == 3) ? (kt == 4 * qb + (w >> 1)) : (j0 <= qw0 + 31)) && !wave_done;
        if (act) {
            const LAS unsigned char* Kb = F.lds + (it & 1) * 9216; const LAS unsigned char* Vb = F.lds + 18432 + (it & 1) * 9216;
            unsigned mw = 0xffffffffu;
            if (MODE == 1) mw = P.MASK[((size_t)(b * 256 + qb * 8 + w) * 128 + kt) * 64 + lane];
            const bool hact1 = (j0 + 32 <= qw0 + 31);
#pragma unroll
            for (int m = 0; m < NMAP; ++m) {
                f32x16 st[2];
#pragma unroll
                for (int kh = 0; kh < 2; ++kh) {
                    if (kh == 0 || hact1) {
                        f32x16 a = cinit;
#pragma unroll
                        for (int s = 0; s < NS; ++s) { const bf16x8 kf = *(const LAS bf16x8*)(Kb + (32 * kh + r) * 144 + (m * 32 + 16 * s + 8 * hh) * 2); a = mfma32(kf, qf[m][s], a); }
                        if (j0 + 32 * kh + 31 > qw0) { const int lim = qw0 + r - j0 - 32 * kh - 4 * hh; asm volatile("; causal-mask block (kept a real branch: as selects it ran on every interior tile too)" ::: "memory");
#pragma unroll
                            for (int e = 0; e < 16; ++e) if (crow_c(e) > lim) a[e] = SOFT ? NEG : 0.f; }
                        if (MODE == 1) {
#pragma unroll
                            for (int e = 0; e < 16; ++e) if (!((mw >> (e + 16 * kh)) & 1u)) a[e] = NEG; }
                        st[kh] = a;
                    } else st[kh] = splat16(SOFT ? NEG : 0.f);
                }
                if (SOFT) {
                    const float off0 = slope2 * (float)(j0 - qw0 - r), off1 = off0 + 32.f * slope2;
                    float mx0 = st[0][0], mx1 = st[1][0];
#pragma unroll
                    for (int e = 1; e < 16; ++e) { mx0 = fmaxf(mx0, st[0][e]); mx1 = fmaxf(mx1, st[1][e]); }
                    float mx = fmaxf(mx0 + off0, mx1 + off1); mx = fmaxf(mx, shx(mx, lane, 32));
                    const float mn = fmaxf(m_run[m], mx); const float msafe = (mn == NEG) ? 0.f : mn;
                    const float alpha = __builtin_amdgcn_exp2f(m_run[m] - msafe); m_run[m] = mn;
                    const float d0 = off0 - msafe, d1 = off1 - msafe; float rs = 0.f;
#pragma unroll
                    for (int e = 0; e < 16; ++e) { const float p0 = __builtin_amdgcn_exp2f(st[0][e] + d0), p1 = __builtin_amdgcn_exp2f(st[1][e] + d1); st[0][e] = p0; st[1][e] = p1; rs += p0 + p1; }
                    rs += shx(rs, lane, 32); l_run[m] = l_run[m] * alpha + rs;
#pragma unroll
                    for (int e = 0; e < 16; ++e) { O[m][0][e] *= alpha; O[m][1][e] *= alpha; }
                }
#pragma unroll
                for (int kh = 0; kh < 2; ++kh) {
                    if (kh == 0 || hact1) {
#pragma unroll
                        for (int s = 0; s < 2; ++s) {
                            const bf16x8 pf = pack8(st[kh][8 * s], st[kh][8 * s + 1], st[kh][8 * s + 2], st[kh][8 * s + 3], st[kh][8 * s + 4], st[kh][8 * s + 5], st[kh][8 * s + 6], st[kh][8 * s + 7]);
#pragma unroll
                            for (int db = 0; db < 2; ++db) {
                                const LAS unsigned char* vp = Vb + (32 * kh + 16 * s + 4 * hh + ((lane & 15) >> 2)) * 144 + (32 * db + 16 * ((lane >> 4) & 1) + 4 * (lane & 3)) * 2;
                                const s16x4 lo = vtr(vp), hi = vtr(vp + 8 * 144);
                                const bf16x8 vf = (bf16x8){lo[0], lo[1], lo[2], lo[3], hi[0], hi[1], hi[2], hi[3]};
                                O[m][db] = mfma32(vf, pf, O[m][db]); } } } }
            }
            if (SOFT) {
                const float dist = slope2 * (float)(qw0 + r - (j0 - 1)); bool fin = true;
#pragma unroll
                for (int m = 0; m < NMAP; ++m) fin = fin && (qk[m] - dist - m_run[m] < -32.f);
                wave_done = (__ballot(fin) == ~0ull);
            }
        }
        if (SOFT && !wave_done && lane == 0) wflag[it % 3] = 1u;
        if (more) { LAS unsigned char* Kb = F.lds + ((it + 1) & 1) * 9216; LAS unsigned char* Vb = F.lds + 18432 + ((it + 1) & 1) * 9216;
            if (sch < KCH) *(LAS u32x4*)(Kb + srow * 144 + sch * 16) = kreg;
            *(LAS u32x4*)(Vb + srow * 144 + sch * 16) = vreg; }
        __syncthreads();
        if (SOFT) { const unsigned any = wflag[it % 3]; if (tid == 0) wflag[(it + 2) % 3] = 0u; if (any == 0u) break; }
    }
    const size_t orow = rowbase + qw0 + r;
    const int ycol = MODE * 256 + h * 64;
    f32x16 o[2];
    if (MODE == 0) { const float i0 = 1.f / l_run[0], i1 = P.lam / l_run[NMAP - 1];
#pragma unroll
        for (int db = 0; db < 2; ++db)
#pragma unroll
            for (int e = 0; e < 16; ++e) o[db][e] = O[0][db][e] * i0 - O[NMAP - 1][db][e] * i1; }
    else if (MODE == 1) { const float i0 = 1.f / l_run[0];
#pragma unroll
        for (int db = 0; db < 2; ++db)
#pragma unroll
            for (int e = 0; e < 16; ++e) o[db][e] = O[0][db][e] * i0; }
    else { o[0] = O[0][0]; o[1] = O[0][1]; }
    float mu = 0.f;
    if (MODE == 2) { float s = 0.f;
#pragma unroll
        for (int db = 0; db < 2; ++db)
#pragma unroll
            for (int e = 0; e < 16; ++e) s += o[db][e];
        s += shx(s, lane, 32); mu = s * (1.f / 64.f); }
    float ss = 0.f;
    if (MODE != 1) {
#pragma unroll
        for (int db = 0; db < 2; ++db)
#pragma unroll
            for (int e = 0; e < 16; ++e) { const float d = o[db][e] - mu; ss += d * d; }
        ss += shx(ss, lane, 32); }
    float rn = 1.f;
    if (MODE != 1) rn = 1.f / sqrtf(ss * (1.f / 64.f) + LN_EPS);
    if (MODE == 0) rn *= (1.f - P.lam_init);
#pragma unroll
    for (int db = 0; db < 2; ++db)
#pragma unroll
        for (int g4 = 0; g4 < 4; ++g4) { const int d0 = 32 * db + 8 * g4 + 4 * hh; float v[4];
#pragma unroll
            for (int i = 0; i < 4; ++i) v[i] = o[db][4 * g4 + i];
            if (MODE != 1) { const f32x4 nw = *(const f32x4*)(P.nw + (MODE == 2 ? h * 64 : 0) + d0);
#pragma unroll
                for (int i = 0; i < 4; ++i) v[i] = (v[i] - mu) * rn * nw[i]; }
            if (MODE >= 2) { const u32x2 gw = *(const u32x2*)(P.Z + orow * ZW + (MODE == 2 ? ZC_CG : ZC_DG) + h * 64 + d0);
                const float g0 = bflo(gw.x), g1 = bfhi(gw.x), g2 = bflo(gw.y), g3 = bfhi(gw.y);
                v[0] *= g0 * sigmoidf_(g0); v[1] *= g1 * sigmoidf_(g1); v[2] *= g2 * sigmoidf_(g2); v[3] *= g3 * sigmoidf_(g3); }
            u32x2 ow; ow.x = pk2(v[0], v[1]); ow.y = pk2(v[2], v[3]);
            *(u32x2*)(P.Y + orow * DM + ycol + d0) = ow; }
}
}

constexpr int PH_PER_LAYER = 12, N_PHASES = 1 + DEPTH * PH_PER_LAYER;

typedef __attribute__((address_space(4))) const Args* KArgP;
#ifdef ONLY_SITE
#define SITE(s) ((s) == ONLY_SITE)
#else
#define SITE(s) true
#endif
#if MK_ONE_LAUNCH
#define IN(k) true
#define SEAM(k) do { if ((k) + 1 < N_PHASES) { XcdBarrier b2_ = bar; asm volatile("" : "+s"(b2_.bar), "+s"(b2_.x)); xcd_barrier(b2_, F.tid == 0); } } while (0)
#else
#define IN(k) (lo <= (k) && (k) < hi)
#define SEAM(k) do { } while (0)
#endif
#define SITE_BEGIN KArgP KA = (KArgP)__builtin_amdgcn_kernarg_segment_ptr(); do { asm volatile("" : "+s"(KA)); \
        int ln_; asm volatile("v_mbcnt_lo_u32_b32 %0, -1, 0\n\tv_mbcnt_hi_u32_b32 %0, -1, %0" : "=v"(ln_)); \
        const unsigned simd_ = (unsigned)__builtin_amdgcn_s_getreg(((2 - 1) << 11) | (4 << 6) | 4);   \
        unsigned tk_ = 0u; if (ln_ == 0) tk_ = __hip_atomic_fetch_add((LAS unsigned*)(F.lds + MISC_OFF + 64) + simd_, 1u, __ATOMIC_RELAXED, __HIP_MEMORY_SCOPE_WORKGROUP); \
        F.wave = __builtin_amdgcn_readfirstlane((int)(simd_ + 4u * (tk_ & 1u))); F.lane = ln_; F.tid = F.wave * 64 + F.lane; \
        F.ws = KA->ws; F.dob = (unsigned char*)KA->out; F.G = G0; F.wg = wg0; asm volatile("" : "+s"(F.G), "+s"(F.wg)); } while (0)


__global__ void __launch_bounds__(NWAVES * 64, 2) fwd_kernel(Args args) {
    extern __shared__ __attribute__((aligned(16))) unsigned char lds_raw[];
    Frame F;
    F.lds = (LAS unsigned char*)lds_raw;
    F.tid = threadIdx.x; F.lane = F.tid & 63; F.wave = __builtin_amdgcn_readfirstlane(F.tid >> 6);
    F.G = gridDim.x; F.wg = blockIdx.x;
    F.ws = args.ws; F.dob = (unsigned char*)args.out;
    volatile LAS unsigned* MISC = (volatile LAS unsigned*)(F.lds + MISC_OFF);
    if (F.tid < 32) MISC[F.tid] = 0u;
    __syncthreads();
    unsigned* ctl = (unsigned*)(F.ws + WS_CTL);
    XcdBarrier bar; bar.bar = ctl + CW_BAR; bar.x = 0; bar.st = nullptr;
#if MK_ONE_LAUNCH
    bar = xcd_barrier_post(ctl + CW_BAR, MISC + 8);
#endif
    const int lo = args.ph_lo, hi = args.ph_hi, subm = args.sub;
    const int G0 = F.G, wg0 = F.wg;
    if (SITE(0) && IN(0)) { SITE_BEGIN; p0_prologue(F, KA); SEAM(0); }

    for (int l = 0; l < DEPTH; ++l) {
        const int pb = 1 + l * PH_PER_LAYER;
        if (SITE(1) && IN(pb + 0)) { SITE_BEGIN; const char* XBc = (const char*)(F.ws + WS_XB); (void)XBc; const unsigned char* w123 = F.ws + WS_W123; const unsigned char* w45 = F.ws + WS_W45 + (size_t)l * W45_STRIDE; (void)w123; (void)w45;
            pg8::EpiStore E{(bf16*)(F.ws + WS_Z), ZW};
            {   pg8::SchedTiles S{XBc, (const char*)(w123 + W123_W1), 2048, 2048, 16, 6, G1_BF_TILES, 0, F.G, F.wg};
                { int tl_ = F.tid; asm volatile("" : "+v"(tl_)); pg8::gemm_phase(F.lds, S, E, tl_); } }
            {   pg8::SchedTiles S{(const char*)(F.dob + DO_XB8), (const char*)(F.dob + DO_W8 + (size_t)l * W8_STRIDE + W8_Z), 1024, 1024, 8, 8, G1_F8_TILES, 1, F.G, F.wg};
                { int tl_ = F.tid; asm volatile("" : "+v"(tl_)); pg8::gemm_phase<pg8::EpiStore, pg8::SchedTiles, true>(F.lds, S, E, tl_); } }
            SEAM(pb + 0);
        }
        if (SITE(2) && IN(pb + 1)) { SITE_BEGIN; const char* XBc = (const char*)(F.ws + WS_XB); (void)XBc; const unsigned char* w123 = F.ws + WS_W123; const unsigned char* w45 = F.ws + WS_W45 + (size_t)l * W45_STRIDE; (void)w123; (void)w45;
            {   unsigned* head = (unsigned*)(F.ws + WS_CTL) + CW_WQ + l * 64 + 32;
                for (;;) { const int i = mx::wq_next(F, head); if (i >= 128 + 1024) break;
                    if (i < 128) { if (subm & 2) mx::prepkv_unit(F, i, KA->in[6] + (size_t)l * 16 * 128, KA->in[7] + l * 128, (unsigned*)(F.ws + WS_CTL) + CW_KMAX + l * 64); }
                    else if (subm & 1) { const int u = i - 128; mx::b1_unit(F, u & 3, 255 - (u >> 2)); } } }
            SEAM(pb + 1);
        }
        if (SITE(3) && IN(pb + 2)) { SITE_BEGIN; const char* XBc = (const char*)(F.ws + WS_XB); (void)XBc; const unsigned char* w123 = F.ws + WS_W123; const unsigned char* w45 = F.ws + WS_W45 + (size_t)l * W45_STRIDE; (void)w123; (void)w45;
            if (subm & 1) mx::scan_phase(F);
            float lam_init = 0.8f - 0.6f * __expf(-0.3f * (float)l);
            const float* lp = KA->in[3] + l * 128; float s01 = 0.f, s23 = 0.f;
            for (int i = 0; i < 32; ++i) { s01 += lp[i] * lp[32 + i]; s23 += lp[64 + i] * lp[96 + i]; }
            mx::EngP P{(const bf16*)(F.ws + WS_Z), (bf16*)(F.ws + WS_Y), nullptr, nullptr, KA->in[4] + l * 64, __expf(s01) - __expf(s23) + lam_init, lam_init, (const unsigned*)(F.ws + WS_CTL) + CW_KMAX + l * 64};
            {   unsigned* head = (unsigned*)(F.ws + WS_CTL) + CW_WQ + l * 64;
                for (;;) { const int i = mx::wq_next(F, head); if (i >= 512) break; const int j = i & 127; mx::eng_unit<0>(F, P, j & 3, 3 - (i >> 7), 31 - (j >> 2)); } }
            SEAM(pb + 2);
        }
        if (SITE(4) && IN(pb + 3)) { SITE_BEGIN; const char* XBc = (const char*)(F.ws + WS_XB); (void)XBc; const unsigned char* w123 = F.ws + WS_W123; const unsigned char* w45 = F.ws + WS_W45 + (size_t)l * W45_STRIDE; (void)w123; (void)w45;
            {   unsigned* head = (unsigned*)(F.ws + WS_CTL) + CW_WQ + l * 64 + 16;
                const mx::EngP PB{(const bf16*)(F.ws + WS_Z), (bf16*)(F.ws + WS_Y), (const unsigned*)(F.ws + WS_MASK), nullptr, nullptr, 0.f, 0.f, (const unsigned*)(F.ws + WS_CTL) + CW_KMAX + l * 64};
                const mx::EngP PC{(const bf16*)(F.ws + WS_Z), (bf16*)(F.ws + WS_Y), nullptr, (const float*)(F.ws + WS_KVC), KA->in[5] + l * 256, 0.f, 0.f, nullptr};
                const mx::EngP PD{(const bf16*)(F.ws + WS_Z), (bf16*)(F.ws + WS_Y), nullptr, (const float*)(F.ws + WS_KVD), KA->in[8] + l * 64, 0.f, 0.f, nullptr};
                for (;;) { const int i = mx::wq_next(F, head); if (i >= 1536) break;
                    if (i < 512) { if (subm & 1) { const int j = i & 127; mx::eng_unit<1>(F, PB, j & 3, 3 - (i >> 7), 31 - (j >> 2)); } }
                    else if (!(subm & (i < 1024 ? 2 : 4))) continue;
                    else if (i < 1024) { const int u = i - 512; mx::eng_unit<2>(F, PC, u >> 7, (u >> 5) & 3, u & 31); }
                    else { const int u = i - 1024; mx::eng_unit<3>(F, PD, u >> 7, (u >> 5) & 3, u & 31); } } }
            SEAM(pb + 3);
        }
        if (SITE(5) && IN(pb + 4)) { SITE_BEGIN;
            const unsigned char* w123 = F.ws + WS_W123;
            for (int n = 0; n < 4; ++n) {
                {   pg8::SchedPlain S{(const char*)(F.dob + DO_XB8), (const char*)(F.dob + DO_W8 + (size_t)l * W8_STRIDE + W8_G) + (size_t)n * 1024 * 1024, 1024, 1024, 8, 128, 4, F.G, F.wg};
                    pg8::EpiSlotStore E{F.ws + WS_SCR2 + (size_t)F.wg * 262144, 1};
                    { int tl_ = F.tid; asm volatile("" : "+v"(tl_)); pg8::gemm_phase<pg8::EpiSlotStore, pg8::SchedPlain, true>(F.lds, S, E, tl_); } }
                {   pg8::SchedPlain S{(const char*)(F.ws + WS_Y) + n * 512, (const char*)(w123 + W123_GB + 8 * MiB) + (size_t)n * 1024 * 512, 2048, 512, 4, 128, 4, F.G, F.wg};
                    pg8::EpiBranch E{F.ws + WS_SCR2 + (size_t)F.wg * 262144, (bf16*)(F.ws + WS_MERGED), n == 0};
                    { int tl_ = F.tid; asm volatile("" : "+v"(tl_)); pg8::gemm_phase(F.lds, S, E, tl_); } }
            }
            SEAM(pb + 4);
        }
        if (SITE(6) && IN(pb + 5)) { SITE_BEGIN; const char* XBc = (const char*)(F.ws + WS_XB); (void)XBc; const unsigned char* w123 = F.ws + WS_W123; const unsigned char* w45 = F.ws + WS_W45 + (size_t)l * W45_STRIDE; (void)w123; (void)w45;
            pg8::SchedPlain S{(const char*)(F.ws + WS_MERGED), (const char*)(w123 + W123_WO), 2048, 2048, 16, 128, 4, F.G, F.wg};
            pg8::EpiG3 E{(bf16*)(F.ws + WS_XB)};
            pg8::gemm_phase(F.lds, S, E, F.tid);
            SEAM(pb + 5);
        }
        if (SITE(7) && IN(pb + 6)) { SITE_BEGIN; const char* XBc = (const char*)(F.ws + WS_XB); (void)XBc; const unsigned char* w123 = F.ws + WS_W123; const unsigned char* w45 = F.ws + WS_W45 + (size_t)l * W45_STRIDE; (void)w123; (void)w45; ln_phase(F, KA->in[11] + l * DM, KA->in[12] + l * DM, nullptr, F.dob + DO_XB8);
            if (l + 1 < DEPTH) convert_w123(F, KA->in[2] + (size_t)(l + 1) * DM * NIN, KA->in[9] + (size_t)(l + 1) * 4 * 256 * DM, KA->in[10] + (size_t)(l + 1) * DM * DM);
            SEAM(pb + 6); }
        if (SITE(8) && IN(pb + 7)) { SITE_BEGIN; const char* XBc = (const char*)(F.ws + WS_XB); (void)XBc; const unsigned char* w123 = F.ws + WS_W123; const unsigned char* w45 = F.ws + WS_W45 + (size_t)l * W45_STRIDE; (void)w123; (void)w45;
            pg8::SchedPlain S{(const char*)(F.dob + DO_XB8), (const char*)(F.dob + DO_W8 + (size_t)l * W8_STRIDE + W8_UP), 1024, 1024, 8, 128, 22, F.G, F.wg};
            pg8::EpiStore E{(bf16*)(F.ws + WS_UG), UGW};
            pg8::gemm_phase<pg8::EpiStore, pg8::SchedPlain, true>(F.lds, S, E, F.tid);
            SEAM(pb + 7);
        }
        if (SITE(9) && IN(pb + 8)) { SITE_BEGIN; const char* XBc = (const char*)(F.ws + WS_XB); (void)XBc; const unsigned char* w123 = F.ws + WS_W123; const unsigned char* w45 = F.ws + WS_W45 + (size_t)l * W45_STRIDE; (void)w123; (void)w45; ffn_act_phase(F, KA->in[14] + (size_t)l * 3 * DFF, KA->in[15] + (size_t)l * DFF); SEAM(pb + 8); }
        if (SITE(10) && IN(pb + 9)) { SITE_BEGIN;
            const unsigned char* w45 = F.ws + WS_W45 + (size_t)l * W45_STRIDE;
            {   pg8::SchedPlain S{(const char*)(F.ws + WS_PB + (size_t)l * M * PDIM * 2), (const char*)(w45 + W45_PP), 512, 512, 4, 128, 4, F.G, F.wg};
                pg8::EpiSlotStore E{F.dob + DO_SCR5 + (size_t)F.wg * 262144, 0};
                { int tl_ = F.tid; asm volatile("" : "+v"(tl_)); pg8::gemm_phase(F.lds, S, E, tl_); } }
            {   pg8::SchedPlain S{(const char*)(F.dob + DO_XB8), (const char*)(F.dob + DO_W8 + (size_t)l * W8_STRIDE + W8_PG), 1024, 1024, 8, 128, 4, F.G, F.wg};
                pg8::EpiSlotMul E{F.dob + DO_SCR5 + (size_t)F.wg * 262144};
                { int tl_ = F.tid; asm volatile("" : "+v"(tl_)); pg8::gemm_phase<pg8::EpiSlotMul, pg8::SchedPlain, true>(F.lds, S, E, tl_); } }
            SEAM(pb + 9);
        }
        if (SITE(11) && IN(pb + 10)) { SITE_BEGIN;
            const unsigned char* w45 = F.ws + WS_W45 + (size_t)l * W45_STRIDE;
            pg8::SchedG5b S{(const char*)(F.ws + WS_UG), (const char*)(F.dob + DO_W8 + (size_t)l * W8_STRIDE + W8_DN), F.G, F.wg};
            pg8::EpiG5b E{F.dob + DO_SCR5 + (size_t)F.wg * 262144, (bf16*)(F.ws + WS_XB)};
            pg8::gemm_phase<pg8::EpiG5b, pg8::SchedG5b, true>(F.lds, S, E, F.tid);
            SEAM(pb + 10);
        }
        if (SITE(12) && IN(pb + 11)) { SITE_BEGIN; const char* XBc = (const char*)(F.ws + WS_XB); (void)XBc; const unsigned char* w123 = F.ws + WS_W123; const unsigned char* w45 = F.ws + WS_W45 + (size_t)l * W45_STRIDE; (void)w123; (void)w45; ln_phase(F, KA->in[19] + l * DM, KA->in[20] + l * DM, l == DEPTH - 1 ? KA->out : nullptr, l == DEPTH - 1 ? nullptr : F.dob + DO_XB8); SEAM(pb + 11); }
    }
#undef IN
#undef SEAM
}

extern "C" void kernel_launch(void* const* d_in, const int* in_sizes, int n_in, void* d_out, int out_size, void* d_ws, size_t ws_size, hipStream_t stream) {
    static int grid = 0;
    if (grid == 0) {
        if (n_in != 21 || out_size != M * DM || ws_size < WS_END) { fprintf(stderr, "kernel_launch: unexpected shapes (n_in %d out %d ws %zu)\n", n_in, out_size, ws_size); grid = -1; return; }
        int dev = 0, cus = 0, per_cu = 0;
        if (hipGetDevice(&dev) != hipSuccess || hipDeviceGetAttribute(&cus, hipDeviceAttributeMultiprocessorCount, dev) != hipSuccess) { grid = -1; return; }
        if (hipFuncSetAttribute((const void*)fwd_kernel, hipFuncAttributeMaxDynamicSharedMemorySize, LDS_BYTES) != hipSuccess) { grid = -1; return; }
        if (hipOccupancyMaxActiveBlocksPerMultiprocessor(&per_cu, (const void*)fwd_kernel, NWAVES * 64, LDS_BYTES) != hipSuccess || per_cu < 1)
            fprintf(stderr, "kernel_launch: occupancy query reports %d\n", per_cu);
        (void)hipGetLastError();
        grid = cus;
    }
    if (grid < 0) return;
    (void)hipMemsetAsync((char*)d_ws + WS_CTL, 0, CTL_ZERO_BYTES, stream);
    Args a{};
    for (int i = 0; i < 21; ++i) a.in[i] = (const float*)d_in[i];
    a.out = (float*)d_out; a.ws = (unsigned char*)d_ws;
#if MK_ONE_LAUNCH
    a.ph_lo = 0; a.ph_hi = N_PHASES; a.sub = 7;
    hipLaunchKernelGGL(fwd_kernel, dim3(grid), dim3(NWAVES * 64), LDS_BYTES, stream, a);
#else
    for (int p = 0; p < N_PHASES; ++p) { a.ph_lo = p; a.ph_hi = p + 1; a.sub = 7;
        hipLaunchKernelGGL(fwd_kernel, dim3(grid), dim3(NWAVES * 64), LDS_BYTES, stream, a);
#ifdef PROBE_PHASE
        if (p >= 1 && (p - 1) % PH_PER_LAYER == PROBE_PHASE) { (void)hipMemsetAsync((char*)d_ws + WS_CTL + CW_WQ * 4, 0, 1024, stream); a.sub = PROBE_SUB;
            hipLaunchKernelGGL(fwd_kernel, dim3(grid), dim3(NWAVES * 64), LDS_BYTES, stream, a); }
#endif
    }
#endif
}
```

```cpp
#include <hip/hip_runtime.h>
#include <cstdio>
#include <cstdint>

#ifndef MK_ONE_LAUNCH
#define MK_ONE_LAUNCH 1
#endif

#define GAS __attribute__((address_space(1)))
#define LAS __attribute__((address_space(3)))
typedef unsigned short bf16;
typedef unsigned u32x4 __attribute__((ext_vector_type(4)));
typedef unsigned u32x2 __attribute__((ext_vector_type(2)));
typedef float f32x2 __attribute__((ext_vector_type(2)));
typedef float f32x4 __attribute__((ext_vector_type(4)));
typedef float f32x16 __attribute__((ext_vector_type(16)));
typedef short bf16x8 __attribute__((ext_vector_type(8)));
typedef short s16x4 __attribute__((ext_vector_type(4)));
typedef GAS unsigned gu32;

constexpr int BATCH = 4, SEQ = 8192, DM = 1024, M = BATCH * SEQ, DEPTH = 2;
constexpr int NIN = 7604, ZW = 3584, DFF = 2816, UGW = 5632, PDIM = 256;
constexpr float LN_EPS = 1e-5f;
constexpr float ALPHA = 1.41421356237f;
constexpr float LOG2E = 1.4426950408889634f;
constexpr int ZC_AQ = 0, ZC_AK = 256, ZC_AV = 512, ZC_BQ = 768, ZC_BK = 1024, ZC_BV = 1280, ZC_CQ = 1536, ZC_CK = 1792, ZC_CV = 2048, ZC_CG = 2304,
              ZC_DQ = 2560, ZC_DK = 2688, ZC_DV = 2816, ZC_DG = 3072, ZC_IQ = 3328, ZC_IK = 3456, ZC_IW = 3488, ZC_DA = 3504;
constexpr int SRC_MG = 3508;

constexpr size_t MiB = 1u << 20;
constexpr size_t WS_CTL = 0, CTL_ZERO_BYTES = 1 * MiB;
constexpr size_t WS_XB = 1 * MiB;
constexpr size_t WS_BIG = 65 * MiB;
constexpr size_t WS_Z = WS_BIG, WS_Y = WS_BIG + 224 * MiB, WS_MERGED = WS_BIG + 288 * MiB, WS_UG = WS_BIG;
constexpr size_t WS_MASK = WS_MERGED, WS_KVC = WS_MERGED + 32 * MiB, WS_KVD = WS_MERGED + 40 * MiB, WS_DE = WS_MERGED + 56 * MiB;
constexpr size_t WS_SCR2 = WS_Z;
constexpr size_t WS_W45 = 417 * MiB, W45_STRIDE = 19 * MiB;
constexpr size_t W45_UP = 0, W45_PG = 11 * MiB, W45_PP = 13 * MiB, W45_DN = 13 * MiB + 512 * 1024;
constexpr size_t WS_PB = 455 * MiB;
constexpr size_t WS_W123 = 487 * MiB;
constexpr size_t WS_END = 506 * MiB;
constexpr size_t W123_W1 = 0, W123_GB = 7 * MiB, W123_WO = 17 * MiB;
constexpr size_t DO_SCR5 = 0;
constexpr size_t DO_XB8 = 64 * MiB;
constexpr size_t DO_W8 = 96 * MiB, W8_STRIDE = 15 * MiB + 256 * 1024, W8_G = 0, W8_UP = 4 * MiB, W8_PG = 9 * MiB + 512 * 1024, W8_DN = 10 * MiB + 512 * 1024, W8_Z = 13 * MiB + 256 * 1024;
constexpr unsigned long long G1_F8_TILES = 0xCB987652ull, G1_BF_TILES = 0xDA4310ull;

constexpr int CW_BAR = 4096, CW_WQ = 8448  , CW_KMAX = 8192;

constexpr int RING_BYTES = 131072;
constexpr int MISC_OFF = 131072 + 320;
constexpr int QST_OFF = 132096;
constexpr int LDS_BYTES = 147456;

constexpr int NWAVES = 8;

#define RLX_AGENT __ATOMIC_RELAXED, __HIP_MEMORY_SCOPE_AGENT
__device__ __forceinline__ unsigned f2bf(float f) { unsigned u = __builtin_bit_cast(unsigned, f); return (u + 0x7fffu + ((u >> 16) & 1u)) >> 16; }
typedef __bf16 bf16x2_t __attribute__((ext_vector_type(2)));
__device__ __forceinline__ unsigned pk2(float lo, float hi) { const f32x2 v = {lo, hi}; const bf16x2_t b = __builtin_convertvector(v, bf16x2_t); return __builtin_bit_cast(unsigned, b); }
__device__ __forceinline__ unsigned pk4f8(float a, float b, float c, float d) { int p = __builtin_amdgcn_cvt_pk_fp8_f32(a, b, 0, false); p = __builtin_amdgcn_cvt_pk_fp8_f32(c, d, p, true); return (unsigned)p; }
__device__ __forceinline__ float bflo(unsigned w) { return __uint_as_float(w << 16); }
__device__ __forceinline__ float bfhi(unsigned w) { return __uint_as_float(w & 0xffff0000u); }
__device__ __forceinline__ float bf1(bf16 b) { return __uint_as_float((unsigned)b << 16); }
__device__ __forceinline__ float sigmoidf_(float x) { return __builtin_amdgcn_rcpf(1.0f + __builtin_amdgcn_exp2f(-LOG2E * x)); }
__device__ __forceinline__ float shx(float v, int lane, int m) { return __int_as_float(__builtin_amdgcn_ds_bpermute((lane ^ m) << 2, __float_as_int(v))); }
__device__ __forceinline__ unsigned shup(unsigned v, int lane, int o) { return (unsigned)__builtin_amdgcn_ds_bpermute((lane - o) << 2, (int)v); }
__device__ __forceinline__ float wave_sum(float v, int lane) {
#pragma unroll
    for (int o = 1; o < 64; o <<= 1) v += shx(v, lane, o);
    return v;
}

#define XB_TMO      128
#define XB_XCNT(j)  (256  + 64 * (j))
#define XB_XSUB(j)  (1280 + 64 * (j))
#define XB_XGEN(j)  (2304 + 64 * (j))
#define XB_TOP      3328
#define XB_TOPGEN   3392
#define XCD_BAR_WORDS 3456
#define XB_SPIN_CAP (1u << 22)

__device__ __forceinline__ unsigned xb_ld(unsigned* p)              { return __hip_atomic_load(p, __ATOMIC_RELAXED, __HIP_MEMORY_SCOPE_AGENT); }
__device__ __forceinline__ unsigned xb_add(unsigned* p, unsigned v) { return __hip_atomic_fetch_add(p, v, __ATOMIC_RELAXED, __HIP_MEMORY_SCOPE_AGENT); }
__device__ __forceinline__ unsigned xb_xcc_id() { return (unsigned)__builtin_amdgcn_s_getreg((3 << 11) | 20) & 0xFu; }
#define XB_SPIN(cond, bar) do { unsigned _sp = 0; while (cond) { __builtin_amdgcn_s_sleep(1); \
    if ((++_sp & 255u) == 0u) { if (xb_ld(&(bar)[XB_TMO])) break; if (_sp > XB_SPIN_CAP) { atomicAdd(&(bar)[XB_TMO], 1u); break; } } } } while (0)

struct XcdBarrier { unsigned* bar; unsigned x; volatile LAS unsigned* st; };

__device__ __forceinline__ XcdBarrier xcd_barrier_post(unsigned* bar, volatile LAS unsigned* st) {
    XcdBarrier b; b.bar = bar; b.x = xb_xcc_id(); b.st = st;
    if (threadIdx.x == 0) (void)xb_add(&bar[XB_XCNT(b.x)], 1u);
    return b;
}
__device__ __forceinline__ void xcd_barrier_complete(unsigned* bar, unsigned x, unsigned& nloc, unsigned& nx) {
    const unsigned G = gridDim.x * gridDim.y * gridDim.z;
    unsigned sum, cnt, mine, sp = 0u;
    for (;;) {
        sum = 0u; cnt = 0u; mine = 0u;
#pragma unroll
        for (unsigned j = 0; j < 16; ++j) { const unsigned c = xb_ld(&bar[XB_XCNT(j)]); sum += c; cnt += (c > 0u) ? 1u : 0u; mine = (j == x) ? c : mine; }
        if (sum == G) break;
        __builtin_amdgcn_s_sleep(1);
        if ((++sp & 255u) == 0u) { if (xb_ld(&bar[XB_TMO])) break; if (sp > XB_SPIN_CAP) { atomicAdd(&bar[XB_TMO], 1u); break; } }
    }
    nloc = mine > 0u ? mine : 1u; nx = cnt > 0u ? cnt : 1u;
}
__device__ __forceinline__ void xcd_barrier(const XcdBarrier& b, const bool leader_thread) {
    asm volatile("s_waitcnt vmcnt(0)" ::: "memory");
    __syncthreads();
    if (leader_thread) {
        unsigned* bar = b.bar;
        __builtin_amdgcn_s_waitcnt(0);
        unsigned nloc = b.st[0], nx = b.st[1];
        if (nloc == 0u) { xcd_barrier_complete(bar, b.x, nloc, nx); b.st[0] = nloc; b.st[1] = nx; }
        const unsigned old = xb_add(&bar[XB_XSUB(b.x)], 1u);
        const unsigned gen = old / nloc;
        if (old + 1u == (gen + 1u) * nloc) {
            __builtin_amdgcn_fence(__ATOMIC_RELEASE, "agent");
            asm volatile("s_waitcnt vmcnt(0)" ::: "memory");
            const unsigned og = xb_add(&bar[XB_TOP], 1u);
            const unsigned tg = og / nx;
            if (og + 1u == (tg + 1u) * nx) xb_add(&bar[XB_TOPGEN], 1u);
            else XB_SPIN(xb_ld(&bar[XB_TOPGEN]) == tg, bar);
            __builtin_amdgcn_fence(__ATOMIC_ACQUIRE, "agent");
            xb_add(&bar[XB_XGEN(b.x)], 1u);
            asm volatile("s_waitcnt vmcnt(0)" ::: "memory");
        } else {
            XB_SPIN(xb_ld(&bar[XB_XGEN(b.x)]) == gen, bar);
            __builtin_amdgcn_fence(__ATOMIC_ACQUIRE, "agent");
            asm volatile("s_waitcnt vmcnt(0)" ::: "memory");
        }
    }
    __syncthreads();
}

namespace pg8 {
constexpr int BM = 256, BK = 64, HALF = 128, HTB = HALF * BK * 2, STAGE_BYTES = 8 * HTB, NXCD = 8, WGM = 8;
__device__ __forceinline__ int lds_byte(int r, int c) { const int st = (r >> 4) * 2 + (c >> 5), rr = r & 15, cc = c & 31, ob = rr * 64 + cc * 2; return st * 1024 + (ob ^ (((ob >> 9) & 1) << 5)); }
__device__ __forceinline__ void stage_rc(int b, int& R, int& C) { const int st = b / 1024, sb = b % 1024, swz = sb ^ (((sb >> 9) & 1) << 5); R = (st >> 1) * 16 + swz / 64; C = (st & 1) * 32 + (swz % 64) / 2; }
__device__ __forceinline__ int perm32(int rho) { const int n = rho >> 4, i = rho & 15; return 8 * (i >> 2) + 4 * n + (i & 3); }

struct UnitD { const char* A; const char* B; int lda2, ldb2, nt, pm, pn, kind; };

__device__ __forceinline__ void tile_map(int L, int nM, int nN, int& pm, int& pn) {
    const int nwg = nM * nN; int wgid = L;
    { const int q = nwg / NXCD, r = nwg % NXCD, xcd = wgid % NXCD, off = wgid / NXCD; wgid = (xcd < r ? xcd * (q + 1) : r * (q + 1) + (xcd - r) * q) + off; }
    const int nig = WGM * nN, gid = wgid / nig, fm = gid * WGM, gsz = (nM - fm) < WGM ? (nM - fm) : WGM;
    pm = fm + ((wgid % nig) % gsz); pn = (wgid % nig) / gsz;
}

typedef int i32x8 __attribute__((ext_vector_type(8)));
template <class Epi, class Sched, bool FP8 = false>
__device__ __forceinline__ void gemm_phase(LAS unsigned char* lds, const Sched& S, const Epi& E, const int tid) {
    const int wid = __builtin_amdgcn_readfirstlane(tid >> 6), lane = tid & 63, wr = wid >> 2, wc = wid & 3, fr = lane & 15, fq = lane >> 4;
    int sR, sRb, sC2;
    { int R, C; stage_rc(tid * 16, R, C); sR = R; sRb = (R & ~31) + perm32(R & 31); sC2 = C * 2; }
    const size_t kstep = (size_t)(BK * 2);
    const unsigned ldsw = (unsigned)wid * 1024u;
    const int aoff = lds_byte(wr * 64 + fr, FP8 ? fq * 16 : fq * 8), boff = lds_byte(wc * 32 + fr, FP8 ? fq * 16 : fq * 8);
#define PG8_SA(b, h) (((b) * 2 + (h)) * HTB)
#define PG8_SB(b, h) ((4 + (b) * 2 + (h)) * HTB)
#define PG8_STAGE(bufoff, gbase, rows, pitch) do { const unsigned _o = (unsigned)((rows) * (pitch) + sC2); _Pragma("unroll") for (int _i = 0; _i < 2; ++_i) \
        __builtin_amdgcn_global_load_lds((const unsigned*)((const char*)(gbase) + (size_t)(_i * 64) * (pitch) + _o), (LAS unsigned*)(lds + (bufoff) + ldsw + _i * 8192), 16, 0, 0); } while (0)
#define PG8_LDA(dst, b, h) do { if constexpr (FP8) { _Pragma("unroll") for (int m = 0; m < 4; ++m) { const u32x4 lo_ = *(const LAS u32x4*)(lds + PG8_SA(b, h) + aoff + m * 2048), hi_ = *(const LAS u32x4*)(lds + PG8_SA(b, h) + aoff + m * 2048 + 16); \
            dst##8[m] = (i32x8){(int)lo_.x, (int)lo_.y, (int)lo_.z, (int)lo_.w, (int)hi_.x, (int)hi_.y, (int)hi_.z, (int)hi_.w}; } } \
        else { _Pragma("unroll") for (int m = 0; m < 4; ++m) _Pragma("unroll") for (int k = 0; k < 2; ++k) dst[m][k] = *(const LAS bf16x8*)(lds + PG8_SA(b, h) + aoff + m * 2048 + k * 1024); } } while (0)
#define PG8_LDB(dst, b, h) do { if constexpr (FP8) { _Pragma("unroll") for (int n = 0; n < 2; ++n) { const u32x4 lo_ = *(const LAS u32x4*)(lds + PG8_SB(b, h) + boff + n * 2048), hi_ = *(const LAS u32x4*)(lds + PG8_SB(b, h) + boff + n * 2048 + 16); \
            dst##8[n] = (i32x8){(int)lo_.x, (int)lo_.y, (int)lo_.z, (int)lo_.w, (int)hi_.x, (int)hi_.y, (int)hi_.z, (int)hi_.w}; } } \
        else { _Pragma("unroll") for (int n = 0; n < 2; ++n) _Pragma("unroll") for (int k = 0; k < 2; ++k) dst[n][k] = *(const LAS bf16x8*)(lds + PG8_SB(b, h) + boff + n * 2048 + k * 1024); } } while (0)
#define PG8_MMA(ai, bj, At, Bt) do { __builtin_amdgcn_s_setprio(1); if constexpr (FP8) { _Pragma("unroll") for (int m = 0; m < 4; ++m) _Pragma("unroll") for (int n = 0; n < 2; ++n) \
            asm volatile("v_mfma_scale_f32_16x16x128_f8f6f4 %0, %1, %2, %0, %3, %3 op_sel_hi:[0,0,0]" : "+v"(acc[ai][bj][m][n]) : "v"(Bt##8[n]), "v"(At##8[m]), "v"(scl8)); } \
        else { _Pragma("unroll") for (int m = 0; m < 4; ++m) _Pragma("unroll") for (int n = 0; n < 2; ++n) _Pragma("unroll") for (int k = 0; k < 2; ++k) \
            acc[ai][bj][m][n] = __builtin_amdgcn_mfma_f32_16x16x32_bf16(Bt[n][k], At[m][k], acc[ai][bj][m][n], 0, 0, 0); } __builtin_amdgcn_s_setprio(0); } while (0)
#define PG8_WAIT_V(n) asm volatile("s_waitcnt vmcnt(" #n ")" ::: "memory")
#define PG8_WAIT_L(n) asm volatile("s_waitcnt lgkmcnt(" #n ")" ::: "memory")
#define PG8_BAR __builtin_amdgcn_s_barrier()
#define PG8_SCHED __builtin_amdgcn_sched_barrier(0)
    UnitD cur, nxt; int ui = 0;
    if (!S.next(0, cur)) return;
    f32x4 acc[2][2][4][2];
#pragma unroll
    for (int a = 0; a < 2; ++a)
#pragma unroll
        for (int b = 0; b < 2; ++b)
#pragma unroll
            for (int m = 0; m < 4; ++m)
#pragma unroll
                for (int n = 0; n < 2; ++n) acc[a][b][m][n] = (f32x4){0.f, 0.f, 0.f, 0.f};
    bf16x8 At[4][2], B0[2][2], B1[2][2]; i32x8 At8[4], B08[2], B18[2];
    int scl8 = 0x7c7c7c7c; asm volatile("" : "+v"(scl8));
    const char* cA = cur.A; const char* cB = cur.B;
    int pA = cur.lda2, pB = cur.ldb2;
    PG8_STAGE(PG8_SB(0, 0), cB, sRb, pB); PG8_STAGE(PG8_SB(0, 1), cB + (size_t)HALF * pB, sRb, pB); PG8_STAGE(PG8_SA(0, 0), cA, sR, pA); PG8_STAGE(PG8_SA(0, 1), cA + (size_t)HALF * pA, sR, pA);
    if (wr == 1) PG8_BAR;
    PG8_WAIT_V(2); PG8_BAR;
    PG8_STAGE(PG8_SB(1, 0), cB + kstep, sRb, pB); PG8_STAGE(PG8_SA(1, 0), cA + kstep, sR, pA); PG8_STAGE(PG8_SB(1, 1), cB + (size_t)HALF * pB + kstep, sRb, pB);
    PG8_WAIT_V(6); PG8_BAR;
    for (;;) {
        const bool has_next = S.next(ui + 1, nxt);
        if (!has_next) nxt = cur;
        const char* nA = nxt.A; const char* nB = nxt.B;
        const int nt = cur.nt;
        for (int t = 0; t < nt; t += 2) {
            const bool last = (t == nt - 2);
            const char* a1 = cA + (size_t)(t + 1) * kstep + (size_t)HALF * pA;
            const char* a2 = last ? nA : cA + (size_t)(t + 2) * kstep; const char* b2 = last ? nB : cB + (size_t)(t + 2) * kstep;
            const int p2A = last ? nxt.lda2 : pA, p2B = last ? nxt.ldb2 : pB;
            const char* a2h = a2 + (size_t)HALF * p2A; const char* b2h = b2 + (size_t)HALF * p2B;
            PG8_LDB(B0, 0, 0); PG8_LDB(B1, 0, 1); PG8_SCHED; PG8_LDA(At, 0, 0); PG8_STAGE(PG8_SA(1, 1), a1, sR, pA);
            PG8_WAIT_V(8); PG8_WAIT_L(0); PG8_BAR; PG8_MMA(0, 0, At, B0); PG8_MMA(0, 1, At, B1); PG8_BAR; PG8_SCHED;
            PG8_LDA(At, 0, 1); PG8_STAGE(PG8_SB(0, 0), b2, sRb, p2B); PG8_STAGE(PG8_SB(0, 1), b2h, sRb, p2B); PG8_STAGE(PG8_SA(0, 0), a2, sR, p2A);
            PG8_WAIT_V(8); PG8_WAIT_L(0); PG8_BAR; PG8_MMA(1, 0, At, B0); PG8_MMA(1, 1, At, B1); PG8_BAR; PG8_SCHED;
            PG8_LDB(B0, 1, 0); PG8_LDB(B1, 1, 1); PG8_SCHED; PG8_LDA(At, 1, 0); PG8_STAGE(PG8_SA(0, 1), a2h, sR, p2A);
            PG8_WAIT_V(8); PG8_WAIT_L(0); PG8_BAR; PG8_MMA(0, 0, At, B0); PG8_MMA(0, 1, At, B1); PG8_BAR; PG8_SCHED;
            PG8_LDA(At, 1, 1); PG8_STAGE(PG8_SB(1, 0), b2 + kstep, sRb, p2B); PG8_STAGE(PG8_SB(1, 1), b2h + kstep, sRb, p2B); PG8_STAGE(PG8_SA(1, 0), a2 + kstep, sR, p2A);
            PG8_WAIT_V(8); PG8_WAIT_L(0); PG8_BAR; PG8_MMA(1, 0, At, B0); PG8_MMA(1, 1, At, B1); PG8_BAR; PG8_SCHED;
        }
        if constexpr (FP8) asm volatile("s_nop 15\n\ts_nop 15" ::: "memory");
        if (wr == 0) PG8_BAR;
        { int l2; asm volatile("v_mbcnt_lo_u32_b32 %0, -1, 0\n\tv_mbcnt_hi_u32_b32 %0, -1, %0" : "=v"(l2)); E(acc, cur, wr, wc, l2 & 15, l2 >> 4, wid * 64 + l2); asm volatile("s_waitcnt vmcnt(0)" ::: "memory"); }
        if (!has_next) break;
#pragma unroll
        for (int a = 0; a < 2; ++a)
#pragma unroll
            for (int b = 0; b < 2; ++b)
#pragma unroll
                for (int m = 0; m < 4; ++m)
#pragma unroll
                    for (int n = 0; n < 2; ++n) acc[a][b][m][n] = (f32x4){0.f, 0.f, 0.f, 0.f};
        cur = nxt; cA = nA; cB = nB; pA = cur.lda2; pB = cur.ldb2;
        ++ui;
        if (wr == 1) PG8_BAR;
    }
    PG8_WAIT_V(0);
    PG8_BAR;
#undef PG8_SA
#undef PG8_SB
#undef PG8_STAGE
#undef PG8_LDA
#undef PG8_LDB
#undef PG8_MMA
#undef PG8_WAIT_V
#undef PG8_WAIT_L
#undef PG8_BAR
#undef PG8_SCHED
}

struct SchedPlain {
    const char* A; const char* B; int lda2, ldb2, nt, nM, nN, G, c;
    __device__ __forceinline__ bool next(int i, UnitD& u) const {
        const long L = (long)i * G + c; if (L >= (long)nM * nN) return false;
        int pm, pn; tile_map((int)L, nM, nN, pm, pn);
        u.A = A + (size_t)pm * 256 * lda2; u.B = B + (size_t)pn * 256 * ldb2; u.lda2 = lda2; u.ldb2 = ldb2; u.nt = nt; u.pm = pm; u.pn = pn; u.kind = i; return true;
    }
};
struct SchedTiles {
    const char* A; const char* B; int lda2, ldb2, nt, ntile; unsigned long long list; int compact, G, c;
    __device__ __forceinline__ bool next(int i, UnitD& u) const {
        const long L = (long)i * G + c; if (L >= (long)128 * ntile) return false;
        int pm, pi; tile_map((int)L, 128, ntile, pm, pi); const int col = (int)((list >> (4 * pi)) & 15ull);
        u.A = A + (size_t)pm * 256 * lda2; u.B = B + (size_t)(compact ? pi : col) * 256 * ldb2; u.lda2 = lda2; u.ldb2 = ldb2; u.nt = nt; u.pm = pm; u.pn = col; u.kind = i; return true;
    }
};
struct SchedG5b {
    const char* A; const char* B; int G, c;
    __device__ __forceinline__ bool next(int i, UnitD& u) const {
        const long L = (long)i * G + c; if (L >= 128 * 4) return false;
        int pm, pn; tile_map((int)L, 128, 4, pm, pn);
        u.A = A + (size_t)pm * 256 * (UGW * 2); u.lda2 = UGW * 2; u.B = B + (size_t)pn * 256 * DFF; u.ldb2 = DFF; u.nt = 22; u.pm = pm; u.pn = pn; u.kind = i; return true;
    }
};

#define EPI_LOOP for (int ai = 0; ai < 2; ++ai) _Pragma("unroll") for (int m = 0; m < 4; ++m) _Pragma("unroll") for (int bj = 0; bj < 2; ++bj)
struct EpiStore {
    bf16* O; int ldc;
    __device__ __forceinline__ void operator()(const f32x4 (&acc)[2][2][4][2], const UnitD& u, int wr, int wc, int fr, int fq, int tid) const {
        const int row0 = u.pm * BM + wr * 64 + fr, col0 = u.pn * BM + wc * 32 + 8 * fq;
#pragma unroll
        EPI_LOOP { const f32x4 v0 = acc[ai][bj][m][0], v1 = acc[ai][bj][m][1];
            u32x4 w; w.x = pk2(v0[0], v0[1]); w.y = pk2(v0[2], v0[3]); w.z = pk2(v1[0], v1[1]); w.w = pk2(v1[2], v1[3]);
            *(u32x4*)(O + (size_t)(row0 + ai * HALF + m * 16) * ldc + col0 + bj * HALF) = w; }
    }
};
struct EpiSlotStore {
    unsigned char* sc_; int act;
    __device__ __forceinline__ void operator()(const f32x4 (&acc)[2][2][4][2], const UnitD& u, int wr, int wc, int fr, int fq, int tid) const {
        unsigned loff = (unsigned)tid * 16u; asm volatile("" : "+v"(loff));
        unsigned char* sc = sc_ + (size_t)u.kind * 131072 + loff;
#pragma unroll
        EPI_LOOP { const int q = (ai * 2 + bj) * 4 + m; f32x4 v0 = acc[ai][bj][m][0], v1 = acc[ai][bj][m][1];
            if (act) { v0 = (f32x4){sigmoidf_(v0[0]), sigmoidf_(v0[1]), sigmoidf_(v0[2]), sigmoidf_(v0[3])}; v1 = (f32x4){sigmoidf_(v1[0]), sigmoidf_(v1[1]), sigmoidf_(v1[2]), sigmoidf_(v1[3])}; }
            u32x4 w; w.x = pk2(v0[0], v0[1]); w.y = pk2(v0[2], v0[3]); w.z = pk2(v1[0], v1[1]); w.w = pk2(v1[2], v1[3]);
            *(u32x4*)(sc + (size_t)q * 8192) = w; }
    }
};
struct EpiSlotMul {
    unsigned char* sc_;
    __device__ __forceinline__ void operator()(const f32x4 (&acc)[2][2][4][2], const UnitD& u, int wr, int wc, int fr, int fq, int tid) const {
        unsigned loff = (unsigned)tid * 16u; asm volatile("" : "+v"(loff));
        unsigned char* sc = sc_ + (size_t)u.kind * 131072 + loff;
#pragma unroll
        EPI_LOOP { const int q = (ai * 2 + bj) * 4 + m; const f32x4 v0 = acc[ai][bj][m][0], v1 = acc[ai][bj][m][1];
            u32x4* sp = (u32x4*)(sc + (size_t)q * 8192); const u32x4 p = *sp;
            u32x4 w; w.x = pk2(sigmoidf_(v0[0]) * bflo(p.x), sigmoidf_(v0[1]) * bfhi(p.x)); w.y = pk2(sigmoidf_(v0[2]) * bflo(p.y), sigmoidf_(v0[3]) * bfhi(p.y));
            w.z = pk2(sigmoidf_(v1[0]) * bflo(p.z), sigmoidf_(v1[1]) * bfhi(p.z)); w.w = pk2(sigmoidf_(v1[2]) * bflo(p.w), sigmoidf_(v1[3]) * bfhi(p.w));
            *sp = w;
            if (m & 1) asm volatile("" ::: "memory"); }
    }
};
struct EpiBranch {
    const unsigned char* sc_; bf16* MG; int first;
    __device__ __forceinline__ void operator()(const f32x4 (&acc)[2][2][4][2], const UnitD& u, int wr, int wc, int fr, int fq, int tid) const {
        const int row0 = u.pm * BM + wr * 64 + fr, col0 = u.pn * BM + wc * 32 + 8 * fq;
        unsigned loff = (unsigned)tid * 16u; asm volatile("" : "+v"(loff));
        const unsigned char* sc = sc_ + (size_t)u.kind * 131072 + loff;
#pragma unroll
        EPI_LOOP { const int q = (ai * 2 + bj) * 4 + m; const f32x4 v0 = acc[ai][bj][m][0], v1 = acc[ai][bj][m][1];
            const u32x4 g = *(const u32x4*)(sc + (size_t)q * 8192);
            u32x4* p = (u32x4*)(MG + (size_t)(row0 + ai * HALF + m * 16) * DM + col0 + bj * HALF);
            f32x4 t0 = (f32x4){bflo(g.x) * v0[0], bfhi(g.x) * v0[1], bflo(g.y) * v0[2], bfhi(g.y) * v0[3]};
            f32x4 t1 = (f32x4){bflo(g.z) * v1[0], bfhi(g.z) * v1[1], bflo(g.w) * v1[2], bfhi(g.w) * v1[3]};
            if (!first) { const u32x4 x = *p; t0 += (f32x4){bflo(x.x), bfhi(x.x), bflo(x.y), bfhi(x.y)}; t1 += (f32x4){bflo(x.z), bfhi(x.z), bflo(x.w), bfhi(x.w)}; }
            u32x4 w; w.x = pk2(t0[0], t0[1]); w.y = pk2(t0[2], t0[3]); w.z = pk2(t1[0], t1[1]); w.w = pk2(t1[2], t1[3]);
            *p = w;
            if (m & 1) asm volatile("" ::: "memory"); }
    }
};
struct EpiG3 {
    bf16* XB;
    __device__ __forceinline__ void operator()(const f32x4 (&acc)[2][2][4][2], const UnitD& u, int wr, int wc, int fr, int fq, int tid) const {
        const int row0 = u.pm * BM + wr * 64 + fr, col0 = u.pn * BM + wc * 32 + 8 * fq;
#pragma unroll
        EPI_LOOP { const f32x4 v0 = acc[ai][bj][m][0], v1 = acc[ai][bj][m][1];
            u32x4* p = (u32x4*)(XB + (size_t)(row0 + ai * HALF + m * 16) * DM + col0 + bj * HALF); const u32x4 x = *p;
            u32x4 w; w.x = pk2(ALPHA * bflo(x.x) + v0[0], ALPHA * bfhi(x.x) + v0[1]); w.y = pk2(ALPHA * bflo(x.y) + v0[2], ALPHA * bfhi(x.y) + v0[3]);
            w.z = pk2(ALPHA * bflo(x.z) + v1[0], ALPHA * bfhi(x.z) + v1[1]); w.w = pk2(ALPHA * bflo(x.w) + v1[2], ALPHA * bfhi(x.w) + v1[3]);
            *p = w; }
    }
};
struct EpiG5b {
    const unsigned char* esc_; bf16* XB;
    __device__ __forceinline__ void operator()(const f32x4 (&acc)[2][2][4][2], const UnitD& u, int wr, int wc, int fr, int fq, int tid) const {
        const int row0 = u.pm * BM + wr * 64 + fr, col0 = u.pn * BM + wc * 32 + 8 * fq;
        unsigned loff = (unsigned)tid * 16u; asm volatile("" : "+v"(loff));
        const unsigned char* esc = esc_ + (size_t)u.kind * 131072 + loff;
#pragma unroll
        EPI_LOOP { const int q = (ai * 2 + bj) * 4 + m; const f32x4 v0 = acc[ai][bj][m][0], v1 = acc[ai][bj][m][1];
            const u32x4 e = *(const u32x4*)(esc + (size_t)q * 8192);
            u32x4* p = (u32x4*)(XB + (size_t)(row0 + ai * HALF + m * 16) * DM + col0 + bj * HALF); const u32x4 x = *p;
            u32x4 w; w.x = pk2(ALPHA * bflo(x.x) + v0[0] + bflo(e.x), ALPHA * bfhi(x.x) + v0[1] + bfhi(e.x)); w.y = pk2(ALPHA * bflo(x.y) + v0[2] + bflo(e.y), ALPHA * bfhi(x.y) + v0[3] + bfhi(e.y));
            w.z = pk2(ALPHA * bflo(x.z) + v1[0] + bflo(e.z), ALPHA * bfhi(x.z) + v1[1] + bfhi(e.z)); w.w = pk2(ALPHA * bflo(x.w) + v1[2] + bflo(e.w), ALPHA * bfhi(x.w) + v1[3] + bfhi(e.w));
            *p = w;
            if (m & 1) asm volatile("" ::: "memory"); }
    }
};
}

struct Frame {
    LAS unsigned char* lds;
    int tid, lane, wave, G, wg;
    unsigned char* ws; unsigned char* dob;
};
struct Args { const float* in[21]; float* out; unsigned char* ws; int ph_lo, ph_hi, sub, pad; };

__device__ __forceinline__ int z_src(int n, float& sc) {
    sc = 1.f;
    if (n < 768) { if (n < 256) sc = 0.17677669529663687f * LOG2E; return n; }
    if (n < 1536) { if (n < 1024) sc = 0.125f * LOG2E; return n; }
    if (n < 2560) { if (n >= 1792 && n < 2048) sc = 0.125f; return 1700 + (n - 1536); }
    if (n < 2816) { if (n < 2688) sc = 0.17677669529663687f; return 2724 + (n - 2560); }
    if (n < 3072) return 2980 + (n - 2816);
    if (n < 3328) return 3252 + (n - 3072);
    if (n < 3456) return 1536 + (n - 3328);
    if (n < 3488) return 1664 + (n - 3456);
    if (n < 3492) return 1696 + (n - 3488);
    if (n >= 3504 && n < 3520) return 3236 + (n - 3504);
    return -1;
}
template <int MODE>
__device__ __forceinline__ void transpose_item(const float* W, int Nsrc, int soff, bf16* WT, int dpitch, int dcol0, int k0, int n0, LAS float* scr, int lane) {
    const int nn = lane & 31; float sc = 1.f; int s;
    if (MODE == 1) s = z_src(n0 + nn, sc); else s = soff + n0 + nn;
#pragma unroll 8
    for (int i = 0; i < 32; ++i) { const int kk = 2 * i + (lane >> 5); scr[kk * 33 + nn] = (s >= 0) ? W[(size_t)(k0 + kk) * Nsrc + s] * sc : 0.f; }
    asm volatile("s_waitcnt lgkmcnt(0)" ::: "memory");
    const int c = lane & 7;
#pragma unroll
    for (int j = 0; j < 4; ++j) { const int n = (lane >> 3) + 8 * j; const LAS float* sp = scr + (8 * c) * 33 + n;
        u32x4 o; o.x = pk2(sp[0 * 33], sp[1 * 33]); o.y = pk2(sp[2 * 33], sp[3 * 33]); o.z = pk2(sp[4 * 33], sp[5 * 33]); o.w = pk2(sp[6 * 33], sp[7 * 33]);
        *(u32x4*)(WT + (size_t)(n0 + n) * dpitch + dcol0 + k0 + 8 * c) = o; }
    asm volatile("s_waitcnt lgkmcnt(0)" ::: "memory");
}
__device__ __forceinline__ void transpose_item8(const float* W, int Nsrc, int soff, unsigned char* WT, int K, int k0, int n0, LAS float* scr, int lane) {
    const int nn = lane & 31; const int s = soff + n0 + nn;
#pragma unroll 8
    for (int i = 0; i < 32; ++i) { const int kk = 2 * i + (lane >> 5); scr[kk * 33 + nn] = W[(size_t)(k0 + kk) * Nsrc + s] * 64.f; }
    asm volatile("s_waitcnt lgkmcnt(0)" ::: "memory");
    const int c = lane & 7;
#pragma unroll
    for (int j = 0; j < 4; ++j) { const int n = (lane >> 3) + 8 * j; const LAS float* sp = scr + (8 * c) * 33 + n;
        u32x2 o; o.x = pk4f8(sp[0 * 33], sp[1 * 33], sp[2 * 33], sp[3 * 33]); o.y = pk4f8(sp[4 * 33], sp[5 * 33], sp[6 * 33], sp[7 * 33]);
        *(u32x2*)(WT + (size_t)(n0 + n) * K + k0 + 8 * c) = o; }
    asm volatile("s_waitcnt lgkmcnt(0)" ::: "memory");
}
__device__ __forceinline__ void transpose_item8z(const float* W, unsigned char* WT, int tile, int slot, int k0, int n0, LAS float* scr, int lane) {
    const int nn = lane & 31; float sc = 1.f; const int s = z_src(tile * 256 + n0 + nn, sc); sc *= 64.f;
#pragma unroll 8
    for (int i = 0; i < 32; ++i) { const int kk = 2 * i + (lane >> 5); scr[kk * 33 + nn] = (s >= 0) ? W[(size_t)(k0 + kk) * NIN + s] * sc : 0.f; }
    asm volatile("s_waitcnt lgkmcnt(0)" ::: "memory");
    const int c = lane & 7;
#pragma unroll
    for (int j = 0; j < 4; ++j) { const int n = (lane >> 3) + 8 * j; const LAS float* sp = scr + (8 * c) * 33 + n;
        u32x2 o; o.x = pk4f8(sp[0 * 33], sp[1 * 33], sp[2 * 33], sp[3 * 33]); o.y = pk4f8(sp[4 * 33], sp[5 * 33], sp[6 * 33], sp[7 * 33]);
        *(u32x2*)(WT + (size_t)(slot * 256 + n0 + n) * 1024 + k0 + 8 * c) = o; }
    asm volatile("s_waitcnt lgkmcnt(0)" ::: "memory");
}
typedef __attribute__((address_space(4))) const struct Args* KArgPtr;
__device__ __forceinline__ void convert_w123(Frame& F, const float* w_in, const float* w_branch, const float* w_out) {
    LAS float* scr = (LAS float*)(F.lds + F.wave * 16384);
    const int gw = F.wg * NWAVES + F.wave, NGW = F.G * NWAVES;
    constexpr int I1 = 16 * 48, I2 = 0, I3 = 4 * 128, I4 = 16 * 32;
    unsigned char* w123 = F.ws + WS_W123;
    for (int it = gw; it < I1 + I2 + I3 + I4; it += NGW) {
        int r = it;
        if (r < I1) { const int nb = r % 48, tile = (int)((G1_BF_TILES >> (4 * (nb >> 3))) & 15); transpose_item<1>(w_in, NIN, 0, (bf16*)(w123 + W123_W1), 1024, 0, 64 * (r / 48), tile * 256 + 32 * (nb & 7), scr, F.lane); continue; } r -= I1;
        if (r < I3) { const int n = r / 128, rr = r % 128; transpose_item<0>(w_branch + (size_t)n * 256 * DM, DM, 0, (bf16*)(w123 + W123_GB + 8 * MiB) + (size_t)n * 1024 * 256, 256, 0, 64 * (rr / 32), 32 * (rr % 32), scr, F.lane); continue; } r -= I3;
        transpose_item<0>(w_out, DM, 0, (bf16*)(w123 + W123_WO), 1024, 0, 64 * (r / 32), 32 * (r % 32), scr, F.lane);
    }
}
__device__ __forceinline__ void p0_prologue(Frame& F, __attribute__((address_space(4))) const Args* Ap) {
    LAS float* scr = (LAS float*)(F.lds + F.wave * 16384);
    const int gw = F.wg * NWAVES + F.wave, NGW = F.G * NWAVES;
    constexpr int I5 = 0, I6 = 0, I7 = 4 * 32, I8 = 0;
    constexpr int IL = I5 + I6 + I7 + I8;
    for (int it = gw; it < 2 * IL; it += NGW) {
        const int l = it / IL; int r = it - l * IL;
        unsigned char* w45 = F.ws + WS_W45 + (size_t)l * W45_STRIDE;
        if (r < I7) { transpose_item<0>(Ap->in[18] + (size_t)l * PDIM * DM, DM, 0, (bf16*)(w45 + W45_PP), 256, 0, 64 * (r / 32), 32 * (r % 32), scr, F.lane); continue; } r -= I7;
        transpose_item<0>(Ap->in[16] + (size_t)l * DFF * DM, DM, 0, (bf16*)(w45 + W45_DN), DFF, 0, 64 * (r / 32), 32 * (r % 32), scr, F.lane);
    }
    {   constexpr int J1 = 16 * 128, J2 = 16 * 176, J3 = 16 * 32, J4 = 44 * 32, J5 = 8 * 16 * 8, JL = J1 + J2 + J3 + J4 + J5;
        for (int it = gw; it < 2 * JL; it += NGW) { const int l = it / JL; int r = it - l * JL; unsigned char* w8 = F.dob + DO_W8 + (size_t)l * W8_STRIDE;
            if (r < J1) { transpose_item8(Ap->in[2] + (size_t)l * DM * NIN, NIN, SRC_MG, w8 + W8_G, 1024, 64 * (r / 128), 32 * (r % 128), scr, F.lane); continue; } r -= J1;
            if (r < J2) { transpose_item8(Ap->in[13] + (size_t)l * DM * UGW, UGW, 0, w8 + W8_UP, 1024, 64 * (r / 176), 32 * (r % 176), scr, F.lane); continue; } r -= J2;
            if (r < J3) { transpose_item8(Ap->in[17] + (size_t)l * DM * DM, DM, 0, w8 + W8_PG, 1024, 64 * (r / 32), 32 * (r % 32), scr, F.lane); continue; } r -= J3;
            if (r < J4) { transpose_item8(Ap->in[16] + (size_t)l * DFF * DM, DM, 0, w8 + W8_DN, DFF, 64 * (r / 32), 32 * (r % 32), scr, F.lane); continue; } r -= J4;
            { const int slot = r >> 7, rr = r & 127; transpose_item8z(Ap->in[2] + (size_t)l * DM * NIN, w8 + W8_Z, (int)((G1_F8_TILES >> (4 * slot)) & 15), slot, 64 * (rr >> 3), 32 * (rr & 7), scr, F.lane); } } }
    convert_w123(F, Ap->in[2], Ap->in[9], Ap->in[10]);
    {   const size_t n8 = (size_t)M * DM / 8; const f32x4* src = (const f32x4*)Ap->in[0]; u32x4* dst = (u32x4*)(F.ws + WS_XB); u32x2* dst8 = (u32x2*)(F.dob + DO_XB8);
        for (size_t i = (size_t)F.wg * 512 + F.tid; i < n8; i += (size_t)F.G * 512) { const f32x4 a = src[2 * i], b = src[2 * i + 1]; u32x4 o; o.x = pk2(a[0], a[1]); o.y = pk2(a[2], a[3]); o.z = pk2(b[0], b[1]); o.w = pk2(b[2], b[3]); dst[i] = o;
            u32x2 o8; o8.x = pk4f8(a[0], a[1], a[2], a[3]); o8.y = pk4f8(b[0], b[1], b[2], b[3]); dst8[i] = o8; } }
    {   const size_t n8 = (size_t)DEPTH * M * PDIM / 8; const f32x4* src = (const f32x4*)Ap->in[1]; u32x4* dst = (u32x4*)(F.ws + WS_PB);
        for (size_t i = (size_t)F.wg * 512 + F.tid; i < n8; i += (size_t)F.G * 512) { const f32x4 a = src[2 * i], b = src[2 * i + 1]; u32x4 o; o.x = pk2(a[0], a[1]); o.y = pk2(a[2], a[3]); o.z = pk2(b[0], b[1]); o.w = pk2(b[2], b[3]); dst[i] = o; } }
}

__device__ __forceinline__ void ln_phase(Frame& F, const float* w, const float* bvec, float* outf, unsigned char* xb8) {
    const int gw = F.wg * NWAVES + F.wave, NGW = F.G * NWAVES;
    bf16* XB = (bf16*)(F.ws + WS_XB);
    for (int row = gw; row < M; row += NGW) {
        u32x4* p = (u32x4*)(XB + (size_t)row * DM) + F.lane;
        const u32x4 a = p[0], b = p[64];
        float v[16] = {bflo(a.x), bfhi(a.x), bflo(a.y), bfhi(a.y), bflo(a.z), bfhi(a.z), bflo(a.w), bfhi(a.w), bflo(b.x), bfhi(b.x), bflo(b.y), bfhi(b.y), bflo(b.z), bfhi(b.z), bflo(b.w), bfhi(b.w)};
        float s = 0.f;
#pragma unroll
        for (int i = 0; i < 16; ++i) s += v[i];
        const float mean = wave_sum(s, F.lane) * (1.f / DM); float q = 0.f;
#pragma unroll
        for (int i = 0; i < 16; ++i) { v[i] -= mean; q += v[i] * v[i]; }
        const float rstd = 1.f / sqrtf(wave_sum(q, F.lane) * (1.f / DM) + LN_EPS);
        const int c0 = F.lane * 8, c1 = 512 + F.lane * 8;
        const f32x4 w0 = *(const f32x4*)(w + c0), w1 = *(const f32x4*)(w + c0 + 4), w2 = *(const f32x4*)(w + c1), w3 = *(const f32x4*)(w + c1 + 4);
        const f32x4 b0 = *(const f32x4*)(bvec + c0), b1 = *(const f32x4*)(bvec + c0 + 4), b2 = *(const f32x4*)(bvec + c1), b3 = *(const f32x4*)(bvec + c1 + 4);
        f32x4 y0, y1, y2, y3;
#pragma unroll
        for (int i = 0; i < 4; ++i) { y0[i] = v[i] * rstd * w0[i] + b0[i]; y1[i] = v[4 + i] * rstd * w1[i] + b1[i]; y2[i] = v[8 + i] * rstd * w2[i] + b2[i]; y3[i] = v[12 + i] * rstd * w3[i] + b3[i]; }
        u32x4 o0, o1; o0.x = pk2(y0[0], y0[1]); o0.y = pk2(y0[2], y0[3]); o0.z = pk2(y1[0], y1[1]); o0.w = pk2(y1[2], y1[3]);
        o1.x = pk2(y2[0], y2[1]); o1.y = pk2(y2[2], y2[3]); o1.z = pk2(y3[0], y3[1]); o1.w = pk2(y3[2], y3[3]);
        p[0] = o0; p[64] = o1;
        if (xb8) { u32x2* q8 = (u32x2*)(xb8 + (size_t)row * DM) + F.lane; u32x2 a8, b8; a8.x = pk4f8(y0[0], y0[1], y0[2], y0[3]); a8.y = pk4f8(y1[0], y1[1], y1[2], y1[3]); b8.x = pk4f8(y2[0], y2[1], y2[2], y2[3]); b8.y = pk4f8(y3[0], y3[1], y3[2], y3[3]); q8[0] = a8; q8[64] = b8; }
        if (outf) { f32x4* op = (f32x4*)(outf + (size_t)row * DM); op[2 * F.lane] = y0; op[2 * F.lane + 1] = y1; op[128 + 2 * F.lane] = y2; op[128 + 2 * F.lane + 1] = y3; }
    }
}

__device__ __forceinline__ float gelu_tanh_(float y) { const float t = 1.5957691216057308f * (y + 0.044715f * y * y * y); return y * __builtin_amdgcn_rcpf(1.0f + __builtin_amdgcn_exp2f(-LOG2E * t)); }
__device__ __forceinline__ void up8(const u32x4 w, float (&v)[8]) { v[0] = bflo(w.x); v[1] = bfhi(w.x); v[2] = bflo(w.y); v[3] = bfhi(w.y); v[4] = bflo(w.z); v[5] = bfhi(w.z); v[6] = bflo(w.w); v[7] = bfhi(w.w); }
__device__ __forceinline__ void ffn_act_phase(Frame& F, const float* cw, const float* cb) {
    unsigned char* UGb = F.ws + WS_UG; constexpr int NV = DFF / 8, RB = 16;
    const int v = F.tid, c0 = v * 8; const bool on = v < NV;
    float w0[8], w1[8], w2[8], bb[8];
#pragma unroll
    for (int i = 0; i < 8; ++i) { w0[i] = on ? cw[c0 + i] : 0.f; w1[i] = on ? cw[DFF + c0 + i] : 0.f; w2[i] = on ? cw[2 * DFF + c0 + i] : 0.f; bb[i] = on ? cb[c0 + i] : 0.f; }
    for (int rb = F.wg; rb < M / RB; rb += F.G) {
        const int t0 = rb * RB; u32x2 outv[RB];
        if (on) { u32x4 uq[RB], gq[RB]; const bf16* base = (const bf16*)(UGb + (size_t)t0 * (UGW * 2));
#pragma unroll
            for (int r = 0; r < RB; ++r) { uq[r] = *(const u32x4*)(base + (size_t)r * UGW + c0); gq[r] = *(const u32x4*)(base + (size_t)r * UGW + DFF + c0); }
            float gm2[8], gm1[8];
            if ((t0 & (SEQ - 1)) == 0) {
#pragma unroll
                for (int i = 0; i < 8; ++i) { gm2[i] = 0.f; gm1[i] = 0.f; }
            } else { up8(*(const u32x4*)(base - 2 * UGW + DFF + c0), gm2); up8(*(const u32x4*)(base - UGW + DFF + c0), gm1); }
#pragma unroll
            for (int r = 0; r < RB; ++r) { float g0[8], uu[8], o[8]; up8(gq[r], g0); up8(uq[r], uu);
#pragma unroll
                for (int i = 0; i < 8; ++i) { const float y = bb[i] + w0[i] * gm2[i] + w1[i] * gm1[i] + w2[i] * g0[i]; o[i] = gelu_tanh_(y) * uu[i]; gm2[i] = gm1[i]; gm1[i] = g0[i]; }
                outv[r].x = pk4f8(o[0], o[1], o[2], o[3]); outv[r].y = pk4f8(o[4], o[5], o[6], o[7]); } }
        __syncthreads();
        if (on) {
#pragma unroll
            for (int r = 0; r < RB; ++r) *(u32x2*)(UGb + (size_t)(t0 + r) * (UGW * 2) + c0) = outv[r]; }
    }
}

namespace mx {
__device__ __forceinline__ f32x16 mfma32(bf16x8 a, bf16x8 b, f32x16 c) { return __builtin_amdgcn_mfma_f32_32x32x16_bf16(a, b, c, 0, 0, 0); }
__device__ __forceinline__ f32x16 splat16(float v) { f32x16 r;
#pragma unroll
    for (int i = 0; i < 16; ++i) r[i] = v;
    return r; }
__device__ __forceinline__ int crow_c(int e) { return (e & 3) + 8 * (e >> 2); }
typedef short v4i16_t __attribute__((ext_vector_type(4)));
__device__ __forceinline__ s16x4 vtr(const LAS unsigned char* p) { return __builtin_bit_cast(s16x4, __builtin_amdgcn_ds_read_tr16_b64_v4i16((LAS v4i16_t*)p)); }
__device__ __forceinline__ bf16x8 pack8(float a0, float a1, float a2, float a3, float a4, float a5, float a6, float a7) {
    u32x4 w; w.x = pk2(a0, a1); w.y = pk2(a2, a3); w.z = pk2(a4, a5); w.w = pk2(a6, a7); return __builtin_bit_cast(bf16x8, w); }

__device__ __forceinline__ float log2gam(int h) { return __builtin_log2f(1.0f - __builtin_exp2f(-5.0f - (float)h)); }
__device__ __forceinline__ void prepkv_unit(Frame& F, int blk, const float* wa2, const float* bap, unsigned* kmaxl) {
    bf16* Z = (bf16*)(F.ws + WS_Z);
    const size_t r0 = (size_t)blk * 256; const int b = blk >> 5, cb = blk & 31;
    const int tid = F.tid;
    {   const int ch = tid >> 7, col = tid & 127;
        const float ba = bap[col];
        float wa[16];
#pragma unroll
        for (int r = 0; r < 16; ++r) wa[r] = wa2[r * 128 + col];
        float cum = 0.f;
        for (int t0 = 0; t0 < 64; t0 += 8) { u32x4 A[8], B[8];
#pragma unroll
            for (int tt = 0; tt < 8; ++tt) { const bf16* zr = Z + (r0 + ch * 64 + t0 + tt) * ZW; A[tt] = *(const u32x4*)(zr + ZC_DA); B[tt] = *(const u32x4*)(zr + ZC_DA + 8); }
#pragma unroll
            for (int tt = 0; tt < 8; ++tt) { float da[8], db[8]; up8(A[tt], da); up8(B[tt], db); float x = ba;
#pragma unroll
                for (int r = 0; r < 8; ++r) x += da[r] * wa[r];
#pragma unroll
                for (int r = 0; r < 8; ++r) x += db[r] * wa[8 + r];
                cum += (fminf(x, 0.f) - __logf(1.0f + __expf(-fabsf(x)))) * 0.0625f; } }
        const float bl = cum; cum = 0.f;
        for (int t0 = 0; t0 < 64; t0 += 8) { u32x4 A[8], B[8]; bf16 qv[8], kv[8];
#pragma unroll
            for (int tt = 0; tt < 8; ++tt) { const bf16* zr = Z + (r0 + ch * 64 + t0 + tt) * ZW; A[tt] = *(const u32x4*)(zr + ZC_DA); B[tt] = *(const u32x4*)(zr + ZC_DA + 8); qv[tt] = zr[ZC_DQ + col]; kv[tt] = zr[ZC_DK + col]; }
#pragma unroll
            for (int tt = 0; tt < 8; ++tt) { bf16* zr = Z + (r0 + ch * 64 + t0 + tt) * ZW; float da[8], db[8]; up8(A[tt], da); up8(B[tt], db); float x = ba;
#pragma unroll
                for (int r = 0; r < 8; ++r) x += da[r] * wa[r];
#pragma unroll
                for (int r = 0; r < 8; ++r) x += db[r] * wa[8 + r];
                cum += (fminf(x, 0.f) - __logf(1.0f + __expf(-fabsf(x)))) * 0.0625f;
                zr[ZC_DQ + col] = (bf16)f2bf(bf1(qv[tt]) * __expf(cum - bl)); zr[ZC_DK + col] = (bf16)f2bf(bf1(kv[tt]) * __expf(bl - cum)); } }
        ((float*)(F.ws + WS_DE))[((size_t)b * 128 + cb * 4 + ch) * 128 + col] = __expf(bl);
    }
    for (int itn = 0; itn < 6; ++itn) { const int task = tid + 512 * itn, sl = task >> 8, row = task & 255;
        const bf16* kp = Z + (r0 + row) * ZW + (sl < 8 ? ZC_AK + (sl >> 1) * 64 + (sl & 1) * 32 : ZC_BK + (sl - 8) * 64); float ss = 0.f;
        const int nch = sl < 8 ? 4 : 8;
        for (int c = 0; c < nch; ++c) { float v[8]; up8(*(const u32x4*)(kp + 8 * c), v);
#pragma unroll
            for (int i = 0; i < 8; ++i) ss += v[i] * v[i]; }
#pragma unroll
        for (int o = 1; o < 64; o <<= 1) ss = fmaxf(ss, shx(ss, F.lane, o));
        if (F.lane == 0) __hip_atomic_fetch_max(kmaxl + b * 16 + sl, __float_as_uint(sqrtf(ss)), __ATOMIC_RELAXED, __HIP_MEMORY_SCOPE_AGENT); }
    for (int i0 = 0; i0 < 32; i0 += 4) { u32x4 vv[4];
#pragma unroll
        for (int k = 0; k < 4; ++k) { const int idx = tid + 512 * (i0 + k); const int row = idx >> 6, chunk = idx & 63, isk = chunk >> 5, c8 = (chunk & 31) * 8;
            vv[k] = *(const u32x4*)(Z + (r0 + row) * ZW + (isk ? ZC_CK : ZC_CQ) + c8); }
#pragma unroll
        for (int k = 0; k < 4; ++k) { const int idx = tid + 512 * (i0 + k); const int row = idx >> 6, chunk = idx & 63, isk = chunk >> 5, c8 = (chunk & 31) * 8, h = c8 >> 6;
            const float e = (float)(255 - row) * log2gam(h); const float f = __builtin_amdgcn_exp2f(isk ? e : -e); float v[8]; up8(vv[k], v);
            u32x4 w; w.x = pk2(v[0] * f, v[1] * f); w.y = pk2(v[2] * f, v[3] * f); w.z = pk2(v[4] * f, v[5] * f); w.w = pk2(v[6] * f, v[7] * f);
            *(u32x4*)(Z + (r0 + row) * ZW + (isk ? ZC_CK : ZC_CQ) + c8) = w; } }
    __threadfence_block(); __syncthreads();
    LAS unsigned char* Kl = F.lds; LAS unsigned char* Vl = F.lds + 36864;
    for (int h = 0; h < 4; ++h) {
        for (int idx = tid; idx < 256 * 8; idx += 512) { const int row = idx >> 3, c = idx & 7;
            *(LAS u32x4*)(Kl + row * 144 + c * 16) = *(const u32x4*)(Z + (r0 + row) * ZW + ZC_CK + h * 64 + c * 8);
            *(LAS u32x4*)(Vl + row * 144 + c * 16) = *(const u32x4*)(Z + (r0 + row) * ZW + ZC_CV + h * 64 + c * 8); }
        __syncthreads();
        {   const int d = tid >> 3, dk8 = (tid & 7) * 8; float acc[8];
#pragma unroll
            for (int i = 0; i < 8; ++i) acc[i] = 0.f;
            for (int j = 0; j < 256; ++j) { const float vv = bf1(*(const LAS bf16*)(Vl + j * 144 + d * 2)); float kk[8]; up8(*(const LAS u32x4*)(Kl + j * 144 + dk8 * 2), kk);
#pragma unroll
                for (int i = 0; i < 8; ++i) acc[i] += vv * kk[i]; }
            float* o = (float*)(F.ws + WS_KVC) + ((size_t)((b * 4 + h) * 32 + cb) * 4096 + d * 64 + dk8);
            *(f32x4*)o = (f32x4){acc[0], acc[1], acc[2], acc[3]}; *(f32x4*)(o + 4) = (f32x4){acc[4], acc[5], acc[6], acc[7]}; }
        __syncthreads();
        for (int idx = tid; idx < 256 * 8; idx += 512) { const int row = idx >> 3, c = idx & 7;
            if (c < 4) *(LAS u32x4*)(Kl + row * 144 + c * 16) = *(const u32x4*)(Z + (r0 + row) * ZW + ZC_DK + h * 32 + c * 8);
            *(LAS u32x4*)(Vl + row * 144 + c * 16) = *(const u32x4*)(Z + (r0 + row) * ZW + ZC_DV + h * 64 + c * 8); }
        __syncthreads();
        {   const int ch = tid >> 7, d = (tid >> 1) & 63, dk16 = (tid & 1) * 16; float acc[16];
#pragma unroll
            for (int i = 0; i < 16; ++i) acc[i] = 0.f;
            for (int j = 0; j < 64; ++j) { const int row = ch * 64 + j; const float vv = bf1(*(const LAS bf16*)(Vl + row * 144 + d * 2)); float k0[8], k1[8];
                up8(*(const LAS u32x4*)(Kl + row * 144 + dk16 * 2), k0); up8(*(const LAS u32x4*)(Kl + row * 144 + dk16 * 2 + 16), k1);
#pragma unroll
                for (int i = 0; i < 8; ++i) { acc[i] += vv * k0[i]; acc[8 + i] += vv * k1[i]; } }
            float* o = (float*)(F.ws + WS_KVD) + ((size_t)((b * 4 + h) * 128 + cb * 4 + ch) * 2048 + d * 32 + dk16);
#pragma unroll
            for (int i = 0; i < 4; ++i) *(f32x4*)(o + 4 * i) = (f32x4){acc[4 * i], acc[4 * i + 1], acc[4 * i + 2], acc[4 * i + 3]}; }
        __syncthreads();
    }
}

__device__ __forceinline__ void scan_phase(Frame& F) {
    const int gt = F.wg * 512 + F.tid, NT = F.G * 512;
    for (int e0 = gt; e0 < 16 * 4096 + 16 * 2048; e0 += NT) {
        if (e0 < 16 * 4096) { const int e = e0;
            const int bh = e >> 12, idx = e & 4095, h = bh & 3; const float g256 = __builtin_amdgcn_exp2f(256.0f * log2gam(h));
            float* p = (float*)(F.ws + WS_KVC) + (size_t)bh * 32 * 4096 + idx; float S = 0.f; float kv[32];
#pragma unroll
            for (int c = 0; c < 32; ++c) kv[c] = p[(size_t)c * 4096];
#pragma unroll
            for (int c = 0; c < 32; ++c) { const float Sp = g256 * S; p[(size_t)c * 4096] = Sp; S = Sp + kv[c]; }
        } else { const int e = e0 - 16 * 4096;
            const int bh = e >> 11, idx = e & 2047, b = bh >> 2, h = bh & 3, dk = idx & 31;
            float* p = (float*)(F.ws + WS_KVD) + (size_t)bh * 128 * 2048 + idx; const float* de = (const float*)(F.ws + WS_DE) + (size_t)b * 128 * 128 + h * 32 + dk; float S = 0.f;
            for (int c0 = 0; c0 < 128; c0 += 16) { float kv[16], dd[16];
#pragma unroll
                for (int c = 0; c < 16; ++c) { kv[c] = p[(size_t)(c0 + c) * 2048]; dd[c] = de[(c0 + c) * 128]; }
#pragma unroll
                for (int c = 0; c < 16; ++c) { const float Sp = dd[c] * S; p[(size_t)(c0 + c) * 2048] = Sp; S = Sp + kv[c]; } }
        }
    }
}

constexpr int HPITCH = 1026, CAP = 256;
struct QState { unsigned mode, thr_lo, thr_hi, thr_idx, krem, lcount, pad0, pad1; };
__device__ __forceinline__ unsigned okey_of(float s) { const unsigned u = __float_as_uint(s); return u ^ ((unsigned)((int)u >> 31) | 0x80000000u); }
__device__ __forceinline__ void b1_load(const bf16* Zb, int t, int r, int hh, bf16x8& k0, bf16x8& k1) {
    const bf16* kr = Zb + (size_t)(32 * t + r) * ZW + ZC_IK + 8 * hh; k0 = *(const bf16x8*)kr; k1 = *(const bf16x8*)(kr + 16); }
__device__ __forceinline__ void b1_scores(const bf16x8 k0, const bf16x8 k1, const bf16x8 (&iqf)[4][2], const float (&w)[4], float (&sc)[16]) {
#pragma unroll
    for (int e = 0; e < 16; ++e) sc[e] = 0.f;
#pragma unroll
    for (int ih = 0; ih < 4; ++ih) { f32x16 lg = mfma32(k0, iqf[ih][0], splat16(0.f)); lg = mfma32(k1, iqf[ih][1], lg);
#pragma unroll
        for (int e = 0; e < 16; ++e) sc[e] = fmaf(w[ih], fmaxf(lg[e], 0.f), sc[e]); }
}
__device__ __forceinline__ void b1_setbit(unsigned* MWq, unsigned j) {
    const unsigned wi = j & 31u, hh = (wi >> 2) & 1u, e = (wi & 3u) + 4u * (wi >> 3), kh = (j >> 5) & 1u;
    __hip_atomic_fetch_or(MWq + (size_t)(j >> 6) * 64 + 32u * hh, 1u << (e + 16u * kh), __ATOMIC_RELAXED, __HIP_MEMORY_SCOPE_AGENT);
}
__device__ __forceinline__ void b1_unit(Frame& F, int b, int g) {
    const int tid = F.tid, lane = F.lane, r = lane & 31, hh = lane >> 5, wid = F.wave;
    const bf16* Zb = (const bf16*)(F.ws + WS_Z) + (size_t)b * SEQ * ZW;
    LAS unsigned* hist = (LAS unsigned*)F.lds;
    LAS QState* qst = (LAS QState*)(F.lds + QST_OFF);
    const int qpos = 32 * g + r;
    unsigned* MWb = (unsigned*)(F.ws + WS_MASK) + ((size_t)(b * 256 + g) * 128) * 64;
    bf16x8 iqf[4][2]; float w[4];
    {   const bf16* qr = Zb + (size_t)qpos * ZW;
#pragma unroll
        for (int ih = 0; ih < 4; ++ih) { iqf[ih][0] = *(const bf16x8*)(qr + ZC_IQ + ih * 32 + 8 * hh); iqf[ih][1] = *(const bf16x8*)(qr + ZC_IQ + ih * 32 + 16 + 8 * hh); w[ih] = bf1(qr[ZC_IW + ih]); } }
    if (g >= 8) {
        for (int i = tid; i < 32 * HPITCH; i += 512) hist[i] = 0u;
        __syncthreads();
        {   bf16x8 n0 = iqf[0][0], n1 = iqf[0][0]; int t = wid; if (t <= g) b1_load(Zb, t, r, hh, n0, n1);
            for (; t <= g; t += 8) { const bf16x8 k0 = n0, k1 = n1; if (t + 8 <= g) b1_load(Zb, t + 8, r, hh, n0, n1);
                float sc[16]; b1_scores(k0, k1, iqf, w, sc);
#pragma unroll
                for (int e = 0; e < 16; ++e) { const int j = 32 * t + crow_c(e) + 4 * hh; if (j <= qpos) { const unsigned bin = okey_of(sc[e]) >> 21;
                    __hip_atomic_fetch_add(hist + r * HPITCH + (bin >> 1), 1u << ((bin & 1) * 16), __ATOMIC_RELAXED, __HIP_MEMORY_SCOPE_WORKGROUP); } } } }
        __syncthreads();
        for (int qq = 0; qq < 4; ++qq) { const int q = 4 * wid + qq; const LAS unsigned* hq = hist + q * HPITCH;
            const int wbase = 1008 - 16 * lane; unsigned s = 0;
#pragma unroll
            for (int k = 0; k < 16; ++k) { const unsigned x = hq[wbase + k]; s += (x & 0xffffu) + (x >> 16); }
            unsigned P = s;
#pragma unroll
            for (int o = 1; o < 64; o <<= 1) { const unsigned t = shup(P, lane, o); if (lane >= o) P += t; }
            const unsigned long long bal = __ballot(P >= 256u);
            const int Lsel = bal ? __builtin_ctzll(bal) : 63;
            if (lane == Lsel) { unsigned cum = P - s; unsigned b1 = 0, cin = 0, cab = 0;
                for (int k = 0; k < 32; ++k) { const int bin = 2047 - 32 * lane - k; const unsigned x = hq[bin >> 1]; const unsigned c = (bin & 1) ? (x >> 16) : (x & 0xffffu);
                    if (cum + c >= 256u) { b1 = (unsigned)bin; cin = c; cab = cum; break; } cum += c; }
                qst[q].thr_lo = b1 << 21; qst[q].thr_hi = (b1 << 21) | 0x1fffffu; qst[q].thr_idx = 0xffffu; qst[q].krem = 256u - cab; qst[q].lcount = 0u; qst[q].pad0 = cin; qst[q].pad1 = 0u;
                qst[q].mode = (b1 == 1024u || cin > (unsigned)CAP) ? 2u : 1u; }
        }
        __syncthreads();
        for (int i = tid; i < 32 * 256; i += 512) ((LAS unsigned*)(F.lds + 65536))[i] = 0u;
        __syncthreads();
    }
    {   unsigned mode = 0u, tlo = 1u, thi = 0u;
        const bool allsel = (g < 8);
        if (!allsel) { mode = qst[r].mode; tlo = qst[r].thr_lo; thi = qst[r].thr_hi; }
        const int nk = g >> 1;
        bf16x8 n0 = iqf[0][0], n1 = iqf[0][0], n2 = iqf[0][0], n3 = iqf[0][0]; int kt = wid;
        if (kt <= nk) { b1_load(Zb, 2 * kt, r, hh, n0, n1); if (2 * kt + 1 <= g) b1_load(Zb, 2 * kt + 1, r, hh, n2, n3); }
        for (; kt <= nk; kt += 8) {
            const bf16x8 k0 = n0, k1 = n1, k2 = n2, k3 = n3;
            if (kt + 8 <= nk) { b1_load(Zb, 2 * kt + 16, r, hh, n0, n1); if (2 * kt + 17 <= g) b1_load(Zb, 2 * kt + 17, r, hh, n2, n3); }
            unsigned word = 0u;
#pragma unroll
            for (int kh = 0; kh < 2; ++kh) { const int t = 2 * kt + kh; if (t <= g) { float sc[16]; b1_scores(kh ? k2 : k0, kh ? k3 : k1, iqf, w, sc);
#pragma unroll
                for (int e = 0; e < 16; ++e) { const int j = 32 * t + crow_c(e) + 4 * hh; const unsigned ok = okey_of(sc[e]); const bool valid = (j <= qpos);
                    const bool sel = valid && (allsel || ok > thi); word |= (sel ? 1u : 0u) << (e + 16 * kh);
                    if (!allsel && valid && ok >= tlo && ok <= thi) {
                        if (mode == 1u) { const unsigned pos = __hip_atomic_fetch_add(&qst[r].lcount, 1u, __ATOMIC_RELAXED, __HIP_MEMORY_SCOPE_WORKGROUP);
                            if (pos < (unsigned)CAP) { LAS unsigned* le = (LAS unsigned*)(F.lds + ((size_t)r * CAP + pos) * 8); le[0] = ok; le[1] = (unsigned)j; } }
                        else __hip_atomic_fetch_or((LAS unsigned*)(F.lds + 65536 + r * 1024) + (j >> 5), 1u << (j & 31), __ATOMIC_RELAXED, __HIP_MEMORY_SCOPE_WORKGROUP); } } } }
            MWb[(size_t)kt * 64 + lane] = word; }
    }
    __syncthreads();
    if (g >= 8) {
        for (int qq = 0; qq < 4; ++qq) { const int q = 4 * wid + qq; const unsigned mode = qst[q].mode, krem = qst[q].krem; unsigned* MWq = MWb + q;
            if (mode == 1u) {
                unsigned L = qst[q].lcount; if (L > (unsigned)CAP) L = CAP; const LAS unsigned* lb = (const LAS unsigned*)(F.lds + (size_t)q * CAP * 8);
                unsigned long long comp[4]; bool has[4]; unsigned jj[4];
#pragma unroll
                for (int k = 0; k < 4; ++k) { const unsigned c = lane + 64 * k; has[k] = c < L; const unsigned ok = has[k] ? lb[2 * c] : 0u; jj[k] = has[k] ? lb[2 * c + 1] : 0u;
                    comp[k] = ((unsigned long long)(ok & 0x1fffffu) << 13) | (unsigned long long)(8191u - jj[k]); }
                unsigned long long prefix = 0ull; unsigned need = krem;
                for (int bit = 33; bit >= 0; --bit) { const unsigned long long want = (prefix >> bit) | 1ull; unsigned cnt = 0;
#pragma unroll
                    for (int k = 0; k < 4; ++k) cnt += (unsigned)__builtin_popcountll(__ballot(has[k] && ((comp[k] >> bit) == want)));
                    if (cnt >= need) prefix |= (1ull << bit); else need -= cnt; }
#pragma unroll
                for (int k = 0; k < 4; ++k) if (has[k] && comp[k] >= prefix) b1_setbit(MWq, jj[k]); }
            else { const LAS unsigned* bm = (const LAS unsigned*)(F.lds + 65536 + q * 1024); unsigned x[4]; unsigned s = 0;
#pragma unroll
                for (int k = 0; k < 4; ++k) { x[k] = bm[4 * lane + k]; s += __builtin_popcount(x[k]); }
                unsigned P = s;
#pragma unroll
                for (int o = 1; o < 64; o <<= 1) { const unsigned t = shup(P, lane, o); if (lane >= o) P += t; }
                unsigned before = P - s;
#pragma unroll
                for (int k = 0; k < 4; ++k) { unsigned y = x[k]; while (y != 0u && before < krem) { const unsigned bit = (unsigned)__builtin_ctz(y); y &= y - 1u; b1_setbit(MWq, 32u * (4 * lane + k) + bit); ++before; } before += __builtin_popcount(y); } }
        }
        __syncthreads();
    }
}

struct EngP { const bf16* Z; bf16* Y; const unsigned* MASK; const float* ST; const float* nw; float lam, lam_init; const unsigned* kmax; };
__device__ __forceinline__ int wq_next(Frame& F, unsigned* head) {
    LAS int* slot = (LAS int*)(F.lds + 36880);
    if (F.tid == 0) *slot = (int)__hip_atomic_fetch_add(head, 1u, __ATOMIC_RELAXED, __HIP_MEMORY_SCOPE_AGENT);
    __syncthreads(); const int u = *slot; __syncthreads();
    asm volatile("" : "+v"(F.tid), "+v"(F.lane));
    return u;
}
template <int MODE>
__device__ __forceinline__ void eng_unit(Frame& F, const EngP& P, int b, int h, int qb) {
    constexpr bool SOFT = MODE <= 1;
    constexpr int NMAP = MODE == 0 ? 2 : 1;
    constexpr int NS = (MODE == 0 || MODE == 3) ? 2 : 4;
    constexpr int KCH = MODE == 3 ? 4 : 8;
    constexpr int QC = MODE == 0 ? ZC_AQ : MODE == 1 ? ZC_BQ : MODE == 2 ? ZC_CQ : ZC_DQ;
    constexpr int KC = MODE == 0 ? ZC_AK : MODE == 1 ? ZC_BK : MODE == 2 ? ZC_CK : ZC_DK;
    constexpr int VC = MODE == 0 ? ZC_AV : MODE == 1 ? ZC_BV : MODE == 2 ? ZC_CV : ZC_DV;
    constexpr int HW = MODE == 3 ? 32 : 64;
    const int tid = F.tid, lane = F.lane, r = lane & 31, hh = lane >> 5, w = F.wave;
    const size_t rowbase = (size_t)b * SEQ;
    const int qw0 = qb * 256 + 32 * w;
    const float NEG = -__builtin_inff();
    const int hidx = MODE <= 1 ? (MODE == 0 ? 2 * h + 1 : 2 * h + 2) : 0;
    const float slope2 = SOFT ? __builtin_amdgcn_exp2f(-(float)hidx) * LOG2E : 0.f;
    bf16x8 qf[NMAP][NS];
    {   const bf16* qrow = P.Z + (rowbase + qw0 + r) * ZW + QC + h * HW;
#pragma unroll
        for (int m = 0; m < NMAP; ++m)
#pragma unroll
            for (int s = 0; s < NS; ++s) qf[m][s] = *(const bf16x8*)(qrow + m * 32 + 16 * s + 8 * hh); }
    f32x16 cinit;
#pragma unroll
    for (int e = 0; e < 16; ++e) cinit[e] = SOFT ? slope2 * (float)(crow_c(e) + 4 * hh) : 0.f;
    float m_run[NMAP], l_run[NMAP]; f32x16 O[NMAP][2];
#pragma unroll
    for (int m = 0; m < NMAP; ++m) { m_run[m] = NEG; l_run[m] = 0.f; O[m][0] = splat16(0.f); O[m][1] = splat16(0.f); }
    if (!SOFT) {
        const int sidx = MODE == 2 ? ((b * 4 + h) * 32 + qb) : ((b * 4 + h) * 128 + 4 * qb + (w >> 1));
        const float* sp = P.ST + (size_t)sidx * (64 * HW);
#pragma unroll
        for (int db = 0; db < 2; ++db)
#pragma unroll
            for (int s = 0; s < NS; ++s) { const float* a = sp + (size_t)(32 * db + r) * HW + 16 * s + 8 * hh; const f32x4 a0 = *(const f32x4*)a, a1 = *(const f32x4*)(a + 4);
                O[0][db] = mfma32(pack8(a0[0], a0[1], a0[2], a0[3], a1[0], a1[1], a1[2], a1[3]), qf[0][s], O[0][db]); }
    }
    const int kt_lo = SOFT ? 0 : 4 * qb, kt_hi = 4 * qb + 3;
    const int srow = tid >> 3, sch = tid & 7;
    float qk[NMAP];
    if (SOFT) {
#pragma unroll
        for (int m = 0; m < NMAP; ++m) { float ss = 0.f;
#pragma unroll
            for (int s = 0; s < NS; ++s) { const u32x4 qq = __builtin_bit_cast(u32x4, qf[m][s]); float v[8]; up8(qq, v);
#pragma unroll
                for (int i = 0; i < 8; ++i) ss += v[i] * v[i]; }
            ss += shx(ss, lane, 32);
            qk[m] = 1.02f * sqrtf(ss) * __uint_as_float(P.kmax[b * 16 + (MODE == 0 ? (h * 2 + m) : (8 + h))]) + 0.01f; }
    }
    LAS unsigned* wflag = (LAS unsigned*)(F.lds + 36864);
    if (SOFT && tid < 3) wflag[tid] = 0u;
    const int kt_first = SOFT ? kt_hi : kt_lo;
    u32x4 kreg = (u32x4){0u, 0u, 0u, 0u}, vreg;
    {   const bf16* zr = P.Z + (rowbase + 64 * kt_first + srow) * ZW;
        if (sch < KCH) kreg = *(const u32x4*)(zr + KC + h * HW + sch * 8);
        vreg = *(const u32x4*)(zr + VC + h * 64 + sch * 8);
        LAS unsigned char* Kb = F.lds; LAS unsigned char* Vb = F.lds + 18432;
        if (sch < KCH) *(LAS u32x4*)(Kb + srow * 144 + sch * 16) = kreg;
        *(LAS u32x4*)(Vb + srow * 144 + sch * 16) = vreg; }
    __syncthreads();
    const int nit = kt_hi - kt_lo + 1;
    bool wave_done = false;
    for (int it = 0; it < nit; ++it) {
        const int kt = SOFT ? kt_hi - it : kt_lo + it, ktn = SOFT ? kt - 1 : kt + 1;
        const bool more = it + 1 < nit;
        if (more) { const bf16* zr = P.Z + (rowbase + 64 * ktn + srow) * ZW;
            if (sch < KCH) kreg = *(const u32x4*)(zr + KC + h * HW + sch * 8);
            vreg = *(const u32x4*)(zr + VC + h * 64 + sch * 8); }
        const int j0 = 64 * kt;
        const bool act = ((MODE == 3) ? (kt == 4 * qb + (w >> 1)) : (j0 <= qw0 + 31)) && !wave_done;
        if (act) {
            const LAS unsigned char* Kb = F.lds + (it & 1) * 9216; const LAS unsigned char* Vb = F.lds + 18432 + (it & 1) * 9216;
            unsigned mw = 0xffffffffu;
            if (MODE == 1) mw = P.MASK[((size_t)(b * 256 + qb * 8 + w) * 128 + kt) * 64 + lane];
            const bool hact1 = (j0 + 32 <= qw0 + 31);
#pragma unroll
            for (int m = 0; m < NMAP; ++m) {
                f32x16 st[2];
#pragma unroll
                for (int kh = 0; kh < 2; ++kh) {
                    if (kh == 0 || hact1) {
                        f32x16 a = cinit;
#pragma unroll
                        for (int s = 0; s < NS; ++s) { const bf16x8 kf = *(const LAS bf16x8*)(Kb + (32 * kh + r) * 144 + (m * 32 + 16 * s + 8 * hh) * 2); a = mfma32(kf, qf[m][s], a); }
                        if (j0 + 32 * kh + 31 > qw0) { const int lim = qw0 + r - j0 - 32 * kh - 4 * hh; asm volatile("; causal-mask block (kept a real branch: as selects it ran on every interior tile too)" ::: "memory");
#pragma unroll
                            for (int e = 0; e < 16; ++e) if (crow_c(e) > lim) a[e] = SOFT ? NEG : 0.f; }
                        if (MODE == 1) {
#pragma unroll
                            for (int e = 0; e < 16; ++e) if (!((mw >> (e + 16 * kh)) & 1u)) a[e] = NEG; }
                        st[kh] = a;
                    } else st[kh] = splat16(SOFT ? NEG : 0.f);
                }
                if (SOFT) {
                    const float off0 = slope2 * (float)(j0 - qw0 - r), off1 = off0 + 32.f * slope2;
                    float mx0 = st[0][0], mx1 = st[1][0];
#pragma unroll
                    for (int e = 1; e < 16; ++e) { mx0 = fmaxf(mx0, st[0][e]); mx1 = fmaxf(mx1, st[1][e]); }
                    float mx = fmaxf(mx0 + off0, mx1 + off1); mx = fmaxf(mx, shx(mx, lane, 32));
                    const float mn = fmaxf(m_run[m], mx); const float msafe = (mn == NEG) ? 0.f : mn;
                    const float alpha = __builtin_amdgcn_exp2f(m_run[m] - msafe); m_run[m] = mn;
                    const float d0 = off0 - msafe, d1 = off1 - msafe; float rs = 0.f;
#pragma unroll
                    for (int e = 0; e < 16; ++e) { const float p0 = __builtin_amdgcn_exp2f(st[0][e] + d0), p1 = __builtin_amdgcn_exp2f(st[1][e] + d1); st[0][e] = p0; st[1][e] = p1; rs += p0 + p1; }
                    rs += shx(rs, lane, 32); l_run[m] = l_run[m] * alpha + rs;
#pragma unroll
                    for (int e = 0; e < 16; ++e) { O[m][0][e] *= alpha; O[m][1][e] *= alpha; }
                }
#pragma unroll
                for (int kh = 0; kh < 2; ++kh) {
                    if (kh == 0 || hact1) {
#pragma unroll
                        for (int s = 0; s < 2; ++s) {
                            const bf16x8 pf = pack8(st[kh][8 * s], st[kh][8 * s + 1], st[kh][8 * s + 2], st[kh][8 * s + 3], st[kh][8 * s + 4], st[kh][8 * s + 5], st[kh][8 * s + 6], st[kh][8 * s + 7]);
#pragma unroll
                            for (int db = 0; db < 2; ++db) {
                                const LAS unsigned char* vp = Vb + (32 * kh + 16 * s + 4 * hh + ((lane & 15) >> 2)) * 144 + (32 * db + 16 * ((lane >> 4) & 1) + 4 * (lane & 3)) * 2;
                                const s16x4 lo = vtr(vp), hi = vtr(vp + 8 * 144);
                                const bf16x8 vf = (bf16x8){lo[0], lo[1], lo[2], lo[3], hi[0], hi[1], hi[2], hi[3]};
                                O[m][db] = mfma32(vf, pf, O[m][db]); } } } }
            }
            if (SOFT) {
                const float dist = slope2 * (float)(qw0 + r - (j0 - 1)); bool fin = true;
#pragma unroll
                for (int m = 0; m < NMAP; ++m) fin = fin && (qk[m] - dist - m_run[m] < -32.f);
                wave_done = (__ballot(fin) == ~0ull);
            }
        }
        if (SOFT && !wave_done && lane == 0) wflag[it % 3] = 1u;
        if (more) { LAS unsigned char* Kb = F.lds + ((it + 1) & 1) * 9216; LAS unsigned char* Vb = F.lds + 18432 + ((it + 1) & 1) * 9216;
            if (sch < KCH) *(LAS u32x4*)(Kb + srow * 144 + sch * 16) = kreg;
            *(LAS u32x4*)(Vb + srow * 144 + sch * 16) = vreg; }
        __syncthreads();
        if (SOFT) { const unsigned any = wflag[it % 3]; if (tid == 0) wflag[(it + 2) % 3] = 0u; if (any == 0u) break; }
    }
    const size_t orow = rowbase + qw0 + r;
    const int ycol = MODE * 256 + h * 64;
    f32x16 o[2];
    if (MODE == 0) { const float i0 = 1.f / l_run[0], i1 = P.lam / l_run[NMAP - 1];
#pragma unroll
        for (int db = 0; db < 2; ++db)
#pragma unroll
            for (int e = 0; e < 16; ++e) o[db][e] = O[0][db][e] * i0 - O[NMAP - 1][db][e] * i1; }
    else if (MODE == 1) { const float i0 = 1.f / l_run[0];
#pragma unroll
        for (int db = 0; db < 2; ++db)
#pragma unroll
            for (int e = 0; e < 16; ++e) o[db][e] = O[0][db][e] * i0; }
    else { o[0] = O[0][0]; o[1] = O[0][1]; }
    float mu = 0.f;
    if (MODE == 2) { float s = 0.f;
#pragma unroll
        for (int db = 0; db < 2; ++db)
#pragma unroll
            for (int e = 0; e < 16; ++e) s += o[db][e];
        s += shx(s, lane, 32); mu = s * (1.f / 64.f); }
    float ss = 0.f;
    if (MODE != 1) {
#pragma unroll
        for (int db = 0; db < 2; ++db)
#pragma unroll
            for (int e = 0; e < 16; ++e) { const float d = o[db][e] - mu; ss += d * d; }
        ss += shx(ss, lane, 32); }
    float rn = 1.f;
    if (MODE != 1) rn = 1.f / sqrtf(ss * (1.f / 64.f) + LN_EPS);
    if (MODE == 0) rn *= (1.f - P.lam_init);
#pragma unroll
    for (int db = 0; db < 2; ++db)
#pragma unroll
        for (int g4 = 0; g4 < 4; ++g4) { const int d0 = 32 * db + 8 * g4 + 4 * hh; float v[4];
#pragma unroll
            for (int i = 0; i < 4; ++i) v[i] = o[db][4 * g4 + i];
            if (MODE != 1) { const f32x4 nw = *(const f32x4*)(P.nw + (MODE == 2 ? h * 64 : 0) + d0);
#pragma unroll
                for (int i = 0; i < 4; ++i) v[i] = (v[i] - mu) * rn * nw[i]; }
            if (MODE >= 2) { const u32x2 gw = *(const u32x2*)(P.Z + orow * ZW + (MODE == 2 ? ZC_CG : ZC_DG) + h * 64 + d0);
                const float g0 = bflo(gw.x), g1 = bfhi(gw.x), g2 = bflo(gw.y), g3 = bfhi(gw.y);
                v[0] *= g0 * sigmoidf_(g0); v[1] *= g1 * sigmoidf_(g1); v[2] *= g2 * sigmoidf_(g2); v[3] *= g3 * sigmoidf_(g3); }
            u32x2 ow; ow.x = pk2(v[0], v[1]); ow.y = pk2(v[2], v[3]);
            *(u32x2*)(P.Y + orow * DM + ycol + d0) = ow; }
}
}

constexpr int PH_PER_LAYER = 12, N_PHASES = 1 + DEPTH * PH_PER_LAYER;

typedef __attribute__((address_space(4))) const Args* KArgP;
#ifdef ONLY_SITE
#define SITE(s) ((s) == ONLY_SITE)
#else
#define SITE(s) true
#endif
#if MK_ONE_LAUNCH
#define IN(k) true
#define SEAM(k) do { if ((k) + 1 < N_PHASES) { XcdBarrier b2_ = bar; asm volatile("" : "+s"(b2_.bar), "+s"(b2_.x)); xcd_barrier(b2_, F.tid == 0); } } while (0)
#else
#define IN(k) (lo <= (k) && (k) < hi)
#define SEAM(k) do { } while (0)
#endif
#define SITE_BEGIN KArgP KA = (KArgP)__builtin_amdgcn_kernarg_segment_ptr(); do { asm volatile("" : "+s"(KA)); \
        int ln_; asm volatile("v_mbcnt_lo_u32_b32 %0, -1, 0\n\tv_mbcnt_hi_u32_b32 %0, -1, %0" : "=v"(ln_)); \
        const unsigned simd_ = (unsigned)__builtin_amdgcn_s_getreg(((2 - 1) << 11) | (4 << 6) | 4);   \
        unsigned tk_ = 0u, tg_ = 0u; if (ln_ == 0) { tk_ = __hip_atomic_fetch_add((LAS unsigned*)(F.lds + MISC_OFF + 64) + simd_, 1u, __ATOMIC_RELAXED, __HIP_MEMORY_SCOPE_WORKGROUP); \
            tg_ = __hip_atomic_fetch_add((LAS unsigned*)(F.lds + MISC_OFF + 96), 1u, __ATOMIC_RELAXED, __HIP_MEMORY_SCOPE_WORKGROUP); } \
        F.wave = __builtin_amdgcn_readfirstlane(simd_balanced ? (int)(simd_ + 4u * (tk_ & 1u)) : (int)(tg_ & 7u)); F.lane = ln_; F.tid = F.wave * 64 + F.lane; \
        F.ws = KA->ws; F.dob = (unsigned char*)KA->out; F.G = G0; F.wg = wg0; asm volatile("" : "+s"(F.G), "+s"(F.wg)); } while (0)


__global__ void __launch_bounds__(NWAVES * 64, 2) fwd_kernel(Args args) {
    extern __shared__ __attribute__((aligned(16))) unsigned char lds_raw[];
    Frame F;
    F.lds = (LAS unsigned char*)lds_raw;
    F.tid = threadIdx.x; F.lane = F.tid & 63; F.wave = __builtin_amdgcn_readfirstlane(F.tid >> 6);
    F.G = gridDim.x; F.wg = blockIdx.x;
    F.ws = args.ws; F.dob = (unsigned char*)args.out;
    volatile LAS unsigned* MISC = (volatile LAS unsigned*)(F.lds + MISC_OFF);
    if (F.tid < 32) MISC[F.tid] = 0u;
    __syncthreads();
    if (F.lane == 0) __hip_atomic_fetch_add((LAS unsigned*)(F.lds + MISC_OFF + 112) + ((unsigned)__builtin_amdgcn_s_getreg(((2 - 1) << 11) | (4 << 6) | 4)), 1u, __ATOMIC_RELAXED, __HIP_MEMORY_SCOPE_WORKGROUP);
    __syncthreads();
    const bool simd_balanced = (MISC[28] == 2u) && (MISC[29] == 2u) && (MISC[30] == 2u) && (MISC[31] == 2u);
    unsigned* ctl = (unsigned*)(F.ws + WS_CTL);
    XcdBarrier bar; bar.bar = ctl + CW_BAR; bar.x = 0; bar.st = nullptr;
#if MK_ONE_LAUNCH
    bar = xcd_barrier_post(ctl + CW_BAR, MISC + 8);
#endif
    const int lo = args.ph_lo, hi = args.ph_hi, subm = args.sub;
    const int G0 = F.G, wg0 = F.wg;
    if (SITE(0) && IN(0)) { SITE_BEGIN; p0_prologue(F, KA); SEAM(0); }

    for (int l = 0; l < DEPTH; ++l) {
        const int pb = 1 + l * PH_PER_LAYER;
        if (SITE(1) && IN(pb + 0)) { SITE_BEGIN; const char* XBc = (const char*)(F.ws + WS_XB); (void)XBc; const unsigned char* w123 = F.ws + WS_W123; const unsigned char* w45 = F.ws + WS_W45 + (size_t)l * W45_STRIDE; (void)w123; (void)w45;
            pg8::EpiStore E{(bf16*)(F.ws + WS_Z), ZW};
            {   pg8::SchedTiles S{XBc, (const char*)(w123 + W123_W1), 2048, 2048, 16, 6, G1_BF_TILES, 0, F.G, F.wg};
                { int tl_ = F.tid; asm volatile("" : "+v"(tl_)); pg8::gemm_phase(F.lds, S, E, tl_); } }
            {   pg8::SchedTiles S{(const char*)(F.dob + DO_XB8), (const char*)(F.dob + DO_W8 + (size_t)l * W8_STRIDE + W8_Z), 1024, 1024, 8, 8, G1_F8_TILES, 1, F.G, F.wg};
                { int tl_ = F.tid; asm volatile("" : "+v"(tl_)); pg8::gemm_phase<pg8::EpiStore, pg8::SchedTiles, true>(F.lds, S, E, tl_); } }
            SEAM(pb + 0);
        }
        if (SITE(2) && IN(pb + 1)) { SITE_BEGIN; const char* XBc = (const char*)(F.ws + WS_XB); (void)XBc; const unsigned char* w123 = F.ws + WS_W123; const unsigned char* w45 = F.ws + WS_W45 + (size_t)l * W45_STRIDE; (void)w123; (void)w45;
            {   unsigned* head = (unsigned*)(F.ws + WS_CTL) + CW_WQ + l * 64 + 32;
                for (;;) { const int i = mx::wq_next(F, head); if (i >= 128 + 1024) break;
                    if (i < 128) { if (subm & 2) mx::prepkv_unit(F, i, KA->in[6] + (size_t)l * 16 * 128, KA->in[7] + l * 128, (unsigned*)(F.ws + WS_CTL) + CW_KMAX + l * 64); }
                    else if (subm & 1) { const int u = i - 128; mx::b1_unit(F, u & 3, 255 - (u >> 2)); } } }
            SEAM(pb + 1);
        }
        if (SITE(3) && IN(pb + 2)) { SITE_BEGIN; const char* XBc = (const char*)(F.ws + WS_XB); (void)XBc; const unsigned char* w123 = F.ws + WS_W123; const unsigned char* w45 = F.ws + WS_W45 + (size_t)l * W45_STRIDE; (void)w123; (void)w45;
            if (subm & 1) mx::scan_phase(F);
            float lam_init = 0.8f - 0.6f * __expf(-0.3f * (float)l);
            const float* lp = KA->in[3] + l * 128; float s01 = 0.f, s23 = 0.f;
            for (int i = 0; i < 32; ++i) { s01 += lp[i] * lp[32 + i]; s23 += lp[64 + i] * lp[96 + i]; }
            mx::EngP P{(const bf16*)(F.ws + WS_Z), (bf16*)(F.ws + WS_Y), nullptr, nullptr, KA->in[4] + l * 64, __expf(s01) - __expf(s23) + lam_init, lam_init, (const unsigned*)(F.ws + WS_CTL) + CW_KMAX + l * 64};
            {   unsigned* head = (unsigned*)(F.ws + WS_CTL) + CW_WQ + l * 64;
                for (;;) { const int i = mx::wq_next(F, head); if (i >= 512) break; const int j = i & 127; mx::eng_unit<0>(F, P, j & 3, 3 - (i >> 7), 31 - (j >> 2)); } }
            SEAM(pb + 2);
        }
        if (SITE(4) && IN(pb + 3)) { SITE_BEGIN; const char* XBc = (const char*)(F.ws + WS_XB); (void)XBc; const unsigned char* w123 = F.ws + WS_W123; const unsigned char* w45 = F.ws + WS_W45 + (size_t)l * W45_STRIDE; (void)w123; (void)w45;
            {   unsigned* head = (unsigned*)(F.ws + WS_CTL) + CW_WQ + l * 64 + 16;
                const mx::EngP PB{(const bf16*)(F.ws + WS_Z), (bf16*)(F.ws + WS_Y), (const unsigned*)(F.ws + WS_MASK), nullptr, nullptr, 0.f, 0.f, (const unsigned*)(F.ws + WS_CTL) + CW_KMAX + l * 64};
                const mx::EngP PC{(const bf16*)(F.ws + WS_Z), (bf16*)(F.ws + WS_Y), nullptr, (const float*)(F.ws + WS_KVC), KA->in[5] + l * 256, 0.f, 0.f, nullptr};
                const mx::EngP PD{(const bf16*)(F.ws + WS_Z), (bf16*)(F.ws + WS_Y), nullptr, (const float*)(F.ws + WS_KVD), KA->in[8] + l * 64, 0.f, 0.f, nullptr};
                for (;;) { const int i = mx::wq_next(F, head); if (i >= 1536) break;
                    if (i < 512) { if (subm & 1) { const int j = i & 127; mx::eng_unit<1>(F, PB, j & 3, 3 - (i >> 7), 31 - (j >> 2)); } }
                    else if (!(subm & (i < 1024 ? 2 : 4))) continue;
                    else if (i < 1024) { const int u = i - 512; mx::eng_unit<2>(F, PC, u >> 7, (u >> 5) & 3, u & 31); }
                    else { const int u = i - 1024; mx::eng_unit<3>(F, PD, u >> 7, (u >> 5) & 3, u & 31); } } }
            SEAM(pb + 3);
        }
        if (SITE(5) && IN(pb + 4)) { SITE_BEGIN;
            const unsigned char* w123 = F.ws + WS_W123;
            for (int n = 0; n < 4; ++n) {
                {   pg8::SchedPlain S{(const char*)(F.dob + DO_XB8), (const char*)(F.dob + DO_W8 + (size_t)l * W8_STRIDE + W8_G) + (size_t)n * 1024 * 1024, 1024, 1024, 8, 128, 4, F.G, F.wg};
                    pg8::EpiSlotStore E{F.ws + WS_SCR2 + (size_t)F.wg * 262144, 1};
                    { int tl_ = F.tid; asm volatile("" : "+v"(tl_)); pg8::gemm_phase<pg8::EpiSlotStore, pg8::SchedPlain, true>(F.lds, S, E, tl_); } }
                {   pg8::SchedPlain S{(const char*)(F.ws + WS_Y) + n * 512, (const char*)(w123 + W123_GB + 8 * MiB) + (size_t)n * 1024 * 512, 2048, 512, 4, 128, 4, F.G, F.wg};
                    pg8::EpiBranch E{F.ws + WS_SCR2 + (size_t)F.wg * 262144, (bf16*)(F.ws + WS_MERGED), n == 0};
                    { int tl_ = F.tid; asm volatile("" : "+v"(tl_)); pg8::gemm_phase(F.lds, S, E, tl_); } }
            }
            SEAM(pb + 4);
        }
        if (SITE(6) && IN(pb + 5)) { SITE_BEGIN; const char* XBc = (const char*)(F.ws + WS_XB); (void)XBc; const unsigned char* w123 = F.ws + WS_W123; const unsigned char* w45 = F.ws + WS_W45 + (size_t)l * W45_STRIDE; (void)w123; (void)w45;
            pg8::SchedPlain S{(const char*)(F.ws + WS_MERGED), (const char*)(w123 + W123_WO), 2048, 2048, 16, 128, 4, F.G, F.wg};
            pg8::EpiG3 E{(bf16*)(F.ws + WS_XB)};
            pg8::gemm_phase(F.lds, S, E, F.tid);
            SEAM(pb + 5);
        }
        if (SITE(7) && IN(pb + 6)) { SITE_BEGIN; const char* XBc = (const char*)(F.ws + WS_XB); (void)XBc; const unsigned char* w123 = F.ws + WS_W123; const unsigned char* w45 = F.ws + WS_W45 + (size_t)l * W45_STRIDE; (void)w123; (void)w45; ln_phase(F, KA->in[11] + l * DM, KA->in[12] + l * DM, nullptr, F.dob + DO_XB8);
            if (l + 1 < DEPTH) convert_w123(F, KA->in[2] + (size_t)(l + 1) * DM * NIN, KA->in[9] + (size_t)(l + 1) * 4 * 256 * DM, KA->in[10] + (size_t)(l + 1) * DM * DM);
            SEAM(pb + 6); }
        if (SITE(8) && IN(pb + 7)) { SITE_BEGIN; const char* XBc = (const char*)(F.ws + WS_XB); (void)XBc; const unsigned char* w123 = F.ws + WS_W123; const unsigned char* w45 = F.ws + WS_W45 + (size_t)l * W45_STRIDE; (void)w123; (void)w45;
            pg8::SchedPlain S{(const char*)(F.dob + DO_XB8), (const char*)(F.dob + DO_W8 + (size_t)l * W8_STRIDE + W8_UP), 1024, 1024, 8, 128, 22, F.G, F.wg};
            pg8::EpiStore E{(bf16*)(F.ws + WS_UG), UGW};
            pg8::gemm_phase<pg8::EpiStore, pg8::SchedPlain, true>(F.lds, S, E, F.tid);
            SEAM(pb + 7);
        }
        if (SITE(9) && IN(pb + 8)) { SITE_BEGIN; const char* XBc = (const char*)(F.ws + WS_XB); (void)XBc; const unsigned char* w123 = F.ws + WS_W123; const unsigned char* w45 = F.ws + WS_W45 + (size_t)l * W45_STRIDE; (void)w123; (void)w45; ffn_act_phase(F, KA->in[14] + (size_t)l * 3 * DFF, KA->in[15] + (size_t)l * DFF); SEAM(pb + 8); }
        if (SITE(10) && IN(pb + 9)) { SITE_BEGIN;
            const unsigned char* w45 = F.ws + WS_W45 + (size_t)l * W45_STRIDE;
            {   pg8::SchedPlain S{(const char*)(F.ws + WS_PB + (size_t)l * M * PDIM * 2), (const char*)(w45 + W45_PP), 512, 512, 4, 128, 4, F.G, F.wg};
                pg8::EpiSlotStore E{F.dob + DO_SCR5 + (size_t)F.wg * 262144, 0};
                { int tl_ = F.tid; asm volatile("" : "+v"(tl_)); pg8::gemm_phase(F.lds, S, E, tl_); } }
            {   pg8::SchedPlain S{(const char*)(F.dob + DO_XB8), (const char*)(F.dob + DO_W8 + (size_t)l * W8_STRIDE + W8_PG), 1024, 1024, 8, 128, 4, F.G, F.wg};
                pg8::EpiSlotMul E{F.dob + DO_SCR5 + (size_t)F.wg * 262144};
                { int tl_ = F.tid; asm volatile("" : "+v"(tl_)); pg8::gemm_phase<pg8::EpiSlotMul, pg8::SchedPlain, true>(F.lds, S, E, tl_); } }
            SEAM(pb + 9);
        }
        if (SITE(11) && IN(pb + 10)) { SITE_BEGIN;
            const unsigned char* w45 = F.ws + WS_W45 + (size_t)l * W45_STRIDE;
            pg8::SchedG5b S{(const char*)(F.ws + WS_UG), (const char*)(F.dob + DO_W8 + (size_t)l * W8_STRIDE + W8_DN), F.G, F.wg};
            pg8::EpiG5b E{F.dob + DO_SCR5 + (size_t)F.wg * 262144, (bf16*)(F.ws + WS_XB)};
            pg8::gemm_phase<pg8::EpiG5b, pg8::SchedG5b, true>(F.lds, S, E, F.tid);
            SEAM(pb + 10);
        }
        if (SITE(12) && IN(pb + 11)) { SITE_BEGIN; const char* XBc = (const char*)(F.ws + WS_XB); (void)XBc; const unsigned char* w123 = F.ws + WS_W123; const unsigned char* w45 = F.ws + WS_W45 + (size_t)l * W45_STRIDE; (void)w123; (void)w45; ln_phase(F, KA->in[19] + l * DM, KA->in[20] + l * DM, l == DEPTH - 1 ? KA->out : nullptr, l == DEPTH - 1 ? nullptr : F.dob + DO_XB8); SEAM(pb + 11); }
    }
#undef IN
#undef SEAM
}

extern "C" void kernel_launch(void* const* d_in, const int* in_sizes, int n_in, void* d_out, int out_size, void* d_ws, size_t ws_size, hipStream_t stream) {
    static int grid = 0;
    if (grid == 0) {
        if (n_in != 21 || out_size != M * DM || ws_size < WS_END) { fprintf(stderr, "kernel_launch: unexpected shapes (n_in %d out %d ws %zu)\n", n_in, out_size, ws_size); grid = -1; return; }
        int dev = 0, cus = 0, per_cu = 0;
        if (hipGetDevice(&dev) != hipSuccess || hipDeviceGetAttribute(&cus, hipDeviceAttributeMultiprocessorCount, dev) != hipSuccess) { grid = -1; return; }
        if (hipFuncSetAttribute((const void*)fwd_kernel, hipFuncAttributeMaxDynamicSharedMemorySize, LDS_BYTES) != hipSuccess) { grid = -1; return; }
        if (hipOccupancyMaxActiveBlocksPerMultiprocessor(&per_cu, (const void*)fwd_kernel, NWAVES * 64, LDS_BYTES) != hipSuccess || per_cu < 1)
            fprintf(stderr, "kernel_launch: occupancy query reports %d\n", per_cu);
        (void)hipGetLastError();
        grid = cus;
    }
    if (grid < 0) return;
    (void)hipMemsetAsync((char*)d_ws + WS_CTL, 0, CTL_ZERO_BYTES, stream);
    Args a{};
    for (int i = 0; i < 21; ++i) a.in[i] = (const float*)d_in[i];
    a.out = (float*)d_out; a.ws = (unsigned char*)d_ws;
#if MK_ONE_LAUNCH
    a.ph_lo = 0; a.ph_hi = N_PHASES; a.sub = 7;
    hipLaunchKernelGGL(fwd_kernel, dim3(grid), dim3(NWAVES * 64), LDS_BYTES, stream, a);
#else
    for (int p = 0; p < N_PHASES; ++p) { a.ph_lo = p; a.ph_hi = p + 1; a.sub = 7;
        hipLaunchKernelGGL(fwd_kernel, dim3(grid), dim3(NWAVES * 64), LDS_BYTES, stream, a);
#ifdef PROBE_PHASE
        if (p >= 1 && (p - 1) % PH_PER_LAYER == PROBE_PHASE) { (void)hipMemsetAsync((char*)d_ws + WS_CTL + CW_WQ * 4, 0, 1024, stream); a.sub = PROBE_SUB;
            hipLaunchKernelGGL(fwd_kernel, dim3(grid), dim3(NWAVES * 64), LDS_BYTES, stream, a); }
#endif
    }
#endif
}
```

```cpp
#include <hip/hip_runtime.h>
#include <cstdio>
#include <cstdint>

#ifndef MK_ONE_LAUNCH
#define MK_ONE_LAUNCH 1
#endif

#define GAS __attribute__((address_space(1)))
#define LAS __attribute__((address_space(3)))
typedef unsigned short bf16;
typedef unsigned u32x4 __attribute__((ext_vector_type(4)));
typedef unsigned u32x2 __attribute__((ext_vector_type(2)));
typedef float f32x2 __attribute__((ext_vector_type(2)));
typedef float f32x4 __attribute__((ext_vector_type(4)));
typedef float f32x16 __attribute__((ext_vector_type(16)));
typedef short bf16x8 __attribute__((ext_vector_type(8)));
typedef short s16x4 __attribute__((ext_vector_type(4)));
typedef GAS unsigned gu32;

constexpr int BATCH = 4, SEQ = 8192, DM = 1024, M = BATCH * SEQ, DEPTH = 2;
constexpr int NIN = 7604, ZW = 3584, DFF = 2816, UGW = 5632, PDIM = 256;
constexpr float LN_EPS = 1e-5f;
constexpr float ALPHA = 1.41421356237f;
constexpr float LOG2E = 1.4426950408889634f;
constexpr int ZC_AQ = 0, ZC_AK = 256, ZC_AV = 512, ZC_BQ = 768, ZC_BK = 1024, ZC_BV = 1280, ZC_CQ = 1536, ZC_CK = 1792, ZC_CV = 2048, ZC_CG = 2304,
              ZC_DQ = 2560, ZC_DK = 2688, ZC_DV = 2816, ZC_DG = 3072, ZC_IQ = 3328, ZC_IK = 3456, ZC_IW = 3488, ZC_DA = 3504;
constexpr int SRC_MG = 3508;

constexpr size_t MiB = 1u << 20;
constexpr size_t WS_CTL = 0, CTL_ZERO_BYTES = 1 * MiB;
constexpr size_t WS_XB = 1 * MiB;
constexpr size_t WS_BIG = 65 * MiB;
constexpr size_t WS_Z = WS_BIG, WS_Y = WS_BIG + 224 * MiB, WS_MERGED = WS_BIG + 288 * MiB, WS_UG = WS_BIG;
constexpr size_t WS_MASK = WS_MERGED, WS_KVC = WS_MERGED + 32 * MiB, WS_KVD = WS_MERGED + 40 * MiB, WS_DE = WS_MERGED + 56 * MiB;
constexpr size_t WS_SCR2 = WS_Z;
constexpr size_t WS_W45 = 417 * MiB, W45_STRIDE = 19 * MiB;
constexpr size_t W45_UP = 0, W45_PG = 11 * MiB, W45_PP = 13 * MiB, W45_DN = 13 * MiB + 512 * 1024;
constexpr size_t WS_PB = 455 * MiB;
constexpr size_t WS_W123 = 487 * MiB;
constexpr size_t WS_END = 506 * MiB;
constexpr size_t W123_W1 = 0, W123_GB = 7 * MiB, W123_WO = 17 * MiB;
constexpr size_t DO_SCR5 = 0;
constexpr size_t DO_XB8 = 64 * MiB;
constexpr size_t DO_W8 = 96 * MiB, W8_STRIDE = 15 * MiB + 256 * 1024, W8_G = 0, W8_UP = 4 * MiB, W8_PG = 9 * MiB + 512 * 1024, W8_DN = 10 * MiB + 512 * 1024, W8_Z = 13 * MiB + 256 * 1024;
constexpr unsigned long long G1_F8_TILES = 0xCB987652ull, G1_BF_TILES = 0xDA4310ull;

constexpr int CW_BAR = 4096, CW_WQ = 8448  , CW_KMAX = 8192;

constexpr int RING_BYTES = 131072;
constexpr int MISC_OFF = 131072 + 320;
constexpr int QST_OFF = 132096;
constexpr int LDS_BYTES = 147456;

constexpr int NWAVES = 8;

#define RLX_AGENT __ATOMIC_RELAXED, __HIP_MEMORY_SCOPE_AGENT
__device__ __forceinline__ unsigned f2bf(float f) { unsigned u = __builtin_bit_cast(unsigned, f); return (u + 0x7fffu + ((u >> 16) & 1u)) >> 16; }
typedef __bf16 bf16x2_t __attribute__((ext_vector_type(2)));
__device__ __forceinline__ unsigned pk2(float lo, float hi) { const f32x2 v = {lo, hi}; const bf16x2_t b = __builtin_convertvector(v, bf16x2_t); return __builtin_bit_cast(unsigned, b); }
__device__ __forceinline__ unsigned pk4f8(float a, float b, float c, float d) { int p = __builtin_amdgcn_cvt_pk_fp8_f32(a, b, 0, false); p = __builtin_amdgcn_cvt_pk_fp8_f32(c, d, p, true); return (unsigned)p; }
__device__ __forceinline__ float bflo(unsigned w) { return __uint_as_float(w << 16); }
__device__ __forceinline__ float bfhi(unsigned w) { return __uint_as_float(w & 0xffff0000u); }
__device__ __forceinline__ float bf1(bf16 b) { return __uint_as_float((unsigned)b << 16); }
__device__ __forceinline__ float sigmoidf_(float x) { return __builtin_amdgcn_rcpf(1.0f + __builtin_amdgcn_exp2f(-LOG2E * x)); }
__device__ __forceinline__ float shx(float v, int lane, int m) { return __int_as_float(__builtin_amdgcn_ds_bpermute((lane ^ m) << 2, __float_as_int(v))); }
__device__ __forceinline__ unsigned shup(unsigned v, int lane, int o) { return (unsigned)__builtin_amdgcn_ds_bpermute((lane - o) << 2, (int)v); }
__device__ __forceinline__ float wave_sum(float v, int lane) {
#pragma unroll
    for (int o = 1; o < 64; o <<= 1) v += shx(v, lane, o);
    return v;
}

#define XB_TMO      128
#define XB_XCNT(j)  (256  + 64 * (j))
#define XB_XSUB(j)  (1280 + 64 * (j))
#define XB_XGEN(j)  (2304 + 64 * (j))
#define XB_TOP      3328
#define XB_TOPGEN   3392
#define XCD_BAR_WORDS 3456
#define XB_SPIN_CAP (1u << 22)

__device__ __forceinline__ unsigned xb_ld(unsigned* p)              { return __hip_atomic_load(p, __ATOMIC_RELAXED, __HIP_MEMORY_SCOPE_AGENT); }
__device__ __forceinline__ unsigned xb_add(unsigned* p, unsigned v) { return __hip_atomic_fetch_add(p, v, __ATOMIC_RELAXED, __HIP_MEMORY_SCOPE_AGENT); }
__device__ __forceinline__ unsigned xb_xcc_id() { return (unsigned)__builtin_amdgcn_s_getreg((3 << 11) | 20) & 0xFu; }
#define XB_SPIN(cond, bar) do { unsigned _sp = 0; while (cond) { __builtin_amdgcn_s_sleep(1); \
    if ((++_sp & 255u) == 0u) { if (xb_ld(&(bar)[XB_TMO])) break; if (_sp > XB_SPIN_CAP) { atomicAdd(&(bar)[XB_TMO], 1u); break; } } } } while (0)

struct XcdBarrier { unsigned* bar; unsigned x; volatile LAS unsigned* st; };

__device__ __forceinline__ XcdBarrier xcd_barrier_post(unsigned* bar, volatile LAS unsigned* st) {
    XcdBarrier b; b.bar = bar; b.x = xb_xcc_id(); b.st = st;
    if (threadIdx.x == 0) (void)xb_add(&bar[XB_XCNT(b.x)], 1u);
    return b;
}
__device__ __forceinline__ void xcd_barrier_complete(unsigned* bar, unsigned x, unsigned& nloc, unsigned& nx) {
    const unsigned G = gridDim.x * gridDim.y * gridDim.z;
    unsigned sum, cnt, mine, sp = 0u;
    for (;;) {
        sum = 0u; cnt = 0u; mine = 0u;
#pragma unroll
        for (unsigned j = 0; j < 16; ++j) { const unsigned c = xb_ld(&bar[XB_XCNT(j)]); sum += c; cnt += (c > 0u) ? 1u : 0u; mine = (j == x) ? c : mine; }
        if (sum == G) break;
        __builtin_amdgcn_s_sleep(1);
        if ((++sp & 255u) == 0u) { if (xb_ld(&bar[XB_TMO])) break; if (sp > XB_SPIN_CAP) { atomicAdd(&bar[XB_TMO], 1u); break; } }
    }
    nloc = mine > 0u ? mine : 1u; nx = cnt > 0u ? cnt : 1u;
}
__device__ __forceinline__ void xcd_barrier(const XcdBarrier& b, const bool leader_thread) {
    asm volatile("s_waitcnt vmcnt(0)" ::: "memory");
    __syncthreads();
    if (leader_thread) {
        unsigned* bar = b.bar;
        __builtin_amdgcn_s_waitcnt(0);
        unsigned nloc = b.st[0], nx = b.st[1];
        if (nloc == 0u) { xcd_barrier_complete(bar, b.x, nloc, nx); b.st[0] = nloc; b.st[1] = nx; }
        const unsigned old = xb_add(&bar[XB_XSUB(b.x)], 1u);
        const unsigned gen = old / nloc;
        if (old + 1u == (gen + 1u) * nloc) {
            __builtin_amdgcn_fence(__ATOMIC_RELEASE, "agent");
            asm volatile("s_waitcnt vmcnt(0)" ::: "memory");
            const unsigned og = xb_add(&bar[XB_TOP], 1u);
            const unsigned tg = og / nx;
            if (og + 1u == (tg + 1u) * nx) xb_add(&bar[XB_TOPGEN], 1u);
            else XB_SPIN(xb_ld(&bar[XB_TOPGEN]) == tg, bar);
            __builtin_amdgcn_fence(__ATOMIC_ACQUIRE, "agent");
            xb_add(&bar[XB_XGEN(b.x)], 1u);
            asm volatile("s_waitcnt vmcnt(0)" ::: "memory");
        } else {
            XB_SPIN(xb_ld(&bar[XB_XGEN(b.x)]) == gen, bar);
            __builtin_amdgcn_fence(__ATOMIC_ACQUIRE, "agent");
            asm volatile("s_waitcnt vmcnt(0)" ::: "memory");
        }
    }
    __syncthreads();
}

namespace pg8 {
constexpr int BM = 256, BK = 64, HALF = 128, HTB = HALF * BK * 2, STAGE_BYTES = 8 * HTB, NXCD = 8, WGM = 8;
__device__ __forceinline__ int lds_byte(int r, int c) { const int st = (r >> 4) * 2 + (c >> 5), rr = r & 15, cc = c & 31, ob = rr * 64 + cc * 2; return st * 1024 + (ob ^ (((ob >> 9) & 1) << 5)); }
__device__ __forceinline__ void stage_rc(int b, int& R, int& C) { const int st = b / 1024, sb = b % 1024, swz = sb ^ (((sb >> 9) & 1) << 5); R = (st >> 1) * 16 + swz / 64; C = (st & 1) * 32 + (swz % 64) / 2; }
__device__ __forceinline__ int perm32(int rho) { const int n = rho >> 4, i = rho & 15; return 8 * (i >> 2) + 4 * n + (i & 3); }

struct UnitD { const char* A; const char* B; int lda2, ldb2, nt, pm, pn, kind; };

__device__ __forceinline__ void tile_map(int L, int nM, int nN, int& pm, int& pn) {
    const int nwg = nM * nN; int wgid = L;
    { const int q = nwg / NXCD, r = nwg % NXCD, xcd = wgid % NXCD, off = wgid / NXCD; wgid = (xcd < r ? xcd * (q + 1) : r * (q + 1) + (xcd - r) * q) + off; }
    const int nig = WGM * nN, gid = wgid / nig, fm = gid * WGM, gsz = (nM - fm) < WGM ? (nM - fm) : WGM;
    pm = fm + ((wgid % nig) % gsz); pn = (wgid % nig) / gsz;
}

typedef int i32x8 __attribute__((ext_vector_type(8)));
template <class Epi, class Sched, bool FP8 = false>
__device__ __forceinline__ void gemm_phase(LAS unsigned char* lds, const Sched& S, const Epi& E, const int tid) {
    const int wid = __builtin_amdgcn_readfirstlane(tid >> 6), lane = tid & 63, wr = wid >> 2, wc = wid & 3, fr = lane & 15, fq = lane >> 4;
    int sR, sRb, sC2;
    { int R, C; stage_rc(tid * 16, R, C); sR = R; sRb = (R & ~31) + perm32(R & 31); sC2 = C * 2; }
    const size_t kstep = (size_t)(BK * 2);
    const unsigned ldsw = (unsigned)wid * 1024u;
    const int aoff = lds_byte(wr * 64 + fr, FP8 ? fq * 16 : fq * 8), boff = lds_byte(wc * 32 + fr, FP8 ? fq * 16 : fq * 8);
#define PG8_SA(b, h) (((b) * 2 + (h)) * HTB)
#define PG8_SB(b, h) ((4 + (b) * 2 + (h)) * HTB)
#define PG8_STAGE(bufoff, gbase, rows, pitch) do { const unsigned _o = (unsigned)((rows) * (pitch) + sC2); _Pragma("unroll") for (int _i = 0; _i < 2; ++_i) \
        __builtin_amdgcn_global_load_lds((const unsigned*)((const char*)(gbase) + (size_t)(_i * 64) * (pitch) + _o), (LAS unsigned*)(lds + (bufoff) + ldsw + _i * 8192), 16, 0, 0); } while (0)
#define PG8_LDA(dst, b, h) do { if constexpr (FP8) { _Pragma("unroll") for (int m = 0; m < 4; ++m) { const u32x4 lo_ = *(const LAS u32x4*)(lds + PG8_SA(b, h) + aoff + m * 2048), hi_ = *(const LAS u32x4*)(lds + PG8_SA(b, h) + aoff + m * 2048 + 16); \
            dst##8[m] = (i32x8){(int)lo_.x, (int)lo_.y, (int)lo_.z, (int)lo_.w, (int)hi_.x, (int)hi_.y, (int)hi_.z, (int)hi_.w}; } } \
        else { _Pragma("unroll") for (int m = 0; m < 4; ++m) _Pragma("unroll") for (int k = 0; k < 2; ++k) dst[m][k] = *(const LAS bf16x8*)(lds + PG8_SA(b, h) + aoff + m * 2048 + k * 1024); } } while (0)
#define PG8_LDB(dst, b, h) do { if constexpr (FP8) { _Pragma("unroll") for (int n = 0; n < 2; ++n) { const u32x4 lo_ = *(const LAS u32x4*)(lds + PG8_SB(b, h) + boff + n * 2048), hi_ = *(const LAS u32x4*)(lds + PG8_SB(b, h) + boff + n * 2048 + 16); \
            dst##8[n] = (i32x8){(int)lo_.x, (int)lo_.y, (int)lo_.z, (int)lo_.w, (int)hi_.x, (int)hi_.y, (int)hi_.z, (int)hi_.w}; } } \
        else { _Pragma("unroll") for (int n = 0; n < 2; ++n) _Pragma("unroll") for (int k = 0; k < 2; ++k) dst[n][k] = *(const LAS bf16x8*)(lds + PG8_SB(b, h) + boff + n * 2048 + k * 1024); } } while (0)
#define PG8_MMA(ai, bj, At, Bt) do { __builtin_amdgcn_s_setprio(1); if constexpr (FP8) { _Pragma("unroll") for (int m = 0; m < 4; ++m) _Pragma("unroll") for (int n = 0; n < 2; ++n) \
            asm volatile("v_mfma_scale_f32_16x16x128_f8f6f4 %0, %1, %2, %0, %3, %3 op_sel_hi:[0,0,0]" : "+v"(acc[ai][bj][m][n]) : "v"(Bt##8[n]), "v"(At##8[m]), "v"(scl8)); } \
        else { _Pragma("unroll") for (int m = 0; m < 4; ++m) _Pragma("unroll") for (int n = 0; n < 2; ++n) _Pragma("unroll") for (int k = 0; k < 2; ++k) \
            acc[ai][bj][m][n] = __builtin_amdgcn_mfma_f32_16x16x32_bf16(Bt[n][k], At[m][k], acc[ai][bj][m][n], 0, 0, 0); } __builtin_amdgcn_s_setprio(0); } while (0)
#define PG8_WAIT_V(n) asm volatile("s_waitcnt vmcnt(" #n ")" ::: "memory")
#define PG8_WAIT_L(n) asm volatile("s_waitcnt lgkmcnt(" #n ")" ::: "memory")
#define PG8_BAR __builtin_amdgcn_s_barrier()
#define PG8_SCHED __builtin_amdgcn_sched_barrier(0)
    UnitD cur, nxt; int ui = 0;
    if (!S.next(0, cur)) return;
    f32x4 acc[2][2][4][2];
#pragma unroll
    for (int a = 0; a < 2; ++a)
#pragma unroll
        for (int b = 0; b < 2; ++b)
#pragma unroll
            for (int m = 0; m < 4; ++m)
#pragma unroll
                for (int n = 0; n < 2; ++n) acc[a][b][m][n] = (f32x4){0.f, 0.f, 0.f, 0.f};
    bf16x8 At[4][2], B0[2][2], B1[2][2]; i32x8 At8[4], B08[2], B18[2];
    int scl8 = 0x7c7c7c7c; asm volatile("" : "+v"(scl8));
    const char* cA = cur.A; const char* cB = cur.B;
    int pA = cur.lda2, pB = cur.ldb2;
    PG8_STAGE(PG8_SB(0, 0), cB, sRb, pB); PG8_STAGE(PG8_SB(0, 1), cB + (size_t)HALF * pB, sRb, pB); PG8_STAGE(PG8_SA(0, 0), cA, sR, pA); PG8_STAGE(PG8_SA(0, 1), cA + (size_t)HALF * pA, sR, pA);
    if (wr == 1) PG8_BAR;
    PG8_WAIT_V(2); PG8_BAR;
    PG8_STAGE(PG8_SB(1, 0), cB + kstep, sRb, pB); PG8_STAGE(PG8_SA(1, 0), cA + kstep, sR, pA); PG8_STAGE(PG8_SB(1, 1), cB + (size_t)HALF * pB + kstep, sRb, pB);
    PG8_WAIT_V(6); PG8_BAR;
    for (;;) {
        const bool has_next = S.next(ui + 1, nxt);
        if (!has_next) nxt = cur;
        const char* nA = nxt.A; const char* nB = nxt.B;
        const int nt = cur.nt;
        for (int t = 0; t < nt; t += 2) {
            const bool last = (t == nt - 2);
            const char* a1 = cA + (size_t)(t + 1) * kstep + (size_t)HALF * pA;
            const char* a2 = last ? nA : cA + (size_t)(t + 2) * kstep; const char* b2 = last ? nB : cB + (size_t)(t + 2) * kstep;
            const int p2A = last ? nxt.lda2 : pA, p2B = last ? nxt.ldb2 : pB;
            const char* a2h = a2 + (size_t)HALF * p2A; const char* b2h = b2 + (size_t)HALF * p2B;
            PG8_LDB(B0, 0, 0); PG8_LDB(B1, 0, 1); PG8_SCHED; PG8_LDA(At, 0, 0); PG8_STAGE(PG8_SA(1, 1), a1, sR, pA);
            PG8_WAIT_V(8); PG8_WAIT_L(0); PG8_BAR; PG8_MMA(0, 0, At, B0); PG8_MMA(0, 1, At, B1); PG8_BAR; PG8_SCHED;
            PG8_LDA(At, 0, 1); PG8_STAGE(PG8_SB(0, 0), b2, sRb, p2B); PG8_STAGE(PG8_SB(0, 1), b2h, sRb, p2B); PG8_STAGE(PG8_SA(0, 0), a2, sR, p2A);
            PG8_WAIT_V(8); PG8_WAIT_L(0); PG8_BAR; PG8_MMA(1, 0, At, B0); PG8_MMA(1, 1, At, B1); PG8_BAR; PG8_SCHED;
            PG8_LDB(B0, 1, 0); PG8_LDB(B1, 1, 1); PG8_SCHED; PG8_LDA(At, 1, 0); PG8_STAGE(PG8_SA(0, 1), a2h, sR, p2A);
            PG8_WAIT_V(8); PG8_WAIT_L(0); PG8_BAR; PG8_MMA(0, 0, At, B0); PG8_MMA(0, 1, At, B1); PG8_BAR; PG8_SCHED;
            PG8_LDA(At, 1, 1); PG8_STAGE(PG8_SB(1, 0), b2 + kstep, sRb, p2B); PG8_STAGE(PG8_SB(1, 1), b2h + kstep, sRb, p2B); PG8_STAGE(PG8_SA(1, 0), a2 + kstep, sR, p2A);
            PG8_WAIT_V(8); PG8_WAIT_L(0); PG8_BAR; PG8_MMA(1, 0, At, B0); PG8_MMA(1, 1, At, B1); PG8_BAR; PG8_SCHED;
        }
        if constexpr (FP8) asm volatile("s_nop 15\n\ts_nop 15" ::: "memory");
        if (wr == 0) PG8_BAR;
        { int l2; asm volatile("v_mbcnt_lo_u32_b32 %0, -1, 0\n\tv_mbcnt_hi_u32_b32 %0, -1, %0" : "=v"(l2)); E(acc, cur, wr, wc, l2 & 15, l2 >> 4, wid * 64 + l2); asm volatile("s_waitcnt vmcnt(0)" ::: "memory"); }
        if (!has_next) break;
#pragma unroll
        for (int a = 0; a < 2; ++a)
#pragma unroll
            for (int b = 0; b < 2; ++b)
#pragma unroll
                for (int m = 0; m < 4; ++m)
#pragma unroll
                    for (int n = 0; n < 2; ++n) acc[a][b][m][n] = (f32x4){0.f, 0.f, 0.f, 0.f};
        cur = nxt; cA = nA; cB = nB; pA = cur.lda2; pB = cur.ldb2;
        ++ui;
        if (wr == 1) PG8_BAR;
    }
    PG8_WAIT_V(0);
    PG8_BAR;
#undef PG8_SA
#undef PG8_SB
#undef PG8_STAGE
#undef PG8_LDA
#undef PG8_LDB
#undef PG8_MMA
#undef PG8_WAIT_V
#undef PG8_WAIT_L
#undef PG8_BAR
#undef PG8_SCHED
}

struct SchedPlain {
    const char* A; const char* B; int lda2, ldb2, nt, nM, nN, G, c;
    __device__ __forceinline__ bool next(int i, UnitD& u) const {
        const long L = (long)i * G + c; if (L >= (long)nM * nN) return false;
        int pm, pn; tile_map((int)L, nM, nN, pm, pn);
        u.A = A + (size_t)pm * 256 * lda2; u.B = B + (size_t)pn * 256 * ldb2; u.lda2 = lda2; u.ldb2 = ldb2; u.nt = nt; u.pm = pm; u.pn = pn; u.kind = i; return true;
    }
};
struct SchedTiles {
    const char* A; const char* B; int lda2, ldb2, nt, ntile; unsigned long long list; int compact, G, c;
    __device__ __forceinline__ bool next(int i, UnitD& u) const {
        const long L = (long)i * G + c; if (L >= (long)128 * ntile) return false;
        int pm, pi; tile_map((int)L, 128, ntile, pm, pi); const int col = (int)((list >> (4 * pi)) & 15ull);
        u.A = A + (size_t)pm * 256 * lda2; u.B = B + (size_t)(compact ? pi : col) * 256 * ldb2; u.lda2 = lda2; u.ldb2 = ldb2; u.nt = nt; u.pm = pm; u.pn = col; u.kind = i; return true;
    }
};
struct SchedG5b {
    const char* A; const char* B; int G, c;
    __device__ __forceinline__ bool next(int i, UnitD& u) const {
        const long L = (long)i * G + c; if (L >= 128 * 4) return false;
        int pm, pn; tile_map((int)L, 128, 4, pm, pn);
        u.A = A + (size_t)pm * 256 * (UGW * 2); u.lda2 = UGW * 2; u.B = B + (size_t)pn * 256 * DFF; u.ldb2 = DFF; u.nt = 22; u.pm = pm; u.pn = pn; u.kind = i; return true;
    }
};

#define EPI_LOOP for (int ai = 0; ai < 2; ++ai) _Pragma("unroll") for (int m = 0; m < 4; ++m) _Pragma("unroll") for (int bj = 0; bj < 2; ++bj)
struct EpiStore {
    bf16* O; int ldc;
    __device__ __forceinline__ void operator()(const f32x4 (&acc)[2][2][4][2], const UnitD& u, int wr, int wc, int fr, int fq, int tid) const {
        const int row0 = u.pm * BM + wr * 64 + fr, col0 = u.pn * BM + wc * 32 + 8 * fq;
#pragma unroll
        EPI_LOOP { const f32x4 v0 = acc[ai][bj][m][0], v1 = acc[ai][bj][m][1];
            u32x4 w; w.x = pk2(v0[0], v0[1]); w.y = pk2(v0[2], v0[3]); w.z = pk2(v1[0], v1[1]); w.w = pk2(v1[2], v1[3]);
            *(u32x4*)(O + (size_t)(row0 + ai * HALF + m * 16) * ldc + col0 + bj * HALF) = w; }
    }
};
struct EpiSlotStore {
    unsigned char* sc_; int act;
    __device__ __forceinline__ void operator()(const f32x4 (&acc)[2][2][4][2], const UnitD& u, int wr, int wc, int fr, int fq, int tid) const {
        unsigned loff = (unsigned)tid * 16u; asm volatile("" : "+v"(loff));
        unsigned char* sc = sc_ + (size_t)u.kind * 131072 + loff;
#pragma unroll
        EPI_LOOP { const int q = (ai * 2 + bj) * 4 + m; f32x4 v0 = acc[ai][bj][m][0], v1 = acc[ai][bj][m][1];
            if (act) { v0 = (f32x4){sigmoidf_(v0[0]), sigmoidf_(v0[1]), sigmoidf_(v0[2]), sigmoidf_(v0[3])}; v1 = (f32x4){sigmoidf_(v1[0]), sigmoidf_(v1[1]), sigmoidf_(v1[2]), sigmoidf_(v1[3])}; }
            u32x4 w; w.x = pk2(v0[0], v0[1]); w.y = pk2(v0[2], v0[3]); w.z = pk2(v1[0], v1[1]); w.w = pk2(v1[2], v1[3]);
            *(u32x4*)(sc + (size_t)q * 8192) = w; }
    }
};
struct EpiSlotMul {
    unsigned char* sc_;
    __device__ __forceinline__ void operator()(const f32x4 (&acc)[2][2][4][2], const UnitD& u, int wr, int wc, int fr, int fq, int tid) const {
        unsigned loff = (unsigned)tid * 16u; asm volatile("" : "+v"(loff));
        unsigned char* sc = sc_ + (size_t)u.kind * 131072 + loff;
#pragma unroll
        EPI_LOOP { const int q = (ai * 2 + bj) * 4 + m; const f32x4 v0 = acc[ai][bj][m][0], v1 = acc[ai][bj][m][1];
            u32x4* sp = (u32x4*)(sc + (size_t)q * 8192); const u32x4 p = *sp;
            u32x4 w; w.x = pk2(sigmoidf_(v0[0]) * bflo(p.x), sigmoidf_(v0[1]) * bfhi(p.x)); w.y = pk2(sigmoidf_(v0[2]) * bflo(p.y), sigmoidf_(v0[3]) * bfhi(p.y));
            w.z = pk2(sigmoidf_(v1[0]) * bflo(p.z), sigmoidf_(v1[1]) * bfhi(p.z)); w.w = pk2(sigmoidf_(v1[2]) * bflo(p.w), sigmoidf_(v1[3]) * bfhi(p.w));
            *sp = w;
            if (m & 1) asm volatile("" ::: "memory"); }
    }
};
struct EpiBranch {
    const unsigned char* sc_; bf16* MG; int first;
    __device__ __forceinline__ void operator()(const f32x4 (&acc)[2][2][4][2], const UnitD& u, int wr, int wc, int fr, int fq, int tid) const {
        const int row0 = u.pm * BM + wr * 64 + fr, col0 = u.pn * BM + wc * 32 + 8 * fq;
        unsigned loff = (unsigned)tid * 16u; asm volatile("" : "+v"(loff));
        const unsigned char* sc = sc_ + (size_t)u.kind * 131072 + loff;
#pragma unroll
        EPI_LOOP { const int q = (ai * 2 + bj) * 4 + m; const f32x4 v0 = acc[ai][bj][m][0], v1 = acc[ai][bj][m][1];
            const u32x4 g = *(const u32x4*)(sc + (size_t)q * 8192);
            u32x4* p = (u32x4*)(MG + (size_t)(row0 + ai * HALF + m * 16) * DM + col0 + bj * HALF);
            f32x4 t0 = (f32x4){bflo(g.x) * v0[0], bfhi(g.x) * v0[1], bflo(g.y) * v0[2], bfhi(g.y) * v0[3]};
            f32x4 t1 = (f32x4){bflo(g.z) * v1[0], bfhi(g.z) * v1[1], bflo(g.w) * v1[2], bfhi(g.w) * v1[3]};
            if (!first) { const u32x4 x = *p; t0 += (f32x4){bflo(x.x), bfhi(x.x), bflo(x.y), bfhi(x.y)}; t1 += (f32x4){bflo(x.z), bfhi(x.z), bflo(x.w), bfhi(x.w)}; }
            u32x4 w; w.x = pk2(t0[0], t0[1]); w.y = pk2(t0[2], t0[3]); w.z = pk2(t1[0], t1[1]); w.w = pk2(t1[2], t1[3]);
            *p = w;
            if (m & 1) asm volatile("" ::: "memory"); }
    }
};
struct EpiG3 {
    bf16* XB;
    __device__ __forceinline__ void operator()(const f32x4 (&acc)[2][2][4][2], const UnitD& u, int wr, int wc, int fr, int fq, int tid) const {
        const int row0 = u.pm * BM + wr * 64 + fr, col0 = u.pn * BM + wc * 32 + 8 * fq;
#pragma unroll
        EPI_LOOP { const f32x4 v0 = acc[ai][bj][m][0], v1 = acc[ai][bj][m][1];
            u32x4* p = (u32x4*)(XB + (size_t)(row0 + ai * HALF + m * 16) * DM + col0 + bj * HALF); const u32x4 x = *p;
            u32x4 w; w.x = pk2(ALPHA * bflo(x.x) + v0[0], ALPHA * bfhi(x.x) + v0[1]); w.y = pk2(ALPHA * bflo(x.y) + v0[2], ALPHA * bfhi(x.y) + v0[3]);
            w.z = pk2(ALPHA * bflo(x.z) + v1[0], ALPHA * bfhi(x.z) + v1[1]); w.w = pk2(ALPHA * bflo(x.w) + v1[2], ALPHA * bfhi(x.w) + v1[3]);
            *p = w; }
    }
};
struct EpiG5b {
    const unsigned char* esc_; bf16* XB;
    __device__ __forceinline__ void operator()(const f32x4 (&acc)[2][2][4][2], const UnitD& u, int wr, int wc, int fr, int fq, int tid) const {
        const int row0 = u.pm * BM + wr * 64 + fr, col0 = u.pn * BM + wc * 32 + 8 * fq;
        unsigned loff = (unsigned)tid * 16u; asm volatile("" : "+v"(loff));
        const unsigned char* esc = esc_ + (size_t)u.kind * 131072 + loff;
#pragma unroll
        EPI_LOOP { const int q = (ai * 2 + bj) * 4 + m; const f32x4 v0 = acc[ai][bj][m][0], v1 = acc[ai][bj][m][1];
            const u32x4 e = *(const u32x4*)(esc + (size_t)q * 8192);
            u32x4* p = (u32x4*)(XB + (size_t)(row0 + ai * HALF + m * 16) * DM + col0 + bj * HALF); const u32x4 x = *p;
            u32x4 w; w.x = pk2(ALPHA * bflo(x.x) + v0[0] + bflo(e.x), ALPHA * bfhi(x.x) + v0[1] + bfhi(e.x)); w.y = pk2(ALPHA * bflo(x.y) + v0[2] + bflo(e.y), ALPHA * bfhi(x.y) + v0[3] + bfhi(e.y));
            w.z = pk2(ALPHA * bflo(x.z) + v1[0] + bflo(e.z), ALPHA * bfhi(x.z) + v1[1] + bfhi(e.z)); w.w = pk2(ALPHA * bflo(x.w) + v1[2] + bflo(e.w), ALPHA * bfhi(x.w) + v1[3] + bfhi(e.w));
            *p = w;
            if (m & 1) asm volatile("" ::: "memory"); }
    }
};
}

struct Frame {
    LAS unsigned char* lds;
    int tid, lane, wave, G, wg;
    unsigned char* ws; unsigned char* dob;
};
struct Args { const float* in[21]; float* out; unsigned char* ws; int ph_lo, ph_hi, sub, pad; };

__device__ __forceinline__ int z_src(int n, float& sc) {
    sc = 1.f;
    if (n < 768) { if (n < 256) sc = 0.17677669529663687f * LOG2E; return n; }
    if (n < 1536) { if (n < 1024) sc = 0.125f * LOG2E; return n; }
    if (n < 2560) { if (n >= 1792 && n < 2048) sc = 0.125f; return 1700 + (n - 1536); }
    if (n < 2816) { if (n < 2688) sc = 0.17677669529663687f; return 2724 + (n - 2560); }
    if (n < 3072) return 2980 + (n - 2816);
    if (n < 3328) return 3252 + (n - 3072);
    if (n < 3456) return 1536 + (n - 3328);
    if (n < 3488) return 1664 + (n - 3456);
    if (n < 3492) return 1696 + (n - 3488);
    if (n >= 3504 && n < 3520) return 3236 + (n - 3504);
    return -1;
}
template <int MODE>
__device__ __forceinline__ void transpose_item(const float* W, int Nsrc, int soff, bf16* WT, int dpitch, int dcol0, int k0, int n0, LAS float* scr, int lane) {
    const int nn = lane & 31; float sc = 1.f; int s;
    if (MODE == 1) s = z_src(n0 + nn, sc); else s = soff + n0 + nn;
#pragma unroll 8
    for (int i = 0; i < 32; ++i) { const int kk = 2 * i + (lane >> 5); scr[kk * 33 + nn] = (s >= 0) ? W[(size_t)(k0 + kk) * Nsrc + s] * sc : 0.f; }
    asm volatile("s_waitcnt lgkmcnt(0)" ::: "memory");
    const int c = lane & 7;
#pragma unroll
    for (int j = 0; j < 4; ++j) { const int n = (lane >> 3) + 8 * j; const LAS float* sp = scr + (8 * c) * 33 + n;
        u32x4 o; o.x = pk2(sp[0 * 33], sp[1 * 33]); o.y = pk2(sp[2 * 33], sp[3 * 33]); o.z = pk2(sp[4 * 33], sp[5 * 33]); o.w = pk2(sp[6 * 33], sp[7 * 33]);
        *(u32x4*)(WT + (size_t)(n0 + n) * dpitch + dcol0 + k0 + 8 * c) = o; }
    asm volatile("s_waitcnt lgkmcnt(0)" ::: "memory");
}
__device__ __forceinline__ void transpose_item8(const float* W, int Nsrc, int soff, unsigned char* WT, int K, int k0, int n0, LAS float* scr, int lane) {
    const int nn = lane & 31; const int s = soff + n0 + nn;
#pragma unroll 8
    for (int i = 0; i < 32; ++i) { const int kk = 2 * i + (lane >> 5); scr[kk * 33 + nn] = W[(size_t)(k0 + kk) * Nsrc + s] * 64.f; }
    asm volatile("s_waitcnt lgkmcnt(0)" ::: "memory");
    const int c = lane & 7;
#pragma unroll
    for (int j = 0; j < 4; ++j) { const int n = (lane >> 3) + 8 * j; const LAS float* sp = scr + (8 * c) * 33 + n;
        u32x2 o; o.x = pk4f8(sp[0 * 33], sp[1 * 33], sp[2 * 33], sp[3 * 33]); o.y = pk4f8(sp[4 * 33], sp[5 * 33], sp[6 * 33], sp[7 * 33]);
        *(u32x2*)(WT + (size_t)(n0 + n) * K + k0 + 8 * c) = o; }
    asm volatile("s_waitcnt lgkmcnt(0)" ::: "memory");
}
__device__ __forceinline__ void transpose_item8z(const float* W, unsigned char* WT, int tile, int slot, int k0, int n0, LAS float* scr, int lane) {
    const int nn = lane & 31; float sc = 1.f; const int s = z_src(tile * 256 + n0 + nn, sc); sc *= 64.f;
#pragma unroll 8
    for (int i = 0; i < 32; ++i) { const int kk = 2 * i + (lane >> 5); scr[kk * 33 + nn] = (s >= 0) ? W[(size_t)(k0 + kk) * NIN + s] * sc : 0.f; }
    asm volatile("s_waitcnt lgkmcnt(0)" ::: "memory");
    const int c = lane & 7;
#pragma unroll
    for (int j = 0; j < 4; ++j) { const int n = (lane >> 3) + 8 * j; const LAS float* sp = scr + (8 * c) * 33 + n;
        u32x2 o; o.x = pk4f8(sp[0 * 33], sp[1 * 33], sp[2 * 33], sp[3 * 33]); o.y = pk4f8(sp[4 * 33], sp[5 * 33], sp[6 * 33], sp[7 * 33]);
        *(u32x2*)(WT + (size_t)(slot * 256 + n0 + n) * 1024 + k0 + 8 * c) = o; }
    asm volatile("s_waitcnt lgkmcnt(0)" ::: "memory");
}
typedef __attribute__((address_space(4))) const struct Args* KArgPtr;
__device__ __forceinline__ void convert_w123(Frame& F, const float* w_in, const float* w_branch, const float* w_out) {
    LAS float* scr = (LAS float*)(F.lds + F.wave * 16384);
    const int gw = F.wg * NWAVES + F.wave, NGW = F.G * NWAVES;
    constexpr int I1 = 16 * 48, I2 = 0, I3 = 4 * 128, I4 = 16 * 32;
    unsigned char* w123 = F.ws + WS_W123;
    for (int it = gw; it < I1 + I2 + I3 + I4; it += NGW) {
        int r = it;
        if (r < I1) { const int nb = r % 48, tile = (int)((G1_BF_TILES >> (4 * (nb >> 3))) & 15); transpose_item<1>(w_in, NIN, 0, (bf16*)(w123 + W123_W1), 1024, 0, 64 * (r / 48), tile * 256 + 32 * (nb & 7), scr, F.lane); continue; } r -= I1;
        if (r < I3) { const int n = r / 128, rr = r % 128; transpose_item<0>(w_branch + (size_t)n * 256 * DM, DM, 0, (bf16*)(w123 + W123_GB + 8 * MiB) + (size_t)n * 1024 * 256, 256, 0, 64 * (rr / 32), 32 * (rr % 32), scr, F.lane); continue; } r -= I3;
        transpose_item<0>(w_out, DM, 0, (bf16*)(w123 + W123_WO), 1024, 0, 64 * (r / 32), 32 * (r % 32), scr, F.lane);
    }
}
__device__ __forceinline__ void p0_prologue(Frame& F, __attribute__((address_space(4))) const Args* Ap) {
    LAS float* scr = (LAS float*)(F.lds + F.wave * 16384);
    const int gw = F.wg * NWAVES + F.wave, NGW = F.G * NWAVES;
    constexpr int I5 = 0, I6 = 0, I7 = 4 * 32, I8 = 0;
    constexpr int IL = I5 + I6 + I7 + I8;
    for (int it = gw; it < 2 * IL; it += NGW) {
        const int l = it / IL; int r = it - l * IL;
        unsigned char* w45 = F.ws + WS_W45 + (size_t)l * W45_STRIDE;
        if (r < I7) { transpose_item<0>(Ap->in[18] + (size_t)l * PDIM * DM, DM, 0, (bf16*)(w45 + W45_PP), 256, 0, 64 * (r / 32), 32 * (r % 32), scr, F.lane); continue; } r -= I7;
        transpose_item<0>(Ap->in[16] + (size_t)l * DFF * DM, DM, 0, (bf16*)(w45 + W45_DN), DFF, 0, 64 * (r / 32), 32 * (r % 32), scr, F.lane);
    }
    {   constexpr int J1 = 16 * 128, J2 = 16 * 176, J3 = 16 * 32, J4 = 44 * 32, J5 = 8 * 16 * 8, JL = J1 + J2 + J3 + J4 + J5;
        for (int it = gw; it < 2 * JL; it += NGW) { const int l = it / JL; int r = it - l * JL; unsigned char* w8 = F.dob + DO_W8 + (size_t)l * W8_STRIDE;
            if (r < J1) { transpose_item8(Ap->in[2] + (size_t)l * DM * NIN, NIN, SRC_MG, w8 + W8_G, 1024, 64 * (r / 128), 32 * (r % 128), scr, F.lane); continue; } r -= J1;
            if (r < J2) { transpose_item8(Ap->in[13] + (size_t)l * DM * UGW, UGW, 0, w8 + W8_UP, 1024, 64 * (r / 176), 32 * (r % 176), scr, F.lane); continue; } r -= J2;
            if (r < J3) { transpose_item8(Ap->in[17] + (size_t)l * DM * DM, DM, 0, w8 + W8_PG, 1024, 64 * (r / 32), 32 * (r % 32), scr, F.lane); continue; } r -= J3;
            if (r < J4) { transpose_item8(Ap->in[16] + (size_t)l * DFF * DM, DM, 0, w8 + W8_DN, DFF, 64 * (r / 32), 32 * (r % 32), scr, F.lane); continue; } r -= J4;
            { const int slot = r >> 7, rr = r & 127; transpose_item8z(Ap->in[2] + (size_t)l * DM * NIN, w8 + W8_Z, (int)((G1_F8_TILES >> (4 * slot)) & 15), slot, 64 * (rr >> 3), 32 * (rr & 7), scr, F.lane); } } }
    convert_w123(F, Ap->in[2], Ap->in[9], Ap->in[10]);
    {   const size_t n8 = (size_t)M * DM / 8; const f32x4* src = (const f32x4*)Ap->in[0]; u32x4* dst = (u32x4*)(F.ws + WS_XB); u32x2* dst8 = (u32x2*)(F.dob + DO_XB8);
        for (size_t i = (size_t)F.wg * 512 + F.tid; i < n8; i += (size_t)F.G * 512) { const f32x4 a = src[2 * i], b = src[2 * i + 1]; u32x4 o; o.x = pk2(a[0], a[1]); o.y = pk2(a[2], a[3]); o.z = pk2(b[0], b[1]); o.w = pk2(b[2], b[3]); dst[i] = o;
            u32x2 o8; o8.x = pk4f8(a[0], a[1], a[2], a[3]); o8.y = pk4f8(b[0], b[1], b[2], b[3]); dst8[i] = o8; } }
    {   const size_t n8 = (size_t)DEPTH * M * PDIM / 8; const f32x4* src = (const f32x4*)Ap->in[1]; u32x4* dst = (u32x4*)(F.ws + WS_PB);
        for (size_t i = (size_t)F.wg * 512 + F.tid; i < n8; i += (size_t)F.G * 512) { const f32x4 a = src[2 * i], b = src[2 * i + 1]; u32x4 o; o.x = pk2(a[0], a[1]); o.y = pk2(a[2], a[3]); o.z = pk2(b[0], b[1]); o.w = pk2(b[2], b[3]); dst[i] = o; } }
}

__device__ __forceinline__ void ln_phase(Frame& F, const float* w, const float* bvec, float* outf, unsigned char* xb8) {
    const int gw = F.wg * NWAVES + F.wave, NGW = F.G * NWAVES;
    bf16* XB = (bf16*)(F.ws + WS_XB);
    for (int row = gw; row < M; row += NGW) {
        u32x4* p = (u32x4*)(XB + (size_t)row * DM) + F.lane;
        const u32x4 a = p[0], b = p[64];
        float v[16] = {bflo(a.x), bfhi(a.x), bflo(a.y), bfhi(a.y), bflo(a.z), bfhi(a.z), bflo(a.w), bfhi(a.w), bflo(b.x), bfhi(b.x), bflo(b.y), bfhi(b.y), bflo(b.z), bfhi(b.z), bflo(b.w), bfhi(b.w)};
        float s = 0.f;
#pragma unroll
        for (int i = 0; i < 16; ++i) s += v[i];
        const float mean = wave_sum(s, F.lane) * (1.f / DM); float q = 0.f;
#pragma unroll
        for (int i = 0; i < 16; ++i) { v[i] -= mean; q += v[i] * v[i]; }
        const float rstd = 1.f / sqrtf(wave_sum(q, F.lane) * (1.f / DM) + LN_EPS);
        const int c0 = F.lane * 8, c1 = 512 + F.lane * 8;
        const f32x4 w0 = *(const f32x4*)(w + c0), w1 = *(const f32x4*)(w + c0 + 4), w2 = *(const f32x4*)(w + c1), w3 = *(const f32x4*)(w + c1 + 4);
        const f32x4 b0 = *(const f32x4*)(bvec + c0), b1 = *(const f32x4*)(bvec + c0 + 4), b2 = *(const f32x4*)(bvec + c1), b3 = *(const f32x4*)(bvec + c1 + 4);
        f32x4 y0, y1, y2, y3;
#pragma unroll
        for (int i = 0; i < 4; ++i) { y0[i] = v[i] * rstd * w0[i] + b0[i]; y1[i] = v[4 + i] * rstd * w1[i] + b1[i]; y2[i] = v[8 + i] * rstd * w2[i] + b2[i]; y3[i] = v[12 + i] * rstd * w3[i] + b3[i]; }
        u32x4 o0, o1; o0.x = pk2(y0[0], y0[1]); o0.y = pk2(y0[2], y0[3]); o0.z = pk2(y1[0], y1[1]); o0.w = pk2(y1[2], y1[3]);
        o1.x = pk2(y2[0], y2[1]); o1.y = pk2(y2[2], y2[3]); o1.z = pk2(y3[0], y3[1]); o1.w = pk2(y3[2], y3[3]);
        p[0] = o0; p[64] = o1;
        if (xb8) { u32x2* q8 = (u32x2*)(xb8 + (size_t)row * DM) + F.lane; u32x2 a8, b8; a8.x = pk4f8(y0[0], y0[1], y0[2], y0[3]); a8.y = pk4f8(y1[0], y1[1], y1[2], y1[3]); b8.x = pk4f8(y2[0], y2[1], y2[2], y2[3]); b8.y = pk4f8(y3[0], y3[1], y3[2], y3[3]); q8[0] = a8; q8[64] = b8; }
        if (outf) { f32x4* op = (f32x4*)(outf + (size_t)row * DM); op[2 * F.lane] = y0; op[2 * F.lane + 1] = y1; op[128 + 2 * F.lane] = y2; op[128 + 2 * F.lane + 1] = y3; }
    }
}

__device__ __forceinline__ float gelu_tanh_(float y) { const float t = 1.5957691216057308f * (y + 0.044715f * y * y * y); return y * __builtin_amdgcn_rcpf(1.0f + __builtin_amdgcn_exp2f(-LOG2E * t)); }
__device__ __forceinline__ void up8(const u32x4 w, float (&v)[8]) { v[0] = bflo(w.x); v[1] = bfhi(w.x); v[2] = bflo(w.y); v[3] = bfhi(w.y); v[4] = bflo(w.z); v[5] = bfhi(w.z); v[6] = bflo(w.w); v[7] = bfhi(w.w); }
__device__ __forceinline__ void ffn_act_phase(Frame& F, const float* cw, const float* cb) {
    unsigned char* UGb = F.ws + WS_UG; constexpr int NV = DFF / 8, RB = 16;
    const int v = F.tid, c0 = v * 8; const bool on = v < NV;
    float w0[8], w1[8], w2[8], bb[8];
#pragma unroll
    for (int i = 0; i < 8; ++i) { w0[i] = on ? cw[c0 + i] : 0.f; w1[i] = on ? cw[DFF + c0 + i] : 0.f; w2[i] = on ? cw[2 * DFF + c0 + i] : 0.f; bb[i] = on ? cb[c0 + i] : 0.f; }
    for (int rb = F.wg; rb < M / RB; rb += F.G) {
        const int t0 = rb * RB; u32x2 outv[RB];
        if (on) { u32x4 uq[RB], gq[RB]; const bf16* base = (const bf16*)(UGb + (size_t)t0 * (UGW * 2));
#pragma unroll
            for (int r = 0; r < RB; ++r) { uq[r] = *(const u32x4*)(base + (size_t)r * UGW + c0); gq[r] = *(const u32x4*)(base + (size_t)r * UGW + DFF + c0); }
            float gm2[8], gm1[8];
            if ((t0 & (SEQ - 1)) == 0) {
#pragma unroll
                for (int i = 0; i < 8; ++i) { gm2[i] = 0.f; gm1[i] = 0.f; }
            } else { up8(*(const u32x4*)(base - 2 * UGW + DFF + c0), gm2); up8(*(const u32x4*)(base - UGW + DFF + c0), gm1); }
#pragma unroll
            for (int r = 0; r < RB; ++r) { float g0[8], uu[8], o[8]; up8(gq[r], g0); up8(uq[r], uu);
#pragma unroll
                for (int i = 0; i < 8; ++i) { const float y = bb[i] + w0[i] * gm2[i] + w1[i] * gm1[i] + w2[i] * g0[i]; o[i] = gelu_tanh_(y) * uu[i]; gm2[i] = gm1[i]; gm1[i] = g0[i]; }
                outv[r].x = pk4f8(o[0], o[1], o[2], o[3]); outv[r].y = pk4f8(o[4], o[5], o[6], o[7]); } }
        __syncthreads();
        if (on) {
#pragma unroll
            for (int r = 0; r < RB; ++r) *(u32x2*)(UGb + (size_t)(t0 + r) * (UGW * 2) + c0) = outv[r]; }
    }
}

namespace mx {
__device__ __forceinline__ f32x16 mfma32(bf16x8 a, bf16x8 b, f32x16 c) { return __builtin_amdgcn_mfma_f32_32x32x16_bf16(a, b, c, 0, 0, 0); }
__device__ __forceinline__ f32x16 splat16(float v) { f32x16 r;
#pragma unroll
    for (int i = 0; i < 16; ++i) r[i] = v;
    return r; }
__device__ __forceinline__ int crow_c(int e) { return (e & 3) + 8 * (e >> 2); }
typedef short v4i16_t __attribute__((ext_vector_type(4)));
__device__ __forceinline__ s16x4 vtr(const LAS unsigned char* p) { return __builtin_bit_cast(s16x4, __builtin_amdgcn_ds_read_tr16_b64_v4i16((LAS v4i16_t*)p)); }
__device__ __forceinline__ bf16x8 pack8(float a0, float a1, float a2, float a3, float a4, float a5, float a6, float a7) {
    u32x4 w; w.x = pk2(a0, a1); w.y = pk2(a2, a3); w.z = pk2(a4, a5); w.w = pk2(a6, a7); return __builtin_bit_cast(bf16x8, w); }

__device__ __forceinline__ float log2gam(int h) { return __builtin_log2f(1.0f - __builtin_exp2f(-5.0f - (float)h)); }
__device__ __forceinline__ void prepkv_unit(Frame& F, int blk, const float* wa2, const float* bap, unsigned* kmaxl) {
    bf16* Z = (bf16*)(F.ws + WS_Z);
    const size_t r0 = (size_t)blk * 256; const int b = blk >> 5, cb = blk & 31;
    const int tid = F.tid;
    {   const int ch = tid >> 7, col = tid & 127;
        const float ba = bap[col];
        float wa[16];
#pragma unroll
        for (int r = 0; r < 16; ++r) wa[r] = wa2[r * 128 + col];
        float cum = 0.f;
        for (int t0 = 0; t0 < 64; t0 += 8) { u32x4 A[8], B[8];
#pragma unroll
            for (int tt = 0; tt < 8; ++tt) { const bf16* zr = Z + (r0 + ch * 64 + t0 + tt) * ZW; A[tt] = *(const u32x4*)(zr + ZC_DA); B[tt] = *(const u32x4*)(zr + ZC_DA + 8); }
#pragma unroll
            for (int tt = 0; tt < 8; ++tt) { float da[8], db[8]; up8(A[tt], da); up8(B[tt], db); float x = ba;
#pragma unroll
                for (int r = 0; r < 8; ++r) x += da[r] * wa[r];
#pragma unroll
                for (int r = 0; r < 8; ++r) x += db[r] * wa[8 + r];
                cum += (fminf(x, 0.f) - __logf(1.0f + __expf(-fabsf(x)))) * 0.0625f; } }
        const float bl = cum; cum = 0.f;
        for (int t0 = 0; t0 < 64; t0 += 8) { u32x4 A[8], B[8]; bf16 qv[8], kv[8];
#pragma unroll
            for (int tt = 0; tt < 8; ++tt) { const bf16* zr = Z + (r0 + ch * 64 + t0 + tt) * ZW; A[tt] = *(const u32x4*)(zr + ZC_DA); B[tt] = *(const u32x4*)(zr + ZC_DA + 8); qv[tt] = zr[ZC_DQ + col]; kv[tt] = zr[ZC_DK + col]; }
#pragma unroll
            for (int tt = 0; tt < 8; ++tt) { bf16* zr = Z + (r0 + ch * 64 + t0 + tt) * ZW; float da[8], db[8]; up8(A[tt], da); up8(B[tt], db); float x = ba;
#pragma unroll
                for (int r = 0; r < 8; ++r) x += da[r] * wa[r];
#pragma unroll
                for (int r = 0; r < 8; ++r) x += db[r] * wa[8 + r];
                cum += (fminf(x, 0.f) - __logf(1.0f + __expf(-fabsf(x)))) * 0.0625f;
                zr[ZC_DQ + col] = (bf16)f2bf(bf1(qv[tt]) * __expf(cum - bl)); zr[ZC_DK + col] = (bf16)f2bf(bf1(kv[tt]) * __expf(bl - cum)); } }
        ((float*)(F.ws + WS_DE))[((size_t)b * 128 + cb * 4 + ch) * 128 + col] = __expf(bl);
    }
    for (int itn = 0; itn < 6; ++itn) { const int task = tid + 512 * itn, sl = task >> 8, row = task & 255;
        const bf16* kp = Z + (r0 + row) * ZW + (sl < 8 ? ZC_AK + (sl >> 1) * 64 + (sl & 1) * 32 : ZC_BK + (sl - 8) * 64); float ss = 0.f;
        const int nch = sl < 8 ? 4 : 8;
        for (int c = 0; c < nch; ++c) { float v[8]; up8(*(const u32x4*)(kp + 8 * c), v);
#pragma unroll
            for (int i = 0; i < 8; ++i) ss += v[i] * v[i]; }
#pragma unroll
        for (int o = 1; o < 64; o <<= 1) ss = fmaxf(ss, shx(ss, F.lane, o));
        if (F.lane == 0) __hip_atomic_fetch_max(kmaxl + b * 16 + sl, __float_as_uint(sqrtf(ss)), __ATOMIC_RELAXED, __HIP_MEMORY_SCOPE_AGENT); }
    for (int i0 = 0; i0 < 32; i0 += 4) { u32x4 vv[4];
#pragma unroll
        for (int k = 0; k < 4; ++k) { const int idx = tid + 512 * (i0 + k); const int row = idx >> 6, chunk = idx & 63, isk = chunk >> 5, c8 = (chunk & 31) * 8;
            vv[k] = *(const u32x4*)(Z + (r0 + row) * ZW + (isk ? ZC_CK : ZC_CQ) + c8); }
#pragma unroll
        for (int k = 0; k < 4; ++k) { const int idx = tid + 512 * (i0 + k); const int row = idx >> 6, chunk = idx & 63, isk = chunk >> 5, c8 = (chunk & 31) * 8, h = c8 >> 6;
            const float e = (float)(255 - row) * log2gam(h); const float f = __builtin_amdgcn_exp2f(isk ? e : -e); float v[8]; up8(vv[k], v);
            u32x4 w; w.x = pk2(v[0] * f, v[1] * f); w.y = pk2(v[2] * f, v[3] * f); w.z = pk2(v[4] * f, v[5] * f); w.w = pk2(v[6] * f, v[7] * f);
            *(u32x4*)(Z + (r0 + row) * ZW + (isk ? ZC_CK : ZC_CQ) + c8) = w; } }
    __threadfence_block(); __syncthreads();
    LAS unsigned char* Kl = F.lds; LAS unsigned char* Vl = F.lds + 36864;
    for (int h = 0; h < 4; ++h) {
        for (int idx = tid; idx < 256 * 8; idx += 512) { const int row = idx >> 3, c = idx & 7;
            *(LAS u32x4*)(Kl + row * 144 + c * 16) = *(const u32x4*)(Z + (r0 + row) * ZW + ZC_CK + h * 64 + c * 8);
            *(LAS u32x4*)(Vl + row * 144 + c * 16) = *(const u32x4*)(Z + (r0 + row) * ZW + ZC_CV + h * 64 + c * 8); }
        __syncthreads();
        {   const int d = tid >> 3, dk8 = (tid & 7) * 8; float acc[8];
#pragma unroll
            for (int i = 0; i < 8; ++i) acc[i] = 0.f;
            for (int j = 0; j < 256; ++j) { const float vv = bf1(*(const LAS bf16*)(Vl + j * 144 + d * 2)); float kk[8]; up8(*(const LAS u32x4*)(Kl + j * 144 + dk8 * 2), kk);
#pragma unroll
                for (int i = 0; i < 8; ++i) acc[i] += vv * kk[i]; }
            float* o = (float*)(F.ws + WS_KVC) + ((size_t)((b * 4 + h) * 32 + cb) * 4096 + d * 64 + dk8);
            *(f32x4*)o = (f32x4){acc[0], acc[1], acc[2], acc[3]}; *(f32x4*)(o + 4) = (f32x4){acc[4], acc[5], acc[6], acc[7]}; }
        __syncthreads();
        for (int idx = tid; idx < 256 * 8; idx += 512) { const int row = idx >> 3, c = idx & 7;
            if (c < 4) *(LAS u32x4*)(Kl + row * 144 + c * 16) = *(const u32x4*)(Z + (r0 + row) * ZW + ZC_DK + h * 32 + c * 8);
            *(LAS u32x4*)(Vl + row * 144 + c * 16) = *(const u32x4*)(Z + (r0 + row) * ZW + ZC_DV + h * 64 + c * 8); }
        __syncthreads();
        {   const int ch = tid >> 7, d = (tid >> 1) & 63, dk16 = (tid & 1) * 16; float acc[16];
#pragma unroll
            for (int i = 0; i < 16; ++i) acc[i] = 0.f;
            for (int j = 0; j < 64; ++j) { const int row = ch * 64 + j; const float vv = bf1(*(const LAS bf16*)(Vl + row * 144 + d * 2)); float k0[8], k1[8];
                up8(*(const LAS u32x4*)(Kl + row * 144 + dk16 * 2), k0); up8(*(const LAS u32x4*)(Kl + row * 144 + dk16 * 2 + 16), k1);
#pragma unroll
                for (int i = 0; i < 8; ++i) { acc[i] += vv * k0[i]; acc[8 + i] += vv * k1[i]; } }
            float* o = (float*)(F.ws + WS_KVD) + ((size_t)((b * 4 + h) * 128 + cb * 4 + ch) * 2048 + d * 32 + dk16);
#pragma unroll
            for (int i = 0; i < 4; ++i) *(f32x4*)(o + 4 * i) = (f32x4){acc[4 * i], acc[4 * i + 1], acc[4 * i + 2], acc[4 * i + 3]}; }
        __syncthreads();
    }
}

__device__ __forceinline__ void scan_phase(Frame& F) {
    const int gt = F.wg * 512 + F.tid, NT = F.G * 512;
    for (int e0 = gt; e0 < 16 * 4096 + 16 * 2048; e0 += NT) {
        if (e0 < 16 * 4096) { const int e = e0;
            const int bh = e >> 12, idx = e & 4095, h = bh & 3; const float g256 = __builtin_amdgcn_exp2f(256.0f * log2gam(h));
            float* p = (float*)(F.ws + WS_KVC) + (size_t)bh * 32 * 4096 + idx; float S = 0.f; float kv[32];
#pragma unroll
            for (int c = 0; c < 32; ++c) kv[c] = p[(size_t)c * 4096];
#pragma unroll
            for (int c = 0; c < 32; ++c) { const float Sp = g256 * S; p[(size_t)c * 4096] = Sp; S = Sp + kv[c]; }
        } else { const int e = e0 - 16 * 4096;
            const int bh = e >> 11, idx = e & 2047, b = bh >> 2, h = bh & 3, dk = idx & 31;
            float* p = (float*)(F.ws + WS_KVD) + (size_t)bh * 128 * 2048 + idx; const float* de = (const float*)(F.ws + WS_DE) + (size_t)b * 128 * 128 + h * 32 + dk; float S = 0.f;
            for (int c0 = 0; c0 < 128; c0 += 16) { float kv[16], dd[16];
#pragma unroll
                for (int c = 0; c < 16; ++c) { kv[c] = p[(size_t)(c0 + c) * 2048]; dd[c] = de[(c0 + c) * 128]; }
#pragma unroll
                for (int c = 0; c < 16; ++c) { const float Sp = dd[c] * S; p[(size_t)(c0 + c) * 2048] = Sp; S = Sp + kv[c]; } }
        }
    }
}

constexpr int HPITCH = 1026, CAP = 256;
struct QState { unsigned mode, thr_lo, thr_hi, thr_idx, krem, lcount, pad0, pad1; };
__device__ __forceinline__ unsigned okey_of(float s) { const unsigned u = __float_as_uint(s); return u ^ ((unsigned)((int)u >> 31) | 0x80000000u); }
__device__ __forceinline__ void b1_load(const bf16* Zb, int t, int r, int hh, bf16x8& k0, bf16x8& k1) {
    const bf16* kr = Zb + (size_t)(32 * t + r) * ZW + ZC_IK + 8 * hh; k0 = *(const bf16x8*)kr; k1 = *(const bf16x8*)(kr + 16); }
__device__ __forceinline__ void b1_scores(const bf16x8 k0, const bf16x8 k1, const bf16x8 (&iqf)[4][2], const float (&w)[4], float (&sc)[16]) {
#pragma unroll
    for (int e = 0; e < 16; ++e) sc[e] = 0.f;
#pragma unroll
    for (int ih = 0; ih < 4; ++ih) { f32x16 lg = mfma32(k0, iqf[ih][0], splat16(0.f)); lg = mfma32(k1, iqf[ih][1], lg);
#pragma unroll
        for (int e = 0; e < 16; ++e) sc[e] = fmaf(w[ih], fmaxf(lg[e], 0.f), sc[e]); }
}
__device__ __forceinline__ void b1_setbit(unsigned* MWq, unsigned j) {
    const unsigned wi = j & 31u, hh = (wi >> 2) & 1u, e = (wi & 3u) + 4u * (wi >> 3), kh = (j >> 5) & 1u;
    __hip_atomic_fetch_or(MWq + (size_t)(j >> 6) * 64 + 32u * hh, 1u << (e + 16u * kh), __ATOMIC_RELAXED, __HIP_MEMORY_SCOPE_AGENT);
}
__device__ __forceinline__ void b1_unit(Frame& F, int b, int g) {
    const int tid = F.tid, lane = F.lane, r = lane & 31, hh = lane >> 5, wid = F.wave;
    const bf16* Zb = (const bf16*)(F.ws + WS_Z) + (size_t)b * SEQ * ZW;
    LAS unsigned* hist = (LAS unsigned*)F.lds;
    LAS QState* qst = (LAS QState*)(F.lds + QST_OFF);
    const int qpos = 32 * g + r;
    unsigned* MWb = (unsigned*)(F.ws + WS_MASK) + ((size_t)(b * 256 + g) * 128) * 64;
    bf16x8 iqf[4][2]; float w[4];
    {   const bf16* qr = Zb + (size_t)qpos * ZW;
#pragma unroll
        for (int ih = 0; ih < 4; ++ih) { iqf[ih][0] = *(const bf16x8*)(qr + ZC_IQ + ih * 32 + 8 * hh); iqf[ih][1] = *(const bf16x8*)(qr + ZC_IQ + ih * 32 + 16 + 8 * hh); w[ih] = bf1(qr[ZC_IW + ih]); } }
    if (g >= 8) {
        for (int i = tid; i < 32 * HPITCH; i += 512) hist[i] = 0u;
        __syncthreads();
        {   bf16x8 n0 = iqf[0][0], n1 = iqf[0][0]; int t = wid; if (t <= g) b1_load(Zb, t, r, hh, n0, n1);
            for (; t <= g; t += 8) { const bf16x8 k0 = n0, k1 = n1; if (t + 8 <= g) b1_load(Zb, t + 8, r, hh, n0, n1);
                float sc[16]; b1_scores(k0, k1, iqf, w, sc);
#pragma unroll
                for (int e = 0; e < 16; ++e) { const int j = 32 * t + crow_c(e) + 4 * hh; if (j <= qpos) { const unsigned bin = okey_of(sc[e]) >> 21;
                    __hip_atomic_fetch_add(hist + r * HPITCH + (bin >> 1), 1u << ((bin & 1) * 16), __ATOMIC_RELAXED, __HIP_MEMORY_SCOPE_WORKGROUP); } } } }
        __syncthreads();
        for (int qq = 0; qq < 4; ++qq) { const int q = 4 * wid + qq; const LAS unsigned* hq = hist + q * HPITCH;
            const int wbase = 1008 - 16 * lane; unsigned s = 0;
#pragma unroll
            for (int k = 0; k < 16; ++k) { const unsigned x = hq[wbase + k]; s += (x & 0xffffu) + (x >> 16); }
            unsigned P = s;
#pragma unroll
            for (int o = 1; o < 64; o <<= 1) { const unsigned t = shup(P, lane, o); if (lane >= o) P += t; }
            const unsigned long long bal = __ballot(P >= 256u);
            const int Lsel = bal ? __builtin_ctzll(bal) : 63;
            if (lane == Lsel) { unsigned cum = P - s; unsigned b1 = 0, cin = 0, cab = 0;
                for (int k = 0; k < 32; ++k) { const int bin = 2047 - 32 * lane - k; const unsigned x = hq[bin >> 1]; const unsigned c = (bin & 1) ? (x >> 16) : (x & 0xffffu);
                    if (cum + c >= 256u) { b1 = (unsigned)bin; cin = c; cab = cum; break; } cum += c; }
                qst[q].thr_lo = b1 << 21; qst[q].thr_hi = (b1 << 21) | 0x1fffffu; qst[q].thr_idx = 0xffffu; qst[q].krem = 256u - cab; qst[q].lcount = 0u; qst[q].pad0 = cin; qst[q].pad1 = 0u;
                qst[q].mode = (b1 == 1024u || cin > (unsigned)CAP) ? 2u : 1u; }
        }
        __syncthreads();
        for (int i = tid; i < 32 * 256; i += 512) ((LAS unsigned*)(F.lds + 65536))[i] = 0u;
        __syncthreads();
    }
    {   unsigned mode = 0u, tlo = 1u, thi = 0u;
        const bool allsel = (g < 8);
        if (!allsel) { mode = qst[r].mode; tlo = qst[r].thr_lo; thi = qst[r].thr_hi; }
        const int nk = g >> 1;
        bf16x8 n0 = iqf[0][0], n1 = iqf[0][0], n2 = iqf[0][0], n3 = iqf[0][0]; int kt = wid;
        if (kt <= nk) { b1_load(Zb, 2 * kt, r, hh, n0, n1); if (2 * kt + 1 <= g) b1_load(Zb, 2 * kt + 1, r, hh, n2, n3); }
        for (; kt <= nk; kt += 8) {
            const bf16x8 k0 = n0, k1 = n1, k2 = n2, k3 = n3;
            if (kt + 8 <= nk) { b1_load(Zb, 2 * kt + 16, r, hh, n0, n1); if (2 * kt + 17 <= g) b1_load(Zb, 2 * kt + 17, r, hh, n2, n3); }
            unsigned word = 0u;
#pragma unroll
            for (int kh = 0; kh < 2; ++kh) { const int t = 2 * kt + kh; if (t <= g) { float sc[16]; b1_scores(kh ? k2 : k0, kh ? k3 : k1, iqf, w, sc);
#pragma unroll
                for (int e = 0; e < 16; ++e) { const int j = 32 * t + crow_c(e) + 4 * hh; const unsigned ok = okey_of(sc[e]); const bool valid = (j <= qpos);
                    const bool sel = valid && (allsel || ok > thi); word |= (sel ? 1u : 0u) << (e + 16 * kh);
                    if (!allsel && valid && ok >= tlo && ok <= thi) {
                        if (mode == 1u) { const unsigned pos = __hip_atomic_fetch_add(&qst[r].lcount, 1u, __ATOMIC_RELAXED, __HIP_MEMORY_SCOPE_WORKGROUP);
                            if (pos < (unsigned)CAP) { LAS unsigned* le = (LAS unsigned*)(F.lds + ((size_t)r * CAP + pos) * 8); le[0] = ok; le[1] = (unsigned)j; } }
                        else __hip_atomic_fetch_or((LAS unsigned*)(F.lds + 65536 + r * 1024) + (j >> 5), 1u << (j & 31), __ATOMIC_RELAXED, __HIP_MEMORY_SCOPE_WORKGROUP); } } } }
            MWb[(size_t)kt * 64 + lane] = word; }
    }
    __syncthreads();
    if (g >= 8) {
        for (int qq = 0; qq < 4; ++qq) { const int q = 4 * wid + qq; const unsigned mode = qst[q].mode, krem = qst[q].krem; unsigned* MWq = MWb + q;
            if (mode == 1u) {
                unsigned L = qst[q].lcount; if (L > (unsigned)CAP) L = CAP; const LAS unsigned* lb = (const LAS unsigned*)(F.lds + (size_t)q * CAP * 8);
                unsigned long long comp[4]; bool has[4]; unsigned jj[4];
#pragma unroll
                for (int k = 0; k < 4; ++k) { const unsigned c = lane + 64 * k; has[k] = c < L; const unsigned ok = has[k] ? lb[2 * c] : 0u; jj[k] = has[k] ? lb[2 * c + 1] : 0u;
                    comp[k] = ((unsigned long long)(ok & 0x1fffffu) << 13) | (unsigned long long)(8191u - jj[k]); }
                unsigned long long prefix = 0ull; unsigned need = krem;
                for (int bit = 33; bit >= 0; --bit) { const unsigned long long want = (prefix >> bit) | 1ull; unsigned cnt = 0;
#pragma unroll
                    for (int k = 0; k < 4; ++k) cnt += (unsigned)__builtin_popcountll(__ballot(has[k] && ((comp[k] >> bit) == want)));
                    if (cnt >= need) prefix |= (1ull << bit); else need -= cnt; }
#pragma unroll
                for (int k = 0; k < 4; ++k) if (has[k] && comp[k] >= prefix) b1_setbit(MWq, jj[k]); }
            else { const LAS unsigned* bm = (const LAS unsigned*)(F.lds + 65536 + q * 1024); unsigned x[4]; unsigned s = 0;
#pragma unroll
                for (int k = 0; k < 4; ++k) { x[k] = bm[4 * lane + k]; s += __builtin_popcount(x[k]); }
                unsigned P = s;
#pragma unroll
                for (int o = 1; o < 64; o <<= 1) { const unsigned t = shup(P, lane, o); if (lane >= o) P += t; }
                unsigned before = P - s;
#pragma unroll
                for (int k = 0; k < 4; ++k) { unsigned y = x[k]; while (y != 0u && before < krem) { const unsigned bit = (unsigned)__builtin_ctz(y); y &= y - 1u; b1_setbit(MWq, 32u * (4 * lane + k) + bit); ++before; } before += __builtin_popcount(y); } }
        }
        __syncthreads();
    }
}

struct EngP { const bf16* Z; bf16* Y; const unsigned* MASK; const float* ST; const float* nw; float lam, lam_init; const unsigned* kmax; };
__device__ __forceinline__ int wq_next(Frame& F, unsigned* head) {
    LAS int* slot = (LAS int*)(F.lds + 55312);
    if (F.tid == 0) *slot = (int)__hip_atomic_fetch_add(head, 1u, __ATOMIC_RELAXED, __HIP_MEMORY_SCOPE_AGENT);
    __syncthreads(); const int u = *slot; __syncthreads();
    asm volatile("" : "+v"(F.tid), "+v"(F.lane));
    return u;
}
template <int MODE>
__device__ __forceinline__ void eng_unit(Frame& F, const EngP& P, int b, int h, int qb) {
    constexpr bool SOFT = MODE <= 1;
    constexpr int NMAP = MODE == 0 ? 2 : 1;
    constexpr int NS = (MODE == 0 || MODE == 3) ? 2 : 4;
    constexpr int KCH = MODE == 3 ? 4 : 8;
    constexpr int QC = MODE == 0 ? ZC_AQ : MODE == 1 ? ZC_BQ : MODE == 2 ? ZC_CQ : ZC_DQ;
    constexpr int KC = MODE == 0 ? ZC_AK : MODE == 1 ? ZC_BK : MODE == 2 ? ZC_CK : ZC_DK;
    constexpr int VC = MODE == 0 ? ZC_AV : MODE == 1 ? ZC_BV : MODE == 2 ? ZC_CV : ZC_DV;
    constexpr int HW = MODE == 3 ? 32 : 64;
    const int tid = F.tid, lane = F.lane, r = lane & 31, hh = lane >> 5, w = F.wave;
    const size_t rowbase = (size_t)b * SEQ;
    const int qw0 = qb * 256 + 32 * w;
    const float NEG = -__builtin_inff();
    const int hidx = MODE <= 1 ? (MODE == 0 ? 2 * h + 1 : 2 * h + 2) : 0;
    const float slope2 = SOFT ? __builtin_amdgcn_exp2f(-(float)hidx) * LOG2E : 0.f;
    bf16x8 qf[NMAP][NS];
    {   const bf16* qrow = P.Z + (rowbase + qw0 + r) * ZW + QC + h * HW;
#pragma unroll
        for (int m = 0; m < NMAP; ++m)
#pragma unroll
            for (int s = 0; s < NS; ++s) qf[m][s] = *(const bf16x8*)(qrow + m * 32 + 16 * s + 8 * hh); }
    f32x16 cinit;
#pragma unroll
    for (int e = 0; e < 16; ++e) cinit[e] = SOFT ? slope2 * (float)(crow_c(e) + 4 * hh) : 0.f;
    float m_run[NMAP], l_run[NMAP]; f32x16 O[NMAP][2];
#pragma unroll
    for (int m = 0; m < NMAP; ++m) { m_run[m] = NEG; l_run[m] = 0.f; O[m][0] = splat16(0.f); O[m][1] = splat16(0.f); }
    if (!SOFT) {
        const int sidx = MODE == 2 ? ((b * 4 + h) * 32 + qb) : ((b * 4 + h) * 128 + 4 * qb + (w >> 1));
        const float* sp = P.ST + (size_t)sidx * (64 * HW);
#pragma unroll
        for (int db = 0; db < 2; ++db)
#pragma unroll
            for (int s = 0; s < NS; ++s) { const float* a = sp + (size_t)(32 * db + r) * HW + 16 * s + 8 * hh; const f32x4 a0 = *(const f32x4*)a, a1 = *(const f32x4*)(a + 4);
                O[0][db] = mfma32(pack8(a0[0], a0[1], a0[2], a0[3], a1[0], a1[1], a1[2], a1[3]), qf[0][s], O[0][db]); }
    }
    const int kt_lo = SOFT ? 0 : 4 * qb, kt_hi = 4 * qb + 3;
    const int srow = tid >> 3, sch = tid & 7;
    float qk[NMAP];
    if (SOFT) {
#pragma unroll
        for (int m = 0; m < NMAP; ++m) { float ss = 0.f;
#pragma unroll
            for (int s = 0; s < NS; ++s) { const u32x4 qq = __builtin_bit_cast(u32x4, qf[m][s]); float v[8]; up8(qq, v);
#pragma unroll
                for (int i = 0; i < 8; ++i) ss += v[i] * v[i]; }
            ss += shx(ss, lane, 32);
            qk[m] = 1.02f * sqrtf(ss) * __uint_as_float(P.kmax[b * 16 + (MODE == 0 ? (h * 2 + m) : (8 + h))]) + 0.01f; }
    }
    LAS unsigned* wflag = (LAS unsigned*)(F.lds + 55296);
    if (SOFT && tid < 3) wflag[tid] = 0u;
    const int kt_first = SOFT ? kt_hi : kt_lo;
    const int nit = kt_hi - kt_lo + 1;
    u32x4 kreg = (u32x4){0u, 0u, 0u, 0u}, vreg;
    {   const bf16* zr = P.Z + (rowbase + 64 * kt_first + srow) * ZW;
        if (sch < KCH) kreg = *(const u32x4*)(zr + KC + h * HW + sch * 8);
        vreg = *(const u32x4*)(zr + VC + h * 64 + sch * 8);
        if (sch < KCH) *(LAS u32x4*)(F.lds + srow * 144 + sch * 16) = kreg;
        *(LAS u32x4*)(F.lds + 9216 + srow * 144 + sch * 16) = vreg;
        if (nit > 1) { const bf16* z1 = P.Z + (rowbase + 64 * (SOFT ? kt_first - 1 : kt_first + 1) + srow) * ZW;
            if (sch < KCH) kreg = *(const u32x4*)(z1 + KC + h * HW + sch * 8);
            vreg = *(const u32x4*)(z1 + VC + h * 64 + sch * 8); } }
    __syncthreads();
    bool wave_done = false;
    const unsigned* mwp = (MODE == 1) ? P.MASK + ((size_t)(b * 256 + qb * 8 + w) * 128) * 64 + lane : nullptr;
    unsigned mwn = 0xffffffffu; if (MODE == 1) mwn = mwp[(size_t)kt_first * 64];
    int sl_cur = 0, sl_nxt = 18432;
    for (int it = 0; it < nit; ++it) {
        const int kt = SOFT ? kt_hi - it : kt_lo + it, ktn = SOFT ? kt - 1 : kt + 1;
        const bool more = it + 1 < nit;
        const unsigned mw = mwn;
        if (more) { if (sch < KCH) *(LAS u32x4*)(F.lds + sl_nxt + srow * 144 + sch * 16) = kreg;
            *(LAS u32x4*)(F.lds + sl_nxt + 9216 + srow * 144 + sch * 16) = vreg;
            if (MODE == 1) mwn = mwp[(size_t)ktn * 64]; }
        if (it + 2 < nit) { const bf16* zr = P.Z + (rowbase + 64 * (SOFT ? kt - 2 : kt + 2) + srow) * ZW;
            if (sch < KCH) kreg = *(const u32x4*)(zr + KC + h * HW + sch * 8);
            vreg = *(const u32x4*)(zr + VC + h * 64 + sch * 8); }
        const int j0 = 64 * kt;
        const bool act = ((MODE == 3) ? (kt == 4 * qb + (w >> 1)) : (j0 <= qw0 + 31)) && !wave_done;
        if (act) {
            const LAS unsigned char* Kb = F.lds + sl_cur; const LAS unsigned char* Vb = F.lds + sl_cur + 9216;
            const bool hact1 = (j0 + 32 <= qw0 + 31);
#pragma unroll
            for (int m = 0; m < NMAP; ++m) {
                f32x16 st[2];
#pragma unroll
                for (int kh = 0; kh < 2; ++kh) {
                    if (kh == 0 || hact1) {
                        f32x16 a = cinit;
#pragma unroll
                        for (int s = 0; s < NS; ++s) { const bf16x8 kf = *(const LAS bf16x8*)(Kb + (32 * kh + r) * 144 + (m * 32 + 16 * s + 8 * hh) * 2); a = mfma32(kf, qf[m][s], a); }
                        if (j0 + 32 * kh + 31 > qw0) { const int lim = qw0 + r - j0 - 32 * kh - 4 * hh; asm volatile("; causal-mask block (kept a real branch: as selects it ran on every interior tile too)" ::: "memory");
#pragma unroll
                            for (int e = 0; e < 16; ++e) if (crow_c(e) > lim) a[e] = SOFT ? NEG : 0.f; }
                        if (MODE == 1) {
#pragma unroll
                            for (int e = 0; e < 16; ++e) if (!((mw >> (e + 16 * kh)) & 1u)) a[e] = NEG; }
                        st[kh] = a;
                    } else st[kh] = splat16(SOFT ? NEG : 0.f);
                }
                if (SOFT) {
                    const float off0 = slope2 * (float)(j0 - qw0 - r), off1 = off0 + 32.f * slope2;
                    float mx0 = st[0][0], mx1 = st[1][0];
#pragma unroll
                    for (int e = 1; e < 16; ++e) { mx0 = fmaxf(mx0, st[0][e]); mx1 = fmaxf(mx1, st[1][e]); }
                    float mx = fmaxf(mx0 + off0, mx1 + off1); mx = fmaxf(mx, shx(mx, lane, 32));
                    const float mn = fmaxf(m_run[m], mx); const float msafe = (mn == NEG) ? 0.f : mn;
                    const float alpha = __builtin_amdgcn_exp2f(m_run[m] - msafe); m_run[m] = mn;
                    const float d0 = off0 - msafe, d1 = off1 - msafe; float rs = 0.f;
#pragma unroll
                    for (int e = 0; e < 16; ++e) { const float p0 = __builtin_amdgcn_exp2f(st[0][e] + d0), p1 = __builtin_amdgcn_exp2f(st[1][e] + d1); st[0][e] = p0; st[1][e] = p1; rs += p0 + p1; }
                    rs += shx(rs, lane, 32); l_run[m] = l_run[m] * alpha + rs;
#pragma unroll
                    for (int e = 0; e < 16; ++e) { O[m][0][e] *= alpha; O[m][1][e] *= alpha; }
                }
#pragma unroll
                for (int kh = 0; kh < 2; ++kh) {
                    if (kh == 0 || hact1) {
#pragma unroll
                        for (int s = 0; s < 2; ++s) {
                            const bf16x8 pf = pack8(st[kh][8 * s], st[kh][8 * s + 1], st[kh][8 * s + 2], st[kh][8 * s + 3], st[kh][8 * s + 4], st[kh][8 * s + 5], st[kh][8 * s + 6], st[kh][8 * s + 7]);
#pragma unroll
                            for (int db = 0; db < 2; ++db) {
                                const LAS unsigned char* vp = Vb + (32 * kh + 16 * s + 4 * hh + ((lane & 15) >> 2)) * 144 + (32 * db + 16 * ((lane >> 4) & 1) + 4 * (lane & 3)) * 2;
                                const s16x4 lo = vtr(vp), hi = vtr(vp + 8 * 144);
                                const bf16x8 vf = (bf16x8){lo[0], lo[1], lo[2], lo[3], hi[0], hi[1], hi[2], hi[3]};
                                O[m][db] = mfma32(vf, pf, O[m][db]); } } } }
            }
            if (SOFT) {
                const float dist = slope2 * (float)(qw0 + r - (j0 - 1)); bool fin = true;
#pragma unroll
                for (int m = 0; m < NMAP; ++m) fin = fin && (qk[m] - dist - m_run[m] < -32.f);
                wave_done = (__ballot(fin) == ~0ull);
            }
        }
        if (SOFT && !wave_done && lane == 0) wflag[it % 3] = 1u;
        sl_cur = sl_nxt; sl_nxt = (sl_nxt == 36864) ? 0 : sl_nxt + 18432;
        __syncthreads();
        if (SOFT) { const unsigned any = wflag[it % 3]; if (tid == 0) wflag[(it + 2) % 3] = 0u; if (any == 0u) break; }
    }
    const size_t orow = rowbase + qw0 + r;
    const int ycol = MODE * 256 + h * 64;
    f32x16 o[2];
    if (MODE == 0) { const float i0 = 1.f / l_run[0], i1 = P.lam / l_run[NMAP - 1];
#pragma unroll
        for (int db = 0; db < 2; ++db)
#pragma unroll
            for (int e = 0; e < 16; ++e) o[db][e] = O[0][db][e] * i0 - O[NMAP - 1][db][e] * i1; }
    else if (MODE == 1) { const float i0 = 1.f / l_run[0];
#pragma unroll
        for (int db = 0; db < 2; ++db)
#pragma unroll
            for (int e = 0; e < 16; ++e) o[db][e] = O[0][db][e] * i0; }
    else { o[0] = O[0][0]; o[1] = O[0][1]; }
    float mu = 0.f;
    if (MODE == 2) { float s = 0.f;
#pragma unroll
        for (int db = 0; db < 2; ++db)
#pragma unroll
            for (int e = 0; e < 16; ++e) s += o[db][e];
        s += shx(s, lane, 32); mu = s * (1.f / 64.f); }
    float ss = 0.f;
    if (MODE != 1) {
#pragma unroll
        for (int db = 0; db < 2; ++db)
#pragma unroll
            for (int e = 0; e < 16; ++e) { const float d = o[db][e] - mu; ss += d * d; }
        ss += shx(ss, lane, 32); }
    float rn = 1.f;
    if (MODE != 1) rn = 1.f / sqrtf(ss * (1.f / 64.f) + LN_EPS);
    if (MODE == 0) rn *= (1.f - P.lam_init);
#pragma unroll
    for (int db = 0; db < 2; ++db)
#pragma unroll
        for (int g4 = 0; g4 < 4; ++g4) { const int d0 = 32 * db + 8 * g4 + 4 * hh; float v[4];
#pragma unroll
            for (int i = 0; i < 4; ++i) v[i] = o[db][4 * g4 + i];
            if (MODE != 1) { const f32x4 nw = *(const f32x4*)(P.nw + (MODE == 2 ? h * 64 : 0) + d0);
#pragma unroll
                for (int i = 0; i < 4; ++i) v[i] = (v[i] - mu) * rn * nw[i]; }
            if (MODE >= 2) { const u32x2 gw = *(const u32x2*)(P.Z + orow * ZW + (MODE == 2 ? ZC_CG : ZC_DG) + h * 64 + d0);
                const float g0 = bflo(gw.x), g1 = bfhi(gw.x), g2 = bflo(gw.y), g3 = bfhi(gw.y);
                v[0] *= g0 * sigmoidf_(g0); v[1] *= g1 * sigmoidf_(g1); v[2] *= g2 * sigmoidf_(g2); v[3] *= g3 * sigmoidf_(g3); }
            u32x2 ow; ow.x = pk2(v[0], v[1]); ow.y = pk2(v[2], v[3]);
            *(u32x2*)(P.Y + orow * DM + ycol + d0) = ow; }
}
}

constexpr int PH_PER_LAYER = 12, N_PHASES = 1 + DEPTH * PH_PER_LAYER;

typedef __attribute__((address_space(4))) const Args* KArgP;
#ifdef ONLY_SITE
#define SITE(s) ((s) == ONLY_SITE)
#else
#define SITE(s) true
#endif
#if MK_ONE_LAUNCH
#define IN(k) true
#define SEAM(k) do { if ((k) + 1 < N_PHASES) { XcdBarrier b2_ = bar; asm volatile("" : "+s"(b2_.bar), "+s"(b2_.x)); xcd_barrier(b2_, F.tid == 0); } } while (0)
#else
#define IN(k) (lo <= (k) && (k) < hi)
#define SEAM(k) do { } while (0)
#endif
#define SITE_BEGIN KArgP KA = (KArgP)__builtin_amdgcn_kernarg_segment_ptr(); do { asm volatile("" : "+s"(KA)); \
        int ln_; asm volatile("v_mbcnt_lo_u32_b32 %0, -1, 0\n\tv_mbcnt_hi_u32_b32 %0, -1, %0" : "=v"(ln_)); \
        const unsigned simd_ = (unsigned)__builtin_amdgcn_s_getreg(((2 - 1) << 11) | (4 << 6) | 4);   \
        unsigned tk_ = 0u, tg_ = 0u; if (ln_ == 0) { tk_ = __hip_atomic_fetch_add((LAS unsigned*)(F.lds + MISC_OFF + 64) + simd_, 1u, __ATOMIC_RELAXED, __HIP_MEMORY_SCOPE_WORKGROUP); \
            tg_ = __hip_atomic_fetch_add((LAS unsigned*)(F.lds + MISC_OFF + 96), 1u, __ATOMIC_RELAXED, __HIP_MEMORY_SCOPE_WORKGROUP); } \
        F.wave = __builtin_amdgcn_readfirstlane(simd_balanced ? (int)(simd_ + 4u * (tk_ & 1u)) : (int)(tg_ & 7u)); F.lane = ln_; F.tid = F.wave * 64 + F.lane; \
        F.ws = KA->ws; F.dob = (unsigned char*)KA->out; F.G = G0; F.wg = wg0; asm volatile("" : "+s"(F.G), "+s"(F.wg)); } while (0)


__global__ void __launch_bounds__(NWAVES * 64, 2) fwd_kernel(Args args) {
    extern __shared__ __attribute__((aligned(16))) unsigned char lds_raw[];
    Frame F;
    F.lds = (LAS unsigned char*)lds_raw;
    F.tid = threadIdx.x; F.lane = F.tid & 63; F.wave = __builtin_amdgcn_readfirstlane(F.tid >> 6);
    F.G = gridDim.x; F.wg = blockIdx.x;
    F.ws = args.ws; F.dob = (unsigned char*)args.out;
    volatile LAS unsigned* MISC = (volatile LAS unsigned*)(F.lds + MISC_OFF);
    if (F.tid < 32) MISC[F.tid] = 0u;
    __syncthreads();
    if (F.lane == 0) __hip_atomic_fetch_add((LAS unsigned*)(F.lds + MISC_OFF + 112) + ((unsigned)__builtin_amdgcn_s_getreg(((2 - 1) << 11) | (4 << 6) | 4)), 1u, __ATOMIC_RELAXED, __HIP_MEMORY_SCOPE_WORKGROUP);
    __syncthreads();
    const bool simd_balanced = (MISC[28] == 2u) && (MISC[29] == 2u) && (MISC[30] == 2u) && (MISC[31] == 2u);
    unsigned* ctl = (unsigned*)(F.ws + WS_CTL);
    XcdBarrier bar; bar.bar = ctl + CW_BAR; bar.x = 0; bar.st = nullptr;
#if MK_ONE_LAUNCH
    bar = xcd_barrier_post(ctl + CW_BAR, MISC + 8);
#endif
    const int lo = args.ph_lo, hi = args.ph_hi, subm = args.sub;
    const int G0 = F.G, wg0 = F.wg;
    if (SITE(0) && IN(0)) { SITE_BEGIN; p0_prologue(F, KA); SEAM(0); }

    for (int l = 0; l < DEPTH; ++l) {
        const int pb = 1 + l * PH_PER_LAYER;
        if (SITE(1) && IN(pb + 0)) { SITE_BEGIN; const char* XBc = (const char*)(F.ws + WS_XB); (void)XBc; const unsigned char* w123 = F.ws + WS_W123; const unsigned char* w45 = F.ws + WS_W45 + (size_t)l * W45_STRIDE; (void)w123; (void)w45;
            pg8::EpiStore E{(bf16*)(F.ws + WS_Z), ZW};
            {   pg8::SchedTiles S{XBc, (const char*)(w123 + W123_W1), 2048, 2048, 16, 6, G1_BF_TILES, 0, F.G, F.wg};
                { int tl_ = F.tid; asm volatile("" : "+v"(tl_)); pg8::gemm_phase(F.lds, S, E, tl_); } }
            {   pg8::SchedTiles S{(const char*)(F.dob + DO_XB8), (const char*)(F.dob + DO_W8 + (size_t)l * W8_STRIDE + W8_Z), 1024, 1024, 8, 8, G1_F8_TILES, 1, F.G, F.wg};
                { int tl_ = F.tid; asm volatile("" : "+v"(tl_)); pg8::gemm_phase<pg8::EpiStore, pg8::SchedTiles, true>(F.lds, S, E, tl_); } }
            SEAM(pb + 0);
        }
        if (SITE(2) && IN(pb + 1)) { SITE_BEGIN; const char* XBc = (const char*)(F.ws + WS_XB); (void)XBc; const unsigned char* w123 = F.ws + WS_W123; const unsigned char* w45 = F.ws + WS_W45 + (size_t)l * W45_STRIDE; (void)w123; (void)w45;
            {   unsigned* head = (unsigned*)(F.ws + WS_CTL) + CW_WQ + l * 64 + 32;
                for (;;) { const int i = mx::wq_next(F, head); if (i >= 128 + 1024) break;
                    if (i < 128) { if (subm & 2) mx::prepkv_unit(F, i, KA->in[6] + (size_t)l * 16 * 128, KA->in[7] + l * 128, (unsigned*)(F.ws + WS_CTL) + CW_KMAX + l * 64); }
                    else if (subm & 1) { const int u = i - 128; mx::b1_unit(F, u & 3, 255 - (u >> 2)); } } }
            SEAM(pb + 1);
        }
        if (SITE(3) && IN(pb + 2)) { SITE_BEGIN; const char* XBc = (const char*)(F.ws + WS_XB); (void)XBc; const unsigned char* w123 = F.ws + WS_W123; const unsigned char* w45 = F.ws + WS_W45 + (size_t)l * W45_STRIDE; (void)w123; (void)w45;
            if (subm & 1) mx::scan_phase(F);
            float lam_init = 0.8f - 0.6f * __expf(-0.3f * (float)l);
            const float* lp = KA->in[3] + l * 128; float s01 = 0.f, s23 = 0.f;
            for (int i = 0; i < 32; ++i) { s01 += lp[i] * lp[32 + i]; s23 += lp[64 + i] * lp[96 + i]; }
            mx::EngP P{(const bf16*)(F.ws + WS_Z), (bf16*)(F.ws + WS_Y), nullptr, nullptr, KA->in[4] + l * 64, __expf(s01) - __expf(s23) + lam_init, lam_init, (const unsigned*)(F.ws + WS_CTL) + CW_KMAX + l * 64};
            {   unsigned* head = (unsigned*)(F.ws + WS_CTL) + CW_WQ + l * 64;
                for (;;) { const int i = mx::wq_next(F, head); if (i >= 512) break; const int j = i & 127; mx::eng_unit<0>(F, P, j & 3, 3 - (i >> 7), 31 - (j >> 2)); } }
            SEAM(pb + 2);
        }
        if (SITE(4) && IN(pb + 3)) { SITE_BEGIN; const char* XBc = (const char*)(F.ws + WS_XB); (void)XBc; const unsigned char* w123 = F.ws + WS_W123; const unsigned char* w45 = F.ws + WS_W45 + (size_t)l * W45_STRIDE; (void)w123; (void)w45;
            {   unsigned* head = (unsigned*)(F.ws + WS_CTL) + CW_WQ + l * 64 + 16;
                const mx::EngP PB{(const bf16*)(F.ws + WS_Z), (bf16*)(F.ws + WS_Y), (const unsigned*)(F.ws + WS_MASK), nullptr, nullptr, 0.f, 0.f, (const unsigned*)(F.ws + WS_CTL) + CW_KMAX + l * 64};
                const mx::EngP PC{(const bf16*)(F.ws + WS_Z), (bf16*)(F.ws + WS_Y), nullptr, (const float*)(F.ws + WS_KVC), KA->in[5] + l * 256, 0.f, 0.f, nullptr};
                const mx::EngP PD{(const bf16*)(F.ws + WS_Z), (bf16*)(F.ws + WS_Y), nullptr, (const float*)(F.ws + WS_KVD), KA->in[8] + l * 64, 0.f, 0.f, nullptr};
                for (;;) { const int i = mx::wq_next(F, head); if (i >= 1536) break;
                    if (i < 512) { if (subm & 1) { const int j = i & 127; mx::eng_unit<1>(F, PB, j & 3, 3 - (i >> 7), 31 - (j >> 2)); } }
                    else if (!(subm & (i < 1024 ? 2 : 4))) continue;
                    else if (i < 1024) { const int u = i - 512; mx::eng_unit<2>(F, PC, u >> 7, (u >> 5) & 3, u & 31); }
                    else { const int u = i - 1024; mx::eng_unit<3>(F, PD, u >> 7, (u >> 5) & 3, u & 31); } } }
            SEAM(pb + 3);
        }
        if (SITE(5) && IN(pb + 4)) { SITE_BEGIN;
            const unsigned char* w123 = F.ws + WS_W123;
            for (int n = 0; n < 4; ++n) {
                {   pg8::SchedPlain S{(const char*)(F.dob + DO_XB8), (const char*)(F.dob + DO_W8 + (size_t)l * W8_STRIDE + W8_G) + (size_t)n * 1024 * 1024, 1024, 1024, 8, 128, 4, F.G, F.wg};
                    pg8::EpiSlotStore E{F.ws + WS_SCR2 + (size_t)F.wg * 262144, 1};
                    { int tl_ = F.tid; asm volatile("" : "+v"(tl_)); pg8::gemm_phase<pg8::EpiSlotStore, pg8::SchedPlain, true>(F.lds, S, E, tl_); } }
                {   pg8::SchedPlain S{(const char*)(F.ws + WS_Y) + n * 512, (const char*)(w123 + W123_GB + 8 * MiB) + (size_t)n * 1024 * 512, 2048, 512, 4, 128, 4, F.G, F.wg};
                    pg8::EpiBranch E{F.ws + WS_SCR2 + (size_t)F.wg * 262144, (bf16*)(F.ws + WS_MERGED), n == 0};
                    { int tl_ = F.tid; asm volatile("" : "+v"(tl_)); pg8::gemm_phase(F.lds, S, E, tl_); } }
            }
            SEAM(pb + 4);
        }
        if (SITE(6) && IN(pb + 5)) { SITE_BEGIN; const char* XBc = (const char*)(F.ws + WS_XB); (void)XBc; const unsigned char* w123 = F.ws + WS_W123; const unsigned char* w45 = F.ws + WS_W45 + (size_t)l * W45_STRIDE; (void)w123; (void)w45;
            pg8::SchedPlain S{(const char*)(F.ws + WS_MERGED), (const char*)(w123 + W123_WO), 2048, 2048, 16, 128, 4, F.G, F.wg};
            pg8::EpiG3 E{(bf16*)(F.ws + WS_XB)};
            pg8::gemm_phase(F.lds, S, E, F.tid);
            SEAM(pb + 5);
        }
        if (SITE(7) && IN(pb + 6)) { SITE_BEGIN; const char* XBc = (const char*)(F.ws + WS_XB); (void)XBc; const unsigned char* w123 = F.ws + WS_W123; const unsigned char* w45 = F.ws + WS_W45 + (size_t)l * W45_STRIDE; (void)w123; (void)w45; ln_phase(F, KA->in[11] + l * DM, KA->in[12] + l * DM, nullptr, F.dob + DO_XB8);
            if (l + 1 < DEPTH) convert_w123(F, KA->in[2] + (size_t)(l + 1) * DM * NIN, KA->in[9] + (size_t)(l + 1) * 4 * 256 * DM, KA->in[10] + (size_t)(l + 1) * DM * DM);
            SEAM(pb + 6); }
        if (SITE(8) && IN(pb + 7)) { SITE_BEGIN; const char* XBc = (const char*)(F.ws + WS_XB); (void)XBc; const unsigned char* w123 = F.ws + WS_W123; const unsigned char* w45 = F.ws + WS_W45 + (size_t)l * W45_STRIDE; (void)w123; (void)w45;
            pg8::SchedPlain S{(const char*)(F.dob + DO_XB8), (const char*)(F.dob + DO_W8 + (size_t)l * W8_STRIDE + W8_UP), 1024, 1024, 8, 128, 22, F.G, F.wg};
            pg8::EpiStore E{(bf16*)(F.ws + WS_UG), UGW};
            pg8::gemm_phase<pg8::EpiStore, pg8::SchedPlain, true>(F.lds, S, E, F.tid);
            SEAM(pb + 7);
        }
        if (SITE(9) && IN(pb + 8)) { SITE_BEGIN; const char* XBc = (const char*)(F.ws + WS_XB); (void)XBc; const unsigned char* w123 = F.ws + WS_W123; const unsigned char* w45 = F.ws + WS_W45 + (size_t)l * W45_STRIDE; (void)w123; (void)w45; ffn_act_phase(F, KA->in[14] + (size_t)l * 3 * DFF, KA->in[15] + (size_t)l * DFF); SEAM(pb + 8); }
        if (SITE(10) && IN(pb + 9)) { SITE_BEGIN;
            const unsigned char* w45 = F.ws + WS_W45 + (size_t)l * W45_STRIDE;
            {   pg8::SchedPlain S{(const char*)(F.ws + WS_PB + (size_t)l * M * PDIM * 2), (const char*)(w45 + W45_PP), 512, 512, 4, 128, 4, F.G, F.wg};
                pg8::EpiSlotStore E{F.dob + DO_SCR5 + (size_t)F.wg * 262144, 0};
                { int tl_ = F.tid; asm volatile("" : "+v"(tl_)); pg8::gemm_phase(F.lds, S, E, tl_); } }
            {   pg8::SchedPlain S{(const char*)(F.dob + DO_XB8), (const char*)(F.dob + DO_W8 + (size_t)l * W8_STRIDE + W8_PG), 1024, 1024, 8, 128, 4, F.G, F.wg};
                pg8::EpiSlotMul E{F.dob + DO_SCR5 + (size_t)F.wg * 262144};
                { int tl_ = F.tid; asm volatile("" : "+v"(tl_)); pg8::gemm_phase<pg8::EpiSlotMul, pg8::SchedPlain, true>(F.lds, S, E, tl_); } }
            SEAM(pb + 9);
        }
        if (SITE(11) && IN(pb + 10)) { SITE_BEGIN;
            const unsigned char* w45 = F.ws + WS_W45 + (size_t)l * W45_STRIDE;
            pg8::SchedG5b S{(const char*)(F.ws + WS_UG), (const char*)(F.dob + DO_W8 + (size_t)l * W8_STRIDE + W8_DN), F.G, F.wg};
            pg8::EpiG5b E{F.dob + DO_SCR5 + (size_t)F.wg * 262144, (bf16*)(F.ws + WS_XB)};
            pg8::gemm_phase<pg8::EpiG5b, pg8::SchedG5b, true>(F.lds, S, E, F.tid);
            SEAM(pb + 10);
        }
        if (SITE(12) && IN(pb + 11)) { SITE_BEGIN; const char* XBc = (const char*)(F.ws + WS_XB); (void)XBc; const unsigned char* w123 = F.ws + WS_W123; const unsigned char* w45 = F.ws + WS_W45 + (size_t)l * W45_STRIDE; (void)w123; (void)w45; ln_phase(F, KA->in[19] + l * DM, KA->in[20] + l * DM, l == DEPTH - 1 ? KA->out : nullptr, l == DEPTH - 1 ? nullptr : F.dob + DO_XB8); SEAM(pb + 11); }
    }
#undef IN
#undef SEAM
}

extern "C" void kernel_launch(void* const* d_in, const int* in_sizes, int n_in, void* d_out, int out_size, void* d_ws, size_t ws_size, hipStream_t stream) {
    static int grid = 0;
    if (grid == 0) {
        if (n_in != 21 || out_size != M * DM || ws_size < WS_END) { fprintf(stderr, "kernel_launch: unexpected shapes (n_in %d out %d ws %zu)\n", n_in, out_size, ws_size); grid = -1; return; }
        int dev = 0, cus = 0, per_cu = 0;
        if (hipGetDevice(&dev) != hipSuccess || hipDeviceGetAttribute(&cus, hipDeviceAttributeMultiprocessorCount, dev) != hipSuccess) { grid = -1; return; }
        if (hipFuncSetAttribute((const void*)fwd_kernel, hipFuncAttributeMaxDynamicSharedMemorySize, LDS_BYTES) != hipSuccess) { grid = -1; return; }
        if (hipOccupancyMaxActiveBlocksPerMultiprocessor(&per_cu, (const void*)fwd_kernel, NWAVES * 64, LDS_BYTES) != hipSuccess || per_cu < 1)
            fprintf(stderr, "kernel_launch: occupancy query reports %d\n", per_cu);
        (void)hipGetLastError();
        grid = cus;
    }
    if (grid < 0) return;
    (void)hipMemsetAsync((char*)d_ws + WS_CTL, 0, CTL_ZERO_BYTES, stream);
    Args a{};
    for (int i = 0; i < 21; ++i) a.in[i] = (const float*)d_in[i];
    a.out = (float*)d_out; a.ws = (unsigned char*)d_ws;
#if MK_ONE_LAUNCH
    a.ph_lo = 0; a.ph_hi = N_PHASES; a.sub = 7;
    hipLaunchKernelGGL(fwd_kernel, dim3(grid), dim3(NWAVES * 64), LDS_BYTES, stream, a);
#else
    for (int p = 0; p < N_PHASES; ++p) { a.ph_lo = p; a.ph_hi = p + 1; a.sub = 7;
        hipLaunchKernelGGL(fwd_kernel, dim3(grid), dim3(NWAVES * 64), LDS_BYTES, stream, a);
#ifdef PROBE_PHASE
        if (p >= 1 && (p - 1) % PH_PER_LAYER == PROBE_PHASE) { (void)hipMemsetAsync((char*)d_ws + WS_CTL + CW_WQ * 4, 0, 1024, stream); a.sub = PROBE_SUB;
            hipLaunchKernelGGL(fwd_kernel, dim3(grid), dim3(NWAVES * 64), LDS_BYTES, stream, a); }
#endif
    }
#endif
}
```

```cpp
#include <hip/hip_runtime.h>
#include <cstdio>
#include <cstdint>

#ifndef MK_ONE_LAUNCH
#define MK_ONE_LAUNCH 1
#endif

#define GAS __attribute__((address_space(1)))
#define LAS __attribute__((address_space(3)))
typedef unsigned short bf16;
typedef unsigned u32x4 __attribute__((ext_vector_type(4)));
typedef unsigned u32x2 __attribute__((ext_vector_type(2)));
typedef float f32x2 __attribute__((ext_vector_type(2)));
typedef float f32x4 __attribute__((ext_vector_type(4)));
typedef float f32x16 __attribute__((ext_vector_type(16)));
typedef short bf16x8 __attribute__((ext_vector_type(8)));
typedef short s16x4 __attribute__((ext_vector_type(4)));
typedef GAS unsigned gu32;

constexpr int BATCH = 4, SEQ = 8192, DM = 1024, M = BATCH * SEQ, DEPTH = 2;
constexpr int NIN = 7604, ZW = 3584, DFF = 2816, UGW = 5632, PDIM = 256;
constexpr float LN_EPS = 1e-5f;
constexpr float ALPHA = 1.41421356237f;
constexpr float LOG2E = 1.4426950408889634f;
constexpr int ZC_AQ = 0, ZC_AK = 256, ZC_AV = 512, ZC_BQ = 768, ZC_BK = 1024, ZC_BV = 1280, ZC_CQ = 1536, ZC_CK = 1792, ZC_CV = 2048, ZC_CG = 2304,
              ZC_DQ = 2560, ZC_DK = 2688, ZC_DV = 2816, ZC_DG = 3072, ZC_IQ = 3328, ZC_IK = 3456, ZC_IW = 3488, ZC_DA = 3504;
constexpr int SRC_MG = 3508;

constexpr size_t MiB = 1u << 20;
constexpr size_t WS_CTL = 0, CTL_ZERO_BYTES = 1 * MiB;
constexpr size_t WS_XB = 1 * MiB;
constexpr size_t WS_BIG = 65 * MiB;
constexpr size_t WS_Z = WS_BIG, WS_Y = WS_BIG + 224 * MiB, WS_MERGED = WS_BIG + 288 * MiB;
constexpr size_t WS_ACT8 = WS_BIG, WS_GS = WS_BIG + 96 * MiB, WS_GE = WS_BIG + 128 * MiB, WS_G0 = WS_BIG + 130 * MiB, WS_U0 = WS_BIG + 132 * MiB;
constexpr size_t WS_MASK = WS_MERGED, WS_KVC = WS_MERGED + 32 * MiB, WS_KVD = WS_MERGED + 40 * MiB, WS_DE = WS_MERGED + 56 * MiB;
constexpr size_t WS_SCR2 = WS_Z;
constexpr size_t WS_W45 = 417 * MiB, W45_STRIDE = 19 * MiB;
constexpr size_t W45_UP = 0, W45_PG = 11 * MiB, W45_PP = 13 * MiB, W45_DN = 13 * MiB + 512 * 1024;
constexpr size_t WS_PB = 455 * MiB;
constexpr size_t WS_W123 = 487 * MiB;
constexpr size_t WS_END = 506 * MiB;
constexpr size_t W123_W1 = 0, W123_GB = 7 * MiB, W123_WO = 17 * MiB;
constexpr size_t DO_SCR5 = 0;
constexpr size_t DO_XB8 = 64 * MiB;
constexpr size_t DO_W8 = 96 * MiB, W8_STRIDE = 15 * MiB + 256 * 1024, W8_G = 0, W8_UP = 4 * MiB, W8_PG = 9 * MiB + 512 * 1024, W8_DN = 10 * MiB + 512 * 1024, W8_Z = 13 * MiB + 256 * 1024;
constexpr unsigned long long G1_F8_TILES = 0xCB987652ull, G1_BF_TILES = 0xDA4310ull;

constexpr int CW_BAR = 4096, CW_WQ = 8448  , CW_KMAX = 8192;

constexpr int RING_BYTES = 131072;
constexpr int MISC_OFF = 131072 + 320;
constexpr int QST_OFF = 132096;
constexpr int LDS_BYTES = 147456;

constexpr int NWAVES = 8;

#define RLX_AGENT __ATOMIC_RELAXED, __HIP_MEMORY_SCOPE_AGENT
__device__ __forceinline__ unsigned f2bf(float f) { unsigned u = __builtin_bit_cast(unsigned, f); return (u + 0x7fffu + ((u >> 16) & 1u)) >> 16; }
typedef __bf16 bf16x2_t __attribute__((ext_vector_type(2)));
__device__ __forceinline__ unsigned pk2(float lo, float hi) { const f32x2 v = {lo, hi}; const bf16x2_t b = __builtin_convertvector(v, bf16x2_t); return __builtin_bit_cast(unsigned, b); }
__device__ __forceinline__ unsigned pk4f8(float a, float b, float c, float d) { int p = __builtin_amdgcn_cvt_pk_fp8_f32(a, b, 0, false); p = __builtin_amdgcn_cvt_pk_fp8_f32(c, d, p, true); return (unsigned)p; }
__device__ __forceinline__ float bflo(unsigned w) { return __uint_as_float(w << 16); }
__device__ __forceinline__ float bfhi(unsigned w) { return __uint_as_float(w & 0xffff0000u); }
__device__ __forceinline__ float bf1(bf16 b) { return __uint_as_float((unsigned)b << 16); }
__device__ __forceinline__ void up8(const u32x4 w, float (&v)[8]) { v[0] = bflo(w.x); v[1] = bfhi(w.x); v[2] = bflo(w.y); v[3] = bfhi(w.y); v[4] = bflo(w.z); v[5] = bfhi(w.z); v[6] = bflo(w.w); v[7] = bfhi(w.w); }
__device__ __forceinline__ float sigmoidf_(float x) { return __builtin_amdgcn_rcpf(1.0f + __builtin_amdgcn_exp2f(-LOG2E * x)); }
__device__ __forceinline__ float shx(float v, int lane, int m) { return __int_as_float(__builtin_amdgcn_ds_bpermute((lane ^ m) << 2, __float_as_int(v))); }
__device__ __forceinline__ unsigned shup(unsigned v, int lane, int o) { return (unsigned)__builtin_amdgcn_ds_bpermute((lane - o) << 2, (int)v); }
__device__ __forceinline__ float wave_sum(float v, int lane) {
#pragma unroll
    for (int o = 1; o < 64; o <<= 1) v += shx(v, lane, o);
    return v;
}

#define XB_TMO      128
#define XB_XCNT(j)  (256  + 64 * (j))
#define XB_XSUB(j)  (1280 + 64 * (j))
#define XB_XGEN(j)  (2304 + 64 * (j))
#define XB_TOP      3328
#define XB_TOPGEN   3392
#define XCD_BAR_WORDS 3456
#define XB_SPIN_CAP (1u << 22)

__device__ __forceinline__ unsigned xb_ld(unsigned* p)              { return __hip_atomic_load(p, __ATOMIC_RELAXED, __HIP_MEMORY_SCOPE_AGENT); }
__device__ __forceinline__ unsigned xb_add(unsigned* p, unsigned v) { return __hip_atomic_fetch_add(p, v, __ATOMIC_RELAXED, __HIP_MEMORY_SCOPE_AGENT); }
__device__ __forceinline__ unsigned xb_xcc_id() { return (unsigned)__builtin_amdgcn_s_getreg((3 << 11) | 20) & 0xFu; }
#define XB_SPIN(cond, bar) do { unsigned _sp = 0; while (cond) { __builtin_amdgcn_s_sleep(1); \
    if ((++_sp & 255u) == 0u) { if (xb_ld(&(bar)[XB_TMO])) break; if (_sp > XB_SPIN_CAP) { atomicAdd(&(bar)[XB_TMO], 1u); break; } } } } while (0)

struct XcdBarrier { unsigned* bar; unsigned x; volatile LAS unsigned* st; };

__device__ __forceinline__ XcdBarrier xcd_barrier_post(unsigned* bar, volatile LAS unsigned* st) {
    XcdBarrier b; b.bar = bar; b.x = xb_xcc_id(); b.st = st;
    if (threadIdx.x == 0) (void)xb_add(&bar[XB_XCNT(b.x)], 1u);
    return b;
}
__device__ __forceinline__ void xcd_barrier_complete(unsigned* bar, unsigned x, unsigned& nloc, unsigned& nx) {
    const unsigned G = gridDim.x * gridDim.y * gridDim.z;
    unsigned sum, cnt, mine, sp = 0u;
    for (;;) {
        sum = 0u; cnt = 0u; mine = 0u;
#pragma unroll
        for (unsigned j = 0; j < 16; ++j) { const unsigned c = xb_ld(&bar[XB_XCNT(j)]); sum += c; cnt += (c > 0u) ? 1u : 0u; mine = (j == x) ? c : mine; }
        if (sum == G) break;
        __builtin_amdgcn_s_sleep(1);
        if ((++sp & 255u) == 0u) { if (xb_ld(&bar[XB_TMO])) break; if (sp > XB_SPIN_CAP) { atomicAdd(&bar[XB_TMO], 1u); break; } }
    }
    nloc = mine > 0u ? mine : 1u; nx = cnt > 0u ? cnt : 1u;
}
__device__ __forceinline__ void xcd_barrier(const XcdBarrier& b, const bool leader_thread) {
    asm volatile("s_waitcnt vmcnt(0)" ::: "memory");
    __syncthreads();
    if (leader_thread) {
        unsigned* bar = b.bar;
        __builtin_amdgcn_s_waitcnt(0);
        unsigned nloc = b.st[0], nx = b.st[1];
        if (nloc == 0u) { xcd_barrier_complete(bar, b.x, nloc, nx); b.st[0] = nloc; b.st[1] = nx; }
        const unsigned old = xb_add(&bar[XB_XSUB(b.x)], 1u);
        const unsigned gen = old / nloc;
        if (old + 1u == (gen + 1u) * nloc) {
            __builtin_amdgcn_fence(__ATOMIC_RELEASE, "agent");
            asm volatile("s_waitcnt vmcnt(0)" ::: "memory");
            const unsigned og = xb_add(&bar[XB_TOP], 1u);
            const unsigned tg = og / nx;
            if (og + 1u == (tg + 1u) * nx) xb_add(&bar[XB_TOPGEN], 1u);
            else XB_SPIN(xb_ld(&bar[XB_TOPGEN]) == tg, bar);
            __builtin_amdgcn_fence(__ATOMIC_ACQUIRE, "agent");
            xb_add(&bar[XB_XGEN(b.x)], 1u);
            asm volatile("s_waitcnt vmcnt(0)" ::: "memory");
        } else {
            XB_SPIN(xb_ld(&bar[XB_XGEN(b.x)]) == gen, bar);
            __builtin_amdgcn_fence(__ATOMIC_ACQUIRE, "agent");
            asm volatile("s_waitcnt vmcnt(0)" ::: "memory");
        }
    }
    __syncthreads();
}

namespace pg8 {
constexpr int BM = 256, BK = 64, HALF = 128, HTB = HALF * BK * 2, STAGE_BYTES = 8 * HTB, NXCD = 8, WGM = 8;
__device__ __forceinline__ int lds_byte(int r, int c) { const int st = (r >> 4) * 2 + (c >> 5), rr = r & 15, cc = c & 31, ob = rr * 64 + cc * 2; return st * 1024 + (ob ^ (((ob >> 9) & 1) << 5)); }
__device__ __forceinline__ void stage_rc(int b, int& R, int& C) { const int st = b / 1024, sb = b % 1024, swz = sb ^ (((sb >> 9) & 1) << 5); R = (st >> 1) * 16 + swz / 64; C = (st & 1) * 32 + (swz % 64) / 2; }
__device__ __forceinline__ int perm32(int rho) { const int n = rho >> 4, i = rho & 15; return 8 * (i >> 2) + 4 * n + (i & 3); }

struct UnitD { const char* A; const char* B; int lda2, ldb2, nt, pm, pn, kind; };

__device__ __forceinline__ void tile_map(int L, int nM, int nN, int& pm, int& pn) {
    const int nwg = nM * nN; int wgid = L;
    { const int q = nwg / NXCD, r = nwg % NXCD, xcd = wgid % NXCD, off = wgid / NXCD; wgid = (xcd < r ? xcd * (q + 1) : r * (q + 1) + (xcd - r) * q) + off; }
    const int nig = WGM * nN, gid = wgid / nig, fm = gid * WGM, gsz = (nM - fm) < WGM ? (nM - fm) : WGM;
    pm = fm + ((wgid % nig) % gsz); pn = (wgid % nig) / gsz;
}

typedef int i32x8 __attribute__((ext_vector_type(8)));
template <class Epi, class Sched, bool FP8 = false>
__device__ __forceinline__ void gemm_phase(LAS unsigned char* lds, const Sched& S, const Epi& E, const int tid) {
    const int wid = __builtin_amdgcn_readfirstlane(tid >> 6), lane = tid & 63, wr = wid >> 2, wc = wid & 3, fr = lane & 15, fq = lane >> 4;
    int sR, sRb, sC2;
    { int R, C; stage_rc(tid * 16, R, C); sR = R; sRb = (R & ~31) + perm32(R & 31); sC2 = C * 2; }
    const size_t kstep = (size_t)(BK * 2);
    const unsigned ldsw = (unsigned)wid * 1024u;
    const int aoff = lds_byte(wr * 64 + fr, FP8 ? fq * 16 : fq * 8), boff = lds_byte(wc * 32 + fr, FP8 ? fq * 16 : fq * 8);
#define PG8_SA(b, h) (((b) * 2 + (h)) * HTB)
#define PG8_SB(b, h) ((4 + (b) * 2 + (h)) * HTB)
#define PG8_STAGE(bufoff, gbase, rows, pitch) do { const unsigned _o = (unsigned)((rows) * (pitch) + sC2); _Pragma("unroll") for (int _i = 0; _i < 2; ++_i) \
        __builtin_amdgcn_global_load_lds((const unsigned*)((const char*)(gbase) + (size_t)(_i * 64) * (pitch) + _o), (LAS unsigned*)(lds + (bufoff) + ldsw + _i * 8192), 16, 0, 0); } while (0)
#define PG8_LDA(dst, b, h) do { if constexpr (FP8) { _Pragma("unroll") for (int m = 0; m < 4; ++m) { const u32x4 lo_ = *(const LAS u32x4*)(lds + PG8_SA(b, h) + aoff + m * 2048), hi_ = *(const LAS u32x4*)(lds + PG8_SA(b, h) + aoff + m * 2048 + 16); \
            dst##8[m] = (i32x8){(int)lo_.x, (int)lo_.y, (int)lo_.z, (int)lo_.w, (int)hi_.x, (int)hi_.y, (int)hi_.z, (int)hi_.w}; } } \
        else { _Pragma("unroll") for (int m = 0; m < 4; ++m) _Pragma("unroll") for (int k = 0; k < 2; ++k) dst[m][k] = *(const LAS bf16x8*)(lds + PG8_SA(b, h) + aoff + m * 2048 + k * 1024); } } while (0)
#define PG8_LDB(dst, b, h) do { if constexpr (FP8) { _Pragma("unroll") for (int n = 0; n < 2; ++n) { const u32x4 lo_ = *(const LAS u32x4*)(lds + PG8_SB(b, h) + boff + n * 2048), hi_ = *(const LAS u32x4*)(lds + PG8_SB(b, h) + boff + n * 2048 + 16); \
            dst##8[n] = (i32x8){(int)lo_.x, (int)lo_.y, (int)lo_.z, (int)lo_.w, (int)hi_.x, (int)hi_.y, (int)hi_.z, (int)hi_.w}; } } \
        else { _Pragma("unroll") for (int n = 0; n < 2; ++n) _Pragma("unroll") for (int k = 0; k < 2; ++k) dst[n][k] = *(const LAS bf16x8*)(lds + PG8_SB(b, h) + boff + n * 2048 + k * 1024); } } while (0)
#define PG8_MMA(ai, bj, At, Bt) do { __builtin_amdgcn_s_setprio(1); if constexpr (FP8) { _Pragma("unroll") for (int m = 0; m < 4; ++m) _Pragma("unroll") for (int n = 0; n < 2; ++n) \
            asm volatile("v_mfma_scale_f32_16x16x128_f8f6f4 %0, %1, %2, %0, %3, %3 op_sel_hi:[0,0,0]" : "+v"(acc[ai][bj][m][n]) : "v"(Bt##8[n]), "v"(At##8[m]), "v"(scl8)); } \
        else { _Pragma("unroll") for (int m = 0; m < 4; ++m) _Pragma("unroll") for (int n = 0; n < 2; ++n) _Pragma("unroll") for (int k = 0; k < 2; ++k) \
            acc[ai][bj][m][n] = __builtin_amdgcn_mfma_f32_16x16x32_bf16(Bt[n][k], At[m][k], acc[ai][bj][m][n], 0, 0, 0); } __builtin_amdgcn_s_setprio(0); } while (0)
#define PG8_WAIT_V(n) asm volatile("s_waitcnt vmcnt(" #n ")" ::: "memory")
#define PG8_WAIT_L(n) asm volatile("s_waitcnt lgkmcnt(" #n ")" ::: "memory")
#define PG8_BAR __builtin_amdgcn_s_barrier()
#define PG8_SCHED __builtin_amdgcn_sched_barrier(0)
    UnitD cur, nxt; int ui = 0;
    if (!S.next(0, cur)) return;
    f32x4 acc[2][2][4][2];
#pragma unroll
    for (int a = 0; a < 2; ++a)
#pragma unroll
        for (int b = 0; b < 2; ++b)
#pragma unroll
            for (int m = 0; m < 4; ++m)
#pragma unroll
                for (int n = 0; n < 2; ++n) acc[a][b][m][n] = (f32x4){0.f, 0.f, 0.f, 0.f};
    bf16x8 At[4][2], B0[2][2], B1[2][2]; i32x8 At8[4], B08[2], B18[2];
    int scl8 = 0x7c7c7c7c; asm volatile("" : "+v"(scl8));
    const char* cA = cur.A; const char* cB = cur.B;
    int pA = cur.lda2, pB = cur.ldb2;
    PG8_STAGE(PG8_SB(0, 0), cB, sRb, pB); PG8_STAGE(PG8_SB(0, 1), cB + (size_t)HALF * pB, sRb, pB); PG8_STAGE(PG8_SA(0, 0), cA, sR, pA); PG8_STAGE(PG8_SA(0, 1), cA + (size_t)HALF * pA, sR, pA);
    if (wr == 1) PG8_BAR;
    PG8_WAIT_V(2); PG8_BAR;
    PG8_STAGE(PG8_SB(1, 0), cB + kstep, sRb, pB); PG8_STAGE(PG8_SA(1, 0), cA + kstep, sR, pA); PG8_STAGE(PG8_SB(1, 1), cB + (size_t)HALF * pB + kstep, sRb, pB);
    PG8_WAIT_V(6); PG8_BAR;
    for (;;) {
        const bool has_next = S.next(ui + 1, nxt);
        if (!has_next) nxt = cur;
        const char* nA = nxt.A; const char* nB = nxt.B;
        const int nt = cur.nt;
        for (int t = 0; t < nt; t += 2) {
            const bool last = (t == nt - 2);
            const char* a1 = cA + (size_t)(t + 1) * kstep + (size_t)HALF * pA;
            const char* a2 = last ? nA : cA + (size_t)(t + 2) * kstep; const char* b2 = last ? nB : cB + (size_t)(t + 2) * kstep;
            const int p2A = last ? nxt.lda2 : pA, p2B = last ? nxt.ldb2 : pB;
            const char* a2h = a2 + (size_t)HALF * p2A; const char* b2h = b2 + (size_t)HALF * p2B;
            PG8_LDB(B0, 0, 0); PG8_LDB(B1, 0, 1); PG8_SCHED; PG8_LDA(At, 0, 0); PG8_STAGE(PG8_SA(1, 1), a1, sR, pA);
            PG8_WAIT_V(8); PG8_WAIT_L(0); PG8_BAR; PG8_MMA(0, 0, At, B0); PG8_MMA(0, 1, At, B1); PG8_BAR; PG8_SCHED;
            PG8_LDA(At, 0, 1); PG8_STAGE(PG8_SB(0, 0), b2, sRb, p2B); PG8_STAGE(PG8_SB(0, 1), b2h, sRb, p2B); PG8_STAGE(PG8_SA(0, 0), a2, sR, p2A);
            PG8_WAIT_V(8); PG8_WAIT_L(0); PG8_BAR; PG8_MMA(1, 0, At, B0); PG8_MMA(1, 1, At, B1); PG8_BAR; PG8_SCHED;
            PG8_LDB(B0, 1, 0); PG8_LDB(B1, 1, 1); PG8_SCHED; PG8_LDA(At, 1, 0); PG8_STAGE(PG8_SA(0, 1), a2h, sR, p2A);
            PG8_WAIT_V(8); PG8_WAIT_L(0); PG8_BAR; PG8_MMA(0, 0, At, B0); PG8_MMA(0, 1, At, B1); PG8_BAR; PG8_SCHED;
            PG8_LDA(At, 1, 1); PG8_STAGE(PG8_SB(1, 0), b2 + kstep, sRb, p2B); PG8_STAGE(PG8_SB(1, 1), b2h + kstep, sRb, p2B); PG8_STAGE(PG8_SA(1, 0), a2 + kstep, sR, p2A);
            PG8_WAIT_V(8); PG8_WAIT_L(0); PG8_BAR; PG8_MMA(1, 0, At, B0); PG8_MMA(1, 1, At, B1); PG8_BAR; PG8_SCHED;
        }
        if constexpr (FP8) asm volatile("s_nop 15\n\ts_nop 15" ::: "memory");
        if (wr == 0) PG8_BAR;
        { int l2; asm volatile("v_mbcnt_lo_u32_b32 %0, -1, 0\n\tv_mbcnt_hi_u32_b32 %0, -1, %0" : "=v"(l2)); E(acc, cur, wr, wc, l2 & 15, l2 >> 4, wid * 64 + l2); }
        if (!has_next) break;
#pragma unroll
        for (int a = 0; a < 2; ++a)
#pragma unroll
            for (int b = 0; b < 2; ++b)
#pragma unroll
                for (int m = 0; m < 4; ++m)
#pragma unroll
                    for (int n = 0; n < 2; ++n) acc[a][b][m][n] = (f32x4){0.f, 0.f, 0.f, 0.f};
        cur = nxt; cA = nA; cB = nB; pA = cur.lda2; pB = cur.ldb2;
        ++ui;
        if (wr == 1) PG8_BAR;
    }
    PG8_WAIT_V(0);
    PG8_BAR;
#undef PG8_SA
#undef PG8_SB
#undef PG8_STAGE
#undef PG8_LDA
#undef PG8_LDB
#undef PG8_MMA
#undef PG8_WAIT_V
#undef PG8_WAIT_L
#undef PG8_BAR
#undef PG8_SCHED
}

struct SchedPlain {
    const char* A; const char* B; int lda2, ldb2, nt, nM, nN, G, c;
    __device__ __forceinline__ bool next(int i, UnitD& u) const {
        const long L = (long)i * G + c; if (L >= (long)nM * nN) return false;
        int pm, pn; tile_map((int)L, nM, nN, pm, pn);
        u.A = A + (size_t)pm * 256 * lda2; u.B = B + (size_t)pn * 256 * ldb2; u.lda2 = lda2; u.ldb2 = ldb2; u.nt = nt; u.pm = pm; u.pn = pn; u.kind = i; return true;
    }
};
struct SchedTiles {
    const char* A; const char* B; int lda2, ldb2, nt, ntile; unsigned long long list; int compact, G, c;
    __device__ __forceinline__ bool next(int i, UnitD& u) const {
        const long L = (long)i * G + c; if (L >= (long)128 * ntile) return false;
        int pm, pi; tile_map((int)L, 128, ntile, pm, pi); const int col = (int)((list >> (4 * pi)) & 15ull);
        u.A = A + (size_t)pm * 256 * lda2; u.B = B + (size_t)(compact ? pi : col) * 256 * ldb2; u.lda2 = lda2; u.ldb2 = ldb2; u.nt = nt; u.pm = pm; u.pn = col; u.kind = i; return true;
    }
};
struct SchedUp {
    const char* A; const char* B; int G, c;
    __device__ __forceinline__ bool next(int i, UnitD& u) const {
        const int it = i >> 1, sub = i & 1; const long L = (long)it * G + c; if (L >= 128 * 11) return false;
        int pm, cb; tile_map((int)L, 128, 11, pm, cb);
        u.A = A + (size_t)pm * 256 * 1024; u.lda2 = 1024; u.B = B + (size_t)((sub == 0 ? DFF : 0) + cb * 256) * 1024; u.ldb2 = 1024; u.nt = 8; u.pm = pm; u.pn = cb; u.kind = sub; return true;
    }
};
struct SchedG5b {
    const char* A; const char* B; int G, c;
    __device__ __forceinline__ bool next(int i, UnitD& u) const {
        const long L = (long)i * G + c; if (L >= 128 * 4) return false;
        int pm, pn; tile_map((int)L, 128, 4, pm, pn);
        u.A = A + (size_t)pm * 256 * DFF; u.lda2 = DFF; u.B = B + (size_t)pn * 256 * DFF; u.ldb2 = DFF; u.nt = 22; u.pm = pm; u.pn = pn; u.kind = i; return true;
    }
};

#define EPI_LOOP for (int ai = 0; ai < 2; ++ai) _Pragma("unroll") for (int m = 0; m < 4; ++m) _Pragma("unroll") for (int bj = 0; bj < 2; ++bj)
struct EpiStore {
    bf16* O; int ldc;
    __device__ __forceinline__ void operator()(const f32x4 (&acc)[2][2][4][2], const UnitD& u, int wr, int wc, int fr, int fq, int tid) const {
        const int row0 = u.pm * BM + wr * 64 + fr, col0 = u.pn * BM + wc * 32 + 8 * fq;
#pragma unroll
        EPI_LOOP { const f32x4 v0 = acc[ai][bj][m][0], v1 = acc[ai][bj][m][1];
            u32x4 w; w.x = pk2(v0[0], v0[1]); w.y = pk2(v0[2], v0[3]); w.z = pk2(v1[0], v1[1]); w.w = pk2(v1[2], v1[3]);
            *(u32x4*)(O + (size_t)(row0 + ai * HALF + m * 16) * ldc + col0 + bj * HALF) = w; }
    }
};
struct EpiSlotStore {
    unsigned char* sc_; int act;
    __device__ __forceinline__ void operator()(const f32x4 (&acc)[2][2][4][2], const UnitD& u, int wr, int wc, int fr, int fq, int tid) const {
        unsigned loff = (unsigned)tid * 16u; asm volatile("" : "+v"(loff));
        unsigned char* sc = sc_ + (size_t)u.kind * 131072 + loff;
#pragma unroll
        EPI_LOOP { const int q = (ai * 2 + bj) * 4 + m; f32x4 v0 = acc[ai][bj][m][0], v1 = acc[ai][bj][m][1];
            if (act) { v0 = (f32x4){sigmoidf_(v0[0]), sigmoidf_(v0[1]), sigmoidf_(v0[2]), sigmoidf_(v0[3])}; v1 = (f32x4){sigmoidf_(v1[0]), sigmoidf_(v1[1]), sigmoidf_(v1[2]), sigmoidf_(v1[3])}; }
            u32x4 w; w.x = pk2(v0[0], v0[1]); w.y = pk2(v0[2], v0[3]); w.z = pk2(v1[0], v1[1]); w.w = pk2(v1[2], v1[3]);
            *(u32x4*)(sc + (size_t)q * 8192) = w; }
    }
};
struct EpiSlotMul {
    unsigned char* sc_;
    __device__ __forceinline__ void operator()(const f32x4 (&acc)[2][2][4][2], const UnitD& u, int wr, int wc, int fr, int fq, int tid) const {
        unsigned loff = (unsigned)tid * 16u; asm volatile("" : "+v"(loff));
        unsigned char* sc = sc_ + (size_t)u.kind * 131072 + loff;
#pragma unroll
        EPI_LOOP { const int q = (ai * 2 + bj) * 4 + m; const f32x4 v0 = acc[ai][bj][m][0], v1 = acc[ai][bj][m][1];
            u32x4* sp = (u32x4*)(sc + (size_t)q * 8192); const u32x4 p = *sp;
            u32x4 w; w.x = pk2(sigmoidf_(v0[0]) * bflo(p.x), sigmoidf_(v0[1]) * bfhi(p.x)); w.y = pk2(sigmoidf_(v0[2]) * bflo(p.y), sigmoidf_(v0[3]) * bfhi(p.y));
            w.z = pk2(sigmoidf_(v1[0]) * bflo(p.z), sigmoidf_(v1[1]) * bfhi(p.z)); w.w = pk2(sigmoidf_(v1[2]) * bflo(p.w), sigmoidf_(v1[3]) * bfhi(p.w));
            *sp = w;
            if (m & 1) asm volatile("" ::: "memory"); }
    }
};
struct EpiBranch {
    const unsigned char* sc_; bf16* MG; int first;
    __device__ __forceinline__ void operator()(const f32x4 (&acc)[2][2][4][2], const UnitD& u, int wr, int wc, int fr, int fq, int tid) const {
        const int row0 = u.pm * BM + wr * 64 + fr, col0 = u.pn * BM + wc * 32 + 8 * fq;
        unsigned loff = (unsigned)tid * 16u; asm volatile("" : "+v"(loff));
        const unsigned char* sc = sc_ + (size_t)u.kind * 131072 + loff;
#pragma unroll
        EPI_LOOP { const int q = (ai * 2 + bj) * 4 + m; const f32x4 v0 = acc[ai][bj][m][0], v1 = acc[ai][bj][m][1];
            const u32x4 g = *(const u32x4*)(sc + (size_t)q * 8192);
            u32x4* p = (u32x4*)(MG + (size_t)(row0 + ai * HALF + m * 16) * DM + col0 + bj * HALF);
            f32x4 t0 = (f32x4){bflo(g.x) * v0[0], bfhi(g.x) * v0[1], bflo(g.y) * v0[2], bfhi(g.y) * v0[3]};
            f32x4 t1 = (f32x4){bflo(g.z) * v1[0], bfhi(g.z) * v1[1], bflo(g.w) * v1[2], bfhi(g.w) * v1[3]};
            if (!first) { const u32x4 x = *p; t0 += (f32x4){bflo(x.x), bfhi(x.x), bflo(x.y), bfhi(x.y)}; t1 += (f32x4){bflo(x.z), bfhi(x.z), bflo(x.w), bfhi(x.w)}; }
            u32x4 w; w.x = pk2(t0[0], t0[1]); w.y = pk2(t0[2], t0[3]); w.z = pk2(t1[0], t1[1]); w.w = pk2(t1[2], t1[3]);
            *p = w;
            if (m & 1) asm volatile("" ::: "memory"); }
    }
};
__device__ __forceinline__ float gelu_tanh_e(float y) { const float t = 1.5957691216057308f * (y + 0.044715f * y * y * y); return y * __builtin_amdgcn_rcpf(1.0f + __builtin_amdgcn_exp2f(-LOG2E * t)); }
struct EpiUp {
    bf16* GS; bf16* GE; bf16* G0; bf16* U0; unsigned char* ACT8; const float* cw; const float* cbias;
    __device__ __forceinline__ void operator()(const f32x4 (&acc)[2][2][4][2], const UnitD& u, int wr, int wc, int fr, int fq, int tid) const {
        const int rl0 = wr * 64 + fr, cl0 = wc * 32 + 8 * fq; const size_t eb = ((size_t)u.pm * 11 + u.pn) * 512;
        if (u.kind == 0) {
#pragma unroll
            EPI_LOOP { const f32x4 v0 = acc[ai][bj][m][0], v1 = acc[ai][bj][m][1]; const int r = rl0 + ai * HALF + m * 16, c = cl0 + bj * HALF;
                u32x4 w; w.x = pk2(v0[0], v0[1]); w.y = pk2(v0[2], v0[3]); w.z = pk2(v1[0], v1[1]); w.w = pk2(v1[2], v1[3]);
                *(u32x4*)(GS + (size_t)r * 256 + c) = w;
                if (r < 2) *(u32x4*)(G0 + eb + (size_t)r * 256 + c) = w;
                if (r >= 254) *(u32x4*)(GE + eb + (size_t)(r - 254) * 256 + c) = w; }
            asm volatile("s_waitcnt vmcnt(0)" ::: "memory");
        } else {
            unsigned gso = (unsigned)(rl0 * 256 + cl0) * 2u; asm volatile("" : "+v"(gso));
#pragma unroll
            for (int bj = 0; bj < 2; ++bj) { const int c = cl0 + bj * HALF, gc = u.pn * 256 + c; f32x4 wv[8];
                wv[0] = *(const f32x4*)(cw + gc); wv[1] = *(const f32x4*)(cw + gc + 4); wv[2] = *(const f32x4*)(cw + DFF + gc); wv[3] = *(const f32x4*)(cw + DFF + gc + 4);
                wv[4] = *(const f32x4*)(cw + 2 * DFF + gc); wv[5] = *(const f32x4*)(cw + 2 * DFF + gc + 4); wv[6] = *(const f32x4*)(cbias + gc); wv[7] = *(const f32x4*)(cbias + gc + 4);
#pragma unroll
                for (int ai = 0; ai < 2; ++ai)
#pragma unroll
                    for (int m = 0; m < 4; ++m) { const int r = rl0 + ai * HALF + m * 16; const f32x4 v0 = acc[ai][bj][m][0], v1 = acc[ai][bj][m][1];
                        const unsigned char* gp = (const unsigned char*)GS + gso + (unsigned)(((ai * HALF + m * 16) * 256 + bj * HALF) * 2);
                        const u32x4 z4 = (u32x4){0u, 0u, 0u, 0u};
                        const u32x4 q0 = *(const u32x4*)gp, q1 = (r >= 1) ? *(const u32x4*)(gp - 512) : z4, q2 = (r >= 2) ? *(const u32x4*)(gp - 1024) : z4;
                        float o[8];
#define ACT1(i, gw0, gw1, gw2, HI, uval) { const float g0_ = HI ? bfhi(gw0) : bflo(gw0), g1_ = HI ? bfhi(gw1) : bflo(gw1), g2_ = HI ? bfhi(gw2) : bflo(gw2); \
                            const float y_ = wv[6 + (i >> 2)][i & 3] + wv[(i >> 2)][i & 3] * g2_ + wv[2 + (i >> 2)][i & 3] * g1_ + wv[4 + (i >> 2)][i & 3] * g0_; o[i] = gelu_tanh_e(y_) * (uval); }
                        ACT1(0, q0.x, q1.x, q2.x, false, v0[0]) ACT1(1, q0.x, q1.x, q2.x, true, v0[1]) ACT1(2, q0.y, q1.y, q2.y, false, v0[2]) ACT1(3, q0.y, q1.y, q2.y, true, v0[3])
                        ACT1(4, q0.z, q1.z, q2.z, false, v1[0]) ACT1(5, q0.z, q1.z, q2.z, true, v1[1]) ACT1(6, q0.w, q1.w, q2.w, false, v1[2]) ACT1(7, q0.w, q1.w, q2.w, true, v1[3])
#undef ACT1
                        u32x2 w8; w8.x = pk4f8(o[0], o[1], o[2], o[3]); w8.y = pk4f8(o[4], o[5], o[6], o[7]);
                        *(u32x2*)(ACT8 + (size_t)(u.pm * BM + r) * DFF + gc) = w8;
                        if (r < 2) { u32x4 w; w.x = pk2(v0[0], v0[1]); w.y = pk2(v0[2], v0[3]); w.z = pk2(v1[0], v1[1]); w.w = pk2(v1[2], v1[3]); *(u32x4*)(U0 + eb + (size_t)r * 256 + c) = w; }
                        if (m & 1) asm volatile("" ::: "memory"); } }
        }
    }
};
struct EpiG3 {
    bf16* XB;
    __device__ __forceinline__ void operator()(const f32x4 (&acc)[2][2][4][2], const UnitD& u, int wr, int wc, int fr, int fq, int tid) const {
        const int row0 = u.pm * BM + wr * 64 + fr, col0 = u.pn * BM + wc * 32 + 8 * fq;
#pragma unroll
        EPI_LOOP { const f32x4 v0 = acc[ai][bj][m][0], v1 = acc[ai][bj][m][1];
            u32x4* p = (u32x4*)(XB + (size_t)(row0 + ai * HALF + m * 16) * DM + col0 + bj * HALF); const u32x4 x = *p;
            u32x4 w; w.x = pk2(ALPHA * bflo(x.x) + v0[0], ALPHA * bfhi(x.x) + v0[1]); w.y = pk2(ALPHA * bflo(x.y) + v0[2], ALPHA * bfhi(x.y) + v0[3]);
            w.z = pk2(ALPHA * bflo(x.z) + v1[0], ALPHA * bfhi(x.z) + v1[1]); w.w = pk2(ALPHA * bflo(x.w) + v1[2], ALPHA * bfhi(x.w) + v1[3]);
            *p = w; }
    }
};
struct EpiG5b {
    const unsigned char* esc_; bf16* XB;
    __device__ __forceinline__ void operator()(const f32x4 (&acc)[2][2][4][2], const UnitD& u, int wr, int wc, int fr, int fq, int tid) const {
        const int row0 = u.pm * BM + wr * 64 + fr, col0 = u.pn * BM + wc * 32 + 8 * fq;
        unsigned loff = (unsigned)tid * 16u; asm volatile("" : "+v"(loff));
        const unsigned char* esc = esc_ + (size_t)u.kind * 131072 + loff;
#pragma unroll
        EPI_LOOP { const int q = (ai * 2 + bj) * 4 + m; const f32x4 v0 = acc[ai][bj][m][0], v1 = acc[ai][bj][m][1];
            const u32x4 e = *(const u32x4*)(esc + (size_t)q * 8192);
            u32x4* p = (u32x4*)(XB + (size_t)(row0 + ai * HALF + m * 16) * DM + col0 + bj * HALF); const u32x4 x = *p;
            u32x4 w; w.x = pk2(ALPHA * bflo(x.x) + v0[0] + bflo(e.x), ALPHA * bfhi(x.x) + v0[1] + bfhi(e.x)); w.y = pk2(ALPHA * bflo(x.y) + v0[2] + bflo(e.y), ALPHA * bfhi(x.y) + v0[3] + bfhi(e.y));
            w.z = pk2(ALPHA * bflo(x.z) + v1[0] + bflo(e.z), ALPHA * bfhi(x.z) + v1[1] + bfhi(e.z)); w.w = pk2(ALPHA * bflo(x.w) + v1[2] + bflo(e.w), ALPHA * bfhi(x.w) + v1[3] + bfhi(e.w));
            *p = w;
            if (m & 1) asm volatile("" ::: "memory"); }
    }
};
}

struct Frame {
    LAS unsigned char* lds;
    int tid, lane, wave, G, wg;
    unsigned char* ws; unsigned char* dob;
};
struct Args { const float* in[21]; float* out; unsigned char* ws; int ph_lo, ph_hi, sub, pad; };

__device__ __forceinline__ int z_src(int n, float& sc) {
    sc = 1.f;
    if (n < 768) { if (n < 256) sc = 0.17677669529663687f * LOG2E; return n; }
    if (n < 1536) { if (n < 1024) sc = 0.125f * LOG2E; return n; }
    if (n < 2560) { if (n >= 1792 && n < 2048) sc = 0.125f; return 1700 + (n - 1536); }
    if (n < 2816) { if (n < 2688) sc = 0.17677669529663687f; return 2724 + (n - 2560); }
    if (n < 3072) return 2980 + (n - 2816);
    if (n < 3328) return 3252 + (n - 3072);
    if (n < 3456) return 1536 + (n - 3328);
    if (n < 3488) return 1664 + (n - 3456);
    if (n < 3492) return 1696 + (n - 3488);
    if (n >= 3504 && n < 3520) return 3236 + (n - 3504);
    return -1;
}
template <int MODE>
__device__ __forceinline__ void transpose_item(const float* W, int Nsrc, int soff, bf16* WT, int dpitch, int dcol0, int k0, int n0, LAS float* scr, int lane) {
    const int nn = lane & 31; float sc = 1.f; int s;
    if (MODE == 1) s = z_src(n0 + nn, sc); else s = soff + n0 + nn;
#pragma unroll 8
    for (int i = 0; i < 32; ++i) { const int kk = 2 * i + (lane >> 5); scr[kk * 33 + nn] = (s >= 0) ? W[(size_t)(k0 + kk) * Nsrc + s] * sc : 0.f; }
    asm volatile("s_waitcnt lgkmcnt(0)" ::: "memory");
    const int c = lane & 7;
#pragma unroll
    for (int j = 0; j < 4; ++j) { const int n = (lane >> 3) + 8 * j; const LAS float* sp = scr + (8 * c) * 33 + n;
        u32x4 o; o.x = pk2(sp[0 * 33], sp[1 * 33]); o.y = pk2(sp[2 * 33], sp[3 * 33]); o.z = pk2(sp[4 * 33], sp[5 * 33]); o.w = pk2(sp[6 * 33], sp[7 * 33]);
        *(u32x4*)(WT + (size_t)(n0 + n) * dpitch + dcol0 + k0 + 8 * c) = o; }
    asm volatile("s_waitcnt lgkmcnt(0)" ::: "memory");
}
__device__ __forceinline__ void transpose_item8(const float* W, int Nsrc, int soff, unsigned char* WT, int K, int k0, int n0, LAS float* scr, int lane) {
    const int nn = lane & 31; const int s = soff + n0 + nn;
#pragma unroll 8
    for (int i = 0; i < 32; ++i) { const int kk = 2 * i + (lane >> 5); scr[kk * 33 + nn] = W[(size_t)(k0 + kk) * Nsrc + s] * 64.f; }
    asm volatile("s_waitcnt lgkmcnt(0)" ::: "memory");
    const int c = lane & 7;
#pragma unroll
    for (int j = 0; j < 4; ++j) { const int n = (lane >> 3) + 8 * j; const LAS float* sp = scr + (8 * c) * 33 + n;
        u32x2 o; o.x = pk4f8(sp[0 * 33], sp[1 * 33], sp[2 * 33], sp[3 * 33]); o.y = pk4f8(sp[4 * 33], sp[5 * 33], sp[6 * 33], sp[7 * 33]);
        *(u32x2*)(WT + (size_t)(n0 + n) * K + k0 + 8 * c) = o; }
    asm volatile("s_waitcnt lgkmcnt(0)" ::: "memory");
}
__device__ __forceinline__ void transpose_item8z(const float* W, unsigned char* WT, int tile, int slot, int k0, int n0, LAS float* scr, int lane) {
    const int nn = lane & 31; float sc = 1.f; const int s = z_src(tile * 256 + n0 + nn, sc); sc *= 64.f;
#pragma unroll 8
    for (int i = 0; i < 32; ++i) { const int kk = 2 * i + (lane >> 5); scr[kk * 33 + nn] = (s >= 0) ? W[(size_t)(k0 + kk) * NIN + s] * sc : 0.f; }
    asm volatile("s_waitcnt lgkmcnt(0)" ::: "memory");
    const int c = lane & 7;
#pragma unroll
    for (int j = 0; j < 4; ++j) { const int n = (lane >> 3) + 8 * j; const LAS float* sp = scr + (8 * c) * 33 + n;
        u32x2 o; o.x = pk4f8(sp[0 * 33], sp[1 * 33], sp[2 * 33], sp[3 * 33]); o.y = pk4f8(sp[4 * 33], sp[5 * 33], sp[6 * 33], sp[7 * 33]);
        *(u32x2*)(WT + (size_t)(slot * 256 + n0 + n) * 1024 + k0 + 8 * c) = o; }
    asm volatile("s_waitcnt lgkmcnt(0)" ::: "memory");
}
typedef __attribute__((address_space(4))) const struct Args* KArgPtr;
__device__ __forceinline__ void convert_w123(Frame& F, const float* w_in, const float* w_branch, const float* w_out) {
    LAS float* scr = (LAS float*)(F.lds + F.wave * 16384);
    const int gw = F.wg * NWAVES + F.wave, NGW = F.G * NWAVES;
    constexpr int I1 = 16 * 48, I2 = 0, I3 = 4 * 128, I4 = 16 * 32;
    unsigned char* w123 = F.ws + WS_W123;
    for (int it = gw; it < I1 + I2 + I3 + I4; it += NGW) {
        int r = it;
        if (r < I1) { const int nb = r % 48, tile = (int)((G1_BF_TILES >> (4 * (nb >> 3))) & 15); transpose_item<1>(w_in, NIN, 0, (bf16*)(w123 + W123_W1), 1024, 0, 64 * (r / 48), tile * 256 + 32 * (nb & 7), scr, F.lane); continue; } r -= I1;
        if (r < I3) { const int n = r / 128, rr = r % 128; transpose_item<0>(w_branch + (size_t)n * 256 * DM, DM, 0, (bf16*)(w123 + W123_GB + 8 * MiB) + (size_t)n * 1024 * 256, 256, 0, 64 * (rr / 32), 32 * (rr % 32), scr, F.lane); continue; } r -= I3;
        transpose_item<0>(w_out, DM, 0, (bf16*)(w123 + W123_WO), 1024, 0, 64 * (r / 32), 32 * (r % 32), scr, F.lane);
    }
}
__device__ __forceinline__ void p0_prologue(Frame& F, __attribute__((address_space(4))) const Args* Ap) {
    LAS float* scr = (LAS float*)(F.lds + F.wave * 16384);
    const int gw = F.wg * NWAVES + F.wave, NGW = F.G * NWAVES;
    constexpr int I5 = 0, I6 = 0, I7 = 4 * 32, I8 = 0;
    constexpr int IL = I5 + I6 + I7 + I8;
    for (int it = gw; it < 2 * IL; it += NGW) {
        const int l = it / IL; int r = it - l * IL;
        unsigned char* w45 = F.ws + WS_W45 + (size_t)l * W45_STRIDE;
        if (r < I7) { transpose_item<0>(Ap->in[18] + (size_t)l * PDIM * DM, DM, 0, (bf16*)(w45 + W45_PP), 256, 0, 64 * (r / 32), 32 * (r % 32), scr, F.lane); continue; } r -= I7;
        transpose_item<0>(Ap->in[16] + (size_t)l * DFF * DM, DM, 0, (bf16*)(w45 + W45_DN), DFF, 0, 64 * (r / 32), 32 * (r % 32), scr, F.lane);
    }
    {   constexpr int J1 = 16 * 128, J2 = 16 * 176, J3 = 16 * 32, J4 = 44 * 32, J5 = 8 * 16 * 8, JL = J1 + J2 + J3 + J4 + J5;
        for (int it = gw; it < 2 * JL; it += NGW) { const int l = it / JL; int r = it - l * JL; unsigned char* w8 = F.dob + DO_W8 + (size_t)l * W8_STRIDE;
            if (r < J1) { transpose_item8(Ap->in[2] + (size_t)l * DM * NIN, NIN, SRC_MG, w8 + W8_G, 1024, 64 * (r / 128), 32 * (r % 128), scr, F.lane); continue; } r -= J1;
            if (r < J2) { transpose_item8(Ap->in[13] + (size_t)l * DM * UGW, UGW, 0, w8 + W8_UP, 1024, 64 * (r / 176), 32 * (r % 176), scr, F.lane); continue; } r -= J2;
            if (r < J3) { transpose_item8(Ap->in[17] + (size_t)l * DM * DM, DM, 0, w8 + W8_PG, 1024, 64 * (r / 32), 32 * (r % 32), scr, F.lane); continue; } r -= J3;
            if (r < J4) { transpose_item8(Ap->in[16] + (size_t)l * DFF * DM, DM, 0, w8 + W8_DN, DFF, 64 * (r / 32), 32 * (r % 32), scr, F.lane); continue; } r -= J4;
            { const int slot = r >> 7, rr = r & 127; transpose_item8z(Ap->in[2] + (size_t)l * DM * NIN, w8 + W8_Z, (int)((G1_F8_TILES >> (4 * slot)) & 15), slot, 64 * (rr >> 3), 32 * (rr & 7), scr, F.lane); } } }
    convert_w123(F, Ap->in[2], Ap->in[9], Ap->in[10]);
    {   const size_t n8 = (size_t)M * DM / 8; const f32x4* src = (const f32x4*)Ap->in[0]; u32x4* dst = (u32x4*)(F.ws + WS_XB); u32x2* dst8 = (u32x2*)(F.dob + DO_XB8);
        for (size_t i = (size_t)F.wg * 512 + F.tid; i < n8; i += (size_t)F.G * 512) { const f32x4 a = src[2 * i], b = src[2 * i + 1]; u32x4 o; o.x = pk2(a[0], a[1]); o.y = pk2(a[2], a[3]); o.z = pk2(b[0], b[1]); o.w = pk2(b[2], b[3]); dst[i] = o;
            u32x2 o8; o8.x = pk4f8(a[0], a[1], a[2], a[3]); o8.y = pk4f8(b[0], b[1], b[2], b[3]); dst8[i] = o8; } }
    {   const size_t n8 = (size_t)DEPTH * M * PDIM / 8; const f32x4* src = (const f32x4*)Ap->in[1]; u32x4* dst = (u32x4*)(F.ws + WS_PB);
        for (size_t i = (size_t)F.wg * 512 + F.tid; i < n8; i += (size_t)F.G * 512) { const f32x4 a = src[2 * i], b = src[2 * i + 1]; u32x4 o; o.x = pk2(a[0], a[1]); o.y = pk2(a[2], a[3]); o.z = pk2(b[0], b[1]); o.w = pk2(b[2], b[3]); dst[i] = o; } }
}

__device__ __forceinline__ void ln_phase(Frame& F, const float* w, const float* bvec, float* outf, unsigned char* xb8) {
    const int gw = F.wg * NWAVES + F.wave, NGW = F.G * NWAVES;
    bf16* XB = (bf16*)(F.ws + WS_XB);
    for (int row = gw; row < M; row += NGW) {
        u32x4* p = (u32x4*)(XB + (size_t)row * DM) + F.lane;
        const u32x4 a = p[0], b = p[64];
        float v[16] = {bflo(a.x), bfhi(a.x), bflo(a.y), bfhi(a.y), bflo(a.z), bfhi(a.z), bflo(a.w), bfhi(a.w), bflo(b.x), bfhi(b.x), bflo(b.y), bfhi(b.y), bflo(b.z), bfhi(b.z), bflo(b.w), bfhi(b.w)};
        float s = 0.f;
#pragma unroll
        for (int i = 0; i < 16; ++i) s += v[i];
        const float mean = wave_sum(s, F.lane) * (1.f / DM); float q = 0.f;
#pragma unroll
        for (int i = 0; i < 16; ++i) { v[i] -= mean; q += v[i] * v[i]; }
        const float rstd = 1.f / sqrtf(wave_sum(q, F.lane) * (1.f / DM) + LN_EPS);
        const int c0 = F.lane * 8, c1 = 512 + F.lane * 8;
        const f32x4 w0 = *(const f32x4*)(w + c0), w1 = *(const f32x4*)(w + c0 + 4), w2 = *(const f32x4*)(w + c1), w3 = *(const f32x4*)(w + c1 + 4);
        const f32x4 b0 = *(const f32x4*)(bvec + c0), b1 = *(const f32x4*)(bvec + c0 + 4), b2 = *(const f32x4*)(bvec + c1), b3 = *(const f32x4*)(bvec + c1 + 4);
        f32x4 y0, y1, y2, y3;
#pragma unroll
        for (int i = 0; i < 4; ++i) { y0[i] = v[i] * rstd * w0[i] + b0[i]; y1[i] = v[4 + i] * rstd * w1[i] + b1[i]; y2[i] = v[8 + i] * rstd * w2[i] + b2[i]; y3[i] = v[12 + i] * rstd * w3[i] + b3[i]; }
        u32x4 o0, o1; o0.x = pk2(y0[0], y0[1]); o0.y = pk2(y0[2], y0[3]); o0.z = pk2(y1[0], y1[1]); o0.w = pk2(y1[2], y1[3]);
        o1.x = pk2(y2[0], y2[1]); o1.y = pk2(y2[2], y2[3]); o1.z = pk2(y3[0], y3[1]); o1.w = pk2(y3[2], y3[3]);
        p[0] = o0; p[64] = o1;
        if (xb8) { u32x2* q8 = (u32x2*)(xb8 + (size_t)row * DM) + F.lane; u32x2 a8, b8; a8.x = pk4f8(y0[0], y0[1], y0[2], y0[3]); a8.y = pk4f8(y1[0], y1[1], y1[2], y1[3]); b8.x = pk4f8(y2[0], y2[1], y2[2], y2[3]); b8.y = pk4f8(y3[0], y3[1], y3[2], y3[3]); q8[0] = a8; q8[64] = b8; }
        if (outf) { f32x4* op = (f32x4*)(outf + (size_t)row * DM); op[2 * F.lane] = y0; op[2 * F.lane + 1] = y1; op[128 + 2 * F.lane] = y2; op[128 + 2 * F.lane + 1] = y3; }
    }
}

__device__ __forceinline__ float gelu_tanh_(float y) { const float t = 1.5957691216057308f * (y + 0.044715f * y * y * y); return y * __builtin_amdgcn_rcpf(1.0f + __builtin_amdgcn_exp2f(-LOG2E * t)); }
__device__ __forceinline__ void ffn_act_phase(Frame& F, const float* cw, const float* cb) {
    const bf16* GE = (const bf16*)(F.ws + WS_GE); const bf16* G0 = (const bf16*)(F.ws + WS_G0); const bf16* U0 = (const bf16*)(F.ws + WS_U0); unsigned char* ACT8 = F.ws + WS_ACT8;
    for (int idx = F.wg * 512 + F.tid; idx < 128 * 11 * 2 * 32; idx += F.G * 512) {
        const int v = idx & 31, r = (idx >> 5) & 1, t = idx >> 6, cb_ = t % 11, pm = t / 11; const int c = 8 * v, gc = cb_ * 256 + c;
        const size_t eb = ((size_t)pm * 11 + cb_) * 512, ebp = ((size_t)(pm - 1) * 11 + cb_) * 512; const bool first = (pm & 31) == 0;
        const u32x4 z4 = (u32x4){0u, 0u, 0u, 0u};
        float gA[8], gB[8], gC[8], uu[8];
        if (r == 0) { up8(first ? z4 : *(const u32x4*)(GE + ebp + c), gA); up8(first ? z4 : *(const u32x4*)(GE + ebp + 256 + c), gB); up8(*(const u32x4*)(G0 + eb + c), gC); }
        else { up8(first ? z4 : *(const u32x4*)(GE + ebp + 256 + c), gA); up8(*(const u32x4*)(G0 + eb + c), gB); up8(*(const u32x4*)(G0 + eb + 256 + c), gC); }
        up8(*(const u32x4*)(U0 + eb + (size_t)r * 256 + c), uu);
        float o[8];
#pragma unroll
        for (int i = 0; i < 8; ++i) { const float y = cb[gc + i] + cw[gc + i] * gA[i] + cw[DFF + gc + i] * gB[i] + cw[2 * DFF + gc + i] * gC[i]; o[i] = gelu_tanh_(y) * uu[i]; }
        u32x2 w8; w8.x = pk4f8(o[0], o[1], o[2], o[3]); w8.y = pk4f8(o[4], o[5], o[6], o[7]);
        *(u32x2*)(ACT8 + (size_t)(pm * 256 + r) * DFF + gc) = w8;
    }
}

namespace mx {
__device__ __forceinline__ f32x16 mfma32(bf16x8 a, bf16x8 b, f32x16 c) { return __builtin_amdgcn_mfma_f32_32x32x16_bf16(a, b, c, 0, 0, 0); }
__device__ __forceinline__ f32x16 splat16(float v) { f32x16 r;
#pragma unroll
    for (int i = 0; i < 16; ++i) r[i] = v;
    return r; }
__device__ __forceinline__ int crow_c(int e) { return (e & 3) + 8 * (e >> 2); }
typedef short v4i16_t __attribute__((ext_vector_type(4)));
__device__ __forceinline__ s16x4 vtr(const LAS unsigned char* p) { return __builtin_bit_cast(s16x4, __builtin_amdgcn_ds_read_tr16_b64_v4i16((LAS v4i16_t*)p)); }
__device__ __forceinline__ bf16x8 pack8(float a0, float a1, float a2, float a3, float a4, float a5, float a6, float a7) {
    u32x4 w; w.x = pk2(a0, a1); w.y = pk2(a2, a3); w.z = pk2(a4, a5); w.w = pk2(a6, a7); return __builtin_bit_cast(bf16x8, w); }

__device__ __forceinline__ float log2gam(int h) { return __builtin_log2f(1.0f - __builtin_exp2f(-5.0f - (float)h)); }
__device__ __forceinline__ void prepkv_unit(Frame& F, int blk, const float* wa2, const float* bap, unsigned* kmaxl) {
    bf16* Z = (bf16*)(F.ws + WS_Z);
    const size_t r0 = (size_t)blk * 256; const int b = blk >> 5, cb = blk & 31;
    const int tid = F.tid;
    {   const int ch = tid >> 7, col = tid & 127;
        const float ba = bap[col];
        float wa[16];
#pragma unroll
        for (int r = 0; r < 16; ++r) wa[r] = wa2[r * 128 + col];
        float cum = 0.f;
        for (int t0 = 0; t0 < 64; t0 += 8) { u32x4 A[8], B[8];
#pragma unroll
            for (int tt = 0; tt < 8; ++tt) { const bf16* zr = Z + (r0 + ch * 64 + t0 + tt) * ZW; A[tt] = *(const u32x4*)(zr + ZC_DA); B[tt] = *(const u32x4*)(zr + ZC_DA + 8); }
#pragma unroll
            for (int tt = 0; tt < 8; ++tt) { float da[8], db[8]; up8(A[tt], da); up8(B[tt], db); float x = ba;
#pragma unroll
                for (int r = 0; r < 8; ++r) x += da[r] * wa[r];
#pragma unroll
                for (int r = 0; r < 8; ++r) x += db[r] * wa[8 + r];
                cum += (fminf(x, 0.f) - __logf(1.0f + __expf(-fabsf(x)))) * 0.0625f; } }
        const float bl = cum; cum = 0.f;
        for (int t0 = 0; t0 < 64; t0 += 8) { u32x4 A[8], B[8]; bf16 qv[8], kv[8];
#pragma unroll
            for (int tt = 0; tt < 8; ++tt) { const bf16* zr = Z + (r0 + ch * 64 + t0 + tt) * ZW; A[tt] = *(const u32x4*)(zr + ZC_DA); B[tt] = *(const u32x4*)(zr + ZC_DA + 8); qv[tt] = zr[ZC_DQ + col]; kv[tt] = zr[ZC_DK + col]; }
#pragma unroll
            for (int tt = 0; tt < 8; ++tt) { bf16* zr = Z + (r0 + ch * 64 + t0 + tt) * ZW; float da[8], db[8]; up8(A[tt], da); up8(B[tt], db); float x = ba;
#pragma unroll
                for (int r = 0; r < 8; ++r) x += da[r] * wa[r];
#pragma unroll
                for (int r = 0; r < 8; ++r) x += db[r] * wa[8 + r];
                cum += (fminf(x, 0.f) - __logf(1.0f + __expf(-fabsf(x)))) * 0.0625f;
                zr[ZC_DQ + col] = (bf16)f2bf(bf1(qv[tt]) * __expf(cum - bl)); zr[ZC_DK + col] = (bf16)f2bf(bf1(kv[tt]) * __expf(bl - cum)); } }
        ((float*)(F.ws + WS_DE))[((size_t)b * 128 + cb * 4 + ch) * 128 + col] = __expf(bl);
    }
    for (int itn = 0; itn < 6; ++itn) { const int task = tid + 512 * itn, sl = task >> 8, row = task & 255;
        const bf16* kp = Z + (r0 + row) * ZW + (sl < 8 ? ZC_AK + (sl >> 1) * 64 + (sl & 1) * 32 : ZC_BK + (sl - 8) * 64); float ss = 0.f;
        const int nch = sl < 8 ? 4 : 8;
        for (int c = 0; c < nch; ++c) { float v[8]; up8(*(const u32x4*)(kp + 8 * c), v);
#pragma unroll
            for (int i = 0; i < 8; ++i) ss += v[i] * v[i]; }
#pragma unroll
        for (int o = 1; o < 64; o <<= 1) ss = fmaxf(ss, shx(ss, F.lane, o));
        if (F.lane == 0) __hip_atomic_fetch_max(kmaxl + b * 16 + sl, __float_as_uint(sqrtf(ss)), __ATOMIC_RELAXED, __HIP_MEMORY_SCOPE_AGENT); }
    for (int i0 = 0; i0 < 32; i0 += 4) { u32x4 vv[4];
#pragma unroll
        for (int k = 0; k < 4; ++k) { const int idx = tid + 512 * (i0 + k); const int row = idx >> 6, chunk = idx & 63, isk = chunk >> 5, c8 = (chunk & 31) * 8;
            vv[k] = *(const u32x4*)(Z + (r0 + row) * ZW + (isk ? ZC_CK : ZC_CQ) + c8); }
#pragma unroll
        for (int k = 0; k < 4; ++k) { const int idx = tid + 512 * (i0 + k); const int row = idx >> 6, chunk = idx & 63, isk = chunk >> 5, c8 = (chunk & 31) * 8, h = c8 >> 6;
            const float e = (float)(255 - row) * log2gam(h); const float f = __builtin_amdgcn_exp2f(isk ? e : -e); float v[8]; up8(vv[k], v);
            u32x4 w; w.x = pk2(v[0] * f, v[1] * f); w.y = pk2(v[2] * f, v[3] * f); w.z = pk2(v[4] * f, v[5] * f); w.w = pk2(v[6] * f, v[7] * f);
            *(u32x4*)(Z + (r0 + row) * ZW + (isk ? ZC_CK : ZC_CQ) + c8) = w; } }
    __threadfence_block(); __syncthreads();
    LAS unsigned char* Kl = F.lds; LAS unsigned char* Vl = F.lds + 36864;
    for (int h = 0; h < 4; ++h) {
        for (int idx = tid; idx < 256 * 8; idx += 512) { const int row = idx >> 3, c = idx & 7;
            *(LAS u32x4*)(Kl + row * 144 + c * 16) = *(const u32x4*)(Z + (r0 + row) * ZW + ZC_CK + h * 64 + c * 8);
            *(LAS u32x4*)(Vl + row * 144 + c * 16) = *(const u32x4*)(Z + (r0 + row) * ZW + ZC_CV + h * 64 + c * 8); }
        __syncthreads();
        {   const int d = tid >> 3, dk8 = (tid & 7) * 8; float acc[8];
#pragma unroll
            for (int i = 0; i < 8; ++i) acc[i] = 0.f;
            for (int j = 0; j < 256; ++j) { const float vv = bf1(*(const LAS bf16*)(Vl + j * 144 + d * 2)); float kk[8]; up8(*(const LAS u32x4*)(Kl + j * 144 + dk8 * 2), kk);
#pragma unroll
                for (int i = 0; i < 8; ++i) acc[i] += vv * kk[i]; }
            float* o = (float*)(F.ws + WS_KVC) + ((size_t)((b * 4 + h) * 32 + cb) * 4096 + d * 64 + dk8);
            *(f32x4*)o = (f32x4){acc[0], acc[1], acc[2], acc[3]}; *(f32x4*)(o + 4) = (f32x4){acc[4], acc[5], acc[6], acc[7]}; }
        __syncthreads();
        for (int idx = tid; idx < 256 * 8; idx += 512) { const int row = idx >> 3, c = idx & 7;
            if (c < 4) *(LAS u32x4*)(Kl + row * 144 + c * 16) = *(const u32x4*)(Z + (r0 + row) * ZW + ZC_DK + h * 32 + c * 8);
            *(LAS u32x4*)(Vl + row * 144 + c * 16) = *(const u32x4*)(Z + (r0 + row) * ZW + ZC_DV + h * 64 + c * 8); }
        __syncthreads();
        {   const int ch = tid >> 7, d = (tid >> 1) & 63, dk16 = (tid & 1) * 16; float acc[16];
#pragma unroll
            for (int i = 0; i < 16; ++i) acc[i] = 0.f;
            for (int j = 0; j < 64; ++j) { const int row = ch * 64 + j; const float vv = bf1(*(const LAS bf16*)(Vl + row * 144 + d * 2)); float k0[8], k1[8];
                up8(*(const LAS u32x4*)(Kl + row * 144 + dk16 * 2), k0); up8(*(const LAS u32x4*)(Kl + row * 144 + dk16 * 2 + 16), k1);
#pragma unroll
                for (int i = 0; i < 8; ++i) { acc[i] += vv * k0[i]; acc[8 + i] += vv * k1[i]; } }
            float* o = (float*)(F.ws + WS_KVD) + ((size_t)((b * 4 + h) * 128 + cb * 4 + ch) * 2048 + d * 32 + dk16);
#pragma unroll
            for (int i = 0; i < 4; ++i) *(f32x4*)(o + 4 * i) = (f32x4){acc[4 * i], acc[4 * i + 1], acc[4 * i + 2], acc[4 * i + 3]}; }
        __syncthreads();
    }
}

__device__ __forceinline__ void scan_phase(Frame& F) {
    const int gt = F.wg * 512 + F.tid, NT = F.G * 512;
    for (int e0 = gt; e0 < 16 * 4096 + 16 * 2048; e0 += NT) {
        if (e0 < 16 * 4096) { const int e = e0;
            const int bh = e >> 12, idx = e & 4095, h = bh & 3; const float g256 = __builtin_amdgcn_exp2f(256.0f * log2gam(h));
            float* p = (float*)(F.ws + WS_KVC) + (size_t)bh * 32 * 4096 + idx; float S = 0.f; float kv[32];
#pragma unroll
            for (int c = 0; c < 32; ++c) kv[c] = p[(size_t)c * 4096];
#pragma unroll
            for (int c = 0; c < 32; ++c) { const float Sp = g256 * S; p[(size_t)c * 4096] = Sp; S = Sp + kv[c]; }
        } else { const int e = e0 - 16 * 4096;
            const int bh = e >> 11, idx = e & 2047, b = bh >> 2, h = bh & 3, dk = idx & 31;
            float* p = (float*)(F.ws + WS_KVD) + (size_t)bh * 128 * 2048 + idx; const float* de = (const float*)(F.ws + WS_DE) + (size_t)b * 128 * 128 + h * 32 + dk; float S = 0.f;
            for (int c0 = 0; c0 < 128; c0 += 16) { float kv[16], dd[16];
#pragma unroll
                for (int c = 0; c < 16; ++c) { kv[c] = p[(size_t)(c0 + c) * 2048]; dd[c] = de[(c0 + c) * 128]; }
#pragma unroll
                for (int c = 0; c < 16; ++c) { const float Sp = dd[c] * S; p[(size_t)(c0 + c) * 2048] = Sp; S = Sp + kv[c]; } }
        }
    }
}

constexpr int HPITCH = 1026, CAP = 256;
struct QState { unsigned mode, thr_lo, thr_hi, thr_idx, krem, lcount, pad0, pad1; };
__device__ __forceinline__ unsigned okey_of(float s) { const unsigned u = __float_as_uint(s); return u ^ ((unsigned)((int)u >> 31) | 0x80000000u); }
__device__ __forceinline__ void b1_load(const bf16* Zb, int t, int r, int hh, bf16x8& k0, bf16x8& k1) {
    const bf16* kr = Zb + (size_t)(32 * t + r) * ZW + ZC_IK + 8 * hh; k0 = *(const bf16x8*)kr; k1 = *(const bf16x8*)(kr + 16); }
__device__ __forceinline__ void b1_scores(const bf16x8 k0, const bf16x8 k1, const bf16x8 (&iqf)[4][2], const float (&w)[4], float (&sc)[16]) {
#pragma unroll
    for (int e = 0; e < 16; ++e) sc[e] = 0.f;
#pragma unroll
    for (int ih = 0; ih < 4; ++ih) { f32x16 lg = mfma32(k0, iqf[ih][0], splat16(0.f)); lg = mfma32(k1, iqf[ih][1], lg);
#pragma unroll
        for (int e = 0; e < 16; ++e) sc[e] = fmaf(w[ih], fmaxf(lg[e], 0.f), sc[e]); }
}
__device__ __forceinline__ void b1_setbit(unsigned* MWq, unsigned j) {
    const unsigned wi = j & 31u, hh = (wi >> 2) & 1u, e = (wi & 3u) + 4u * (wi >> 3), kh = (j >> 5) & 1u;
    __hip_atomic_fetch_or(MWq + (size_t)(j >> 6) * 64 + 32u * hh, 1u << (e + 16u * kh), __ATOMIC_RELAXED, __HIP_MEMORY_SCOPE_AGENT);
}
__device__ __forceinline__ void b1_unit(Frame& F, int b, int g) {
    const int tid = F.tid, lane = F.lane, r = lane & 31, hh = lane >> 5, wid = F.wave;
    const bf16* Zb = (const bf16*)(F.ws + WS_Z) + (size_t)b * SEQ * ZW;
    LAS unsigned* hist = (LAS unsigned*)F.lds;
    LAS QState* qst = (LAS QState*)(F.lds + QST_OFF);
    const int qpos = 32 * g + r;
    unsigned* MWb = (unsigned*)(F.ws + WS_MASK) + ((size_t)(b * 256 + g) * 128) * 64;
    bf16x8 iqf[4][2]; float w[4];
    {   const bf16* qr = Zb + (size_t)qpos * ZW;
#pragma unroll
        for (int ih = 0; ih < 4; ++ih) { iqf[ih][0] = *(const bf16x8*)(qr + ZC_IQ + ih * 32 + 8 * hh); iqf[ih][1] = *(const bf16x8*)(qr + ZC_IQ + ih * 32 + 16 + 8 * hh); w[ih] = bf1(qr[ZC_IW + ih]); } }
    if (g >= 8) {
        for (int i = tid; i < 32 * HPITCH; i += 512) hist[i] = 0u;
        __syncthreads();
        {   bf16x8 n0 = iqf[0][0], n1 = iqf[0][0]; int t = wid; if (t <= g) b1_load(Zb, t, r, hh, n0, n1);
            for (; t <= g; t += 8) { const bf16x8 k0 = n0, k1 = n1; if (t + 8 <= g) b1_load(Zb, t + 8, r, hh, n0, n1);
                float sc[16]; b1_scores(k0, k1, iqf, w, sc);
#pragma unroll
                for (int e = 0; e < 16; ++e) { const int j = 32 * t + crow_c(e) + 4 * hh; if (j <= qpos) { const unsigned bin = okey_of(sc[e]) >> 21;
                    __hip_atomic_fetch_add(hist + r * HPITCH + (bin >> 1), 1u << ((bin & 1) * 16), __ATOMIC_RELAXED, __HIP_MEMORY_SCOPE_WORKGROUP); } } } }
        __syncthreads();
        for (int qq = 0; qq < 4; ++qq) { const int q = 4 * wid + qq; const LAS unsigned* hq = hist + q * HPITCH;
            const int wbase = 1008 - 16 * lane; unsigned s = 0;
#pragma unroll
            for (int k = 0; k < 16; ++k) { const unsigned x = hq[wbase + k]; s += (x & 0xffffu) + (x >> 16); }
            unsigned P = s;
#pragma unroll
            for (int o = 1; o < 64; o <<= 1) { const unsigned t = shup(P, lane, o); if (lane >= o) P += t; }
            const unsigned long long bal = __ballot(P >= 256u);
            const int Lsel = bal ? __builtin_ctzll(bal) : 63;
            if (lane == Lsel) { unsigned cum = P - s; unsigned b1 = 0, cin = 0, cab = 0;
                for (int k = 0; k < 32; ++k) { const int bin = 2047 - 32 * lane - k; const unsigned x = hq[bin >> 1]; const unsigned c = (bin & 1) ? (x >> 16) : (x & 0xffffu);
                    if (cum + c >= 256u) { b1 = (unsigned)bin; cin = c; cab = cum; break; } cum += c; }
                qst[q].thr_lo = b1 << 21; qst[q].thr_hi = (b1 << 21) | 0x1fffffu; qst[q].thr_idx = 0xffffu; qst[q].krem = 256u - cab; qst[q].lcount = 0u; qst[q].pad0 = cin; qst[q].pad1 = 0u;
                qst[q].mode = (b1 == 1024u || cin > (unsigned)CAP) ? 2u : 1u; }
        }
        __syncthreads();
        for (int i = tid; i < 32 * 256; i += 512) ((LAS unsigned*)(F.lds + 65536))[i] = 0u;
        __syncthreads();
    }
    {   unsigned mode = 0u, tlo = 1u, thi = 0u;
        const bool allsel = (g < 8);
        if (!allsel) { mode = qst[r].mode; tlo = qst[r].thr_lo; thi = qst[r].thr_hi; }
        const int nk = g >> 1;
        bf16x8 n0 = iqf[0][0], n1 = iqf[0][0], n2 = iqf[0][0], n3 = iqf[0][0]; int kt = wid;
        if (kt <= nk) { b1_load(Zb, 2 * kt, r, hh, n0, n1); if (2 * kt + 1 <= g) b1_load(Zb, 2 * kt + 1, r, hh, n2, n3); }
        for (; kt <= nk; kt += 8) {
            const bf16x8 k0 = n0, k1 = n1, k2 = n2, k3 = n3;
            if (kt + 8 <= nk) { b1_load(Zb, 2 * kt + 16, r, hh, n0, n1); if (2 * kt + 17 <= g) b1_load(Zb, 2 * kt + 17, r, hh, n2, n3); }
            unsigned word = 0u;
#pragma unroll
            for (int kh = 0; kh < 2; ++kh) { const int t = 2 * kt + kh; if (t <= g) { float sc[16]; b1_scores(kh ? k2 : k0, kh ? k3 : k1, iqf, w, sc);
#pragma unroll
                for (int e = 0; e < 16; ++e) { const int j = 32 * t + crow_c(e) + 4 * hh; const unsigned ok = okey_of(sc[e]); const bool valid = (j <= qpos);
                    const bool sel = valid && (allsel || ok > thi); word |= (sel ? 1u : 0u) << (e + 16 * kh);
                    if (!allsel && valid && ok >= tlo && ok <= thi) {
                        if (mode == 1u) { const unsigned pos = __hip_atomic_fetch_add(&qst[r].lcount, 1u, __ATOMIC_RELAXED, __HIP_MEMORY_SCOPE_WORKGROUP);
                            if (pos < (unsigned)CAP) { LAS unsigned* le = (LAS unsigned*)(F.lds + ((size_t)r * CAP + pos) * 8); le[0] = ok; le[1] = (unsigned)j; } }
                        else __hip_atomic_fetch_or((LAS unsigned*)(F.lds + 65536 + r * 1024) + (j >> 5), 1u << (j & 31), __ATOMIC_RELAXED, __HIP_MEMORY_SCOPE_WORKGROUP); } } } }
            MWb[(size_t)kt * 64 + lane] = word; }
    }
    __syncthreads();
    if (g >= 8) {
        for (int qq = 0; qq < 4; ++qq) { const int q = 4 * wid + qq; const unsigned mode = qst[q].mode, krem = qst[q].krem; unsigned* MWq = MWb + q;
            if (mode == 1u) {
                unsigned L = qst[q].lcount; if (L > (unsigned)CAP) L = CAP; const LAS unsigned* lb = (const LAS unsigned*)(F.lds + (size_t)q * CAP * 8);
                unsigned long long comp[4]; bool has[4]; unsigned jj[4];
#pragma unroll
                for (int k = 0; k < 4; ++k) { const unsigned c = lane + 64 * k; has[k] = c < L; const unsigned ok = has[k] ? lb[2 * c] : 0u; jj[k] = has[k] ? lb[2 * c + 1] : 0u;
                    comp[k] = ((unsigned long long)(ok & 0x1fffffu) << 13) | (unsigned long long)(8191u - jj[k]); }
                unsigned long long prefix = 0ull; unsigned need = krem;
                for (int bit = 33; bit >= 0; --bit) { const unsigned long long want = (prefix >> bit) | 1ull; unsigned cnt = 0;
#pragma unroll
                    for (int k = 0; k < 4; ++k) cnt += (unsigned)__builtin_popcountll(__ballot(has[k] && ((comp[k] >> bit) == want)));
                    if (cnt >= need) prefix |= (1ull << bit); else need -= cnt; }
#pragma unroll
                for (int k = 0; k < 4; ++k) if (has[k] && comp[k] >= prefix) b1_setbit(MWq, jj[k]); }
            else { const LAS unsigned* bm = (const LAS unsigned*)(F.lds + 65536 + q * 1024); unsigned x[4]; unsigned s = 0;
#pragma unroll
                for (int k = 0; k < 4; ++k) { x[k] = bm[4 * lane + k]; s += __builtin_popcount(x[k]); }
                unsigned P = s;
#pragma unroll
                for (int o = 1; o < 64; o <<= 1) { const unsigned t = shup(P, lane, o); if (lane >= o) P += t; }
                unsigned before = P - s;
#pragma unroll
                for (int k = 0; k < 4; ++k) { unsigned y = x[k]; while (y != 0u && before < krem) { const unsigned bit = (unsigned)__builtin_ctz(y); y &= y - 1u; b1_setbit(MWq, 32u * (4 * lane + k) + bit); ++before; } before += __builtin_popcount(y); } }
        }
        __syncthreads();
    }
}

struct EngP { const bf16* Z; bf16* Y; const unsigned* MASK; const float* ST; const float* nw; float lam, lam_init; const unsigned* kmax; };
__device__ __forceinline__ int wq_next(Frame& F, unsigned* head) {
    LAS int* slot = (LAS int*)(F.lds + 55312);
    if (F.tid == 0) *slot = (int)__hip_atomic_fetch_add(head, 1u, __ATOMIC_RELAXED, __HIP_MEMORY_SCOPE_AGENT);
    __syncthreads(); const int u = *slot; __syncthreads();
    asm volatile("" : "+v"(F.tid), "+v"(F.lane));
    return u;
}
template <int MODE>
__device__ __forceinline__ void eng_unit(Frame& F, const EngP& P, int b, int h, int qb) {
    constexpr bool SOFT = MODE <= 1;
    constexpr int NMAP = MODE == 0 ? 2 : 1;
    constexpr int NS = (MODE == 0 || MODE == 3) ? 2 : 4;
    constexpr int KCH = MODE == 3 ? 4 : 8;
    constexpr int QC = MODE == 0 ? ZC_AQ : MODE == 1 ? ZC_BQ : MODE == 2 ? ZC_CQ : ZC_DQ;
    constexpr int KC = MODE == 0 ? ZC_AK : MODE == 1 ? ZC_BK : MODE == 2 ? ZC_CK : ZC_DK;
    constexpr int VC = MODE == 0 ? ZC_AV : MODE == 1 ? ZC_BV : MODE == 2 ? ZC_CV : ZC_DV;
    constexpr int HW = MODE == 3 ? 32 : 64;
    const int tid = F.tid, lane = F.lane, r = lane & 31, hh = lane >> 5, w = F.wave;
    const size_t rowbase = (size_t)b * SEQ;
    const int qw0 = qb * 256 + 32 * w;
    const float NEG = -__builtin_inff();
    const int hidx = MODE <= 1 ? (MODE == 0 ? 2 * h + 1 : 2 * h + 2) : 0;
    const float slope2 = SOFT ? __builtin_amdgcn_exp2f(-(float)hidx) * LOG2E : 0.f;
    bf16x8 qf[NMAP][NS];
    {   const bf16* qrow = P.Z + (rowbase + qw0 + r) * ZW + QC + h * HW;
#pragma unroll
        for (int m = 0; m < NMAP; ++m)
#pragma unroll
            for (int s = 0; s < NS; ++s) qf[m][s] = *(const bf16x8*)(qrow + m * 32 + 16 * s + 8 * hh); }
    f32x16 cinit;
#pragma unroll
    for (int e = 0; e < 16; ++e) cinit[e] = SOFT ? slope2 * (float)(crow_c(e) + 4 * hh) : 0.f;
    float m_run[NMAP], l_run[NMAP]; f32x16 O[NMAP][2];
#pragma unroll
    for (int m = 0; m < NMAP; ++m) { m_run[m] = NEG; l_run[m] = 0.f; O[m][0] = splat16(0.f); O[m][1] = splat16(0.f); }
    if (!SOFT) {
        const int sidx = MODE == 2 ? ((b * 4 + h) * 32 + qb) : ((b * 4 + h) * 128 + 4 * qb + (w >> 1));
        const float* sp = P.ST + (size_t)sidx * (64 * HW);
#pragma unroll
        for (int db = 0; db < 2; ++db)
#pragma unroll
            for (int s = 0; s < NS; ++s) { const float* a = sp + (size_t)(32 * db + r) * HW + 16 * s + 8 * hh; const f32x4 a0 = *(const f32x4*)a, a1 = *(const f32x4*)(a + 4);
                O[0][db] = mfma32(pack8(a0[0], a0[1], a0[2], a0[3], a1[0], a1[1], a1[2], a1[3]), qf[0][s], O[0][db]); }
    }
    const int kt_lo = SOFT ? 0 : 4 * qb, kt_hi = 4 * qb + 3;
    const int srow = tid >> 3, sch = tid & 7;
    float qk[NMAP];
    if (SOFT) {
#pragma unroll
        for (int m = 0; m < NMAP; ++m) { float ss = 0.f;
#pragma unroll
            for (int s = 0; s < NS; ++s) { const u32x4 qq = __builtin_bit_cast(u32x4, qf[m][s]); float v[8]; up8(qq, v);
#pragma unroll
                for (int i = 0; i < 8; ++i) ss += v[i] * v[i]; }
            ss += shx(ss, lane, 32);
            qk[m] = 1.02f * sqrtf(ss) * __uint_as_float(P.kmax[b * 16 + (MODE == 0 ? (h * 2 + m) : (8 + h))]) + 0.01f; }
    }
    LAS unsigned* wflag = (LAS unsigned*)(F.lds + 55296);
    if (SOFT && tid < 3) wflag[tid] = 0u;
    const int kt_first = SOFT ? kt_hi : kt_lo;
    const int nit = kt_hi - kt_lo + 1;
    u32x4 kreg = (u32x4){0u, 0u, 0u, 0u}, vreg;
    {   const bf16* zr = P.Z + (rowbase + 64 * kt_first + srow) * ZW;
        if (sch < KCH) kreg = *(const u32x4*)(zr + KC + h * HW + sch * 8);
        vreg = *(const u32x4*)(zr + VC + h * 64 + sch * 8);
        if (sch < KCH) *(LAS u32x4*)(F.lds + srow * 144 + sch * 16) = kreg;
        *(LAS u32x4*)(F.lds + 9216 + srow * 144 + sch * 16) = vreg;
        if (nit > 1) { const bf16* z1 = P.Z + (rowbase + 64 * (SOFT ? kt_first - 1 : kt_first + 1) + srow) * ZW;
            if (sch < KCH) kreg = *(const u32x4*)(z1 + KC + h * HW + sch * 8);
            vreg = *(const u32x4*)(z1 + VC + h * 64 + sch * 8); } }
    __syncthreads();
    bool wave_done = false;
    const unsigned* mwp = (MODE == 1) ? P.MASK + ((size_t)(b * 256 + qb * 8 + w) * 128) * 64 + lane : nullptr;
    unsigned mwn = 0xffffffffu; if (MODE == 1) mwn = mwp[(size_t)kt_first * 64];
    int sl_cur = 0, sl_nxt = 18432;
    for (int it = 0; it < nit; ++it) {
        const int kt = SOFT ? kt_hi - it : kt_lo + it, ktn = SOFT ? kt - 1 : kt + 1;
        const bool more = it + 1 < nit;
        const unsigned mw = mwn;
        if (more) { if (sch < KCH) *(LAS u32x4*)(F.lds + sl_nxt + srow * 144 + sch * 16) = kreg;
            *(LAS u32x4*)(F.lds + sl_nxt + 9216 + srow * 144 + sch * 16) = vreg;
            if (MODE == 1) mwn = mwp[(size_t)ktn * 64]; }
        if (it + 2 < nit) { const bf16* zr = P.Z + (rowbase + 64 * (SOFT ? kt - 2 : kt + 2) + srow) * ZW;
            if (sch < KCH) kreg = *(const u32x4*)(zr + KC + h * HW + sch * 8);
            vreg = *(const u32x4*)(zr + VC + h * 64 + sch * 8); }
        const int j0 = 64 * kt;
        const bool act = ((MODE == 3) ? (kt == 4 * qb + (w >> 1)) : (j0 <= qw0 + 31)) && !wave_done;
        if (act) {
            const LAS unsigned char* Kb = F.lds + sl_cur; const LAS unsigned char* Vb = F.lds + sl_cur + 9216;
            const bool hact1 = (j0 + 32 <= qw0 + 31);
#pragma unroll
            for (int m = 0; m < NMAP; ++m) {
                f32x16 st[2];
#pragma unroll
                for (int kh = 0; kh < 2; ++kh) {
                    if (kh == 0 || hact1) {
                        f32x16 a = cinit;
#pragma unroll
                        for (int s = 0; s < NS; ++s) { const bf16x8 kf = *(const LAS bf16x8*)(Kb + (32 * kh + r) * 144 + (m * 32 + 16 * s + 8 * hh) * 2); a = mfma32(kf, qf[m][s], a); }
                        if (j0 + 32 * kh + 31 > qw0) { const int lim = qw0 + r - j0 - 32 * kh - 4 * hh; asm volatile("; causal-mask block (kept a real branch: as selects it ran on every interior tile too)" ::: "memory");
#pragma unroll
                            for (int e = 0; e < 16; ++e) if (crow_c(e) > lim) a[e] = SOFT ? NEG : 0.f; }
                        if (MODE == 1) {
#pragma unroll
                            for (int e = 0; e < 16; ++e) if (!((mw >> (e + 16 * kh)) & 1u)) a[e] = NEG; }
                        st[kh] = a;
                    } else st[kh] = splat16(SOFT ? NEG : 0.f);
                }
                if (SOFT) {
                    const float off0 = slope2 * (float)(j0 - qw0 - r), off1 = off0 + 32.f * slope2;
                    float mx0 = st[0][0], mx1 = st[1][0];
#pragma unroll
                    for (int e = 1; e < 16; ++e) { mx0 = fmaxf(mx0, st[0][e]); mx1 = fmaxf(mx1, st[1][e]); }
                    float mx = fmaxf(mx0 + off0, mx1 + off1); mx = fmaxf(mx, shx(mx, lane, 32));
                    const float mn = fmaxf(m_run[m], mx); const float msafe = (mn == NEG) ? 0.f : mn;
                    const float alpha = __builtin_amdgcn_exp2f(m_run[m] - msafe); m_run[m] = mn;
                    const float d0 = off0 - msafe, d1 = off1 - msafe; float rs = 0.f;
#pragma unroll
                    for (int e = 0; e < 16; ++e) { const float p0 = __builtin_amdgcn_exp2f(st[0][e] + d0), p1 = __builtin_amdgcn_exp2f(st[1][e] + d1); st[0][e] = p0; st[1][e] = p1; rs += p0 + p1; }
                    rs += shx(rs, lane, 32); l_run[m] = l_run[m] * alpha + rs;
#pragma unroll
                    for (int e = 0; e < 16; ++e) { O[m][0][e] *= alpha; O[m][1][e] *= alpha; }
                }
#pragma unroll
                for (int kh = 0; kh < 2; ++kh) {
                    if (kh == 0 || hact1) {
#pragma unroll
                        for (int s = 0; s < 2; ++s) {
                            const bf16x8 pf = pack8(st[kh][8 * s], st[kh][8 * s + 1], st[kh][8 * s + 2], st[kh][8 * s + 3], st[kh][8 * s + 4], st[kh][8 * s + 5], st[kh][8 * s + 6], st[kh][8 * s + 7]);
#pragma unroll
                            for (int db = 0; db < 2; ++db) {
                                const LAS unsigned char* vp = Vb + (32 * kh + 16 * s + 4 * hh + ((lane & 15) >> 2)) * 144 + (32 * db + 16 * ((lane >> 4) & 1) + 4 * (lane & 3)) * 2;
                                const s16x4 lo = vtr(vp), hi = vtr(vp + 8 * 144);
                                const bf16x8 vf = (bf16x8){lo[0], lo[1], lo[2], lo[3], hi[0], hi[1], hi[2], hi[3]};
                                O[m][db] = mfma32(vf, pf, O[m][db]); } } } }
            }
            if (SOFT) {
                const float dist = slope2 * (float)(qw0 + r - (j0 - 1)); bool fin = true;
#pragma unroll
                for (int m = 0; m < NMAP; ++m) fin = fin && (qk[m] - dist - m_run[m] < -32.f);
                wave_done = (__ballot(fin) == ~0ull);
            }
        }
        if (SOFT && !wave_done && lane == 0) wflag[it % 3] = 1u;
        sl_cur = sl_nxt; sl_nxt = (sl_nxt == 36864) ? 0 : sl_nxt + 18432;
        __syncthreads();
        if (SOFT) { const unsigned any = wflag[it % 3]; if (tid == 0) wflag[(it + 2) % 3] = 0u; if (any == 0u) break; }
    }
    const size_t orow = rowbase + qw0 + r;
    const int ycol = MODE * 256 + h * 64;
    f32x16 o[2];
    if (MODE == 0) { const float i0 = 1.f / l_run[0], i1 = P.lam / l_run[NMAP - 1];
#pragma unroll
        for (int db = 0; db < 2; ++db)
#pragma unroll
            for (int e = 0; e < 16; ++e) o[db][e] = O[0][db][e] * i0 - O[NMAP - 1][db][e] * i1; }
    else if (MODE == 1) { const float i0 = 1.f / l_run[0];
#pragma unroll
        for (int db = 0; db < 2; ++db)
#pragma unroll
            for (int e = 0; e < 16; ++e) o[db][e] = O[0][db][e] * i0; }
    else { o[0] = O[0][0]; o[1] = O[0][1]; }
    float mu = 0.f;
    if (MODE == 2) { float s = 0.f;
#pragma unroll
        for (int db = 0; db < 2; ++db)
#pragma unroll
            for (int e = 0; e < 16; ++e) s += o[db][e];
        s += shx(s, lane, 32); mu = s * (1.f / 64.f); }
    float ss = 0.f;
    if (MODE != 1) {
#pragma unroll
        for (int db = 0; db < 2; ++db)
#pragma unroll
            for (int e = 0; e < 16; ++e) { const float d = o[db][e] - mu; ss += d * d; }
        ss += shx(ss, lane, 32); }
    float rn = 1.f;
    if (MODE != 1) rn = 1.f / sqrtf(ss * (1.f / 64.f) + LN_EPS);
    if (MODE == 0) rn *= (1.f - P.lam_init);
#pragma unroll
    for (int db = 0; db < 2; ++db)
#pragma unroll
        for (int g4 = 0; g4 < 4; ++g4) { const int d0 = 32 * db + 8 * g4 + 4 * hh; float v[4];
#pragma unroll
            for (int i = 0; i < 4; ++i) v[i] = o[db][4 * g4 + i];
            if (MODE != 1) { const f32x4 nw = *(const f32x4*)(P.nw + (MODE == 2 ? h * 64 : 0) + d0);
#pragma unroll
                for (int i = 0; i < 4; ++i) v[i] = (v[i] - mu) * rn * nw[i]; }
            if (MODE >= 2) { const u32x2 gw = *(const u32x2*)(P.Z + orow * ZW + (MODE == 2 ? ZC_CG : ZC_DG) + h * 64 + d0);
                const float g0 = bflo(gw.x), g1 = bfhi(gw.x), g2 = bflo(gw.y), g3 = bfhi(gw.y);
                v[0] *= g0 * sigmoidf_(g0); v[1] *= g1 * sigmoidf_(g1); v[2] *= g2 * sigmoidf_(g2); v[3] *= g3 * sigmoidf_(g3); }
            u32x2 ow; ow.x = pk2(v[0], v[1]); ow.y = pk2(v[2], v[3]);
            *(u32x2*)(P.Y + orow * DM + ycol + d0) = ow; }
}
}

constexpr int PH_PER_LAYER = 12, N_PHASES = 1 + DEPTH * PH_PER_LAYER;

typedef __attribute__((address_space(4))) const Args* KArgP;
#ifdef ONLY_SITE
#define SITE(s) ((s) == ONLY_SITE)
#else
#define SITE(s) true
#endif
#if MK_ONE_LAUNCH
#define IN(k) true
#define SEAM(k) do { if ((k) + 1 < N_PHASES) { XcdBarrier b2_ = bar; asm volatile("" : "+s"(b2_.bar), "+s"(b2_.x)); xcd_barrier(b2_, F.tid == 0); } } while (0)
#else
#define IN(k) (lo <= (k) && (k) < hi)
#define SEAM(k) do { } while (0)
#endif
#define SITE_BEGIN KArgP KA = (KArgP)__builtin_amdgcn_kernarg_segment_ptr(); do { asm volatile("" : "+s"(KA)); \
        int ln_; asm volatile("v_mbcnt_lo_u32_b32 %0, -1, 0\n\tv_mbcnt_hi_u32_b32 %0, -1, %0" : "=v"(ln_)); \
        const unsigned simd_ = (unsigned)__builtin_amdgcn_s_getreg(((2 - 1) << 11) | (4 << 6) | 4);   \
        unsigned tk_ = 0u, tg_ = 0u; if (ln_ == 0) { tk_ = __hip_atomic_fetch_add((LAS unsigned*)(F.lds + MISC_OFF + 64) + simd_, 1u, __ATOMIC_RELAXED, __HIP_MEMORY_SCOPE_WORKGROUP); \
            tg_ = __hip_atomic_fetch_add((LAS unsigned*)(F.lds + MISC_OFF + 96), 1u, __ATOMIC_RELAXED, __HIP_MEMORY_SCOPE_WORKGROUP); } \
        F.wave = __builtin_amdgcn_readfirstlane(simd_balanced ? (int)(simd_ + 4u * (tk_ & 1u)) : (int)(tg_ & 7u)); F.lane = ln_; F.tid = F.wave * 64 + F.lane; \
        F.ws = KA->ws; F.dob = (unsigned char*)KA->out; F.G = G0; F.wg = wg0; asm volatile("" : "+s"(F.G), "+s"(F.wg)); } while (0)


__global__ void __launch_bounds__(NWAVES * 64, 2) fwd_kernel(Args args) {
    extern __shared__ __attribute__((aligned(16))) unsigned char lds_raw[];
    Frame F;
    F.lds = (LAS unsigned char*)lds_raw;
    F.tid = threadIdx.x; F.lane = F.tid & 63; F.wave = __builtin_amdgcn_readfirstlane(F.tid >> 6);
    F.G = gridDim.x; F.wg = blockIdx.x;
    F.ws = args.ws; F.dob = (unsigned char*)args.out;
    volatile LAS unsigned* MISC = (volatile LAS unsigned*)(F.lds + MISC_OFF);
    if (F.tid < 32) MISC[F.tid] = 0u;
    __syncthreads();
    if (F.lane == 0) __hip_atomic_fetch_add((LAS unsigned*)(F.lds + MISC_OFF + 112) + ((unsigned)__builtin_amdgcn_s_getreg(((2 - 1) << 11) | (4 << 6) | 4)), 1u, __ATOMIC_RELAXED, __HIP_MEMORY_SCOPE_WORKGROUP);
    __syncthreads();
    const bool simd_balanced = (MISC[28] == 2u) && (MISC[29] == 2u) && (MISC[30] == 2u) && (MISC[31] == 2u);
    unsigned* ctl = (unsigned*)(F.ws + WS_CTL);
    XcdBarrier bar; bar.bar = ctl + CW_BAR; bar.x = 0; bar.st = nullptr;
#if MK_ONE_LAUNCH
    bar = xcd_barrier_post(ctl + CW_BAR, MISC + 8);
#endif
    const int lo = args.ph_lo, hi = args.ph_hi, subm = args.sub;
    const int G0 = F.G, wg0 = F.wg;
    if (SITE(0) && IN(0)) { SITE_BEGIN; p0_prologue(F, KA); SEAM(0); }

    for (int l = 0; l < DEPTH; ++l) {
        const int pb = 1 + l * PH_PER_LAYER;
        if (SITE(1) && IN(pb + 0)) { SITE_BEGIN; const char* XBc = (const char*)(F.ws + WS_XB); (void)XBc; const unsigned char* w123 = F.ws + WS_W123; const unsigned char* w45 = F.ws + WS_W45 + (size_t)l * W45_STRIDE; (void)w123; (void)w45;
            pg8::EpiStore E{(bf16*)(F.ws + WS_Z), ZW};
            {   pg8::SchedTiles S{XBc, (const char*)(w123 + W123_W1), 2048, 2048, 16, 6, G1_BF_TILES, 0, F.G, F.wg};
                { int tl_ = F.tid; asm volatile("" : "+v"(tl_)); pg8::gemm_phase(F.lds, S, E, tl_); } }
            {   pg8::SchedTiles S{(const char*)(F.dob + DO_XB8), (const char*)(F.dob + DO_W8 + (size_t)l * W8_STRIDE + W8_Z), 1024, 1024, 8, 8, G1_F8_TILES, 1, F.G, F.wg};
                { int tl_ = F.tid; asm volatile("" : "+v"(tl_)); pg8::gemm_phase<pg8::EpiStore, pg8::SchedTiles, true>(F.lds, S, E, tl_); } }
            SEAM(pb + 0);
        }
        if (SITE(2) && IN(pb + 1)) { SITE_BEGIN; const char* XBc = (const char*)(F.ws + WS_XB); (void)XBc; const unsigned char* w123 = F.ws + WS_W123; const unsigned char* w45 = F.ws + WS_W45 + (size_t)l * W45_STRIDE; (void)w123; (void)w45;
            {   unsigned* head = (unsigned*)(F.ws + WS_CTL) + CW_WQ + l * 64 + 32;
                for (;;) { const int i = mx::wq_next(F, head); if (i >= 128 + 1024) break;
                    if (i < 128) { if (subm & 2) mx::prepkv_unit(F, i, KA->in[6] + (size_t)l * 16 * 128, KA->in[7] + l * 128, (unsigned*)(F.ws + WS_CTL) + CW_KMAX + l * 64); }
                    else if (subm & 1) { const int u = i - 128; mx::b1_unit(F, u & 3, 255 - (u >> 2)); } } }
            SEAM(pb + 1);
        }
        if (SITE(3) && IN(pb + 2)) { SITE_BEGIN; const char* XBc = (const char*)(F.ws + WS_XB); (void)XBc; const unsigned char* w123 = F.ws + WS_W123; const unsigned char* w45 = F.ws + WS_W45 + (size_t)l * W45_STRIDE; (void)w123; (void)w45;
            if (subm & 1) mx::scan_phase(F);
            float lam_init = 0.8f - 0.6f * __expf(-0.3f * (float)l);
            const float* lp = KA->in[3] + l * 128; float s01 = 0.f, s23 = 0.f;
            for (int i = 0; i < 32; ++i) { s01 += lp[i] * lp[32 + i]; s23 += lp[64 + i] * lp[96 + i]; }
            mx::EngP P{(const bf16*)(F.ws + WS_Z), (bf16*)(F.ws + WS_Y), nullptr, nullptr, KA->in[4] + l * 64, __expf(s01) - __expf(s23) + lam_init, lam_init, (const unsigned*)(F.ws + WS_CTL) + CW_KMAX + l * 64};
            {   unsigned* head = (unsigned*)(F.ws + WS_CTL) + CW_WQ + l * 64;
                for (;;) { const int i = mx::wq_next(F, head); if (i >= 512) break; const int j = i & 127; mx::eng_unit<0>(F, P, j & 3, 3 - (i >> 7), 31 - (j >> 2)); } }
            SEAM(pb + 2);
        }
        if (SITE(4) && IN(pb + 3)) { SITE_BEGIN; const char* XBc = (const char*)(F.ws + WS_XB); (void)XBc; const unsigned char* w123 = F.ws + WS_W123; const unsigned char* w45 = F.ws + WS_W45 + (size_t)l * W45_STRIDE; (void)w123; (void)w45;
            {   unsigned* head = (unsigned*)(F.ws + WS_CTL) + CW_WQ + l * 64 + 16;
                const mx::EngP PB{(const bf16*)(F.ws + WS_Z), (bf16*)(F.ws + WS_Y), (const unsigned*)(F.ws + WS_MASK), nullptr, nullptr, 0.f, 0.f, (const unsigned*)(F.ws + WS_CTL) + CW_KMAX + l * 64};
                const mx::EngP PC{(const bf16*)(F.ws + WS_Z), (bf16*)(F.ws + WS_Y), nullptr, (const float*)(F.ws + WS_KVC), KA->in[5] + l * 256, 0.f, 0.f, nullptr};
                const mx::EngP PD{(const bf16*)(F.ws + WS_Z), (bf16*)(F.ws + WS_Y), nullptr, (const float*)(F.ws + WS_KVD), KA->in[8] + l * 64, 0.f, 0.f, nullptr};
                for (;;) { const int i = mx::wq_next(F, head); if (i >= 1536) break;
                    if (i < 512) { if (subm & 1) { const int j = i & 127; mx::eng_unit<1>(F, PB, j & 3, 3 - (i >> 7), 31 - (j >> 2)); } }
                    else if (!(subm & (i < 1024 ? 2 : 4))) continue;
                    else if (i < 1024) { const int u = i - 512; mx::eng_unit<2>(F, PC, u >> 7, (u >> 5) & 3, u & 31); }
                    else { const int u = i - 1024; mx::eng_unit<3>(F, PD, u >> 7, (u >> 5) & 3, u & 31); } } }
            SEAM(pb + 3);
        }
        if (SITE(5) && IN(pb + 4)) { SITE_BEGIN;
            const unsigned char* w123 = F.ws + WS_W123;
            for (int n = 0; n < 4; ++n) {
                {   pg8::SchedPlain S{(const char*)(F.dob + DO_XB8), (const char*)(F.dob + DO_W8 + (size_t)l * W8_STRIDE + W8_G) + (size_t)n * 1024 * 1024, 1024, 1024, 8, 128, 4, F.G, F.wg};
                    pg8::EpiSlotStore E{F.ws + WS_SCR2 + (size_t)F.wg * 262144, 1};
                    { int tl_ = F.tid; asm volatile("" : "+v"(tl_)); pg8::gemm_phase<pg8::EpiSlotStore, pg8::SchedPlain, true>(F.lds, S, E, tl_); } }
                {   pg8::SchedPlain S{(const char*)(F.ws + WS_Y) + n * 512, (const char*)(w123 + W123_GB + 8 * MiB) + (size_t)n * 1024 * 512, 2048, 512, 4, 128, 4, F.G, F.wg};
                    pg8::EpiBranch E{F.ws + WS_SCR2 + (size_t)F.wg * 262144, (bf16*)(F.ws + WS_MERGED), n == 0};
                    { int tl_ = F.tid; asm volatile("" : "+v"(tl_)); pg8::gemm_phase(F.lds, S, E, tl_); } }
            }
            SEAM(pb + 4);
        }
        if (SITE(6) && IN(pb + 5)) { SITE_BEGIN; const char* XBc = (const char*)(F.ws + WS_XB); (void)XBc; const unsigned char* w123 = F.ws + WS_W123; const unsigned char* w45 = F.ws + WS_W45 + (size_t)l * W45_STRIDE; (void)w123; (void)w45;
            pg8::SchedPlain S{(const char*)(F.ws + WS_MERGED), (const char*)(w123 + W123_WO), 2048, 2048, 16, 128, 4, F.G, F.wg};
            pg8::EpiG3 E{(bf16*)(F.ws + WS_XB)};
            pg8::gemm_phase(F.lds, S, E, F.tid);
            SEAM(pb + 5);
        }
        if (SITE(7) && IN(pb + 6)) { SITE_BEGIN; const char* XBc = (const char*)(F.ws + WS_XB); (void)XBc; const unsigned char* w123 = F.ws + WS_W123; const unsigned char* w45 = F.ws + WS_W45 + (size_t)l * W45_STRIDE; (void)w123; (void)w45; ln_phase(F, KA->in[11] + l * DM, KA->in[12] + l * DM, nullptr, F.dob + DO_XB8);
            if (l + 1 < DEPTH) convert_w123(F, KA->in[2] + (size_t)(l + 1) * DM * NIN, KA->in[9] + (size_t)(l + 1) * 4 * 256 * DM, KA->in[10] + (size_t)(l + 1) * DM * DM);
            SEAM(pb + 6); }
        if (SITE(8) && IN(pb + 7)) { SITE_BEGIN; const char* XBc = (const char*)(F.ws + WS_XB); (void)XBc; const unsigned char* w123 = F.ws + WS_W123; const unsigned char* w45 = F.ws + WS_W45 + (size_t)l * W45_STRIDE; (void)w123; (void)w45;
            pg8::SchedUp S{(const char*)(F.dob + DO_XB8), (const char*)(F.dob + DO_W8 + (size_t)l * W8_STRIDE + W8_UP), F.G, F.wg};
            pg8::EpiUp E{(bf16*)(F.ws + WS_GS + (size_t)F.wg * 131072), (bf16*)(F.ws + WS_GE), (bf16*)(F.ws + WS_G0), (bf16*)(F.ws + WS_U0), F.ws + WS_ACT8, KA->in[14] + (size_t)l * 3 * DFF, KA->in[15] + (size_t)l * DFF};
            pg8::gemm_phase<pg8::EpiUp, pg8::SchedUp, true>(F.lds, S, E, F.tid);
            SEAM(pb + 7);
        }
        if (SITE(9) && IN(pb + 8)) { SITE_BEGIN; const char* XBc = (const char*)(F.ws + WS_XB); (void)XBc; const unsigned char* w123 = F.ws + WS_W123; const unsigned char* w45 = F.ws + WS_W45 + (size_t)l * W45_STRIDE; (void)w123; (void)w45; ffn_act_phase(F, KA->in[14] + (size_t)l * 3 * DFF, KA->in[15] + (size_t)l * DFF); SEAM(pb + 8); }
        if (SITE(10) && IN(pb + 9)) { SITE_BEGIN;
            const unsigned char* w45 = F.ws + WS_W45 + (size_t)l * W45_STRIDE;
            {   pg8::SchedPlain S{(const char*)(F.ws + WS_PB + (size_t)l * M * PDIM * 2), (const char*)(w45 + W45_PP), 512, 512, 4, 128, 4, F.G, F.wg};
                pg8::EpiSlotStore E{F.dob + DO_SCR5 + (size_t)F.wg * 262144, 0};
                { int tl_ = F.tid; asm volatile("" : "+v"(tl_)); pg8::gemm_phase(F.lds, S, E, tl_); } }
            {   pg8::SchedPlain S{(const char*)(F.dob + DO_XB8), (const char*)(F.dob + DO_W8 + (size_t)l * W8_STRIDE + W8_PG), 1024, 1024, 8, 128, 4, F.G, F.wg};
                pg8::EpiSlotMul E{F.dob + DO_SCR5 + (size_t)F.wg * 262144};
                { int tl_ = F.tid; asm volatile("" : "+v"(tl_)); pg8::gemm_phase<pg8::EpiSlotMul, pg8::SchedPlain, true>(F.lds, S, E, tl_); } }
            SEAM(pb + 9);
        }
        if (SITE(11) && IN(pb + 10)) { SITE_BEGIN;
            const unsigned char* w45 = F.ws + WS_W45 + (size_t)l * W45_STRIDE;
            pg8::SchedG5b S{(const char*)(F.ws + WS_ACT8), (const char*)(F.dob + DO_W8 + (size_t)l * W8_STRIDE + W8_DN), F.G, F.wg};
            pg8::EpiG5b E{F.dob + DO_SCR5 + (size_t)F.wg * 262144, (bf16*)(F.ws + WS_XB)};
            pg8::gemm_phase<pg8::EpiG5b, pg8::SchedG5b, true>(F.lds, S, E, F.tid);
            SEAM(pb + 10);
        }
        if (SITE(12) && IN(pb + 11)) { SITE_BEGIN; const char* XBc = (const char*)(F.ws + WS_XB); (void)XBc; const unsigned char* w123 = F.ws + WS_W123; const unsigned char* w45 = F.ws + WS_W45 + (size_t)l * W45_STRIDE; (void)w123; (void)w45; ln_phase(F, KA->in[19] + l * DM, KA->in[20] + l * DM, l == DEPTH - 1 ? KA->out : nullptr, l == DEPTH - 1 ? nullptr : F.dob + DO_XB8); SEAM(pb + 11); }
    }
#undef IN
#undef SEAM
}

extern "C" void kernel_launch(void* const* d_in, const int* in_sizes, int n_in, void* d_out, int out_size, void* d_ws, size_t ws_size, hipStream_t stream) {
    static int grid = 0;
    if (grid == 0) {
        if (n_in != 21 || out_size != M * DM || ws_size < WS_END) { fprintf(stderr, "kernel_launch: unexpected shapes (n_in %d out %d ws %zu)\n", n_in, out_size, ws_size); grid = -1; return; }
        int dev = 0, cus = 0, per_cu = 0;
        if (hipGetDevice(&dev) != hipSuccess || hipDeviceGetAttribute(&cus, hipDeviceAttributeMultiprocessorCount, dev) != hipSuccess) { grid = -1; return; }
        if (hipFuncSetAttribute((const void*)fwd_kernel, hipFuncAttributeMaxDynamicSharedMemorySize, LDS_BYTES) != hipSuccess) { grid = -1; return; }
        if (hipOccupancyMaxActiveBlocksPerMultiprocessor(&per_cu, (const void*)fwd_kernel, NWAVES * 64, LDS_BYTES) != hipSuccess || per_cu < 1)
            fprintf(stderr, "kernel_launch: occupancy query reports %d\n", per_cu);
        (void)hipGetLastError();
        grid = cus;
    }
    if (grid < 0) return;
    (void)hipMemsetAsync((char*)d_ws + WS_CTL, 0, CTL_ZERO_BYTES, stream);
    Args a{};
    for (int i = 0; i < 21; ++i) a.in[i] = (const float*)d_in[i];
    a.out = (float*)d_out; a.ws = (unsigned char*)d_ws;
#if MK_ONE_LAUNCH
    a.ph_lo = 0; a.ph_hi = N_PHASES; a.sub = 7;
    hipLaunchKernelGGL(fwd_kernel, dim3(grid), dim3(NWAVES * 64), LDS_BYTES, stream, a);
#else
    for (int p = 0; p < N_PHASES; ++p) { a.ph_lo = p; a.ph_hi = p + 1; a.sub = 7;
        hipLaunchKernelGGL(fwd_kernel, dim3(grid), dim3(NWAVES * 64), LDS_BYTES, stream, a);
#ifdef PROBE_PHASE
        if (p >= 1 && (p - 1) % PH_PER_LAYER == PROBE_PHASE) { (void)hipMemsetAsync((char*)d_ws + WS_CTL + CW_WQ * 4, 0, 1024, stream); a.sub = PROBE_SUB;
            hipLaunchKernelGGL(fwd_kernel, dim3(grid), dim3(NWAVES * 64), LDS_BYTES, stream, a); }
#endif
    }
#endif
}
```

```cpp
#include <hip/hip_runtime.h>
#include <cstdio>
#include <cstdint>

#ifndef MK_ONE_LAUNCH
#define MK_ONE_LAUNCH 1
#endif

#define GAS __attribute__((address_space(1)))
#define LAS __attribute__((address_space(3)))
typedef unsigned short bf16;
typedef unsigned u32x4 __attribute__((ext_vector_type(4)));
typedef unsigned u32x2 __attribute__((ext_vector_type(2)));
typedef float f32x2 __attribute__((ext_vector_type(2)));
typedef float f32x4 __attribute__((ext_vector_type(4)));
typedef float f32x16 __attribute__((ext_vector_type(16)));
typedef short bf16x8 __attribute__((ext_vector_type(8)));
typedef short s16x4 __attribute__((ext_vector_type(4)));
typedef GAS unsigned gu32;

constexpr int BATCH = 4, SEQ = 8192, DM = 1024, M = BATCH * SEQ, DEPTH = 2;
constexpr int NIN = 7604, ZW = 3584, DFF = 2816, UGW = 5632, PDIM = 256;
constexpr float LN_EPS = 1e-5f;
constexpr float ALPHA = 1.41421356237f;
constexpr float LOG2E = 1.4426950408889634f;
constexpr int ZC_AQ = 0, ZC_AK = 256, ZC_AV = 512, ZC_BQ = 768, ZC_BK = 1024, ZC_BV = 1280, ZC_CQ = 1536, ZC_CK = 1792, ZC_CV = 2048, ZC_CG = 2304,
              ZC_DQ = 2560, ZC_DK = 2688, ZC_DV = 2816, ZC_DG = 3072, ZC_IQ = 3328, ZC_IK = 3456, ZC_IW = 3488, ZC_DA = 3504;
constexpr int SRC_MG = 3508;

constexpr size_t MiB = 1u << 20;
constexpr size_t WS_CTL = 0, CTL_ZERO_BYTES = 1 * MiB;
constexpr size_t WS_XB = 1 * MiB;
constexpr size_t WS_BIG = 65 * MiB;
constexpr size_t WS_Z = WS_BIG, WS_Y = WS_BIG + 224 * MiB, WS_MERGED = WS_BIG + 288 * MiB;
constexpr size_t WS_ACT8 = WS_BIG, WS_GE = WS_BIG + 96 * MiB, WS_G0 = WS_BIG + 104 * MiB, WS_U0 = WS_BIG + 112 * MiB;
constexpr size_t WS_MASK = WS_MERGED, WS_KVC = WS_MERGED + 32 * MiB, WS_KVD = WS_MERGED + 40 * MiB, WS_DE = WS_MERGED + 56 * MiB;
constexpr size_t WS_SCR2 = WS_Z;
constexpr size_t WS_W45 = 417 * MiB, W45_STRIDE = 19 * MiB;
constexpr size_t W45_UP = 0, W45_PG = 11 * MiB, W45_PP = 13 * MiB, W45_DN = 13 * MiB + 512 * 1024;
constexpr size_t WS_PB = 455 * MiB;
constexpr size_t WS_W123 = 487 * MiB;
constexpr size_t WS_END = 506 * MiB;
constexpr size_t W123_W1 = 0, W123_GB = 7 * MiB, W123_WO = 17 * MiB;
constexpr size_t DO_SCR5 = 0;
constexpr size_t DO_XB8 = 64 * MiB;
constexpr size_t DO_W8 = 96 * MiB, W8_STRIDE = 15 * MiB + 256 * 1024, W8_G = 0, W8_UP = 4 * MiB, W8_PG = 9 * MiB + 512 * 1024, W8_DN = 10 * MiB + 512 * 1024, W8_Z = 13 * MiB + 256 * 1024;
constexpr unsigned long long G1_F8_TILES = 0xCB987652ull, G1_BF_TILES = 0xDA4310ull;

constexpr int CW_BAR = 4096, CW_WQ = 8448  , CW_KMAX = 8192;

constexpr int RING_BYTES = 131072;
constexpr int MISC_OFF = 131072 + 320;
constexpr int QST_OFF = 132096;
constexpr int LDS_BYTES = 147456;

constexpr int NWAVES = 8;

#define RLX_AGENT __ATOMIC_RELAXED, __HIP_MEMORY_SCOPE_AGENT
__device__ __forceinline__ unsigned f2bf(float f) { unsigned u = __builtin_bit_cast(unsigned, f); return (u + 0x7fffu + ((u >> 16) & 1u)) >> 16; }
typedef __bf16 bf16x2_t __attribute__((ext_vector_type(2)));
__device__ __forceinline__ unsigned pk2(float lo, float hi) { const f32x2 v = {lo, hi}; const bf16x2_t b = __builtin_convertvector(v, bf16x2_t); return __builtin_bit_cast(unsigned, b); }
__device__ __forceinline__ unsigned pk4f8(float a, float b, float c, float d) { int p = __builtin_amdgcn_cvt_pk_fp8_f32(a, b, 0, false); p = __builtin_amdgcn_cvt_pk_fp8_f32(c, d, p, true); return (unsigned)p; }
__device__ __forceinline__ float bflo(unsigned w) { return __uint_as_float(w << 16); }
__device__ __forceinline__ float bfhi(unsigned w) { return __uint_as_float(w & 0xffff0000u); }
__device__ __forceinline__ float bf1(bf16 b) { return __uint_as_float((unsigned)b << 16); }
__device__ __forceinline__ void up8(const u32x4 w, float (&v)[8]) { v[0] = bflo(w.x); v[1] = bfhi(w.x); v[2] = bflo(w.y); v[3] = bfhi(w.y); v[4] = bflo(w.z); v[5] = bfhi(w.z); v[6] = bflo(w.w); v[7] = bfhi(w.w); }
__device__ __forceinline__ float sigmoidf_(float x) { return __builtin_amdgcn_rcpf(1.0f + __builtin_amdgcn_exp2f(-LOG2E * x)); }
__device__ __forceinline__ float shx(float v, int lane, int m) { return __int_as_float(__builtin_amdgcn_ds_bpermute((lane ^ m) << 2, __float_as_int(v))); }
__device__ __forceinline__ unsigned shup(unsigned v, int lane, int o) { return (unsigned)__builtin_amdgcn_ds_bpermute((lane - o) << 2, (int)v); }
__device__ __forceinline__ float wave_sum(float v, int lane) {
#pragma unroll
    for (int o = 1; o < 64; o <<= 1) v += shx(v, lane, o);
    return v;
}

#define XB_TMO      128
#define XB_XCNT(j)  (256  + 64 * (j))
#define XB_XSUB(j)  (1280 + 64 * (j))
#define XB_XGEN(j)  (2304 + 64 * (j))
#define XB_TOP      3328
#define XB_TOPGEN   3392
#define XCD_BAR_WORDS 3456
#define XB_SPIN_CAP (1u << 22)

__device__ __forceinline__ unsigned xb_ld(unsigned* p)              { return __hip_atomic_load(p, __ATOMIC_RELAXED, __HIP_MEMORY_SCOPE_AGENT); }
__device__ __forceinline__ unsigned xb_add(unsigned* p, unsigned v) { return __hip_atomic_fetch_add(p, v, __ATOMIC_RELAXED, __HIP_MEMORY_SCOPE_AGENT); }
__device__ __forceinline__ unsigned xb_xcc_id() { return (unsigned)__builtin_amdgcn_s_getreg((3 << 11) | 20) & 0xFu; }
#define XB_SPIN(cond, bar) do { unsigned _sp = 0; while (cond) { __builtin_amdgcn_s_sleep(1); \
    if ((++_sp & 255u) == 0u) { if (xb_ld(&(bar)[XB_TMO])) break; if (_sp > XB_SPIN_CAP) { atomicAdd(&(bar)[XB_TMO], 1u); break; } } } } while (0)

struct XcdBarrier { unsigned* bar; unsigned x; volatile LAS unsigned* st; };

__device__ __forceinline__ XcdBarrier xcd_barrier_post(unsigned* bar, volatile LAS unsigned* st) {
    XcdBarrier b; b.bar = bar; b.x = xb_xcc_id(); b.st = st;
    if (threadIdx.x == 0) (void)xb_add(&bar[XB_XCNT(b.x)], 1u);
    return b;
}
__device__ __forceinline__ void xcd_barrier_complete(unsigned* bar, unsigned x, unsigned& nloc, unsigned& nx) {
    const unsigned G = gridDim.x * gridDim.y * gridDim.z;
    unsigned sum, cnt, mine, sp = 0u;
    for (;;) {
        sum = 0u; cnt = 0u; mine = 0u;
#pragma unroll
        for (unsigned j = 0; j < 16; ++j) { const unsigned c = xb_ld(&bar[XB_XCNT(j)]); sum += c; cnt += (c > 0u) ? 1u : 0u; mine = (j == x) ? c : mine; }
        if (sum == G) break;
        __builtin_amdgcn_s_sleep(1);
        if ((++sp & 255u) == 0u) { if (xb_ld(&bar[XB_TMO])) break; if (sp > XB_SPIN_CAP) { atomicAdd(&bar[XB_TMO], 1u); break; } }
    }
    nloc = mine > 0u ? mine : 1u; nx = cnt > 0u ? cnt : 1u;
}
__device__ __forceinline__ void xcd_barrier(const XcdBarrier& b, const bool leader_thread) {
    asm volatile("s_waitcnt vmcnt(0)" ::: "memory");
    __syncthreads();
    if (leader_thread) {
        unsigned* bar = b.bar;
        __builtin_amdgcn_s_waitcnt(0);
        unsigned nloc = b.st[0], nx = b.st[1];
        if (nloc == 0u) { xcd_barrier_complete(bar, b.x, nloc, nx); b.st[0] = nloc; b.st[1] = nx; }
        const unsigned old = xb_add(&bar[XB_XSUB(b.x)], 1u);
        const unsigned gen = old / nloc;
        if (old + 1u == (gen + 1u) * nloc) {
            __builtin_amdgcn_fence(__ATOMIC_RELEASE, "agent");
            asm volatile("s_waitcnt vmcnt(0)" ::: "memory");
            const unsigned og = xb_add(&bar[XB_TOP], 1u);
            const unsigned tg = og / nx;
            if (og + 1u == (tg + 1u) * nx) xb_add(&bar[XB_TOPGEN], 1u);
            else XB_SPIN(xb_ld(&bar[XB_TOPGEN]) == tg, bar);
            __builtin_amdgcn_fence(__ATOMIC_ACQUIRE, "agent");
            xb_add(&bar[XB_XGEN(b.x)], 1u);
            asm volatile("s_waitcnt vmcnt(0)" ::: "memory");
        } else {
            XB_SPIN(xb_ld(&bar[XB_XGEN(b.x)]) == gen, bar);
            __builtin_amdgcn_fence(__ATOMIC_ACQUIRE, "agent");
            asm volatile("s_waitcnt vmcnt(0)" ::: "memory");
        }
    }
    __syncthreads();
}

namespace pg8 {
constexpr int BM = 256, BK = 64, HALF = 128, HTB = HALF * BK * 2, STAGE_BYTES = 8 * HTB, NXCD = 8, WGM = 8;
__device__ __forceinline__ int lds_byte(int r, int c) { const int st = (r >> 4) * 2 + (c >> 5), rr = r & 15, cc = c & 31, ob = rr * 64 + cc * 2; return st * 1024 + (ob ^ (((ob >> 9) & 1) << 5)); }
__device__ __forceinline__ void stage_rc(int b, int& R, int& C) { const int st = b / 1024, sb = b % 1024, swz = sb ^ (((sb >> 9) & 1) << 5); R = (st >> 1) * 16 + swz / 64; C = (st & 1) * 32 + (swz % 64) / 2; }
__device__ __forceinline__ int perm32(int rho) { const int n = rho >> 4, i = rho & 15; return 8 * (i >> 2) + 4 * n + (i & 3); }

struct UnitD { const char* A; const char* B; int lda2, ldb2, nt, pm, pn, kind; };

__device__ __forceinline__ void tile_map(int L, int nM, int nN, int& pm, int& pn) {
    const int nwg = nM * nN; int wgid = L;
    { const int q = nwg / NXCD, r = nwg % NXCD, xcd = wgid % NXCD, off = wgid / NXCD; wgid = (xcd < r ? xcd * (q + 1) : r * (q + 1) + (xcd - r) * q) + off; }
    const int nig = WGM * nN, gid = wgid / nig, fm = gid * WGM, gsz = (nM - fm) < WGM ? (nM - fm) : WGM;
    pm = fm + ((wgid % nig) % gsz); pn = (wgid % nig) / gsz;
}

typedef int i32x8 __attribute__((ext_vector_type(8)));
template <class Epi, class Sched, bool FP8 = false>
__device__ __forceinline__ void gemm_phase(LAS unsigned char* lds, const Sched& S, const Epi& E, const int tid) {
    const int wid = __builtin_amdgcn_readfirstlane(tid >> 6), lane = tid & 63, wr = wid >> 2, wc = wid & 3, fr = lane & 15, fq = lane >> 4;
    int sR, sRb, sC2;
    { int R, C; stage_rc(tid * 16, R, C); sR = R; sRb = (R & ~31) + perm32(R & 31); sC2 = C * 2; }
    const size_t kstep = (size_t)(BK * 2);
    const unsigned ldsw = (unsigned)wid * 1024u;
    const int aoff = lds_byte(wr * 64 + fr, FP8 ? fq * 16 : fq * 8), boff = lds_byte(wc * 32 + fr, FP8 ? fq * 16 : fq * 8);
#define PG8_SA(b, h) (((b) * 2 + (h)) * HTB)
#define PG8_SB(b, h) ((4 + (b) * 2 + (h)) * HTB)
#define PG8_STAGE(bufoff, gbase, rows, pitch) do { const unsigned _o = (unsigned)((rows) * (pitch) + sC2); _Pragma("unroll") for (int _i = 0; _i < 2; ++_i) \
        __builtin_amdgcn_global_load_lds((const unsigned*)((const char*)(gbase) + (size_t)(_i * 64) * (pitch) + _o), (LAS unsigned*)(lds + (bufoff) + ldsw + _i * 8192), 16, 0, 0); } while (0)
#define PG8_LDA(dst, b, h) do { if constexpr (FP8) { _Pragma("unroll") for (int m = 0; m < 4; ++m) { const u32x4 lo_ = *(const LAS u32x4*)(lds + PG8_SA(b, h) + aoff + m * 2048), hi_ = *(const LAS u32x4*)(lds + PG8_SA(b, h) + aoff + m * 2048 + 16); \
            dst##8[m] = (i32x8){(int)lo_.x, (int)lo_.y, (int)lo_.z, (int)lo_.w, (int)hi_.x, (int)hi_.y, (int)hi_.z, (int)hi_.w}; } } \
        else { _Pragma("unroll") for (int m = 0; m < 4; ++m) _Pragma("unroll") for (int k = 0; k < 2; ++k) dst[m][k] = *(const LAS bf16x8*)(lds + PG8_SA(b, h) + aoff + m * 2048 + k * 1024); } } while (0)
#define PG8_LDB(dst, b, h) do { if constexpr (FP8) { _Pragma("unroll") for (int n = 0; n < 2; ++n) { const u32x4 lo_ = *(const LAS u32x4*)(lds + PG8_SB(b, h) + boff + n * 2048), hi_ = *(const LAS u32x4*)(lds + PG8_SB(b, h) + boff + n * 2048 + 16); \
            dst##8[n] = (i32x8){(int)lo_.x, (int)lo_.y, (int)lo_.z, (int)lo_.w, (int)hi_.x, (int)hi_.y, (int)hi_.z, (int)hi_.w}; } } \
        else { _Pragma("unroll") for (int n = 0; n < 2; ++n) _Pragma("unroll") for (int k = 0; k < 2; ++k) dst[n][k] = *(const LAS bf16x8*)(lds + PG8_SB(b, h) + boff + n * 2048 + k * 1024); } } while (0)
#define PG8_MMA(ai, bj, At, Bt) do { __builtin_amdgcn_s_setprio(1); if constexpr (FP8) { _Pragma("unroll") for (int m = 0; m < 4; ++m) _Pragma("unroll") for (int n = 0; n < 2; ++n) \
            asm volatile("v_mfma_scale_f32_16x16x128_f8f6f4 %0, %1, %2, %0, %3, %3 op_sel_hi:[0,0,0]" : "+v"(acc[ai][bj][m][n]) : "v"(Bt##8[n]), "v"(At##8[m]), "v"(scl8)); } \
        else { _Pragma("unroll") for (int m = 0; m < 4; ++m) _Pragma("unroll") for (int n = 0; n < 2; ++n) _Pragma("unroll") for (int k = 0; k < 2; ++k) \
            acc[ai][bj][m][n] = __builtin_amdgcn_mfma_f32_16x16x32_bf16(Bt[n][k], At[m][k], acc[ai][bj][m][n], 0, 0, 0); } __builtin_amdgcn_s_setprio(0); } while (0)
#define PG8_WAIT_V(n) asm volatile("s_waitcnt vmcnt(" #n ")" ::: "memory")
#define PG8_WAIT_L(n) asm volatile("s_waitcnt lgkmcnt(" #n ")" ::: "memory")
#define PG8_BAR __builtin_amdgcn_s_barrier()
#define PG8_SCHED __builtin_amdgcn_sched_barrier(0)
    UnitD cur, nxt; int ui = 0;
    if (!S.next(0, cur)) return;
    f32x4 acc[2][2][4][2];
#pragma unroll
    for (int a = 0; a < 2; ++a)
#pragma unroll
        for (int b = 0; b < 2; ++b)
#pragma unroll
            for (int m = 0; m < 4; ++m)
#pragma unroll
                for (int n = 0; n < 2; ++n) acc[a][b][m][n] = (f32x4){0.f, 0.f, 0.f, 0.f};
    bf16x8 At[4][2], B0[2][2], B1[2][2]; i32x8 At8[4], B08[2], B18[2];
    int scl8 = 0x7c7c7c7c; asm volatile("" : "+v"(scl8));
    const char* cA = cur.A; const char* cB = cur.B;
    int pA = cur.lda2, pB = cur.ldb2;
    PG8_STAGE(PG8_SB(0, 0), cB, sRb, pB); PG8_STAGE(PG8_SB(0, 1), cB + (size_t)HALF * pB, sRb, pB); PG8_STAGE(PG8_SA(0, 0), cA, sR, pA); PG8_STAGE(PG8_SA(0, 1), cA + (size_t)HALF * pA, sR, pA);
    if (wr == 1) PG8_BAR;
    PG8_WAIT_V(2); PG8_BAR;
    PG8_STAGE(PG8_SB(1, 0), cB + kstep, sRb, pB); PG8_STAGE(PG8_SA(1, 0), cA + kstep, sR, pA); PG8_STAGE(PG8_SB(1, 1), cB + (size_t)HALF * pB + kstep, sRb, pB);
    PG8_WAIT_V(6); PG8_BAR;
    for (;;) {
        const bool has_next = S.next(ui + 1, nxt);
        if (!has_next) nxt = cur;
        const char* nA = nxt.A; const char* nB = nxt.B;
        const int nt = cur.nt;
        for (int t = 0; t < nt; t += 2) {
            const bool last = (t == nt - 2);
            const char* a1 = cA + (size_t)(t + 1) * kstep + (size_t)HALF * pA;
            const char* a2 = last ? nA : cA + (size_t)(t + 2) * kstep; const char* b2 = last ? nB : cB + (size_t)(t + 2) * kstep;
            const int p2A = last ? nxt.lda2 : pA, p2B = last ? nxt.ldb2 : pB;
            const char* a2h = a2 + (size_t)HALF * p2A; const char* b2h = b2 + (size_t)HALF * p2B;
            PG8_LDB(B0, 0, 0); PG8_LDB(B1, 0, 1); PG8_SCHED; PG8_LDA(At, 0, 0); PG8_STAGE(PG8_SA(1, 1), a1, sR, pA);
            PG8_WAIT_V(8); PG8_WAIT_L(0); PG8_BAR; PG8_MMA(0, 0, At, B0); PG8_MMA(0, 1, At, B1); PG8_BAR; PG8_SCHED;
            PG8_LDA(At, 0, 1); PG8_STAGE(PG8_SB(0, 0), b2, sRb, p2B); PG8_STAGE(PG8_SB(0, 1), b2h, sRb, p2B); PG8_STAGE(PG8_SA(0, 0), a2, sR, p2A);
            PG8_WAIT_V(8); PG8_WAIT_L(0); PG8_BAR; PG8_MMA(1, 0, At, B0); PG8_MMA(1, 1, At, B1); PG8_BAR; PG8_SCHED;
            PG8_LDB(B0, 1, 0); PG8_LDB(B1, 1, 1); PG8_SCHED; PG8_LDA(At, 1, 0); PG8_STAGE(PG8_SA(0, 1), a2h, sR, p2A);
            PG8_WAIT_V(8); PG8_WAIT_L(0); PG8_BAR; PG8_MMA(0, 0, At, B0); PG8_MMA(0, 1, At, B1); PG8_BAR; PG8_SCHED;
            PG8_LDA(At, 1, 1); PG8_STAGE(PG8_SB(1, 0), b2 + kstep, sRb, p2B); PG8_STAGE(PG8_SB(1, 1), b2h + kstep, sRb, p2B); PG8_STAGE(PG8_SA(1, 0), a2 + kstep, sR, p2A);
            PG8_WAIT_V(8); PG8_WAIT_L(0); PG8_BAR; PG8_MMA(1, 0, At, B0); PG8_MMA(1, 1, At, B1); PG8_BAR; PG8_SCHED;
        }
        if constexpr (FP8) asm volatile("s_nop 15\n\ts_nop 15" ::: "memory");
        if (wr == 0) PG8_BAR;
        { int l2; asm volatile("v_mbcnt_lo_u32_b32 %0, -1, 0\n\tv_mbcnt_hi_u32_b32 %0, -1, %0" : "=v"(l2)); E(acc, cur, wr, wc, l2 & 15, l2 >> 4, wid * 64 + l2); }
        if (!has_next) break;
#pragma unroll
        for (int a = 0; a < 2; ++a)
#pragma unroll
            for (int b = 0; b < 2; ++b)
#pragma unroll
                for (int m = 0; m < 4; ++m)
#pragma unroll
                    for (int n = 0; n < 2; ++n) acc[a][b][m][n] = (f32x4){0.f, 0.f, 0.f, 0.f};
        cur = nxt; cA = nA; cB = nB; pA = cur.lda2; pB = cur.ldb2;
        ++ui;
        if (wr == 1) PG8_BAR;
    }
    PG8_WAIT_V(0);
    PG8_BAR;
#undef PG8_SA
#undef PG8_SB
#undef PG8_STAGE
#undef PG8_LDA
#undef PG8_LDB
#undef PG8_MMA
#undef PG8_WAIT_V
#undef PG8_WAIT_L
#undef PG8_BAR
#undef PG8_SCHED
}

struct SchedPlain {
    const char* A; const char* B; int lda2, ldb2, nt, nM, nN, G, c;
    __device__ __forceinline__ bool next(int i, UnitD& u) const {
        const long L = (long)i * G + c; if (L >= (long)nM * nN) return false;
        int pm, pn; tile_map((int)L, nM, nN, pm, pn);
        u.A = A + (size_t)pm * 256 * lda2; u.B = B + (size_t)pn * 256 * ldb2; u.lda2 = lda2; u.ldb2 = ldb2; u.nt = nt; u.pm = pm; u.pn = pn; u.kind = i; return true;
    }
};
struct SchedTiles {
    const char* A; const char* B; int lda2, ldb2, nt, ntile; unsigned long long list; int compact, G, c;
    __device__ __forceinline__ bool next(int i, UnitD& u) const {
        const long L = (long)i * G + c; if (L >= (long)128 * ntile) return false;
        int pm, pi; tile_map((int)L, 128, ntile, pm, pi); const int col = (int)((list >> (4 * pi)) & 15ull);
        u.A = A + (size_t)pm * 256 * lda2; u.B = B + (size_t)(compact ? pi : col) * 256 * ldb2; u.lda2 = lda2; u.ldb2 = ldb2; u.nt = nt; u.pm = pm; u.pn = col; u.kind = i; return true;
    }
};
struct SchedUp {
    const char* A; const char* B; int G, c;
    __device__ __forceinline__ bool next(int i, UnitD& u) const {
        const long L = (long)i * G + c; if (L >= 128 * 22) return false;
        int pm, cb; tile_map((int)L, 128, 22, pm, cb);
        u.A = A + (size_t)pm * 256 * 1024; u.lda2 = 1024; u.B = B + (size_t)cb * 256 * 1024; u.ldb2 = 1024; u.nt = 8; u.pm = pm; u.pn = cb; u.kind = i; return true;
    }
};
struct SchedG5b {
    const char* A; const char* B; int G, c;
    __device__ __forceinline__ bool next(int i, UnitD& u) const {
        const long L = (long)i * G + c; if (L >= 128 * 4) return false;
        int pm, pn; tile_map((int)L, 128, 4, pm, pn);
        u.A = A + (size_t)pm * 256 * DFF; u.lda2 = DFF; u.B = B + (size_t)pn * 256 * DFF; u.ldb2 = DFF; u.nt = 22; u.pm = pm; u.pn = pn; u.kind = i; return true;
    }
};

#define EPI_LOOP for (int ai = 0; ai < 2; ++ai) _Pragma("unroll") for (int m = 0; m < 4; ++m) _Pragma("unroll") for (int bj = 0; bj < 2; ++bj)
struct EpiStore {
    bf16* O; int ldc;
    __device__ __forceinline__ void operator()(const f32x4 (&acc)[2][2][4][2], const UnitD& u, int wr, int wc, int fr, int fq, int tid) const {
        const int row0 = u.pm * BM + wr * 64 + fr, col0 = u.pn * BM + wc * 32 + 8 * fq;
#pragma unroll
        EPI_LOOP { const f32x4 v0 = acc[ai][bj][m][0], v1 = acc[ai][bj][m][1];
            u32x4 w; w.x = pk2(v0[0], v0[1]); w.y = pk2(v0[2], v0[3]); w.z = pk2(v1[0], v1[1]); w.w = pk2(v1[2], v1[3]);
            *(u32x4*)(O + (size_t)(row0 + ai * HALF + m * 16) * ldc + col0 + bj * HALF) = w; }
    }
};
struct EpiSlotStore {
    unsigned char* sc_; int act;
    __device__ __forceinline__ void operator()(const f32x4 (&acc)[2][2][4][2], const UnitD& u, int wr, int wc, int fr, int fq, int tid) const {
        unsigned loff = (unsigned)tid * 16u; asm volatile("" : "+v"(loff));
        unsigned char* sc = sc_ + (size_t)u.kind * 131072 + loff;
#pragma unroll
        EPI_LOOP { const int q = (ai * 2 + bj) * 4 + m; f32x4 v0 = acc[ai][bj][m][0], v1 = acc[ai][bj][m][1];
            if (act) { v0 = (f32x4){sigmoidf_(v0[0]), sigmoidf_(v0[1]), sigmoidf_(v0[2]), sigmoidf_(v0[3])}; v1 = (f32x4){sigmoidf_(v1[0]), sigmoidf_(v1[1]), sigmoidf_(v1[2]), sigmoidf_(v1[3])}; }
            u32x4 w; w.x = pk2(v0[0], v0[1]); w.y = pk2(v0[2], v0[3]); w.z = pk2(v1[0], v1[1]); w.w = pk2(v1[2], v1[3]);
            *(u32x4*)(sc + (size_t)q * 8192) = w; }
    }
};
struct EpiSlotMul {
    unsigned char* sc_;
    __device__ __forceinline__ void operator()(const f32x4 (&acc)[2][2][4][2], const UnitD& u, int wr, int wc, int fr, int fq, int tid) const {
        unsigned loff = (unsigned)tid * 16u; asm volatile("" : "+v"(loff));
        unsigned char* sc = sc_ + (size_t)u.kind * 131072 + loff;
#pragma unroll
        EPI_LOOP { const int q = (ai * 2 + bj) * 4 + m; const f32x4 v0 = acc[ai][bj][m][0], v1 = acc[ai][bj][m][1];
            u32x4* sp = (u32x4*)(sc + (size_t)q * 8192); const u32x4 p = *sp;
            u32x4 w; w.x = pk2(sigmoidf_(v0[0]) * bflo(p.x), sigmoidf_(v0[1]) * bfhi(p.x)); w.y = pk2(sigmoidf_(v0[2]) * bflo(p.y), sigmoidf_(v0[3]) * bfhi(p.y));
            w.z = pk2(sigmoidf_(v1[0]) * bflo(p.z), sigmoidf_(v1[1]) * bfhi(p.z)); w.w = pk2(sigmoidf_(v1[2]) * bflo(p.w), sigmoidf_(v1[3]) * bfhi(p.w));
            *sp = w;
            if (m & 1) asm volatile("" ::: "memory"); }
    }
};
struct EpiBranch {
    const unsigned char* sc_; bf16* MG; int first;
    __device__ __forceinline__ void operator()(const f32x4 (&acc)[2][2][4][2], const UnitD& u, int wr, int wc, int fr, int fq, int tid) const {
        const int row0 = u.pm * BM + wr * 64 + fr, col0 = u.pn * BM + wc * 32 + 8 * fq;
        unsigned loff = (unsigned)tid * 16u; asm volatile("" : "+v"(loff));
        const unsigned char* sc = sc_ + (size_t)u.kind * 131072 + loff;
#pragma unroll
        EPI_LOOP { const int q = (ai * 2 + bj) * 4 + m; const f32x4 v0 = acc[ai][bj][m][0], v1 = acc[ai][bj][m][1];
            const u32x4 g = *(const u32x4*)(sc + (size_t)q * 8192);
            u32x4* p = (u32x4*)(MG + (size_t)(row0 + ai * HALF + m * 16) * DM + col0 + bj * HALF);
            f32x4 t0 = (f32x4){bflo(g.x) * v0[0], bfhi(g.x) * v0[1], bflo(g.y) * v0[2], bfhi(g.y) * v0[3]};
            f32x4 t1 = (f32x4){bflo(g.z) * v1[0], bfhi(g.z) * v1[1], bflo(g.w) * v1[2], bfhi(g.w) * v1[3]};
            if (!first) { const u32x4 x = *p; t0 += (f32x4){bflo(x.x), bfhi(x.x), bflo(x.y), bfhi(x.y)}; t1 += (f32x4){bflo(x.z), bfhi(x.z), bflo(x.w), bfhi(x.w)}; }
            u32x4 w; w.x = pk2(t0[0], t0[1]); w.y = pk2(t0[2], t0[3]); w.z = pk2(t1[0], t1[1]); w.w = pk2(t1[2], t1[3]);
            *p = w;
            if (m & 1) asm volatile("" ::: "memory"); }
    }
};
__device__ __forceinline__ float gelu_tanh_e(float y) { const float t = 1.5957691216057308f * (y + 0.044715f * y * y * y); return y * __builtin_amdgcn_rcpf(1.0f + __builtin_amdgcn_exp2f(-LOG2E * t)); }
__device__ __forceinline__ float dpp_prev1(float prev, float cur) {
    const int o = __builtin_amdgcn_update_dpp(0, __builtin_bit_cast(int, prev), 0x121, 0xf, 0xf, true);
    return __builtin_bit_cast(float, __builtin_amdgcn_update_dpp(o, __builtin_bit_cast(int, cur), 0x111, 0xf, 0xf, false)); }
__device__ __forceinline__ float dpp_prev2(float prev, float cur) {
    const int o = __builtin_amdgcn_update_dpp(0, __builtin_bit_cast(int, prev), 0x122, 0xf, 0xf, true);
    return __builtin_bit_cast(float, __builtin_amdgcn_update_dpp(o, __builtin_bit_cast(int, cur), 0x112, 0xf, 0xf, false)); }
struct EpiUp {
    bf16* GE; bf16* G0; bf16* U0; unsigned char* ACT8; const float* cw; const float* cbias;
    __device__ __forceinline__ void operator()(const f32x4 (&acc)[2][2][4][2], const UnitD& u, int wr, int wc, int fr, int fq, int tid) const {
        const int gc = u.pn * 128 + wc * 32 + 8 * fq; f32x4 wv[8];
        wv[0] = *(const f32x4*)(cw + gc); wv[1] = *(const f32x4*)(cw + gc + 4); wv[2] = *(const f32x4*)(cw + DFF + gc); wv[3] = *(const f32x4*)(cw + DFF + gc + 4);
        wv[4] = *(const f32x4*)(cw + 2 * DFF + gc); wv[5] = *(const f32x4*)(cw + 2 * DFF + gc + 4); wv[6] = *(const f32x4*)(cbias + gc); wv[7] = *(const f32x4*)(cbias + gc + 4);
#pragma unroll
        for (int ai = 0; ai < 2; ++ai) { const int rb = u.pm * 4 + ai * 2 + wr;
#pragma unroll
            for (int m = 0; m < 4; ++m) { const int r = wr * 64 + fr + ai * HALF + m * 16; float o[8];
#pragma unroll
                for (int i = 0; i < 8; ++i) { const float g0_ = acc[ai][0][m][i >> 2][i & 3], gp_ = (m > 0) ? acc[ai][0][m > 0 ? m - 1 : 0][i >> 2][i & 3] : 0.f;
                    const float g1_ = dpp_prev1(gp_, g0_), g2_ = dpp_prev2(gp_, g0_);
                    const float y_ = wv[6 + (i >> 2)][i & 3] + wv[(i >> 2)][i & 3] * g2_ + wv[2 + (i >> 2)][i & 3] * g1_ + wv[4 + (i >> 2)][i & 3] * g0_; o[i] = gelu_tanh_e(y_) * acc[ai][1][m][i >> 2][i & 3]; }
                u32x2 w8; w8.x = pk4f8(o[0], o[1], o[2], o[3]); w8.y = pk4f8(o[4], o[5], o[6], o[7]);
                *(u32x2*)(ACT8 + (size_t)(u.pm * BM + r) * DFF + gc) = w8;
                if (m == 0 || m == 3) { const f32x4 v0 = acc[ai][0][m][0], v1 = acc[ai][0][m][1]; u32x4 w; w.x = pk2(v0[0], v0[1]); w.y = pk2(v0[2], v0[3]); w.z = pk2(v1[0], v1[1]); w.w = pk2(v1[2], v1[3]);
                    if (m == 0 && fr < 2) { *(u32x4*)(G0 + ((size_t)rb * 2 + fr) * DFF + gc) = w;
                        const f32x4 x0 = acc[ai][1][m][0], x1 = acc[ai][1][m][1]; u32x4 wu; wu.x = pk2(x0[0], x0[1]); wu.y = pk2(x0[2], x0[3]); wu.z = pk2(x1[0], x1[1]); wu.w = pk2(x1[2], x1[3]);
                        *(u32x4*)(U0 + ((size_t)rb * 2 + fr) * DFF + gc) = wu; }
                    if (m == 3 && fr >= 14) *(u32x4*)(GE + ((size_t)rb * 2 + (fr - 14)) * DFF + gc) = w; } } }
    }
};
struct EpiG3 {
    bf16* XB;
    __device__ __forceinline__ void operator()(const f32x4 (&acc)[2][2][4][2], const UnitD& u, int wr, int wc, int fr, int fq, int tid) const {
        const int row0 = u.pm * BM + wr * 64 + fr, col0 = u.pn * BM + wc * 32 + 8 * fq;
#pragma unroll
        EPI_LOOP { const f32x4 v0 = acc[ai][bj][m][0], v1 = acc[ai][bj][m][1];
            u32x4* p = (u32x4*)(XB + (size_t)(row0 + ai * HALF + m * 16) * DM + col0 + bj * HALF); const u32x4 x = *p;
            u32x4 w; w.x = pk2(ALPHA * bflo(x.x) + v0[0], ALPHA * bfhi(x.x) + v0[1]); w.y = pk2(ALPHA * bflo(x.y) + v0[2], ALPHA * bfhi(x.y) + v0[3]);
            w.z = pk2(ALPHA * bflo(x.z) + v1[0], ALPHA * bfhi(x.z) + v1[1]); w.w = pk2(ALPHA * bflo(x.w) + v1[2], ALPHA * bfhi(x.w) + v1[3]);
            *p = w; }
    }
};
struct EpiG5b {
    const unsigned char* esc_; bf16* XB;
    __device__ __forceinline__ void operator()(const f32x4 (&acc)[2][2][4][2], const UnitD& u, int wr, int wc, int fr, int fq, int tid) const {
        const int row0 = u.pm * BM + wr * 64 + fr, col0 = u.pn * BM + wc * 32 + 8 * fq;
        unsigned loff = (unsigned)tid * 16u; asm volatile("" : "+v"(loff));
        const unsigned char* esc = esc_ + (size_t)u.kind * 131072 + loff;
#pragma unroll
        EPI_LOOP { const int q = (ai * 2 + bj) * 4 + m; const f32x4 v0 = acc[ai][bj][m][0], v1 = acc[ai][bj][m][1];
            const u32x4 e = *(const u32x4*)(esc + (size_t)q * 8192);
            u32x4* p = (u32x4*)(XB + (size_t)(row0 + ai * HALF + m * 16) * DM + col0 + bj * HALF); const u32x4 x = *p;
            u32x4 w; w.x = pk2(ALPHA * bflo(x.x) + v0[0] + bflo(e.x), ALPHA * bfhi(x.x) + v0[1] + bfhi(e.x)); w.y = pk2(ALPHA * bflo(x.y) + v0[2] + bflo(e.y), ALPHA * bfhi(x.y) + v0[3] + bfhi(e.y));
            w.z = pk2(ALPHA * bflo(x.z) + v1[0] + bflo(e.z), ALPHA * bfhi(x.z) + v1[1] + bfhi(e.z)); w.w = pk2(ALPHA * bflo(x.w) + v1[2] + bflo(e.w), ALPHA * bfhi(x.w) + v1[3] + bfhi(e.w));
            *p = w;
            if (m & 1) asm volatile("" ::: "memory"); }
    }
};
}

struct Frame {
    LAS unsigned char* lds;
    int tid, lane, wave, G, wg;
    unsigned char* ws; unsigned char* dob;
};
struct Args { const float* in[21]; float* out; unsigned char* ws; int ph_lo, ph_hi, sub, pad; };

__device__ __forceinline__ int z_src(int n, float& sc) {
    sc = 1.f;
    if (n < 768) { if (n < 256) sc = 0.17677669529663687f * LOG2E; return n; }
    if (n < 1536) { if (n < 1024) sc = 0.125f * LOG2E; return n; }
    if (n < 2560) { if (n >= 1792 && n < 2048) sc = 0.125f; return 1700 + (n - 1536); }
    if (n < 2816) { if (n < 2688) sc = 0.17677669529663687f; return 2724 + (n - 2560); }
    if (n < 3072) return 2980 + (n - 2816);
    if (n < 3328) return 3252 + (n - 3072);
    if (n < 3456) return 1536 + (n - 3328);
    if (n < 3488) return 1664 + (n - 3456);
    if (n < 3492) return 1696 + (n - 3488);
    if (n >= 3504 && n < 3520) return 3236 + (n - 3504);
    return -1;
}
template <int MODE>
__device__ __forceinline__ void transpose_item(const float* W, int Nsrc, int soff, bf16* WT, int dpitch, int dcol0, int k0, int n0, LAS float* scr, int lane) {
    const int nn = lane & 31; float sc = 1.f; int s;
    if (MODE == 1) s = z_src(n0 + nn, sc); else s = soff + n0 + nn;
#pragma unroll 8
    for (int i = 0; i < 32; ++i) { const int kk = 2 * i + (lane >> 5); scr[kk * 33 + nn] = (s >= 0) ? W[(size_t)(k0 + kk) * Nsrc + s] * sc : 0.f; }
    asm volatile("s_waitcnt lgkmcnt(0)" ::: "memory");
    const int c = lane & 7;
#pragma unroll
    for (int j = 0; j < 4; ++j) { const int n = (lane >> 3) + 8 * j; const LAS float* sp = scr + (8 * c) * 33 + n;
        u32x4 o; o.x = pk2(sp[0 * 33], sp[1 * 33]); o.y = pk2(sp[2 * 33], sp[3 * 33]); o.z = pk2(sp[4 * 33], sp[5 * 33]); o.w = pk2(sp[6 * 33], sp[7 * 33]);
        *(u32x4*)(WT + (size_t)(n0 + n) * dpitch + dcol0 + k0 + 8 * c) = o; }
    asm volatile("s_waitcnt lgkmcnt(0)" ::: "memory");
}
__device__ __forceinline__ void transpose_item8(const float* W, int Nsrc, int soff, unsigned char* WT, int K, int k0, int n0, LAS float* scr, int lane) {
    const int nn = lane & 31; const int s = soff + n0 + nn;
#pragma unroll 8
    for (int i = 0; i < 32; ++i) { const int kk = 2 * i + (lane >> 5); scr[kk * 33 + nn] = W[(size_t)(k0 + kk) * Nsrc + s] * 64.f; }
    asm volatile("s_waitcnt lgkmcnt(0)" ::: "memory");
    const int c = lane & 7;
#pragma unroll
    for (int j = 0; j < 4; ++j) { const int n = (lane >> 3) + 8 * j; const LAS float* sp = scr + (8 * c) * 33 + n;
        u32x2 o; o.x = pk4f8(sp[0 * 33], sp[1 * 33], sp[2 * 33], sp[3 * 33]); o.y = pk4f8(sp[4 * 33], sp[5 * 33], sp[6 * 33], sp[7 * 33]);
        *(u32x2*)(WT + (size_t)(n0 + n) * K + k0 + 8 * c) = o; }
    asm volatile("s_waitcnt lgkmcnt(0)" ::: "memory");
}
__device__ __forceinline__ void transpose_item8z(const float* W, unsigned char* WT, int tile, int slot, int k0, int n0, LAS float* scr, int lane) {
    const int nn = lane & 31; float sc = 1.f; const int s = z_src(tile * 256 + n0 + nn, sc); sc *= 64.f;
#pragma unroll 8
    for (int i = 0; i < 32; ++i) { const int kk = 2 * i + (lane >> 5); scr[kk * 33 + nn] = (s >= 0) ? W[(size_t)(k0 + kk) * NIN + s] * sc : 0.f; }
    asm volatile("s_waitcnt lgkmcnt(0)" ::: "memory");
    const int c = lane & 7;
#pragma unroll
    for (int j = 0; j < 4; ++j) { const int n = (lane >> 3) + 8 * j; const LAS float* sp = scr + (8 * c) * 33 + n;
        u32x2 o; o.x = pk4f8(sp[0 * 33], sp[1 * 33], sp[2 * 33], sp[3 * 33]); o.y = pk4f8(sp[4 * 33], sp[5 * 33], sp[6 * 33], sp[7 * 33]);
        *(u32x2*)(WT + (size_t)(slot * 256 + n0 + n) * 1024 + k0 + 8 * c) = o; }
    asm volatile("s_waitcnt lgkmcnt(0)" ::: "memory");
}
typedef __attribute__((address_space(4))) const struct Args* KArgPtr;
__device__ __forceinline__ void convert_w123(Frame& F, const float* w_in, const float* w_branch, const float* w_out) {
    LAS float* scr = (LAS float*)(F.lds + F.wave * 16384);
    const int gw = F.wg * NWAVES + F.wave, NGW = F.G * NWAVES;
    constexpr int I1 = 16 * 48, I2 = 0, I3 = 4 * 128, I4 = 16 * 32;
    unsigned char* w123 = F.ws + WS_W123;
    for (int it = gw; it < I1 + I2 + I3 + I4; it += NGW) {
        int r = it;
        if (r < I1) { const int nb = r % 48, tile = (int)((G1_BF_TILES >> (4 * (nb >> 3))) & 15); transpose_item<1>(w_in, NIN, 0, (bf16*)(w123 + W123_W1), 1024, 0, 64 * (r / 48), tile * 256 + 32 * (nb & 7), scr, F.lane); continue; } r -= I1;
        if (r < I3) { const int n = r / 128, rr = r % 128; transpose_item<0>(w_branch + (size_t)n * 256 * DM, DM, 0, (bf16*)(w123 + W123_GB + 8 * MiB) + (size_t)n * 1024 * 256, 256, 0, 64 * (rr / 32), 32 * (rr % 32), scr, F.lane); continue; } r -= I3;
        transpose_item<0>(w_out, DM, 0, (bf16*)(w123 + W123_WO), 1024, 0, 64 * (r / 32), 32 * (r % 32), scr, F.lane);
    }
}
__device__ __forceinline__ void p0_prologue(Frame& F, __attribute__((address_space(4))) const Args* Ap) {
    LAS float* scr = (LAS float*)(F.lds + F.wave * 16384);
    const int gw = F.wg * NWAVES + F.wave, NGW = F.G * NWAVES;
    constexpr int I5 = 0, I6 = 0, I7 = 4 * 32, I8 = 0;
    constexpr int IL = I5 + I6 + I7 + I8;
    for (int it = gw; it < 2 * IL; it += NGW) {
        const int l = it / IL; int r = it - l * IL;
        unsigned char* w45 = F.ws + WS_W45 + (size_t)l * W45_STRIDE;
        if (r < I7) { transpose_item<0>(Ap->in[18] + (size_t)l * PDIM * DM, DM, 0, (bf16*)(w45 + W45_PP), 256, 0, 64 * (r / 32), 32 * (r % 32), scr, F.lane); continue; } r -= I7;
        transpose_item<0>(Ap->in[16] + (size_t)l * DFF * DM, DM, 0, (bf16*)(w45 + W45_DN), DFF, 0, 64 * (r / 32), 32 * (r % 32), scr, F.lane);
    }
    {   constexpr int J1 = 16 * 128, J2 = 16 * 176, J3 = 16 * 32, J4 = 44 * 32, J5 = 8 * 16 * 8, JL = J1 + J2 + J3 + J4 + J5;
        for (int it = gw; it < 2 * JL; it += NGW) { const int l = it / JL; int r = it - l * JL; unsigned char* w8 = F.dob + DO_W8 + (size_t)l * W8_STRIDE;
            if (r < J1) { transpose_item8(Ap->in[2] + (size_t)l * DM * NIN, NIN, SRC_MG, w8 + W8_G, 1024, 64 * (r / 128), 32 * (r % 128), scr, F.lane); continue; } r -= J1;
            if (r < J2) { const int sn = 32 * (r % 176), dn = sn < DFF ? (sn >> 7) * 256 + 128 + (sn & 127) : ((sn - DFF) >> 7) * 256 + ((sn - DFF) & 127);
                transpose_item8(Ap->in[13] + (size_t)l * DM * UGW, UGW, sn - dn, w8 + W8_UP, 1024, 64 * (r / 176), dn, scr, F.lane); continue; } r -= J2;
            if (r < J3) { transpose_item8(Ap->in[17] + (size_t)l * DM * DM, DM, 0, w8 + W8_PG, 1024, 64 * (r / 32), 32 * (r % 32), scr, F.lane); continue; } r -= J3;
            if (r < J4) { transpose_item8(Ap->in[16] + (size_t)l * DFF * DM, DM, 0, w8 + W8_DN, DFF, 64 * (r / 32), 32 * (r % 32), scr, F.lane); continue; } r -= J4;
            { const int slot = r >> 7, rr = r & 127; transpose_item8z(Ap->in[2] + (size_t)l * DM * NIN, w8 + W8_Z, (int)((G1_F8_TILES >> (4 * slot)) & 15), slot, 64 * (rr >> 3), 32 * (rr & 7), scr, F.lane); } } }
    convert_w123(F, Ap->in[2], Ap->in[9], Ap->in[10]);
    {   const size_t n8 = (size_t)M * DM / 8; const f32x4* src = (const f32x4*)Ap->in[0]; u32x4* dst = (u32x4*)(F.ws + WS_XB); u32x2* dst8 = (u32x2*)(F.dob + DO_XB8);
        for (size_t i = (size_t)F.wg * 512 + F.tid; i < n8; i += (size_t)F.G * 512) { const f32x4 a = src[2 * i], b = src[2 * i + 1]; u32x4 o; o.x = pk2(a[0], a[1]); o.y = pk2(a[2], a[3]); o.z = pk2(b[0], b[1]); o.w = pk2(b[2], b[3]); dst[i] = o;
            u32x2 o8; o8.x = pk4f8(a[0], a[1], a[2], a[3]); o8.y = pk4f8(b[0], b[1], b[2], b[3]); dst8[i] = o8; } }
    {   const size_t n8 = (size_t)DEPTH * M * PDIM / 8; const f32x4* src = (const f32x4*)Ap->in[1]; u32x4* dst = (u32x4*)(F.ws + WS_PB);
        for (size_t i = (size_t)F.wg * 512 + F.tid; i < n8; i += (size_t)F.G * 512) { const f32x4 a = src[2 * i], b = src[2 * i + 1]; u32x4 o; o.x = pk2(a[0], a[1]); o.y = pk2(a[2], a[3]); o.z = pk2(b[0], b[1]); o.w = pk2(b[2], b[3]); dst[i] = o; } }
}

__device__ __forceinline__ void ln_phase(Frame& F, const float* w, const float* bvec, float* outf, unsigned char* xb8) {
    const int gw = F.wg * NWAVES + F.wave, NGW = F.G * NWAVES;
    bf16* XB = (bf16*)(F.ws + WS_XB);
    for (int row = gw; row < M; row += NGW) {
        u32x4* p = (u32x4*)(XB + (size_t)row * DM) + F.lane;
        const u32x4 a = p[0], b = p[64];
        float v[16] = {bflo(a.x), bfhi(a.x), bflo(a.y), bfhi(a.y), bflo(a.z), bfhi(a.z), bflo(a.w), bfhi(a.w), bflo(b.x), bfhi(b.x), bflo(b.y), bfhi(b.y), bflo(b.z), bfhi(b.z), bflo(b.w), bfhi(b.w)};
        float s = 0.f;
#pragma unroll
        for (int i = 0; i < 16; ++i) s += v[i];
        const float mean = wave_sum(s, F.lane) * (1.f / DM); float q = 0.f;
#pragma unroll
        for (int i = 0; i < 16; ++i) { v[i] -= mean; q += v[i] * v[i]; }
        const float rstd = 1.f / sqrtf(wave_sum(q, F.lane) * (1.f / DM) + LN_EPS);
        const int c0 = F.lane * 8, c1 = 512 + F.lane * 8;
        const f32x4 w0 = *(const f32x4*)(w + c0), w1 = *(const f32x4*)(w + c0 + 4), w2 = *(const f32x4*)(w + c1), w3 = *(const f32x4*)(w + c1 + 4);
        const f32x4 b0 = *(const f32x4*)(bvec + c0), b1 = *(const f32x4*)(bvec + c0 + 4), b2 = *(const f32x4*)(bvec + c1), b3 = *(const f32x4*)(bvec + c1 + 4);
        f32x4 y0, y1, y2, y3;
#pragma unroll
        for (int i = 0; i < 4; ++i) { y0[i] = v[i] * rstd * w0[i] + b0[i]; y1[i] = v[4 + i] * rstd * w1[i] + b1[i]; y2[i] = v[8 + i] * rstd * w2[i] + b2[i]; y3[i] = v[12 + i] * rstd * w3[i] + b3[i]; }
        u32x4 o0, o1; o0.x = pk2(y0[0], y0[1]); o0.y = pk2(y0[2], y0[3]); o0.z = pk2(y1[0], y1[1]); o0.w = pk2(y1[2], y1[3]);
        o1.x = pk2(y2[0], y2[1]); o1.y = pk2(y2[2], y2[3]); o1.z = pk2(y3[0], y3[1]); o1.w = pk2(y3[2], y3[3]);
        p[0] = o0; p[64] = o1;
        if (xb8) { u32x2* q8 = (u32x2*)(xb8 + (size_t)row * DM) + F.lane; u32x2 a8, b8; a8.x = pk4f8(y0[0], y0[1], y0[2], y0[3]); a8.y = pk4f8(y1[0], y1[1], y1[2], y1[3]); b8.x = pk4f8(y2[0], y2[1], y2[2], y2[3]); b8.y = pk4f8(y3[0], y3[1], y3[2], y3[3]); q8[0] = a8; q8[64] = b8; }
        if (outf) { f32x4* op = (f32x4*)(outf + (size_t)row * DM); op[2 * F.lane] = y0; op[2 * F.lane + 1] = y1; op[128 + 2 * F.lane] = y2; op[128 + 2 * F.lane + 1] = y3; }
    }
}

__device__ __forceinline__ float gelu_tanh_(float y) { const float t = 1.5957691216057308f * (y + 0.044715f * y * y * y); return y * __builtin_amdgcn_rcpf(1.0f + __builtin_amdgcn_exp2f(-LOG2E * t)); }
__device__ __forceinline__ void ffn_act_phase(Frame& F, const float* cw, const float* cb) {
    const bf16* GE = (const bf16*)(F.ws + WS_GE); const bf16* G0 = (const bf16*)(F.ws + WS_G0); const bf16* U0 = (const bf16*)(F.ws + WS_U0); unsigned char* ACT8 = F.ws + WS_ACT8;
    for (int idx = F.wg * 512 + F.tid; idx < 512 * 2 * 352; idx += F.G * 512) {
        const int v = idx % 352, t = idx / 352, r = t & 1, rb = t >> 1; const int gc = 8 * v;
        const size_t eb = (size_t)rb * 2 * DFF + gc, ebp = (size_t)(rb - 1) * 2 * DFF + gc; const bool first = (rb & 127) == 0;
        const u32x4 z4 = (u32x4){0u, 0u, 0u, 0u};
        float gA[8], gB[8], gC[8], uu[8];
        if (r == 0) { up8(first ? z4 : *(const u32x4*)(GE + ebp), gA); up8(first ? z4 : *(const u32x4*)(GE + ebp + DFF), gB); up8(*(const u32x4*)(G0 + eb), gC); }
        else { up8(first ? z4 : *(const u32x4*)(GE + ebp + DFF), gA); up8(*(const u32x4*)(G0 + eb), gB); up8(*(const u32x4*)(G0 + eb + DFF), gC); }
        up8(*(const u32x4*)(U0 + eb + (size_t)r * DFF), uu);
        float o[8];
#pragma unroll
        for (int i = 0; i < 8; ++i) { const float y = cb[gc + i] + cw[gc + i] * gA[i] + cw[DFF + gc + i] * gB[i] + cw[2 * DFF + gc + i] * gC[i]; o[i] = gelu_tanh_(y) * uu[i]; }
        u32x2 w8; w8.x = pk4f8(o[0], o[1], o[2], o[3]); w8.y = pk4f8(o[4], o[5], o[6], o[7]);
        *(u32x2*)(ACT8 + (size_t)(rb * 64 + r) * DFF + gc) = w8;
    }
}

namespace mx {
__device__ __forceinline__ f32x16 mfma32(bf16x8 a, bf16x8 b, f32x16 c) { return __builtin_amdgcn_mfma_f32_32x32x16_bf16(a, b, c, 0, 0, 0); }
__device__ __forceinline__ f32x16 splat16(float v) { f32x16 r;
#pragma unroll
    for (int i = 0; i < 16; ++i) r[i] = v;
    return r; }
__device__ __forceinline__ int crow_c(int e) { return (e & 3) + 8 * (e >> 2); }
typedef short v4i16_t __attribute__((ext_vector_type(4)));
__device__ __forceinline__ s16x4 vtr(const LAS unsigned char* p) { return __builtin_bit_cast(s16x4, __builtin_amdgcn_ds_read_tr16_b64_v4i16((LAS v4i16_t*)p)); }
__device__ __forceinline__ bf16x8 pack8(float a0, float a1, float a2, float a3, float a4, float a5, float a6, float a7) {
    u32x4 w; w.x = pk2(a0, a1); w.y = pk2(a2, a3); w.z = pk2(a4, a5); w.w = pk2(a6, a7); return __builtin_bit_cast(bf16x8, w); }

__device__ __forceinline__ float log2gam(int h) { return __builtin_log2f(1.0f - __builtin_exp2f(-5.0f - (float)h)); }
__device__ __forceinline__ void prepkv_unit(Frame& F, int blk, const float* wa2, const float* bap, unsigned* kmaxl) {
    bf16* Z = (bf16*)(F.ws + WS_Z);
    const size_t r0 = (size_t)blk * 256; const int b = blk >> 5, cb = blk & 31;
    const int tid = F.tid;
    {   const int ch = tid >> 7, col = tid & 127;
        const float ba = bap[col];
        float wa[16];
#pragma unroll
        for (int r = 0; r < 16; ++r) wa[r] = wa2[r * 128 + col];
        float cum = 0.f;
        for (int t0 = 0; t0 < 64; t0 += 8) { u32x4 A[8], B[8];
#pragma unroll
            for (int tt = 0; tt < 8; ++tt) { const bf16* zr = Z + (r0 + ch * 64 + t0 + tt) * ZW; A[tt] = *(const u32x4*)(zr + ZC_DA); B[tt] = *(const u32x4*)(zr + ZC_DA + 8); }
#pragma unroll
            for (int tt = 0; tt < 8; ++tt) { float da[8], db[8]; up8(A[tt], da); up8(B[tt], db); float x = ba;
#pragma unroll
                for (int r = 0; r < 8; ++r) x += da[r] * wa[r];
#pragma unroll
                for (int r = 0; r < 8; ++r) x += db[r] * wa[8 + r];
                cum += (fminf(x, 0.f) - __logf(1.0f + __expf(-fabsf(x)))) * 0.0625f; } }
        const float bl = cum; cum = 0.f;
        for (int t0 = 0; t0 < 64; t0 += 8) { u32x4 A[8], B[8]; bf16 qv[8], kv[8];
#pragma unroll
            for (int tt = 0; tt < 8; ++tt) { const bf16* zr = Z + (r0 + ch * 64 + t0 + tt) * ZW; A[tt] = *(const u32x4*)(zr + ZC_DA); B[tt] = *(const u32x4*)(zr + ZC_DA + 8); qv[tt] = zr[ZC_DQ + col]; kv[tt] = zr[ZC_DK + col]; }
#pragma unroll
            for (int tt = 0; tt < 8; ++tt) { bf16* zr = Z + (r0 + ch * 64 + t0 + tt) * ZW; float da[8], db[8]; up8(A[tt], da); up8(B[tt], db); float x = ba;
#pragma unroll
                for (int r = 0; r < 8; ++r) x += da[r] * wa[r];
#pragma unroll
                for (int r = 0; r < 8; ++r) x += db[r] * wa[8 + r];
                cum += (fminf(x, 0.f) - __logf(1.0f + __expf(-fabsf(x)))) * 0.0625f;
                zr[ZC_DQ + col] = (bf16)f2bf(bf1(qv[tt]) * __expf(cum - bl)); zr[ZC_DK + col] = (bf16)f2bf(bf1(kv[tt]) * __expf(bl - cum)); } }
        ((float*)(F.ws + WS_DE))[((size_t)b * 128 + cb * 4 + ch) * 128 + col] = __expf(bl);
    }
    for (int itn = 0; itn < 6; ++itn) { const int task = tid + 512 * itn, sl = task >> 8, row = task & 255;
        const bf16* kp = Z + (r0 + row) * ZW + (sl < 8 ? ZC_AK + (sl >> 1) * 64 + (sl & 1) * 32 : ZC_BK + (sl - 8) * 64); float ss = 0.f;
        const int nch = sl < 8 ? 4 : 8;
        for (int c = 0; c < nch; ++c) { float v[8]; up8(*(const u32x4*)(kp + 8 * c), v);
#pragma unroll
            for (int i = 0; i < 8; ++i) ss += v[i] * v[i]; }
#pragma unroll
        for (int o = 1; o < 64; o <<= 1) ss = fmaxf(ss, shx(ss, F.lane, o));
        if (F.lane == 0) __hip_atomic_fetch_max(kmaxl + b * 16 + sl, __float_as_uint(sqrtf(ss)), __ATOMIC_RELAXED, __HIP_MEMORY_SCOPE_AGENT); }
    for (int i0 = 0; i0 < 32; i0 += 4) { u32x4 vv[4];
#pragma unroll
        for (int k = 0; k < 4; ++k) { const int idx = tid + 512 * (i0 + k); const int row = idx >> 6, chunk = idx & 63, isk = chunk >> 5, c8 = (chunk & 31) * 8;
            vv[k] = *(const u32x4*)(Z + (r0 + row) * ZW + (isk ? ZC_CK : ZC_CQ) + c8); }
#pragma unroll
        for (int k = 0; k < 4; ++k) { const int idx = tid + 512 * (i0 + k); const int row = idx >> 6, chunk = idx & 63, isk = chunk >> 5, c8 = (chunk & 31) * 8, h = c8 >> 6;
            const float e = (float)(255 - row) * log2gam(h); const float f = __builtin_amdgcn_exp2f(isk ? e : -e); float v[8]; up8(vv[k], v);
            u32x4 w; w.x = pk2(v[0] * f, v[1] * f); w.y = pk2(v[2] * f, v[3] * f); w.z = pk2(v[4] * f, v[5] * f); w.w = pk2(v[6] * f, v[7] * f);
            *(u32x4*)(Z + (r0 + row) * ZW + (isk ? ZC_CK : ZC_CQ) + c8) = w; } }
    __threadfence_block(); __syncthreads();
    LAS unsigned char* Kl = F.lds; LAS unsigned char* Vl = F.lds + 36864;
    for (int h = 0; h < 4; ++h) {
        for (int idx = tid; idx < 256 * 8; idx += 512) { const int row = idx >> 3, c = idx & 7;
            *(LAS u32x4*)(Kl + row * 144 + c * 16) = *(const u32x4*)(Z + (r0 + row) * ZW + ZC_CK + h * 64 + c * 8);
            *(LAS u32x4*)(Vl + row * 144 + c * 16) = *(const u32x4*)(Z + (r0 + row) * ZW + ZC_CV + h * 64 + c * 8); }
        __syncthreads();
        {   const int d = tid >> 3, dk8 = (tid & 7) * 8; float acc[8];
#pragma unroll
            for (int i = 0; i < 8; ++i) acc[i] = 0.f;
            for (int j = 0; j < 256; ++j) { const float vv = bf1(*(const LAS bf16*)(Vl + j * 144 + d * 2)); float kk[8]; up8(*(const LAS u32x4*)(Kl + j * 144 + dk8 * 2), kk);
#pragma unroll
                for (int i = 0; i < 8; ++i) acc[i] += vv * kk[i]; }
            float* o = (float*)(F.ws + WS_KVC) + ((size_t)((b * 4 + h) * 32 + cb) * 4096 + d * 64 + dk8);
            *(f32x4*)o = (f32x4){acc[0], acc[1], acc[2], acc[3]}; *(f32x4*)(o + 4) = (f32x4){acc[4], acc[5], acc[6], acc[7]}; }
        __syncthreads();
        for (int idx = tid; idx < 256 * 8; idx += 512) { const int row = idx >> 3, c = idx & 7;
            if (c < 4) *(LAS u32x4*)(Kl + row * 144 + c * 16) = *(const u32x4*)(Z + (r0 + row) * ZW + ZC_DK + h * 32 + c * 8);
            *(LAS u32x4*)(Vl + row * 144 + c * 16) = *(const u32x4*)(Z + (r0 + row) * ZW + ZC_DV + h * 64 + c * 8); }
        __syncthreads();
        {   const int ch = tid >> 7, d = (tid >> 1) & 63, dk16 = (tid & 1) * 16; float acc[16];
#pragma unroll
            for (int i = 0; i < 16; ++i) acc[i] = 0.f;
            for (int j = 0; j < 64; ++j) { const int row = ch * 64 + j; const float vv = bf1(*(const LAS bf16*)(Vl + row * 144 + d * 2)); float k0[8], k1[8];
                up8(*(const LAS u32x4*)(Kl + row * 144 + dk16 * 2), k0); up8(*(const LAS u32x4*)(Kl + row * 144 + dk16 * 2 + 16), k1);
#pragma unroll
                for (int i = 0; i < 8; ++i) { acc[i] += vv * k0[i]; acc[8 + i] += vv * k1[i]; } }
            float* o = (float*)(F.ws + WS_KVD) + ((size_t)((b * 4 + h) * 128 + cb * 4 + ch) * 2048 + d * 32 + dk16);
#pragma unroll
            for (int i = 0; i < 4; ++i) *(f32x4*)(o + 4 * i) = (f32x4){acc[4 * i], acc[4 * i + 1], acc[4 * i + 2], acc[4 * i + 3]}; }
        __syncthreads();
    }
}

__device__ __forceinline__ void scan_phase(Frame& F) {
    const int gt = F.wg * 512 + F.tid, NT = F.G * 512;
    for (int e0 = gt; e0 < 16 * 4096 + 16 * 2048; e0 += NT) {
        if (e0 < 16 * 4096) { const int e = e0;
            const int bh = e >> 12, idx = e & 4095, h = bh & 3; const float g256 = __builtin_amdgcn_exp2f(256.0f * log2gam(h));
            float* p = (float*)(F.ws + WS_KVC) + (size_t)bh * 32 * 4096 + idx; float S = 0.f; float kv[32];
#pragma unroll
            for (int c = 0; c < 32; ++c) kv[c] = p[(size_t)c * 4096];
#pragma unroll
            for (int c = 0; c < 32; ++c) { const float Sp = g256 * S; p[(size_t)c * 4096] = Sp; S = Sp + kv[c]; }
        } else { const int e = e0 - 16 * 4096;
            const int bh = e >> 11, idx = e & 2047, b = bh >> 2, h = bh & 3, dk = idx & 31;
            float* p = (float*)(F.ws + WS_KVD) + (size_t)bh * 128 * 2048 + idx; const float* de = (const float*)(F.ws + WS_DE) + (size_t)b * 128 * 128 + h * 32 + dk; float S = 0.f;
            for (int c0 = 0; c0 < 128; c0 += 16) { float kv[16], dd[16];
#pragma unroll
                for (int c = 0; c < 16; ++c) { kv[c] = p[(size_t)(c0 + c) * 2048]; dd[c] = de[(c0 + c) * 128]; }
#pragma unroll
                for (int c = 0; c < 16; ++c) { const float Sp = dd[c] * S; p[(size_t)(c0 + c) * 2048] = Sp; S = Sp + kv[c]; } }
        }
    }
}

constexpr int HPITCH = 1026, CAP = 256;
struct QState { unsigned mode, thr_lo, thr_hi, thr_idx, krem, lcount, pad0, pad1; };
__device__ __forceinline__ unsigned okey_of(float s) { const unsigned u = __float_as_uint(s); return u ^ ((unsigned)((int)u >> 31) | 0x80000000u); }
__device__ __forceinline__ void b1_load(const bf16* Zb, int t, int r, int hh, bf16x8& k0, bf16x8& k1) {
    const bf16* kr = Zb + (size_t)(32 * t + r) * ZW + ZC_IK + 8 * hh; k0 = *(const bf16x8*)kr; k1 = *(const bf16x8*)(kr + 16); }
__device__ __forceinline__ void b1_scores(const bf16x8 k0, const bf16x8 k1, const bf16x8 (&iqf)[4][2], const float (&w)[4], float (&sc)[16]) {
#pragma unroll
    for (int e = 0; e < 16; ++e) sc[e] = 0.f;
#pragma unroll
    for (int ih = 0; ih < 4; ++ih) { f32x16 lg = mfma32(k0, iqf[ih][0], splat16(0.f)); lg = mfma32(k1, iqf[ih][1], lg);
#pragma unroll
        for (int e = 0; e < 16; ++e) sc[e] = fmaf(w[ih], fmaxf(lg[e], 0.f), sc[e]); }
}
__device__ __forceinline__ void b1_setbit(unsigned* MWq, unsigned j) {
    const unsigned wi = j & 31u, hh = (wi >> 2) & 1u, e = (wi & 3u) + 4u * (wi >> 3), kh = (j >> 5) & 1u;
    __hip_atomic_fetch_or(MWq + (size_t)(j >> 6) * 64 + 32u * hh, 1u << (e + 16u * kh), __ATOMIC_RELAXED, __HIP_MEMORY_SCOPE_AGENT);
}
__device__ __forceinline__ void b1_unit(Frame& F, int b, int g) {
    const int tid = F.tid, lane = F.lane, r = lane & 31, hh = lane >> 5, wid = F.wave;
    const bf16* Zb = (const bf16*)(F.ws + WS_Z) + (size_t)b * SEQ * ZW;
    LAS unsigned* hist = (LAS unsigned*)F.lds;
    LAS QState* qst = (LAS QState*)(F.lds + QST_OFF);
    const int qpos = 32 * g + r;
    unsigned* MWb = (unsigned*)(F.ws + WS_MASK) + ((size_t)(b * 256 + g) * 128) * 64;
    bf16x8 iqf[4][2]; float w[4];
    {   const bf16* qr = Zb + (size_t)qpos * ZW;
#pragma unroll
        for (int ih = 0; ih < 4; ++ih) { iqf[ih][0] = *(const bf16x8*)(qr + ZC_IQ + ih * 32 + 8 * hh); iqf[ih][1] = *(const bf16x8*)(qr + ZC_IQ + ih * 32 + 16 + 8 * hh); w[ih] = bf1(qr[ZC_IW + ih]); } }
    if (g >= 8) {
        for (int i = tid; i < 32 * HPITCH; i += 512) hist[i] = 0u;
        __syncthreads();
        {   bf16x8 n0 = iqf[0][0], n1 = iqf[0][0]; int t = wid; if (t <= g) b1_load(Zb, t, r, hh, n0, n1);
            for (; t <= g; t += 8) { const bf16x8 k0 = n0, k1 = n1; if (t + 8 <= g) b1_load(Zb, t + 8, r, hh, n0, n1);
                float sc[16]; b1_scores(k0, k1, iqf, w, sc);
#pragma unroll
                for (int e = 0; e < 16; ++e) { const int j = 32 * t + crow_c(e) + 4 * hh; if (j <= qpos) { const unsigned bin = okey_of(sc[e]) >> 21;
                    __hip_atomic_fetch_add(hist + r * HPITCH + (bin >> 1), 1u << ((bin & 1) * 16), __ATOMIC_RELAXED, __HIP_MEMORY_SCOPE_WORKGROUP); } } } }
        __syncthreads();
        for (int qq = 0; qq < 4; ++qq) { const int q = 4 * wid + qq; const LAS unsigned* hq = hist + q * HPITCH;
            const int wbase = 1008 - 16 * lane; unsigned s = 0;
#pragma unroll
            for (int k = 0; k < 16; ++k) { const unsigned x = hq[wbase + k]; s += (x & 0xffffu) + (x >> 16); }
            unsigned P = s;
#pragma unroll
            for (int o = 1; o < 64; o <<= 1) { const unsigned t = shup(P, lane, o); if (lane >= o) P += t; }
            const unsigned long long bal = __ballot(P >= 256u);
            const int Lsel = bal ? __builtin_ctzll(bal) : 63;
            if (lane == Lsel) { unsigned cum = P - s; unsigned b1 = 0, cin = 0, cab = 0;
                for (int k = 0; k < 32; ++k) { const int bin = 2047 - 32 * lane - k; const unsigned x = hq[bin >> 1]; const unsigned c = (bin & 1) ? (x >> 16) : (x & 0xffffu);
                    if (cum + c >= 256u) { b1 = (unsigned)bin; cin = c; cab = cum; break; } cum += c; }
                qst[q].thr_lo = b1 << 21; qst[q].thr_hi = (b1 << 21) | 0x1fffffu; qst[q].thr_idx = 0xffffu; qst[q].krem = 256u - cab; qst[q].lcount = 0u; qst[q].pad0 = cin; qst[q].pad1 = 0u;
                qst[q].mode = (b1 == 1024u || cin > (unsigned)CAP) ? 2u : 1u; }
        }
        __syncthreads();
        for (int i = tid; i < 32 * 256; i += 512) ((LAS unsigned*)(F.lds + 65536))[i] = 0u;
        __syncthreads();
    }
    {   unsigned mode = 0u, tlo = 1u, thi = 0u;
        const bool allsel = (g < 8);
        if (!allsel) { mode = qst[r].mode; tlo = qst[r].thr_lo; thi = qst[r].thr_hi; }
        const int nk = g >> 1;
        bf16x8 n0 = iqf[0][0], n1 = iqf[0][0], n2 = iqf[0][0], n3 = iqf[0][0]; int kt = wid;
        if (kt <= nk) { b1_load(Zb, 2 * kt, r, hh, n0, n1); if (2 * kt + 1 <= g) b1_load(Zb, 2 * kt + 1, r, hh, n2, n3); }
        for (; kt <= nk; kt += 8) {
            const bf16x8 k0 = n0, k1 = n1, k2 = n2, k3 = n3;
            if (kt + 8 <= nk) { b1_load(Zb, 2 * kt + 16, r, hh, n0, n1); if (2 * kt + 17 <= g) b1_load(Zb, 2 * kt + 17, r, hh, n2, n3); }
            unsigned word = 0u;
#pragma unroll
            for (int kh = 0; kh < 2; ++kh) { const int t = 2 * kt + kh; if (t <= g) { float sc[16]; b1_scores(kh ? k2 : k0, kh ? k3 : k1, iqf, w, sc);
#pragma unroll
                for (int e = 0; e < 16; ++e) { const int j = 32 * t + crow_c(e) + 4 * hh; const unsigned ok = okey_of(sc[e]); const bool valid = (j <= qpos);
                    const bool sel = valid && (allsel || ok > thi); word |= (sel ? 1u : 0u) << (e + 16 * kh);
                    if (!allsel && valid && ok >= tlo && ok <= thi) {
                        if (mode == 1u) { const unsigned pos = __hip_atomic_fetch_add(&qst[r].lcount, 1u, __ATOMIC_RELAXED, __HIP_MEMORY_SCOPE_WORKGROUP);
                            if (pos < (unsigned)CAP) { LAS unsigned* le = (LAS unsigned*)(F.lds + ((size_t)r * CAP + pos) * 8); le[0] = ok; le[1] = (unsigned)j; } }
                        else __hip_atomic_fetch_or((LAS unsigned*)(F.lds + 65536 + r * 1024) + (j >> 5), 1u << (j & 31), __ATOMIC_RELAXED, __HIP_MEMORY_SCOPE_WORKGROUP); } } } }
            MWb[(size_t)kt * 64 + lane] = word; }
    }
    __syncthreads();
    if (g >= 8) {
        for (int qq = 0; qq < 4; ++qq) { const int q = 4 * wid + qq; const unsigned mode = qst[q].mode, krem = qst[q].krem; unsigned* MWq = MWb + q;
            if (mode == 1u) {
                unsigned L = qst[q].lcount; if (L > (unsigned)CAP) L = CAP; const LAS unsigned* lb = (const LAS unsigned*)(F.lds + (size_t)q * CAP * 8);
                unsigned long long comp[4]; bool has[4]; unsigned jj[4];
#pragma unroll
                for (int k = 0; k < 4; ++k) { const unsigned c = lane + 64 * k; has[k] = c < L; const unsigned ok = has[k] ? lb[2 * c] : 0u; jj[k] = has[k] ? lb[2 * c + 1] : 0u;
                    comp[k] = ((unsigned long long)(ok & 0x1fffffu) << 13) | (unsigned long long)(8191u - jj[k]); }
                unsigned long long prefix = 0ull; unsigned need = krem;
                for (int bit = 33; bit >= 0; --bit) { const unsigned long long want = (prefix >> bit) | 1ull; unsigned cnt = 0;
#pragma unroll
                    for (int k = 0; k < 4; ++k) cnt += (unsigned)__builtin_popcountll(__ballot(has[k] && ((comp[k] >> bit) == want)));
                    if (cnt >= need) prefix |= (1ull << bit); else need -= cnt; }
#pragma unroll
                for (int k = 0; k < 4; ++k) if (has[k] && comp[k] >= prefix) b1_setbit(MWq, jj[k]); }
            else { const LAS unsigned* bm = (const LAS unsigned*)(F.lds + 65536 + q * 1024); unsigned x[4]; unsigned s = 0;
#pragma unroll
                for (int k = 0; k < 4; ++k) { x[k] = bm[4 * lane + k]; s += __builtin_popcount(x[k]); }
                unsigned P = s;
#pragma unroll
                for (int o = 1; o < 64; o <<= 1) { const unsigned t = shup(P, lane, o); if (lane >= o) P += t; }
                unsigned before = P - s;
#pragma unroll
                for (int k = 0; k < 4; ++k) { unsigned y = x[k]; while (y != 0u && before < krem) { const unsigned bit = (unsigned)__builtin_ctz(y); y &= y - 1u; b1_setbit(MWq, 32u * (4 * lane + k) + bit); ++before; } before += __builtin_popcount(y); } }
        }
        __syncthreads();
    }
}

struct EngP { const bf16* Z; bf16* Y; const unsigned* MASK; const float* ST; const float* nw; float lam, lam_init; const unsigned* kmax; };
__device__ __forceinline__ int wq_next(Frame& F, unsigned* head) {
    LAS int* slot = (LAS int*)(F.lds + 55312);
    if (F.tid == 0) *slot = (int)__hip_atomic_fetch_add(head, 1u, __ATOMIC_RELAXED, __HIP_MEMORY_SCOPE_AGENT);
    __syncthreads(); const int u = *slot; __syncthreads();
    asm volatile("" : "+v"(F.tid), "+v"(F.lane));
    return u;
}
template <int MODE>
__device__ __forceinline__ void eng_unit(Frame& F, const EngP& P, int b, int h, int qb) {
    constexpr bool SOFT = MODE <= 1;
    constexpr int NMAP = MODE == 0 ? 2 : 1;
    constexpr int NS = (MODE == 0 || MODE == 3) ? 2 : 4;
    constexpr int KCH = MODE == 3 ? 4 : 8;
    constexpr int QC = MODE == 0 ? ZC_AQ : MODE == 1 ? ZC_BQ : MODE == 2 ? ZC_CQ : ZC_DQ;
    constexpr int KC = MODE == 0 ? ZC_AK : MODE == 1 ? ZC_BK : MODE == 2 ? ZC_CK : ZC_DK;
    constexpr int VC = MODE == 0 ? ZC_AV : MODE == 1 ? ZC_BV : MODE == 2 ? ZC_CV : ZC_DV;
    constexpr int HW = MODE == 3 ? 32 : 64;
    const int tid = F.tid, lane = F.lane, r = lane & 31, hh = lane >> 5, w = F.wave;
    const size_t rowbase = (size_t)b * SEQ;
    const int qw0 = qb * 256 + 32 * w;
    const float NEG = -__builtin_inff();
    const int hidx = MODE <= 1 ? (MODE == 0 ? 2 * h + 1 : 2 * h + 2) : 0;
    const float slope2 = SOFT ? __builtin_amdgcn_exp2f(-(float)hidx) * LOG2E : 0.f;
    bf16x8 qf[NMAP][NS];
    {   const bf16* qrow = P.Z + (rowbase + qw0 + r) * ZW + QC + h * HW;
#pragma unroll
        for (int m = 0; m < NMAP; ++m)
#pragma unroll
            for (int s = 0; s < NS; ++s) qf[m][s] = *(const bf16x8*)(qrow + m * 32 + 16 * s + 8 * hh); }
    f32x16 cinit;
#pragma unroll
    for (int e = 0; e < 16; ++e) cinit[e] = SOFT ? slope2 * (float)(crow_c(e) + 4 * hh) : 0.f;
    float m_run[NMAP], l_run[NMAP]; f32x16 O[NMAP][2];
#pragma unroll
    for (int m = 0; m < NMAP; ++m) { m_run[m] = NEG; l_run[m] = 0.f; O[m][0] = splat16(0.f); O[m][1] = splat16(0.f); }
    if (!SOFT) {
        const int sidx = MODE == 2 ? ((b * 4 + h) * 32 + qb) : ((b * 4 + h) * 128 + 4 * qb + (w >> 1));
        const float* sp = P.ST + (size_t)sidx * (64 * HW);
#pragma unroll
        for (int db = 0; db < 2; ++db)
#pragma unroll
            for (int s = 0; s < NS; ++s) { const float* a = sp + (size_t)(32 * db + r) * HW + 16 * s + 8 * hh; const f32x4 a0 = *(const f32x4*)a, a1 = *(const f32x4*)(a + 4);
                O[0][db] = mfma32(pack8(a0[0], a0[1], a0[2], a0[3], a1[0], a1[1], a1[2], a1[3]), qf[0][s], O[0][db]); }
    }
    const int kt_lo = SOFT ? 0 : 4 * qb, kt_hi = 4 * qb + 3;
    const int srow = tid >> 3, sch = tid & 7;
    float qk[NMAP];
    if (SOFT) {
#pragma unroll
        for (int m = 0; m < NMAP; ++m) { float ss = 0.f;
#pragma unroll
            for (int s = 0; s < NS; ++s) { const u32x4 qq = __builtin_bit_cast(u32x4, qf[m][s]); float v[8]; up8(qq, v);
#pragma unroll
                for (int i = 0; i < 8; ++i) ss += v[i] * v[i]; }
            ss += shx(ss, lane, 32);
            qk[m] = 1.02f * sqrtf(ss) * __uint_as_float(P.kmax[b * 16 + (MODE == 0 ? (h * 2 + m) : (8 + h))]) + 0.01f; }
    }
    LAS unsigned* wflag = (LAS unsigned*)(F.lds + 55296);
    if (SOFT && tid < 3) wflag[tid] = 0u;
    const int kt_first = SOFT ? kt_hi : kt_lo;
    const int nit = kt_hi - kt_lo + 1;
    u32x4 kreg = (u32x4){0u, 0u, 0u, 0u}, vreg;
    {   const bf16* zr = P.Z + (rowbase + 64 * kt_first + srow) * ZW;
        if (sch < KCH) kreg = *(const u32x4*)(zr + KC + h * HW + sch * 8);
        vreg = *(const u32x4*)(zr + VC + h * 64 + sch * 8);
        if (sch < KCH) *(LAS u32x4*)(F.lds + srow * 144 + sch * 16) = kreg;
        *(LAS u32x4*)(F.lds + 9216 + srow * 144 + sch * 16) = vreg;
        if (nit > 1) { const bf16* z1 = P.Z + (rowbase + 64 * (SOFT ? kt_first - 1 : kt_first + 1) + srow) * ZW;
            if (sch < KCH) kreg = *(const u32x4*)(z1 + KC + h * HW + sch * 8);
            vreg = *(const u32x4*)(z1 + VC + h * 64 + sch * 8); } }
    __syncthreads();
    bool wave_done = false;
    const unsigned* mwp = (MODE == 1) ? P.MASK + ((size_t)(b * 256 + qb * 8 + w) * 128) * 64 + lane : nullptr;
    unsigned mwn = 0xffffffffu; if (MODE == 1) mwn = mwp[(size_t)kt_first * 64];
    int sl_cur = 0, sl_nxt = 18432;
    for (int it = 0; it < nit; ++it) {
        const int kt = SOFT ? kt_hi - it : kt_lo + it, ktn = SOFT ? kt - 1 : kt + 1;
        const bool more = it + 1 < nit;
        const unsigned mw = mwn;
        if (more) { if (sch < KCH) *(LAS u32x4*)(F.lds + sl_nxt + srow * 144 + sch * 16) = kreg;
            *(LAS u32x4*)(F.lds + sl_nxt + 9216 + srow * 144 + sch * 16) = vreg;
            if (MODE == 1) mwn = mwp[(size_t)ktn * 64]; }
        if (it + 2 < nit) { const bf16* zr = P.Z + (rowbase + 64 * (SOFT ? kt - 2 : kt + 2) + srow) * ZW;
            if (sch < KCH) kreg = *(const u32x4*)(zr + KC + h * HW + sch * 8);
            vreg = *(const u32x4*)(zr + VC + h * 64 + sch * 8); }
        const int j0 = 64 * kt;
        const bool act = ((MODE == 3) ? (kt == 4 * qb + (w >> 1)) : (j0 <= qw0 + 31)) && !wave_done;
        if (act) {
            const LAS unsigned char* Kb = F.lds + sl_cur; const LAS unsigned char* Vb = F.lds + sl_cur + 9216;
            const bool hact1 = (j0 + 32 <= qw0 + 31);
#pragma unroll
            for (int m = 0; m < NMAP; ++m) {
                f32x16 st[2];
#pragma unroll
                for (int kh = 0; kh < 2; ++kh) {
                    if (kh == 0 || hact1) {
                        f32x16 a = cinit;
#pragma unroll
                        for (int s = 0; s < NS; ++s) { const bf16x8 kf = *(const LAS bf16x8*)(Kb + (32 * kh + r) * 144 + (m * 32 + 16 * s + 8 * hh) * 2); a = mfma32(kf, qf[m][s], a); }
                        if (j0 + 32 * kh + 31 > qw0) { const int lim = qw0 + r - j0 - 32 * kh - 4 * hh; asm volatile("; causal-mask block (kept a real branch: as selects it ran on every interior tile too)" ::: "memory");
#pragma unroll
                            for (int e = 0; e < 16; ++e) if (crow_c(e) > lim) a[e] = SOFT ? NEG : 0.f; }
                        if (MODE == 1) {
#pragma unroll
                            for (int e = 0; e < 16; ++e) if (!((mw >> (e + 16 * kh)) & 1u)) a[e] = NEG; }
                        st[kh] = a;
                    } else st[kh] = splat16(SOFT ? NEG : 0.f);
                }
                if (SOFT) {
                    const float off0 = slope2 * (float)(j0 - qw0 - r), off1 = off0 + 32.f * slope2;
                    float mx0 = st[0][0], mx1 = st[1][0];
#pragma unroll
                    for (int e = 1; e < 16; ++e) { mx0 = fmaxf(mx0, st[0][e]); mx1 = fmaxf(mx1, st[1][e]); }
                    float mx = fmaxf(mx0 + off0, mx1 + off1); mx = fmaxf(mx, shx(mx, lane, 32));
                    const float mn = fmaxf(m_run[m], mx); const float msafe = (mn == NEG) ? 0.f : mn;
                    const float alpha = __builtin_amdgcn_exp2f(m_run[m] - msafe); m_run[m] = mn;
                    const float d0 = off0 - msafe, d1 = off1 - msafe; float rs = 0.f;
#pragma unroll
                    for (int e = 0; e < 16; ++e) { const float p0 = __builtin_amdgcn_exp2f(st[0][e] + d0), p1 = __builtin_amdgcn_exp2f(st[1][e] + d1); st[0][e] = p0; st[1][e] = p1; rs += p0 + p1; }
                    rs += shx(rs, lane, 32); l_run[m] = l_run[m] * alpha + rs;
#pragma unroll
                    for (int e = 0; e < 16; ++e) { O[m][0][e] *= alpha; O[m][1][e] *= alpha; }
                }
#pragma unroll
                for (int kh = 0; kh < 2; ++kh) {
                    if (kh == 0 || hact1) {
#pragma unroll
                        for (int s = 0; s < 2; ++s) {
                            const bf16x8 pf = pack8(st[kh][8 * s], st[kh][8 * s + 1], st[kh][8 * s + 2], st[kh][8 * s + 3], st[kh][8 * s + 4], st[kh][8 * s + 5], st[kh][8 * s + 6], st[kh][8 * s + 7]);
#pragma unroll
                            for (int db = 0; db < 2; ++db) {
                                const LAS unsigned char* vp = Vb + (32 * kh + 16 * s + 4 * hh + ((lane & 15) >> 2)) * 144 + (32 * db + 16 * ((lane >> 4) & 1) + 4 * (lane & 3)) * 2;
                                const s16x4 lo = vtr(vp), hi = vtr(vp + 8 * 144);
                                const bf16x8 vf = (bf16x8){lo[0], lo[1], lo[2], lo[3], hi[0], hi[1], hi[2], hi[3]};
                                O[m][db] = mfma32(vf, pf, O[m][db]); } } } }
            }
            if (SOFT) {
                const float dist = slope2 * (float)(qw0 + r - (j0 - 1)); bool fin = true;
#pragma unroll
                for (int m = 0; m < NMAP; ++m) fin = fin && (qk[m] - dist - m_run[m] < -32.f);
                wave_done = (__ballot(fin) == ~0ull);
            }
        }
        if (SOFT && !wave_done && lane == 0) wflag[it % 3] = 1u;
        sl_cur = sl_nxt; sl_nxt = (sl_nxt == 36864) ? 0 : sl_nxt + 18432;
        __syncthreads();
        if (SOFT) { const unsigned any = wflag[it % 3]; if (tid == 0) wflag[(it + 2) % 3] = 0u; if (any == 0u) break; }
    }
    const size_t orow = rowbase + qw0 + r;
    const int ycol = MODE * 256 + h * 64;
    f32x16 o[2];
    if (MODE == 0) { const float i0 = 1.f / l_run[0], i1 = P.lam / l_run[NMAP - 1];
#pragma unroll
        for (int db = 0; db < 2; ++db)
#pragma unroll
            for (int e = 0; e < 16; ++e) o[db][e] = O[0][db][e] * i0 - O[NMAP - 1][db][e] * i1; }
    else if (MODE == 1) { const float i0 = 1.f / l_run[0];
#pragma unroll
        for (int db = 0; db < 2; ++db)
#pragma unroll
            for (int e = 0; e < 16; ++e) o[db][e] = O[0][db][e] * i0; }
    else { o[0] = O[0][0]; o[1] = O[0][1]; }
    float mu = 0.f;
    if (MODE == 2) { float s = 0.f;
#pragma unroll
        for (int db = 0; db < 2; ++db)
#pragma unroll
            for (int e = 0; e < 16; ++e) s += o[db][e];
        s += shx(s, lane, 32); mu = s * (1.f / 64.f); }
    float ss = 0.f;
    if (MODE != 1) {
#pragma unroll
        for (int db = 0; db < 2; ++db)
#pragma unroll
            for (int e = 0; e < 16; ++e) { const float d = o[db][e] - mu; ss += d * d; }
        ss += shx(ss, lane, 32); }
    float rn = 1.f;
    if (MODE != 1) rn = 1.f / sqrtf(ss * (1.f / 64.f) + LN_EPS);
    if (MODE == 0) rn *= (1.f - P.lam_init);
#pragma unroll
    for (int db = 0; db < 2; ++db)
#pragma unroll
        for (int g4 = 0; g4 < 4; ++g4) { const int d0 = 32 * db + 8 * g4 + 4 * hh; float v[4];
#pragma unroll
            for (int i = 0; i < 4; ++i) v[i] = o[db][4 * g4 + i];
            if (MODE != 1) { const f32x4 nw = *(const f32x4*)(P.nw + (MODE == 2 ? h * 64 : 0) + d0);
#pragma unroll
                for (int i = 0; i < 4; ++i) v[i] = (v[i] - mu) * rn * nw[i]; }
            if (MODE >= 2) { const u32x2 gw = *(const u32x2*)(P.Z + orow * ZW + (MODE == 2 ? ZC_CG : ZC_DG) + h * 64 + d0);
                const float g0 = bflo(gw.x), g1 = bfhi(gw.x), g2 = bflo(gw.y), g3 = bfhi(gw.y);
                v[0] *= g0 * sigmoidf_(g0); v[1] *= g1 * sigmoidf_(g1); v[2] *= g2 * sigmoidf_(g2); v[3] *= g3 * sigmoidf_(g3); }
            u32x2 ow; ow.x = pk2(v[0], v[1]); ow.y = pk2(v[2], v[3]);
            *(u32x2*)(P.Y + orow * DM + ycol + d0) = ow; }
}
}

constexpr int PH_PER_LAYER = 12, N_PHASES = 1 + DEPTH * PH_PER_LAYER;

typedef __attribute__((address_space(4))) const Args* KArgP;
#ifdef ONLY_SITE
#define SITE(s) ((s) == ONLY_SITE)
#else
#define SITE(s) true
#endif
#if MK_ONE_LAUNCH
#define IN(k) true
#define SEAM(k) do { if ((k) + 1 < N_PHASES) { XcdBarrier b2_ = bar; asm volatile("" : "+s"(b2_.bar), "+s"(b2_.x)); xcd_barrier(b2_, F.tid == 0); } } while (0)
#else
#define IN(k) (lo <= (k) && (k) < hi)
#define SEAM(k) do { } while (0)
#endif
#define SITE_BEGIN KArgP KA = (KArgP)__builtin_amdgcn_kernarg_segment_ptr(); do { asm volatile("" : "+s"(KA)); \
        int ln_; asm volatile("v_mbcnt_lo_u32_b32 %0, -1, 0\n\tv_mbcnt_hi_u32_b32 %0, -1, %0" : "=v"(ln_)); \
        const unsigned simd_ = (unsigned)__builtin_amdgcn_s_getreg(((2 - 1) << 11) | (4 << 6) | 4);   \
        unsigned tk_ = 0u, tg_ = 0u; if (ln_ == 0) { tk_ = __hip_atomic_fetch_add((LAS unsigned*)(F.lds + MISC_OFF + 64) + simd_, 1u, __ATOMIC_RELAXED, __HIP_MEMORY_SCOPE_WORKGROUP); \
            tg_ = __hip_atomic_fetch_add((LAS unsigned*)(F.lds + MISC_OFF + 96), 1u, __ATOMIC_RELAXED, __HIP_MEMORY_SCOPE_WORKGROUP); } \
        F.wave = __builtin_amdgcn_readfirstlane(simd_balanced ? (int)(simd_ + 4u * (tk_ & 1u)) : (int)(tg_ & 7u)); F.lane = ln_; F.tid = F.wave * 64 + F.lane; \
        F.ws = KA->ws; F.dob = (unsigned char*)KA->out; F.G = G0; F.wg = wg0; asm volatile("" : "+s"(F.G), "+s"(F.wg)); } while (0)


__global__ void __launch_bounds__(NWAVES * 64, 2) fwd_kernel(Args args) {
    extern __shared__ __attribute__((aligned(16))) unsigned char lds_raw[];
    Frame F;
    F.lds = (LAS unsigned char*)lds_raw;
    F.tid = threadIdx.x; F.lane = F.tid & 63; F.wave = __builtin_amdgcn_readfirstlane(F.tid >> 6);
    F.G = gridDim.x; F.wg = blockIdx.x;
    F.ws = args.ws; F.dob = (unsigned char*)args.out;
    volatile LAS unsigned* MISC = (volatile LAS unsigned*)(F.lds + MISC_OFF);
    if (F.tid < 32) MISC[F.tid] = 0u;
    __syncthreads();
    if (F.lane == 0) __hip_atomic_fetch_add((LAS unsigned*)(F.lds + MISC_OFF + 112) + ((unsigned)__builtin_amdgcn_s_getreg(((2 - 1) << 11) | (4 << 6) | 4)), 1u, __ATOMIC_RELAXED, __HIP_MEMORY_SCOPE_WORKGROUP);
    __syncthreads();
    const bool simd_balanced = (MISC[28] == 2u) && (MISC[29] == 2u) && (MISC[30] == 2u) && (MISC[31] == 2u);
    unsigned* ctl = (unsigned*)(F.ws + WS_CTL);
    XcdBarrier bar; bar.bar = ctl + CW_BAR; bar.x = 0; bar.st = nullptr;
#if MK_ONE_LAUNCH
    bar = xcd_barrier_post(ctl + CW_BAR, MISC + 8);
#endif
    const int lo = args.ph_lo, hi = args.ph_hi, subm = args.sub;
    const int G0 = F.G, wg0 = F.wg;
    if (SITE(0) && IN(0)) { SITE_BEGIN; p0_prologue(F, KA); SEAM(0); }

    for (int l = 0; l < DEPTH; ++l) {
        const int pb = 1 + l * PH_PER_LAYER;
        if (SITE(1) && IN(pb + 0)) { SITE_BEGIN; const char* XBc = (const char*)(F.ws + WS_XB); (void)XBc; const unsigned char* w123 = F.ws + WS_W123; const unsigned char* w45 = F.ws + WS_W45 + (size_t)l * W45_STRIDE; (void)w123; (void)w45;
            pg8::EpiStore E{(bf16*)(F.ws + WS_Z), ZW};
            {   pg8::SchedTiles S{XBc, (const char*)(w123 + W123_W1), 2048, 2048, 16, 6, G1_BF_TILES, 0, F.G, F.wg};
                { int tl_ = F.tid; asm volatile("" : "+v"(tl_)); pg8::gemm_phase(F.lds, S, E, tl_); } }
            {   pg8::SchedTiles S{(const char*)(F.dob + DO_XB8), (const char*)(F.dob + DO_W8 + (size_t)l * W8_STRIDE + W8_Z), 1024, 1024, 8, 8, G1_F8_TILES, 1, F.G, F.wg};
                { int tl_ = F.tid; asm volatile("" : "+v"(tl_)); pg8::gemm_phase<pg8::EpiStore, pg8::SchedTiles, true>(F.lds, S, E, tl_); } }
            SEAM(pb + 0);
        }
        if (SITE(2) && IN(pb + 1)) { SITE_BEGIN; const char* XBc = (const char*)(F.ws + WS_XB); (void)XBc; const unsigned char* w123 = F.ws + WS_W123; const unsigned char* w45 = F.ws + WS_W45 + (size_t)l * W45_STRIDE; (void)w123; (void)w45;
            {   unsigned* head = (unsigned*)(F.ws + WS_CTL) + CW_WQ + l * 64 + 32;
                for (;;) { const int i = mx::wq_next(F, head); if (i >= 128 + 1024) break;
                    if (i < 128) { if (subm & 2) mx::prepkv_unit(F, i, KA->in[6] + (size_t)l * 16 * 128, KA->in[7] + l * 128, (unsigned*)(F.ws + WS_CTL) + CW_KMAX + l * 64); }
                    else if (subm & 1) { const int u = i - 128; mx::b1_unit(F, u & 3, 255 - (u >> 2)); } } }
            SEAM(pb + 1);
        }
        if (SITE(3) && IN(pb + 2)) { SITE_BEGIN; const char* XBc = (const char*)(F.ws + WS_XB); (void)XBc; const unsigned char* w123 = F.ws + WS_W123; const unsigned char* w45 = F.ws + WS_W45 + (size_t)l * W45_STRIDE; (void)w123; (void)w45;
            if (subm & 1) mx::scan_phase(F);
            float lam_init = 0.8f - 0.6f * __expf(-0.3f * (float)l);
            const float* lp = KA->in[3] + l * 128; float s01 = 0.f, s23 = 0.f;
            for (int i = 0; i < 32; ++i) { s01 += lp[i] * lp[32 + i]; s23 += lp[64 + i] * lp[96 + i]; }
            mx::EngP P{(const bf16*)(F.ws + WS_Z), (bf16*)(F.ws + WS_Y), nullptr, nullptr, KA->in[4] + l * 64, __expf(s01) - __expf(s23) + lam_init, lam_init, (const unsigned*)(F.ws + WS_CTL) + CW_KMAX + l * 64};
            {   unsigned* head = (unsigned*)(F.ws + WS_CTL) + CW_WQ + l * 64;
                for (;;) { const int i = mx::wq_next(F, head); if (i >= 512) break; const int j = i & 127; mx::eng_unit<0>(F, P, j & 3, 3 - (i >> 7), 31 - (j >> 2)); } }
            SEAM(pb + 2);
        }
        if (SITE(4) && IN(pb + 3)) { SITE_BEGIN; const char* XBc = (const char*)(F.ws + WS_XB); (void)XBc; const unsigned char* w123 = F.ws + WS_W123; const unsigned char* w45 = F.ws + WS_W45 + (size_t)l * W45_STRIDE; (void)w123; (void)w45;
            {   unsigned* head = (unsigned*)(F.ws + WS_CTL) + CW_WQ + l * 64 + 16;
                const mx::EngP PB{(const bf16*)(F.ws + WS_Z), (bf16*)(F.ws + WS_Y), (const unsigned*)(F.ws + WS_MASK), nullptr, nullptr, 0.f, 0.f, (const unsigned*)(F.ws + WS_CTL) + CW_KMAX + l * 64};
                const mx::EngP PC{(const bf16*)(F.ws + WS_Z), (bf16*)(F.ws + WS_Y), nullptr, (const float*)(F.ws + WS_KVC), KA->in[5] + l * 256, 0.f, 0.f, nullptr};
                const mx::EngP PD{(const bf16*)(F.ws + WS_Z), (bf16*)(F.ws + WS_Y), nullptr, (const float*)(F.ws + WS_KVD), KA->in[8] + l * 64, 0.f, 0.f, nullptr};
                for (;;) { const int i = mx::wq_next(F, head); if (i >= 1536) break;
                    if (i < 512) { if (subm & 1) { const int j = i & 127; mx::eng_unit<1>(F, PB, j & 3, 3 - (i >> 7), 31 - (j >> 2)); } }
                    else if (!(subm & (i < 1024 ? 2 : 4))) continue;
                    else if (i < 1024) { const int u = i - 512; mx::eng_unit<2>(F, PC, u >> 7, (u >> 5) & 3, u & 31); }
                    else { const int u = i - 1024; mx::eng_unit<3>(F, PD, u >> 7, (u >> 5) & 3, u & 31); } } }
            SEAM(pb + 3);
        }
        if (SITE(5) && IN(pb + 4)) { SITE_BEGIN;
            const unsigned char* w123 = F.ws + WS_W123;
            for (int n = 0; n < 4; ++n) {
                {   pg8::SchedPlain S{(const char*)(F.dob + DO_XB8), (const char*)(F.dob + DO_W8 + (size_t)l * W8_STRIDE + W8_G) + (size_t)n * 1024 * 1024, 1024, 1024, 8, 128, 4, F.G, F.wg};
                    pg8::EpiSlotStore E{F.ws + WS_SCR2 + (size_t)F.wg * 262144, 1};
                    { int tl_ = F.tid; asm volatile("" : "+v"(tl_)); pg8::gemm_phase<pg8::EpiSlotStore, pg8::SchedPlain, true>(F.lds, S, E, tl_); } }
                {   pg8::SchedPlain S{(const char*)(F.ws + WS_Y) + n * 512, (const char*)(w123 + W123_GB + 8 * MiB) + (size_t)n * 1024 * 512, 2048, 512, 4, 128, 4, F.G, F.wg};
                    pg8::EpiBranch E{F.ws + WS_SCR2 + (size_t)F.wg * 262144, (bf16*)(F.ws + WS_MERGED), n == 0};
                    { int tl_ = F.tid; asm volatile("" : "+v"(tl_)); pg8::gemm_phase(F.lds, S, E, tl_); } }
            }
            SEAM(pb + 4);
        }
        if (SITE(6) && IN(pb + 5)) { SITE_BEGIN; const char* XBc = (const char*)(F.ws + WS_XB); (void)XBc; const unsigned char* w123 = F.ws + WS_W123; const unsigned char* w45 = F.ws + WS_W45 + (size_t)l * W45_STRIDE; (void)w123; (void)w45;
            pg8::SchedPlain S{(const char*)(F.ws + WS_MERGED), (const char*)(w123 + W123_WO), 2048, 2048, 16, 128, 4, F.G, F.wg};
            pg8::EpiG3 E{(bf16*)(F.ws + WS_XB)};
            pg8::gemm_phase(F.lds, S, E, F.tid);
            SEAM(pb + 5);
        }
        if (SITE(7) && IN(pb + 6)) { SITE_BEGIN; const char* XBc = (const char*)(F.ws + WS_XB); (void)XBc; const unsigned char* w123 = F.ws + WS_W123; const unsigned char* w45 = F.ws + WS_W45 + (size_t)l * W45_STRIDE; (void)w123; (void)w45; ln_phase(F, KA->in[11] + l * DM, KA->in[12] + l * DM, nullptr, F.dob + DO_XB8);
            if (l + 1 < DEPTH) convert_w123(F, KA->in[2] + (size_t)(l + 1) * DM * NIN, KA->in[9] + (size_t)(l + 1) * 4 * 256 * DM, KA->in[10] + (size_t)(l + 1) * DM * DM);
            SEAM(pb + 6); }
        if (SITE(8) && IN(pb + 7)) { SITE_BEGIN; const char* XBc = (const char*)(F.ws + WS_XB); (void)XBc; const unsigned char* w123 = F.ws + WS_W123; const unsigned char* w45 = F.ws + WS_W45 + (size_t)l * W45_STRIDE; (void)w123; (void)w45;
            pg8::SchedUp S{(const char*)(F.dob + DO_XB8), (const char*)(F.dob + DO_W8 + (size_t)l * W8_STRIDE + W8_UP), F.G, F.wg};
            pg8::EpiUp E{(bf16*)(F.ws + WS_GE), (bf16*)(F.ws + WS_G0), (bf16*)(F.ws + WS_U0), F.ws + WS_ACT8, KA->in[14] + (size_t)l * 3 * DFF, KA->in[15] + (size_t)l * DFF};
            pg8::gemm_phase<pg8::EpiUp, pg8::SchedUp, true>(F.lds, S, E, F.tid);
            SEAM(pb + 7);
        }
        if (SITE(9) && IN(pb + 8)) { SITE_BEGIN; const char* XBc = (const char*)(F.ws + WS_XB); (void)XBc; const unsigned char* w123 = F.ws + WS_W123; const unsigned char* w45 = F.ws + WS_W45 + (size_t)l * W45_STRIDE; (void)w123; (void)w45; ffn_act_phase(F, KA->in[14] + (size_t)l * 3 * DFF, KA->in[15] + (size_t)l * DFF); SEAM(pb + 8); }
        if (SITE(10) && IN(pb + 9)) { SITE_BEGIN;
            const unsigned char* w45 = F.ws + WS_W45 + (size_t)l * W45_STRIDE;
            {   pg8::SchedPlain S{(const char*)(F.ws + WS_PB + (size_t)l * M * PDIM * 2), (const char*)(w45 + W45_PP), 512, 512, 4, 128, 4, F.G, F.wg};
                pg8::EpiSlotStore E{F.dob + DO_SCR5 + (size_t)F.wg * 262144, 0};
                { int tl_ = F.tid; asm volatile("" : "+v"(tl_)); pg8::gemm_phase(F.lds, S, E, tl_); } }
            {   pg8::SchedPlain S{(const char*)(F.dob + DO_XB8), (const char*)(F.dob + DO_W8 + (size_t)l * W8_STRIDE + W8_PG), 1024, 1024, 8, 128, 4, F.G, F.wg};
                pg8::EpiSlotMul E{F.dob + DO_SCR5 + (size_t)F.wg * 262144};
                { int tl_ = F.tid; asm volatile("" : "+v"(tl_)); pg8::gemm_phase<pg8::EpiSlotMul, pg8::SchedPlain, true>(F.lds, S, E, tl_); } }
            SEAM(pb + 9);
        }
        if (SITE(11) && IN(pb + 10)) { SITE_BEGIN;
            const unsigned char* w45 = F.ws + WS_W45 + (size_t)l * W45_STRIDE;
            pg8::SchedG5b S{(const char*)(F.ws + WS_ACT8), (const char*)(F.dob + DO_W8 + (size_t)l * W8_STRIDE + W8_DN), F.G, F.wg};
            pg8::EpiG5b E{F.dob + DO_SCR5 + (size_t)F.wg * 262144, (bf16*)(F.ws + WS_XB)};
            pg8::gemm_phase<pg8::EpiG5b, pg8::SchedG5b, true>(F.lds, S, E, F.tid);
            SEAM(pb + 10);
        }
        if (SITE(12) && IN(pb + 11)) { SITE_BEGIN; const char* XBc = (const char*)(F.ws + WS_XB); (void)XBc; const unsigned char* w123 = F.ws + WS_W123; const unsigned char* w45 = F.ws + WS_W45 + (size_t)l * W45_STRIDE; (void)w123; (void)w45; ln_phase(F, KA->in[19] + l * DM, KA->in[20] + l * DM, l == DEPTH - 1 ? KA->out : nullptr, l == DEPTH - 1 ? nullptr : F.dob + DO_XB8); SEAM(pb + 11); }
    }
#undef IN
#undef SEAM
}

extern "C" void kernel_launch(void* const* d_in, const int* in_sizes, int n_in, void* d_out, int out_size, void* d_ws, size_t ws_size, hipStream_t stream) {
    static int grid = 0;
    if (grid == 0) {
        if (n_in != 21 || out_size != M * DM || ws_size < WS_END) { fprintf(stderr, "kernel_launch: unexpected shapes (n_in %d out %d ws %zu)\n", n_in, out_size, ws_size); grid = -1; return; }
        int dev = 0, cus = 0, per_cu = 0;
        if (hipGetDevice(&dev) != hipSuccess || hipDeviceGetAttribute(&cus, hipDeviceAttributeMultiprocessorCount, dev) != hipSuccess) { grid = -1; return; }
        if (hipFuncSetAttribute((const void*)fwd_kernel, hipFuncAttributeMaxDynamicSharedMemorySize, LDS_BYTES) != hipSuccess) { grid = -1; return; }
        if (hipOccupancyMaxActiveBlocksPerMultiprocessor(&per_cu, (const void*)fwd_kernel, NWAVES * 64, LDS_BYTES) != hipSuccess || per_cu < 1)
            fprintf(stderr, "kernel_launch: occupancy query reports %d\n", per_cu);
        (void)hipGetLastError();
        grid = cus;
    }
    if (grid < 0) return;
    (void)hipMemsetAsync((char*)d_ws + WS_CTL, 0, CTL_ZERO_BYTES, stream);
    Args a{};
    for (int i = 0; i < 21; ++i) a.in[i] = (const float*)d_in[i];
    a.out = (float*)d_out; a.ws = (unsigned char*)d_ws;
#if MK_ONE_LAUNCH
    a.ph_lo = 0; a.ph_hi = N_PHASES; a.sub = 7;
    hipLaunchKernelGGL(fwd_kernel, dim3(grid), dim3(NWAVES * 64), LDS_BYTES, stream, a);
#else
    for (int p = 0; p < N_PHASES; ++p) { a.ph_lo = p; a.ph_hi = p + 1; a.sub = 7;
        hipLaunchKernelGGL(fwd_kernel, dim3(grid), dim3(NWAVES * 64), LDS_BYTES, stream, a);
#ifdef PROBE_PHASE
        if (p >= 1 && (p - 1) % PH_PER_LAYER == PROBE_PHASE) { (void)hipMemsetAsync((char*)d_ws + WS_CTL + CW_WQ * 4, 0, 1024, stream); a.sub = PROBE_SUB;
            hipLaunchKernelGGL(fwd_kernel, dim3(grid), dim3(NWAVES * 64), LDS_BYTES, stream, a); }
#endif
    }
#endif
}
```

```cpp
#include <hip/hip_runtime.h>
#include <cstdio>
#include <cstdint>

#ifndef MK_ONE_LAUNCH
#define MK_ONE_LAUNCH 1
#endif

#define GAS __attribute__((address_space(1)))
#define LAS __attribute__((address_space(3)))
typedef unsigned short bf16;
typedef unsigned u32x4 __attribute__((ext_vector_type(4)));
typedef unsigned u32x2 __attribute__((ext_vector_type(2)));
typedef float f32x2 __attribute__((ext_vector_type(2)));
typedef float f32x4 __attribute__((ext_vector_type(4)));
typedef float f32x16 __attribute__((ext_vector_type(16)));
typedef short bf16x8 __attribute__((ext_vector_type(8)));
typedef short s16x4 __attribute__((ext_vector_type(4)));
typedef GAS unsigned gu32;

constexpr int BATCH = 4, SEQ = 8192, DM = 1024, M = BATCH * SEQ, DEPTH = 2;
constexpr int NIN = 7604, ZW = 3648  , DFF = 2816, UGW = 5632, PDIM = 256;
constexpr float LN_EPS = 1e-5f;
constexpr float ALPHA = 1.41421356237f;
constexpr float LOG2E = 1.4426950408889634f;
constexpr int ZC_AQ = 0, ZC_AK = 256, ZC_AV = 512, ZC_BQ = 768, ZC_BK = 1024, ZC_BV = 1280, ZC_CQ = 1536, ZC_CK = 1792, ZC_CV = 2048, ZC_CG = 2304,
              ZC_DQ = 2560, ZC_DK = 2688, ZC_DV = 2816, ZC_DG = 3072, ZC_IQ = 3328, ZC_IK = 3456, ZC_IW = 3488, ZC_DA = 3504;
constexpr int SRC_MG = 3508;

constexpr size_t MiB = 1u << 20;
constexpr size_t WS_CTL = 0, CTL_ZERO_BYTES = 1 * MiB;
constexpr size_t WS_XB = 1 * MiB;
constexpr size_t WS_BIG = 65 * MiB;
constexpr size_t WS_Z = WS_BIG, WS_Y = WS_BIG + 228 * MiB, WS_MERGED = WS_BIG + 292 * MiB;
constexpr size_t WS_ACT8 = WS_BIG, WS_GE = WS_BIG + 96 * MiB, WS_G0 = WS_BIG + 104 * MiB, WS_U0 = WS_BIG + 112 * MiB;
constexpr size_t WS_MASK = WS_MERGED, WS_KVC = WS_MERGED + 32 * MiB, WS_KVD = WS_MERGED + 40 * MiB, WS_DE = WS_MERGED + 56 * MiB;
constexpr size_t WS_SCR2 = WS_Z;
constexpr size_t WS_W45 = 421 * MiB, W45_STRIDE = 15 * MiB, WS_IKC = 451 * MiB;
constexpr size_t W45_UP = 0, W45_PG = 11 * MiB, W45_PP = 13 * MiB, W45_DN = 13 * MiB + 512 * 1024;
constexpr size_t WS_PB = 455 * MiB;
constexpr size_t WS_W123 = 487 * MiB;
constexpr size_t WS_END = 506 * MiB;
constexpr size_t W123_W1 = 0, W123_GB = 7 * MiB, W123_WO = 17 * MiB;
constexpr size_t DO_SCR5 = 0;
constexpr size_t DO_XB8 = 64 * MiB;
constexpr size_t DO_W8 = 96 * MiB, W8_STRIDE = 15 * MiB + 256 * 1024, W8_G = 0, W8_UP = 4 * MiB, W8_PG = 9 * MiB + 512 * 1024, W8_DN = 10 * MiB + 512 * 1024, W8_Z = 13 * MiB + 256 * 1024;
constexpr unsigned long long G1_F8_TILES = 0xCB987652ull, G1_BF_TILES = 0xDA4310ull;

constexpr int CW_BAR = 4096, CW_WQ = 8448  , CW_KMAX = 8192;

constexpr int RING_BYTES = 131072;
constexpr int MISC_OFF = 131072 + 320;
constexpr int QST_OFF = 132096;
constexpr int LDS_BYTES = 147456;

constexpr int NWAVES = 8;

#define RLX_AGENT __ATOMIC_RELAXED, __HIP_MEMORY_SCOPE_AGENT
__device__ __forceinline__ unsigned f2bf(float f) { unsigned u = __builtin_bit_cast(unsigned, f); return (u + 0x7fffu + ((u >> 16) & 1u)) >> 16; }
typedef __bf16 bf16x2_t __attribute__((ext_vector_type(2)));
__device__ __forceinline__ unsigned pk2(float lo, float hi) { const f32x2 v = {lo, hi}; const bf16x2_t b = __builtin_convertvector(v, bf16x2_t); return __builtin_bit_cast(unsigned, b); }
__device__ __forceinline__ unsigned pk4f8(float a, float b, float c, float d) { int p = __builtin_amdgcn_cvt_pk_fp8_f32(a, b, 0, false); p = __builtin_amdgcn_cvt_pk_fp8_f32(c, d, p, true); return (unsigned)p; }
__device__ __forceinline__ float bflo(unsigned w) { return __uint_as_float(w << 16); }
__device__ __forceinline__ float bfhi(unsigned w) { return __uint_as_float(w & 0xffff0000u); }
__device__ __forceinline__ float bf1(bf16 b) { return __uint_as_float((unsigned)b << 16); }
__device__ __forceinline__ void up8(const u32x4 w, float (&v)[8]) { v[0] = bflo(w.x); v[1] = bfhi(w.x); v[2] = bflo(w.y); v[3] = bfhi(w.y); v[4] = bflo(w.z); v[5] = bfhi(w.z); v[6] = bflo(w.w); v[7] = bfhi(w.w); }
__device__ __forceinline__ float sigmoidf_(float x) { return __builtin_amdgcn_rcpf(1.0f + __builtin_amdgcn_exp2f(-LOG2E * x)); }
__device__ __forceinline__ float shx(float v, int lane, int m) { return __int_as_float(__builtin_amdgcn_ds_bpermute((lane ^ m) << 2, __float_as_int(v))); }
__device__ __forceinline__ unsigned shup(unsigned v, int lane, int o) { return (unsigned)__builtin_amdgcn_ds_bpermute((lane - o) << 2, (int)v); }
__device__ __forceinline__ float wave_sum(float v, int lane) {
#pragma unroll
    for (int o = 1; o < 64; o <<= 1) v += shx(v, lane, o);
    return v;
}

#define XB_TMO      128
#define XB_XCNT(j)  (256  + 64 * (j))
#define XB_XSUB(j)  (1280 + 64 * (j))
#define XB_XGEN(j)  (2304 + 64 * (j))
#define XB_TOP      3328
#define XB_TOPGEN   3392
#define XCD_BAR_WORDS 3456
#define XB_SPIN_CAP (1u << 22)

__device__ __forceinline__ unsigned xb_ld(unsigned* p)              { return __hip_atomic_load(p, __ATOMIC_RELAXED, __HIP_MEMORY_SCOPE_AGENT); }
__device__ __forceinline__ unsigned xb_add(unsigned* p, unsigned v) { return __hip_atomic_fetch_add(p, v, __ATOMIC_RELAXED, __HIP_MEMORY_SCOPE_AGENT); }
__device__ __forceinline__ unsigned xb_xcc_id() { return (unsigned)__builtin_amdgcn_s_getreg((3 << 11) | 20) & 0xFu; }
#define XB_SPIN(cond, bar) do { unsigned _sp = 0; while (cond) { __builtin_amdgcn_s_sleep(1); \
    if ((++_sp & 255u) == 0u) { if (xb_ld(&(bar)[XB_TMO])) break; if (_sp > XB_SPIN_CAP) { atomicAdd(&(bar)[XB_TMO], 1u); break; } } } } while (0)

struct XcdBarrier { unsigned* bar; unsigned x; volatile LAS unsigned* st; };

__device__ __forceinline__ XcdBarrier xcd_barrier_post(unsigned* bar, volatile LAS unsigned* st) {
    XcdBarrier b; b.bar = bar; b.x = xb_xcc_id(); b.st = st;
    if (threadIdx.x == 0) (void)xb_add(&bar[XB_XCNT(b.x)], 1u);
    return b;
}
__device__ __forceinline__ void xcd_barrier_complete(unsigned* bar, unsigned x, unsigned& nloc, unsigned& nx) {
    const unsigned G = gridDim.x * gridDim.y * gridDim.z;
    unsigned sum, cnt, mine, sp = 0u;
    for (;;) {
        sum = 0u; cnt = 0u; mine = 0u;
#pragma unroll
        for (unsigned j = 0; j < 16; ++j) { const unsigned c = xb_ld(&bar[XB_XCNT(j)]); sum += c; cnt += (c > 0u) ? 1u : 0u; mine = (j == x) ? c : mine; }
        if (sum == G) break;
        __builtin_amdgcn_s_sleep(1);
        if ((++sp & 255u) == 0u) { if (xb_ld(&bar[XB_TMO])) break; if (sp > XB_SPIN_CAP) { atomicAdd(&bar[XB_TMO], 1u); break; } }
    }
    nloc = mine > 0u ? mine : 1u; nx = cnt > 0u ? cnt : 1u;
}
__device__ __forceinline__ void xcd_barrier(const XcdBarrier& b, const bool leader_thread) {
    asm volatile("s_waitcnt vmcnt(0)" ::: "memory");
    __syncthreads();
    if (leader_thread) {
        unsigned* bar = b.bar;
        __builtin_amdgcn_s_waitcnt(0);
        unsigned nloc = b.st[0], nx = b.st[1];
        if (nloc == 0u) { xcd_barrier_complete(bar, b.x, nloc, nx); b.st[0] = nloc; b.st[1] = nx; }
        const unsigned old = xb_add(&bar[XB_XSUB(b.x)], 1u);
        const unsigned gen = old / nloc;
        if (old + 1u == (gen + 1u) * nloc) {
            __builtin_amdgcn_fence(__ATOMIC_RELEASE, "agent");
            asm volatile("s_waitcnt vmcnt(0)" ::: "memory");
            const unsigned og = xb_add(&bar[XB_TOP], 1u);
            const unsigned tg = og / nx;
            if (og + 1u == (tg + 1u) * nx) xb_add(&bar[XB_TOPGEN], 1u);
            else XB_SPIN(xb_ld(&bar[XB_TOPGEN]) == tg, bar);
            __builtin_amdgcn_fence(__ATOMIC_ACQUIRE, "agent");
            xb_add(&bar[XB_XGEN(b.x)], 1u);
            asm volatile("s_waitcnt vmcnt(0)" ::: "memory");
        } else {
            XB_SPIN(xb_ld(&bar[XB_XGEN(b.x)]) == gen, bar);
            __builtin_amdgcn_fence(__ATOMIC_ACQUIRE, "agent");
            asm volatile("s_waitcnt vmcnt(0)" ::: "memory");
        }
    }
    __syncthreads();
}

namespace pg8 {
constexpr int BM = 256, BK = 64, HALF = 128, HTB = HALF * BK * 2, STAGE_BYTES = 8 * HTB, NXCD = 8, WGM = 8;
__device__ __forceinline__ int lds_byte(int r, int c) { const int st = (r >> 4) * 2 + (c >> 5), rr = r & 15, cc = c & 31, ob = rr * 64 + cc * 2; return st * 1024 + (ob ^ (((ob >> 9) & 1) << 5)); }
__device__ __forceinline__ void stage_rc(int b, int& R, int& C) { const int st = b / 1024, sb = b % 1024, swz = sb ^ (((sb >> 9) & 1) << 5); R = (st >> 1) * 16 + swz / 64; C = (st & 1) * 32 + (swz % 64) / 2; }
__device__ __forceinline__ int perm32(int rho) { const int n = rho >> 4, i = rho & 15; return 8 * (i >> 2) + 4 * n + (i & 3); }

struct UnitD { const char* A; const char* B; int lda2, ldb2, nt, pm, pn, kind; };

__device__ __forceinline__ void tile_map(int L, int nM, int nN, int& pm, int& pn) {
    const int nwg = nM * nN; int wgid = L;
    { const int q = nwg / NXCD, r = nwg % NXCD, xcd = wgid % NXCD, off = wgid / NXCD; wgid = (xcd < r ? xcd * (q + 1) : r * (q + 1) + (xcd - r) * q) + off; }
    const int nig = WGM * nN, gid = wgid / nig, fm = gid * WGM, gsz = (nM - fm) < WGM ? (nM - fm) : WGM;
    pm = fm + ((wgid % nig) % gsz); pn = (wgid % nig) / gsz;
}

typedef int i32x8 __attribute__((ext_vector_type(8)));
template <class Epi, class Sched, bool FP8 = false>
__device__ __forceinline__ void gemm_phase(LAS unsigned char* lds, const Sched& S, const Epi& E, const int tid) {
    const int wid = __builtin_amdgcn_readfirstlane(tid >> 6), lane = tid & 63, wr = wid >> 2, wc = wid & 3, fr = lane & 15, fq = lane >> 4;
    int sR, sRb, sC2;
    { int R, C; stage_rc(tid * 16, R, C); sR = R; sRb = (R & ~31) + perm32(R & 31); sC2 = C * 2; }
    const size_t kstep = (size_t)(BK * 2);
    const unsigned ldsw = (unsigned)wid * 1024u;
    const int aoff = lds_byte(wr * 64 + fr, FP8 ? fq * 16 : fq * 8), boff = lds_byte(wc * 32 + fr, FP8 ? fq * 16 : fq * 8);
#define PG8_SA(b, h) (((b) * 2 + (h)) * HTB)
#define PG8_SB(b, h) ((4 + (b) * 2 + (h)) * HTB)
#define PG8_STAGE(bufoff, gbase, rows, pitch) do { const unsigned _o = (unsigned)((rows) * (pitch) + sC2); _Pragma("unroll") for (int _i = 0; _i < 2; ++_i) \
        __builtin_amdgcn_global_load_lds((const unsigned*)((const char*)(gbase) + (size_t)(_i * 64) * (pitch) + _o), (LAS unsigned*)(lds + (bufoff) + ldsw + _i * 8192), 16, 0, 0); } while (0)
#define PG8_LDA(dst, b, h) do { if constexpr (FP8) { _Pragma("unroll") for (int m = 0; m < 4; ++m) { const u32x4 lo_ = *(const LAS u32x4*)(lds + PG8_SA(b, h) + aoff + m * 2048), hi_ = *(const LAS u32x4*)(lds + PG8_SA(b, h) + aoff + m * 2048 + 16); \
            dst##8[m] = (i32x8){(int)lo_.x, (int)lo_.y, (int)lo_.z, (int)lo_.w, (int)hi_.x, (int)hi_.y, (int)hi_.z, (int)hi_.w}; } } \
        else { _Pragma("unroll") for (int m = 0; m < 4; ++m) _Pragma("unroll") for (int k = 0; k < 2; ++k) dst[m][k] = *(const LAS bf16x8*)(lds + PG8_SA(b, h) + aoff + m * 2048 + k * 1024); } } while (0)
#define PG8_LDB(dst, b, h) do { if constexpr (FP8) { _Pragma("unroll") for (int n = 0; n < 2; ++n) { const u32x4 lo_ = *(const LAS u32x4*)(lds + PG8_SB(b, h) + boff + n * 2048), hi_ = *(const LAS u32x4*)(lds + PG8_SB(b, h) + boff + n * 2048 + 16); \
            dst##8[n] = (i32x8){(int)lo_.x, (int)lo_.y, (int)lo_.z, (int)lo_.w, (int)hi_.x, (int)hi_.y, (int)hi_.z, (int)hi_.w}; } } \
        else { _Pragma("unroll") for (int n = 0; n < 2; ++n) _Pragma("unroll") for (int k = 0; k < 2; ++k) dst[n][k] = *(const LAS bf16x8*)(lds + PG8_SB(b, h) + boff + n * 2048 + k * 1024); } } while (0)
#define PG8_MMA(ai, bj, At, Bt) do { __builtin_amdgcn_s_setprio(1); if constexpr (FP8) { _Pragma("unroll") for (int m = 0; m < 4; ++m) _Pragma("unroll") for (int n = 0; n < 2; ++n) \
            asm volatile("v_mfma_scale_f32_16x16x128_f8f6f4 %0, %1, %2, %0, %3, %3 op_sel_hi:[0,0,0]" : "+v"(acc[ai][bj][m][n]) : "v"(Bt##8[n]), "v"(At##8[m]), "v"(scl8)); } \
        else { _Pragma("unroll") for (int m = 0; m < 4; ++m) _Pragma("unroll") for (int n = 0; n < 2; ++n) _Pragma("unroll") for (int k = 0; k < 2; ++k) \
            acc[ai][bj][m][n] = __builtin_amdgcn_mfma_f32_16x16x32_bf16(Bt[n][k], At[m][k], acc[ai][bj][m][n], 0, 0, 0); } __builtin_amdgcn_s_setprio(0); } while (0)
#define PG8_WAIT_V(n) asm volatile("s_waitcnt vmcnt(" #n ")" ::: "memory")
#define PG8_WAIT_L(n) asm volatile("s_waitcnt lgkmcnt(" #n ")" ::: "memory")
#define PG8_BAR __builtin_amdgcn_s_barrier()
#define PG8_SCHED __builtin_amdgcn_sched_barrier(0)
    UnitD cur, nxt; int ui = 0;
    if (!S.next(0, cur)) return;
    f32x4 acc[2][2][4][2];
#pragma unroll
    for (int a = 0; a < 2; ++a)
#pragma unroll
        for (int b = 0; b < 2; ++b)
#pragma unroll
            for (int m = 0; m < 4; ++m)
#pragma unroll
                for (int n = 0; n < 2; ++n) acc[a][b][m][n] = (f32x4){0.f, 0.f, 0.f, 0.f};
    bf16x8 At[4][2], B0[2][2], B1[2][2]; i32x8 At8[4], B08[2], B18[2];
    int scl8 = 0x7c7c7c7c; asm volatile("" : "+v"(scl8));
    const char* cA = cur.A; const char* cB = cur.B;
    int pA = cur.lda2, pB = cur.ldb2;
    PG8_STAGE(PG8_SB(0, 0), cB, sRb, pB); PG8_STAGE(PG8_SB(0, 1), cB + (size_t)HALF * pB, sRb, pB); PG8_STAGE(PG8_SA(0, 0), cA, sR, pA); PG8_STAGE(PG8_SA(0, 1), cA + (size_t)HALF * pA, sR, pA);
    if (wr == 1) PG8_BAR;
    PG8_WAIT_V(2); PG8_BAR;
    PG8_STAGE(PG8_SB(1, 0), cB + kstep, sRb, pB); PG8_STAGE(PG8_SA(1, 0), cA + kstep, sR, pA); PG8_STAGE(PG8_SB(1, 1), cB + (size_t)HALF * pB + kstep, sRb, pB);
    PG8_WAIT_V(6); PG8_BAR;
    for (;;) {
        const bool has_next = S.next(ui + 1, nxt);
        if (!has_next) nxt = cur;
        const char* nA = nxt.A; const char* nB = nxt.B;
        const int nt = cur.nt;
        for (int t = 0; t < nt; t += 2) {
            const bool last = (t == nt - 2);
            const char* a1 = cA + (size_t)(t + 1) * kstep + (size_t)HALF * pA;
            const char* a2 = last ? nA : cA + (size_t)(t + 2) * kstep; const char* b2 = last ? nB : cB + (size_t)(t + 2) * kstep;
            const int p2A = last ? nxt.lda2 : pA, p2B = last ? nxt.ldb2 : pB;
            const char* a2h = a2 + (size_t)HALF * p2A; const char* b2h = b2 + (size_t)HALF * p2B;
            PG8_LDB(B0, 0, 0); PG8_LDB(B1, 0, 1); PG8_SCHED; PG8_LDA(At, 0, 0); PG8_STAGE(PG8_SA(1, 1), a1, sR, pA);
            PG8_WAIT_V(8); PG8_WAIT_L(0); PG8_BAR; PG8_MMA(0, 0, At, B0); PG8_MMA(0, 1, At, B1); PG8_BAR; PG8_SCHED;
            PG8_LDA(At, 0, 1); PG8_STAGE(PG8_SB(0, 0), b2, sRb, p2B); PG8_STAGE(PG8_SB(0, 1), b2h, sRb, p2B); PG8_STAGE(PG8_SA(0, 0), a2, sR, p2A);
            PG8_WAIT_V(8); PG8_WAIT_L(0); PG8_BAR; PG8_MMA(1, 0, At, B0); PG8_MMA(1, 1, At, B1); PG8_BAR; PG8_SCHED;
            PG8_LDB(B0, 1, 0); PG8_LDB(B1, 1, 1); PG8_SCHED; PG8_LDA(At, 1, 0); PG8_STAGE(PG8_SA(0, 1), a2h, sR, p2A);
            PG8_WAIT_V(8); PG8_WAIT_L(0); PG8_BAR; PG8_MMA(0, 0, At, B0); PG8_MMA(0, 1, At, B1); PG8_BAR; PG8_SCHED;
            PG8_LDA(At, 1, 1); PG8_STAGE(PG8_SB(1, 0), b2 + kstep, sRb, p2B); PG8_STAGE(PG8_SB(1, 1), b2h + kstep, sRb, p2B); PG8_STAGE(PG8_SA(1, 0), a2 + kstep, sR, p2A);
            PG8_WAIT_V(8); PG8_WAIT_L(0); PG8_BAR; PG8_MMA(1, 0, At, B0); PG8_MMA(1, 1, At, B1); PG8_BAR; PG8_SCHED;
        }
        if constexpr (FP8) asm volatile("s_nop 15\n\ts_nop 15" ::: "memory");
        if (wr == 0) PG8_BAR;
        { int l2; asm volatile("v_mbcnt_lo_u32_b32 %0, -1, 0\n\tv_mbcnt_hi_u32_b32 %0, -1, %0" : "=v"(l2)); E(acc, cur, wr, wc, l2 & 15, l2 >> 4, wid * 64 + l2); }
        if (!has_next) break;
#pragma unroll
        for (int a = 0; a < 2; ++a)
#pragma unroll
            for (int b = 0; b < 2; ++b)
#pragma unroll
                for (int m = 0; m < 4; ++m)
#pragma unroll
                    for (int n = 0; n < 2; ++n) acc[a][b][m][n] = (f32x4){0.f, 0.f, 0.f, 0.f};
        cur = nxt; cA = nA; cB = nB; pA = cur.lda2; pB = cur.ldb2;
        ++ui;
        if (wr == 1) PG8_BAR;
    }
    PG8_WAIT_V(0);
    PG8_BAR;
#undef PG8_SA
#undef PG8_SB
#undef PG8_STAGE
#undef PG8_LDA
#undef PG8_LDB
#undef PG8_MMA
#undef PG8_WAIT_V
#undef PG8_WAIT_L
#undef PG8_BAR
#undef PG8_SCHED
}

struct SchedPlain {
    const char* A; const char* B; int lda2, ldb2, nt, nM, nN, G, c;
    __device__ __forceinline__ bool next(int i, UnitD& u) const {
        const long L = (long)i * G + c; if (L >= (long)nM * nN) return false;
        int pm, pn; tile_map((int)L, nM, nN, pm, pn);
        u.A = A + (size_t)pm * 256 * lda2; u.B = B + (size_t)pn * 256 * ldb2; u.lda2 = lda2; u.ldb2 = ldb2; u.nt = nt; u.pm = pm; u.pn = pn; u.kind = i; return true;
    }
};
struct SchedTiles {
    const char* A; const char* B; int lda2, ldb2, nt, ntile; unsigned long long list; int compact, G, c;
    __device__ __forceinline__ bool next(int i, UnitD& u) const {
        const long L = (long)i * G + c; if (L >= (long)128 * ntile) return false;
        int pm, pi; tile_map((int)L, 128, ntile, pm, pi); const int col = (int)((list >> (4 * pi)) & 15ull);
        u.A = A + (size_t)pm * 256 * lda2; u.B = B + (size_t)(compact ? pi : col) * 256 * ldb2; u.lda2 = lda2; u.ldb2 = ldb2; u.nt = nt; u.pm = pm; u.pn = col; u.kind = i; return true;
    }
};
struct SchedUp {
    const char* A; const char* B; int G, c;
    __device__ __forceinline__ bool next(int i, UnitD& u) const {
        const long L = (long)i * G + c; if (L >= 128 * 22) return false;
        int pm, cb; tile_map((int)L, 128, 22, pm, cb);
        u.A = A + (size_t)pm * 256 * 1024; u.lda2 = 1024; u.B = B + (size_t)cb * 256 * 1024; u.ldb2 = 1024; u.nt = 8; u.pm = pm; u.pn = cb; u.kind = i; return true;
    }
};
struct SchedG5b {
    const char* A; const char* B; int G, c;
    __device__ __forceinline__ bool next(int i, UnitD& u) const {
        const long L = (long)i * G + c; if (L >= 128 * 4) return false;
        int pm, pn; tile_map((int)L, 128, 4, pm, pn);
        u.A = A + (size_t)pm * 256 * DFF; u.lda2 = DFF; u.B = B + (size_t)pn * 256 * DFF; u.ldb2 = DFF; u.nt = 22; u.pm = pm; u.pn = pn; u.kind = i; return true;
    }
};

#define EPI_LOOP for (int ai = 0; ai < 2; ++ai) _Pragma("unroll") for (int m = 0; m < 4; ++m) _Pragma("unroll") for (int bj = 0; bj < 2; ++bj)
struct EpiStore {
    bf16* O; int ldc; unsigned char* IKC;
    __device__ __forceinline__ void operator()(const f32x4 (&acc)[2][2][4][2], const UnitD& u, int wr, int wc, int fr, int fq, int tid) const {
        const int row0 = u.pm * BM + wr * 64 + fr, col0 = u.pn * BM + wc * 32 + 8 * fq;
#pragma unroll
        EPI_LOOP { const f32x4 v0 = acc[ai][bj][m][0], v1 = acc[ai][bj][m][1];
            u32x4 w; w.x = pk2(v0[0], v0[1]); w.y = pk2(v0[2], v0[3]); w.z = pk2(v1[0], v1[1]); w.w = pk2(v1[2], v1[3]);
            const int R = row0 + ai * HALF + m * 16;
            *(u32x4*)(O + (size_t)R * ldc + col0 + bj * HALF) = w;
            if (bj == 1 && u.pn == 13 && wc == 0) *(u32x4*)(IKC + ((size_t)((R >> 5) * 2 + (fq >> 1)) * 64 + (fq & 1) * 32 + (R & 31)) * 16) = w; }
    }
};
struct EpiSlotStore {
    unsigned char* sc_; int act;
    __device__ __forceinline__ void operator()(const f32x4 (&acc)[2][2][4][2], const UnitD& u, int wr, int wc, int fr, int fq, int tid) const {
        unsigned loff = (unsigned)tid * 16u; asm volatile("" : "+v"(loff));
        unsigned char* sc = sc_ + (size_t)u.kind * 131072 + loff;
#pragma unroll
        EPI_LOOP { const int q = (ai * 2 + bj) * 4 + m; f32x4 v0 = acc[ai][bj][m][0], v1 = acc[ai][bj][m][1];
            if (act) { v0 = (f32x4){sigmoidf_(v0[0]), sigmoidf_(v0[1]), sigmoidf_(v0[2]), sigmoidf_(v0[3])}; v1 = (f32x4){sigmoidf_(v1[0]), sigmoidf_(v1[1]), sigmoidf_(v1[2]), sigmoidf_(v1[3])}; }
            u32x4 w; w.x = pk2(v0[0], v0[1]); w.y = pk2(v0[2], v0[3]); w.z = pk2(v1[0], v1[1]); w.w = pk2(v1[2], v1[3]);
            *(u32x4*)(sc + (size_t)q * 8192) = w; }
    }
};
struct EpiSlotMul {
    unsigned char* sc_;
    __device__ __forceinline__ void operator()(const f32x4 (&acc)[2][2][4][2], const UnitD& u, int wr, int wc, int fr, int fq, int tid) const {
        unsigned loff = (unsigned)tid * 16u; asm volatile("" : "+v"(loff));
        unsigned char* sc = sc_ + (size_t)u.kind * 131072 + loff;
#pragma unroll
        EPI_LOOP { const int q = (ai * 2 + bj) * 4 + m; const f32x4 v0 = acc[ai][bj][m][0], v1 = acc[ai][bj][m][1];
            u32x4* sp = (u32x4*)(sc + (size_t)q * 8192); const u32x4 p = *sp;
            u32x4 w; w.x = pk2(sigmoidf_(v0[0]) * bflo(p.x), sigmoidf_(v0[1]) * bfhi(p.x)); w.y = pk2(sigmoidf_(v0[2]) * bflo(p.y), sigmoidf_(v0[3]) * bfhi(p.y));
            w.z = pk2(sigmoidf_(v1[0]) * bflo(p.z), sigmoidf_(v1[1]) * bfhi(p.z)); w.w = pk2(sigmoidf_(v1[2]) * bflo(p.w), sigmoidf_(v1[3]) * bfhi(p.w));
            *sp = w;
            if (m & 1) asm volatile("" ::: "memory"); }
    }
};
struct EpiBranch {
    const unsigned char* sc_; bf16* MG; int first;
    __device__ __forceinline__ void operator()(const f32x4 (&acc)[2][2][4][2], const UnitD& u, int wr, int wc, int fr, int fq, int tid) const {
        const int row0 = u.pm * BM + wr * 64 + fr, col0 = u.pn * BM + wc * 32 + 8 * fq;
        unsigned loff = (unsigned)tid * 16u; asm volatile("" : "+v"(loff));
        const unsigned char* sc = sc_ + (size_t)u.kind * 131072 + loff;
#pragma unroll
        EPI_LOOP { const int q = (ai * 2 + bj) * 4 + m; const f32x4 v0 = acc[ai][bj][m][0], v1 = acc[ai][bj][m][1];
            const u32x4 g = *(const u32x4*)(sc + (size_t)q * 8192);
            u32x4* p = (u32x4*)(MG + (size_t)(row0 + ai * HALF + m * 16) * DM + col0 + bj * HALF);
            f32x4 t0 = (f32x4){bflo(g.x) * v0[0], bfhi(g.x) * v0[1], bflo(g.y) * v0[2], bfhi(g.y) * v0[3]};
            f32x4 t1 = (f32x4){bflo(g.z) * v1[0], bfhi(g.z) * v1[1], bflo(g.w) * v1[2], bfhi(g.w) * v1[3]};
            if (!first) { const u32x4 x = *p; t0 += (f32x4){bflo(x.x), bfhi(x.x), bflo(x.y), bfhi(x.y)}; t1 += (f32x4){bflo(x.z), bfhi(x.z), bflo(x.w), bfhi(x.w)}; }
            u32x4 w; w.x = pk2(t0[0], t0[1]); w.y = pk2(t0[2], t0[3]); w.z = pk2(t1[0], t1[1]); w.w = pk2(t1[2], t1[3]);
            *p = w;
            if (m & 1) asm volatile("" ::: "memory"); }
    }
};
__device__ __forceinline__ float gelu_tanh_e(float y) { const float t = 1.5957691216057308f * (y + 0.044715f * y * y * y); return y * __builtin_amdgcn_rcpf(1.0f + __builtin_amdgcn_exp2f(-LOG2E * t)); }
__device__ __forceinline__ float dpp_prev1(float prev, float cur) {
    const int o = __builtin_amdgcn_update_dpp(0, __builtin_bit_cast(int, prev), 0x121, 0xf, 0xf, true);
    return __builtin_bit_cast(float, __builtin_amdgcn_update_dpp(o, __builtin_bit_cast(int, cur), 0x111, 0xf, 0xf, false)); }
__device__ __forceinline__ float dpp_prev2(float prev, float cur) {
    const int o = __builtin_amdgcn_update_dpp(0, __builtin_bit_cast(int, prev), 0x122, 0xf, 0xf, true);
    return __builtin_bit_cast(float, __builtin_amdgcn_update_dpp(o, __builtin_bit_cast(int, cur), 0x112, 0xf, 0xf, false)); }
struct EpiUp {
    bf16* GE; bf16* G0; bf16* U0; unsigned char* ACT8; const float* cw; const float* cbias;
    __device__ __forceinline__ void operator()(const f32x4 (&acc)[2][2][4][2], const UnitD& u, int wr, int wc, int fr, int fq, int tid) const {
        const int gc = u.pn * 128 + wc * 32 + 8 * fq; f32x4 wv[8];
        wv[0] = *(const f32x4*)(cw + gc); wv[1] = *(const f32x4*)(cw + gc + 4); wv[2] = *(const f32x4*)(cw + DFF + gc); wv[3] = *(const f32x4*)(cw + DFF + gc + 4);
        wv[4] = *(const f32x4*)(cw + 2 * DFF + gc); wv[5] = *(const f32x4*)(cw + 2 * DFF + gc + 4); wv[6] = *(const f32x4*)(cbias + gc); wv[7] = *(const f32x4*)(cbias + gc + 4);
#pragma unroll
        for (int ai = 0; ai < 2; ++ai) { const int rb = u.pm * 4 + ai * 2 + wr;
#pragma unroll
            for (int m = 0; m < 4; ++m) { const int r = wr * 64 + fr + ai * HALF + m * 16; float o[8];
#pragma unroll
                for (int i = 0; i < 8; ++i) { const float g0_ = acc[ai][0][m][i >> 2][i & 3], gp_ = (m > 0) ? acc[ai][0][m > 0 ? m - 1 : 0][i >> 2][i & 3] : 0.f;
                    const float g1_ = dpp_prev1(gp_, g0_), g2_ = dpp_prev2(gp_, g0_);
                    const float y_ = wv[6 + (i >> 2)][i & 3] + wv[(i >> 2)][i & 3] * g2_ + wv[2 + (i >> 2)][i & 3] * g1_ + wv[4 + (i >> 2)][i & 3] * g0_; o[i] = gelu_tanh_e(y_) * acc[ai][1][m][i >> 2][i & 3]; }
                u32x2 w8; w8.x = pk4f8(o[0], o[1], o[2], o[3]); w8.y = pk4f8(o[4], o[5], o[6], o[7]);
                *(u32x2*)(ACT8 + (size_t)(u.pm * BM + r) * DFF + gc) = w8;
                if (m == 0 || m == 3) { const f32x4 v0 = acc[ai][0][m][0], v1 = acc[ai][0][m][1]; u32x4 w; w.x = pk2(v0[0], v0[1]); w.y = pk2(v0[2], v0[3]); w.z = pk2(v1[0], v1[1]); w.w = pk2(v1[2], v1[3]);
                    if (m == 0 && fr < 2) { *(u32x4*)(G0 + ((size_t)rb * 2 + fr) * DFF + gc) = w;
                        const f32x4 x0 = acc[ai][1][m][0], x1 = acc[ai][1][m][1]; u32x4 wu; wu.x = pk2(x0[0], x0[1]); wu.y = pk2(x0[2], x0[3]); wu.z = pk2(x1[0], x1[1]); wu.w = pk2(x1[2], x1[3]);
                        *(u32x4*)(U0 + ((size_t)rb * 2 + fr) * DFF + gc) = wu; }
                    if (m == 3 && fr >= 14) *(u32x4*)(GE + ((size_t)rb * 2 + (fr - 14)) * DFF + gc) = w; } } }
    }
};
struct EpiG3 {
    bf16* XB;
    __device__ __forceinline__ void operator()(const f32x4 (&acc)[2][2][4][2], const UnitD& u, int wr, int wc, int fr, int fq, int tid) const {
        const int row0 = u.pm * BM + wr * 64 + fr, col0 = u.pn * BM + wc * 32 + 8 * fq;
#pragma unroll
        EPI_LOOP { const f32x4 v0 = acc[ai][bj][m][0], v1 = acc[ai][bj][m][1];
            u32x4* p = (u32x4*)(XB + (size_t)(row0 + ai * HALF + m * 16) * DM + col0 + bj * HALF); const u32x4 x = *p;
            u32x4 w; w.x = pk2(ALPHA * bflo(x.x) + v0[0], ALPHA * bfhi(x.x) + v0[1]); w.y = pk2(ALPHA * bflo(x.y) + v0[2], ALPHA * bfhi(x.y) + v0[3]);
            w.z = pk2(ALPHA * bflo(x.z) + v1[0], ALPHA * bfhi(x.z) + v1[1]); w.w = pk2(ALPHA * bflo(x.w) + v1[2], ALPHA * bfhi(x.w) + v1[3]);
            *p = w; }
    }
};
struct EpiG5b {
    const unsigned char* esc_; bf16* XB;
    __device__ __forceinline__ void operator()(const f32x4 (&acc)[2][2][4][2], const UnitD& u, int wr, int wc, int fr, int fq, int tid) const {
        const int row0 = u.pm * BM + wr * 64 + fr, col0 = u.pn * BM + wc * 32 + 8 * fq;
        unsigned loff = (unsigned)tid * 16u; asm volatile("" : "+v"(loff));
        const unsigned char* esc = esc_ + (size_t)u.kind * 131072 + loff;
#pragma unroll
        EPI_LOOP { const int q = (ai * 2 + bj) * 4 + m; const f32x4 v0 = acc[ai][bj][m][0], v1 = acc[ai][bj][m][1];
            const u32x4 e = *(const u32x4*)(esc + (size_t)q * 8192);
            u32x4* p = (u32x4*)(XB + (size_t)(row0 + ai * HALF + m * 16) * DM + col0 + bj * HALF); const u32x4 x = *p;
            u32x4 w; w.x = pk2(ALPHA * bflo(x.x) + v0[0] + bflo(e.x), ALPHA * bfhi(x.x) + v0[1] + bfhi(e.x)); w.y = pk2(ALPHA * bflo(x.y) + v0[2] + bflo(e.y), ALPHA * bfhi(x.y) + v0[3] + bfhi(e.y));
            w.z = pk2(ALPHA * bflo(x.z) + v1[0] + bflo(e.z), ALPHA * bfhi(x.z) + v1[1] + bfhi(e.z)); w.w = pk2(ALPHA * bflo(x.w) + v1[2] + bflo(e.w), ALPHA * bfhi(x.w) + v1[3] + bfhi(e.w));
            *p = w;
            if (m & 1) asm volatile("" ::: "memory"); }
    }
};
}

struct Frame {
    LAS unsigned char* lds;
    int tid, lane, wave, G, wg;
    unsigned char* ws; unsigned char* dob;
};
struct Args { const float* in[21]; float* out; unsigned char* ws; int ph_lo, ph_hi, sub, pad; };

__device__ __forceinline__ int z_src(int n, float& sc) {
    sc = 1.f;
    if (n < 768) { if (n < 256) sc = 0.17677669529663687f * LOG2E; return n; }
    if (n < 1536) { if (n < 1024) sc = 0.125f * LOG2E; return n; }
    if (n < 2560) { if (n >= 1792 && n < 2048) sc = 0.125f; return 1700 + (n - 1536); }
    if (n < 2816) { if (n < 2688) sc = 0.17677669529663687f; return 2724 + (n - 2560); }
    if (n < 3072) return 2980 + (n - 2816);
    if (n < 3328) return 3252 + (n - 3072);
    if (n < 3456) return 1536 + (n - 3328);
    if (n < 3488) return 1664 + (n - 3456);
    if (n < 3492) return 1696 + (n - 3488);
    if (n >= 3504 && n < 3520) return 3236 + (n - 3504);
    return -1;
}
template <int MODE>
__device__ __forceinline__ void transpose_item(const float* W, int Nsrc, int soff, bf16* WT, int dpitch, int dcol0, int k0, int n0, LAS float* scr, int lane) {
    const int nn = lane & 31; float sc = 1.f; int s;
    if (MODE == 1) s = z_src(n0 + nn, sc); else s = soff + n0 + nn;
#pragma unroll 8
    for (int i = 0; i < 32; ++i) { const int kk = 2 * i + (lane >> 5); scr[kk * 33 + nn] = (s >= 0) ? W[(size_t)(k0 + kk) * Nsrc + s] * sc : 0.f; }
    asm volatile("s_waitcnt lgkmcnt(0)" ::: "memory");
    const int c = lane & 7;
#pragma unroll
    for (int j = 0; j < 4; ++j) { const int n = (lane >> 3) + 8 * j; const LAS float* sp = scr + (8 * c) * 33 + n;
        u32x4 o; o.x = pk2(sp[0 * 33], sp[1 * 33]); o.y = pk2(sp[2 * 33], sp[3 * 33]); o.z = pk2(sp[4 * 33], sp[5 * 33]); o.w = pk2(sp[6 * 33], sp[7 * 33]);
        *(u32x4*)(WT + (size_t)(n0 + n) * dpitch + dcol0 + k0 + 8 * c) = o; }
    asm volatile("s_waitcnt lgkmcnt(0)" ::: "memory");
}
__device__ __forceinline__ void transpose_item8(const float* W, int Nsrc, int soff, unsigned char* WT, int K, int k0, int n0, LAS float* scr, int lane) {
    const int nn = lane & 31; const int s = soff + n0 + nn;
#pragma unroll 8
    for (int i = 0; i < 32; ++i) { const int kk = 2 * i + (lane >> 5); scr[kk * 33 + nn] = W[(size_t)(k0 + kk) * Nsrc + s] * 64.f; }
    asm volatile("s_waitcnt lgkmcnt(0)" ::: "memory");
    const int c = lane & 7;
#pragma unroll
    for (int j = 0; j < 4; ++j) { const int n = (lane >> 3) + 8 * j; const LAS float* sp = scr + (8 * c) * 33 + n;
        u32x2 o; o.x = pk4f8(sp[0 * 33], sp[1 * 33], sp[2 * 33], sp[3 * 33]); o.y = pk4f8(sp[4 * 33], sp[5 * 33], sp[6 * 33], sp[7 * 33]);
        *(u32x2*)(WT + (size_t)(n0 + n) * K + k0 + 8 * c) = o; }
    asm volatile("s_waitcnt lgkmcnt(0)" ::: "memory");
}
__device__ __forceinline__ void transpose_item8z(const float* W, unsigned char* WT, int tile, int slot, int k0, int n0, LAS float* scr, int lane) {
    const int nn = lane & 31; float sc = 1.f; const int s = z_src(tile * 256 + n0 + nn, sc); sc *= 64.f;
#pragma unroll 8
    for (int i = 0; i < 32; ++i) { const int kk = 2 * i + (lane >> 5); scr[kk * 33 + nn] = (s >= 0) ? W[(size_t)(k0 + kk) * NIN + s] * sc : 0.f; }
    asm volatile("s_waitcnt lgkmcnt(0)" ::: "memory");
    const int c = lane & 7;
#pragma unroll
    for (int j = 0; j < 4; ++j) { const int n = (lane >> 3) + 8 * j; const LAS float* sp = scr + (8 * c) * 33 + n;
        u32x2 o; o.x = pk4f8(sp[0 * 33], sp[1 * 33], sp[2 * 33], sp[3 * 33]); o.y = pk4f8(sp[4 * 33], sp[5 * 33], sp[6 * 33], sp[7 * 33]);
        *(u32x2*)(WT + (size_t)(slot * 256 + n0 + n) * 1024 + k0 + 8 * c) = o; }
    asm volatile("s_waitcnt lgkmcnt(0)" ::: "memory");
}
typedef __attribute__((address_space(4))) const struct Args* KArgPtr;
__device__ __forceinline__ void convert_w123(Frame& F, const float* w_in, const float* w_branch, const float* w_out) {
    LAS float* scr = (LAS float*)(F.lds + F.wave * 16384);
    const int gw = F.wg * NWAVES + F.wave, NGW = F.G * NWAVES;
    constexpr int I1 = 16 * 48, I2 = 0, I3 = 4 * 128, I4 = 16 * 32;
    unsigned char* w123 = F.ws + WS_W123;
    for (int it = gw; it < I1 + I2 + I3 + I4; it += NGW) {
        int r = it;
        if (r < I1) { const int nb = r % 48, tile = (int)((G1_BF_TILES >> (4 * (nb >> 3))) & 15); transpose_item<1>(w_in, NIN, 0, (bf16*)(w123 + W123_W1), 1024, 0, 64 * (r / 48), tile * 256 + 32 * (nb & 7), scr, F.lane); continue; } r -= I1;
        if (r < I3) { const int n = r / 128, rr = r % 128; transpose_item<0>(w_branch + (size_t)n * 256 * DM, DM, 0, (bf16*)(w123 + W123_GB + 8 * MiB) + (size_t)n * 1024 * 256, 256, 0, 64 * (rr / 32), 32 * (rr % 32), scr, F.lane); continue; } r -= I3;
        transpose_item<0>(w_out, DM, 0, (bf16*)(w123 + W123_WO), 1024, 0, 64 * (r / 32), 32 * (r % 32), scr, F.lane);
    }
}
__device__ __forceinline__ void p0_prologue(Frame& F, __attribute__((address_space(4))) const Args* Ap) {
    LAS float* scr = (LAS float*)(F.lds + F.wave * 16384);
    const int gw = F.wg * NWAVES + F.wave, NGW = F.G * NWAVES;
    constexpr int I5 = 0, I6 = 0, I7 = 4 * 32, I8 = 0;
    constexpr int IL = I5 + I6 + I7 + I8;
    for (int it = gw; it < 2 * IL; it += NGW) {
        const int l = it / IL; int r = it - l * IL;
        unsigned char* w45 = F.ws + WS_W45 + (size_t)l * W45_STRIDE;
        if (r < I7) { transpose_item<0>(Ap->in[18] + (size_t)l * PDIM * DM, DM, 0, (bf16*)(w45 + W45_PP), 256, 0, 64 * (r / 32), 32 * (r % 32), scr, F.lane); continue; } r -= I7;
        transpose_item<0>(Ap->in[16] + (size_t)l * DFF * DM, DM, 0, (bf16*)(w45 + W45_DN), DFF, 0, 64 * (r / 32), 32 * (r % 32), scr, F.lane);
    }
    {   constexpr int J1 = 16 * 128, J2 = 16 * 176, J3 = 16 * 32, J4 = 44 * 32, J5 = 8 * 16 * 8, JL = J1 + J2 + J3 + J4 + J5;
        for (int it = gw; it < 2 * JL; it += NGW) { const int l = it / JL; int r = it - l * JL; unsigned char* w8 = F.dob + DO_W8 + (size_t)l * W8_STRIDE;
            if (r < J1) { transpose_item8(Ap->in[2] + (size_t)l * DM * NIN, NIN, SRC_MG, w8 + W8_G, 1024, 64 * (r / 128), 32 * (r % 128), scr, F.lane); continue; } r -= J1;
            if (r < J2) { const int sn = 32 * (r % 176), dn = sn < DFF ? (sn >> 7) * 256 + 128 + (sn & 127) : ((sn - DFF) >> 7) * 256 + ((sn - DFF) & 127);
                transpose_item8(Ap->in[13] + (size_t)l * DM * UGW, UGW, sn - dn, w8 + W8_UP, 1024, 64 * (r / 176), dn, scr, F.lane); continue; } r -= J2;
            if (r < J3) { transpose_item8(Ap->in[17] + (size_t)l * DM * DM, DM, 0, w8 + W8_PG, 1024, 64 * (r / 32), 32 * (r % 32), scr, F.lane); continue; } r -= J3;
            if (r < J4) { transpose_item8(Ap->in[16] + (size_t)l * DFF * DM, DM, 0, w8 + W8_DN, DFF, 64 * (r / 32), 32 * (r % 32), scr, F.lane); continue; } r -= J4;
            { const int slot = r >> 7, rr = r & 127; transpose_item8z(Ap->in[2] + (size_t)l * DM * NIN, w8 + W8_Z, (int)((G1_F8_TILES >> (4 * slot)) & 15), slot, 64 * (rr >> 3), 32 * (rr & 7), scr, F.lane); } } }
    convert_w123(F, Ap->in[2], Ap->in[9], Ap->in[10]);
    {   const size_t n8 = (size_t)M * DM / 8; const f32x4* src = (const f32x4*)Ap->in[0]; u32x4* dst = (u32x4*)(F.ws + WS_XB); u32x2* dst8 = (u32x2*)(F.dob + DO_XB8);
        for (size_t i = (size_t)F.wg * 512 + F.tid; i < n8; i += (size_t)F.G * 512) { const f32x4 a = src[2 * i], b = src[2 * i + 1]; u32x4 o; o.x = pk2(a[0], a[1]); o.y = pk2(a[2], a[3]); o.z = pk2(b[0], b[1]); o.w = pk2(b[2], b[3]); dst[i] = o;
            u32x2 o8; o8.x = pk4f8(a[0], a[1], a[2], a[3]); o8.y = pk4f8(b[0], b[1], b[2], b[3]); dst8[i] = o8; } }
    {   const size_t n8 = (size_t)DEPTH * M * PDIM / 8; const f32x4* src = (const f32x4*)Ap->in[1]; u32x4* dst = (u32x4*)(F.ws + WS_PB);
        for (size_t i = (size_t)F.wg * 512 + F.tid; i < n8; i += (size_t)F.G * 512) { const f32x4 a = src[2 * i], b = src[2 * i + 1]; u32x4 o; o.x = pk2(a[0], a[1]); o.y = pk2(a[2], a[3]); o.z = pk2(b[0], b[1]); o.w = pk2(b[2], b[3]); dst[i] = o; } }
}

__device__ __forceinline__ void ln_phase(Frame& F, const float* w, const float* bvec, float* outf, unsigned char* xb8) {
    const int gw = F.wg * NWAVES + F.wave, NGW = F.G * NWAVES;
    bf16* XB = (bf16*)(F.ws + WS_XB);
    for (int row = gw; row < M; row += NGW) {
        u32x4* p = (u32x4*)(XB + (size_t)row * DM) + F.lane;
        const u32x4 a = p[0], b = p[64];
        float v[16] = {bflo(a.x), bfhi(a.x), bflo(a.y), bfhi(a.y), bflo(a.z), bfhi(a.z), bflo(a.w), bfhi(a.w), bflo(b.x), bfhi(b.x), bflo(b.y), bfhi(b.y), bflo(b.z), bfhi(b.z), bflo(b.w), bfhi(b.w)};
        float s = 0.f;
#pragma unroll
        for (int i = 0; i < 16; ++i) s += v[i];
        const float mean = wave_sum(s, F.lane) * (1.f / DM); float q = 0.f;
#pragma unroll
        for (int i = 0; i < 16; ++i) { v[i] -= mean; q += v[i] * v[i]; }
        const float rstd = 1.f / sqrtf(wave_sum(q, F.lane) * (1.f / DM) + LN_EPS);
        const int c0 = F.lane * 8, c1 = 512 + F.lane * 8;
        const f32x4 w0 = *(const f32x4*)(w + c0), w1 = *(const f32x4*)(w + c0 + 4), w2 = *(const f32x4*)(w + c1), w3 = *(const f32x4*)(w + c1 + 4);
        const f32x4 b0 = *(const f32x4*)(bvec + c0), b1 = *(const f32x4*)(bvec + c0 + 4), b2 = *(const f32x4*)(bvec + c1), b3 = *(const f32x4*)(bvec + c1 + 4);
        f32x4 y0, y1, y2, y3;
#pragma unroll
        for (int i = 0; i < 4; ++i) { y0[i] = v[i] * rstd * w0[i] + b0[i]; y1[i] = v[4 + i] * rstd * w1[i] + b1[i]; y2[i] = v[8 + i] * rstd * w2[i] + b2[i]; y3[i] = v[12 + i] * rstd * w3[i] + b3[i]; }
        u32x4 o0, o1; o0.x = pk2(y0[0], y0[1]); o0.y = pk2(y0[2], y0[3]); o0.z = pk2(y1[0], y1[1]); o0.w = pk2(y1[2], y1[3]);
        o1.x = pk2(y2[0], y2[1]); o1.y = pk2(y2[2], y2[3]); o1.z = pk2(y3[0], y3[1]); o1.w = pk2(y3[2], y3[3]);
        p[0] = o0; p[64] = o1;
        if (xb8) { u32x2* q8 = (u32x2*)(xb8 + (size_t)row * DM) + F.lane; u32x2 a8, b8; a8.x = pk4f8(y0[0], y0[1], y0[2], y0[3]); a8.y = pk4f8(y1[0], y1[1], y1[2], y1[3]); b8.x = pk4f8(y2[0], y2[1], y2[2], y2[3]); b8.y = pk4f8(y3[0], y3[1], y3[2], y3[3]); q8[0] = a8; q8[64] = b8; }
        if (outf) { f32x4* op = (f32x4*)(outf + (size_t)row * DM); op[2 * F.lane] = y0; op[2 * F.lane + 1] = y1; op[128 + 2 * F.lane] = y2; op[128 + 2 * F.lane + 1] = y3; }
    }
}

__device__ __forceinline__ float gelu_tanh_(float y) { const float t = 1.5957691216057308f * (y + 0.044715f * y * y * y); return y * __builtin_amdgcn_rcpf(1.0f + __builtin_amdgcn_exp2f(-LOG2E * t)); }
__device__ __forceinline__ void ffn_act_phase(Frame& F, const float* cw, const float* cb) {
    const bf16* GE = (const bf16*)(F.ws + WS_GE); const bf16* G0 = (const bf16*)(F.ws + WS_G0); const bf16* U0 = (const bf16*)(F.ws + WS_U0); unsigned char* ACT8 = F.ws + WS_ACT8;
    for (int idx = F.wg * 512 + F.tid; idx < 512 * 2 * 352; idx += F.G * 512) {
        const int v = idx % 352, t = idx / 352, r = t & 1, rb = t >> 1; const int gc = 8 * v;
        const size_t eb = (size_t)rb * 2 * DFF + gc, ebp = (size_t)(rb - 1) * 2 * DFF + gc; const bool first = (rb & 127) == 0;
        const u32x4 z4 = (u32x4){0u, 0u, 0u, 0u};
        float gA[8], gB[8], gC[8], uu[8];
        if (r == 0) { up8(first ? z4 : *(const u32x4*)(GE + ebp), gA); up8(first ? z4 : *(const u32x4*)(GE + ebp + DFF), gB); up8(*(const u32x4*)(G0 + eb), gC); }
        else { up8(first ? z4 : *(const u32x4*)(GE + ebp + DFF), gA); up8(*(const u32x4*)(G0 + eb), gB); up8(*(const u32x4*)(G0 + eb + DFF), gC); }
        up8(*(const u32x4*)(U0 + eb + (size_t)r * DFF), uu);
        float o[8];
#pragma unroll
        for (int i = 0; i < 8; ++i) { const float y = cb[gc + i] + cw[gc + i] * gA[i] + cw[DFF + gc + i] * gB[i] + cw[2 * DFF + gc + i] * gC[i]; o[i] = gelu_tanh_(y) * uu[i]; }
        u32x2 w8; w8.x = pk4f8(o[0], o[1], o[2], o[3]); w8.y = pk4f8(o[4], o[5], o[6], o[7]);
        *(u32x2*)(ACT8 + (size_t)(rb * 64 + r) * DFF + gc) = w8;
    }
}

namespace mx {
__device__ __forceinline__ f32x16 mfma32(bf16x8 a, bf16x8 b, f32x16 c) { return __builtin_amdgcn_mfma_f32_32x32x16_bf16(a, b, c, 0, 0, 0); }
__device__ __forceinline__ f32x16 splat16(float v) { f32x16 r;
#pragma unroll
    for (int i = 0; i < 16; ++i) r[i] = v;
    return r; }
__device__ __forceinline__ int crow_c(int e) { return (e & 3) + 8 * (e >> 2); }
typedef short v4i16_t __attribute__((ext_vector_type(4)));
__device__ __forceinline__ s16x4 vtr(const LAS unsigned char* p) { return __builtin_bit_cast(s16x4, __builtin_amdgcn_ds_read_tr16_b64_v4i16((LAS v4i16_t*)p)); }
__device__ __forceinline__ bf16x8 pack8(float a0, float a1, float a2, float a3, float a4, float a5, float a6, float a7) {
    u32x4 w; w.x = pk2(a0, a1); w.y = pk2(a2, a3); w.z = pk2(a4, a5); w.w = pk2(a6, a7); return __builtin_bit_cast(bf16x8, w); }

__device__ __forceinline__ bf16x8 tr_frag(const LAS unsigned char* T, int key0, int cblk, int lane) {
    const LAS unsigned char* p = T + (key0 + 4 * (lane >> 5) + ((lane & 15) >> 2)) * 144 + (32 * cblk + 16 * ((lane >> 4) & 1) + 4 * (lane & 3)) * 2;
    const s16x4 lo = vtr(p), hi = vtr(p + 8 * 144); return (bf16x8){lo[0], lo[1], lo[2], lo[3], hi[0], hi[1], hi[2], hi[3]}; }
__device__ __forceinline__ float log2gam(int h) { return __builtin_log2f(1.0f - __builtin_exp2f(-5.0f - (float)h)); }
__device__ __forceinline__ void prepkv_unit(Frame& F, int blk, const float* wa2, const float* bap, unsigned* kmaxl) {
    bf16* Z = (bf16*)(F.ws + WS_Z);
    const size_t r0 = (size_t)blk * 256; const int b = blk >> 5, cb = blk & 31;
    const int tid = F.tid;
    {   const int ch = tid >> 7, col = tid & 127;
        const float ba = bap[col];
        float wa[16];
#pragma unroll
        for (int r = 0; r < 16; ++r) wa[r] = wa2[r * 128 + col];
        float cum = 0.f;
        for (int t0 = 0; t0 < 64; t0 += 8) { u32x4 A[8], B[8];
#pragma unroll
            for (int tt = 0; tt < 8; ++tt) { const bf16* zr = Z + (r0 + ch * 64 + t0 + tt) * ZW; A[tt] = *(const u32x4*)(zr + ZC_DA); B[tt] = *(const u32x4*)(zr + ZC_DA + 8); }
#pragma unroll
            for (int tt = 0; tt < 8; ++tt) { float da[8], db[8]; up8(A[tt], da); up8(B[tt], db); float x = ba;
#pragma unroll
                for (int r = 0; r < 8; ++r) x += da[r] * wa[r];
#pragma unroll
                for (int r = 0; r < 8; ++r) x += db[r] * wa[8 + r];
                cum += (fminf(x, 0.f) - __logf(1.0f + __expf(-fabsf(x)))) * 0.0625f; } }
        const float bl = cum; cum = 0.f;
        for (int t0 = 0; t0 < 64; t0 += 8) { u32x4 A[8], B[8]; bf16 qv[8], kv[8];
#pragma unroll
            for (int tt = 0; tt < 8; ++tt) { const bf16* zr = Z + (r0 + ch * 64 + t0 + tt) * ZW; A[tt] = *(const u32x4*)(zr + ZC_DA); B[tt] = *(const u32x4*)(zr + ZC_DA + 8); qv[tt] = zr[ZC_DQ + col]; kv[tt] = zr[ZC_DK + col]; }
#pragma unroll
            for (int tt = 0; tt < 8; ++tt) { bf16* zr = Z + (r0 + ch * 64 + t0 + tt) * ZW; float da[8], db[8]; up8(A[tt], da); up8(B[tt], db); float x = ba;
#pragma unroll
                for (int r = 0; r < 8; ++r) x += da[r] * wa[r];
#pragma unroll
                for (int r = 0; r < 8; ++r) x += db[r] * wa[8 + r];
                cum += (fminf(x, 0.f) - __logf(1.0f + __expf(-fabsf(x)))) * 0.0625f;
                zr[ZC_DQ + col] = (bf16)f2bf(bf1(qv[tt]) * __expf(cum - bl)); zr[ZC_DK + col] = (bf16)f2bf(bf1(kv[tt]) * __expf(bl - cum)); } }
        ((float*)(F.ws + WS_DE))[((size_t)b * 128 + cb * 4 + ch) * 128 + col] = __expf(bl);
    }
    for (int itn = 0; itn < 6; ++itn) { const int task = tid + 512 * itn, sl = task >> 8, row = task & 255;
        const bf16* kp = Z + (r0 + row) * ZW + (sl < 8 ? ZC_AK + (sl >> 1) * 64 + (sl & 1) * 32 : ZC_BK + (sl - 8) * 64); float ss = 0.f;
        const int nch = sl < 8 ? 4 : 8;
        for (int c = 0; c < nch; ++c) { float v[8]; up8(*(const u32x4*)(kp + 8 * c), v);
#pragma unroll
            for (int i = 0; i < 8; ++i) ss += v[i] * v[i]; }
#pragma unroll
        for (int o = 1; o < 64; o <<= 1) ss = fmaxf(ss, shx(ss, F.lane, o));
        if (F.lane == 0) __hip_atomic_fetch_max(kmaxl + b * 16 + sl, __float_as_uint(sqrtf(ss)), __ATOMIC_RELAXED, __HIP_MEMORY_SCOPE_AGENT); }
    for (int i0 = 0; i0 < 32; i0 += 4) { u32x4 vv[4];
#pragma unroll
        for (int k = 0; k < 4; ++k) { const int idx = tid + 512 * (i0 + k); const int row = idx >> 6, chunk = idx & 63, isk = chunk >> 5, c8 = (chunk & 31) * 8;
            vv[k] = *(const u32x4*)(Z + (r0 + row) * ZW + (isk ? ZC_CK : ZC_CQ) + c8); }
#pragma unroll
        for (int k = 0; k < 4; ++k) { const int idx = tid + 512 * (i0 + k); const int row = idx >> 6, chunk = idx & 63, isk = chunk >> 5, c8 = (chunk & 31) * 8, h = c8 >> 6;
            const float e = (float)(255 - row) * log2gam(h); const float f = __builtin_amdgcn_exp2f(isk ? e : -e); float v[8]; up8(vv[k], v);
            u32x4 w; w.x = pk2(v[0] * f, v[1] * f); w.y = pk2(v[2] * f, v[3] * f); w.z = pk2(v[4] * f, v[5] * f); w.w = pk2(v[6] * f, v[7] * f);
            *(u32x4*)(Z + (r0 + row) * ZW + (isk ? ZC_CK : ZC_CQ) + c8) = w; } }
    __threadfence_block(); __syncthreads();
    LAS unsigned char* Kl = F.lds; LAS unsigned char* Vl = F.lds + 36864;
    for (int h = 0; h < 4; ++h) {
        for (int idx = tid; idx < 256 * 8; idx += 512) { const int row = idx >> 3, c = idx & 7;
            *(LAS u32x4*)(Kl + row * 144 + c * 16) = *(const u32x4*)(Z + (r0 + row) * ZW + ZC_CK + h * 64 + c * 8);
            *(LAS u32x4*)(Vl + row * 144 + c * 16) = *(const u32x4*)(Z + (r0 + row) * ZW + ZC_CV + h * 64 + c * 8); }
        __syncthreads();
        if (F.wave < 4) {
            const int db = F.wave & 1, nb = F.wave >> 1; f32x16 acc = splat16(0.f);
#pragma unroll 4
            for (int kb = 0; kb < 16; ++kb) acc = mfma32(tr_frag(Vl, 16 * kb, db, F.lane), tr_frag(Kl, 16 * kb, nb, F.lane), acc);
            float* o = (float*)(F.ws + WS_KVC) + ((size_t)((b * 4 + h) * 32 + cb) * 4096) + 32 * nb + (F.lane & 31);
#pragma unroll
            for (int e = 0; e < 16; ++e) o[(32 * db + crow_c(e) + 4 * (F.lane >> 5)) * 64] = acc[e]; }
        __syncthreads();
        for (int idx = tid; idx < 256 * 8; idx += 512) { const int row = idx >> 3, c = idx & 7;
            if (c < 4) *(LAS u32x4*)(Kl + row * 144 + c * 16) = *(const u32x4*)(Z + (r0 + row) * ZW + ZC_DK + h * 32 + c * 8);
            *(LAS u32x4*)(Vl + row * 144 + c * 16) = *(const u32x4*)(Z + (r0 + row) * ZW + ZC_DV + h * 64 + c * 8); }
        __syncthreads();
        {   const int ch = F.wave >> 1, db = F.wave & 1; f32x16 acc = splat16(0.f);
#pragma unroll
            for (int kb = 0; kb < 4; ++kb) acc = mfma32(tr_frag(Vl, 64 * ch + 16 * kb, db, F.lane), tr_frag(Kl, 64 * ch + 16 * kb, 0, F.lane), acc);
            float* o = (float*)(F.ws + WS_KVD) + ((size_t)((b * 4 + h) * 128 + cb * 4 + ch) * 2048) + (F.lane & 31);
#pragma unroll
            for (int e = 0; e < 16; ++e) o[(32 * db + crow_c(e) + 4 * (F.lane >> 5)) * 32] = acc[e]; }
        __syncthreads();
    }
}

__device__ __forceinline__ void scan_phase(Frame& F) {
    const int gt = F.wg * 512 + F.tid, NT = F.G * 512;
    for (int e0 = gt; e0 < 16 * 4096 + 16 * 2048; e0 += NT) {
        if (e0 < 16 * 4096) { const int e = e0;
            const int bh = e >> 12, idx = e & 4095, h = bh & 3; const float g256 = __builtin_amdgcn_exp2f(256.0f * log2gam(h));
            float* p = (float*)(F.ws + WS_KVC) + (size_t)bh * 32 * 4096 + idx; float S = 0.f; float kv[32];
#pragma unroll
            for (int c = 0; c < 32; ++c) kv[c] = p[(size_t)c * 4096];
#pragma unroll
            for (int c = 0; c < 32; ++c) { const float Sp = g256 * S; p[(size_t)c * 4096] = Sp; S = Sp + kv[c]; }
        } else { const int e = e0 - 16 * 4096;
            const int bh = e >> 11, idx = e & 2047, b = bh >> 2, h = bh & 3, dk = idx & 31;
            float* p = (float*)(F.ws + WS_KVD) + (size_t)bh * 128 * 2048 + idx; const float* de = (const float*)(F.ws + WS_DE) + (size_t)b * 128 * 128 + h * 32 + dk; float S = 0.f;
            for (int c0 = 0; c0 < 128; c0 += 16) { float kv[16], dd[16];
#pragma unroll
                for (int c = 0; c < 16; ++c) { kv[c] = p[(size_t)(c0 + c) * 2048]; dd[c] = de[(c0 + c) * 128]; }
#pragma unroll
                for (int c = 0; c < 16; ++c) { const float Sp = dd[c] * S; p[(size_t)(c0 + c) * 2048] = Sp; S = Sp + kv[c]; } }
        }
    }
}

constexpr int HPITCH = 1026, CAP = 256;
struct QState { unsigned mode, thr_lo, thr_hi, thr_idx, krem, lcount, pad0, pad1; };
__device__ __forceinline__ unsigned okey_of(float s) { const unsigned u = __float_as_uint(s); return u ^ ((unsigned)((int)u >> 31) | 0x80000000u); }
__device__ __forceinline__ void b1_load(const unsigned char* IKb, int t, int lane, bf16x8& k0, bf16x8& k1) {
    const unsigned char* p = IKb + (size_t)t * 2048 + lane * 16; k0 = *(const bf16x8*)p; k1 = *(const bf16x8*)(p + 1024); }
__device__ __forceinline__ void b1_scores(const bf16x8 k0, const bf16x8 k1, const bf16x8 (&iqf)[4][2], const float (&w)[4], float (&sc)[16]) {
#pragma unroll
    for (int e = 0; e < 16; ++e) sc[e] = 0.f;
#pragma unroll
    for (int ih = 0; ih < 4; ++ih) { f32x16 lg = mfma32(k0, iqf[ih][0], splat16(0.f)); lg = mfma32(k1, iqf[ih][1], lg);
#pragma unroll
        for (int e = 0; e < 16; ++e) sc[e] = fmaf(w[ih], __builtin_amdgcn_fmed3f(lg[e], 0.f, __builtin_inff()), sc[e]); }
}
__device__ __forceinline__ void b1_setbit(unsigned* MWq, unsigned j) {
    const unsigned wi = j & 31u, hh = (wi >> 2) & 1u, e = (wi & 3u) + 4u * (wi >> 3), kh = (j >> 5) & 1u;
    __hip_atomic_fetch_or(MWq + (size_t)(j >> 6) * 64 + 32u * hh, 1u << (e + 16u * kh), __ATOMIC_RELAXED, __HIP_MEMORY_SCOPE_AGENT);
}
template <bool DIAG>
__device__ __forceinline__ void b1_hist_tile(LAS unsigned* hrow, const float (&sc)[16], int jbase, int qpos) {
#pragma unroll
    for (int e = 0; e < 16; ++e) { if (!DIAG || jbase + crow_c(e) <= qpos) { const unsigned bin = okey_of(sc[e]) >> 21;
        __hip_atomic_fetch_add(hrow + (bin >> 1), 1u << ((bin & 1) * 16), __ATOMIC_RELAXED, __HIP_MEMORY_SCOPE_WORKGROUP); } }
}
template <bool DIAG>
__device__ __forceinline__ unsigned b1_mask_tile(const float (&sc)[16], int jbase, int qpos, float tlo_f, float thi_f, unsigned mode, unsigned word, LAS QState* qs, LAS unsigned char* lds, int r) {
#pragma unroll
    for (int e = 15; e >= 0; --e) { const float s = sc[e]; const int j = jbase + crow_c(e); const bool valid = !DIAG || (j <= qpos);
        if (DIAG) word = word + word + ((valid && s > thi_f) ? 1u : 0u);
        else asm("v_cmp_gt_f32 vcc, %1, %2\n\tv_addc_co_u32 %0, vcc, %0, %0, vcc" : "+v"(word) : "v"(s), "v"(thi_f) : "vcc");
        if (valid && s >= tlo_f && !(s > thi_f)) {
            if (mode == 1u) { const unsigned pos = __hip_atomic_fetch_add(&qs->lcount, 1u, __ATOMIC_RELAXED, __HIP_MEMORY_SCOPE_WORKGROUP);
                if (pos < (unsigned)CAP) { LAS unsigned* le = (LAS unsigned*)(lds + ((size_t)r * CAP + pos) * 8); le[0] = okey_of(s); le[1] = (unsigned)j; } }
            else __hip_atomic_fetch_or((LAS unsigned*)(lds + 65536 + r * 1024) + (j >> 5), 1u << (j & 31), __ATOMIC_RELAXED, __HIP_MEMORY_SCOPE_WORKGROUP); } }
    return word;
}
__device__ __forceinline__ float b1_fkey(unsigned k) { return __uint_as_float((k & 0x80000000u) ? (k ^ 0x80000000u) : ~k); }
__device__ __forceinline__ void b1_unit(Frame& F, int b, int g) {
    const int tid = F.tid, lane = F.lane, r = lane & 31, hh = lane >> 5, wid = F.wave;
    const bf16* Zb = (const bf16*)(F.ws + WS_Z) + (size_t)b * SEQ * ZW;
    const unsigned char* IKb = F.ws + WS_IKC + (size_t)b * (SEQ / 32) * 2048;
    LAS unsigned* hist = (LAS unsigned*)F.lds;
    LAS QState* qst = (LAS QState*)(F.lds + QST_OFF);
    const int qpos = 32 * g + r;
    unsigned* MWb = (unsigned*)(F.ws + WS_MASK) + ((size_t)(b * 256 + g) * 128) * 64;
    bf16x8 iqf[4][2]; float w[4];
    {   const bf16* qr = Zb + (size_t)qpos * ZW;
#pragma unroll
        for (int ih = 0; ih < 4; ++ih) { iqf[ih][0] = *(const bf16x8*)(qr + ZC_IQ + ih * 32 + 8 * hh); iqf[ih][1] = *(const bf16x8*)(qr + ZC_IQ + ih * 32 + 16 + 8 * hh); w[ih] = bf1(qr[ZC_IW + ih]); } }
    if (g >= 8) {
        for (int i = tid; i < 32 * HPITCH; i += 512) hist[i] = 0u;
        __syncthreads();
        {   LAS unsigned* hrow = hist + r * HPITCH;
            bf16x8 a0 = iqf[0][0], a1 = iqf[0][0], c0 = iqf[0][0], c1 = iqf[0][0]; int t = wid;
            if (t <= g) b1_load(IKb, t, lane, a0, a1);
            if (t + 8 <= g) b1_load(IKb, t + 8, lane, c0, c1);
            for (; t < g; t += 8) { const bf16x8 k0 = a0, k1 = a1; a0 = c0; a1 = c1; if (t + 16 <= g) b1_load(IKb, t + 16, lane, c0, c1);
                float sc[16]; b1_scores(k0, k1, iqf, w, sc); b1_hist_tile<false>(hrow, sc, 32 * t + 4 * hh, qpos); }
            if (t == g) { float sc[16]; b1_scores(a0, a1, iqf, w, sc); b1_hist_tile<true>(hrow, sc, 32 * t + 4 * hh, qpos); } }
        __syncthreads();
        for (int qq = 0; qq < 4; ++qq) { const int q = 4 * wid + qq; const LAS unsigned* hq = hist + q * HPITCH;
            const int wbase = 1008 - 16 * lane; unsigned s = 0;
#pragma unroll
            for (int k = 0; k < 16; ++k) { const unsigned x = hq[wbase + k]; s += (x & 0xffffu) + (x >> 16); }
            unsigned P = s;
#pragma unroll
            for (int o = 1; o < 64; o <<= 1) { const unsigned t = shup(P, lane, o); if (lane >= o) P += t; }
            const unsigned long long bal = __ballot(P >= 256u);
            const int Lsel = bal ? __builtin_ctzll(bal) : 63;
            if (lane == Lsel) { unsigned cum = P - s; unsigned b1 = 0, cin = 0, cab = 0;
                for (int k = 0; k < 32; ++k) { const int bin = 2047 - 32 * lane - k; const unsigned x = hq[bin >> 1]; const unsigned c = (bin & 1) ? (x >> 16) : (x & 0xffffu);
                    if (cum + c >= 256u) { b1 = (unsigned)bin; cin = c; cab = cum; break; } cum += c; }
                qst[q].thr_lo = b1 << 21; qst[q].thr_hi = (b1 << 21) | 0x1fffffu; qst[q].thr_idx = 0xffffu; qst[q].krem = 256u - cab; qst[q].lcount = 0u; qst[q].pad0 = cin; qst[q].pad1 = 0u;
                qst[q].mode = (b1 == 1024u || cin > (unsigned)CAP) ? 2u : 1u; }
        }
        __syncthreads();
        for (int i = tid; i < 32 * 256; i += 512) ((LAS unsigned*)(F.lds + 65536))[i] = 0u;
        __syncthreads();
    }
    {   unsigned mode = 0u; float tlo_f = __builtin_inff(), thi_f = -__builtin_inff();
        if (g >= 8) { mode = qst[r].mode; const unsigned tlo = qst[r].thr_lo, thi = qst[r].thr_hi; tlo_f = b1_fkey(tlo); thi_f = (thi == 0x7fffffffu) ? __uint_as_float(0x80000001u) : b1_fkey(thi); }
        const int nk = g >> 1; LAS QState* qs = &qst[r];
        bf16x8 a0 = iqf[0][0], a1 = iqf[0][0], a2 = iqf[0][0], a3 = iqf[0][0], c0 = iqf[0][0], c1 = iqf[0][0], c2 = iqf[0][0], c3 = iqf[0][0]; int kt = wid;
        if (kt <= nk) { b1_load(IKb, 2 * kt, lane, a0, a1); if (2 * kt + 1 <= g) b1_load(IKb, 2 * kt + 1, lane, a2, a3); }
        if (kt + 8 <= nk) { b1_load(IKb, 2 * kt + 16, lane, c0, c1); if (2 * kt + 17 <= g) b1_load(IKb, 2 * kt + 17, lane, c2, c3); }
        for (; kt < nk; kt += 8) {
            const bf16x8 k0 = a0, k1 = a1, k2 = a2, k3 = a3; a0 = c0; a1 = c1; a2 = c2; a3 = c3;
            if (kt + 16 <= nk) { b1_load(IKb, 2 * kt + 32, lane, c0, c1); if (2 * kt + 33 <= g) b1_load(IKb, 2 * kt + 33, lane, c2, c3); }
            unsigned word = 0u;
            { float sc[16]; b1_scores(k2, k3, iqf, w, sc); word = b1_mask_tile<false>(sc, 32 * (2 * kt + 1) + 4 * hh, qpos, tlo_f, thi_f, mode, word, qs, F.lds, r); }
            { float sc[16]; b1_scores(k0, k1, iqf, w, sc); word = b1_mask_tile<false>(sc, 32 * (2 * kt) + 4 * hh, qpos, tlo_f, thi_f, mode, word, qs, F.lds, r); }
            MWb[(size_t)kt * 64 + lane] = word; }
        if (kt == nk) {
            unsigned word = 0u;
            if (2 * kt + 1 <= g) { float sc[16]; b1_scores(a2, a3, iqf, w, sc); word = b1_mask_tile<true>(sc, 32 * (2 * kt + 1) + 4 * hh, qpos, tlo_f, thi_f, mode, word, qs, F.lds, r); }
            word <<= (2 * kt + 1 <= g) ? 0 : 16;
            { float sc[16]; b1_scores(a0, a1, iqf, w, sc); word = b1_mask_tile<true>(sc, 32 * (2 * kt) + 4 * hh, qpos, tlo_f, thi_f, mode, word, qs, F.lds, r); }
            MWb[(size_t)kt * 64 + lane] = word; }
    }
    __syncthreads();
    if (g >= 8) {
        for (int qq = 0; qq < 4; ++qq) { const int q = 4 * wid + qq; const unsigned mode = qst[q].mode, krem = qst[q].krem; unsigned* MWq = MWb + q;
            if (mode == 1u) {
                unsigned L = qst[q].lcount; if (L > (unsigned)CAP) L = CAP; const LAS unsigned* lb = (const LAS unsigned*)(F.lds + (size_t)q * CAP * 8);
                unsigned long long comp[4]; bool has[4]; unsigned jj[4];
#pragma unroll
                for (int k = 0; k < 4; ++k) { const unsigned c = lane + 64 * k; has[k] = c < L; const unsigned ok = has[k] ? lb[2 * c] : 0u; jj[k] = has[k] ? lb[2 * c + 1] : 0u;
                    comp[k] = ((unsigned long long)(ok & 0x1fffffu) << 13) | (unsigned long long)(8191u - jj[k]); }
                unsigned long long prefix = 0ull; unsigned need = krem;
                for (int bit = 33; bit >= 0; --bit) { const unsigned long long want = (prefix >> bit) | 1ull; unsigned cnt = 0;
#pragma unroll
                    for (int k = 0; k < 4; ++k) cnt += (unsigned)__builtin_popcountll(__ballot(has[k] && ((comp[k] >> bit) == want)));
                    if (cnt >= need) prefix |= (1ull << bit); else need -= cnt; }
#pragma unroll
                for (int k = 0; k < 4; ++k) if (has[k] && comp[k] >= prefix) b1_setbit(MWq, jj[k]); }
            else { const LAS unsigned* bm = (const LAS unsigned*)(F.lds + 65536 + q * 1024); unsigned x[4]; unsigned s = 0;
#pragma unroll
                for (int k = 0; k < 4; ++k) { x[k] = bm[4 * lane + k]; s += __builtin_popcount(x[k]); }
                unsigned P = s;
#pragma unroll
                for (int o = 1; o < 64; o <<= 1) { const unsigned t = shup(P, lane, o); if (lane >= o) P += t; }
                unsigned before = P - s;
#pragma unroll
                for (int k = 0; k < 4; ++k) { unsigned y = x[k]; while (y != 0u && before < krem) { const unsigned bit = (unsigned)__builtin_ctz(y); y &= y - 1u; b1_setbit(MWq, 32u * (4 * lane + k) + bit); ++before; } before += __builtin_popcount(y); } }
        }
        __syncthreads();
    }
}

struct EngP { const bf16* Z; bf16* Y; const unsigned* MASK; const float* ST; const float* nw; float lam, lam_init; const unsigned* kmax; };
__device__ __forceinline__ int wq_next(Frame& F, unsigned* head) {
    LAS int* slot = (LAS int*)(F.lds + 55312);
    if (F.tid == 0) *slot = (int)__hip_atomic_fetch_add(head, 1u, __ATOMIC_RELAXED, __HIP_MEMORY_SCOPE_AGENT);
    __syncthreads(); const int u = *slot; __syncthreads();
    asm volatile("" : "+v"(F.tid), "+v"(F.lane));
    return u;
}
template <int MODE>
__device__ __forceinline__ void eng_unit(Frame& F, const EngP& P, int b, int h, int qb) {
    constexpr bool SOFT = MODE <= 1;
    constexpr int NMAP = MODE == 0 ? 2 : 1;
    constexpr int NS = (MODE == 0 || MODE == 3) ? 2 : 4;
    constexpr int KCH = MODE == 3 ? 4 : 8;
    constexpr int QC = MODE == 0 ? ZC_AQ : MODE == 1 ? ZC_BQ : MODE == 2 ? ZC_CQ : ZC_DQ;
    constexpr int KC = MODE == 0 ? ZC_AK : MODE == 1 ? ZC_BK : MODE == 2 ? ZC_CK : ZC_DK;
    constexpr int VC = MODE == 0 ? ZC_AV : MODE == 1 ? ZC_BV : MODE == 2 ? ZC_CV : ZC_DV;
    constexpr int HW = MODE == 3 ? 32 : 64;
    const int tid = F.tid, lane = F.lane, r = lane & 31, hh = lane >> 5, w = F.wave;
    const size_t rowbase = (size_t)b * SEQ;
    const int qw0 = qb * 256 + 32 * w;
    const float NEG = -__builtin_inff();
    const int hidx = MODE <= 1 ? (MODE == 0 ? 2 * h + 1 : 2 * h + 2) : 0;
    const float slope2 = SOFT ? __builtin_amdgcn_exp2f(-(float)hidx) * LOG2E : 0.f;
    bf16x8 qf[NMAP][NS];
    {   const bf16* qrow = P.Z + (rowbase + qw0 + r) * ZW + QC + h * HW;
#pragma unroll
        for (int m = 0; m < NMAP; ++m)
#pragma unroll
            for (int s = 0; s < NS; ++s) qf[m][s] = *(const bf16x8*)(qrow + m * 32 + 16 * s + 8 * hh); }
    f32x16 cinit;
#pragma unroll
    for (int e = 0; e < 16; ++e) cinit[e] = SOFT ? slope2 * (float)(crow_c(e) + 4 * hh) : 0.f;
    float m_run[NMAP], l_run[NMAP]; f32x16 O[NMAP][2];
#pragma unroll
    for (int m = 0; m < NMAP; ++m) { m_run[m] = NEG; l_run[m] = 0.f; O[m][0] = splat16(0.f); O[m][1] = splat16(0.f); }
    if (!SOFT) {
        const int sidx = MODE == 2 ? ((b * 4 + h) * 32 + qb) : ((b * 4 + h) * 128 + 4 * qb + (w >> 1));
        const float* sp = P.ST + (size_t)sidx * (64 * HW);
#pragma unroll
        for (int db = 0; db < 2; ++db)
#pragma unroll
            for (int s = 0; s < NS; ++s) { const float* a = sp + (size_t)(32 * db + r) * HW + 16 * s + 8 * hh; const f32x4 a0 = *(const f32x4*)a, a1 = *(const f32x4*)(a + 4);
                O[0][db] = mfma32(pack8(a0[0], a0[1], a0[2], a0[3], a1[0], a1[1], a1[2], a1[3]), qf[0][s], O[0][db]); }
    }
    const int kt_lo = SOFT ? 0 : 4 * qb, kt_hi = 4 * qb + 3;
    const int srow = tid >> 3, sch = tid & 7;
    float qk[NMAP];
    if (SOFT) {
#pragma unroll
        for (int m = 0; m < NMAP; ++m) { float ss = 0.f;
#pragma unroll
            for (int s = 0; s < NS; ++s) { const u32x4 qq = __builtin_bit_cast(u32x4, qf[m][s]); float v[8]; up8(qq, v);
#pragma unroll
                for (int i = 0; i < 8; ++i) ss += v[i] * v[i]; }
            ss += shx(ss, lane, 32);
            qk[m] = 1.02f * sqrtf(ss) * __uint_as_float(P.kmax[b * 16 + (MODE == 0 ? (h * 2 + m) : (8 + h))]) + 0.01f; }
    }
    LAS unsigned* wflag = (LAS unsigned*)(F.lds + 55296);
    if (SOFT && tid < 3) wflag[tid] = 0u;
    const int kt_first = SOFT ? kt_hi : kt_lo;
    const int nit = kt_hi - kt_lo + 1;
    u32x4 kreg = (u32x4){0u, 0u, 0u, 0u}, vreg;
    {   const bf16* zr = P.Z + (rowbase + 64 * kt_first + srow) * ZW;
        if (sch < KCH) kreg = *(const u32x4*)(zr + KC + h * HW + sch * 8);
        vreg = *(const u32x4*)(zr + VC + h * 64 + sch * 8);
        if (sch < KCH) *(LAS u32x4*)(F.lds + srow * 144 + sch * 16) = kreg;
        *(LAS u32x4*)(F.lds + 9216 + srow * 144 + sch * 16) = vreg;
        if (nit > 1) { const bf16* z1 = P.Z + (rowbase + 64 * (SOFT ? kt_first - 1 : kt_first + 1) + srow) * ZW;
            if (sch < KCH) kreg = *(const u32x4*)(z1 + KC + h * HW + sch * 8);
            vreg = *(const u32x4*)(z1 + VC + h * 64 + sch * 8); } }
    __syncthreads();
    bool wave_done = false;
    const unsigned* mwp = (MODE == 1) ? P.MASK + ((size_t)(b * 256 + qb * 8 + w) * 128) * 64 + lane : nullptr;
    unsigned mwn = 0xffffffffu; if (MODE == 1) mwn = mwp[(size_t)kt_first * 64];
    int sl_cur = 0, sl_nxt = 18432;
    for (int it = 0; it < nit; ++it) {
        const int kt = SOFT ? kt_hi - it : kt_lo + it, ktn = SOFT ? kt - 1 : kt + 1;
        const bool more = it + 1 < nit;
        const unsigned mw = mwn;
        if (more) { if (sch < KCH) *(LAS u32x4*)(F.lds + sl_nxt + srow * 144 + sch * 16) = kreg;
            *(LAS u32x4*)(F.lds + sl_nxt + 9216 + srow * 144 + sch * 16) = vreg;
            if (MODE == 1) mwn = mwp[(size_t)ktn * 64]; }
        if (it + 2 < nit) { const bf16* zr = P.Z + (rowbase + 64 * (SOFT ? kt - 2 : kt + 2) + srow) * ZW;
            if (sch < KCH) kreg = *(const u32x4*)(zr + KC + h * HW + sch * 8);
            vreg = *(const u32x4*)(zr + VC + h * 64 + sch * 8); }
        const int j0 = 64 * kt;
        const bool act = ((MODE == 3) ? (kt == 4 * qb + (w >> 1)) : (j0 <= qw0 + 31)) && !wave_done;
        if (act) {
            const LAS unsigned char* Kb = F.lds + sl_cur; const LAS unsigned char* Vb = F.lds + sl_cur + 9216;
            const bool hact1 = (j0 + 32 <= qw0 + 31);
#pragma unroll
            for (int m = 0; m < NMAP; ++m) {
                f32x16 st[2];
#pragma unroll
                for (int kh = 0; kh < 2; ++kh) {
                    if (kh == 0 || hact1) {
                        f32x16 a = cinit;
#pragma unroll
                        for (int s = 0; s < NS; ++s) { const bf16x8 kf = *(const LAS bf16x8*)(Kb + (32 * kh + r) * 144 + (m * 32 + 16 * s + 8 * hh) * 2); a = mfma32(kf, qf[m][s], a); }
                        if (j0 + 32 * kh + 31 > qw0) { const int lim = qw0 + r - j0 - 32 * kh - 4 * hh; asm volatile("; causal-mask block (kept a real branch: as selects it ran on every interior tile too)" ::: "memory");
#pragma unroll
                            for (int e = 0; e < 16; ++e) if (crow_c(e) > lim) a[e] = SOFT ? NEG : 0.f; }
                        if (MODE == 1) {
#pragma unroll
                            for (int e = 0; e < 16; ++e) if (!((mw >> (e + 16 * kh)) & 1u)) a[e] = NEG; }
                        st[kh] = a;
                    } else st[kh] = splat16(SOFT ? NEG : 0.f);
                }
                if (SOFT) {
                    const float off0 = slope2 * (float)(j0 - qw0 - r), off1 = off0 + 32.f * slope2;
                    float mx0 = st[0][0], mx1 = st[1][0];
#pragma unroll
                    for (int e = 1; e < 16; ++e) { mx0 = fmaxf(mx0, st[0][e]); mx1 = fmaxf(mx1, st[1][e]); }
                    float mx = fmaxf(mx0 + off0, mx1 + off1); mx = fmaxf(mx, shx(mx, lane, 32));
                    const float mn = fmaxf(m_run[m], mx); const float msafe = (mn == NEG) ? 0.f : mn;
                    const float alpha = __builtin_amdgcn_exp2f(m_run[m] - msafe); m_run[m] = mn;
                    const float d0 = off0 - msafe, d1 = off1 - msafe; float rs = 0.f;
#pragma unroll
                    for (int e = 0; e < 16; ++e) { const float p0 = __builtin_amdgcn_exp2f(st[0][e] + d0), p1 = __builtin_amdgcn_exp2f(st[1][e] + d1); st[0][e] = p0; st[1][e] = p1; rs += p0 + p1; }
                    rs += shx(rs, lane, 32); l_run[m] = l_run[m] * alpha + rs;
#pragma unroll
                    for (int e = 0; e < 16; ++e) { O[m][0][e] *= alpha; O[m][1][e] *= alpha; }
                }
#pragma unroll
                for (int kh = 0; kh < 2; ++kh) {
                    if (kh == 0 || hact1) {
#pragma unroll
                        for (int s = 0; s < 2; ++s) {
                            const bf16x8 pf = pack8(st[kh][8 * s], st[kh][8 * s + 1], st[kh][8 * s + 2], st[kh][8 * s + 3], st[kh][8 * s + 4], st[kh][8 * s + 5], st[kh][8 * s + 6], st[kh][8 * s + 7]);
#pragma unroll
                            for (int db = 0; db < 2; ++db) {
                                const LAS unsigned char* vp = Vb + (32 * kh + 16 * s + 4 * hh + ((lane & 15) >> 2)) * 144 + (32 * db + 16 * ((lane >> 4) & 1) + 4 * (lane & 3)) * 2;
                                const s16x4 lo = vtr(vp), hi = vtr(vp + 8 * 144);
                                const bf16x8 vf = (bf16x8){lo[0], lo[1], lo[2], lo[3], hi[0], hi[1], hi[2], hi[3]};
                                O[m][db] = mfma32(vf, pf, O[m][db]); } } } }
            }
            if (SOFT) {
                const float dist = slope2 * (float)(qw0 + r - (j0 - 1)); bool fin = true;
#pragma unroll
                for (int m = 0; m < NMAP; ++m) fin = fin && (qk[m] - dist - m_run[m] < -32.f);
                wave_done = (__ballot(fin) == ~0ull);
            }
        }
        if (SOFT && !wave_done && lane == 0) wflag[it % 3] = 1u;
        sl_cur = sl_nxt; sl_nxt = (sl_nxt == 36864) ? 0 : sl_nxt + 18432;
        __syncthreads();
        if (SOFT) { const unsigned any = wflag[it % 3]; if (tid == 0) wflag[(it + 2) % 3] = 0u; if (any == 0u) break; }
    }
    const size_t orow = rowbase + qw0 + r;
    const int ycol = MODE * 256 + h * 64;
    f32x16 o[2];
    if (MODE == 0) { const float i0 = 1.f / l_run[0], i1 = P.lam / l_run[NMAP - 1];
#pragma unroll
        for (int db = 0; db < 2; ++db)
#pragma unroll
            for (int e = 0; e < 16; ++e) o[db][e] = O[0][db][e] * i0 - O[NMAP - 1][db][e] * i1; }
    else if (MODE == 1) { const float i0 = 1.f / l_run[0];
#pragma unroll
        for (int db = 0; db < 2; ++db)
#pragma unroll
            for (int e = 0; e < 16; ++e) o[db][e] = O[0][db][e] * i0; }
    else { o[0] = O[0][0]; o[1] = O[0][1]; }
    float mu = 0.f;
    if (MODE == 2) { float s = 0.f;
#pragma unroll
        for (int db = 0; db < 2; ++db)
#pragma unroll
            for (int e = 0; e < 16; ++e) s += o[db][e];
        s += shx(s, lane, 32); mu = s * (1.f / 64.f); }
    float ss = 0.f;
    if (MODE != 1) {
#pragma unroll
        for (int db = 0; db < 2; ++db)
#pragma unroll
            for (int e = 0; e < 16; ++e) { const float d = o[db][e] - mu; ss += d * d; }
        ss += shx(ss, lane, 32); }
    float rn = 1.f;
    if (MODE != 1) rn = 1.f / sqrtf(ss * (1.f / 64.f) + LN_EPS);
    if (MODE == 0) rn *= (1.f - P.lam_init);
#pragma unroll
    for (int db = 0; db < 2; ++db)
#pragma unroll
        for (int g4 = 0; g4 < 4; ++g4) { const int d0 = 32 * db + 8 * g4 + 4 * hh; float v[4];
#pragma unroll
            for (int i = 0; i < 4; ++i) v[i] = o[db][4 * g4 + i];
            if (MODE != 1) { const f32x4 nw = *(const f32x4*)(P.nw + (MODE == 2 ? h * 64 : 0) + d0);
#pragma unroll
                for (int i = 0; i < 4; ++i) v[i] = (v[i] - mu) * rn * nw[i]; }
            if (MODE >= 2) { const u32x2 gw = *(const u32x2*)(P.Z + orow * ZW + (MODE == 2 ? ZC_CG : ZC_DG) + h * 64 + d0);
                const float g0 = bflo(gw.x), g1 = bfhi(gw.x), g2 = bflo(gw.y), g3 = bfhi(gw.y);
                v[0] *= g0 * sigmoidf_(g0); v[1] *= g1 * sigmoidf_(g1); v[2] *= g2 * sigmoidf_(g2); v[3] *= g3 * sigmoidf_(g3); }
            u32x2 ow; ow.x = pk2(v[0], v[1]); ow.y = pk2(v[2], v[3]);
            *(u32x2*)(P.Y + orow * DM + ycol + d0) = ow; }
}
}

constexpr int PH_PER_LAYER = 12, N_PHASES = 1 + DEPTH * PH_PER_LAYER;

typedef __attribute__((address_space(4))) const Args* KArgP;
#ifdef ONLY_SITE
#define SITE(s) ((s) == ONLY_SITE)
#else
#define SITE(s) true
#endif
#if MK_ONE_LAUNCH
#define IN(k) true
#define SEAM(k) do { if ((k) + 1 < N_PHASES) { XcdBarrier b2_ = bar; asm volatile("" : "+s"(b2_.bar), "+s"(b2_.x)); xcd_barrier(b2_, F.tid == 0); } } while (0)
#else
#define IN(k) (lo <= (k) && (k) < hi)
#define SEAM(k) do { } while (0)
#endif
#define SITE_BEGIN KArgP KA = (KArgP)__builtin_amdgcn_kernarg_segment_ptr(); do { asm volatile("" : "+s"(KA)); \
        int ln_; asm volatile("v_mbcnt_lo_u32_b32 %0, -1, 0\n\tv_mbcnt_hi_u32_b32 %0, -1, %0" : "=v"(ln_)); \
        const unsigned simd_ = (unsigned)__builtin_amdgcn_s_getreg(((2 - 1) << 11) | (4 << 6) | 4);   \
        unsigned tk_ = 0u, tg_ = 0u; if (ln_ == 0) { tk_ = __hip_atomic_fetch_add((LAS unsigned*)(F.lds + MISC_OFF + 64) + simd_, 1u, __ATOMIC_RELAXED, __HIP_MEMORY_SCOPE_WORKGROUP); \
            tg_ = __hip_atomic_fetch_add((LAS unsigned*)(F.lds + MISC_OFF + 96), 1u, __ATOMIC_RELAXED, __HIP_MEMORY_SCOPE_WORKGROUP); } \
        F.wave = __builtin_amdgcn_readfirstlane(simd_balanced ? (int)(simd_ + 4u * (tk_ & 1u)) : (int)(tg_ & 7u)); F.lane = ln_; F.tid = F.wave * 64 + F.lane; \
        F.ws = KA->ws; F.dob = (unsigned char*)KA->out; F.G = G0; F.wg = wg0; asm volatile("" : "+s"(F.G), "+s"(F.wg)); } while (0)


__global__ void __launch_bounds__(NWAVES * 64, 2) fwd_kernel(Args args) {
    extern __shared__ __attribute__((aligned(16))) unsigned char lds_raw[];
    Frame F;
    F.lds = (LAS unsigned char*)lds_raw;
    F.tid = threadIdx.x; F.lane = F.tid & 63; F.wave = __builtin_amdgcn_readfirstlane(F.tid >> 6);
    F.G = gridDim.x; F.wg = blockIdx.x;
    F.ws = args.ws; F.dob = (unsigned char*)args.out;
    volatile LAS unsigned* MISC = (volatile LAS unsigned*)(F.lds + MISC_OFF);
    if (F.tid < 32) MISC[F.tid] = 0u;
    __syncthreads();
    if (F.lane == 0) __hip_atomic_fetch_add((LAS unsigned*)(F.lds + MISC_OFF + 112) + ((unsigned)__builtin_amdgcn_s_getreg(((2 - 1) << 11) | (4 << 6) | 4)), 1u, __ATOMIC_RELAXED, __HIP_MEMORY_SCOPE_WORKGROUP);
    __syncthreads();
    const bool simd_balanced = (MISC[28] == 2u) && (MISC[29] == 2u) && (MISC[30] == 2u) && (MISC[31] == 2u);
    unsigned* ctl = (unsigned*)(F.ws + WS_CTL);
    XcdBarrier bar; bar.bar = ctl + CW_BAR; bar.x = 0; bar.st = nullptr;
#if MK_ONE_LAUNCH
    bar = xcd_barrier_post(ctl + CW_BAR, MISC + 8);
#endif
    const int lo = args.ph_lo, hi = args.ph_hi, subm = args.sub;
    const int G0 = F.G, wg0 = F.wg;
    if (SITE(0) && IN(0)) { SITE_BEGIN; p0_prologue(F, KA); SEAM(0); }

    for (int l = 0; l < DEPTH; ++l) {
        const int pb = 1 + l * PH_PER_LAYER;
        if (SITE(1) && IN(pb + 0)) { SITE_BEGIN; const char* XBc = (const char*)(F.ws + WS_XB); (void)XBc; const unsigned char* w123 = F.ws + WS_W123; const unsigned char* w45 = F.ws + WS_W45 + (size_t)l * W45_STRIDE; (void)w123; (void)w45;
            pg8::EpiStore E{(bf16*)(F.ws + WS_Z), ZW, F.ws + WS_IKC};
            {   pg8::SchedTiles S{XBc, (const char*)(w123 + W123_W1), 2048, 2048, 16, 6, G1_BF_TILES, 0, F.G, F.wg};
                { int tl_ = F.tid; asm volatile("" : "+v"(tl_)); pg8::gemm_phase(F.lds, S, E, tl_); } }
            {   pg8::SchedTiles S{(const char*)(F.dob + DO_XB8), (const char*)(F.dob + DO_W8 + (size_t)l * W8_STRIDE + W8_Z), 1024, 1024, 8, 8, G1_F8_TILES, 1, F.G, F.wg};
                { int tl_ = F.tid; asm volatile("" : "+v"(tl_)); pg8::gemm_phase<pg8::EpiStore, pg8::SchedTiles, true>(F.lds, S, E, tl_); } }
            SEAM(pb + 0);
        }
        if (SITE(2) && IN(pb + 1)) { SITE_BEGIN; const char* XBc = (const char*)(F.ws + WS_XB); (void)XBc; const unsigned char* w123 = F.ws + WS_W123; const unsigned char* w45 = F.ws + WS_W45 + (size_t)l * W45_STRIDE; (void)w123; (void)w45;
            {   unsigned* head = (unsigned*)(F.ws + WS_CTL) + CW_WQ + l * 64 + 32;
                for (;;) { const int i = mx::wq_next(F, head); if (i >= 128 + 1024) break;
                    if (i < 128) { if (subm & 2) mx::prepkv_unit(F, i, KA->in[6] + (size_t)l * 16 * 128, KA->in[7] + l * 128, (unsigned*)(F.ws + WS_CTL) + CW_KMAX + l * 64); }
                    else if (subm & 1) { const int u = i - 128; mx::b1_unit(F, u & 3, 255 - (u >> 2)); } } }
            SEAM(pb + 1);
        }
        if (SITE(3) && IN(pb + 2)) { SITE_BEGIN; const char* XBc = (const char*)(F.ws + WS_XB); (void)XBc; const unsigned char* w123 = F.ws + WS_W123; const unsigned char* w45 = F.ws + WS_W45 + (size_t)l * W45_STRIDE; (void)w123; (void)w45;
            if (subm & 1) mx::scan_phase(F);
            float lam_init = 0.8f - 0.6f * __expf(-0.3f * (float)l);
            const float* lp = KA->in[3] + l * 128; float s01 = 0.f, s23 = 0.f;
            for (int i = 0; i < 32; ++i) { s01 += lp[i] * lp[32 + i]; s23 += lp[64 + i] * lp[96 + i]; }
            mx::EngP P{(const bf16*)(F.ws + WS_Z), (bf16*)(F.ws + WS_Y), nullptr, nullptr, KA->in[4] + l * 64, __expf(s01) - __expf(s23) + lam_init, lam_init, (const unsigned*)(F.ws + WS_CTL) + CW_KMAX + l * 64};
            {   unsigned* head = (unsigned*)(F.ws + WS_CTL) + CW_WQ + l * 64;
                for (;;) { const int i = mx::wq_next(F, head); if (i >= 512) break; const int j = i & 127; mx::eng_unit<0>(F, P, j & 3, 3 - (i >> 7), 31 - (j >> 2)); } }
            SEAM(pb + 2);
        }
        if (SITE(4) && IN(pb + 3)) { SITE_BEGIN; const char* XBc = (const char*)(F.ws + WS_XB); (void)XBc; const unsigned char* w123 = F.ws + WS_W123; const unsigned char* w45 = F.ws + WS_W45 + (size_t)l * W45_STRIDE; (void)w123; (void)w45;
            {   unsigned* head = (unsigned*)(F.ws + WS_CTL) + CW_WQ + l * 64 + 16;
                const mx::EngP PB{(const bf16*)(F.ws + WS_Z), (bf16*)(F.ws + WS_Y), (const unsigned*)(F.ws + WS_MASK), nullptr, nullptr, 0.f, 0.f, (const unsigned*)(F.ws + WS_CTL) + CW_KMAX + l * 64};
                const mx::EngP PC{(const bf16*)(F.ws + WS_Z), (bf16*)(F.ws + WS_Y), nullptr, (const float*)(F.ws + WS_KVC), KA->in[5] + l * 256, 0.f, 0.f, nullptr};
                const mx::EngP PD{(const bf16*)(F.ws + WS_Z), (bf16*)(F.ws + WS_Y), nullptr, (const float*)(F.ws + WS_KVD), KA->in[8] + l * 64, 0.f, 0.f, nullptr};
                for (;;) { const int i = mx::wq_next(F, head); if (i >= 1536) break;
                    if (i < 512) { if (subm & 1) { const int j = i & 127; mx::eng_unit<1>(F, PB, j & 3, 3 - (i >> 7), 31 - (j >> 2)); } }
                    else if (!(subm & (i < 1024 ? 2 : 4))) continue;
                    else if (i < 1024) { const int u = i - 512; mx::eng_unit<2>(F, PC, u >> 7, (u >> 5) & 3, u & 31); }
                    else { const int u = i - 1024; mx::eng_unit<3>(F, PD, u >> 7, (u >> 5) & 3, u & 31); } } }
            SEAM(pb + 3);
        }
        if (SITE(5) && IN(pb + 4)) { SITE_BEGIN;
            const unsigned char* w123 = F.ws + WS_W123;
            for (int n = 0; n < 4; ++n) {
                {   pg8::SchedPlain S{(const char*)(F.dob + DO_XB8), (const char*)(F.dob + DO_W8 + (size_t)l * W8_STRIDE + W8_G) + (size_t)n * 1024 * 1024, 1024, 1024, 8, 128, 4, F.G, F.wg};
                    pg8::EpiSlotStore E{F.ws + WS_SCR2 + (size_t)F.wg * 262144, 1};
                    { int tl_ = F.tid; asm volatile("" : "+v"(tl_)); pg8::gemm_phase<pg8::EpiSlotStore, pg8::SchedPlain, true>(F.lds, S, E, tl_); } }
                {   pg8::SchedPlain S{(const char*)(F.ws + WS_Y) + n * 512, (const char*)(w123 + W123_GB + 8 * MiB) + (size_t)n * 1024 * 512, 2048, 512, 4, 128, 4, F.G, F.wg};
                    pg8::EpiBranch E{F.ws + WS_SCR2 + (size_t)F.wg * 262144, (bf16*)(F.ws + WS_MERGED), n == 0};
                    { int tl_ = F.tid; asm volatile("" : "+v"(tl_)); pg8::gemm_phase(F.lds, S, E, tl_); } }
            }
            SEAM(pb + 4);
        }
        if (SITE(6) && IN(pb + 5)) { SITE_BEGIN; const char* XBc = (const char*)(F.ws + WS_XB); (void)XBc; const unsigned char* w123 = F.ws + WS_W123; const unsigned char* w45 = F.ws + WS_W45 + (size_t)l * W45_STRIDE; (void)w123; (void)w45;
            pg8::SchedPlain S{(const char*)(F.ws + WS_MERGED), (const char*)(w123 + W123_WO), 2048, 2048, 16, 128, 4, F.G, F.wg};
            pg8::EpiG3 E{(bf16*)(F.ws + WS_XB)};
            pg8::gemm_phase(F.lds, S, E, F.tid);
            SEAM(pb + 5);
        }
        if (SITE(7) && IN(pb + 6)) { SITE_BEGIN; const char* XBc = (const char*)(F.ws + WS_XB); (void)XBc; const unsigned char* w123 = F.ws + WS_W123; const unsigned char* w45 = F.ws + WS_W45 + (size_t)l * W45_STRIDE; (void)w123; (void)w45; ln_phase(F, KA->in[11] + l * DM, KA->in[12] + l * DM, nullptr, F.dob + DO_XB8);
            if (l + 1 < DEPTH) convert_w123(F, KA->in[2] + (size_t)(l + 1) * DM * NIN, KA->in[9] + (size_t)(l + 1) * 4 * 256 * DM, KA->in[10] + (size_t)(l + 1) * DM * DM);
            SEAM(pb + 6); }
        if (SITE(8) && IN(pb + 7)) { SITE_BEGIN; const char* XBc = (const char*)(F.ws + WS_XB); (void)XBc; const unsigned char* w123 = F.ws + WS_W123; const unsigned char* w45 = F.ws + WS_W45 + (size_t)l * W45_STRIDE; (void)w123; (void)w45;
            pg8::SchedUp S{(const char*)(F.dob + DO_XB8), (const char*)(F.dob + DO_W8 + (size_t)l * W8_STRIDE + W8_UP), F.G, F.wg};
            pg8::EpiUp E{(bf16*)(F.ws + WS_GE), (bf16*)(F.ws + WS_G0), (bf16*)(F.ws + WS_U0), F.ws + WS_ACT8, KA->in[14] + (size_t)l * 3 * DFF, KA->in[15] + (size_t)l * DFF};
            pg8::gemm_phase<pg8::EpiUp, pg8::SchedUp, true>(F.lds, S, E, F.tid);
            SEAM(pb + 7);
        }
        if (SITE(9) && IN(pb + 8)) { SITE_BEGIN; const char* XBc = (const char*)(F.ws + WS_XB); (void)XBc; const unsigned char* w123 = F.ws + WS_W123; const unsigned char* w45 = F.ws + WS_W45 + (size_t)l * W45_STRIDE; (void)w123; (void)w45; ffn_act_phase(F, KA->in[14] + (size_t)l * 3 * DFF, KA->in[15] + (size_t)l * DFF); SEAM(pb + 8); }
        if (SITE(10) && IN(pb + 9)) { SITE_BEGIN;
            const unsigned char* w45 = F.ws + WS_W45 + (size_t)l * W45_STRIDE;
            {   pg8::SchedPlain S{(const char*)(F.ws + WS_PB + (size_t)l * M * PDIM * 2), (const char*)(w45 + W45_PP), 512, 512, 4, 128, 4, F.G, F.wg};
                pg8::EpiSlotStore E{F.dob + DO_SCR5 + (size_t)F.wg * 262144, 0};
                { int tl_ = F.tid; asm volatile("" : "+v"(tl_)); pg8::gemm_phase(F.lds, S, E, tl_); } }
            {   pg8::SchedPlain S{(const char*)(F.dob + DO_XB8), (const char*)(F.dob + DO_W8 + (size_t)l * W8_STRIDE + W8_PG), 1024, 1024, 8, 128, 4, F.G, F.wg};
                pg8::EpiSlotMul E{F.dob + DO_SCR5 + (size_t)F.wg * 262144};
                { int tl_ = F.tid; asm volatile("" : "+v"(tl_)); pg8::gemm_phase<pg8::EpiSlotMul, pg8::SchedPlain, true>(F.lds, S, E, tl_); } }
            SEAM(pb + 9);
        }
        if (SITE(11) && IN(pb + 10)) { SITE_BEGIN;
            const unsigned char* w45 = F.ws + WS_W45 + (size_t)l * W45_STRIDE;
            pg8::SchedG5b S{(const char*)(F.ws + WS_ACT8), (const char*)(F.dob + DO_W8 + (size_t)l * W8_STRIDE + W8_DN), F.G, F.wg};
            pg8::EpiG5b E{F.dob + DO_SCR5 + (size_t)F.wg * 262144, (bf16*)(F.ws + WS_XB)};
            pg8::gemm_phase<pg8::EpiG5b, pg8::SchedG5b, true>(F.lds, S, E, F.tid);
            SEAM(pb + 10);
        }
        if (SITE(12) && IN(pb + 11)) { SITE_BEGIN; const char* XBc = (const char*)(F.ws + WS_XB); (void)XBc; const unsigned char* w123 = F.ws + WS_W123; const unsigned char* w45 = F.ws + WS_W45 + (size_t)l * W45_STRIDE; (void)w123; (void)w45; ln_phase(F, KA->in[19] + l * DM, KA->in[20] + l * DM, l == DEPTH - 1 ? KA->out : nullptr, l == DEPTH - 1 ? nullptr : F.dob + DO_XB8); SEAM(pb + 11); }
    }
#undef IN
#undef SEAM
}

extern "C" void kernel_launch(void* const* d_in, const int* in_sizes, int n_in, void* d_out, int out_size, void* d_ws, size_t ws_size, hipStream_t stream) {
    static int grid = 0;
    if (grid == 0) {
        if (n_in != 21 || out_size != M * DM || ws_size < WS_END) { fprintf(stderr, "kernel_launch: unexpected shapes (n_in %d out %d ws %zu)\n", n_in, out_size, ws_size); grid = -1; return; }
        int dev = 0, cus = 0, per_cu = 0;
        if (hipGetDevice(&dev) != hipSuccess || hipDeviceGetAttribute(&cus, hipDeviceAttributeMultiprocessorCount, dev) != hipSuccess) { grid = -1; return; }
        if (hipFuncSetAttribute((const void*)fwd_kernel, hipFuncAttributeMaxDynamicSharedMemorySize, LDS_BYTES) != hipSuccess) { grid = -1; return; }
        if (hipOccupancyMaxActiveBlocksPerMultiprocessor(&per_cu, (const void*)fwd_kernel, NWAVES * 64, LDS_BYTES) != hipSuccess || per_cu < 1)
            fprintf(stderr, "kernel_launch: occupancy query reports %d\n", per_cu);
        (void)hipGetLastError();
        grid = cus;
    }
    if (grid < 0) return;
    (void)hipMemsetAsync((char*)d_ws + WS_CTL, 0, CTL_ZERO_BYTES, stream);
    Args a{};
    for (int i = 0; i < 21; ++i) a.in[i] = (const float*)d_in[i];
    a.out = (float*)d_out; a.ws = (unsigned char*)d_ws;
#if MK_ONE_LAUNCH
    a.ph_lo = 0; a.ph_hi = N_PHASES; a.sub = 7;
    hipLaunchKernelGGL(fwd_kernel, dim3(grid), dim3(NWAVES * 64), LDS_BYTES, stream, a);
#else
    for (int p = 0; p < N_PHASES; ++p) { a.ph_lo = p; a.ph_hi = p + 1; a.sub = 7;
        hipLaunchKernelGGL(fwd_kernel, dim3(grid), dim3(NWAVES * 64), LDS_BYTES, stream, a);
#ifdef PROBE_PHASE
        if (p >= 1 && (p - 1) % PH_PER_LAYER == PROBE_PHASE) { (void)hipMemsetAsync((char*)d_ws + WS_CTL + CW_WQ * 4, 0, 1024, stream); a.sub = PROBE_SUB;
            hipLaunchKernelGGL(fwd_kernel, dim3(grid), dim3(NWAVES * 64), LDS_BYTES, stream, a); }
#endif
    }
#endif
}
```

```cpp
#include <hip/hip_runtime.h>
#include <cstdio>
#include <cstdint>

#ifndef MK_ONE_LAUNCH
#define MK_ONE_LAUNCH 1
#endif

#define GAS __attribute__((address_space(1)))
#define LAS __attribute__((address_space(3)))
typedef unsigned short bf16;
typedef unsigned u32x4 __attribute__((ext_vector_type(4)));
typedef unsigned u32x2 __attribute__((ext_vector_type(2)));
typedef float f32x2 __attribute__((ext_vector_type(2)));
typedef float f32x4 __attribute__((ext_vector_type(4)));
typedef float f32x16 __attribute__((ext_vector_type(16)));
typedef short bf16x8 __attribute__((ext_vector_type(8)));
typedef short s16x4 __attribute__((ext_vector_type(4)));
typedef GAS unsigned gu32;

constexpr int BATCH = 4, SEQ = 8192, DM = 1024, M = BATCH * SEQ, DEPTH = 2;
constexpr int NIN = 7604, ZW = 3648  , DFF = 2816, UGW = 5632, PDIM = 256;
constexpr float LN_EPS = 1e-5f;
constexpr float ALPHA = 1.41421356237f;
constexpr float LOG2E = 1.4426950408889634f;
constexpr int ZC_AQ = 0, ZC_AK = 256, ZC_AV = 512, ZC_BQ = 768, ZC_BK = 1024, ZC_BV = 1280, ZC_CQ = 1536, ZC_CK = 1792, ZC_CV = 2048, ZC_CG = 2304,
              ZC_DQ = 2560, ZC_DK = 2688, ZC_DV = 2816, ZC_DG = 3072, ZC_IQ = 3328, ZC_IK = 3456, ZC_IW = 3488, ZC_DA = 3504;
constexpr int SRC_MG = 3508;

constexpr size_t MiB = 1u << 20;
constexpr size_t WS_CTL = 0, CTL_ZERO_BYTES = 1 * MiB;
constexpr size_t WS_XB = 1 * MiB;
constexpr size_t WS_BIG = 65 * MiB;
constexpr size_t WS_Z = WS_BIG, WS_Y = WS_BIG + 228 * MiB, WS_MERGED = WS_BIG + 292 * MiB;
constexpr size_t WS_ACT8 = WS_BIG, WS_GE = WS_BIG + 96 * MiB, WS_G0 = WS_BIG + 104 * MiB, WS_U0 = WS_BIG + 112 * MiB;
constexpr size_t WS_MASK = WS_MERGED, WS_KVC = WS_MERGED + 32 * MiB, WS_KVD = WS_MERGED + 40 * MiB, WS_DE = WS_MERGED + 56 * MiB;
constexpr size_t WS_SCR2 = WS_Z;
constexpr size_t WS_W45 = 421 * MiB, W45_STRIDE = 15 * MiB, WS_IKC = 451 * MiB;
constexpr size_t W45_UP = 0, W45_PG = 11 * MiB, W45_PP = 13 * MiB, W45_DN = 13 * MiB + 512 * 1024;
constexpr size_t WS_PB = 455 * MiB;
constexpr size_t WS_W123 = 487 * MiB;
constexpr size_t WS_END = 506 * MiB;
constexpr size_t W123_W1 = 0, W123_GB = 7 * MiB, W123_WO = 17 * MiB;
constexpr size_t DO_SCR5 = 0;
constexpr size_t DO_XB8 = 64 * MiB;
constexpr size_t DO_W8 = 96 * MiB, W8_STRIDE = 15 * MiB + 256 * 1024, W8_G = 0, W8_UP = 4 * MiB, W8_PG = 9 * MiB + 512 * 1024, W8_DN = 10 * MiB + 512 * 1024, W8_Z = 13 * MiB + 256 * 1024;
constexpr unsigned long long G1_F8_TILES = 0xCB987652ull, G1_BF_TILES = 0xDA4310ull;

constexpr int CW_BAR = 4096, CW_WQ = 8448  , CW_KMAX = 8192;

constexpr int RING_BYTES = 131072;
constexpr int MISC_OFF = 131072 + 320;
constexpr int QST_OFF = 132096;
constexpr int LDS_BYTES = 147456;

constexpr int NWAVES = 8;

#define RLX_AGENT __ATOMIC_RELAXED, __HIP_MEMORY_SCOPE_AGENT
__device__ __forceinline__ unsigned f2bf(float f) { unsigned u = __builtin_bit_cast(unsigned, f); return (u + 0x7fffu + ((u >> 16) & 1u)) >> 16; }
typedef __bf16 bf16x2_t __attribute__((ext_vector_type(2)));
__device__ __forceinline__ unsigned pk2(float lo, float hi) { const f32x2 v = {lo, hi}; const bf16x2_t b = __builtin_convertvector(v, bf16x2_t); return __builtin_bit_cast(unsigned, b); }
__device__ __forceinline__ unsigned pk4f8(float a, float b, float c, float d) { int p = __builtin_amdgcn_cvt_pk_fp8_f32(a, b, 0, false); p = __builtin_amdgcn_cvt_pk_fp8_f32(c, d, p, true); return (unsigned)p; }
__device__ __forceinline__ float bflo(unsigned w) { return __uint_as_float(w << 16); }
__device__ __forceinline__ float bfhi(unsigned w) { return __uint_as_float(w & 0xffff0000u); }
__device__ __forceinline__ float bf1(bf16 b) { return __uint_as_float((unsigned)b << 16); }
__device__ __forceinline__ void up8(const u32x4 w, float (&v)[8]) { v[0] = bflo(w.x); v[1] = bfhi(w.x); v[2] = bflo(w.y); v[3] = bfhi(w.y); v[4] = bflo(w.z); v[5] = bfhi(w.z); v[6] = bflo(w.w); v[7] = bfhi(w.w); }
__device__ __forceinline__ float sigmoidf_(float x) { return __builtin_amdgcn_rcpf(1.0f + __builtin_amdgcn_exp2f(-LOG2E * x)); }
__device__ __forceinline__ float shx(float v, int lane, int m) { return __int_as_float(__builtin_amdgcn_ds_bpermute((lane ^ m) << 2, __float_as_int(v))); }
__device__ __forceinline__ unsigned shup(unsigned v, int lane, int o) { return (unsigned)__builtin_amdgcn_ds_bpermute((lane - o) << 2, (int)v); }
__device__ __forceinline__ float wave_sum(float v, int lane) {
#pragma unroll
    for (int o = 1; o < 64; o <<= 1) v += shx(v, lane, o);
    return v;
}

#define XB_TMO      128
#define XB_XCNT(j)  (256  + 64 * (j))
#define XB_XSUB(j)  (1280 + 64 * (j))
#define XB_XGEN(j)  (2304 + 64 * (j))
#define XB_TOP      3328
#define XB_TOPGEN   3392
#define XCD_BAR_WORDS 3456
#define XB_SPIN_CAP (1u << 22)

__device__ __forceinline__ unsigned xb_ld(unsigned* p)              { return __hip_atomic_load(p, __ATOMIC_RELAXED, __HIP_MEMORY_SCOPE_AGENT); }
__device__ __forceinline__ unsigned xb_add(unsigned* p, unsigned v) { return __hip_atomic_fetch_add(p, v, __ATOMIC_RELAXED, __HIP_MEMORY_SCOPE_AGENT); }
__device__ __forceinline__ unsigned xb_xcc_id() { return (unsigned)__builtin_amdgcn_s_getreg((3 << 11) | 20) & 0xFu; }
#define XB_SPIN(cond, bar) do { unsigned _sp = 0; while (cond) { __builtin_amdgcn_s_sleep(1); \
    if ((++_sp & 255u) == 0u) { if (xb_ld(&(bar)[XB_TMO])) break; if (_sp > XB_SPIN_CAP) { atomicAdd(&(bar)[XB_TMO], 1u); break; } } } } while (0)

struct XcdBarrier { unsigned* bar; unsigned x; volatile LAS unsigned* st; };

__device__ __forceinline__ XcdBarrier xcd_barrier_post(unsigned* bar, volatile LAS unsigned* st) {
    XcdBarrier b; b.bar = bar; b.x = xb_xcc_id(); b.st = st;
    if (threadIdx.x == 0) (void)xb_add(&bar[XB_XCNT(b.x)], 1u);
    return b;
}
__device__ __forceinline__ void xcd_barrier_complete(unsigned* bar, unsigned x, unsigned& nloc, unsigned& nx) {
    const unsigned G = gridDim.x * gridDim.y * gridDim.z;
    unsigned sum, cnt, mine, sp = 0u;
    for (;;) {
        sum = 0u; cnt = 0u; mine = 0u;
#pragma unroll
        for (unsigned j = 0; j < 16; ++j) { const unsigned c = xb_ld(&bar[XB_XCNT(j)]); sum += c; cnt += (c > 0u) ? 1u : 0u; mine = (j == x) ? c : mine; }
        if (sum == G) break;
        __builtin_amdgcn_s_sleep(1);
        if ((++sp & 255u) == 0u) { if (xb_ld(&bar[XB_TMO])) break; if (sp > XB_SPIN_CAP) { atomicAdd(&bar[XB_TMO], 1u); break; } }
    }
    nloc = mine > 0u ? mine : 1u; nx = cnt > 0u ? cnt : 1u;
}
__device__ __forceinline__ void xcd_barrier(const XcdBarrier& b, const bool leader_thread) {
    asm volatile("s_waitcnt vmcnt(0)" ::: "memory");
    __syncthreads();
    if (leader_thread) {
        unsigned* bar = b.bar;
        __builtin_amdgcn_s_waitcnt(0);
        unsigned nloc = b.st[0], nx = b.st[1];
        if (nloc == 0u) { xcd_barrier_complete(bar, b.x, nloc, nx); b.st[0] = nloc; b.st[1] = nx; }
        const unsigned old = xb_add(&bar[XB_XSUB(b.x)], 1u);
        const unsigned gen = old / nloc;
        if (old + 1u == (gen + 1u) * nloc) {
            __builtin_amdgcn_fence(__ATOMIC_RELEASE, "agent");
            asm volatile("s_waitcnt vmcnt(0)" ::: "memory");
            const unsigned og = xb_add(&bar[XB_TOP], 1u);
            const unsigned tg = og / nx;
            if (og + 1u == (tg + 1u) * nx) xb_add(&bar[XB_TOPGEN], 1u);
            else XB_SPIN(xb_ld(&bar[XB_TOPGEN]) == tg, bar);
            __builtin_amdgcn_fence(__ATOMIC_ACQUIRE, "agent");
            xb_add(&bar[XB_XGEN(b.x)], 1u);
            asm volatile("s_waitcnt vmcnt(0)" ::: "memory");
        } else {
            XB_SPIN(xb_ld(&bar[XB_XGEN(b.x)]) == gen, bar);
            __builtin_amdgcn_fence(__ATOMIC_ACQUIRE, "agent");
            asm volatile("s_waitcnt vmcnt(0)" ::: "memory");
        }
    }
    __syncthreads();
}

namespace pg8 {
constexpr int BM = 256, BK = 64, HALF = 128, HTB = HALF * BK * 2, STAGE_BYTES = 8 * HTB, NXCD = 8, WGM = 8;
__device__ __forceinline__ int lds_byte(int r, int c) { const int st = (r >> 4) * 2 + (c >> 5), rr = r & 15, cc = c & 31, ob = rr * 64 + cc * 2; return st * 1024 + (ob ^ (((ob >> 9) & 1) << 5)); }
__device__ __forceinline__ void stage_rc(int b, int& R, int& C) { const int st = b / 1024, sb = b % 1024, swz = sb ^ (((sb >> 9) & 1) << 5); R = (st >> 1) * 16 + swz / 64; C = (st & 1) * 32 + (swz % 64) / 2; }
__device__ __forceinline__ int perm32(int rho) { const int n = rho >> 4, i = rho & 15; return 8 * (i >> 2) + 4 * n + (i & 3); }

struct UnitD { const char* A; const char* B; int lda2, ldb2, nt, pm, pn, kind; };

__device__ __forceinline__ void tile_map(int L, int nM, int nN, int& pm, int& pn) {
    const int nwg = nM * nN; int wgid = L;
    { const int q = nwg / NXCD, r = nwg % NXCD, xcd = wgid % NXCD, off = wgid / NXCD; wgid = (xcd < r ? xcd * (q + 1) : r * (q + 1) + (xcd - r) * q) + off; }
    const int nig = WGM * nN, gid = wgid / nig, fm = gid * WGM, gsz = (nM - fm) < WGM ? (nM - fm) : WGM;
    pm = fm + ((wgid % nig) % gsz); pn = (wgid % nig) / gsz;
}

typedef int i32x8 __attribute__((ext_vector_type(8)));
template <class Epi, class Sched, bool FP8 = false>
__device__ __forceinline__ void gemm_phase(LAS unsigned char* lds, const Sched& S, const Epi& E, const int tid) {
    const int wid = __builtin_amdgcn_readfirstlane(tid >> 6), lane = tid & 63, wr = wid >> 2, wc = wid & 3, fr = lane & 15, fq = lane >> 4;
    int sR, sRb, sC2;
    { int R, C; stage_rc(tid * 16, R, C); sR = R; sRb = (R & ~31) + perm32(R & 31); sC2 = C * 2; }
    const size_t kstep = (size_t)(BK * 2);
    const unsigned ldsw = (unsigned)wid * 1024u;
    const int aoff = lds_byte(wr * 64 + fr, FP8 ? fq * 16 : fq * 8), boff = lds_byte(wc * 32 + fr, FP8 ? fq * 16 : fq * 8);
#define PG8_SA(b, h) (((b) * 2 + (h)) * HTB)
#define PG8_SB(b, h) ((4 + (b) * 2 + (h)) * HTB)
#define PG8_STAGE(bufoff, gbase, rows, pitch) do { const unsigned _o = (unsigned)((rows) * (pitch) + sC2); _Pragma("unroll") for (int _i = 0; _i < 2; ++_i) \
        __builtin_amdgcn_global_load_lds((const unsigned*)((const char*)(gbase) + (size_t)(_i * 64) * (pitch) + _o), (LAS unsigned*)(lds + (bufoff) + ldsw + _i * 8192), 16, 0, 0); } while (0)
#define PG8_LDA(dst, b, h) do { if constexpr (FP8) { _Pragma("unroll") for (int m = 0; m < 4; ++m) { const u32x4 lo_ = *(const LAS u32x4*)(lds + PG8_SA(b, h) + aoff + m * 2048), hi_ = *(const LAS u32x4*)(lds + PG8_SA(b, h) + aoff + m * 2048 + 16); \
            dst##8[m] = (i32x8){(int)lo_.x, (int)lo_.y, (int)lo_.z, (int)lo_.w, (int)hi_.x, (int)hi_.y, (int)hi_.z, (int)hi_.w}; } } \
        else { _Pragma("unroll") for (int m = 0; m < 4; ++m) _Pragma("unroll") for (int k = 0; k < 2; ++k) dst[m][k] = *(const LAS bf16x8*)(lds + PG8_SA(b, h) + aoff + m * 2048 + k * 1024); } } while (0)
#define PG8_LDB(dst, b, h) do { if constexpr (FP8) { _Pragma("unroll") for (int n = 0; n < 2; ++n) { const u32x4 lo_ = *(const LAS u32x4*)(lds + PG8_SB(b, h) + boff + n * 2048), hi_ = *(const LAS u32x4*)(lds + PG8_SB(b, h) + boff + n * 2048 + 16); \
            dst##8[n] = (i32x8){(int)lo_.x, (int)lo_.y, (int)lo_.z, (int)lo_.w, (int)hi_.x, (int)hi_.y, (int)hi_.z, (int)hi_.w}; } } \
        else { _Pragma("unroll") for (int n = 0; n < 2; ++n) _Pragma("unroll") for (int k = 0; k < 2; ++k) dst[n][k] = *(const LAS bf16x8*)(lds + PG8_SB(b, h) + boff + n * 2048 + k * 1024); } } while (0)
#define PG8_MMA(ai, bj, At, Bt) do { __builtin_amdgcn_s_setprio(1); if constexpr (FP8) { _Pragma("unroll") for (int m = 0; m < 4; ++m) _Pragma("unroll") for (int n = 0; n < 2; ++n) \
            asm volatile("v_mfma_scale_f32_16x16x128_f8f6f4 %0, %1, %2, %0, %3, %3 op_sel_hi:[0,0,0]" : "+v"(acc[ai][bj][m][n]) : "v"(Bt##8[n]), "v"(At##8[m]), "v"(scl8)); } \
        else { _Pragma("unroll") for (int m = 0; m < 4; ++m) _Pragma("unroll") for (int n = 0; n < 2; ++n) _Pragma("unroll") for (int k = 0; k < 2; ++k) \
            acc[ai][bj][m][n] = __builtin_amdgcn_mfma_f32_16x16x32_bf16(Bt[n][k], At[m][k], acc[ai][bj][m][n], 0, 0, 0); } __builtin_amdgcn_s_setprio(0); } while (0)
#define PG8_WAIT_V(n) asm volatile("s_waitcnt vmcnt(" #n ")" ::: "memory")
#define PG8_WAIT_L(n) asm volatile("s_waitcnt lgkmcnt(" #n ")" ::: "memory")
#define PG8_BAR __builtin_amdgcn_s_barrier()
#define PG8_SCHED __builtin_amdgcn_sched_barrier(0)
    UnitD cur, nxt; int ui = 0;
    if (!S.next(0, cur)) return;
    f32x4 acc[2][2][4][2];
#pragma unroll
    for (int a = 0; a < 2; ++a)
#pragma unroll
        for (int b = 0; b < 2; ++b)
#pragma unroll
            for (int m = 0; m < 4; ++m)
#pragma unroll
                for (int n = 0; n < 2; ++n) acc[a][b][m][n] = (f32x4){0.f, 0.f, 0.f, 0.f};
    bf16x8 At[4][2], B0[2][2], B1[2][2]; i32x8 At8[4], B08[2], B18[2];
    int scl8 = 0x7c7c7c7c; asm volatile("" : "+v"(scl8));
    const char* cA = cur.A; const char* cB = cur.B;
    int pA = cur.lda2, pB = cur.ldb2;
    PG8_STAGE(PG8_SB(0, 0), cB, sRb, pB); PG8_STAGE(PG8_SB(0, 1), cB + (size_t)HALF * pB, sRb, pB); PG8_STAGE(PG8_SA(0, 0), cA, sR, pA); PG8_STAGE(PG8_SA(0, 1), cA + (size_t)HALF * pA, sR, pA);
    if (wr == 1) PG8_BAR;
    PG8_WAIT_V(2); PG8_BAR;
    PG8_STAGE(PG8_SB(1, 0), cB + kstep, sRb, pB); PG8_STAGE(PG8_SA(1, 0), cA + kstep, sR, pA); PG8_STAGE(PG8_SB(1, 1), cB + (size_t)HALF * pB + kstep, sRb, pB);
    PG8_WAIT_V(6); PG8_BAR;
    for (;;) {
        const bool has_next = S.next(ui + 1, nxt);
        if (!has_next) nxt = cur;
        const char* nA = nxt.A; const char* nB = nxt.B;
        const int nt = cur.nt;
        for (int t = 0; t < nt; t += 2) {
            const bool last = (t == nt - 2);
            const char* a1 = cA + (size_t)(t + 1) * kstep + (size_t)HALF * pA;
            const char* a2 = last ? nA : cA + (size_t)(t + 2) * kstep; const char* b2 = last ? nB : cB + (size_t)(t + 2) * kstep;
            const int p2A = last ? nxt.lda2 : pA, p2B = last ? nxt.ldb2 : pB;
            const char* a2h = a2 + (size_t)HALF * p2A; const char* b2h = b2 + (size_t)HALF * p2B;
            PG8_LDB(B0, 0, 0); PG8_LDB(B1, 0, 1); PG8_SCHED; PG8_LDA(At, 0, 0); PG8_STAGE(PG8_SA(1, 1), a1, sR, pA);
            PG8_WAIT_V(8); PG8_WAIT_L(0); PG8_BAR; PG8_MMA(0, 0, At, B0); PG8_MMA(0, 1, At, B1); PG8_BAR; PG8_SCHED;
            PG8_LDA(At, 0, 1); PG8_STAGE(PG8_SB(0, 0), b2, sRb, p2B); PG8_STAGE(PG8_SB(0, 1), b2h, sRb, p2B); PG8_STAGE(PG8_SA(0, 0), a2, sR, p2A);
            PG8_WAIT_V(8); PG8_WAIT_L(0); PG8_BAR; PG8_MMA(1, 0, At, B0); PG8_MMA(1, 1, At, B1); PG8_BAR; PG8_SCHED;
            PG8_LDB(B0, 1, 0); PG8_LDB(B1, 1, 1); PG8_SCHED; PG8_LDA(At, 1, 0); PG8_STAGE(PG8_SA(0, 1), a2h, sR, p2A);
            PG8_WAIT_V(8); PG8_WAIT_L(0); PG8_BAR; PG8_MMA(0, 0, At, B0); PG8_MMA(0, 1, At, B1); PG8_BAR; PG8_SCHED;
            PG8_LDA(At, 1, 1); PG8_STAGE(PG8_SB(1, 0), b2 + kstep, sRb, p2B); PG8_STAGE(PG8_SB(1, 1), b2h + kstep, sRb, p2B); PG8_STAGE(PG8_SA(1, 0), a2 + kstep, sR, p2A);
            PG8_WAIT_V(8); PG8_WAIT_L(0); PG8_BAR; PG8_MMA(1, 0, At, B0); PG8_MMA(1, 1, At, B1); PG8_BAR; PG8_SCHED;
        }
        if constexpr (FP8) asm volatile("s_nop 15\n\ts_nop 15" ::: "memory");
        if (wr == 0) PG8_BAR;
        { int l2; asm volatile("v_mbcnt_lo_u32_b32 %0, -1, 0\n\tv_mbcnt_hi_u32_b32 %0, -1, %0" : "=v"(l2)); E(acc, cur, wr, wc, l2 & 15, l2 >> 4, wid * 64 + l2); }
        if (!has_next) break;
#pragma unroll
        for (int a = 0; a < 2; ++a)
#pragma unroll
            for (int b = 0; b < 2; ++b)
#pragma unroll
                for (int m = 0; m < 4; ++m)
#pragma unroll
                    for (int n = 0; n < 2; ++n) acc[a][b][m][n] = (f32x4){0.f, 0.f, 0.f, 0.f};
        cur = nxt; cA = nA; cB = nB; pA = cur.lda2; pB = cur.ldb2;
        ++ui;
        if (wr == 1) PG8_BAR;
    }
    PG8_WAIT_V(0);
    PG8_BAR;
#undef PG8_SA
#undef PG8_SB
#undef PG8_STAGE
#undef PG8_LDA
#undef PG8_LDB
#undef PG8_MMA
#undef PG8_WAIT_V
#undef PG8_WAIT_L
#undef PG8_BAR
#undef PG8_SCHED
}

struct SchedPlain {
    const char* A; const char* B; int lda2, ldb2, nt, nM, nN, G, c;
    __device__ __forceinline__ bool next(int i, UnitD& u) const {
        const long L = (long)i * G + c; if (L >= (long)nM * nN) return false;
        int pm, pn; tile_map((int)L, nM, nN, pm, pn);
        u.A = A + (size_t)pm * 256 * lda2; u.B = B + (size_t)pn * 256 * ldb2; u.lda2 = lda2; u.ldb2 = ldb2; u.nt = nt; u.pm = pm; u.pn = pn; u.kind = i; return true;
    }
};
struct SchedTiles {
    const char* A; const char* B; int lda2, ldb2, nt, ntile; unsigned long long list; int compact, G, c;
    __device__ __forceinline__ bool next(int i, UnitD& u) const {
        const long L = (long)i * G + c; if (L >= (long)128 * ntile) return false;
        int pm, pi; tile_map((int)L, 128, ntile, pm, pi); const int col = (int)((list >> (4 * pi)) & 15ull);
        u.A = A + (size_t)pm * 256 * lda2; u.B = B + (size_t)(compact ? pi : col) * 256 * ldb2; u.lda2 = lda2; u.ldb2 = ldb2; u.nt = nt; u.pm = pm; u.pn = col; u.kind = i; return true;
    }
};
struct SchedUp {
    const char* A; const char* B; int G, c;
    __device__ __forceinline__ bool next(int i, UnitD& u) const {
        const long L = (long)i * G + c; if (L >= 128 * 22) return false;
        int pm, cb; tile_map((int)L, 128, 22, pm, cb);
        u.A = A + (size_t)pm * 256 * 1024; u.lda2 = 1024; u.B = B + (size_t)cb * 256 * 1024; u.ldb2 = 1024; u.nt = 8; u.pm = pm; u.pn = cb; u.kind = i; return true;
    }
};
struct SchedG5b {
    const char* A; const char* B; int G, c;
    __device__ __forceinline__ bool next(int i, UnitD& u) const {
        const long L = (long)i * G + c; if (L >= 128 * 4) return false;
        int pm, pn; tile_map((int)L, 128, 4, pm, pn);
        u.A = A + (size_t)pm * 256 * DFF; u.lda2 = DFF; u.B = B + (size_t)pn * 256 * DFF; u.ldb2 = DFF; u.nt = 22; u.pm = pm; u.pn = pn; u.kind = i; return true;
    }
};

#define EPI_LOOP for (int ai = 0; ai < 2; ++ai) _Pragma("unroll") for (int m = 0; m < 4; ++m) _Pragma("unroll") for (int bj = 0; bj < 2; ++bj)
struct EpiStore {
    bf16* O; int ldc; unsigned char* IKC;
    __device__ __forceinline__ void operator()(const f32x4 (&acc)[2][2][4][2], const UnitD& u, int wr, int wc, int fr, int fq, int tid) const {
        const int row0 = u.pm * BM + wr * 64 + fr, col0 = u.pn * BM + wc * 32 + 8 * fq;
#pragma unroll
        EPI_LOOP { const f32x4 v0 = acc[ai][bj][m][0], v1 = acc[ai][bj][m][1];
            u32x4 w; w.x = pk2(v0[0], v0[1]); w.y = pk2(v0[2], v0[3]); w.z = pk2(v1[0], v1[1]); w.w = pk2(v1[2], v1[3]);
            const int R = row0 + ai * HALF + m * 16;
            *(u32x4*)(O + (size_t)R * ldc + col0 + bj * HALF) = w;
            if (bj == 1 && u.pn == 13 && wc == 0) *(u32x4*)(IKC + ((size_t)((R >> 5) * 2 + (fq >> 1)) * 64 + (fq & 1) * 32 + (R & 31)) * 16) = w; }
    }
};
struct EpiSlotStore {
    unsigned char* sc_; int act;
    __device__ __forceinline__ void operator()(const f32x4 (&acc)[2][2][4][2], const UnitD& u, int wr, int wc, int fr, int fq, int tid) const {
        unsigned loff = (unsigned)tid * 16u; asm volatile("" : "+v"(loff));
        unsigned char* sc = sc_ + (size_t)u.kind * 131072 + loff;
#pragma unroll
        EPI_LOOP { const int q = (ai * 2 + bj) * 4 + m; f32x4 v0 = acc[ai][bj][m][0], v1 = acc[ai][bj][m][1];
            if (act) { v0 = (f32x4){sigmoidf_(v0[0]), sigmoidf_(v0[1]), sigmoidf_(v0[2]), sigmoidf_(v0[3])}; v1 = (f32x4){sigmoidf_(v1[0]), sigmoidf_(v1[1]), sigmoidf_(v1[2]), sigmoidf_(v1[3])}; }
            u32x4 w; w.x = pk2(v0[0], v0[1]); w.y = pk2(v0[2], v0[3]); w.z = pk2(v1[0], v1[1]); w.w = pk2(v1[2], v1[3]);
            *(u32x4*)(sc + (size_t)q * 8192) = w; }
    }
};
struct EpiSlotMul {
    unsigned char* sc_;
    __device__ __forceinline__ void operator()(const f32x4 (&acc)[2][2][4][2], const UnitD& u, int wr, int wc, int fr, int fq, int tid) const {
        unsigned loff = (unsigned)tid * 16u; asm volatile("" : "+v"(loff));
        unsigned char* sc = sc_ + (size_t)u.kind * 131072 + loff;
#pragma unroll
        EPI_LOOP { const int q = (ai * 2 + bj) * 4 + m; const f32x4 v0 = acc[ai][bj][m][0], v1 = acc[ai][bj][m][1];
            u32x4* sp = (u32x4*)(sc + (size_t)q * 8192); const u32x4 p = *sp;
            u32x4 w; w.x = pk2(sigmoidf_(v0[0]) * bflo(p.x), sigmoidf_(v0[1]) * bfhi(p.x)); w.y = pk2(sigmoidf_(v0[2]) * bflo(p.y), sigmoidf_(v0[3]) * bfhi(p.y));
            w.z = pk2(sigmoidf_(v1[0]) * bflo(p.z), sigmoidf_(v1[1]) * bfhi(p.z)); w.w = pk2(sigmoidf_(v1[2]) * bflo(p.w), sigmoidf_(v1[3]) * bfhi(p.w));
            *sp = w;
            if (m & 1) asm volatile("" ::: "memory"); }
    }
};
struct EpiBranch {
    const unsigned char* sc_; bf16* MG; int first;
    __device__ __forceinline__ void operator()(const f32x4 (&acc)[2][2][4][2], const UnitD& u, int wr, int wc, int fr, int fq, int tid) const {
        const int row0 = u.pm * BM + wr * 64 + fr, col0 = u.pn * BM + wc * 32 + 8 * fq;
        unsigned loff = (unsigned)tid * 16u; asm volatile("" : "+v"(loff));
        const unsigned char* sc = sc_ + (size_t)u.kind * 131072 + loff;
#pragma unroll
        EPI_LOOP { const int q = (ai * 2 + bj) * 4 + m; const f32x4 v0 = acc[ai][bj][m][0], v1 = acc[ai][bj][m][1];
            const u32x4 g = *(const u32x4*)(sc + (size_t)q * 8192);
            u32x4* p = (u32x4*)(MG + (size_t)(row0 + ai * HALF + m * 16) * DM + col0 + bj * HALF);
            f32x4 t0 = (f32x4){bflo(g.x) * v0[0], bfhi(g.x) * v0[1], bflo(g.y) * v0[2], bfhi(g.y) * v0[3]};
            f32x4 t1 = (f32x4){bflo(g.z) * v1[0], bfhi(g.z) * v1[1], bflo(g.w) * v1[2], bfhi(g.w) * v1[3]};
            if (!first) { const u32x4 x = *p; t0 += (f32x4){bflo(x.x), bfhi(x.x), bflo(x.y), bfhi(x.y)}; t1 += (f32x4){bflo(x.z), bfhi(x.z), bflo(x.w), bfhi(x.w)}; }
            u32x4 w; w.x = pk2(t0[0], t0[1]); w.y = pk2(t0[2], t0[3]); w.z = pk2(t1[0], t1[1]); w.w = pk2(t1[2], t1[3]);
            *p = w;
            if (m & 1) asm volatile("" ::: "memory"); }
    }
};
__device__ __forceinline__ float gelu_tanh_e(float y) { const float t = 1.5957691216057308f * (y + 0.044715f * y * y * y); return y * __builtin_amdgcn_rcpf(1.0f + __builtin_amdgcn_exp2f(-LOG2E * t)); }
__device__ __forceinline__ float dpp_prev1(float prev, float cur) {
    const int o = __builtin_amdgcn_update_dpp(0, __builtin_bit_cast(int, prev), 0x121, 0xf, 0xf, true);
    return __builtin_bit_cast(float, __builtin_amdgcn_update_dpp(o, __builtin_bit_cast(int, cur), 0x111, 0xf, 0xf, false)); }
__device__ __forceinline__ float dpp_prev2(float prev, float cur) {
    const int o = __builtin_amdgcn_update_dpp(0, __builtin_bit_cast(int, prev), 0x122, 0xf, 0xf, true);
    return __builtin_bit_cast(float, __builtin_amdgcn_update_dpp(o, __builtin_bit_cast(int, cur), 0x112, 0xf, 0xf, false)); }
struct EpiUp {
    bf16* GE; bf16* G0; bf16* U0; unsigned char* ACT8; const float* cw; const float* cbias;
    __device__ __forceinline__ void operator()(const f32x4 (&acc)[2][2][4][2], const UnitD& u, int wr, int wc, int fr, int fq, int tid) const {
        const int gc = u.pn * 128 + wc * 32 + 8 * fq; f32x4 wv[8];
        wv[0] = *(const f32x4*)(cw + gc); wv[1] = *(const f32x4*)(cw + gc + 4); wv[2] = *(const f32x4*)(cw + DFF + gc); wv[3] = *(const f32x4*)(cw + DFF + gc + 4);
        wv[4] = *(const f32x4*)(cw + 2 * DFF + gc); wv[5] = *(const f32x4*)(cw + 2 * DFF + gc + 4); wv[6] = *(const f32x4*)(cbias + gc); wv[7] = *(const f32x4*)(cbias + gc + 4);
#pragma unroll
        for (int ai = 0; ai < 2; ++ai) { const int rb = u.pm * 4 + ai * 2 + wr;
#pragma unroll
            for (int m = 0; m < 4; ++m) { const int r = wr * 64 + fr + ai * HALF + m * 16; float o[8];
#pragma unroll
                for (int i = 0; i < 8; ++i) { const float g0_ = acc[ai][0][m][i >> 2][i & 3], gp_ = (m > 0) ? acc[ai][0][m > 0 ? m - 1 : 0][i >> 2][i & 3] : 0.f;
                    const float g1_ = dpp_prev1(gp_, g0_), g2_ = dpp_prev2(gp_, g0_);
                    const float y_ = wv[6 + (i >> 2)][i & 3] + wv[(i >> 2)][i & 3] * g2_ + wv[2 + (i >> 2)][i & 3] * g1_ + wv[4 + (i >> 2)][i & 3] * g0_; o[i] = gelu_tanh_e(y_) * acc[ai][1][m][i >> 2][i & 3]; }
                u32x2 w8; w8.x = pk4f8(o[0], o[1], o[2], o[3]); w8.y = pk4f8(o[4], o[5], o[6], o[7]);
                *(u32x2*)(ACT8 + (size_t)(u.pm * BM + r) * DFF + gc) = w8;
                if (m == 0 || m == 3) { const f32x4 v0 = acc[ai][0][m][0], v1 = acc[ai][0][m][1]; u32x4 w; w.x = pk2(v0[0], v0[1]); w.y = pk2(v0[2], v0[3]); w.z = pk2(v1[0], v1[1]); w.w = pk2(v1[2], v1[3]);
                    if (m == 0 && fr < 2) { *(u32x4*)(G0 + ((size_t)rb * 2 + fr) * DFF + gc) = w;
                        const f32x4 x0 = acc[ai][1][m][0], x1 = acc[ai][1][m][1]; u32x4 wu; wu.x = pk2(x0[0], x0[1]); wu.y = pk2(x0[2], x0[3]); wu.z = pk2(x1[0], x1[1]); wu.w = pk2(x1[2], x1[3]);
                        *(u32x4*)(U0 + ((size_t)rb * 2 + fr) * DFF + gc) = wu; }
                    if (m == 3 && fr >= 14) *(u32x4*)(GE + ((size_t)rb * 2 + (fr - 14)) * DFF + gc) = w; } } }
    }
};
struct EpiG3 {
    bf16* XB;
    __device__ __forceinline__ void operator()(const f32x4 (&acc)[2][2][4][2], const UnitD& u, int wr, int wc, int fr, int fq, int tid) const {
        const int row0 = u.pm * BM + wr * 64 + fr, col0 = u.pn * BM + wc * 32 + 8 * fq;
#pragma unroll
        EPI_LOOP { const f32x4 v0 = acc[ai][bj][m][0], v1 = acc[ai][bj][m][1];
            u32x4* p = (u32x4*)(XB + (size_t)(row0 + ai * HALF + m * 16) * DM + col0 + bj * HALF); const u32x4 x = *p;
            u32x4 w; w.x = pk2(ALPHA * bflo(x.x) + v0[0], ALPHA * bfhi(x.x) + v0[1]); w.y = pk2(ALPHA * bflo(x.y) + v0[2], ALPHA * bfhi(x.y) + v0[3]);
            w.z = pk2(ALPHA * bflo(x.z) + v1[0], ALPHA * bfhi(x.z) + v1[1]); w.w = pk2(ALPHA * bflo(x.w) + v1[2], ALPHA * bfhi(x.w) + v1[3]);
            *p = w; }
    }
};
struct EpiG5b {
    const unsigned char* esc_; bf16* XB;
    __device__ __forceinline__ void operator()(const f32x4 (&acc)[2][2][4][2], const UnitD& u, int wr, int wc, int fr, int fq, int tid) const {
        const int row0 = u.pm * BM + wr * 64 + fr, col0 = u.pn * BM + wc * 32 + 8 * fq;
        unsigned loff = (unsigned)tid * 16u; asm volatile("" : "+v"(loff));
        const unsigned char* esc = esc_ + (size_t)u.kind * 131072 + loff;
#pragma unroll
        EPI_LOOP { const int q = (ai * 2 + bj) * 4 + m; const f32x4 v0 = acc[ai][bj][m][0], v1 = acc[ai][bj][m][1];
            const u32x4 e = *(const u32x4*)(esc + (size_t)q * 8192);
            u32x4* p = (u32x4*)(XB + (size_t)(row0 + ai * HALF + m * 16) * DM + col0 + bj * HALF); const u32x4 x = *p;
            u32x4 w; w.x = pk2(ALPHA * bflo(x.x) + v0[0] + bflo(e.x), ALPHA * bfhi(x.x) + v0[1] + bfhi(e.x)); w.y = pk2(ALPHA * bflo(x.y) + v0[2] + bflo(e.y), ALPHA * bfhi(x.y) + v0[3] + bfhi(e.y));
            w.z = pk2(ALPHA * bflo(x.z) + v1[0] + bflo(e.z), ALPHA * bfhi(x.z) + v1[1] + bfhi(e.z)); w.w = pk2(ALPHA * bflo(x.w) + v1[2] + bflo(e.w), ALPHA * bfhi(x.w) + v1[3] + bfhi(e.w));
            *p = w;
            if (m & 1) asm volatile("" ::: "memory"); }
    }
};
}

struct Frame {
    LAS unsigned char* lds;
    int tid, lane, wave, G, wg;
    unsigned char* ws; unsigned char* dob;
};
struct Args { const float* in[21]; float* out; unsigned char* ws; int ph_lo, ph_hi, sub, pad; };

__device__ __forceinline__ int z_src(int n, float& sc) {
    sc = 1.f;
    if (n < 768) { if (n < 256) sc = 0.17677669529663687f * LOG2E; return n; }
    if (n < 1536) { if (n < 1024) sc = 0.125f * LOG2E; return n; }
    if (n < 2560) { if (n >= 1792 && n < 2048) sc = 0.125f; return 1700 + (n - 1536); }
    if (n < 2816) { if (n < 2688) sc = 0.17677669529663687f; return 2724 + (n - 2560); }
    if (n < 3072) return 2980 + (n - 2816);
    if (n < 3328) return 3252 + (n - 3072);
    if (n < 3456) return 1536 + (n - 3328);
    if (n < 3488) return 1664 + (n - 3456);
    if (n < 3492) return 1696 + (n - 3488);
    if (n >= 3504 && n < 3520) return 3236 + (n - 3504);
    return -1;
}
template <int MODE>
__device__ __forceinline__ void transpose_item(const float* W, int Nsrc, int soff, bf16* WT, int dpitch, int dcol0, int k0, int n0, LAS float* scr, int lane) {
    const int nn = lane & 31; float sc = 1.f; int s;
    if (MODE == 1) s = z_src(n0 + nn, sc); else s = soff + n0 + nn;
#pragma unroll 8
    for (int i = 0; i < 32; ++i) { const int kk = 2 * i + (lane >> 5); scr[kk * 33 + nn] = (s >= 0) ? W[(size_t)(k0 + kk) * Nsrc + s] * sc : 0.f; }
    asm volatile("s_waitcnt lgkmcnt(0)" ::: "memory");
    const int c = lane & 7;
#pragma unroll
    for (int j = 0; j < 4; ++j) { const int n = (lane >> 3) + 8 * j; const LAS float* sp = scr + (8 * c) * 33 + n;
        u32x4 o; o.x = pk2(sp[0 * 33], sp[1 * 33]); o.y = pk2(sp[2 * 33], sp[3 * 33]); o.z = pk2(sp[4 * 33], sp[5 * 33]); o.w = pk2(sp[6 * 33], sp[7 * 33]);
        *(u32x4*)(WT + (size_t)(n0 + n) * dpitch + dcol0 + k0 + 8 * c) = o; }
    asm volatile("s_waitcnt lgkmcnt(0)" ::: "memory");
}
__device__ __forceinline__ void transpose_item8(const float* W, int Nsrc, int soff, unsigned char* WT, int K, int k0, int n0, LAS float* scr, int lane) {
    const int nn = lane & 31; const int s = soff + n0 + nn;
#pragma unroll 8
    for (int i = 0; i < 32; ++i) { const int kk = 2 * i + (lane >> 5); scr[kk * 33 + nn] = W[(size_t)(k0 + kk) * Nsrc + s] * 64.f; }
    asm volatile("s_waitcnt lgkmcnt(0)" ::: "memory");
    const int c = lane & 7;
#pragma unroll
    for (int j = 0; j < 4; ++j) { const int n = (lane >> 3) + 8 * j; const LAS float* sp = scr + (8 * c) * 33 + n;
        u32x2 o; o.x = pk4f8(sp[0 * 33], sp[1 * 33], sp[2 * 33], sp[3 * 33]); o.y = pk4f8(sp[4 * 33], sp[5 * 33], sp[6 * 33], sp[7 * 33]);
        *(u32x2*)(WT + (size_t)(n0 + n) * K + k0 + 8 * c) = o; }
    asm volatile("s_waitcnt lgkmcnt(0)" ::: "memory");
}
__device__ __forceinline__ void transpose_item8z(const float* W, unsigned char* WT, int tile, int slot, int k0, int n0, LAS float* scr, int lane) {
    const int nn = lane & 31; float sc = 1.f; const int s = z_src(tile * 256 + n0 + nn, sc); sc *= 64.f;
#pragma unroll 8
    for (int i = 0; i < 32; ++i) { const int kk = 2 * i + (lane >> 5); scr[kk * 33 + nn] = (s >= 0) ? W[(size_t)(k0 + kk) * NIN + s] * sc : 0.f; }
    asm volatile("s_waitcnt lgkmcnt(0)" ::: "memory");
    const int c = lane & 7;
#pragma unroll
    for (int j = 0; j < 4; ++j) { const int n = (lane >> 3) + 8 * j; const LAS float* sp = scr + (8 * c) * 33 + n;
        u32x2 o; o.x = pk4f8(sp[0 * 33], sp[1 * 33], sp[2 * 33], sp[3 * 33]); o.y = pk4f8(sp[4 * 33], sp[5 * 33], sp[6 * 33], sp[7 * 33]);
        *(u32x2*)(WT + (size_t)(slot * 256 + n0 + n) * 1024 + k0 + 8 * c) = o; }
    asm volatile("s_waitcnt lgkmcnt(0)" ::: "memory");
}
typedef __attribute__((address_space(4))) const struct Args* KArgPtr;
__device__ __forceinline__ void convert_w123(Frame& F, const float* w_in, const float* w_branch, const float* w_out) {
    LAS float* scr = (LAS float*)(F.lds + F.wave * 16384);
    const int gw = F.wg * NWAVES + F.wave, NGW = F.G * NWAVES;
    constexpr int I1 = 16 * 48, I2 = 0, I3 = 4 * 128, I4 = 16 * 32;
    unsigned char* w123 = F.ws + WS_W123;
    for (int it = gw; it < I1 + I2 + I3 + I4; it += NGW) {
        int r = it;
        if (r < I1) { const int nb = r % 48, tile = (int)((G1_BF_TILES >> (4 * (nb >> 3))) & 15); transpose_item<1>(w_in, NIN, 0, (bf16*)(w123 + W123_W1), 1024, 0, 64 * (r / 48), tile * 256 + 32 * (nb & 7), scr, F.lane); continue; } r -= I1;
        if (r < I3) { const int n = r / 128, rr = r % 128; transpose_item<0>(w_branch + (size_t)n * 256 * DM, DM, 0, (bf16*)(w123 + W123_GB + 8 * MiB) + (size_t)n * 1024 * 256, 256, 0, 64 * (rr / 32), 32 * (rr % 32), scr, F.lane); continue; } r -= I3;
        transpose_item<0>(w_out, DM, 0, (bf16*)(w123 + W123_WO), 1024, 0, 64 * (r / 32), 32 * (r % 32), scr, F.lane);
    }
}
__device__ __forceinline__ void p0_prologue(Frame& F, __attribute__((address_space(4))) const Args* Ap) {
    LAS float* scr = (LAS float*)(F.lds + F.wave * 16384);
    const int gw = F.wg * NWAVES + F.wave, NGW = F.G * NWAVES;
    constexpr int I5 = 0, I6 = 0, I7 = 4 * 32, I8 = 0;
    constexpr int IL = I5 + I6 + I7 + I8;
    for (int it = gw; it < 2 * IL; it += NGW) {
        const int l = it / IL; int r = it - l * IL;
        unsigned char* w45 = F.ws + WS_W45 + (size_t)l * W45_STRIDE;
        if (r < I7) { transpose_item<0>(Ap->in[18] + (size_t)l * PDIM * DM, DM, 0, (bf16*)(w45 + W45_PP), 256, 0, 64 * (r / 32), 32 * (r % 32), scr, F.lane); continue; } r -= I7;
        transpose_item<0>(Ap->in[16] + (size_t)l * DFF * DM, DM, 0, (bf16*)(w45 + W45_DN), DFF, 0, 64 * (r / 32), 32 * (r % 32), scr, F.lane);
    }
    {   constexpr int J1 = 16 * 128, J2 = 16 * 176, J3 = 16 * 32, J4 = 44 * 32, J5 = 8 * 16 * 8, JL = J1 + J2 + J3 + J4 + J5;
        for (int it = gw; it < 2 * JL; it += NGW) { const int l = it / JL; int r = it - l * JL; unsigned char* w8 = F.dob + DO_W8 + (size_t)l * W8_STRIDE;
            if (r < J1) { transpose_item8(Ap->in[2] + (size_t)l * DM * NIN, NIN, SRC_MG, w8 + W8_G, 1024, 64 * (r / 128), 32 * (r % 128), scr, F.lane); continue; } r -= J1;
            if (r < J2) { const int sn = 32 * (r % 176), dn = sn < DFF ? (sn >> 7) * 256 + 128 + (sn & 127) : ((sn - DFF) >> 7) * 256 + ((sn - DFF) & 127);
                transpose_item8(Ap->in[13] + (size_t)l * DM * UGW, UGW, sn - dn, w8 + W8_UP, 1024, 64 * (r / 176), dn, scr, F.lane); continue; } r -= J2;
            if (r < J3) { transpose_item8(Ap->in[17] + (size_t)l * DM * DM, DM, 0, w8 + W8_PG, 1024, 64 * (r / 32), 32 * (r % 32), scr, F.lane); continue; } r -= J3;
            if (r < J4) { transpose_item8(Ap->in[16] + (size_t)l * DFF * DM, DM, 0, w8 + W8_DN, DFF, 64 * (r / 32), 32 * (r % 32), scr, F.lane); continue; } r -= J4;
            { const int slot = r >> 7, rr = r & 127; transpose_item8z(Ap->in[2] + (size_t)l * DM * NIN, w8 + W8_Z, (int)((G1_F8_TILES >> (4 * slot)) & 15), slot, 64 * (rr >> 3), 32 * (rr & 7), scr, F.lane); } } }
    convert_w123(F, Ap->in[2], Ap->in[9], Ap->in[10]);
    {   const size_t n8 = (size_t)M * DM / 8; const f32x4* src = (const f32x4*)Ap->in[0]; u32x4* dst = (u32x4*)(F.ws + WS_XB); u32x2* dst8 = (u32x2*)(F.dob + DO_XB8);
        for (size_t i = (size_t)F.wg * 512 + F.tid; i < n8; i += (size_t)F.G * 512) { const f32x4 a = src[2 * i], b = src[2 * i + 1]; u32x4 o; o.x = pk2(a[0], a[1]); o.y = pk2(a[2], a[3]); o.z = pk2(b[0], b[1]); o.w = pk2(b[2], b[3]); dst[i] = o;
            u32x2 o8; o8.x = pk4f8(a[0], a[1], a[2], a[3]); o8.y = pk4f8(b[0], b[1], b[2], b[3]); dst8[i] = o8; } }
    {   const size_t n8 = (size_t)DEPTH * M * PDIM / 8; const f32x4* src = (const f32x4*)Ap->in[1]; u32x4* dst = (u32x4*)(F.ws + WS_PB);
        for (size_t i = (size_t)F.wg * 512 + F.tid; i < n8; i += (size_t)F.G * 512) { const f32x4 a = src[2 * i], b = src[2 * i + 1]; u32x4 o; o.x = pk2(a[0], a[1]); o.y = pk2(a[2], a[3]); o.z = pk2(b[0], b[1]); o.w = pk2(b[2], b[3]); dst[i] = o; } }
}

__device__ __forceinline__ void ln_phase(Frame& F, const float* w, const float* bvec, float* outf, unsigned char* xb8) {
    const int gw = F.wg * NWAVES + F.wave, NGW = F.G * NWAVES;
    bf16* XB = (bf16*)(F.ws + WS_XB);
    for (int row = gw; row < M; row += NGW) {
        u32x4* p = (u32x4*)(XB + (size_t)row * DM) + F.lane;
        const u32x4 a = p[0], b = p[64];
        float v[16] = {bflo(a.x), bfhi(a.x), bflo(a.y), bfhi(a.y), bflo(a.z), bfhi(a.z), bflo(a.w), bfhi(a.w), bflo(b.x), bfhi(b.x), bflo(b.y), bfhi(b.y), bflo(b.z), bfhi(b.z), bflo(b.w), bfhi(b.w)};
        float s = 0.f;
#pragma unroll
        for (int i = 0; i < 16; ++i) s += v[i];
        const float mean = wave_sum(s, F.lane) * (1.f / DM); float q = 0.f;
#pragma unroll
        for (int i = 0; i < 16; ++i) { v[i] -= mean; q += v[i] * v[i]; }
        const float rstd = 1.f / sqrtf(wave_sum(q, F.lane) * (1.f / DM) + LN_EPS);
        const int c0 = F.lane * 8, c1 = 512 + F.lane * 8;
        const f32x4 w0 = *(const f32x4*)(w + c0), w1 = *(const f32x4*)(w + c0 + 4), w2 = *(const f32x4*)(w + c1), w3 = *(const f32x4*)(w + c1 + 4);
        const f32x4 b0 = *(const f32x4*)(bvec + c0), b1 = *(const f32x4*)(bvec + c0 + 4), b2 = *(const f32x4*)(bvec + c1), b3 = *(const f32x4*)(bvec + c1 + 4);
        f32x4 y0, y1, y2, y3;
#pragma unroll
        for (int i = 0; i < 4; ++i) { y0[i] = v[i] * rstd * w0[i] + b0[i]; y1[i] = v[4 + i] * rstd * w1[i] + b1[i]; y2[i] = v[8 + i] * rstd * w2[i] + b2[i]; y3[i] = v[12 + i] * rstd * w3[i] + b3[i]; }
        u32x4 o0, o1; o0.x = pk2(y0[0], y0[1]); o0.y = pk2(y0[2], y0[3]); o0.z = pk2(y1[0], y1[1]); o0.w = pk2(y1[2], y1[3]);
        o1.x = pk2(y2[0], y2[1]); o1.y = pk2(y2[2], y2[3]); o1.z = pk2(y3[0], y3[1]); o1.w = pk2(y3[2], y3[3]);
        p[0] = o0; p[64] = o1;
        if (xb8) { u32x2* q8 = (u32x2*)(xb8 + (size_t)row * DM) + F.lane; u32x2 a8, b8; a8.x = pk4f8(y0[0], y0[1], y0[2], y0[3]); a8.y = pk4f8(y1[0], y1[1], y1[2], y1[3]); b8.x = pk4f8(y2[0], y2[1], y2[2], y2[3]); b8.y = pk4f8(y3[0], y3[1], y3[2], y3[3]); q8[0] = a8; q8[64] = b8; }
        if (outf) { f32x4* op = (f32x4*)(outf + (size_t)row * DM); op[2 * F.lane] = y0; op[2 * F.lane + 1] = y1; op[128 + 2 * F.lane] = y2; op[128 + 2 * F.lane + 1] = y3; }
    }
}

__device__ __forceinline__ float gelu_tanh_(float y) { const float t = 1.5957691216057308f * (y + 0.044715f * y * y * y); return y * __builtin_amdgcn_rcpf(1.0f + __builtin_amdgcn_exp2f(-LOG2E * t)); }
__device__ __forceinline__ void ffn_act_phase(Frame& F, const float* cw, const float* cb) {
    const bf16* GE = (const bf16*)(F.ws + WS_GE); const bf16* G0 = (const bf16*)(F.ws + WS_G0); const bf16* U0 = (const bf16*)(F.ws + WS_U0); unsigned char* ACT8 = F.ws + WS_ACT8;
    for (int idx = F.wg * 512 + F.tid; idx < 512 * 2 * 352; idx += F.G * 512) {
        const int v = idx % 352, t = idx / 352, r = t & 1, rb = t >> 1; const int gc = 8 * v;
        const size_t eb = (size_t)rb * 2 * DFF + gc, ebp = (size_t)(rb - 1) * 2 * DFF + gc; const bool first = (rb & 127) == 0;
        const u32x4 z4 = (u32x4){0u, 0u, 0u, 0u};
        float gA[8], gB[8], gC[8], uu[8];
        if (r == 0) { up8(first ? z4 : *(const u32x4*)(GE + ebp), gA); up8(first ? z4 : *(const u32x4*)(GE + ebp + DFF), gB); up8(*(const u32x4*)(G0 + eb), gC); }
        else { up8(first ? z4 : *(const u32x4*)(GE + ebp + DFF), gA); up8(*(const u32x4*)(G0 + eb), gB); up8(*(const u32x4*)(G0 + eb + DFF), gC); }
        up8(*(const u32x4*)(U0 + eb + (size_t)r * DFF), uu);
        float o[8];
#pragma unroll
        for (int i = 0; i < 8; ++i) { const float y = cb[gc + i] + cw[gc + i] * gA[i] + cw[DFF + gc + i] * gB[i] + cw[2 * DFF + gc + i] * gC[i]; o[i] = gelu_tanh_(y) * uu[i]; }
        u32x2 w8; w8.x = pk4f8(o[0], o[1], o[2], o[3]); w8.y = pk4f8(o[4], o[5], o[6], o[7]);
        *(u32x2*)(ACT8 + (size_t)(rb * 64 + r) * DFF + gc) = w8;
    }
}

namespace mx {
__device__ __forceinline__ f32x16 mfma32(bf16x8 a, bf16x8 b, f32x16 c) { return __builtin_amdgcn_mfma_f32_32x32x16_bf16(a, b, c, 0, 0, 0); }
__device__ __forceinline__ f32x16 splat16(float v) { f32x16 r;
#pragma unroll
    for (int i = 0; i < 16; ++i) r[i] = v;
    return r; }
__device__ __forceinline__ int crow_c(int e) { return (e & 3) + 8 * (e >> 2); }
typedef short v4i16_t __attribute__((ext_vector_type(4)));
__device__ __forceinline__ s16x4 vtr(const LAS unsigned char* p) { return __builtin_bit_cast(s16x4, __builtin_amdgcn_ds_read_tr16_b64_v4i16((LAS v4i16_t*)p)); }
__device__ __forceinline__ bf16x8 pack8(float a0, float a1, float a2, float a3, float a4, float a5, float a6, float a7) {
    u32x4 w; w.x = pk2(a0, a1); w.y = pk2(a2, a3); w.z = pk2(a4, a5); w.w = pk2(a6, a7); return __builtin_bit_cast(bf16x8, w); }

__device__ __forceinline__ bf16x8 tr_frag(const LAS unsigned char* T, int key0, int cblk, int lane) {
    const LAS unsigned char* p = T + (key0 + 4 * (lane >> 5) + ((lane & 15) >> 2)) * 144 + (32 * cblk + 16 * ((lane >> 4) & 1) + 4 * (lane & 3)) * 2;
    const s16x4 lo = vtr(p), hi = vtr(p + 8 * 144); return (bf16x8){lo[0], lo[1], lo[2], lo[3], hi[0], hi[1], hi[2], hi[3]}; }
__device__ __forceinline__ float log2gam(int h) { return __builtin_log2f(1.0f - __builtin_exp2f(-5.0f - (float)h)); }
__device__ __forceinline__ void prepkv_unit(Frame& F, int blk, const float* wa2, const float* bap, unsigned* kmaxl) {
    bf16* Z = (bf16*)(F.ws + WS_Z);
    const size_t r0 = (size_t)blk * 256; const int b = blk >> 5, cb = blk & 31;
    const int tid = F.tid;
    {   const int ch = tid >> 7, col = tid & 127;
        const float ba = bap[col];
        float wa[16];
#pragma unroll
        for (int r = 0; r < 16; ++r) wa[r] = wa2[r * 128 + col];
        float cum = 0.f;
        for (int t0 = 0; t0 < 64; t0 += 8) { u32x4 A[8], B[8];
#pragma unroll
            for (int tt = 0; tt < 8; ++tt) { const bf16* zr = Z + (r0 + ch * 64 + t0 + tt) * ZW; A[tt] = *(const u32x4*)(zr + ZC_DA); B[tt] = *(const u32x4*)(zr + ZC_DA + 8); }
#pragma unroll
            for (int tt = 0; tt < 8; ++tt) { float da[8], db[8]; up8(A[tt], da); up8(B[tt], db); float x = ba;
#pragma unroll
                for (int r = 0; r < 8; ++r) x += da[r] * wa[r];
#pragma unroll
                for (int r = 0; r < 8; ++r) x += db[r] * wa[8 + r];
                cum += (fminf(x, 0.f) - __logf(1.0f + __expf(-fabsf(x)))) * 0.0625f; } }
        const float bl = cum; cum = 0.f;
        for (int t0 = 0; t0 < 64; t0 += 8) { u32x4 A[8], B[8]; bf16 qv[8], kv[8];
#pragma unroll
            for (int tt = 0; tt < 8; ++tt) { const bf16* zr = Z + (r0 + ch * 64 + t0 + tt) * ZW; A[tt] = *(const u32x4*)(zr + ZC_DA); B[tt] = *(const u32x4*)(zr + ZC_DA + 8); qv[tt] = zr[ZC_DQ + col]; kv[tt] = zr[ZC_DK + col]; }
#pragma unroll
            for (int tt = 0; tt < 8; ++tt) { bf16* zr = Z + (r0 + ch * 64 + t0 + tt) * ZW; float da[8], db[8]; up8(A[tt], da); up8(B[tt], db); float x = ba;
#pragma unroll
                for (int r = 0; r < 8; ++r) x += da[r] * wa[r];
#pragma unroll
                for (int r = 0; r < 8; ++r) x += db[r] * wa[8 + r];
                cum += (fminf(x, 0.f) - __logf(1.0f + __expf(-fabsf(x)))) * 0.0625f;
                zr[ZC_DQ + col] = (bf16)f2bf(bf1(qv[tt]) * __expf(cum - bl)); zr[ZC_DK + col] = (bf16)f2bf(bf1(kv[tt]) * __expf(bl - cum)); } }
        ((float*)(F.ws + WS_DE))[((size_t)b * 128 + cb * 4 + ch) * 128 + col] = __expf(bl);
    }
    for (int itn = 0; itn < 6; ++itn) { const int task = tid + 512 * itn, sl = task >> 8, row = task & 255;
        const bf16* kp = Z + (r0 + row) * ZW + (sl < 8 ? ZC_AK + (sl >> 1) * 64 + (sl & 1) * 32 : ZC_BK + (sl - 8) * 64); float ss = 0.f;
        const int nch = sl < 8 ? 4 : 8;
        for (int c = 0; c < nch; ++c) { float v[8]; up8(*(const u32x4*)(kp + 8 * c), v);
#pragma unroll
            for (int i = 0; i < 8; ++i) ss += v[i] * v[i]; }
#pragma unroll
        for (int o = 1; o < 64; o <<= 1) ss = fmaxf(ss, shx(ss, F.lane, o));
        if (F.lane == 0) __hip_atomic_fetch_max(kmaxl + b * 16 + sl, __float_as_uint(sqrtf(ss)), __ATOMIC_RELAXED, __HIP_MEMORY_SCOPE_AGENT); }
    for (int i0 = 0; i0 < 32; i0 += 4) { u32x4 vv[4];
#pragma unroll
        for (int k = 0; k < 4; ++k) { const int idx = tid + 512 * (i0 + k); const int row = idx >> 6, chunk = idx & 63, isk = chunk >> 5, c8 = (chunk & 31) * 8;
            vv[k] = *(const u32x4*)(Z + (r0 + row) * ZW + (isk ? ZC_CK : ZC_CQ) + c8); }
#pragma unroll
        for (int k = 0; k < 4; ++k) { const int idx = tid + 512 * (i0 + k); const int row = idx >> 6, chunk = idx & 63, isk = chunk >> 5, c8 = (chunk & 31) * 8, h = c8 >> 6;
            const float e = (float)(255 - row) * log2gam(h); const float f = __builtin_amdgcn_exp2f(isk ? e : -e); float v[8]; up8(vv[k], v);
            u32x4 w; w.x = pk2(v[0] * f, v[1] * f); w.y = pk2(v[2] * f, v[3] * f); w.z = pk2(v[4] * f, v[5] * f); w.w = pk2(v[6] * f, v[7] * f);
            *(u32x4*)(Z + (r0 + row) * ZW + (isk ? ZC_CK : ZC_CQ) + c8) = w; } }
    __threadfence_block(); __syncthreads();
    LAS unsigned char* Kl = F.lds; LAS unsigned char* Vl = F.lds + 36864;
    for (int h = 0; h < 4; ++h) {
        for (int idx = tid; idx < 256 * 8; idx += 512) { const int row = idx >> 3, c = idx & 7;
            *(LAS u32x4*)(Kl + row * 144 + c * 16) = *(const u32x4*)(Z + (r0 + row) * ZW + ZC_CK + h * 64 + c * 8);
            *(LAS u32x4*)(Vl + row * 144 + c * 16) = *(const u32x4*)(Z + (r0 + row) * ZW + ZC_CV + h * 64 + c * 8); }
        __syncthreads();
        if (F.wave < 4) {
            const int db = F.wave & 1, nb = F.wave >> 1; f32x16 acc = splat16(0.f);
#pragma unroll 4
            for (int kb = 0; kb < 16; ++kb) acc = mfma32(tr_frag(Vl, 16 * kb, db, F.lane), tr_frag(Kl, 16 * kb, nb, F.lane), acc);
            float* o = (float*)(F.ws + WS_KVC) + ((size_t)((b * 4 + h) * 32 + cb) * 4096) + 32 * nb + (F.lane & 31);
#pragma unroll
            for (int e = 0; e < 16; ++e) o[(32 * db + crow_c(e) + 4 * (F.lane >> 5)) * 64] = acc[e]; }
        __syncthreads();
        for (int idx = tid; idx < 256 * 8; idx += 512) { const int row = idx >> 3, c = idx & 7;
            if (c < 4) *(LAS u32x4*)(Kl + row * 144 + c * 16) = *(const u32x4*)(Z + (r0 + row) * ZW + ZC_DK + h * 32 + c * 8);
            *(LAS u32x4*)(Vl + row * 144 + c * 16) = *(const u32x4*)(Z + (r0 + row) * ZW + ZC_DV + h * 64 + c * 8); }
        __syncthreads();
        {   const int ch = F.wave >> 1, db = F.wave & 1; f32x16 acc = splat16(0.f);
#pragma unroll
            for (int kb = 0; kb < 4; ++kb) acc = mfma32(tr_frag(Vl, 64 * ch + 16 * kb, db, F.lane), tr_frag(Kl, 64 * ch + 16 * kb, 0, F.lane), acc);
            float* o = (float*)(F.ws + WS_KVD) + ((size_t)((b * 4 + h) * 128 + cb * 4 + ch) * 2048) + (F.lane & 31);
#pragma unroll
            for (int e = 0; e < 16; ++e) o[(32 * db + crow_c(e) + 4 * (F.lane >> 5)) * 32] = acc[e]; }
        __syncthreads();
    }
}

__device__ __forceinline__ void scan_phase(Frame& F) {
    const int gt = F.wg * 512 + F.tid, NT = F.G * 512;
    for (int e0 = gt; e0 < 16 * 4096 + 16 * 2048; e0 += NT) {
        if (e0 < 16 * 4096) { const int e = e0;
            const int bh = e >> 12, idx = e & 4095, h = bh & 3; const float g256 = __builtin_amdgcn_exp2f(256.0f * log2gam(h));
            float* p = (float*)(F.ws + WS_KVC) + (size_t)bh * 32 * 4096 + idx; float S = 0.f; float kv[32];
#pragma unroll
            for (int c = 0; c < 32; ++c) kv[c] = p[(size_t)c * 4096];
#pragma unroll
            for (int c = 0; c < 32; ++c) { const float Sp = g256 * S; p[(size_t)c * 4096] = Sp; S = Sp + kv[c]; }
        } else { const int e = e0 - 16 * 4096;
            const int bh = e >> 11, idx = e & 2047, b = bh >> 2, h = bh & 3, dk = idx & 31;
            float* p = (float*)(F.ws + WS_KVD) + (size_t)bh * 128 * 2048 + idx; const float* de = (const float*)(F.ws + WS_DE) + (size_t)b * 128 * 128 + h * 32 + dk; float S = 0.f;
            for (int c0 = 0; c0 < 128; c0 += 16) { float kv[16], dd[16];
#pragma unroll
                for (int c = 0; c < 16; ++c) { kv[c] = p[(size_t)(c0 + c) * 2048]; dd[c] = de[(c0 + c) * 128]; }
#pragma unroll
                for (int c = 0; c < 16; ++c) { const float Sp = dd[c] * S; p[(size_t)(c0 + c) * 2048] = Sp; S = Sp + kv[c]; } }
        }
    }
}

constexpr int HPITCH = 1026, CAP = 256;
struct QState { unsigned mode, thr_lo, thr_hi, thr_idx, krem, lcount, pad0, pad1; };
__device__ __forceinline__ unsigned okey_of(float s) { const unsigned u = __float_as_uint(s); return u ^ ((unsigned)((int)u >> 31) | 0x80000000u); }
__device__ __forceinline__ void b1_load(const unsigned char* IKb, int t, int lane, bf16x8& k0, bf16x8& k1) {
    const unsigned char* p = IKb + (size_t)t * 2048 + lane * 16; k0 = *(const bf16x8*)p; k1 = *(const bf16x8*)(p + 1024); }
__device__ __forceinline__ void b1_scores(const bf16x8 k0, const bf16x8 k1, const bf16x8 (&iqf)[4][2], const float (&w)[4], float (&sc)[16]) {
#pragma unroll
    for (int e = 0; e < 16; ++e) sc[e] = 0.f;
#pragma unroll
    for (int ih = 0; ih < 4; ++ih) { f32x16 lg = mfma32(k0, iqf[ih][0], splat16(0.f)); lg = mfma32(k1, iqf[ih][1], lg);
#pragma unroll
        for (int e = 0; e < 16; ++e) sc[e] = fmaf(w[ih], __builtin_amdgcn_fmed3f(lg[e], 0.f, __builtin_inff()), sc[e]); }
}
__device__ __forceinline__ void b1_setbit(LAS unsigned* MWq, unsigned j) {
    const unsigned wi = j & 31u, hh = (wi >> 2) & 1u, e = (wi & 3u) + 4u * (wi >> 3), kh = (j >> 5) & 1u;
    __hip_atomic_fetch_or(MWq + (j >> 6) * 64 + 32u * hh, 1u << (e + 16u * kh), __ATOMIC_RELAXED, __HIP_MEMORY_SCOPE_WORKGROUP);
}
template <bool DIAG>
__device__ __forceinline__ void b1_hist_tile(LAS unsigned* hrow, const float (&sc)[16], int jbase, int qpos) {
#pragma unroll
    for (int e = 0; e < 16; ++e) { if (!DIAG || jbase + crow_c(e) <= qpos) { const unsigned bin = okey_of(sc[e]) >> 21;
        __hip_atomic_fetch_add(hrow + (bin >> 1), 1u << ((bin & 1) * 16), __ATOMIC_RELAXED, __HIP_MEMORY_SCOPE_WORKGROUP); } }
}
template <bool DIAG>
__device__ __forceinline__ unsigned b1_mask_tile(const float (&sc)[16], int jbase, int qpos, float tlo_f, float thi_f, unsigned mode, unsigned word, LAS QState* qs, LAS unsigned char* lds, int r) {
#pragma unroll
    for (int e = 15; e >= 0; --e) { const float s = sc[e]; const int j = jbase + crow_c(e); const bool valid = !DIAG || (j <= qpos);
        if (DIAG) word = word + word + ((valid && s > thi_f) ? 1u : 0u);
        else asm("v_cmp_gt_f32 vcc, %1, %2\n\tv_addc_co_u32 %0, vcc, %0, %0, vcc" : "+v"(word) : "v"(s), "v"(thi_f) : "vcc");
        if (valid && s >= tlo_f && !(s > thi_f)) {
            if (mode == 1u) { const unsigned pos = __hip_atomic_fetch_add(&qs->lcount, 1u, __ATOMIC_RELAXED, __HIP_MEMORY_SCOPE_WORKGROUP);
                if (pos < (unsigned)CAP) { LAS unsigned* le = (LAS unsigned*)(lds + ((size_t)r * CAP + pos) * 8); le[0] = okey_of(s); le[1] = (unsigned)j; } }
            else __hip_atomic_fetch_or((LAS unsigned*)(lds + 65536 + r * 1024) + (j >> 5), 1u << (j & 31), __ATOMIC_RELAXED, __HIP_MEMORY_SCOPE_WORKGROUP); } }
    return word;
}
__device__ __forceinline__ unsigned rowsum16(unsigned v) {
    v += (unsigned)__builtin_amdgcn_update_dpp(0, (int)v, 0x128, 0xf, 0xf, true); v += (unsigned)__builtin_amdgcn_update_dpp(0, (int)v, 0x124, 0xf, 0xf, true);
    v += (unsigned)__builtin_amdgcn_update_dpp(0, (int)v, 0x122, 0xf, 0xf, true); v += (unsigned)__builtin_amdgcn_update_dpp(0, (int)v, 0x121, 0xf, 0xf, true); return v; }
__device__ __forceinline__ float b1_fkey(unsigned k) { return __uint_as_float((k & 0x80000000u) ? (k ^ 0x80000000u) : ~k); }
__device__ __forceinline__ void b1_unit(Frame& F, int b, int g) {
    const int tid = F.tid, lane = F.lane, r = lane & 31, hh = lane >> 5, wid = F.wave;
    const bf16* Zb = (const bf16*)(F.ws + WS_Z) + (size_t)b * SEQ * ZW;
    const unsigned char* IKb = F.ws + WS_IKC + (size_t)b * (SEQ / 32) * 2048;
    LAS unsigned* hist = (LAS unsigned*)F.lds;
    LAS QState* qst = (LAS QState*)(F.lds + QST_OFF);
    const int qpos = 32 * g + r;
    unsigned* MWb = (unsigned*)(F.ws + WS_MASK) + ((size_t)(b * 256 + g) * 128) * 64;
    LAS unsigned* MWl = (LAS unsigned*)(F.lds + 98304);
    bf16x8 iqf[4][2]; float w[4];
    {   const bf16* qr = Zb + (size_t)qpos * ZW;
#pragma unroll
        for (int ih = 0; ih < 4; ++ih) { iqf[ih][0] = *(const bf16x8*)(qr + ZC_IQ + ih * 32 + 8 * hh); iqf[ih][1] = *(const bf16x8*)(qr + ZC_IQ + ih * 32 + 16 + 8 * hh); w[ih] = bf1(qr[ZC_IW + ih]); } }
    if (g >= 8) {
        for (int i = tid; i < 32 * HPITCH; i += 512) hist[i] = 0u;
        __syncthreads();
        {   LAS unsigned* hrow = hist + r * HPITCH;
            bf16x8 a0 = iqf[0][0], a1 = iqf[0][0], c0 = iqf[0][0], c1 = iqf[0][0]; int t = wid;
            if (t <= g) b1_load(IKb, t, lane, a0, a1);
            if (t + 8 <= g) b1_load(IKb, t + 8, lane, c0, c1);
            for (; t < g; t += 8) { const bf16x8 k0 = a0, k1 = a1; a0 = c0; a1 = c1; if (t + 16 <= g) b1_load(IKb, t + 16, lane, c0, c1);
                float sc[16]; b1_scores(k0, k1, iqf, w, sc); b1_hist_tile<false>(hrow, sc, 32 * t + 4 * hh, qpos); }
            if (t == g) { float sc[16]; b1_scores(a0, a1, iqf, w, sc); b1_hist_tile<true>(hrow, sc, 32 * t + 4 * hh, qpos); } }
        __syncthreads();
        for (int qq = 0; qq < 4; ++qq) { const int q = 4 * wid + qq; const LAS unsigned* hq = hist + q * HPITCH;
            const int wbase = 1008 - 16 * lane; unsigned s = 0;
#pragma unroll
            for (int k = 0; k < 16; ++k) { const unsigned x = hq[wbase + k]; s += (x & 0xffffu) + (x >> 16); }
            unsigned P = s;
#pragma unroll
            for (int o = 1; o < 64; o <<= 1) { const unsigned t = shup(P, lane, o); if (lane >= o) P += t; }
            const unsigned long long bal = __ballot(P >= 256u);
            const int Lsel = bal ? __builtin_ctzll(bal) : 63;
            if (lane == Lsel) { unsigned cum = P - s; unsigned b1 = 0, cin = 0, cab = 0;
                for (int k = 0; k < 32; ++k) { const int bin = 2047 - 32 * lane - k; const unsigned x = hq[bin >> 1]; const unsigned c = (bin & 1) ? (x >> 16) : (x & 0xffffu);
                    if (cum + c >= 256u) { b1 = (unsigned)bin; cin = c; cab = cum; break; } cum += c; }
                qst[q].thr_lo = b1 << 21; qst[q].thr_hi = (b1 << 21) | 0x1fffffu; qst[q].thr_idx = 0xffffu; qst[q].krem = 256u - cab; qst[q].lcount = 0u; qst[q].pad0 = cin; qst[q].pad1 = 0u;
                qst[q].mode = (b1 == 1024u || cin > (unsigned)CAP) ? 2u : 1u; }
        }
        __syncthreads();
        for (int i = tid; i < 32 * 256; i += 512) ((LAS unsigned*)(F.lds + 65536))[i] = 0u;
        __syncthreads();
    }
    {   unsigned mode = 0u; float tlo_f = __builtin_inff(), thi_f = -__builtin_inff();
        if (g >= 8) { mode = qst[r].mode; const unsigned tlo = qst[r].thr_lo, thi = qst[r].thr_hi; tlo_f = b1_fkey(tlo); thi_f = (thi == 0x7fffffffu) ? __uint_as_float(0x80000001u) : b1_fkey(thi); }
        const int nk = g >> 1; LAS QState* qs = &qst[r];
        bf16x8 a0 = iqf[0][0], a1 = iqf[0][0], a2 = iqf[0][0], a3 = iqf[0][0], c0 = iqf[0][0], c1 = iqf[0][0], c2 = iqf[0][0], c3 = iqf[0][0]; int kt = wid;
        if (kt <= nk) { b1_load(IKb, 2 * kt, lane, a0, a1); if (2 * kt + 1 <= g) b1_load(IKb, 2 * kt + 1, lane, a2, a3); }
        if (kt + 8 <= nk) { b1_load(IKb, 2 * kt + 16, lane, c0, c1); if (2 * kt + 17 <= g) b1_load(IKb, 2 * kt + 17, lane, c2, c3); }
        for (; kt < nk; kt += 8) {
            const bf16x8 k0 = a0, k1 = a1, k2 = a2, k3 = a3; a0 = c0; a1 = c1; a2 = c2; a3 = c3;
            if (kt + 16 <= nk) { b1_load(IKb, 2 * kt + 32, lane, c0, c1); if (2 * kt + 33 <= g) b1_load(IKb, 2 * kt + 33, lane, c2, c3); }
            unsigned word = 0u;
            { float sc[16]; b1_scores(k2, k3, iqf, w, sc); word = b1_mask_tile<false>(sc, 32 * (2 * kt + 1) + 4 * hh, qpos, tlo_f, thi_f, mode, word, qs, F.lds, r); }
            { float sc[16]; b1_scores(k0, k1, iqf, w, sc); word = b1_mask_tile<false>(sc, 32 * (2 * kt) + 4 * hh, qpos, tlo_f, thi_f, mode, word, qs, F.lds, r); }
            MWl[kt * 64 + lane] = word; }
        if (kt == nk) {
            unsigned word = 0u;
            if (2 * kt + 1 <= g) { float sc[16]; b1_scores(a2, a3, iqf, w, sc); word = b1_mask_tile<true>(sc, 32 * (2 * kt + 1) + 4 * hh, qpos, tlo_f, thi_f, mode, word, qs, F.lds, r); }
            word <<= (2 * kt + 1 <= g) ? 0 : 16;
            { float sc[16]; b1_scores(a0, a1, iqf, w, sc); word = b1_mask_tile<true>(sc, 32 * (2 * kt) + 4 * hh, qpos, tlo_f, thi_f, mode, word, qs, F.lds, r); }
            MWl[kt * 64 + lane] = word; }
    }
    __syncthreads();
    if (g >= 8) {
        {
            const int q = 4 * wid + (lane >> 4), sl = lane & 15; LAS unsigned* MWq = MWl + q;
            unsigned L = qst[q].lcount; if (L > (unsigned)CAP) L = CAP; if (qst[q].mode != 1u) L = 0u;
            const LAS unsigned* lb = (const LAS unsigned*)(F.lds + (size_t)q * CAP * 8);
            unsigned key[16], jj[16];
#pragma unroll
            for (int k = 0; k < 16; ++k) { const unsigned c = sl + 16 * k; const bool has = c < L; key[k] = has ? ((lb[2 * c] & 0x1fffffu) | 0x200000u) : 0u; jj[k] = has ? lb[2 * c + 1] : 0u; }
            unsigned prefix = 0x200000u, need = qst[q].krem;
            for (int bit = 20; bit >= 0; --bit) { const unsigned want = (prefix >> bit) | 1u; unsigned cnt = 0;
#pragma unroll
                for (int k = 0; k < 16; ++k) cnt += ((key[k] >> bit) == want) ? 1u : 0u;
                cnt = rowsum16(cnt);
                if (cnt >= need) prefix |= (1u << bit); else need -= cnt; }
            unsigned ties = 0;
#pragma unroll
            for (int k = 0; k < 16; ++k) ties += (key[k] == prefix) ? 1u : 0u;
            ties = rowsum16(ties);
            unsigned p2 = 0u;
            if (__ballot(ties != need && L != 0u)) { p2 = 0x2000u; unsigned need2 = need;
                for (int bit = 12; bit >= 0; --bit) { const unsigned want = (p2 >> bit) | 1u; unsigned cnt = 0;
#pragma unroll
                    for (int k = 0; k < 16; ++k) cnt += (key[k] == prefix && (((0x2000u | (8191u - jj[k])) >> bit) == want)) ? 1u : 0u;
                    cnt = rowsum16(cnt);
                    if (cnt >= need2) p2 |= (1u << bit); else need2 -= cnt; } }
#pragma unroll
            for (int k = 0; k < 16; ++k) if (key[k] > prefix || (key[k] == prefix && (0x2000u | (8191u - jj[k])) >= p2)) b1_setbit(MWq, jj[k]);
        }
        for (int qq = 0; qq < 4; ++qq) { const int q = 4 * wid + qq; const unsigned mode = qst[q].mode, krem = qst[q].krem; LAS unsigned* MWq = MWl + q;
            if (mode == 1u) continue;
            { const LAS unsigned* bm = (const LAS unsigned*)(F.lds + 65536 + q * 1024); unsigned x[4]; unsigned s = 0;
#pragma unroll
                for (int k = 0; k < 4; ++k) { x[k] = bm[4 * lane + k]; s += __builtin_popcount(x[k]); }
                unsigned P = s;
#pragma unroll
                for (int o = 1; o < 64; o <<= 1) { const unsigned t = shup(P, lane, o); if (lane >= o) P += t; }
                unsigned before = P - s;
#pragma unroll
                for (int k = 0; k < 4; ++k) { unsigned y = x[k]; while (y != 0u && before < krem) { const unsigned bit = (unsigned)__builtin_ctz(y); y &= y - 1u; b1_setbit(MWq, 32u * (4 * lane + k) + bit); ++before; } before += __builtin_popcount(y); } }
        }
        __syncthreads();
    }
    {   const int nw4 = ((g >> 1) + 1) * 16;
        for (int i = tid; i < nw4; i += 512) *(u32x4*)(MWb + 4 * i) = *(const LAS u32x4*)(MWl + 4 * i); }
}

struct EngP { const bf16* Z; bf16* Y; const unsigned* MASK; const float* ST; const float* nw; float lam, lam_init; const unsigned* kmax; };
__device__ __forceinline__ int wq_next(Frame& F, unsigned* head) {
    LAS int* slot = (LAS int*)(F.lds + 55312);
    if (F.tid == 0) *slot = (int)__hip_atomic_fetch_add(head, 1u, __ATOMIC_RELAXED, __HIP_MEMORY_SCOPE_AGENT);
    __syncthreads(); const int u = *slot; __syncthreads();
    asm volatile("" : "+v"(F.tid), "+v"(F.lane));
    return u;
}
template <int MODE>
__device__ __forceinline__ void eng_unit(Frame& F, const EngP& P, int b, int h, int qb) {
    constexpr bool SOFT = MODE <= 1;
    constexpr int NMAP = MODE == 0 ? 2 : 1;
    constexpr int NS = (MODE == 0 || MODE == 3) ? 2 : 4;
    constexpr int KCH = MODE == 3 ? 4 : 8;
    constexpr int QC = MODE == 0 ? ZC_AQ : MODE == 1 ? ZC_BQ : MODE == 2 ? ZC_CQ : ZC_DQ;
    constexpr int KC = MODE == 0 ? ZC_AK : MODE == 1 ? ZC_BK : MODE == 2 ? ZC_CK : ZC_DK;
    constexpr int VC = MODE == 0 ? ZC_AV : MODE == 1 ? ZC_BV : MODE == 2 ? ZC_CV : ZC_DV;
    constexpr int HW = MODE == 3 ? 32 : 64;
    const int tid = F.tid, lane = F.lane, r = lane & 31, hh = lane >> 5, w = F.wave;
    const size_t rowbase = (size_t)b * SEQ;
    const int qw0 = qb * 256 + 32 * w;
    const float NEG = -__builtin_inff();
    const int hidx = MODE <= 1 ? (MODE == 0 ? 2 * h + 1 : 2 * h + 2) : 0;
    const float slope2 = SOFT ? __builtin_amdgcn_exp2f(-(float)hidx) * LOG2E : 0.f;
    bf16x8 qf[NMAP][NS];
    {   const bf16* qrow = P.Z + (rowbase + qw0 + r) * ZW + QC + h * HW;
#pragma unroll
        for (int m = 0; m < NMAP; ++m)
#pragma unroll
            for (int s = 0; s < NS; ++s) qf[m][s] = *(const bf16x8*)(qrow + m * 32 + 16 * s + 8 * hh); }
    f32x16 cinit;
#pragma unroll
    for (int e = 0; e < 16; ++e) cinit[e] = SOFT ? slope2 * (float)(crow_c(e) + 4 * hh) : 0.f;
    float m_run[NMAP], l_run[NMAP]; f32x16 O[NMAP][2];
#pragma unroll
    for (int m = 0; m < NMAP; ++m) { m_run[m] = NEG; l_run[m] = 0.f; O[m][0] = splat16(0.f); O[m][1] = splat16(0.f); }
    if (!SOFT) {
        const int sidx = MODE == 2 ? ((b * 4 + h) * 32 + qb) : ((b * 4 + h) * 128 + 4 * qb + (w >> 1));
        const float* sp = P.ST + (size_t)sidx * (64 * HW);
#pragma unroll
        for (int db = 0; db < 2; ++db)
#pragma unroll
            for (int s = 0; s < NS; ++s) { const float* a = sp + (size_t)(32 * db + r) * HW + 16 * s + 8 * hh; const f32x4 a0 = *(const f32x4*)a, a1 = *(const f32x4*)(a + 4);
                O[0][db] = mfma32(pack8(a0[0], a0[1], a0[2], a0[3], a1[0], a1[1], a1[2], a1[3]), qf[0][s], O[0][db]); }
    }
    const int kt_lo = SOFT ? 0 : 4 * qb, kt_hi = 4 * qb + 3;
    const int srow = tid >> 3, sch = tid & 7;
    float qk[NMAP];
    if (SOFT) {
#pragma unroll
        for (int m = 0; m < NMAP; ++m) { float ss = 0.f;
#pragma unroll
            for (int s = 0; s < NS; ++s) { const u32x4 qq = __builtin_bit_cast(u32x4, qf[m][s]); float v[8]; up8(qq, v);
#pragma unroll
                for (int i = 0; i < 8; ++i) ss += v[i] * v[i]; }
            ss += shx(ss, lane, 32);
            qk[m] = 1.02f * sqrtf(ss) * __uint_as_float(P.kmax[b * 16 + (MODE == 0 ? (h * 2 + m) : (8 + h))]) + 0.01f; }
    }
    LAS unsigned* wflag = (LAS unsigned*)(F.lds + 55296);
    if (SOFT && tid < 3) wflag[tid] = 0u;
    const int kt_first = SOFT ? kt_hi : kt_lo;
    const int nit = kt_hi - kt_lo + 1;
    u32x4 kreg = (u32x4){0u, 0u, 0u, 0u}, vreg;
    {   const bf16* zr = P.Z + (rowbase + 64 * kt_first + srow) * ZW;
        if (sch < KCH) kreg = *(const u32x4*)(zr + KC + h * HW + sch * 8);
        vreg = *(const u32x4*)(zr + VC + h * 64 + sch * 8);
        if (sch < KCH) *(LAS u32x4*)(F.lds + srow * 144 + sch * 16) = kreg;
        *(LAS u32x4*)(F.lds + 9216 + srow * 144 + sch * 16) = vreg;
        if (nit > 1) { const bf16* z1 = P.Z + (rowbase + 64 * (SOFT ? kt_first - 1 : kt_first + 1) + srow) * ZW;
            if (sch < KCH) kreg = *(const u32x4*)(z1 + KC + h * HW + sch * 8);
            vreg = *(const u32x4*)(z1 + VC + h * 64 + sch * 8); } }
    __syncthreads();
    bool wave_done = false;
    const unsigned* mwp = (MODE == 1) ? P.MASK + ((size_t)(b * 256 + qb * 8 + w) * 128) * 64 + lane : nullptr;
    unsigned mwn = 0xffffffffu; if (MODE == 1) mwn = mwp[(size_t)kt_first * 64];
    int sl_cur = 0, sl_nxt = 18432;
    for (int it = 0; it < nit; ++it) {
        const int kt = SOFT ? kt_hi - it : kt_lo + it, ktn = SOFT ? kt - 1 : kt + 1;
        const bool more = it + 1 < nit;
        const unsigned mw = mwn;
        if (more) { if (sch < KCH) *(LAS u32x4*)(F.lds + sl_nxt + srow * 144 + sch * 16) = kreg;
            *(LAS u32x4*)(F.lds + sl_nxt + 9216 + srow * 144 + sch * 16) = vreg;
            if (MODE == 1) mwn = mwp[(size_t)ktn * 64]; }
        if (it + 2 < nit) { const bf16* zr = P.Z + (rowbase + 64 * (SOFT ? kt - 2 : kt + 2) + srow) * ZW;
            if (sch < KCH) kreg = *(const u32x4*)(zr + KC + h * HW + sch * 8);
            vreg = *(const u32x4*)(zr + VC + h * 64 + sch * 8); }
        const int j0 = 64 * kt;
        const bool act = ((MODE == 3) ? (kt == 4 * qb + (w >> 1)) : (j0 <= qw0 + 31)) && !wave_done;
        if (act) {
            const LAS unsigned char* Kb = F.lds + sl_cur; const LAS unsigned char* Vb = F.lds + sl_cur + 9216;
            const bool hact1 = (j0 + 32 <= qw0 + 31);
#pragma unroll
            for (int m = 0; m < NMAP; ++m) {
                f32x16 st[2];
#pragma unroll
                for (int kh = 0; kh < 2; ++kh) {
                    if (kh == 0 || hact1) {
                        f32x16 a = cinit;
#pragma unroll
                        for (int s = 0; s < NS; ++s) { const bf16x8 kf = *(const LAS bf16x8*)(Kb + (32 * kh + r) * 144 + (m * 32 + 16 * s + 8 * hh) * 2); a = mfma32(kf, qf[m][s], a); }
                        if (j0 + 32 * kh + 31 > qw0) { const int lim = qw0 + r - j0 - 32 * kh - 4 * hh; asm volatile("; causal-mask block (kept a real branch: as selects it ran on every interior tile too)" ::: "memory");
#pragma unroll
                            for (int e = 0; e < 16; ++e) if (crow_c(e) > lim) a[e] = SOFT ? NEG : 0.f; }
                        if (MODE == 1) {
#pragma unroll
                            for (int e = 0; e < 16; ++e) if (!((mw >> (e + 16 * kh)) & 1u)) a[e] = NEG; }
                        st[kh] = a;
                    } else st[kh] = splat16(SOFT ? NEG : 0.f);
                }
                if (SOFT) {
                    const float off0 = slope2 * (float)(j0 - qw0 - r), off1 = off0 + 32.f * slope2;
                    float mx0 = st[0][0], mx1 = st[1][0];
#pragma unroll
                    for (int e = 1; e < 16; ++e) { mx0 = fmaxf(mx0, st[0][e]); mx1 = fmaxf(mx1, st[1][e]); }
                    float mx = fmaxf(mx0 + off0, mx1 + off1); mx = fmaxf(mx, shx(mx, lane, 32));
                    const float mn = fmaxf(m_run[m], mx); const float msafe = (mn == NEG) ? 0.f : mn;
                    const float alpha = __builtin_amdgcn_exp2f(m_run[m] - msafe); m_run[m] = mn;
                    const float d0 = off0 - msafe, d1 = off1 - msafe; float rs = 0.f;
#pragma unroll
                    for (int e = 0; e < 16; ++e) { const float p0 = __builtin_amdgcn_exp2f(st[0][e] + d0), p1 = __builtin_amdgcn_exp2f(st[1][e] + d1); st[0][e] = p0; st[1][e] = p1; rs += p0 + p1; }
                    rs += shx(rs, lane, 32); l_run[m] = l_run[m] * alpha + rs;
#pragma unroll
                    for (int e = 0; e < 16; ++e) { O[m][0][e] *= alpha; O[m][1][e] *= alpha; }
                }
#pragma unroll
                for (int kh = 0; kh < 2; ++kh) {
                    if (kh == 0 || hact1) {
#pragma unroll
                        for (int s = 0; s < 2; ++s) {
                            const bf16x8 pf = pack8(st[kh][8 * s], st[kh][8 * s + 1], st[kh][8 * s + 2], st[kh][8 * s + 3], st[kh][8 * s + 4], st[kh][8 * s + 5], st[kh][8 * s + 6], st[kh][8 * s + 7]);
#pragma unroll
                            for (int db = 0; db < 2; ++db) {
                                const LAS unsigned char* vp = Vb + (32 * kh + 16 * s + 4 * hh + ((lane & 15) >> 2)) * 144 + (32 * db + 16 * ((lane >> 4) & 1) + 4 * (lane & 3)) * 2;
                                const s16x4 lo = vtr(vp), hi = vtr(vp + 8 * 144);
                                const bf16x8 vf = (bf16x8){lo[0], lo[1], lo[2], lo[3], hi[0], hi[1], hi[2], hi[3]};
                                O[m][db] = mfma32(vf, pf, O[m][db]); } } } }
            }
            if (SOFT) {
                const float dist = slope2 * (float)(qw0 + r - (j0 - 1)); bool fin = true;
#pragma unroll
                for (int m = 0; m < NMAP; ++m) fin = fin && (qk[m] - dist - m_run[m] < -32.f);
                wave_done = (__ballot(fin) == ~0ull);
            }
        }
        if (SOFT && !wave_done && lane == 0) wflag[it % 3] = 1u;
        sl_cur = sl_nxt; sl_nxt = (sl_nxt == 36864) ? 0 : sl_nxt + 18432;
        __syncthreads();
        if (SOFT) { const unsigned any = wflag[it % 3]; if (tid == 0) wflag[(it + 2) % 3] = 0u; if (any == 0u) break; }
    }
    const size_t orow = rowbase + qw0 + r;
    const int ycol = MODE * 256 + h * 64;
    f32x16 o[2];
    if (MODE == 0) { const float i0 = 1.f / l_run[0], i1 = P.lam / l_run[NMAP - 1];
#pragma unroll
        for (int db = 0; db < 2; ++db)
#pragma unroll
            for (int e = 0; e < 16; ++e) o[db][e] = O[0][db][e] * i0 - O[NMAP - 1][db][e] * i1; }
    else if (MODE == 1) { const float i0 = 1.f / l_run[0];
#pragma unroll
        for (int db = 0; db < 2; ++db)
#pragma unroll
            for (int e = 0; e < 16; ++e) o[db][e] = O[0][db][e] * i0; }
    else { o[0] = O[0][0]; o[1] = O[0][1]; }
    float mu = 0.f;
    if (MODE == 2) { float s = 0.f;
#pragma unroll
        for (int db = 0; db < 2; ++db)
#pragma unroll
            for (int e = 0; e < 16; ++e) s += o[db][e];
        s += shx(s, lane, 32); mu = s * (1.f / 64.f); }
    float ss = 0.f;
    if (MODE != 1) {
#pragma unroll
        for (int db = 0; db < 2; ++db)
#pragma unroll
            for (int e = 0; e < 16; ++e) { const float d = o[db][e] - mu; ss += d * d; }
        ss += shx(ss, lane, 32); }
    float rn = 1.f;
    if (MODE != 1) rn = 1.f / sqrtf(ss * (1.f / 64.f) + LN_EPS);
    if (MODE == 0) rn *= (1.f - P.lam_init);
#pragma unroll
    for (int db = 0; db < 2; ++db)
#pragma unroll
        for (int g4 = 0; g4 < 4; ++g4) { const int d0 = 32 * db + 8 * g4 + 4 * hh; float v[4];
#pragma unroll
            for (int i = 0; i < 4; ++i) v[i] = o[db][4 * g4 + i];
            if (MODE != 1) { const f32x4 nw = *(const f32x4*)(P.nw + (MODE == 2 ? h * 64 : 0) + d0);
#pragma unroll
                for (int i = 0; i < 4; ++i) v[i] = (v[i] - mu) * rn * nw[i]; }
            if (MODE >= 2) { const u32x2 gw = *(const u32x2*)(P.Z + orow * ZW + (MODE == 2 ? ZC_CG : ZC_DG) + h * 64 + d0);
                const float g0 = bflo(gw.x), g1 = bfhi(gw.x), g2 = bflo(gw.y), g3 = bfhi(gw.y);
                v[0] *= g0 * sigmoidf_(g0); v[1] *= g1 * sigmoidf_(g1); v[2] *= g2 * sigmoidf_(g2); v[3] *= g3 * sigmoidf_(g3); }
            u32x2 ow; ow.x = pk2(v[0], v[1]); ow.y = pk2(v[2], v[3]);
            *(u32x2*)(P.Y + orow * DM + ycol + d0) = ow; }
}
}

constexpr int PH_PER_LAYER = 12, N_PHASES = 1 + DEPTH * PH_PER_LAYER;

typedef __attribute__((address_space(4))) const Args* KArgP;
#ifdef ONLY_SITE
#define SITE(s) ((s) == ONLY_SITE)
#else
#define SITE(s) true
#endif
#if MK_ONE_LAUNCH
#define IN(k) true
#define SEAM(k) do { if ((k) + 1 < N_PHASES) { XcdBarrier b2_ = bar; asm volatile("" : "+s"(b2_.bar), "+s"(b2_.x)); xcd_barrier(b2_, F.tid == 0); } } while (0)
#else
#define IN(k) (lo <= (k) && (k) < hi)
#define SEAM(k) do { } while (0)
#endif
#define SITE_BEGIN KArgP KA = (KArgP)__builtin_amdgcn_kernarg_segment_ptr(); do { asm volatile("" : "+s"(KA)); \
        int ln_; asm volatile("v_mbcnt_lo_u32_b32 %0, -1, 0\n\tv_mbcnt_hi_u32_b32 %0, -1, %0" : "=v"(ln_)); \
        const unsigned simd_ = (unsigned)__builtin_amdgcn_s_getreg(((2 - 1) << 11) | (4 << 6) | 4);   \
        unsigned tk_ = 0u, tg_ = 0u; if (ln_ == 0) { tk_ = __hip_atomic_fetch_add((LAS unsigned*)(F.lds + MISC_OFF + 64) + simd_, 1u, __ATOMIC_RELAXED, __HIP_MEMORY_SCOPE_WORKGROUP); \
            tg_ = __hip_atomic_fetch_add((LAS unsigned*)(F.lds + MISC_OFF + 96), 1u, __ATOMIC_RELAXED, __HIP_MEMORY_SCOPE_WORKGROUP); } \
        F.wave = __builtin_amdgcn_readfirstlane(simd_balanced ? (int)(simd_ + 4u * (tk_ & 1u)) : (int)(tg_ & 7u)); F.lane = ln_; F.tid = F.wave * 64 + F.lane; \
        F.ws = KA->ws; F.dob = (unsigned char*)KA->out; F.G = G0; F.wg = wg0; asm volatile("" : "+s"(F.G), "+s"(F.wg)); } while (0)


__global__ void __launch_bounds__(NWAVES * 64, 2) fwd_kernel(Args args) {
    extern __shared__ __attribute__((aligned(16))) unsigned char lds_raw[];
    Frame F;
    F.lds = (LAS unsigned char*)lds_raw;
    F.tid = threadIdx.x; F.lane = F.tid & 63; F.wave = __builtin_amdgcn_readfirstlane(F.tid >> 6);
    F.G = gridDim.x; F.wg = blockIdx.x;
    F.ws = args.ws; F.dob = (unsigned char*)args.out;
    volatile LAS unsigned* MISC = (volatile LAS unsigned*)(F.lds + MISC_OFF);
    if (F.tid < 32) MISC[F.tid] = 0u;
    __syncthreads();
    if (F.lane == 0) __hip_atomic_fetch_add((LAS unsigned*)(F.lds + MISC_OFF + 112) + ((unsigned)__builtin_amdgcn_s_getreg(((2 - 1) << 11) | (4 << 6) | 4)), 1u, __ATOMIC_RELAXED, __HIP_MEMORY_SCOPE_WORKGROUP);
    __syncthreads();
    const bool simd_balanced = (MISC[28] == 2u) && (MISC[29] == 2u) && (MISC[30] == 2u) && (MISC[31] == 2u);
    unsigned* ctl = (unsigned*)(F.ws + WS_CTL);
    XcdBarrier bar; bar.bar = ctl + CW_BAR; bar.x = 0; bar.st = nullptr;
#if MK_ONE_LAUNCH
    bar = xcd_barrier_post(ctl + CW_BAR, MISC + 8);
#endif
    const int lo = args.ph_lo, hi = args.ph_hi, subm = args.sub;
    const int G0 = F.G, wg0 = F.wg;
    if (SITE(0) && IN(0)) { SITE_BEGIN; p0_prologue(F, KA); SEAM(0); }

    for (int l = 0; l < DEPTH; ++l) {
        const int pb = 1 + l * PH_PER_LAYER;
        if (SITE(1) && IN(pb + 0)) { SITE_BEGIN; const char* XBc = (const char*)(F.ws + WS_XB); (void)XBc; const unsigned char* w123 = F.ws + WS_W123; const unsigned char* w45 = F.ws + WS_W45 + (size_t)l * W45_STRIDE; (void)w123; (void)w45;
            pg8::EpiStore E{(bf16*)(F.ws + WS_Z), ZW, F.ws + WS_IKC};
            {   pg8::SchedTiles S{XBc, (const char*)(w123 + W123_W1), 2048, 2048, 16, 6, G1_BF_TILES, 0, F.G, F.wg};
                { int tl_ = F.tid; asm volatile("" : "+v"(tl_)); pg8::gemm_phase(F.lds, S, E, tl_); } }
            {   pg8::SchedTiles S{(const char*)(F.dob + DO_XB8), (const char*)(F.dob + DO_W8 + (size_t)l * W8_STRIDE + W8_Z), 1024, 1024, 8, 8, G1_F8_TILES, 1, F.G, F.wg};
                { int tl_ = F.tid; asm volatile("" : "+v"(tl_)); pg8::gemm_phase<pg8::EpiStore, pg8::SchedTiles, true>(F.lds, S, E, tl_); } }
            SEAM(pb + 0);
        }
        if (SITE(2) && IN(pb + 1)) { SITE_BEGIN; const char* XBc = (const char*)(F.ws + WS_XB); (void)XBc; const unsigned char* w123 = F.ws + WS_W123; const unsigned char* w45 = F.ws + WS_W45 + (size_t)l * W45_STRIDE; (void)w123; (void)w45;
            {   unsigned* head = (unsigned*)(F.ws + WS_CTL) + CW_WQ + l * 64 + 32;
                for (;;) { const int i = mx::wq_next(F, head); if (i >= 128 + 1024) break;
                    if (i < 128) { if (subm & 2) mx::prepkv_unit(F, i, KA->in[6] + (size_t)l * 16 * 128, KA->in[7] + l * 128, (unsigned*)(F.ws + WS_CTL) + CW_KMAX + l * 64); }
                    else if (subm & 1) { const int u = i - 128; mx::b1_unit(F, u & 3, 255 - (u >> 2)); } } }
            SEAM(pb + 1);
        }
        if (SITE(3) && IN(pb + 2)) { SITE_BEGIN; const char* XBc = (const char*)(F.ws + WS_XB); (void)XBc; const unsigned char* w123 = F.ws + WS_W123; const unsigned char* w45 = F.ws + WS_W45 + (size_t)l * W45_STRIDE; (void)w123; (void)w45;
            if (subm & 1) mx::scan_phase(F);
            float lam_init = 0.8f - 0.6f * __expf(-0.3f * (float)l);
            const float* lp = KA->in[3] + l * 128; float s01 = 0.f, s23 = 0.f;
            for (int i = 0; i < 32; ++i) { s01 += lp[i] * lp[32 + i]; s23 += lp[64 + i] * lp[96 + i]; }
            mx::EngP P{(const bf16*)(F.ws + WS_Z), (bf16*)(F.ws + WS_Y), nullptr, nullptr, KA->in[4] + l * 64, __expf(s01) - __expf(s23) + lam_init, lam_init, (const unsigned*)(F.ws + WS_CTL) + CW_KMAX + l * 64};
            {   unsigned* head = (unsigned*)(F.ws + WS_CTL) + CW_WQ + l * 64;
                for (;;) { const int i = mx::wq_next(F, head); if (i >= 512) break; const int j = i & 127; mx::eng_unit<0>(F, P, j & 3, 3 - (i >> 7), 31 - (j >> 2)); } }
            SEAM(pb + 2);
        }
        if (SITE(4) && IN(pb + 3)) { SITE_BEGIN; const char* XBc = (const char*)(F.ws + WS_XB); (void)XBc; const unsigned char* w123 = F.ws + WS_W123; const unsigned char* w45 = F.ws + WS_W45 + (size_t)l * W45_STRIDE; (void)w123; (void)w45;
            {   unsigned* head = (unsigned*)(F.ws + WS_CTL) + CW_WQ + l * 64 + 16;
                const mx::EngP PB{(const bf16*)(F.ws + WS_Z), (bf16*)(F.ws + WS_Y), (const unsigned*)(F.ws + WS_MASK), nullptr, nullptr, 0.f, 0.f, (const unsigned*)(F.ws + WS_CTL) + CW_KMAX + l * 64};
                const mx::EngP PC{(const bf16*)(F.ws + WS_Z), (bf16*)(F.ws + WS_Y), nullptr, (const float*)(F.ws + WS_KVC), KA->in[5] + l * 256, 0.f, 0.f, nullptr};
                const mx::EngP PD{(const bf16*)(F.ws + WS_Z), (bf16*)(F.ws + WS_Y), nullptr, (const float*)(F.ws + WS_KVD), KA->in[8] + l * 64, 0.f, 0.f, nullptr};
                for (;;) { const int i = mx::wq_next(F, head); if (i >= 1536) break;
                    if (i < 512) { if (subm & 1) { const int j = i & 127; mx::eng_unit<1>(F, PB, j & 3, 3 - (i >> 7), 31 - (j >> 2)); } }
                    else if (!(subm & (i < 1024 ? 2 : 4))) continue;
                    else if (i < 1024) { const int u = i - 512; mx::eng_unit<2>(F, PC, u >> 7, (u >> 5) & 3, u & 31); }
                    else { const int u = i - 1024; mx::eng_unit<3>(F, PD, u >> 7, (u >> 5) & 3, u & 31); } } }
            SEAM(pb + 3);
        }
        if (SITE(5) && IN(pb + 4)) { SITE_BEGIN;
            const unsigned char* w123 = F.ws + WS_W123;
            for (int n = 0; n < 4; ++n) {
                {   pg8::SchedPlain S{(const char*)(F.dob + DO_XB8), (const char*)(F.dob + DO_W8 + (size_t)l * W8_STRIDE + W8_G) + (size_t)n * 1024 * 1024, 1024, 1024, 8, 128, 4, F.G, F.wg};
                    pg8::EpiSlotStore E{F.ws + WS_SCR2 + (size_t)F.wg * 262144, 1};
                    { int tl_ = F.tid; asm volatile("" : "+v"(tl_)); pg8::gemm_phase<pg8::EpiSlotStore, pg8::SchedPlain, true>(F.lds, S, E, tl_); } }
                {   pg8::SchedPlain S{(const char*)(F.ws + WS_Y) + n * 512, (const char*)(w123 + W123_GB + 8 * MiB) + (size_t)n * 1024 * 512, 2048, 512, 4, 128, 4, F.G, F.wg};
                    pg8::EpiBranch E{F.ws + WS_SCR2 + (size_t)F.wg * 262144, (bf16*)(F.ws + WS_MERGED), n == 0};
                    { int tl_ = F.tid; asm volatile("" : "+v"(tl_)); pg8::gemm_phase(F.lds, S, E, tl_); } }
            }
            SEAM(pb + 4);
        }
        if (SITE(6) && IN(pb + 5)) { SITE_BEGIN; const char* XBc = (const char*)(F.ws + WS_XB); (void)XBc; const unsigned char* w123 = F.ws + WS_W123; const unsigned char* w45 = F.ws + WS_W45 + (size_t)l * W45_STRIDE; (void)w123; (void)w45;
            pg8::SchedPlain S{(const char*)(F.ws + WS_MERGED), (const char*)(w123 + W123_WO), 2048, 2048, 16, 128, 4, F.G, F.wg};
            pg8::EpiG3 E{(bf16*)(F.ws + WS_XB)};
            pg8::gemm_phase(F.lds, S, E, F.tid);
            SEAM(pb + 5);
        }
        if (SITE(7) && IN(pb + 6)) { SITE_BEGIN; const char* XBc = (const char*)(F.ws + WS_XB); (void)XBc; const unsigned char* w123 = F.ws + WS_W123; const unsigned char* w45 = F.ws + WS_W45 + (size_t)l * W45_STRIDE; (void)w123; (void)w45; ln_phase(F, KA->in[11] + l * DM, KA->in[12] + l * DM, nullptr, F.dob + DO_XB8);
            if (l + 1 < DEPTH) convert_w123(F, KA->in[2] + (size_t)(l + 1) * DM * NIN, KA->in[9] + (size_t)(l + 1) * 4 * 256 * DM, KA->in[10] + (size_t)(l + 1) * DM * DM);
            SEAM(pb + 6); }
        if (SITE(8) && IN(pb + 7)) { SITE_BEGIN; const char* XBc = (const char*)(F.ws + WS_XB); (void)XBc; const unsigned char* w123 = F.ws + WS_W123; const unsigned char* w45 = F.ws + WS_W45 + (size_t)l * W45_STRIDE; (void)w123; (void)w45;
            pg8::SchedUp S{(const char*)(F.dob + DO_XB8), (const char*)(F.dob + DO_W8 + (size_t)l * W8_STRIDE + W8_UP), F.G, F.wg};
            pg8::EpiUp E{(bf16*)(F.ws + WS_GE), (bf16*)(F.ws + WS_G0), (bf16*)(F.ws + WS_U0), F.ws + WS_ACT8, KA->in[14] + (size_t)l * 3 * DFF, KA->in[15] + (size_t)l * DFF};
            pg8::gemm_phase<pg8::EpiUp, pg8::SchedUp, true>(F.lds, S, E, F.tid);
            SEAM(pb + 7);
        }
        if (SITE(9) && IN(pb + 8)) { SITE_BEGIN; const char* XBc = (const char*)(F.ws + WS_XB); (void)XBc; const unsigned char* w123 = F.ws + WS_W123; const unsigned char* w45 = F.ws + WS_W45 + (size_t)l * W45_STRIDE; (void)w123; (void)w45; ffn_act_phase(F, KA->in[14] + (size_t)l * 3 * DFF, KA->in[15] + (size_t)l * DFF); SEAM(pb + 8); }
        if (SITE(10) && IN(pb + 9)) { SITE_BEGIN;
            const unsigned char* w45 = F.ws + WS_W45 + (size_t)l * W45_STRIDE;
            {   pg8::SchedPlain S{(const char*)(F.ws + WS_PB + (size_t)l * M * PDIM * 2), (const char*)(w45 + W45_PP), 512, 512, 4, 128, 4, F.G, F.wg};
                pg8::EpiSlotStore E{F.dob + DO_SCR5 + (size_t)F.wg * 262144, 0};
                { int tl_ = F.tid; asm volatile("" : "+v"(tl_)); pg8::gemm_phase(F.lds, S, E, tl_); } }
            {   pg8::SchedPlain S{(const char*)(F.dob + DO_XB8), (const char*)(F.dob + DO_W8 + (size_t)l * W8_STRIDE + W8_PG), 1024, 1024, 8, 128, 4, F.G, F.wg};
                pg8::EpiSlotMul E{F.dob + DO_SCR5 + (size_t)F.wg * 262144};
                { int tl_ = F.tid; asm volatile("" : "+v"(tl_)); pg8::gemm_phase<pg8::EpiSlotMul, pg8::SchedPlain, true>(F.lds, S, E, tl_); } }
            SEAM(pb + 9);
        }
        if (SITE(11) && IN(pb + 10)) { SITE_BEGIN;
            const unsigned char* w45 = F.ws + WS_W45 + (size_t)l * W45_STRIDE;
            pg8::SchedG5b S{(const char*)(F.ws + WS_ACT8), (const char*)(F.dob + DO_W8 + (size_t)l * W8_STRIDE + W8_DN), F.G, F.wg};
            pg8::EpiG5b E{F.dob + DO_SCR5 + (size_t)F.wg * 262144, (bf16*)(F.ws + WS_XB)};
            pg8::gemm_phase<pg8::EpiG5b, pg8::SchedG5b, true>(F.lds, S, E, F.tid);
            SEAM(pb + 10);
        }
        if (SITE(12) && IN(pb + 11)) { SITE_BEGIN; const char* XBc = (const char*)(F.ws + WS_XB); (void)XBc; const unsigned char* w123 = F.ws + WS_W123; const unsigned char* w45 = F.ws + WS_W45 + (size_t)l * W45_STRIDE; (void)w123; (void)w45; ln_phase(F, KA->in[19] + l * DM, KA->in[20] + l * DM, l == DEPTH - 1 ? KA->out : nullptr, l == DEPTH - 1 ? nullptr : F.dob + DO_XB8); SEAM(pb + 11); }
    }
#undef IN
#undef SEAM
}

extern "C" void kernel_launch(void* const* d_in, const int* in_sizes, int n_in, void* d_out, int out_size, void* d_ws, size_t ws_size, hipStream_t stream) {
    static int grid = 0;
    if (grid == 0) {
        if (n_in != 21 || out_size != M * DM || ws_size < WS_END) { fprintf(stderr, "kernel_launch: unexpected shapes (n_in %d out %d ws %zu)\n", n_in, out_size, ws_size); grid = -1; return; }
        int dev = 0, cus = 0, per_cu = 0;
        if (hipGetDevice(&dev) != hipSuccess || hipDeviceGetAttribute(&cus, hipDeviceAttributeMultiprocessorCount, dev) != hipSuccess) { grid = -1; return; }
        if (hipFuncSetAttribute((const void*)fwd_kernel, hipFuncAttributeMaxDynamicSharedMemorySize, LDS_BYTES) != hipSuccess) { grid = -1; return; }
        if (hipOccupancyMaxActiveBlocksPerMultiprocessor(&per_cu, (const void*)fwd_kernel, NWAVES * 64, LDS_BYTES) != hipSuccess || per_cu < 1)
            fprintf(stderr, "kernel_launch: occupancy query reports %d\n", per_cu);
        (void)hipGetLastError();
        grid = cus;
    }
    if (grid < 0) return;
    (void)hipMemsetAsync((char*)d_ws + WS_CTL, 0, CTL_ZERO_BYTES, stream);
    Args a{};
    for (int i = 0; i < 21; ++i) a.in[i] = (const float*)d_in[i];
    a.out = (float*)d_out; a.ws = (unsigned char*)d_ws;
#if MK_ONE_LAUNCH
    a.ph_lo = 0; a.ph_hi = N_PHASES; a.sub = 7;
    hipLaunchKernelGGL(fwd_kernel, dim3(grid), dim3(NWAVES * 64), LDS_BYTES, stream, a);
#else
    for (int p = 0; p < N_PHASES; ++p) { a.ph_lo = p; a.ph_hi = p + 1; a.sub = 7;
        hipLaunchKernelGGL(fwd_kernel, dim3(grid), dim3(NWAVES * 64), LDS_BYTES, stream, a);
#ifdef PROBE_PHASE
        if (p >= 1 && (p - 1) % PH_PER_LAYER == PROBE_PHASE) { (void)hipMemsetAsync((char*)d_ws + WS_CTL + CW_WQ * 4, 0, 1024, stream); a.sub = PROBE_SUB;
            hipLaunchKernelGGL(fwd_kernel, dim3(grid), dim3(NWAVES * 64), LDS_BYTES, stream, a); }
#endif
    }
#endif
}
```

```cpp
#include <hip/hip_runtime.h>
#include <cstdio>
#include <cstdint>

#ifndef MK_ONE_LAUNCH
#define MK_ONE_LAUNCH 1
#endif

#define GAS __attribute__((address_space(1)))
#define LAS __attribute__((address_space(3)))
typedef unsigned short bf16;
typedef unsigned u32x4 __attribute__((ext_vector_type(4)));
typedef unsigned u32x2 __attribute__((ext_vector_type(2)));
typedef float f32x2 __attribute__((ext_vector_type(2)));
typedef float f32x4 __attribute__((ext_vector_type(4)));
typedef float f32x16 __attribute__((ext_vector_type(16)));
typedef short bf16x8 __attribute__((ext_vector_type(8)));
typedef short s16x4 __attribute__((ext_vector_type(4)));
typedef GAS unsigned gu32;

constexpr int BATCH = 4, SEQ = 8192, DM = 1024, M = BATCH * SEQ, DEPTH = 2;
constexpr int NIN = 7604, ZW = 3648  , DFF = 2816, UGW = 5632, PDIM = 256;
constexpr float LN_EPS = 1e-5f;
constexpr float ALPHA = 1.41421356237f;
constexpr float LOG2E = 1.4426950408889634f;
constexpr int ZC_AQ = 0, ZC_AK = 256, ZC_AV = 512, ZC_BQ = 768, ZC_BK = 1024, ZC_BV = 1280, ZC_CQ = 1536, ZC_CK = 1792, ZC_CV = 2048, ZC_CG = 2304,
              ZC_DQ = 2560, ZC_DK = 2688, ZC_DV = 2816, ZC_DG = 3072, ZC_IQ = 3328, ZC_IK = 3456, ZC_IW = 3488, ZC_DA = 3504;
constexpr int SRC_MG = 3508;

constexpr size_t MiB = 1u << 20;
constexpr size_t WS_CTL = 0, CTL_ZERO_BYTES = 1 * MiB;
constexpr size_t WS_XB = 1 * MiB;
constexpr size_t WS_BIG = 65 * MiB;
constexpr size_t WS_Z = WS_BIG, WS_Y = WS_BIG + 228 * MiB, WS_MERGED = WS_BIG + 292 * MiB;
constexpr size_t WS_ACT8 = WS_BIG, WS_GE = WS_BIG + 96 * MiB, WS_G0 = WS_BIG + 104 * MiB, WS_U0 = WS_BIG + 112 * MiB;
constexpr size_t WS_MASK = WS_MERGED, WS_KVC = WS_MERGED + 32 * MiB, WS_KVD = WS_MERGED + 40 * MiB, WS_DE = WS_MERGED + 56 * MiB;
constexpr size_t WS_SCR2 = WS_Z;
constexpr size_t WS_W45 = 421 * MiB, W45_STRIDE = 15 * MiB, WS_IKC = 451 * MiB;
constexpr size_t W45_UP = 0, W45_PG = 11 * MiB, W45_PP = 13 * MiB, W45_DN = 13 * MiB + 512 * 1024;
constexpr size_t WS_PB = 455 * MiB;
constexpr size_t WS_W123 = 487 * MiB;
constexpr size_t WS_END = 506 * MiB;
constexpr size_t W123_W1 = 0, W123_GB = 7 * MiB, W123_WO = 17 * MiB;
constexpr size_t DO_SCR5 = 0;
constexpr size_t DO_XB8 = 64 * MiB;
constexpr size_t DO_W8 = 96 * MiB, W8_STRIDE = 15 * MiB + 256 * 1024, W8_G = 0, W8_UP = 4 * MiB, W8_PG = 9 * MiB + 512 * 1024, W8_DN = 10 * MiB + 512 * 1024, W8_Z = 13 * MiB + 256 * 1024;
constexpr unsigned long long G1_F8_TILES = 0xCB987652ull, G1_BF_TILES = 0xDA4310ull;

constexpr int CW_BAR = 4096, CW_WQ = 8448  , CW_KMAX = 8192;

constexpr int RING_BYTES = 131072;
constexpr int MISC_OFF = 131072 + 320;
constexpr int QST_OFF = 132096;
constexpr int LDS_BYTES = 147456;

constexpr int NWAVES = 8;

#define RLX_AGENT __ATOMIC_RELAXED, __HIP_MEMORY_SCOPE_AGENT
__device__ __forceinline__ unsigned f2bf(float f) { unsigned u = __builtin_bit_cast(unsigned, f); return (u + 0x7fffu + ((u >> 16) & 1u)) >> 16; }
typedef __bf16 bf16x2_t __attribute__((ext_vector_type(2)));
__device__ __forceinline__ unsigned pk2(float lo, float hi) { const f32x2 v = {lo, hi}; const bf16x2_t b = __builtin_convertvector(v, bf16x2_t); return __builtin_bit_cast(unsigned, b); }
__device__ __forceinline__ unsigned pk4f8(float a, float b, float c, float d) { int p = __builtin_amdgcn_cvt_pk_fp8_f32(a, b, 0, false); p = __builtin_amdgcn_cvt_pk_fp8_f32(c, d, p, true); return (unsigned)p; }
__device__ __forceinline__ float bflo(unsigned w) { return __uint_as_float(w << 16); }
__device__ __forceinline__ float bfhi(unsigned w) { return __uint_as_float(w & 0xffff0000u); }
__device__ __forceinline__ float bf1(bf16 b) { return __uint_as_float((unsigned)b << 16); }
__device__ __forceinline__ void up8(const u32x4 w, float (&v)[8]) { v[0] = bflo(w.x); v[1] = bfhi(w.x); v[2] = bflo(w.y); v[3] = bfhi(w.y); v[4] = bflo(w.z); v[5] = bfhi(w.z); v[6] = bflo(w.w); v[7] = bfhi(w.w); }
__device__ __forceinline__ float sigmoidf_(float x) { return __builtin_amdgcn_rcpf(1.0f + __builtin_amdgcn_exp2f(-LOG2E * x)); }
__device__ __forceinline__ float shx(float v, int lane, int m) { return __int_as_float(__builtin_amdgcn_ds_bpermute((lane ^ m) << 2, __float_as_int(v))); }
__device__ __forceinline__ unsigned shup(unsigned v, int lane, int o) { return (unsigned)__builtin_amdgcn_ds_bpermute((lane - o) << 2, (int)v); }
__device__ __forceinline__ float wave_sum(float v, int lane) {
#pragma unroll
    for (int o = 1; o < 64; o <<= 1) v += shx(v, lane, o);
    return v;
}

#define XB_TMO      128
#define XB_XCNT(j)  (256  + 64 * (j))
#define XB_XSUB(j)  (1280 + 64 * (j))
#define XB_XGEN(j)  (2304 + 64 * (j))
#define XB_TOP      3328
#define XB_TOPGEN   3392
#define XCD_BAR_WORDS 3456
#define XB_SPIN_CAP (1u << 22)

__device__ __forceinline__ unsigned xb_ld(unsigned* p)              { return __hip_atomic_load(p, __ATOMIC_RELAXED, __HIP_MEMORY_SCOPE_AGENT); }
__device__ __forceinline__ unsigned xb_add(unsigned* p, unsigned v) { return __hip_atomic_fetch_add(p, v, __ATOMIC_RELAXED, __HIP_MEMORY_SCOPE_AGENT); }
__device__ __forceinline__ unsigned xb_xcc_id() { return (unsigned)__builtin_amdgcn_s_getreg((3 << 11) | 20) & 0xFu; }
#define XB_SPIN(cond, bar) do { unsigned _sp = 0; while (cond) { __builtin_amdgcn_s_sleep(1); \
    if ((++_sp & 255u) == 0u) { if (xb_ld(&(bar)[XB_TMO])) break; if (_sp > XB_SPIN_CAP) { atomicAdd(&(bar)[XB_TMO], 1u); break; } } } } while (0)

struct XcdBarrier { unsigned* bar; unsigned x; volatile LAS unsigned* st; };

__device__ __forceinline__ XcdBarrier xcd_barrier_post(unsigned* bar, volatile LAS unsigned* st) {
    XcdBarrier b; b.bar = bar; b.x = xb_xcc_id(); b.st = st;
    if (threadIdx.x == 0) (void)xb_add(&bar[XB_XCNT(b.x)], 1u);
    return b;
}
__device__ __forceinline__ void xcd_barrier_complete(unsigned* bar, unsigned x, unsigned& nloc, unsigned& nx) {
    const unsigned G = gridDim.x * gridDim.y * gridDim.z;
    unsigned sum, cnt, mine, sp = 0u;
    for (;;) {
        sum = 0u; cnt = 0u; mine = 0u;
#pragma unroll
        for (unsigned j = 0; j < 16; ++j) { const unsigned c = xb_ld(&bar[XB_XCNT(j)]); sum += c; cnt += (c > 0u) ? 1u : 0u; mine = (j == x) ? c : mine; }
        if (sum == G) break;
        __builtin_amdgcn_s_sleep(1);
        if ((++sp & 255u) == 0u) { if (xb_ld(&bar[XB_TMO])) break; if (sp > XB_SPIN_CAP) { atomicAdd(&bar[XB_TMO], 1u); break; } }
    }
    nloc = mine > 0u ? mine : 1u; nx = cnt > 0u ? cnt : 1u;
}
__device__ __forceinline__ void xcd_barrier(const XcdBarrier& b, const bool leader_thread) {
    asm volatile("s_waitcnt vmcnt(0)" ::: "memory");
    __syncthreads();
    if (leader_thread) {
        unsigned* bar = b.bar;
        __builtin_amdgcn_s_waitcnt(0);
        unsigned nloc = b.st[0], nx = b.st[1];
        if (nloc == 0u) { xcd_barrier_complete(bar, b.x, nloc, nx); b.st[0] = nloc; b.st[1] = nx; }
        const unsigned old = xb_add(&bar[XB_XSUB(b.x)], 1u);
        const unsigned gen = old / nloc;
        if (old + 1u == (gen + 1u) * nloc) {
            __builtin_amdgcn_fence(__ATOMIC_RELEASE, "agent");
            asm volatile("s_waitcnt vmcnt(0)" ::: "memory");
            const unsigned og = xb_add(&bar[XB_TOP], 1u);
            const unsigned tg = og / nx;
            if (og + 1u == (tg + 1u) * nx) xb_add(&bar[XB_TOPGEN], 1u);
            else XB_SPIN(xb_ld(&bar[XB_TOPGEN]) == tg, bar);
            __builtin_amdgcn_fence(__ATOMIC_ACQUIRE, "agent");
            xb_add(&bar[XB_XGEN(b.x)], 1u);
            asm volatile("s_waitcnt vmcnt(0)" ::: "memory");
        } else {
            XB_SPIN(xb_ld(&bar[XB_XGEN(b.x)]) == gen, bar);
            __builtin_amdgcn_fence(__ATOMIC_ACQUIRE, "agent");
            asm volatile("s_waitcnt vmcnt(0)" ::: "memory");
        }
    }
    __syncthreads();
}

namespace pg8 {
constexpr int BM = 256, BK = 64, HALF = 128, HTB = HALF * BK * 2, STAGE_BYTES = 8 * HTB, NXCD = 8, WGM = 8;
__device__ __forceinline__ int lds_byte(int r, int c) { const int st = (r >> 4) * 2 + (c >> 5), rr = r & 15, cc = c & 31, ob = rr * 64 + cc * 2; return st * 1024 + (ob ^ (((ob >> 9) & 1) << 5)); }
__device__ __forceinline__ void stage_rc(int b, int& R, int& C) { const int st = b / 1024, sb = b % 1024, swz = sb ^ (((sb >> 9) & 1) << 5); R = (st >> 1) * 16 + swz / 64; C = (st & 1) * 32 + (swz % 64) / 2; }
__device__ __forceinline__ int perm32(int rho) { const int n = rho >> 4, i = rho & 15; return 8 * (i >> 2) + 4 * n + (i & 3); }

struct UnitD { const char* A; const char* B; int lda2, ldb2, nt, pm, pn, kind; };

__device__ __forceinline__ void tile_map(int L, int nM, int nN, int& pm, int& pn) {
    const int nwg = nM * nN; int wgid = L;
    { const int q = nwg / NXCD, r = nwg % NXCD, xcd = wgid % NXCD, off = wgid / NXCD; wgid = (xcd < r ? xcd * (q + 1) : r * (q + 1) + (xcd - r) * q) + off; }
    const int nig = WGM * nN, gid = wgid / nig, fm = gid * WGM, gsz = (nM - fm) < WGM ? (nM - fm) : WGM;
    pm = fm + ((wgid % nig) % gsz); pn = (wgid % nig) / gsz;
}

typedef int i32x8 __attribute__((ext_vector_type(8)));
template <class Epi, class Sched, bool FP8 = false>
__device__ __forceinline__ void gemm_phase(LAS unsigned char* lds, const Sched& S, const Epi& E, const int tid) {
    const int wid = __builtin_amdgcn_readfirstlane(tid >> 6), lane = tid & 63, wr = wid >> 2, wc = wid & 3, fr = lane & 15, fq = lane >> 4;
    int sR, sRb, sC2;
    { int R, C; stage_rc(tid * 16, R, C); sR = R; sRb = (R & ~31) + perm32(R & 31); sC2 = C * 2; }
    const size_t kstep = (size_t)(BK * 2);
    const unsigned ldsw = (unsigned)wid * 1024u;
    const int aoff = lds_byte(wr * 64 + fr, FP8 ? fq * 16 : fq * 8), boff = lds_byte(wc * 32 + fr, FP8 ? fq * 16 : fq * 8);
#define PG8_SA(b, h) (((b) * 2 + (h)) * HTB)
#define PG8_SB(b, h) ((4 + (b) * 2 + (h)) * HTB)
#define PG8_STAGE(bufoff, gbase, rows, pitch) do { const unsigned _o = (unsigned)((rows) * (pitch) + sC2); _Pragma("unroll") for (int _i = 0; _i < 2; ++_i) \
        __builtin_amdgcn_global_load_lds((const unsigned*)((const char*)(gbase) + (size_t)(_i * 64) * (pitch) + _o), (LAS unsigned*)(lds + (bufoff) + ldsw + _i * 8192), 16, 0, 0); } while (0)
#define PG8_LDA(dst, b, h) do { if constexpr (FP8) { _Pragma("unroll") for (int m = 0; m < 4; ++m) { const u32x4 lo_ = *(const LAS u32x4*)(lds + PG8_SA(b, h) + aoff + m * 2048), hi_ = *(const LAS u32x4*)(lds + PG8_SA(b, h) + aoff + m * 2048 + 16); \
            dst##8[m] = (i32x8){(int)lo_.x, (int)lo_.y, (int)lo_.z, (int)lo_.w, (int)hi_.x, (int)hi_.y, (int)hi_.z, (int)hi_.w}; } } \
        else { _Pragma("unroll") for (int m = 0; m < 4; ++m) _Pragma("unroll") for (int k = 0; k < 2; ++k) dst[m][k] = *(const LAS bf16x8*)(lds + PG8_SA(b, h) + aoff + m * 2048 + k * 1024); } } while (0)
#define PG8_LDB(dst, b, h) do { if constexpr (FP8) { _Pragma("unroll") for (int n = 0; n < 2; ++n) { const u32x4 lo_ = *(const LAS u32x4*)(lds + PG8_SB(b, h) + boff + n * 2048), hi_ = *(const LAS u32x4*)(lds + PG8_SB(b, h) + boff + n * 2048 + 16); \
            dst##8[n] = (i32x8){(int)lo_.x, (int)lo_.y, (int)lo_.z, (int)lo_.w, (int)hi_.x, (int)hi_.y, (int)hi_.z, (int)hi_.w}; } } \
        else { _Pragma("unroll") for (int n = 0; n < 2; ++n) _Pragma("unroll") for (int k = 0; k < 2; ++k) dst[n][k] = *(const LAS bf16x8*)(lds + PG8_SB(b, h) + boff + n * 2048 + k * 1024); } } while (0)
#define PG8_MMA(ai, bj, At, Bt) do { __builtin_amdgcn_s_setprio(1); if constexpr (FP8) { _Pragma("unroll") for (int m = 0; m < 4; ++m) _Pragma("unroll") for (int n = 0; n < 2; ++n) \
            asm volatile("v_mfma_scale_f32_16x16x128_f8f6f4 %0, %1, %2, %0, %3, %3 op_sel_hi:[0,0,0]" : "+v"(acc[ai][bj][m][n]) : "v"(Bt##8[n]), "v"(At##8[m]), "v"(scl8)); } \
        else { _Pragma("unroll") for (int m = 0; m < 4; ++m) _Pragma("unroll") for (int n = 0; n < 2; ++n) _Pragma("unroll") for (int k = 0; k < 2; ++k) \
            acc[ai][bj][m][n] = __builtin_amdgcn_mfma_f32_16x16x32_bf16(Bt[n][k], At[m][k], acc[ai][bj][m][n], 0, 0, 0); } __builtin_amdgcn_s_setprio(0); } while (0)
#define PG8_WAIT_V(n) asm volatile("s_waitcnt vmcnt(" #n ")" ::: "memory")
#define PG8_WAIT_L(n) asm volatile("s_waitcnt lgkmcnt(" #n ")" ::: "memory")
#define PG8_BAR __builtin_amdgcn_s_barrier()
#define PG8_SCHED __builtin_amdgcn_sched_barrier(0)
    UnitD cur, nxt; int ui = 0;
    if (!S.next(0, cur)) return;
    f32x4 acc[2][2][4][2];
#pragma unroll
    for (int a = 0; a < 2; ++a)
#pragma unroll
        for (int b = 0; b < 2; ++b)
#pragma unroll
            for (int m = 0; m < 4; ++m)
#pragma unroll
                for (int n = 0; n < 2; ++n) acc[a][b][m][n] = (f32x4){0.f, 0.f, 0.f, 0.f};
    bf16x8 At[4][2], B0[2][2], B1[2][2]; i32x8 At8[4], B08[2], B18[2];
    int scl8 = 0x7c7c7c7c; asm volatile("" : "+v"(scl8));
    const char* cA = cur.A; const char* cB = cur.B;
    int pA = cur.lda2, pB = cur.ldb2;
    PG8_STAGE(PG8_SB(0, 0), cB, sRb, pB); PG8_STAGE(PG8_SB(0, 1), cB + (size_t)HALF * pB, sRb, pB); PG8_STAGE(PG8_SA(0, 0), cA, sR, pA); PG8_STAGE(PG8_SA(0, 1), cA + (size_t)HALF * pA, sR, pA);
    if (wr == 1) PG8_BAR;
    PG8_WAIT_V(2); PG8_BAR;
    PG8_STAGE(PG8_SB(1, 0), cB + kstep, sRb, pB); PG8_STAGE(PG8_SA(1, 0), cA + kstep, sR, pA); PG8_STAGE(PG8_SB(1, 1), cB + (size_t)HALF * pB + kstep, sRb, pB);
    PG8_WAIT_V(6); PG8_BAR;
    for (;;) {
        const bool has_next = S.next(ui + 1, nxt);
        if (!has_next) nxt = cur;
        const char* nA = nxt.A; const char* nB = nxt.B;
        const int nt = cur.nt;
        for (int t = 0; t < nt; t += 2) {
            const bool last = (t == nt - 2);
            const char* a1 = cA + (size_t)(t + 1) * kstep + (size_t)HALF * pA;
            const char* a2 = last ? nA : cA + (size_t)(t + 2) * kstep; const char* b2 = last ? nB : cB + (size_t)(t + 2) * kstep;
            const int p2A = last ? nxt.lda2 : pA, p2B = last ? nxt.ldb2 : pB;
            const char* a2h = a2 + (size_t)HALF * p2A; const char* b2h = b2 + (size_t)HALF * p2B;
            PG8_LDB(B0, 0, 0); PG8_LDB(B1, 0, 1); PG8_SCHED; PG8_LDA(At, 0, 0); PG8_STAGE(PG8_SA(1, 1), a1, sR, pA);
            PG8_WAIT_V(8); PG8_WAIT_L(0); PG8_BAR; PG8_MMA(0, 0, At, B0); PG8_MMA(0, 1, At, B1); PG8_BAR; PG8_SCHED;
            PG8_LDA(At, 0, 1); PG8_STAGE(PG8_SB(0, 0), b2, sRb, p2B); PG8_STAGE(PG8_SB(0, 1), b2h, sRb, p2B); PG8_STAGE(PG8_SA(0, 0), a2, sR, p2A);
            PG8_WAIT_V(8); PG8_WAIT_L(0); PG8_BAR; PG8_MMA(1, 0, At, B0); PG8_MMA(1, 1, At, B1); PG8_BAR; PG8_SCHED;
            PG8_LDB(B0, 1, 0); PG8_LDB(B1, 1, 1); PG8_SCHED; PG8_LDA(At, 1, 0); PG8_STAGE(PG8_SA(0, 1), a2h, sR, p2A);
            PG8_WAIT_V(8); PG8_WAIT_L(0); PG8_BAR; PG8_MMA(0, 0, At, B0); PG8_MMA(0, 1, At, B1); PG8_BAR; PG8_SCHED;
            PG8_LDA(At, 1, 1); PG8_STAGE(PG8_SB(1, 0), b2 + kstep, sRb, p2B); PG8_STAGE(PG8_SB(1, 1), b2h + kstep, sRb, p2B); PG8_STAGE(PG8_SA(1, 0), a2 + kstep, sR, p2A);
            PG8_WAIT_V(8); PG8_WAIT_L(0); PG8_BAR; PG8_MMA(1, 0, At, B0); PG8_MMA(1, 1, At, B1); PG8_BAR; PG8_SCHED;
        }
        if constexpr (FP8) asm volatile("s_nop 15\n\ts_nop 15" ::: "memory");
        if (wr == 0) PG8_BAR;
        { int l2; asm volatile("v_mbcnt_lo_u32_b32 %0, -1, 0\n\tv_mbcnt_hi_u32_b32 %0, -1, %0" : "=v"(l2)); E(acc, cur, wr, wc, l2 & 15, l2 >> 4, wid * 64 + l2); }
        if (!has_next) break;
#pragma unroll
        for (int a = 0; a < 2; ++a)
#pragma unroll
            for (int b = 0; b < 2; ++b)
#pragma unroll
                for (int m = 0; m < 4; ++m)
#pragma unroll
                    for (int n = 0; n < 2; ++n) acc[a][b][m][n] = (f32x4){0.f, 0.f, 0.f, 0.f};
        cur = nxt; cA = nA; cB = nB; pA = cur.lda2; pB = cur.ldb2;
        ++ui;
        if (wr == 1) PG8_BAR;
    }
    PG8_WAIT_V(0);
    PG8_BAR;
#undef PG8_SA
#undef PG8_SB
#undef PG8_STAGE
#undef PG8_LDA
#undef PG8_LDB
#undef PG8_MMA
#undef PG8_WAIT_V
#undef PG8_WAIT_L
#undef PG8_BAR
#undef PG8_SCHED
}

struct SchedPlain {
    const char* A; const char* B; int lda2, ldb2, nt, nM, nN, G, c;
    __device__ __forceinline__ bool next(int i, UnitD& u) const {
        const long L = (long)i * G + c; if (L >= (long)nM * nN) return false;
        int pm, pn; tile_map((int)L, nM, nN, pm, pn);
        u.A = A + (size_t)pm * 256 * lda2; u.B = B + (size_t)pn * 256 * ldb2; u.lda2 = lda2; u.ldb2 = ldb2; u.nt = nt; u.pm = pm; u.pn = pn; u.kind = i; return true;
    }
};
struct SchedTiles {
    const char* A; const char* B; int lda2, ldb2, nt, ntile; unsigned long long list; int compact, G, c;
    __device__ __forceinline__ bool next(int i, UnitD& u) const {
        const long L = (long)i * G + c; if (L >= (long)128 * ntile) return false;
        int pm, pi; tile_map((int)L, 128, ntile, pm, pi); const int col = (int)((list >> (4 * pi)) & 15ull);
        u.A = A + (size_t)pm * 256 * lda2; u.B = B + (size_t)(compact ? pi : col) * 256 * ldb2; u.lda2 = lda2; u.ldb2 = ldb2; u.nt = nt; u.pm = pm; u.pn = col; u.kind = i; return true;
    }
};
struct SchedUp {
    const char* A; const char* B; int G, c;
    __device__ __forceinline__ bool next(int i, UnitD& u) const {
        const long L = (long)i * G + c; if (L >= 128 * 22) return false;
        int pm, cb; tile_map((int)L, 128, 22, pm, cb);
        u.A = A + (size_t)pm * 256 * 1024; u.lda2 = 1024; u.B = B + (size_t)cb * 256 * 1024; u.ldb2 = 1024; u.nt = 8; u.pm = pm; u.pn = cb; u.kind = i; return true;
    }
};
struct SchedG5b {
    const char* A; const char* B; int G, c;
    __device__ __forceinline__ bool next(int i, UnitD& u) const {
        const long L = (long)i * G + c; if (L >= 128 * 4) return false;
        int pm, pn; tile_map((int)L, 128, 4, pm, pn);
        u.A = A + (size_t)pm * 256 * DFF; u.lda2 = DFF; u.B = B + (size_t)pn * 256 * DFF; u.ldb2 = DFF; u.nt = 22; u.pm = pm; u.pn = pn; u.kind = i; return true;
    }
};

#define EPI_LOOP for (int ai = 0; ai < 2; ++ai) _Pragma("unroll") for (int m = 0; m < 4; ++m) _Pragma("unroll") for (int bj = 0; bj < 2; ++bj)
struct EpiStore {
    bf16* O; int ldc; unsigned char* IKC;
    __device__ __forceinline__ void operator()(const f32x4 (&acc)[2][2][4][2], const UnitD& u, int wr, int wc, int fr, int fq, int tid) const {
        const int row0 = u.pm * BM + wr * 64 + fr, col0 = u.pn * BM + wc * 32 + 8 * fq;
#pragma unroll
        EPI_LOOP { const f32x4 v0 = acc[ai][bj][m][0], v1 = acc[ai][bj][m][1];
            u32x4 w; w.x = pk2(v0[0], v0[1]); w.y = pk2(v0[2], v0[3]); w.z = pk2(v1[0], v1[1]); w.w = pk2(v1[2], v1[3]);
            const int R = row0 + ai * HALF + m * 16;
            *(u32x4*)(O + (size_t)R * ldc + col0 + bj * HALF) = w;
            if (bj == 1 && u.pn == 13 && wc == 0) *(u32x4*)(IKC + ((size_t)((R >> 5) * 2 + (fq >> 1)) * 64 + (fq & 1) * 32 + (R & 31)) * 16) = w; }
    }
};
struct EpiSlotStore {
    unsigned char* sc_; int act;
    __device__ __forceinline__ void operator()(const f32x4 (&acc)[2][2][4][2], const UnitD& u, int wr, int wc, int fr, int fq, int tid) const {
        unsigned loff = (unsigned)tid * 16u; asm volatile("" : "+v"(loff));
        unsigned char* sc = sc_ + (size_t)u.kind * 131072 + loff;
#pragma unroll
        EPI_LOOP { const int q = (ai * 2 + bj) * 4 + m; f32x4 v0 = acc[ai][bj][m][0], v1 = acc[ai][bj][m][1];
            if (act) { v0 = (f32x4){sigmoidf_(v0[0]), sigmoidf_(v0[1]), sigmoidf_(v0[2]), sigmoidf_(v0[3])}; v1 = (f32x4){sigmoidf_(v1[0]), sigmoidf_(v1[1]), sigmoidf_(v1[2]), sigmoidf_(v1[3])}; }
            u32x4 w; w.x = pk2(v0[0], v0[1]); w.y = pk2(v0[2], v0[3]); w.z = pk2(v1[0], v1[1]); w.w = pk2(v1[2], v1[3]);
            *(u32x4*)(sc + (size_t)q * 8192) = w; }
    }
};
struct EpiSlotMul {
    unsigned char* sc_;
    __device__ __forceinline__ void operator()(const f32x4 (&acc)[2][2][4][2], const UnitD& u, int wr, int wc, int fr, int fq, int tid) const {
        unsigned loff = (unsigned)tid * 16u; asm volatile("" : "+v"(loff));
        unsigned char* sc = sc_ + (size_t)u.kind * 131072 + loff;
#pragma unroll
        EPI_LOOP { const int q = (ai * 2 + bj) * 4 + m; const f32x4 v0 = acc[ai][bj][m][0], v1 = acc[ai][bj][m][1];
            u32x4* sp = (u32x4*)(sc + (size_t)q * 8192); const u32x4 p = *sp;
            u32x4 w; w.x = pk2(sigmoidf_(v0[0]) * bflo(p.x), sigmoidf_(v0[1]) * bfhi(p.x)); w.y = pk2(sigmoidf_(v0[2]) * bflo(p.y), sigmoidf_(v0[3]) * bfhi(p.y));
            w.z = pk2(sigmoidf_(v1[0]) * bflo(p.z), sigmoidf_(v1[1]) * bfhi(p.z)); w.w = pk2(sigmoidf_(v1[2]) * bflo(p.w), sigmoidf_(v1[3]) * bfhi(p.w));
            *sp = w;
            if (m & 1) asm volatile("" ::: "memory"); }
    }
};
struct EpiBranch {
    const unsigned char* sc_; bf16* MG; int first;
    __device__ __forceinline__ void operator()(const f32x4 (&acc)[2][2][4][2], const UnitD& u, int wr, int wc, int fr, int fq, int tid) const {
        const int row0 = u.pm * BM + wr * 64 + fr, col0 = u.pn * BM + wc * 32 + 8 * fq;
        unsigned loff = (unsigned)tid * 16u; asm volatile("" : "+v"(loff));
        const unsigned char* sc = sc_ + (size_t)u.kind * 131072 + loff;
#pragma unroll
        EPI_LOOP { const int q = (ai * 2 + bj) * 4 + m; const f32x4 v0 = acc[ai][bj][m][0], v1 = acc[ai][bj][m][1];
            const u32x4 g = *(const u32x4*)(sc + (size_t)q * 8192);
            u32x4* p = (u32x4*)(MG + (size_t)(row0 + ai * HALF + m * 16) * DM + col0 + bj * HALF);
            f32x4 t0 = (f32x4){bflo(g.x) * v0[0], bfhi(g.x) * v0[1], bflo(g.y) * v0[2], bfhi(g.y) * v0[3]};
            f32x4 t1 = (f32x4){bflo(g.z) * v1[0], bfhi(g.z) * v1[1], bflo(g.w) * v1[2], bfhi(g.w) * v1[3]};
            if (!first) { const u32x4 x = *p; t0 += (f32x4){bflo(x.x), bfhi(x.x), bflo(x.y), bfhi(x.y)}; t1 += (f32x4){bflo(x.z), bfhi(x.z), bflo(x.w), bfhi(x.w)}; }
            u32x4 w; w.x = pk2(t0[0], t0[1]); w.y = pk2(t0[2], t0[3]); w.z = pk2(t1[0], t1[1]); w.w = pk2(t1[2], t1[3]);
            *p = w;
            if (m & 1) asm volatile("" ::: "memory"); }
    }
};
__device__ __forceinline__ float gelu_tanh_mul(float y, float u) {
    const float x = y * __builtin_fmaf(y * y, -0.10294324f, -2.3022082f); return (y * u) * __builtin_amdgcn_rcpf(1.0f + __builtin_amdgcn_exp2f(x)); }
__device__ __forceinline__ float dpp_prev1(float prev, float cur) {
    const int o = __builtin_amdgcn_update_dpp(0, __builtin_bit_cast(int, prev), 0x121, 0xf, 0xf, true);
    return __builtin_bit_cast(float, __builtin_amdgcn_update_dpp(o, __builtin_bit_cast(int, cur), 0x111, 0xf, 0xf, false)); }
__device__ __forceinline__ float dpp_prev2(float prev, float cur) {
    const int o = __builtin_amdgcn_update_dpp(0, __builtin_bit_cast(int, prev), 0x122, 0xf, 0xf, true);
    return __builtin_bit_cast(float, __builtin_amdgcn_update_dpp(o, __builtin_bit_cast(int, cur), 0x112, 0xf, 0xf, false)); }
struct EpiUp {
    bf16* GE; bf16* G0; bf16* U0; unsigned char* ACT8; const float* cw; const float* cbias;
    __device__ __forceinline__ void operator()(const f32x4 (&acc)[2][2][4][2], const UnitD& u, int wr, int wc, int fr, int fq, int tid) const {
        const int gc = u.pn * 128 + wc * 32 + 8 * fq; f32x4 wv[8];
        wv[0] = *(const f32x4*)(cw + gc); wv[1] = *(const f32x4*)(cw + gc + 4); wv[2] = *(const f32x4*)(cw + DFF + gc); wv[3] = *(const f32x4*)(cw + DFF + gc + 4);
        wv[4] = *(const f32x4*)(cw + 2 * DFF + gc); wv[5] = *(const f32x4*)(cw + 2 * DFF + gc + 4); wv[6] = *(const f32x4*)(cbias + gc); wv[7] = *(const f32x4*)(cbias + gc + 4);
#pragma unroll
        for (int ai = 0; ai < 2; ++ai) { const int rb = u.pm * 4 + ai * 2 + wr; u32x2 wprev = (u32x2){0u, 0u};
#pragma unroll
            for (int m = 0; m < 4; ++m) { const int r = wr * 64 + fr + ai * HALF + m * 16; float o[8];
#pragma unroll
                for (int i = 0; i < 8; ++i) { const float g0_ = acc[ai][0][m][i >> 2][i & 3], gp_ = (m > 0) ? acc[ai][0][m > 0 ? m - 1 : 0][i >> 2][i & 3] : 0.f;
                    const float g1_ = dpp_prev1(gp_, g0_), g2_ = dpp_prev2(gp_, g0_);
                    const float y_ = __builtin_fmaf(wv[4 + (i >> 2)][i & 3], g0_, __builtin_fmaf(wv[2 + (i >> 2)][i & 3], g1_, __builtin_fmaf(wv[(i >> 2)][i & 3], g2_, wv[6 + (i >> 2)][i & 3])));
                    o[i] = gelu_tanh_mul(y_, acc[ai][1][m][i >> 2][i & 3]); }
                u32x2 w8; w8.x = pk4f8(o[0], o[1], o[2], o[3]); w8.y = pk4f8(o[4], o[5], o[6], o[7]);
                if (!(m & 1)) wprev = w8;
                else {
                    const auto sx = __builtin_amdgcn_permlane16_swap(wprev.x, w8.x, false, false); const auto sy = __builtin_amdgcn_permlane16_swap(wprev.y, w8.y, false, false);
                    u32x4 w16; w16.x = sx[0]; w16.y = sy[0]; w16.z = sx[1]; w16.w = sy[1];
                    *(u32x4*)(ACT8 + (size_t)(u.pm * BM + r - 16 + 16 * (fq & 1)) * DFF + gc - 8 * (fq & 1)) = w16; }
                if (m == 0 || m == 3) { const f32x4 v0 = acc[ai][0][m][0], v1 = acc[ai][0][m][1]; u32x4 w; w.x = pk2(v0[0], v0[1]); w.y = pk2(v0[2], v0[3]); w.z = pk2(v1[0], v1[1]); w.w = pk2(v1[2], v1[3]);
                    if (m == 0 && fr < 2) { *(u32x4*)(G0 + ((size_t)rb * 2 + fr) * DFF + gc) = w;
                        const f32x4 x0 = acc[ai][1][m][0], x1 = acc[ai][1][m][1]; u32x4 wu; wu.x = pk2(x0[0], x0[1]); wu.y = pk2(x0[2], x0[3]); wu.z = pk2(x1[0], x1[1]); wu.w = pk2(x1[2], x1[3]);
                        *(u32x4*)(U0 + ((size_t)rb * 2 + fr) * DFF + gc) = wu; }
                    if (m == 3 && fr >= 14) *(u32x4*)(GE + ((size_t)rb * 2 + (fr - 14)) * DFF + gc) = w; } } }
    }
};
struct EpiG3 {
    bf16* XB;
    __device__ __forceinline__ void operator()(const f32x4 (&acc)[2][2][4][2], const UnitD& u, int wr, int wc, int fr, int fq, int tid) const {
        const int row0 = u.pm * BM + wr * 64 + fr, col0 = u.pn * BM + wc * 32 + 8 * fq;
#pragma unroll
        EPI_LOOP { const f32x4 v0 = acc[ai][bj][m][0], v1 = acc[ai][bj][m][1];
            u32x4* p = (u32x4*)(XB + (size_t)(row0 + ai * HALF + m * 16) * DM + col0 + bj * HALF); const u32x4 x = *p;
            u32x4 w; w.x = pk2(ALPHA * bflo(x.x) + v0[0], ALPHA * bfhi(x.x) + v0[1]); w.y = pk2(ALPHA * bflo(x.y) + v0[2], ALPHA * bfhi(x.y) + v0[3]);
            w.z = pk2(ALPHA * bflo(x.z) + v1[0], ALPHA * bfhi(x.z) + v1[1]); w.w = pk2(ALPHA * bflo(x.w) + v1[2], ALPHA * bfhi(x.w) + v1[3]);
            *p = w; }
    }
};
struct EpiG5b {
    const unsigned char* esc_; bf16* XB;
    __device__ __forceinline__ void operator()(const f32x4 (&acc)[2][2][4][2], const UnitD& u, int wr, int wc, int fr, int fq, int tid) const {
        const int row0 = u.pm * BM + wr * 64 + fr, col0 = u.pn * BM + wc * 32 + 8 * fq;
        unsigned loff = (unsigned)tid * 16u; asm volatile("" : "+v"(loff));
        const unsigned char* esc = esc_ + (size_t)u.kind * 131072 + loff;
#pragma unroll
        EPI_LOOP { const int q = (ai * 2 + bj) * 4 + m; const f32x4 v0 = acc[ai][bj][m][0], v1 = acc[ai][bj][m][1];
            const u32x4 e = *(const u32x4*)(esc + (size_t)q * 8192);
            u32x4* p = (u32x4*)(XB + (size_t)(row0 + ai * HALF + m * 16) * DM + col0 + bj * HALF); const u32x4 x = *p;
            u32x4 w; w.x = pk2(ALPHA * bflo(x.x) + v0[0] + bflo(e.x), ALPHA * bfhi(x.x) + v0[1] + bfhi(e.x)); w.y = pk2(ALPHA * bflo(x.y) + v0[2] + bflo(e.y), ALPHA * bfhi(x.y) + v0[3] + bfhi(e.y));
            w.z = pk2(ALPHA * bflo(x.z) + v1[0] + bflo(e.z), ALPHA * bfhi(x.z) + v1[1] + bfhi(e.z)); w.w = pk2(ALPHA * bflo(x.w) + v1[2] + bflo(e.w), ALPHA * bfhi(x.w) + v1[3] + bfhi(e.w));
            *p = w;
            if (m & 1) asm volatile("" ::: "memory"); }
    }
};
}

struct Frame {
    LAS unsigned char* lds;
    int tid, lane, wave, G, wg;
    unsigned char* ws; unsigned char* dob;
};
struct Args { const float* in[21]; float* out; unsigned char* ws; int ph_lo, ph_hi, sub, pad; };

__device__ __forceinline__ int z_src(int n, float& sc) {
    sc = 1.f;
    if (n < 768) { if (n < 256) sc = 0.17677669529663687f * LOG2E; return n; }
    if (n < 1536) { if (n < 1024) sc = 0.125f * LOG2E; return n; }
    if (n < 2560) { if (n >= 1792 && n < 2048) sc = 0.125f; return 1700 + (n - 1536); }
    if (n < 2816) { if (n < 2688) sc = 0.17677669529663687f; return 2724 + (n - 2560); }
    if (n < 3072) return 2980 + (n - 2816);
    if (n < 3328) return 3252 + (n - 3072);
    if (n < 3456) return 1536 + (n - 3328);
    if (n < 3488) return 1664 + (n - 3456);
    if (n < 3492) return 1696 + (n - 3488);
    if (n >= 3504 && n < 3520) return 3236 + (n - 3504);
    return -1;
}
template <int MODE>
__device__ __forceinline__ void transpose_item(const float* W, int Nsrc, int soff, bf16* WT, int dpitch, int dcol0, int k0, int n0, LAS float* scr, int lane) {
    const int nn = lane & 31; float sc = 1.f; int s;
    if (MODE == 1) s = z_src(n0 + nn, sc); else s = soff + n0 + nn;
#pragma unroll 8
    for (int i = 0; i < 32; ++i) { const int kk = 2 * i + (lane >> 5); scr[kk * 33 + nn] = (s >= 0) ? W[(size_t)(k0 + kk) * Nsrc + s] * sc : 0.f; }
    asm volatile("s_waitcnt lgkmcnt(0)" ::: "memory");
    const int c = lane & 7;
#pragma unroll
    for (int j = 0; j < 4; ++j) { const int n = (lane >> 3) + 8 * j; const LAS float* sp = scr + (8 * c) * 33 + n;
        u32x4 o; o.x = pk2(sp[0 * 33], sp[1 * 33]); o.y = pk2(sp[2 * 33], sp[3 * 33]); o.z = pk2(sp[4 * 33], sp[5 * 33]); o.w = pk2(sp[6 * 33], sp[7 * 33]);
        *(u32x4*)(WT + (size_t)(n0 + n) * dpitch + dcol0 + k0 + 8 * c) = o; }
    asm volatile("s_waitcnt lgkmcnt(0)" ::: "memory");
}
__device__ __forceinline__ void transpose_item8(const float* W, int Nsrc, int soff, unsigned char* WT, int K, int k0, int n0, LAS float* scr, int lane) {
    const int nn = lane & 31; const int s = soff + n0 + nn;
#pragma unroll 8
    for (int i = 0; i < 32; ++i) { const int kk = 2 * i + (lane >> 5); scr[kk * 33 + nn] = W[(size_t)(k0 + kk) * Nsrc + s] * 64.f; }
    asm volatile("s_waitcnt lgkmcnt(0)" ::: "memory");
    const int c = lane & 7;
#pragma unroll
    for (int j = 0; j < 4; ++j) { const int n = (lane >> 3) + 8 * j; const LAS float* sp = scr + (8 * c) * 33 + n;
        u32x2 o; o.x = pk4f8(sp[0 * 33], sp[1 * 33], sp[2 * 33], sp[3 * 33]); o.y = pk4f8(sp[4 * 33], sp[5 * 33], sp[6 * 33], sp[7 * 33]);
        *(u32x2*)(WT + (size_t)(n0 + n) * K + k0 + 8 * c) = o; }
    asm volatile("s_waitcnt lgkmcnt(0)" ::: "memory");
}
__device__ __forceinline__ void transpose_item8z(const float* W, unsigned char* WT, int tile, int slot, int k0, int n0, LAS float* scr, int lane) {
    const int nn = lane & 31; float sc = 1.f; const int s = z_src(tile * 256 + n0 + nn, sc); sc *= 64.f;
#pragma unroll 8
    for (int i = 0; i < 32; ++i) { const int kk = 2 * i + (lane >> 5); scr[kk * 33 + nn] = (s >= 0) ? W[(size_t)(k0 + kk) * NIN + s] * sc : 0.f; }
    asm volatile("s_waitcnt lgkmcnt(0)" ::: "memory");
    const int c = lane & 7;
#pragma unroll
    for (int j = 0; j < 4; ++j) { const int n = (lane >> 3) + 8 * j; const LAS float* sp = scr + (8 * c) * 33 + n;
        u32x2 o; o.x = pk4f8(sp[0 * 33], sp[1 * 33], sp[2 * 33], sp[3 * 33]); o.y = pk4f8(sp[4 * 33], sp[5 * 33], sp[6 * 33], sp[7 * 33]);
        *(u32x2*)(WT + (size_t)(slot * 256 + n0 + n) * 1024 + k0 + 8 * c) = o; }
    asm volatile("s_waitcnt lgkmcnt(0)" ::: "memory");
}
typedef __attribute__((address_space(4))) const struct Args* KArgPtr;
__device__ __forceinline__ void convert_w123(Frame& F, const float* w_in, const float* w_branch, const float* w_out) {
    LAS float* scr = (LAS float*)(F.lds + F.wave * 16384);
    const int gw = F.wg * NWAVES + F.wave, NGW = F.G * NWAVES;
    constexpr int I1 = 16 * 48, I2 = 0, I3 = 4 * 128, I4 = 16 * 32;
    unsigned char* w123 = F.ws + WS_W123;
    for (int it = gw; it < I1 + I2 + I3 + I4; it += NGW) {
        int r = it;
        if (r < I1) { const int nb = r % 48, tile = (int)((G1_BF_TILES >> (4 * (nb >> 3))) & 15); transpose_item<1>(w_in, NIN, 0, (bf16*)(w123 + W123_W1), 1024, 0, 64 * (r / 48), tile * 256 + 32 * (nb & 7), scr, F.lane); continue; } r -= I1;
        if (r < I3) { const int n = r / 128, rr = r % 128; transpose_item<0>(w_branch + (size_t)n * 256 * DM, DM, 0, (bf16*)(w123 + W123_GB + 8 * MiB) + (size_t)n * 1024 * 256, 256, 0, 64 * (rr / 32), 32 * (rr % 32), scr, F.lane); continue; } r -= I3;
        transpose_item<0>(w_out, DM, 0, (bf16*)(w123 + W123_WO), 1024, 0, 64 * (r / 32), 32 * (r % 32), scr, F.lane);
    }
}
__device__ __forceinline__ void p0_prologue(Frame& F, __attribute__((address_space(4))) const Args* Ap) {
    LAS float* scr = (LAS float*)(F.lds + F.wave * 16384);
    const int gw = F.wg * NWAVES + F.wave, NGW = F.G * NWAVES;
    constexpr int I5 = 0, I6 = 0, I7 = 4 * 32, I8 = 0;
    constexpr int IL = I5 + I6 + I7 + I8;
    for (int it = gw; it < 2 * IL; it += NGW) {
        const int l = it / IL; int r = it - l * IL;
        unsigned char* w45 = F.ws + WS_W45 + (size_t)l * W45_STRIDE;
        if (r < I7) { transpose_item<0>(Ap->in[18] + (size_t)l * PDIM * DM, DM, 0, (bf16*)(w45 + W45_PP), 256, 0, 64 * (r / 32), 32 * (r % 32), scr, F.lane); continue; } r -= I7;
        transpose_item<0>(Ap->in[16] + (size_t)l * DFF * DM, DM, 0, (bf16*)(w45 + W45_DN), DFF, 0, 64 * (r / 32), 32 * (r % 32), scr, F.lane);
    }
    {   constexpr int J1 = 16 * 128, J2 = 16 * 176, J3 = 16 * 32, J4 = 44 * 32, J5 = 8 * 16 * 8, JL = J1 + J2 + J3 + J4 + J5;
        for (int it = gw; it < 2 * JL; it += NGW) { const int l = it / JL; int r = it - l * JL; unsigned char* w8 = F.dob + DO_W8 + (size_t)l * W8_STRIDE;
            if (r < J1) { transpose_item8(Ap->in[2] + (size_t)l * DM * NIN, NIN, SRC_MG, w8 + W8_G, 1024, 64 * (r / 128), 32 * (r % 128), scr, F.lane); continue; } r -= J1;
            if (r < J2) { const int sn = 32 * (r % 176), dn = sn < DFF ? (sn >> 7) * 256 + 128 + (sn & 127) : ((sn - DFF) >> 7) * 256 + ((sn - DFF) & 127);
                transpose_item8(Ap->in[13] + (size_t)l * DM * UGW, UGW, sn - dn, w8 + W8_UP, 1024, 64 * (r / 176), dn, scr, F.lane); continue; } r -= J2;
            if (r < J3) { transpose_item8(Ap->in[17] + (size_t)l * DM * DM, DM, 0, w8 + W8_PG, 1024, 64 * (r / 32), 32 * (r % 32), scr, F.lane); continue; } r -= J3;
            if (r < J4) { transpose_item8(Ap->in[16] + (size_t)l * DFF * DM, DM, 0, w8 + W8_DN, DFF, 64 * (r / 32), 32 * (r % 32), scr, F.lane); continue; } r -= J4;
            { const int slot = r >> 7, rr = r & 127; transpose_item8z(Ap->in[2] + (size_t)l * DM * NIN, w8 + W8_Z, (int)((G1_F8_TILES >> (4 * slot)) & 15), slot, 64 * (rr >> 3), 32 * (rr & 7), scr, F.lane); } } }
    convert_w123(F, Ap->in[2], Ap->in[9], Ap->in[10]);
    {   const size_t n8 = (size_t)M * DM / 8; const f32x4* src = (const f32x4*)Ap->in[0]; u32x4* dst = (u32x4*)(F.ws + WS_XB); u32x2* dst8 = (u32x2*)(F.dob + DO_XB8);
        for (size_t i = (size_t)F.wg * 512 + F.tid; i < n8; i += (size_t)F.G * 512) { const f32x4 a = src[2 * i], b = src[2 * i + 1]; u32x4 o; o.x = pk2(a[0], a[1]); o.y = pk2(a[2], a[3]); o.z = pk2(b[0], b[1]); o.w = pk2(b[2], b[3]); dst[i] = o;
            u32x2 o8; o8.x = pk4f8(a[0], a[1], a[2], a[3]); o8.y = pk4f8(b[0], b[1], b[2], b[3]); dst8[i] = o8; } }
    {   const size_t n8 = (size_t)DEPTH * M * PDIM / 8; const f32x4* src = (const f32x4*)Ap->in[1]; u32x4* dst = (u32x4*)(F.ws + WS_PB);
        for (size_t i = (size_t)F.wg * 512 + F.tid; i < n8; i += (size_t)F.G * 512) { const f32x4 a = src[2 * i], b = src[2 * i + 1]; u32x4 o; o.x = pk2(a[0], a[1]); o.y = pk2(a[2], a[3]); o.z = pk2(b[0], b[1]); o.w = pk2(b[2], b[3]); dst[i] = o; } }
}

__device__ __forceinline__ void ln_phase(Frame& F, const float* w, const float* bvec, float* outf, unsigned char* xb8) {
    const int gw = F.wg * NWAVES + F.wave, NGW = F.G * NWAVES;
    bf16* XB = (bf16*)(F.ws + WS_XB);
    for (int row = gw; row < M; row += NGW) {
        u32x4* p = (u32x4*)(XB + (size_t)row * DM) + F.lane;
        const u32x4 a = p[0], b = p[64];
        float v[16] = {bflo(a.x), bfhi(a.x), bflo(a.y), bfhi(a.y), bflo(a.z), bfhi(a.z), bflo(a.w), bfhi(a.w), bflo(b.x), bfhi(b.x), bflo(b.y), bfhi(b.y), bflo(b.z), bfhi(b.z), bflo(b.w), bfhi(b.w)};
        float s = 0.f;
#pragma unroll
        for (int i = 0; i < 16; ++i) s += v[i];
        const float mean = wave_sum(s, F.lane) * (1.f / DM); float q = 0.f;
#pragma unroll
        for (int i = 0; i < 16; ++i) { v[i] -= mean; q += v[i] * v[i]; }
        const float rstd = 1.f / sqrtf(wave_sum(q, F.lane) * (1.f / DM) + LN_EPS);
        const int c0 = F.lane * 8, c1 = 512 + F.lane * 8;
        const f32x4 w0 = *(const f32x4*)(w + c0), w1 = *(const f32x4*)(w + c0 + 4), w2 = *(const f32x4*)(w + c1), w3 = *(const f32x4*)(w + c1 + 4);
        const f32x4 b0 = *(const f32x4*)(bvec + c0), b1 = *(const f32x4*)(bvec + c0 + 4), b2 = *(const f32x4*)(bvec + c1), b3 = *(const f32x4*)(bvec + c1 + 4);
        f32x4 y0, y1, y2, y3;
#pragma unroll
        for (int i = 0; i < 4; ++i) { y0[i] = v[i] * rstd * w0[i] + b0[i]; y1[i] = v[4 + i] * rstd * w1[i] + b1[i]; y2[i] = v[8 + i] * rstd * w2[i] + b2[i]; y3[i] = v[12 + i] * rstd * w3[i] + b3[i]; }
        u32x4 o0, o1; o0.x = pk2(y0[0], y0[1]); o0.y = pk2(y0[2], y0[3]); o0.z = pk2(y1[0], y1[1]); o0.w = pk2(y1[2], y1[3]);
        o1.x = pk2(y2[0], y2[1]); o1.y = pk2(y2[2], y2[3]); o1.z = pk2(y3[0], y3[1]); o1.w = pk2(y3[2], y3[3]);
        p[0] = o0; p[64] = o1;
        if (xb8) { u32x2* q8 = (u32x2*)(xb8 + (size_t)row * DM) + F.lane; u32x2 a8, b8; a8.x = pk4f8(y0[0], y0[1], y0[2], y0[3]); a8.y = pk4f8(y1[0], y1[1], y1[2], y1[3]); b8.x = pk4f8(y2[0], y2[1], y2[2], y2[3]); b8.y = pk4f8(y3[0], y3[1], y3[2], y3[3]); q8[0] = a8; q8[64] = b8; }
        if (outf) { f32x4* op = (f32x4*)(outf + (size_t)row * DM); op[2 * F.lane] = y0; op[2 * F.lane + 1] = y1; op[128 + 2 * F.lane] = y2; op[128 + 2 * F.lane + 1] = y3; }
    }
}

__device__ __forceinline__ float gelu_tanh_(float y) { const float t = 1.5957691216057308f * (y + 0.044715f * y * y * y); return y * __builtin_amdgcn_rcpf(1.0f + __builtin_amdgcn_exp2f(-LOG2E * t)); }
__device__ __forceinline__ void ffn_act_phase(Frame& F, const float* cw, const float* cb) {
    const bf16* GE = (const bf16*)(F.ws + WS_GE); const bf16* G0 = (const bf16*)(F.ws + WS_G0); const bf16* U0 = (const bf16*)(F.ws + WS_U0); unsigned char* ACT8 = F.ws + WS_ACT8;
    for (int idx = F.wg * 512 + F.tid; idx < 512 * 2 * 352; idx += F.G * 512) {
        const int v = idx % 352, t = idx / 352, r = t & 1, rb = t >> 1; const int gc = 8 * v;
        const size_t eb = (size_t)rb * 2 * DFF + gc, ebp = (size_t)(rb - 1) * 2 * DFF + gc; const bool first = (rb & 127) == 0;
        const u32x4 z4 = (u32x4){0u, 0u, 0u, 0u};
        float gA[8], gB[8], gC[8], uu[8];
        if (r == 0) { up8(first ? z4 : *(const u32x4*)(GE + ebp), gA); up8(first ? z4 : *(const u32x4*)(GE + ebp + DFF), gB); up8(*(const u32x4*)(G0 + eb), gC); }
        else { up8(first ? z4 : *(const u32x4*)(GE + ebp + DFF), gA); up8(*(const u32x4*)(G0 + eb), gB); up8(*(const u32x4*)(G0 + eb + DFF), gC); }
        up8(*(const u32x4*)(U0 + eb + (size_t)r * DFF), uu);
        float o[8];
#pragma unroll
        for (int i = 0; i < 8; ++i) { const float y = cb[gc + i] + cw[gc + i] * gA[i] + cw[DFF + gc + i] * gB[i] + cw[2 * DFF + gc + i] * gC[i]; o[i] = gelu_tanh_(y) * uu[i]; }
        u32x2 w8; w8.x = pk4f8(o[0], o[1], o[2], o[3]); w8.y = pk4f8(o[4], o[5], o[6], o[7]);
        *(u32x2*)(ACT8 + (size_t)(rb * 64 + r) * DFF + gc) = w8;
    }
}

namespace mx {
__device__ __forceinline__ f32x16 mfma32(bf16x8 a, bf16x8 b, f32x16 c) { return __builtin_amdgcn_mfma_f32_32x32x16_bf16(a, b, c, 0, 0, 0); }
__device__ __forceinline__ f32x16 splat16(float v) { f32x16 r;
#pragma unroll
    for (int i = 0; i < 16; ++i) r[i] = v;
    return r; }
__device__ __forceinline__ int crow_c(int e) { return (e & 3) + 8 * (e >> 2); }
typedef short v4i16_t __attribute__((ext_vector_type(4)));
__device__ __forceinline__ s16x4 vtr(const LAS unsigned char* p) { return __builtin_bit_cast(s16x4, __builtin_amdgcn_ds_read_tr16_b64_v4i16((LAS v4i16_t*)p)); }
__device__ __forceinline__ bf16x8 pack8(float a0, float a1, float a2, float a3, float a4, float a5, float a6, float a7) {
    u32x4 w; w.x = pk2(a0, a1); w.y = pk2(a2, a3); w.z = pk2(a4, a5); w.w = pk2(a6, a7); return __builtin_bit_cast(bf16x8, w); }

__device__ __forceinline__ bf16x8 tr_frag(const LAS unsigned char* T, int key0, int cblk, int lane) {
    const LAS unsigned char* p = T + (key0 + 4 * (lane >> 5) + ((lane & 15) >> 2)) * 144 + (32 * cblk + 16 * ((lane >> 4) & 1) + 4 * (lane & 3)) * 2;
    const s16x4 lo = vtr(p), hi = vtr(p + 8 * 144); return (bf16x8){lo[0], lo[1], lo[2], lo[3], hi[0], hi[1], hi[2], hi[3]}; }
__device__ __forceinline__ float log2gam(int h) { return __builtin_log2f(1.0f - __builtin_exp2f(-5.0f - (float)h)); }
__device__ __forceinline__ void prepkv_unit(Frame& F, int blk, const float* wa2, const float* bap, unsigned* kmaxl) {
    bf16* Z = (bf16*)(F.ws + WS_Z);
    const size_t r0 = (size_t)blk * 256; const int b = blk >> 5, cb = blk & 31;
    const int tid = F.tid;
    {   const int ch = tid >> 7, col = tid & 127;
        const float ba = bap[col];
        float wa[16];
#pragma unroll
        for (int r = 0; r < 16; ++r) wa[r] = wa2[r * 128 + col];
        float cum = 0.f;
        for (int t0 = 0; t0 < 64; t0 += 8) { u32x4 A[8], B[8];
#pragma unroll
            for (int tt = 0; tt < 8; ++tt) { const bf16* zr = Z + (r0 + ch * 64 + t0 + tt) * ZW; A[tt] = *(const u32x4*)(zr + ZC_DA); B[tt] = *(const u32x4*)(zr + ZC_DA + 8); }
#pragma unroll
            for (int tt = 0; tt < 8; ++tt) { float da[8], db[8]; up8(A[tt], da); up8(B[tt], db); float x = ba;
#pragma unroll
                for (int r = 0; r < 8; ++r) x += da[r] * wa[r];
#pragma unroll
                for (int r = 0; r < 8; ++r) x += db[r] * wa[8 + r];
                cum += (fminf(x, 0.f) - __logf(1.0f + __expf(-fabsf(x)))) * 0.0625f; } }
        const float bl = cum; cum = 0.f;
        for (int t0 = 0; t0 < 64; t0 += 8) { u32x4 A[8], B[8]; bf16 qv[8], kv[8];
#pragma unroll
            for (int tt = 0; tt < 8; ++tt) { const bf16* zr = Z + (r0 + ch * 64 + t0 + tt) * ZW; A[tt] = *(const u32x4*)(zr + ZC_DA); B[tt] = *(const u32x4*)(zr + ZC_DA + 8); qv[tt] = zr[ZC_DQ + col]; kv[tt] = zr[ZC_DK + col]; }
#pragma unroll
            for (int tt = 0; tt < 8; ++tt) { bf16* zr = Z + (r0 + ch * 64 + t0 + tt) * ZW; float da[8], db[8]; up8(A[tt], da); up8(B[tt], db); float x = ba;
#pragma unroll
                for (int r = 0; r < 8; ++r) x += da[r] * wa[r];
#pragma unroll
                for (int r = 0; r < 8; ++r) x += db[r] * wa[8 + r];
                cum += (fminf(x, 0.f) - __logf(1.0f + __expf(-fabsf(x)))) * 0.0625f;
                zr[ZC_DQ + col] = (bf16)f2bf(bf1(qv[tt]) * __expf(cum - bl)); zr[ZC_DK + col] = (bf16)f2bf(bf1(kv[tt]) * __expf(bl - cum)); } }
        ((float*)(F.ws + WS_DE))[((size_t)b * 128 + cb * 4 + ch) * 128 + col] = __expf(bl);
    }
    for (int itn = 0; itn < 6; ++itn) { const int task = tid + 512 * itn, sl = task >> 8, row = task & 255;
        const bf16* kp = Z + (r0 + row) * ZW + (sl < 8 ? ZC_AK + (sl >> 1) * 64 + (sl & 1) * 32 : ZC_BK + (sl - 8) * 64); float ss = 0.f;
        const int nch = sl < 8 ? 4 : 8;
        for (int c = 0; c < nch; ++c) { float v[8]; up8(*(const u32x4*)(kp + 8 * c), v);
#pragma unroll
            for (int i = 0; i < 8; ++i) ss += v[i] * v[i]; }
#pragma unroll
        for (int o = 1; o < 64; o <<= 1) ss = fmaxf(ss, shx(ss, F.lane, o));
        if (F.lane == 0) __hip_atomic_fetch_max(kmaxl + b * 16 + sl, __float_as_uint(sqrtf(ss)), __ATOMIC_RELAXED, __HIP_MEMORY_SCOPE_AGENT); }
    for (int i0 = 0; i0 < 32; i0 += 4) { u32x4 vv[4];
#pragma unroll
        for (int k = 0; k < 4; ++k) { const int idx = tid + 512 * (i0 + k); const int row = idx >> 6, chunk = idx & 63, isk = chunk >> 5, c8 = (chunk & 31) * 8;
            vv[k] = *(const u32x4*)(Z + (r0 + row) * ZW + (isk ? ZC_CK : ZC_CQ) + c8); }
#pragma unroll
        for (int k = 0; k < 4; ++k) { const int idx = tid + 512 * (i0 + k); const int row = idx >> 6, chunk = idx & 63, isk = chunk >> 5, c8 = (chunk & 31) * 8, h = c8 >> 6;
            const float e = (float)(255 - row) * log2gam(h); const float f = __builtin_amdgcn_exp2f(isk ? e : -e); float v[8]; up8(vv[k], v);
            u32x4 w; w.x = pk2(v[0] * f, v[1] * f); w.y = pk2(v[2] * f, v[3] * f); w.z = pk2(v[4] * f, v[5] * f); w.w = pk2(v[6] * f, v[7] * f);
            *(u32x4*)(Z + (r0 + row) * ZW + (isk ? ZC_CK : ZC_CQ) + c8) = w; } }
    __threadfence_block(); __syncthreads();
    LAS unsigned char* Kl = F.lds; LAS unsigned char* Vl = F.lds + 36864;
    for (int h = 0; h < 4; ++h) {
        for (int idx = tid; idx < 256 * 8; idx += 512) { const int row = idx >> 3, c = idx & 7;
            *(LAS u32x4*)(Kl + row * 144 + c * 16) = *(const u32x4*)(Z + (r0 + row) * ZW + ZC_CK + h * 64 + c * 8);
            *(LAS u32x4*)(Vl + row * 144 + c * 16) = *(const u32x4*)(Z + (r0 + row) * ZW + ZC_CV + h * 64 + c * 8); }
        __syncthreads();
        if (F.wave < 4) {
            const int db = F.wave & 1, nb = F.wave >> 1; f32x16 acc = splat16(0.f);
#pragma unroll 4
            for (int kb = 0; kb < 16; ++kb) acc = mfma32(tr_frag(Vl, 16 * kb, db, F.lane), tr_frag(Kl, 16 * kb, nb, F.lane), acc);
            float* o = (float*)(F.ws + WS_KVC) + ((size_t)((b * 4 + h) * 32 + cb) * 4096) + 32 * nb + (F.lane & 31);
#pragma unroll
            for (int e = 0; e < 16; ++e) o[(32 * db + crow_c(e) + 4 * (F.lane >> 5)) * 64] = acc[e]; }
        __syncthreads();
        for (int idx = tid; idx < 256 * 8; idx += 512) { const int row = idx >> 3, c = idx & 7;
            if (c < 4) *(LAS u32x4*)(Kl + row * 144 + c * 16) = *(const u32x4*)(Z + (r0 + row) * ZW + ZC_DK + h * 32 + c * 8);
            *(LAS u32x4*)(Vl + row * 144 + c * 16) = *(const u32x4*)(Z + (r0 + row) * ZW + ZC_DV + h * 64 + c * 8); }
        __syncthreads();
        {   const int ch = F.wave >> 1, db = F.wave & 1; f32x16 acc = splat16(0.f);
#pragma unroll
            for (int kb = 0; kb < 4; ++kb) acc = mfma32(tr_frag(Vl, 64 * ch + 16 * kb, db, F.lane), tr_frag(Kl, 64 * ch + 16 * kb, 0, F.lane), acc);
            float* o = (float*)(F.ws + WS_KVD) + ((size_t)((b * 4 + h) * 128 + cb * 4 + ch) * 2048) + (F.lane & 31);
#pragma unroll
            for (int e = 0; e < 16; ++e) o[(32 * db + crow_c(e) + 4 * (F.lane >> 5)) * 32] = acc[e]; }
        __syncthreads();
    }
}

__device__ __forceinline__ void scan_phase(Frame& F) {
    const int gt = F.wg * 512 + F.tid, NT = F.G * 512;
    for (int e0 = gt; e0 < 16 * 4096 + 16 * 2048; e0 += NT) {
        if (e0 < 16 * 4096) { const int e = e0;
            const int bh = e >> 12, idx = e & 4095, h = bh & 3; const float g256 = __builtin_amdgcn_exp2f(256.0f * log2gam(h));
            float* p = (float*)(F.ws + WS_KVC) + (size_t)bh * 32 * 4096 + idx; float S = 0.f; float kv[32];
#pragma unroll
            for (int c = 0; c < 32; ++c) kv[c] = p[(size_t)c * 4096];
#pragma unroll
            for (int c = 0; c < 32; ++c) { const float Sp = g256 * S; p[(size_t)c * 4096] = Sp; S = Sp + kv[c]; }
        } else { const int e = e0 - 16 * 4096;
            const int bh = e >> 11, idx = e & 2047, b = bh >> 2, h = bh & 3, dk = idx & 31;
            float* p = (float*)(F.ws + WS_KVD) + (size_t)bh * 128 * 2048 + idx; const float* de = (const float*)(F.ws + WS_DE) + (size_t)b * 128 * 128 + h * 32 + dk; float S = 0.f;
            for (int c0 = 0; c0 < 128; c0 += 16) { float kv[16], dd[16];
#pragma unroll
                for (int c = 0; c < 16; ++c) { kv[c] = p[(size_t)(c0 + c) * 2048]; dd[c] = de[(c0 + c) * 128]; }
#pragma unroll
                for (int c = 0; c < 16; ++c) { const float Sp = dd[c] * S; p[(size_t)(c0 + c) * 2048] = Sp; S = Sp + kv[c]; } }
        }
    }
}

constexpr int HPITCH = 1026, CAP = 256;
struct QState { unsigned mode, thr_lo, thr_hi, thr_idx, krem, lcount, pad0, pad1; };
__device__ __forceinline__ unsigned okey_of(float s) { const unsigned u = __float_as_uint(s); return u ^ ((unsigned)((int)u >> 31) | 0x80000000u); }
__device__ __forceinline__ void b1_load(const unsigned char* IKb, int t, int lane, bf16x8& k0, bf16x8& k1) {
    const unsigned char* p = IKb + (size_t)t * 2048 + lane * 16; k0 = *(const bf16x8*)p; k1 = *(const bf16x8*)(p + 1024); }
__device__ __forceinline__ void b1_scores(const bf16x8 k0, const bf16x8 k1, const bf16x8 (&iqf)[4][2], const float (&w)[4], float (&sc)[16]) {
#pragma unroll
    for (int e = 0; e < 16; ++e) sc[e] = 0.f;
#pragma unroll
    for (int ih = 0; ih < 4; ++ih) { f32x16 lg = mfma32(k0, iqf[ih][0], splat16(0.f)); lg = mfma32(k1, iqf[ih][1], lg);
#pragma unroll
        for (int e = 0; e < 16; ++e) sc[e] = fmaf(w[ih], __builtin_amdgcn_fmed3f(lg[e], 0.f, __builtin_inff()), sc[e]); }
}
__device__ __forceinline__ void b1_setbit(LAS unsigned* MWq, unsigned j) {
    const unsigned wi = j & 31u, hh = (wi >> 2) & 1u, e = (wi & 3u) + 4u * (wi >> 3), kh = (j >> 5) & 1u;
    __hip_atomic_fetch_or(MWq + (j >> 6) * 64 + 32u * hh, 1u << (e + 16u * kh), __ATOMIC_RELAXED, __HIP_MEMORY_SCOPE_WORKGROUP);
}
template <bool DIAG>
__device__ __forceinline__ void b1_hist_tile(LAS unsigned* hrow, const float (&sc)[16], int jbase, int qpos) {
#pragma unroll
    for (int e = 0; e < 16; ++e) { if (!DIAG || jbase + crow_c(e) <= qpos) { const unsigned bin = okey_of(sc[e]) >> 21;
        __hip_atomic_fetch_add(hrow + (bin >> 1), 1u << ((bin & 1) * 16), __ATOMIC_RELAXED, __HIP_MEMORY_SCOPE_WORKGROUP); } }
}
template <bool DIAG>
__device__ __forceinline__ unsigned b1_mask_tile(const float (&sc)[16], int jbase, int qpos, float tlo_f, float thi_f, unsigned mode, unsigned word, LAS QState* qs, LAS unsigned char* lds, int r) {
#pragma unroll
    for (int e = 15; e >= 0; --e) { const float s = sc[e]; const int j = jbase + crow_c(e); const bool valid = !DIAG || (j <= qpos);
        if (DIAG) word = word + word + ((valid && s > thi_f) ? 1u : 0u);
        else asm("v_cmp_gt_f32 vcc, %1, %2\n\tv_addc_co_u32 %0, vcc, %0, %0, vcc" : "+v"(word) : "v"(s), "v"(thi_f) : "vcc");
        if (valid && s >= tlo_f && !(s > thi_f)) {
            if (mode == 1u) { const unsigned pos = __hip_atomic_fetch_add(&qs->lcount, 1u, __ATOMIC_RELAXED, __HIP_MEMORY_SCOPE_WORKGROUP);
                if (pos < (unsigned)CAP) { LAS unsigned* le = (LAS unsigned*)(lds + ((size_t)r * CAP + pos) * 8); le[0] = okey_of(s); le[1] = (unsigned)j; } }
            else __hip_atomic_fetch_or((LAS unsigned*)(lds + 65536 + r * 1024) + (j >> 5), 1u << (j & 31), __ATOMIC_RELAXED, __HIP_MEMORY_SCOPE_WORKGROUP); } }
    return word;
}
__device__ __forceinline__ unsigned rowsum16(unsigned v) {
    v += (unsigned)__builtin_amdgcn_update_dpp(0, (int)v, 0x128, 0xf, 0xf, true); v += (unsigned)__builtin_amdgcn_update_dpp(0, (int)v, 0x124, 0xf, 0xf, true);
    v += (unsigned)__builtin_amdgcn_update_dpp(0, (int)v, 0x122, 0xf, 0xf, true); v += (unsigned)__builtin_amdgcn_update_dpp(0, (int)v, 0x121, 0xf, 0xf, true); return v; }
__device__ __forceinline__ float b1_fkey(unsigned k) { return __uint_as_float((k & 0x80000000u) ? (k ^ 0x80000000u) : ~k); }
__device__ __forceinline__ void b1_unit(Frame& F, int b, int g) {
    const int tid = F.tid, lane = F.lane, r = lane & 31, hh = lane >> 5, wid = F.wave;
    const bf16* Zb = (const bf16*)(F.ws + WS_Z) + (size_t)b * SEQ * ZW;
    const unsigned char* IKb = F.ws + WS_IKC + (size_t)b * (SEQ / 32) * 2048;
    LAS unsigned* hist = (LAS unsigned*)F.lds;
    LAS QState* qst = (LAS QState*)(F.lds + QST_OFF);
    const int qpos = 32 * g + r;
    unsigned* MWb = (unsigned*)(F.ws + WS_MASK) + ((size_t)(b * 256 + g) * 128) * 64;
    LAS unsigned* MWl = (LAS unsigned*)(F.lds + 98304);
    bf16x8 iqf[4][2]; float w[4];
    {   const bf16* qr = Zb + (size_t)qpos * ZW;
#pragma unroll
        for (int ih = 0; ih < 4; ++ih) { iqf[ih][0] = *(const bf16x8*)(qr + ZC_IQ + ih * 32 + 8 * hh); iqf[ih][1] = *(const bf16x8*)(qr + ZC_IQ + ih * 32 + 16 + 8 * hh); w[ih] = bf1(qr[ZC_IW + ih]); } }
    if (g >= 8) {
        for (int i = tid; i < 32 * HPITCH; i += 512) hist[i] = 0u;
        __syncthreads();
        {   LAS unsigned* hrow = hist + r * HPITCH;
            bf16x8 a0 = iqf[0][0], a1 = iqf[0][0], c0 = iqf[0][0], c1 = iqf[0][0]; int t = wid;
            if (t <= g) b1_load(IKb, t, lane, a0, a1);
            if (t + 8 <= g) b1_load(IKb, t + 8, lane, c0, c1);
            for (; t < g; t += 8) { const bf16x8 k0 = a0, k1 = a1; a0 = c0; a1 = c1; if (t + 16 <= g) b1_load(IKb, t + 16, lane, c0, c1);
                float sc[16]; b1_scores(k0, k1, iqf, w, sc); b1_hist_tile<false>(hrow, sc, 32 * t + 4 * hh, qpos); }
            if (t == g) { float sc[16]; b1_scores(a0, a1, iqf, w, sc); b1_hist_tile<true>(hrow, sc, 32 * t + 4 * hh, qpos); } }
        __syncthreads();
        for (int qq = 0; qq < 4; ++qq) { const int q = 4 * wid + qq; const LAS unsigned* hq = hist + q * HPITCH;
            const int wbase = 1008 - 16 * lane; unsigned s = 0;
#pragma unroll
            for (int k = 0; k < 16; ++k) { const unsigned x = hq[wbase + k]; s += (x & 0xffffu) + (x >> 16); }
            unsigned P = s;
#pragma unroll
            for (int o = 1; o < 64; o <<= 1) { const unsigned t = shup(P, lane, o); if (lane >= o) P += t; }
            const unsigned long long bal = __ballot(P >= 256u);
            const int Lsel = bal ? __builtin_ctzll(bal) : 63;
            if (lane == Lsel) { unsigned cum = P - s; unsigned b1 = 0, cin = 0, cab = 0;
                for (int k = 0; k < 32; ++k) { const int bin = 2047 - 32 * lane - k; const unsigned x = hq[bin >> 1]; const unsigned c = (bin & 1) ? (x >> 16) : (x & 0xffffu);
                    if (cum + c >= 256u) { b1 = (unsigned)bin; cin = c; cab = cum; break; } cum += c; }
                qst[q].thr_lo = b1 << 21; qst[q].thr_hi = (b1 << 21) | 0x1fffffu; qst[q].thr_idx = 0xffffu; qst[q].krem = 256u - cab; qst[q].lcount = 0u; qst[q].pad0 = cin; qst[q].pad1 = 0u;
                qst[q].mode = (b1 == 1024u || cin > (unsigned)CAP) ? 2u : 1u; }
        }
        __syncthreads();
        for (int i = tid; i < 32 * 256; i += 512) ((LAS unsigned*)(F.lds + 65536))[i] = 0u;
        __syncthreads();
    }
    {   unsigned mode = 0u; float tlo_f = __builtin_inff(), thi_f = -__builtin_inff();
        if (g >= 8) { mode = qst[r].mode; const unsigned tlo = qst[r].thr_lo, thi = qst[r].thr_hi; tlo_f = b1_fkey(tlo); thi_f = (thi == 0x7fffffffu) ? __uint_as_float(0x80000001u) : b1_fkey(thi); }
        const int nk = g >> 1; LAS QState* qs = &qst[r];
        bf16x8 a0 = iqf[0][0], a1 = iqf[0][0], a2 = iqf[0][0], a3 = iqf[0][0], c0 = iqf[0][0], c1 = iqf[0][0], c2 = iqf[0][0], c3 = iqf[0][0]; int kt = wid;
        if (kt <= nk) { b1_load(IKb, 2 * kt, lane, a0, a1); if (2 * kt + 1 <= g) b1_load(IKb, 2 * kt + 1, lane, a2, a3); }
        if (kt + 8 <= nk) { b1_load(IKb, 2 * kt + 16, lane, c0, c1); if (2 * kt + 17 <= g) b1_load(IKb, 2 * kt + 17, lane, c2, c3); }
        for (; kt < nk; kt += 8) {
            const bf16x8 k0 = a0, k1 = a1, k2 = a2, k3 = a3; a0 = c0; a1 = c1; a2 = c2; a3 = c3;
            if (kt + 16 <= nk) { b1_load(IKb, 2 * kt + 32, lane, c0, c1); if (2 * kt + 33 <= g) b1_load(IKb, 2 * kt + 33, lane, c2, c3); }
            unsigned word = 0u;
            { float sc[16]; b1_scores(k2, k3, iqf, w, sc); word = b1_mask_tile<false>(sc, 32 * (2 * kt + 1) + 4 * hh, qpos, tlo_f, thi_f, mode, word, qs, F.lds, r); }
            { float sc[16]; b1_scores(k0, k1, iqf, w, sc); word = b1_mask_tile<false>(sc, 32 * (2 * kt) + 4 * hh, qpos, tlo_f, thi_f, mode, word, qs, F.lds, r); }
            MWl[kt * 64 + lane] = word; }
        if (kt == nk) {
            unsigned word = 0u;
            if (2 * kt + 1 <= g) { float sc[16]; b1_scores(a2, a3, iqf, w, sc); word = b1_mask_tile<true>(sc, 32 * (2 * kt + 1) + 4 * hh, qpos, tlo_f, thi_f, mode, word, qs, F.lds, r); }
            word <<= (2 * kt + 1 <= g) ? 0 : 16;
            { float sc[16]; b1_scores(a0, a1, iqf, w, sc); word = b1_mask_tile<true>(sc, 32 * (2 * kt) + 4 * hh, qpos, tlo_f, thi_f, mode, word, qs, F.lds, r); }
            MWl[kt * 64 + lane] = word; }
    }
    __syncthreads();
    if (g >= 8) {
        {
            const int q = 4 * wid + (lane >> 4), sl = lane & 15; LAS unsigned* MWq = MWl + q;
            unsigned L = qst[q].lcount; if (L > (unsigned)CAP) L = CAP; if (qst[q].mode != 1u) L = 0u;
            const LAS unsigned* lb = (const LAS unsigned*)(F.lds + (size_t)q * CAP * 8);
            unsigned key[16], jj[16];
#pragma unroll
            for (int k = 0; k < 16; ++k) { const unsigned c = sl + 16 * k; const bool has = c < L; key[k] = has ? ((lb[2 * c] & 0x1fffffu) | 0x200000u) : 0u; jj[k] = has ? lb[2 * c + 1] : 0u; }
            unsigned prefix = 0x200000u, need = qst[q].krem;
            for (int bit = 20; bit >= 0; --bit) { const unsigned want = (prefix >> bit) | 1u; unsigned cnt = 0;
#pragma unroll
                for (int k = 0; k < 16; ++k) cnt += ((key[k] >> bit) == want) ? 1u : 0u;
                cnt = rowsum16(cnt);
                if (cnt >= need) prefix |= (1u << bit); else need -= cnt; }
            unsigned ties = 0;
#pragma unroll
            for (int k = 0; k < 16; ++k) ties += (key[k] == prefix) ? 1u : 0u;
            ties = rowsum16(ties);
            unsigned p2 = 0u;
            if (__ballot(ties != need && L != 0u)) { p2 = 0x2000u; unsigned need2 = need;
                for (int bit = 12; bit >= 0; --bit) { const unsigned want = (p2 >> bit) | 1u; unsigned cnt = 0;
#pragma unroll
                    for (int k = 0; k < 16; ++k) cnt += (key[k] == prefix && (((0x2000u | (8191u - jj[k])) >> bit) == want)) ? 1u : 0u;
                    cnt = rowsum16(cnt);
                    if (cnt >= need2) p2 |= (1u << bit); else need2 -= cnt; } }
#pragma unroll
            for (int k = 0; k < 16; ++k) if (key[k] > prefix || (key[k] == prefix && (0x2000u | (8191u - jj[k])) >= p2)) b1_setbit(MWq, jj[k]);
        }
        for (int qq = 0; qq < 4; ++qq) { const int q = 4 * wid + qq; const unsigned mode = qst[q].mode, krem = qst[q].krem; LAS unsigned* MWq = MWl + q;
            if (mode == 1u) continue;
            { const LAS unsigned* bm = (const LAS unsigned*)(F.lds + 65536 + q * 1024); unsigned x[4]; unsigned s = 0;
#pragma unroll
                for (int k = 0; k < 4; ++k) { x[k] = bm[4 * lane + k]; s += __builtin_popcount(x[k]); }
                unsigned P = s;
#pragma unroll
                for (int o = 1; o < 64; o <<= 1) { const unsigned t = shup(P, lane, o); if (lane >= o) P += t; }
                unsigned before = P - s;
#pragma unroll
                for (int k = 0; k < 4; ++k) { unsigned y = x[k]; while (y != 0u && before < krem) { const unsigned bit = (unsigned)__builtin_ctz(y); y &= y - 1u; b1_setbit(MWq, 32u * (4 * lane + k) + bit); ++before; } before += __builtin_popcount(y); } }
        }
        __syncthreads();
    }
    {   const int nw4 = ((g >> 1) + 1) * 16;
        for (int i = tid; i < nw4; i += 512) *(u32x4*)(MWb + 4 * i) = *(const LAS u32x4*)(MWl + 4 * i); }
}

struct EngP { const bf16* Z; bf16* Y; const unsigned* MASK; const float* ST; const float* nw; float lam, lam_init; const unsigned* kmax; };
__device__ __forceinline__ int wq_next(Frame& F, unsigned* head) {
    LAS int* slot = (LAS int*)(F.lds + 55312);
    if (F.tid == 0) *slot = (int)__hip_atomic_fetch_add(head, 1u, __ATOMIC_RELAXED, __HIP_MEMORY_SCOPE_AGENT);
    __syncthreads(); const int u = *slot; __syncthreads();
    asm volatile("" : "+v"(F.tid), "+v"(F.lane));
    return u;
}
template <int MODE>
__device__ __forceinline__ void eng_unit(Frame& F, const EngP& P, int b, int h, int qb) {
    constexpr bool SOFT = MODE <= 1;
    constexpr int NMAP = MODE == 0 ? 2 : 1;
    constexpr int NS = (MODE == 0 || MODE == 3) ? 2 : 4;
    constexpr int KCH = MODE == 3 ? 4 : 8;
    constexpr int QC = MODE == 0 ? ZC_AQ : MODE == 1 ? ZC_BQ : MODE == 2 ? ZC_CQ : ZC_DQ;
    constexpr int KC = MODE == 0 ? ZC_AK : MODE == 1 ? ZC_BK : MODE == 2 ? ZC_CK : ZC_DK;
    constexpr int VC = MODE == 0 ? ZC_AV : MODE == 1 ? ZC_BV : MODE == 2 ? ZC_CV : ZC_DV;
    constexpr int HW = MODE == 3 ? 32 : 64;
    const int tid = F.tid, lane = F.lane, r = lane & 31, hh = lane >> 5, w = F.wave;
    const size_t rowbase = (size_t)b * SEQ;
    const int qw0 = qb * 256 + 32 * w;
    const float NEG = -__builtin_inff();
    const int hidx = MODE <= 1 ? (MODE == 0 ? 2 * h + 1 : 2 * h + 2) : 0;
    const float slope2 = SOFT ? __builtin_amdgcn_exp2f(-(float)hidx) * LOG2E : 0.f;
    bf16x8 qf[NMAP][NS];
    {   const bf16* qrow = P.Z + (rowbase + qw0 + r) * ZW + QC + h * HW;
#pragma unroll
        for (int m = 0; m < NMAP; ++m)
#pragma unroll
            for (int s = 0; s < NS; ++s) qf[m][s] = *(const bf16x8*)(qrow + m * 32 + 16 * s + 8 * hh); }
    f32x16 cinit;
#pragma unroll
    for (int e = 0; e < 16; ++e) cinit[e] = SOFT ? slope2 * (float)(crow_c(e) + 4 * hh) : 0.f;
    float m_run[NMAP], l_run[NMAP]; f32x16 O[NMAP][2];
#pragma unroll
    for (int m = 0; m < NMAP; ++m) { m_run[m] = NEG; l_run[m] = 0.f; O[m][0] = splat16(0.f); O[m][1] = splat16(0.f); }
    if (!SOFT) {
        const int sidx = MODE == 2 ? ((b * 4 + h) * 32 + qb) : ((b * 4 + h) * 128 + 4 * qb + (w >> 1));
        const float* sp = P.ST + (size_t)sidx * (64 * HW);
#pragma unroll
        for (int db = 0; db < 2; ++db)
#pragma unroll
            for (int s = 0; s < NS; ++s) { const float* a = sp + (size_t)(32 * db + r) * HW + 16 * s + 8 * hh; const f32x4 a0 = *(const f32x4*)a, a1 = *(const f32x4*)(a + 4);
                O[0][db] = mfma32(pack8(a0[0], a0[1], a0[2], a0[3], a1[0], a1[1], a1[2], a1[3]), qf[0][s], O[0][db]); }
    }
    const int kt_lo = SOFT ? 0 : 4 * qb, kt_hi = 4 * qb + 3;
    const int srow = tid >> 3, sch = tid & 7;
    float qk[NMAP];
    if (SOFT) {
#pragma unroll
        for (int m = 0; m < NMAP; ++m) { float ss = 0.f;
#pragma unroll
            for (int s = 0; s < NS; ++s) { const u32x4 qq = __builtin_bit_cast(u32x4, qf[m][s]); float v[8]; up8(qq, v);
#pragma unroll
                for (int i = 0; i < 8; ++i) ss += v[i] * v[i]; }
            ss += shx(ss, lane, 32);
            qk[m] = 1.02f * sqrtf(ss) * __uint_as_float(P.kmax[b * 16 + (MODE == 0 ? (h * 2 + m) : (8 + h))]) + 0.01f; }
    }
    LAS unsigned* wflag = (LAS unsigned*)(F.lds + 55296);
    if (SOFT && tid < 3) wflag[tid] = 0u;
    const int kt_first = SOFT ? kt_hi : kt_lo;
    const int nit = kt_hi - kt_lo + 1;
    u32x4 kreg = (u32x4){0u, 0u, 0u, 0u}, vreg;
    {   const bf16* zr = P.Z + (rowbase + 64 * kt_first + srow) * ZW;
        if (sch < KCH) kreg = *(const u32x4*)(zr + KC + h * HW + sch * 8);
        vreg = *(const u32x4*)(zr + VC + h * 64 + sch * 8);
        if (sch < KCH) *(LAS u32x4*)(F.lds + srow * 144 + sch * 16) = kreg;
        *(LAS u32x4*)(F.lds + 9216 + srow * 144 + sch * 16) = vreg;
        if (nit > 1) { const bf16* z1 = P.Z + (rowbase + 64 * (SOFT ? kt_first - 1 : kt_first + 1) + srow) * ZW;
            if (sch < KCH) kreg = *(const u32x4*)(z1 + KC + h * HW + sch * 8);
            vreg = *(const u32x4*)(z1 + VC + h * 64 + sch * 8); } }
    __syncthreads();
    bool wave_done = false;
    const unsigned* mwp = (MODE == 1) ? P.MASK + ((size_t)(b * 256 + qb * 8 + w) * 128) * 64 + lane : nullptr;
    unsigned mwn = 0xffffffffu; if (MODE == 1) mwn = mwp[(size_t)kt_first * 64];
    int sl_cur = 0, sl_nxt = 18432;
    for (int it = 0; it < nit; ++it) {
        const int kt = SOFT ? kt_hi - it : kt_lo + it, ktn = SOFT ? kt - 1 : kt + 1;
        const bool more = it + 1 < nit;
        const unsigned mw = mwn;
        if (more) { if (sch < KCH) *(LAS u32x4*)(F.lds + sl_nxt + srow * 144 + sch * 16) = kreg;
            *(LAS u32x4*)(F.lds + sl_nxt + 9216 + srow * 144 + sch * 16) = vreg;
            if (MODE == 1) mwn = mwp[(size_t)ktn * 64]; }
        if (it + 2 < nit) { const bf16* zr = P.Z + (rowbase + 64 * (SOFT ? kt - 2 : kt + 2) + srow) * ZW;
            if (sch < KCH) kreg = *(const u32x4*)(zr + KC + h * HW + sch * 8);
            vreg = *(const u32x4*)(zr + VC + h * 64 + sch * 8); }
        const int j0 = 64 * kt;
        const bool act = ((MODE == 3) ? (kt == 4 * qb + (w >> 1)) : (j0 <= qw0 + 31)) && !wave_done;
        if (act) {
            const LAS unsigned char* Kb = F.lds + sl_cur; const LAS unsigned char* Vb = F.lds + sl_cur + 9216;
            const bool hact1 = (j0 + 32 <= qw0 + 31);
#pragma unroll
            for (int m = 0; m < NMAP; ++m) {
                f32x16 st[2];
#pragma unroll
                for (int kh = 0; kh < 2; ++kh) {
                    if (kh == 0 || hact1) {
                        f32x16 a = cinit;
#pragma unroll
                        for (int s = 0; s < NS; ++s) { const bf16x8 kf = *(const LAS bf16x8*)(Kb + (32 * kh + r) * 144 + (m * 32 + 16 * s + 8 * hh) * 2); a = mfma32(kf, qf[m][s], a); }
                        if (j0 + 32 * kh + 31 > qw0) { const int lim = qw0 + r - j0 - 32 * kh - 4 * hh; asm volatile("; causal-mask block (kept a real branch: as selects it ran on every interior tile too)" ::: "memory");
#pragma unroll
                            for (int e = 0; e < 16; ++e) if (crow_c(e) > lim) a[e] = SOFT ? NEG : 0.f; }
                        if (MODE == 1) {
#pragma unroll
                            for (int e = 0; e < 16; ++e) if (!((mw >> (e + 16 * kh)) & 1u)) a[e] = NEG; }
                        st[kh] = a;
                    } else st[kh] = splat16(SOFT ? NEG : 0.f);
                }
                if (SOFT) {
                    const float off0 = slope2 * (float)(j0 - qw0 - r), off1 = off0 + 32.f * slope2;
                    float mx0 = st[0][0], mx1 = st[1][0];
#pragma unroll
                    for (int e = 1; e < 16; ++e) { mx0 = fmaxf(mx0, st[0][e]); mx1 = fmaxf(mx1, st[1][e]); }
                    float mx = fmaxf(mx0 + off0, mx1 + off1); mx = fmaxf(mx, shx(mx, lane, 32));
                    const float mn = fmaxf(m_run[m], mx); const float msafe = (mn == NEG) ? 0.f : mn;
                    const float alpha = __builtin_amdgcn_exp2f(m_run[m] - msafe); m_run[m] = mn;
                    const float d0 = off0 - msafe, d1 = off1 - msafe; float rs = 0.f;
#pragma unroll
                    for (int e = 0; e < 16; ++e) { const float p0 = __builtin_amdgcn_exp2f(st[0][e] + d0), p1 = __builtin_amdgcn_exp2f(st[1][e] + d1); st[0][e] = p0; st[1][e] = p1; rs += p0 + p1; }
                    rs += shx(rs, lane, 32); l_run[m] = l_run[m] * alpha + rs;
#pragma unroll
                    for (int e = 0; e < 16; ++e) { O[m][0][e] *= alpha; O[m][1][e] *= alpha; }
                }
#pragma unroll
                for (int kh = 0; kh < 2; ++kh) {
                    if (kh == 0 || hact1) {
#pragma unroll
                        for (int s = 0; s < 2; ++s) {
                            const bf16x8 pf = pack8(st[kh][8 * s], st[kh][8 * s + 1], st[kh][8 * s + 2], st[kh][8 * s + 3], st[kh][8 * s + 4], st[kh][8 * s + 5], st[kh][8 * s + 6], st[kh][8 * s + 7]);
#pragma unroll
                            for (int db = 0; db < 2; ++db) {
                                const LAS unsigned char* vp = Vb + (32 * kh + 16 * s + 4 * hh + ((lane & 15) >> 2)) * 144 + (32 * db + 16 * ((lane >> 4) & 1) + 4 * (lane & 3)) * 2;
                                const s16x4 lo = vtr(vp), hi = vtr(vp + 8 * 144);
                                const bf16x8 vf = (bf16x8){lo[0], lo[1], lo[2], lo[3], hi[0], hi[1], hi[2], hi[3]};
                                O[m][db] = mfma32(vf, pf, O[m][db]); } } } }
            }
            if (SOFT) {
                const float dist = slope2 * (float)(qw0 + r - (j0 - 1)); bool fin = true;
#pragma unroll
                for (int m = 0; m < NMAP; ++m) fin = fin && (qk[m] - dist - m_run[m] < -32.f);
                wave_done = (__ballot(fin) == ~0ull);
            }
        }
        if (SOFT && !wave_done && lane == 0) wflag[it % 3] = 1u;
        sl_cur = sl_nxt; sl_nxt = (sl_nxt == 36864) ? 0 : sl_nxt + 18432;
        __syncthreads();
        if (SOFT) { const unsigned any = wflag[it % 3]; if (tid == 0) wflag[(it + 2) % 3] = 0u; if (any == 0u) break; }
    }
    const size_t orow = rowbase + qw0 + r;
    const int ycol = MODE * 256 + h * 64;
    f32x16 o[2];
    if (MODE == 0) { const float i0 = 1.f / l_run[0], i1 = P.lam / l_run[NMAP - 1];
#pragma unroll
        for (int db = 0; db < 2; ++db)
#pragma unroll
            for (int e = 0; e < 16; ++e) o[db][e] = O[0][db][e] * i0 - O[NMAP - 1][db][e] * i1; }
    else if (MODE == 1) { const float i0 = 1.f / l_run[0];
#pragma unroll
        for (int db = 0; db < 2; ++db)
#pragma unroll
            for (int e = 0; e < 16; ++e) o[db][e] = O[0][db][e] * i0; }
    else { o[0] = O[0][0]; o[1] = O[0][1]; }
    float mu = 0.f;
    if (MODE == 2) { float s = 0.f;
#pragma unroll
        for (int db = 0; db < 2; ++db)
#pragma unroll
            for (int e = 0; e < 16; ++e) s += o[db][e];
        s += shx(s, lane, 32); mu = s * (1.f / 64.f); }
    float ss = 0.f;
    if (MODE != 1) {
#pragma unroll
        for (int db = 0; db < 2; ++db)
#pragma unroll
            for (int e = 0; e < 16; ++e) { const float d = o[db][e] - mu; ss += d * d; }
        ss += shx(ss, lane, 32); }
    float rn = 1.f;
    if (MODE != 1) rn = 1.f / sqrtf(ss * (1.f / 64.f) + LN_EPS);
    if (MODE == 0) rn *= (1.f - P.lam_init);
#pragma unroll
    for (int db = 0; db < 2; ++db)
#pragma unroll
        for (int g4 = 0; g4 < 4; ++g4) { const int d0 = 32 * db + 8 * g4 + 4 * hh; float v[4];
#pragma unroll
            for (int i = 0; i < 4; ++i) v[i] = o[db][4 * g4 + i];
            if (MODE != 1) { const f32x4 nw = *(const f32x4*)(P.nw + (MODE == 2 ? h * 64 : 0) + d0);
#pragma unroll
                for (int i = 0; i < 4; ++i) v[i] = (v[i] - mu) * rn * nw[i]; }
            if (MODE >= 2) { const u32x2 gw = *(const u32x2*)(P.Z + orow * ZW + (MODE == 2 ? ZC_CG : ZC_DG) + h * 64 + d0);
                const float g0 = bflo(gw.x), g1 = bfhi(gw.x), g2 = bflo(gw.y), g3 = bfhi(gw.y);
                v[0] *= g0 * sigmoidf_(g0); v[1] *= g1 * sigmoidf_(g1); v[2] *= g2 * sigmoidf_(g2); v[3] *= g3 * sigmoidf_(g3); }
            u32x2 ow; ow.x = pk2(v[0], v[1]); ow.y = pk2(v[2], v[3]);
            *(u32x2*)(P.Y + orow * DM + ycol + d0) = ow; }
}
}

constexpr int PH_PER_LAYER = 12, N_PHASES = 1 + DEPTH * PH_PER_LAYER;

typedef __attribute__((address_space(4))) const Args* KArgP;
#ifdef ONLY_SITE
#define SITE(s) ((s) == ONLY_SITE)
#else
#define SITE(s) true
#endif
#if MK_ONE_LAUNCH
#define IN(k) true
#define SEAM(k) do { if ((k) + 1 < N_PHASES) { XcdBarrier b2_ = bar; asm volatile("" : "+s"(b2_.bar), "+s"(b2_.x)); xcd_barrier(b2_, F.tid == 0); } } while (0)
#else
#define IN(k) (lo <= (k) && (k) < hi)
#define SEAM(k) do { } while (0)
#endif
#define SITE_BEGIN KArgP KA = (KArgP)__builtin_amdgcn_kernarg_segment_ptr(); do { asm volatile("" : "+s"(KA)); \
        int ln_; asm volatile("v_mbcnt_lo_u32_b32 %0, -1, 0\n\tv_mbcnt_hi_u32_b32 %0, -1, %0" : "=v"(ln_)); \
        const unsigned simd_ = (unsigned)__builtin_amdgcn_s_getreg(((2 - 1) << 11) | (4 << 6) | 4);   \
        unsigned tk_ = 0u, tg_ = 0u; if (ln_ == 0) { tk_ = __hip_atomic_fetch_add((LAS unsigned*)(F.lds + MISC_OFF + 64) + simd_, 1u, __ATOMIC_RELAXED, __HIP_MEMORY_SCOPE_WORKGROUP); \
            tg_ = __hip_atomic_fetch_add((LAS unsigned*)(F.lds + MISC_OFF + 96), 1u, __ATOMIC_RELAXED, __HIP_MEMORY_SCOPE_WORKGROUP); } \
        F.wave = __builtin_amdgcn_readfirstlane(simd_balanced ? (int)(simd_ + 4u * (tk_ & 1u)) : (int)(tg_ & 7u)); F.lane = ln_; F.tid = F.wave * 64 + F.lane; \
        F.ws = KA->ws; F.dob = (unsigned char*)KA->out; F.G = G0; F.wg = wg0; asm volatile("" : "+s"(F.G), "+s"(F.wg)); } while (0)


__global__ void __launch_bounds__(NWAVES * 64, 2) fwd_kernel(Args args) {
    extern __shared__ __attribute__((aligned(16))) unsigned char lds_raw[];
    Frame F;
    F.lds = (LAS unsigned char*)lds_raw;
    F.tid = threadIdx.x; F.lane = F.tid & 63; F.wave = __builtin_amdgcn_readfirstlane(F.tid >> 6);
    F.G = gridDim.x; F.wg = blockIdx.x;
    F.ws = args.ws; F.dob = (unsigned char*)args.out;
    volatile LAS unsigned* MISC = (volatile LAS unsigned*)(F.lds + MISC_OFF);
    if (F.tid < 32) MISC[F.tid] = 0u;
    __syncthreads();
    if (F.lane == 0) __hip_atomic_fetch_add((LAS unsigned*)(F.lds + MISC_OFF + 112) + ((unsigned)__builtin_amdgcn_s_getreg(((2 - 1) << 11) | (4 << 6) | 4)), 1u, __ATOMIC_RELAXED, __HIP_MEMORY_SCOPE_WORKGROUP);
    __syncthreads();
    const bool simd_balanced = (MISC[28] == 2u) && (MISC[29] == 2u) && (MISC[30] == 2u) && (MISC[31] == 2u);
    unsigned* ctl = (unsigned*)(F.ws + WS_CTL);
    XcdBarrier bar; bar.bar = ctl + CW_BAR; bar.x = 0; bar.st = nullptr;
#if MK_ONE_LAUNCH
    bar = xcd_barrier_post(ctl + CW_BAR, MISC + 8);
#endif
    const int lo = args.ph_lo, hi = args.ph_hi, subm = args.sub;
    const int G0 = F.G, wg0 = F.wg;
    if (SITE(0) && IN(0)) { SITE_BEGIN; p0_prologue(F, KA); SEAM(0); }

    for (int l = 0; l < DEPTH; ++l) {
        const int pb = 1 + l * PH_PER_LAYER;
        if (SITE(1) && IN(pb + 0)) { SITE_BEGIN; const char* XBc = (const char*)(F.ws + WS_XB); (void)XBc; const unsigned char* w123 = F.ws + WS_W123; const unsigned char* w45 = F.ws + WS_W45 + (size_t)l * W45_STRIDE; (void)w123; (void)w45;
            pg8::EpiStore E{(bf16*)(F.ws + WS_Z), ZW, F.ws + WS_IKC};
            {   pg8::SchedTiles S{XBc, (const char*)(w123 + W123_W1), 2048, 2048, 16, 6, G1_BF_TILES, 0, F.G, F.wg};
                { int tl_ = F.tid; asm volatile("" : "+v"(tl_)); pg8::gemm_phase(F.lds, S, E, tl_); } }
            {   pg8::SchedTiles S{(const char*)(F.dob + DO_XB8), (const char*)(F.dob + DO_W8 + (size_t)l * W8_STRIDE + W8_Z), 1024, 1024, 8, 8, G1_F8_TILES, 1, F.G, F.wg};
                { int tl_ = F.tid; asm volatile("" : "+v"(tl_)); pg8::gemm_phase<pg8::EpiStore, pg8::SchedTiles, true>(F.lds, S, E, tl_); } }
            SEAM(pb + 0);
        }
        if (SITE(2) && IN(pb + 1)) { SITE_BEGIN; const char* XBc = (const char*)(F.ws + WS_XB); (void)XBc; const unsigned char* w123 = F.ws + WS_W123; const unsigned char* w45 = F.ws + WS_W45 + (size_t)l * W45_STRIDE; (void)w123; (void)w45;
            {   unsigned* head = (unsigned*)(F.ws + WS_CTL) + CW_WQ + l * 64 + 32;
                for (;;) { const int i = mx::wq_next(F, head); if (i >= 128 + 1024) break;
                    if (i < 128) { if (subm & 2) mx::prepkv_unit(F, i, KA->in[6] + (size_t)l * 16 * 128, KA->in[7] + l * 128, (unsigned*)(F.ws + WS_CTL) + CW_KMAX + l * 64); }
                    else if (subm & 1) { const int u = i - 128; mx::b1_unit(F, u & 3, 255 - (u >> 2)); } } }
            SEAM(pb + 1);
        }
        if (SITE(3) && IN(pb + 2)) { SITE_BEGIN; const char* XBc = (const char*)(F.ws + WS_XB); (void)XBc; const unsigned char* w123 = F.ws + WS_W123; const unsigned char* w45 = F.ws + WS_W45 + (size_t)l * W45_STRIDE; (void)w123; (void)w45;
            if (subm & 1) mx::scan_phase(F);
            float lam_init = 0.8f - 0.6f * __expf(-0.3f * (float)l);
            const float* lp = KA->in[3] + l * 128; float s01 = 0.f, s23 = 0.f;
            for (int i = 0; i < 32; ++i) { s01 += lp[i] * lp[32 + i]; s23 += lp[64 + i] * lp[96 + i]; }
            mx::EngP P{(const bf16*)(F.ws + WS_Z), (bf16*)(F.ws + WS_Y), nullptr, nullptr, KA->in[4] + l * 64, __expf(s01) - __expf(s23) + lam_init, lam_init, (const unsigned*)(F.ws + WS_CTL) + CW_KMAX + l * 64};
            {   unsigned* head = (unsigned*)(F.ws + WS_CTL) + CW_WQ + l * 64;
                for (;;) { const int i = mx::wq_next(F, head); if (i >= 512) break; const int j = i & 127; mx::eng_unit<0>(F, P, j & 3, 3 - (i >> 7), 31 - (j >> 2)); } }
            SEAM(pb + 2);
        }
        if (SITE(4) && IN(pb + 3)) { SITE_BEGIN; const char* XBc = (const char*)(F.ws + WS_XB); (void)XBc; const unsigned char* w123 = F.ws + WS_W123; const unsigned char* w45 = F.ws + WS_W45 + (size_t)l * W45_STRIDE; (void)w123; (void)w45;
            {   unsigned* head = (unsigned*)(F.ws + WS_CTL) + CW_WQ + l * 64 + 16;
                const mx::EngP PB{(const bf16*)(F.ws + WS_Z), (bf16*)(F.ws + WS_Y), (const unsigned*)(F.ws + WS_MASK), nullptr, nullptr, 0.f, 0.f, (const unsigned*)(F.ws + WS_CTL) + CW_KMAX + l * 64};
                const mx::EngP PC{(const bf16*)(F.ws + WS_Z), (bf16*)(F.ws + WS_Y), nullptr, (const float*)(F.ws + WS_KVC), KA->in[5] + l * 256, 0.f, 0.f, nullptr};
                const mx::EngP PD{(const bf16*)(F.ws + WS_Z), (bf16*)(F.ws + WS_Y), nullptr, (const float*)(F.ws + WS_KVD), KA->in[8] + l * 64, 0.f, 0.f, nullptr};
                for (;;) { const int i = mx::wq_next(F, head); if (i >= 1536) break;
                    if (i < 512) { if (subm & 1) { const int j = i & 127; mx::eng_unit<1>(F, PB, j & 3, 3 - (i >> 7), 31 - (j >> 2)); } }
                    else if (!(subm & (i < 1024 ? 2 : 4))) continue;
                    else if (i < 1024) { const int u = i - 512; mx::eng_unit<2>(F, PC, u >> 7, (u >> 5) & 3, u & 31); }
                    else { const int u = i - 1024; mx::eng_unit<3>(F, PD, u >> 7, (u >> 5) & 3, u & 31); } } }
            SEAM(pb + 3);
        }
        if (SITE(5) && IN(pb + 4)) { SITE_BEGIN;
            const unsigned char* w123 = F.ws + WS_W123;
            for (int n = 0; n < 4; ++n) {
                {   pg8::SchedPlain S{(const char*)(F.dob + DO_XB8), (const char*)(F.dob + DO_W8 + (size_t)l * W8_STRIDE + W8_G) + (size_t)n * 1024 * 1024, 1024, 1024, 8, 128, 4, F.G, F.wg};
                    pg8::EpiSlotStore E{F.ws + WS_SCR2 + (size_t)F.wg * 262144, 1};
                    { int tl_ = F.tid; asm volatile("" : "+v"(tl_)); pg8::gemm_phase<pg8::EpiSlotStore, pg8::SchedPlain, true>(F.lds, S, E, tl_); } }
                {   pg8::SchedPlain S{(const char*)(F.ws + WS_Y) + n * 512, (const char*)(w123 + W123_GB + 8 * MiB) + (size_t)n * 1024 * 512, 2048, 512, 4, 128, 4, F.G, F.wg};
                    pg8::EpiBranch E{F.ws + WS_SCR2 + (size_t)F.wg * 262144, (bf16*)(F.ws + WS_MERGED), n == 0};
                    { int tl_ = F.tid; asm volatile("" : "+v"(tl_)); pg8::gemm_phase(F.lds, S, E, tl_); } }
            }
            SEAM(pb + 4);
        }
        if (SITE(6) && IN(pb + 5)) { SITE_BEGIN; const char* XBc = (const char*)(F.ws + WS_XB); (void)XBc; const unsigned char* w123 = F.ws + WS_W123; const unsigned char* w45 = F.ws + WS_W45 + (size_t)l * W45_STRIDE; (void)w123; (void)w45;
            pg8::SchedPlain S{(const char*)(F.ws + WS_MERGED), (const char*)(w123 + W123_WO), 2048, 2048, 16, 128, 4, F.G, F.wg};
            pg8::EpiG3 E{(bf16*)(F.ws + WS_XB)};
            pg8::gemm_phase(F.lds, S, E, F.tid);
            SEAM(pb + 5);
        }
        if (SITE(7) && IN(pb + 6)) { SITE_BEGIN; const char* XBc = (const char*)(F.ws + WS_XB); (void)XBc; const unsigned char* w123 = F.ws + WS_W123; const unsigned char* w45 = F.ws + WS_W45 + (size_t)l * W45_STRIDE; (void)w123; (void)w45; ln_phase(F, KA->in[11] + l * DM, KA->in[12] + l * DM, nullptr, F.dob + DO_XB8);
            if (l + 1 < DEPTH) convert_w123(F, KA->in[2] + (size_t)(l + 1) * DM * NIN, KA->in[9] + (size_t)(l + 1) * 4 * 256 * DM, KA->in[10] + (size_t)(l + 1) * DM * DM);
            SEAM(pb + 6); }
        if (SITE(8) && IN(pb + 7)) { SITE_BEGIN; const char* XBc = (const char*)(F.ws + WS_XB); (void)XBc; const unsigned char* w123 = F.ws + WS_W123; const unsigned char* w45 = F.ws + WS_W45 + (size_t)l * W45_STRIDE; (void)w123; (void)w45;
            pg8::SchedUp S{(const char*)(F.dob + DO_XB8), (const char*)(F.dob + DO_W8 + (size_t)l * W8_STRIDE + W8_UP), F.G, F.wg};
            pg8::EpiUp E{(bf16*)(F.ws + WS_GE), (bf16*)(F.ws + WS_G0), (bf16*)(F.ws + WS_U0), F.ws + WS_ACT8, KA->in[14] + (size_t)l * 3 * DFF, KA->in[15] + (size_t)l * DFF};
            pg8::gemm_phase<pg8::EpiUp, pg8::SchedUp, true>(F.lds, S, E, F.tid);
            SEAM(pb + 7);
        }
        if (SITE(9) && IN(pb + 8)) { SITE_BEGIN; const char* XBc = (const char*)(F.ws + WS_XB); (void)XBc; const unsigned char* w123 = F.ws + WS_W123; const unsigned char* w45 = F.ws + WS_W45 + (size_t)l * W45_STRIDE; (void)w123; (void)w45; ffn_act_phase(F, KA->in[14] + (size_t)l * 3 * DFF, KA->in[15] + (size_t)l * DFF);   }
        if (SITE(10) && IN(pb + 9)) { SITE_BEGIN;
            const unsigned char* w45 = F.ws + WS_W45 + (size_t)l * W45_STRIDE;
            {   pg8::SchedPlain S{(const char*)(F.ws + WS_PB + (size_t)l * M * PDIM * 2), (const char*)(w45 + W45_PP), 512, 512, 4, 128, 4, F.G, F.wg};
                pg8::EpiSlotStore E{F.dob + DO_SCR5 + (size_t)F.wg * 262144, 0};
                { int tl_ = F.tid; asm volatile("" : "+v"(tl_)); pg8::gemm_phase(F.lds, S, E, tl_); } }
            {   pg8::SchedPlain S{(const char*)(F.dob + DO_XB8), (const char*)(F.dob + DO_W8 + (size_t)l * W8_STRIDE + W8_PG), 1024, 1024, 8, 128, 4, F.G, F.wg};
                pg8::EpiSlotMul E{F.dob + DO_SCR5 + (size_t)F.wg * 262144};
                { int tl_ = F.tid; asm volatile("" : "+v"(tl_)); pg8::gemm_phase<pg8::EpiSlotMul, pg8::SchedPlain, true>(F.lds, S, E, tl_); } }
            SEAM(pb + 9);
        }
        if (SITE(11) && IN(pb + 10)) { SITE_BEGIN;
            const unsigned char* w45 = F.ws + WS_W45 + (size_t)l * W45_STRIDE;
            pg8::SchedG5b S{(const char*)(F.ws + WS_ACT8), (const char*)(F.dob + DO_W8 + (size_t)l * W8_STRIDE + W8_DN), F.G, F.wg};
            pg8::EpiG5b E{F.dob + DO_SCR5 + (size_t)F.wg * 262144, (bf16*)(F.ws + WS_XB)};
            pg8::gemm_phase<pg8::EpiG5b, pg8::SchedG5b, true>(F.lds, S, E, F.tid);
            SEAM(pb + 10);
        }
        if (SITE(12) && IN(pb + 11)) { SITE_BEGIN; const char* XBc = (const char*)(F.ws + WS_XB); (void)XBc; const unsigned char* w123 = F.ws + WS_W123; const unsigned char* w45 = F.ws + WS_W45 + (size_t)l * W45_STRIDE; (void)w123; (void)w45; ln_phase(F, KA->in[19] + l * DM, KA->in[20] + l * DM, l == DEPTH - 1 ? KA->out : nullptr, l == DEPTH - 1 ? nullptr : F.dob + DO_XB8); SEAM(pb + 11); }
    }
#undef IN
#undef SEAM
}

extern "C" void kernel_launch(void* const* d_in, const int* in_sizes, int n_in, void* d_out, int out_size, void* d_ws, size_t ws_size, hipStream_t stream) {
    static int grid = 0;
    if (grid == 0) {
        if (n_in != 21 || out_size != M * DM || ws_size < WS_END) { fprintf(stderr, "kernel_launch: unexpected shapes (n_in %d out %d ws %zu)\n", n_in, out_size, ws_size); grid = -1; return; }
        int dev = 0, cus = 0, per_cu = 0;
        if (hipGetDevice(&dev) != hipSuccess || hipDeviceGetAttribute(&cus, hipDeviceAttributeMultiprocessorCount, dev) != hipSuccess) { grid = -1; return; }
        if (hipFuncSetAttribute((const void*)fwd_kernel, hipFuncAttributeMaxDynamicSharedMemorySize, LDS_BYTES) != hipSuccess) { grid = -1; return; }
        if (hipOccupancyMaxActiveBlocksPerMultiprocessor(&per_cu, (const void*)fwd_kernel, NWAVES * 64, LDS_BYTES) != hipSuccess || per_cu < 1)
            fprintf(stderr, "kernel_launch: occupancy query reports %d\n", per_cu);
        (void)hipGetLastError();
        grid = cus;
    }
    if (grid < 0) return;
    (void)hipMemsetAsync((char*)d_ws + WS_CTL, 0, CTL_ZERO_BYTES, stream);
    Args a{};
    for (int i = 0; i < 21; ++i) a.in[i] = (const float*)d_in[i];
    a.out = (float*)d_out; a.ws = (unsigned char*)d_ws;
#if MK_ONE_LAUNCH
    a.ph_lo = 0; a.ph_hi = N_PHASES; a.sub = 7;
    hipLaunchKernelGGL(fwd_kernel, dim3(grid), dim3(NWAVES * 64), LDS_BYTES, stream, a);
#else
    for (int p = 0; p < N_PHASES; ++p) { a.ph_lo = p; a.ph_hi = p + 1; a.sub = 7;
        hipLaunchKernelGGL(fwd_kernel, dim3(grid), dim3(NWAVES * 64), LDS_BYTES, stream, a);
#ifdef PROBE_PHASE
        if (p >= 1 && (p - 1) % PH_PER_LAYER == PROBE_PHASE) { (void)hipMemsetAsync((char*)d_ws + WS_CTL + CW_WQ * 4, 0, 1024, stream); a.sub = PROBE_SUB;
            hipLaunchKernelGGL(fwd_kernel, dim3(grid), dim3(NWAVES * 64), LDS_BYTES, stream, a); }
#endif
    }
#endif
}
```
